# Optimizing an MI355X kernel written in HIP

```python
import math
import jax, jax.numpy as jnp
from jax import lax
import numpy as np

D_MODEL = 1024
BATCH = 4
SEQ = 8192
DEPTH = 2

N_META = 16
EPS = 1e-6
LRU_WIDTH = D_MODEL
LRU_BLOCKS = 4
LRU_BLOCK = LRU_WIDTH // LRU_BLOCKS
CONV_WIDTH = 4
LRU_C = 8.0
SSM_WIDTH = D_MODEL // 2
SSM_GROUP = 16
SSM_GROUPS = SSM_WIDTH // SSM_GROUP
SSM_STATE = 64
EVEN_IN = 2 * LRU_WIDTH + SSM_WIDTH
EVEN_MIX = LRU_WIDTH + SSM_WIDTH
D_FF = 3 * D_MODEL
GLA_HEADS = 4
GLA_DK = D_MODEL // 2 // GLA_HEADS
GLA_DV = D_MODEL // GLA_HEADS
GLA_KEY = GLA_HEADS * GLA_DK
GLA_VAL = GLA_HEADS * GLA_DV
GLA_RANK = 16
GLA_TAU = 16.0
GLA_CHUNK = 64
ODD_IN = 2 * GLA_KEY + 2 * GLA_VAL + GLA_RANK
N_EXPERTS = 8
TOP_K = 2
D_FF_EXPERT = 7 * D_MODEL // 2
N_EVEN = (DEPTH + 1) // 2
N_ODD = DEPTH // 2

kernel_name = "hybrid_rglru_s5_gla_moe_meta"

F32 = jnp.float32


def rms_norm(x, g):
    xf = x.astype(F32)
    y = xf * lax.rsqrt(jnp.mean(xf * xf, axis=-1, keepdims=True) + EPS)
    return (y * g.astype(F32)).astype(x.dtype)


def swiglu(h, w_gate, w_up, w_down):
    return (jax.nn.silu(h @ w_gate) * (h @ w_up)) @ w_down


def causal_conv(x, w, b):
    K = w.shape[0]
    L = x.shape[1]
    xp = jnp.pad(x, ((0, 0), (K - 1, 0), (0, 0)))
    return b + sum(w[k] * xp[:, k:k + L] for k in range(K))


def _real_combine(e1, e2):
    a1, b1 = e1
    a2, b2 = e2
    return a1 * a2, a2 * b1 + b2


def _complex_combine(e1, e2):
    ar1, ai1, br1, bi1 = e1
    ar2, ai2, br2, bi2 = e2
    return (ar1 * ar2 - ai1 * ai2,
            ar1 * ai2 + ai1 * ar2,
            ar2 * br1 - ai2 * bi1 + br2,
            ar2 * bi1 + ai2 * br1 + bi2)


def rg_lru(x, gate_a_w, gate_a_b, gate_x_w, gate_x_b, lam):
    B_, L, _ = x.shape
    xb = x.reshape(B_, L, LRU_BLOCKS, LRU_BLOCK)
    r = jax.nn.sigmoid(jnp.einsum('blhi,hij->blhj', xb, gate_a_w).reshape(B_, L, LRU_WIDTH) + gate_a_b)
    i = jax.nn.sigmoid(jnp.einsum('blhi,hij->blhj', xb, gate_x_w).reshape(B_, L, LRU_WIDTH) + gate_x_b)
    log_a = -LRU_C * r.astype(F32) * jax.nn.softplus(-lam.astype(F32))
    a = jnp.exp(log_a)
    b = jnp.sqrt(-jnp.expm1(2.0 * log_a)) * (i * x).astype(F32)
    _, h = lax.associative_scan(_real_combine, (a, b), axis=1)
    return h.astype(x.dtype)


def s5_ssm(u, lam_re, lam_im, log_dt, b_re, b_im, c_re, c_im, d, glu_w, glu_b):
    B_, L, _ = u.shape
    lr, li = lam_re.astype(F32), lam_im.astype(F32)
    dt = jnp.exp(log_dt.astype(F32))[:, None]
    mag = jnp.exp(dt * lr)
    ar, ai = mag * jnp.cos(dt * li), mag * jnp.sin(dt * li)
    den = lr * lr + li * li
    nr = ar - 1.0
    zr = (nr * lr + ai * li) / den
    zi = (ai * lr - nr * li) / den
    br_ = zr[..., None] * b_re.astype(F32) - zi[..., None] * b_im.astype(F32)
    bi_ = zr[..., None] * b_im.astype(F32) + zi[..., None] * b_re.astype(F32)
    ug = u.reshape(B_, L, SSM_GROUPS, SSM_GROUP).astype(F32)
    xr = jnp.einsum('blgh,gnh->blgn', ug, br_)
    xi = jnp.einsum('blgh,gnh->blgn', ug, bi_)
    a_shape = (1, L, SSM_GROUPS, SSM_STATE)
    ar_t = jnp.broadcast_to(ar[None, None], a_shape)
    ai_t = jnp.broadcast_to(ai[None, None], a_shape)
    _, _, hr, hi = lax.associative_scan(_complex_combine, (ar_t, ai_t, xr, xi), axis=1)
    y = (jnp.einsum('blgn,ghn->blgh', hr, c_re.astype(F32))
         - jnp.einsum('blgn,ghn->blgh', hi, c_im.astype(F32)))
    y = y.reshape(B_, L, SSM_WIDTH) + d.astype(F32) * u.astype(F32)
    g = jax.nn.gelu(y).astype(u.dtype)
    return g * jax.nn.sigmoid(g @ glu_w + glu_b)


def even_mixer(h, w_in, conv_w, conv_b, gate_a_w, gate_a_b, gate_x_w, gate_x_b, lru_lambda,
               lam_re, lam_im, log_dt, b_re, b_im, c_re, c_im, d, glu_w, glu_b, w_out):
    z = h @ w_in
    gate_branch = z[..., :LRU_WIDTH]
    rec_branch = z[..., LRU_WIDTH:2 * LRU_WIDTH]
    ssm_in = z[..., 2 * LRU_WIDTH:]
    rec = rg_lru(causal_conv(rec_branch, conv_w, conv_b), gate_a_w, gate_a_b, gate_x_w, gate_x_b, lru_lambda)
    a_out = jax.nn.gelu(gate_branch) * rec
    b_out = s5_ssm(ssm_in, lam_re, lam_im, log_dt, b_re, b_im, c_re, c_im, d, glu_w, glu_b)
    return (jnp.concatenate([a_out, b_out.astype(h.dtype)], axis=-1) @ w_out).astype(h.dtype)


def gla_chunk(S, q, k, v, lg):
    size = q.shape[2]
    b = jnp.cumsum(lg, axis=2)
    causal = jnp.tril(jnp.ones((size, size), dtype=bool))[:, :, None]
    diff = b[:, :, :, None, :] - b[:, :, None, :, :]
    decay = jnp.exp(jnp.where(causal, diff, -jnp.inf))
    att = jnp.einsum('bhtk,bhsk,bhtsk->bhts', q, k, decay)
    o = jnp.einsum('bhts,bhsv->bhtv', att, v) + jnp.einsum('bhtk,bhkv->bhtv', q * jnp.exp(b), S)
    b_last = b[:, :, -1:, :]
    S_new = (jnp.exp(b_last[:, :, 0, :])[..., None] * S
             + jnp.einsum('bhsk,bhsv->bhkv', k * jnp.exp(b_last - b), v))
    return S_new, o


def gla_mixer(h, w_in, gate_w2, gate_b, head_norm, w_out):
    B_, L, _ = h.shape
    z = h @ w_in
    q = z[..., :GLA_KEY] * (GLA_DK ** -0.5)
    k = z[..., GLA_KEY:2 * GLA_KEY]
    v = z[..., 2 * GLA_KEY:2 * GLA_KEY + GLA_VAL]
    g = z[..., 2 * GLA_KEY + GLA_VAL:2 * GLA_KEY + 2 * GLA_VAL]
    glr = z[..., 2 * GLA_KEY + 2 * GLA_VAL:]
    lg = jax.nn.log_sigmoid((glr @ gate_w2 + gate_b).astype(F32)) / GLA_TAU

    def heads(t, dh):
        return t.reshape(B_, L, GLA_HEADS, dh).transpose(0, 2, 1, 3).astype(F32)

    q, k, lg, v = heads(q, GLA_DK), heads(k, GLA_DK), heads(lg, GLA_DK), heads(v, GLA_DV)
    S0 = jnp.zeros((B_, GLA_HEADS, GLA_DK, GLA_DV), F32)
    S1, o_meta = gla_chunk(S0, q[:, :, :N_META], k[:, :, :N_META], v[:, :, :N_META], lg[:, :, :N_META])
    n_chunks = (L - N_META) // GLA_CHUNK

    def to_chunks(t):
        return t[:, :, N_META:].reshape(B_, GLA_HEADS, n_chunks, GLA_CHUNK, t.shape[-1]).transpose(2, 0, 1, 3, 4)

    _, o_real = lax.scan(lambda S, xs: gla_chunk(S, *xs), S1,
                         (to_chunks(q), to_chunks(k), to_chunks(v), to_chunks(lg)))
    o_real = o_real.transpose(1, 2, 0, 3, 4).reshape(B_, GLA_HEADS, L - N_META, GLA_DV)
    o = jnp.concatenate([o_meta, o_real], axis=2).transpose(0, 2, 1, 3)
    o = o * lax.rsqrt(jnp.mean(o * o, axis=-1, keepdims=True) + EPS)
    o = o.reshape(B_, L, GLA_VAL) * head_norm.astype(F32)
    o = o.astype(h.dtype) * jax.nn.silu(g)
    return o @ w_out


def moe_swiglu(h, router_w, w_gate, w_up, w_down):
    logits = (h @ router_w).astype(F32)
    top_v, top_i = lax.top_k(logits, TOP_K)
    top_w = jax.nn.softmax(top_v, axis=-1)
    gates = jnp.sum(jax.nn.one_hot(top_i, N_EXPERTS, dtype=F32) * top_w[..., None], axis=-2)
    out = jnp.zeros_like(h)
    for e in range(N_EXPERTS):
        out = out + gates[..., e:e + 1].astype(h.dtype) * swiglu(h, w_gate[e], w_up[e], w_down[e])
    return out


def _normal(key, shape, scale):
    return scale * jax.random.normal(key, shape, F32)


def setup_inputs(seed: int = 0) -> dict:
    key = jax.random.key(seed)
    ks = iter(jax.random.split(key, 48))
    D, E, O = D_MODEL, N_EVEN, N_ODD
    G, N, H = SSM_GROUPS, SSM_STATE, SSM_GROUP
    x = _normal(next(ks), (BATCH, SEQ, D), 1.0)
    meta_tokens = _normal(next(ks), (N_META, D), 1.0)
    ev_norm_mix = 1.0 + _normal(next(ks), (E, D), 0.02)
    ev_w_in = _normal(next(ks), (E, D, EVEN_IN), D ** -0.5)
    ev_conv_w = _normal(next(ks), (E, CONV_WIDTH, LRU_WIDTH), CONV_WIDTH ** -0.5)
    ev_conv_b = _normal(next(ks), (E, LRU_WIDTH), 0.01)
    ev_gate_a_w = _normal(next(ks), (E, LRU_BLOCKS, LRU_BLOCK, LRU_BLOCK), LRU_BLOCK ** -0.5)
    ev_gate_a_b = _normal(next(ks), (E, LRU_WIDTH), 0.01)
    ev_gate_x_w = _normal(next(ks), (E, LRU_BLOCKS, LRU_BLOCK, LRU_BLOCK), LRU_BLOCK ** -0.5)
    ev_gate_x_b = _normal(next(ks), (E, LRU_WIDTH), 0.01)
    a_c = jax.random.uniform(next(ks), (E, LRU_WIDTH), F32, minval=0.9, maxval=0.999)
    s = a_c ** (1.0 / LRU_C)
    ev_lru_lambda = jnp.log(s) - jnp.log1p(-s)
    ev_ssm_lambda_re = -0.5 + _normal(next(ks), (E, G, N), 0.01)
    ev_ssm_lambda_im = jnp.pi * jnp.arange(N, dtype=F32) + _normal(next(ks), (E, G, N), 0.01)
    ev_ssm_log_dt = jax.random.uniform(next(ks), (E, G), F32, minval=math.log(1e-3), maxval=math.log(1e-1))
    ev_ssm_b_re = _normal(next(ks), (E, G, N, H), (2 * H) ** -0.5)
    ev_ssm_b_im = _normal(next(ks), (E, G, N, H), (2 * H) ** -0.5)
    ev_ssm_c_re = _normal(next(ks), (E, G, H, N), N ** -0.5)
    ev_ssm_c_im = _normal(next(ks), (E, G, H, N), N ** -0.5)
    ev_ssm_d = _normal(next(ks), (E, SSM_WIDTH), 1.0)
    ev_ssm_glu_w = _normal(next(ks), (E, SSM_WIDTH, SSM_WIDTH), SSM_WIDTH ** -0.5)
    ev_ssm_glu_b = _normal(next(ks), (E, SSM_WIDTH), 0.01)
    ev_w_out = _normal(next(ks), (E, EVEN_MIX, D), EVEN_MIX ** -0.5)
    ev_norm_ffn = 1.0 + _normal(next(ks), (E, D), 0.02)
    ev_ffn_w_gate = _normal(next(ks), (E, D, D_FF), D ** -0.5)
    ev_ffn_w_up = _normal(next(ks), (E, D, D_FF), D ** -0.5)
    ev_ffn_w_down = _normal(next(ks), (E, D_FF, D), D_FF ** -0.5)
    od_norm_mix = 1.0 + _normal(next(ks), (O, D), 0.02)
    od_w_in = _normal(next(ks), (O, D, ODD_IN), D ** -0.5)
    od_gla_gate_w2 = _normal(next(ks), (O, GLA_RANK, GLA_KEY), GLA_RANK ** -0.5)
    od_gla_gate_b = _normal(next(ks), (O, GLA_KEY), 0.1)
    od_gla_norm = 1.0 + _normal(next(ks), (O, GLA_VAL), 0.02)
    od_w_out = _normal(next(ks), (O, GLA_VAL, D), GLA_VAL ** -0.5)
    od_norm_ffn = 1.0 + _normal(next(ks), (O, D), 0.02)
    od_router_w = _normal(next(ks), (O, D, N_EXPERTS), D ** -0.5)
    od_moe_w_gate = _normal(next(ks), (O, N_EXPERTS, D, D_FF_EXPERT), D ** -0.5)
    od_moe_w_up = _normal(next(ks), (O, N_EXPERTS, D, D_FF_EXPERT), D ** -0.5)
    od_moe_w_down = _normal(next(ks), (O, N_EXPERTS, D_FF_EXPERT, D), D_FF_EXPERT ** -0.5)
    final_norm = 1.0 + _normal(next(ks), (D,), 0.02)
    return {
        "x": x, "meta_tokens": meta_tokens,
        "ev_norm_mix": ev_norm_mix, "ev_w_in": ev_w_in, "ev_conv_w": ev_conv_w, "ev_conv_b": ev_conv_b,
        "ev_gate_a_w": ev_gate_a_w, "ev_gate_a_b": ev_gate_a_b, "ev_gate_x_w": ev_gate_x_w,
        "ev_gate_x_b": ev_gate_x_b, "ev_lru_lambda": ev_lru_lambda,
        "ev_ssm_lambda_re": ev_ssm_lambda_re, "ev_ssm_lambda_im": ev_ssm_lambda_im,
        "ev_ssm_log_dt": ev_ssm_log_dt, "ev_ssm_b_re": ev_ssm_b_re, "ev_ssm_b_im": ev_ssm_b_im,
        "ev_ssm_c_re": ev_ssm_c_re, "ev_ssm_c_im": ev_ssm_c_im, "ev_ssm_d": ev_ssm_d,
        "ev_ssm_glu_w": ev_ssm_glu_w, "ev_ssm_glu_b": ev_ssm_glu_b, "ev_w_out": ev_w_out,
        "ev_norm_ffn": ev_norm_ffn, "ev_ffn_w_gate": ev_ffn_w_gate, "ev_ffn_w_up": ev_ffn_w_up,
        "ev_ffn_w_down": ev_ffn_w_down,
        "od_norm_mix": od_norm_mix, "od_w_in": od_w_in, "od_gla_gate_w2": od_gla_gate_w2,
        "od_gla_gate_b": od_gla_gate_b, "od_gla_norm": od_gla_norm, "od_w_out": od_w_out,
        "od_norm_ffn": od_norm_ffn, "od_router_w": od_router_w, "od_moe_w_gate": od_moe_w_gate,
        "od_moe_w_up": od_moe_w_up, "od_moe_w_down": od_moe_w_down,
        "final_norm": final_norm,
    }


def reference(x, meta_tokens,
              ev_norm_mix, ev_w_in, ev_conv_w, ev_conv_b, ev_gate_a_w, ev_gate_a_b, ev_gate_x_w,
              ev_gate_x_b, ev_lru_lambda, ev_ssm_lambda_re, ev_ssm_lambda_im, ev_ssm_log_dt,
              ev_ssm_b_re, ev_ssm_b_im, ev_ssm_c_re, ev_ssm_c_im, ev_ssm_d, ev_ssm_glu_w, ev_ssm_glu_b,
              ev_w_out, ev_norm_ffn, ev_ffn_w_gate, ev_ffn_w_up, ev_ffn_w_down,
              od_norm_mix, od_w_in, od_gla_gate_w2, od_gla_gate_b, od_gla_norm, od_w_out,
              od_norm_ffn, od_router_w, od_moe_w_gate, od_moe_w_up, od_moe_w_down,
              final_norm):
    B_ = x.shape[0]
    meta = jnp.broadcast_to(meta_tokens.astype(x.dtype)[None], (B_, N_META, D_MODEL))
    h = jnp.concatenate([meta, x], axis=1)
    for layer in range(DEPTH):
        j = layer // 2
        if layer % 2 == 0:
            h = h + even_mixer(rms_norm(h, ev_norm_mix[j]), ev_w_in[j], ev_conv_w[j], ev_conv_b[j],
                               ev_gate_a_w[j], ev_gate_a_b[j], ev_gate_x_w[j], ev_gate_x_b[j],
                               ev_lru_lambda[j], ev_ssm_lambda_re[j], ev_ssm_lambda_im[j],
                               ev_ssm_log_dt[j], ev_ssm_b_re[j], ev_ssm_b_im[j], ev_ssm_c_re[j],
                               ev_ssm_c_im[j], ev_ssm_d[j], ev_ssm_glu_w[j], ev_ssm_glu_b[j], ev_w_out[j])
            h = h + swiglu(rms_norm(h, ev_norm_ffn[j]), ev_ffn_w_gate[j], ev_ffn_w_up[j], ev_ffn_w_down[j])
        else:
            h = h + gla_mixer(rms_norm(h, od_norm_mix[j]), od_w_in[j], od_gla_gate_w2[j],
                              od_gla_gate_b[j], od_gla_norm[j], od_w_out[j])
            h = h + moe_swiglu(rms_norm(h, od_norm_ffn[j]), od_router_w[j], od_moe_w_gate[j],
                               od_moe_w_up[j], od_moe_w_down[j])
    return rms_norm(h, final_norm)[:, N_META:]
```

```cpp
#include <hip/hip_runtime.h>
#include <cstdio>
#include <cstdint>

#ifndef MK_PER_PHASE
#define MK_PER_PHASE 0
#endif

#define GAS __attribute__((address_space(1)))
#define LAS __attribute__((address_space(3)))
typedef unsigned short bf16;
typedef unsigned v4u __attribute__((ext_vector_type(4)));
typedef unsigned v2u __attribute__((ext_vector_type(2)));
typedef float f32x4 __attribute__((ext_vector_type(4)));
typedef float f32x2 __attribute__((ext_vector_type(2)));
typedef short bf16x8 __attribute__((ext_vector_type(8)));

constexpr int D = 1024, NB = 4, SEQ = 8192, NMETA = 16;
constexpr int TR = NB * SEQ;
constexpr int RM0 = TR;
constexpr int NPR = 128, NPA = 129;
constexpr int RALL = NPA * 256;
constexpr int LRUW = 1024, SSMW = 512, NG = 32, NS = 64, EV_IN = 2560, EV_MIX = 1536, FF0 = 3072;
constexpr int GK = 512, GV = 1024, GH = 4, GDK = 128, GDV = 256, OD_INP = 3584  , OD_IN = 3088;
constexpr int NE = 8, FFE = 3584, MROWS = 34816  , MPAN = 136;
constexpr float EPS = 1e-6f;
constexpr int NCH = 128;
constexpr int NSEG = 16, SEGC = 8;

constexpr size_t MiB = 1u << 20;
constexpr size_t WS_CTL = 0, CTL_ZERO_BYTES = 1 * MiB;
constexpr size_t WS_TAB = 1 * MiB;
constexpr size_t WS_WIN0 = 2 * MiB, WS_GW = 7 * MiB, WS_GLUW = 8 * MiB, WS_WOUT0 = 9 * MiB, WS_WUP0 = 12 * MiB, WS_WDN0 = 24 * MiB, WS_WIN1 = 30 * MiB, WS_WOUT1 = 37 * MiB;
constexpr size_t WS_PEND = 40 * MiB, WS_HEND = 42 * MiB, WS_CIN = 44 * MiB, WS_SSE = 46 * MiB, WS_SSIN = 54 * MiB, WS_GDS = 62 * MiB, WS_HMETA = 94 * MiB;
constexpr size_t WS_G = 96 * MiB, WS_U = 161 * MiB, WS_A = 194 * MiB, WS_XRBX = 323 * MiB, WS_HN = 388 * MiB, WS_AOUT = 388 * MiB, WS_XC = 453 * MiB, WS_GS = 485 * MiB;
constexpr size_t WS_HID0 = 96 * MiB;
constexpr size_t WS_Q = 96 * MiB, WS_K = 129 * MiB, WS_V = 162 * MiB, WS_GATE = 227 * MiB, WS_LG = 292 * MiB, WS_AOUT2 = 453 * MiB;
constexpr size_t WS_HNM = 40 * MiB, WS_WMOE = 105 * MiB, WS_HIDM = 273 * MiB, WS_TOKINFO = 511 * MiB, WS_ROWTOK = 512 * MiB, WS_ROWW = 512 * MiB + 512 * 1024, WS_END = 513 * MiB;
constexpr size_t TB_BBR = 0, TB_BBI = 131072, TB_AR = 262144, TB_AI = 270336, TB_AR64 = 278528, TB_AI64 = 286720, TB_SP8 = 294912, TB_GAM = 299008  , TB_PEXP = 430080  , TB_NPAN = 432128;
constexpr int CW_TMO = 0, CW_CODE = 1, CW_CNT = 64  , CW_BAR = 4096;

constexpr int RING_OFF = 0, RING_BYTES = 131072;
constexpr int TABL_OFF = RING_BYTES, TABL_BYTES = 24576;
constexpr int MISC_OFF = TABL_OFF + TABL_BYTES;
constexpr int LDS_BYTES = MISC_OFF + 128;

#define RLX_AGENT __ATOMIC_RELAXED, __HIP_MEMORY_SCOPE_AGENT
#define LDS_WAIT() asm volatile("s_waitcnt lgkmcnt(0)" ::: "memory")
#define VM_WAIT() asm volatile("s_waitcnt vmcnt(0)" ::: "memory")
__device__ __forceinline__ unsigned f2bf(float f) { unsigned u = __builtin_bit_cast(unsigned, f); return (u + 0x7fffu + ((u >> 16) & 1u)) >> 16; }
__device__ __forceinline__ unsigned pk2(float lo, float hi) { return f2bf(lo) | (f2bf(hi) << 16); }
__device__ __forceinline__ float bf2f(unsigned b) { return __builtin_bit_cast(float, b << 16); }
__device__ __forceinline__ float bflo(unsigned w) { return __builtin_bit_cast(float, w << 16); }
__device__ __forceinline__ float bfhi(unsigned w) { return __builtin_bit_cast(float, w & 0xffff0000u); }
__device__ __forceinline__ float rcpf_(float x) { return __builtin_amdgcn_rcpf(x); }
__device__ __forceinline__ float sigmoidf_(float x) { return rcpf_(1.0f + __expf(-x)); }
__device__ __forceinline__ float siluf_(float x) { return x * rcpf_(1.0f + __expf(-x)); }
__device__ __forceinline__ float gelu_tanh(float x) { const float u = 0.7978845608028654f * (x + 0.044715f * x * x * x); return x * rcpf_(1.0f + __expf(-2.0f * u)); }
__device__ __forceinline__ float one_minus_exp(float x) { const float p = -x * (1.0f + 0.5f * x * (1.0f + (1.0f / 3.0f) * x * (1.0f + 0.25f * x * (1.0f + 0.2f * x * (1.0f + (1.0f / 6.0f) * x))))); return x > -0.25f ? p : 1.0f - __expf(x); }
__device__ __forceinline__ float logsigmoidf_(float x) { return fminf(x, 0.0f) - log1pf(__expf(-fabsf(x))); }
__device__ __forceinline__ float wave_sum(float v) {
#pragma unroll
    for (int o = 1; o < 64; o <<= 1) v += __shfl_xor(v, o);
    return v;
}

namespace pg8 {
constexpr int BM = 256, BK = 64, HALF = 128, HTB = HALF * BK * 2, STAGE_BYTES = 8 * HTB, NXCD = 8, WGM = 8;
__host__ __device__ __forceinline__ int lds_byte(int r, int c) { const int st = (r >> 4) * 2 + (c >> 5), rr = r & 15, cc = c & 31, ob = rr * 64 + cc * 2; return st * 1024 + (ob ^ (((ob >> 9) & 1) << 5)); }
__host__ __device__ __forceinline__ void stage_rc(int b, int& R, int& C) { const int st = b / 1024, sb = b % 1024, swz = sb ^ (((sb >> 9) & 1) << 5); R = (st >> 1) * 16 + swz / 64; C = (st & 1) * 32 + (swz % 64) / 2; }
__host__ __device__ __forceinline__ int perm32(int rho) { const int n = rho >> 4, i = rho & 15; return 8 * (i >> 2) + 4 * n + (i & 3); }

struct Unit { int pm, pn, slot; const char* a; const char* b; };
__device__ __forceinline__ bool static_tile(int i, int G, int c, int nM, int nN, int& pm, int& pn) {
    const int nwg = nM * nN; const long L = (long)i * G + c; if (L >= nwg) return false;
    int wgid = (int)L; { const int q = nwg / NXCD, r = nwg % NXCD, xcd = wgid % NXCD, off = wgid / NXCD; wgid = (xcd < r ? xcd * (q + 1) : r * (q + 1) + (xcd - r) * q) + off; }
    const int nig = WGM * nN, gid = wgid / nig, fm = gid * WGM, gsz = (nM - fm) < WGM ? (nM - fm) : WGM;
    pm = fm + ((wgid % nig) % gsz); pn = (wgid % nig) / gsz; return true;
}
__device__ __forceinline__ unsigned cvt_pk_bf16(float lo, float hi) { unsigned r; asm volatile("v_cvt_pk_bf16_f32 %0, %1, %2" : "=v"(r) : "v"(lo), "v"(hi)); return r; }

template <class Epi, class Sched, bool GATHER>
__device__ __forceinline__ void gemm_phase(LAS unsigned char* lds, const int K, const int lda, const Sched& S, const Epi& E, const LAS int* gtab) {
    const int tid = threadIdx.x, wid = __builtin_amdgcn_readfirstlane(tid >> 6), lane = tid & 63, wr = wid >> 2, wc = wid & 3, fr = lane & 15, fq = lane >> 4;
    int nt = K / BK; asm volatile("" : "+s"(nt));
    int RA[2], CA[2]; unsigned voffB[2];
#pragma unroll
    for (int i = 0; i < 2; ++i) { int R, C; stage_rc(tid * 16 + i * 8192, R, C); const int Rb = Epi::PERM ? ((R & ~31) + perm32(R & 31)) : R;
        RA[i] = R; CA[i] = C; voffB[i] = (unsigned)(Rb * K + C) * 2u; }
    const size_t kstep = (size_t)(BK * 2);
    const size_t hstepB = (size_t)HALF * K * 2;
    const unsigned ldsw = (unsigned)wid * 1024u;
    const int aoff = lds_byte(wr * 64 + fr, fq * 8), boff = lds_byte(wc * 32 + fr, fq * 8);
    unsigned offC[2][2], offN[2][2];
#define PG8_SETOFF(dst, unit) do { _Pragma("unroll") for (int _h = 0; _h < 2; ++_h) _Pragma("unroll") for (int _i = 0; _i < 2; ++_i) { \
        if constexpr (GATHER) { int _t = gtab[(unit).slot * 256 + _h * HALF + RA[_i]]; _t = _t < 0 ? 0 : _t; dst[_h][_i] = ((unsigned)_t * (unsigned)lda + (unsigned)CA[_i]) * 2u; } \
        else dst[_h][_i] = ((unsigned)(_h * HALF + RA[_i]) * (unsigned)lda + (unsigned)CA[_i]) * 2u; } } while (0)
#define PG8_SA(b, h) (((b) * 2 + (h)) * HTB)
#define PG8_SB(b, h) ((4 + (b) * 2 + (h)) * HTB)
#define PG8_STAGEB(bufoff, gbase) do { _Pragma("unroll") for (int _i = 0; _i < 2; ++_i) \
        __builtin_amdgcn_global_load_lds((const unsigned*)((const char*)(gbase) + voffB[_i]), (LAS unsigned*)(lds + (bufoff) + ldsw + _i * 8192), 16, 0, 0); } while (0)
#define PG8_STAGEA(bufoff, gbase, o0, o1) do { \
        __builtin_amdgcn_global_load_lds((const unsigned*)((const char*)(gbase) + (o0)), (LAS unsigned*)(lds + (bufoff) + ldsw), 16, 0, 0); \
        __builtin_amdgcn_global_load_lds((const unsigned*)((const char*)(gbase) + (o1)), (LAS unsigned*)(lds + (bufoff) + ldsw + 8192), 16, 0, 0); } while (0)
#define PG8_LDA(dst, b, h) do { _Pragma("unroll") for (int m = 0; m < 4; ++m) _Pragma("unroll") for (int k = 0; k < 2; ++k) dst[m][k] = *(const LAS bf16x8*)(lds + PG8_SA(b, h) + aoff + m * 2048 + k * 1024); } while (0)
#define PG8_LDB(dst, b, h) do { _Pragma("unroll") for (int n = 0; n < 2; ++n) _Pragma("unroll") for (int k = 0; k < 2; ++k) dst[n][k] = *(const LAS bf16x8*)(lds + PG8_SB(b, h) + boff + n * 2048 + k * 1024); } while (0)
#define PG8_MMA(ai, bj, At, Bt) do { __builtin_amdgcn_s_setprio(1); _Pragma("unroll") for (int m = 0; m < 4; ++m) _Pragma("unroll") for (int n = 0; n < 2; ++n) _Pragma("unroll") for (int k = 0; k < 2; ++k) \
        acc[ai][bj][m][n] = __builtin_amdgcn_mfma_f32_16x16x32_bf16(Bt[n][k], At[m][k], acc[ai][bj][m][n], 0, 0, 0); __builtin_amdgcn_s_setprio(0); } while (0)
#define PG8_WAIT_V(n) asm volatile("s_waitcnt vmcnt(" #n ")" ::: "memory")
#define PG8_WAIT_L(n) asm volatile("s_waitcnt lgkmcnt(" #n ")" ::: "memory")
#define PG8_BAR __builtin_amdgcn_s_barrier()
#define PG8_SCHED __builtin_amdgcn_sched_barrier(0)
    Unit cur, nxt; int ui = 0;
    if (!S.next(0, cur)) return;
    f32x4 acc[2][2][4][2];
#pragma unroll
    for (int a = 0; a < 2; ++a)
#pragma unroll
        for (int b = 0; b < 2; ++b)
#pragma unroll
            for (int m = 0; m < 4; ++m)
#pragma unroll
                for (int n = 0; n < 2; ++n) acc[a][b][m][n] = (f32x4){0.f, 0.f, 0.f, 0.f};
    bf16x8 At[4][2], B0[2][2], B1[2][2];
    const char* cA = cur.a; const char* cB = cur.b;
    PG8_SETOFF(offC, cur);
    PG8_STAGEB(PG8_SB(0, 0), cB); PG8_STAGEB(PG8_SB(0, 1), cB + hstepB); PG8_STAGEA(PG8_SA(0, 0), cA, offC[0][0], offC[0][1]); PG8_STAGEA(PG8_SA(0, 1), cA, offC[1][0], offC[1][1]);
    if (wr == 1) PG8_BAR;
    PG8_WAIT_V(2); PG8_BAR;
    PG8_STAGEB(PG8_SB(1, 0), cB + kstep); PG8_STAGEA(PG8_SA(1, 0), cA + kstep, offC[0][0], offC[0][1]); PG8_STAGEB(PG8_SB(1, 1), cB + hstepB + kstep);
    PG8_WAIT_V(6); PG8_BAR;
    for (;;) {
        const bool has_next = S.next(ui + 1, nxt);
        const char* nA = has_next ? nxt.a : cA; const char* nB = has_next ? nxt.b : cB;
#pragma unroll
        for (int h = 0; h < 2; ++h)
#pragma unroll
            for (int i = 0; i < 2; ++i) offN[h][i] = offC[h][i];
        for (int t = 0; t < nt; t += 2) {
            const bool last = (t == nt - 2);
            const char* a1 = cA + (size_t)(t + 1) * kstep;
            const char* a2 = last ? nA : cA + (size_t)(t + 2) * kstep; const char* b2 = last ? nB : cB + (size_t)(t + 2) * kstep;
            const char* a3 = a2 + kstep; const char* b3 = b2 + kstep;
            if constexpr (GATHER) { if (last && has_next) PG8_SETOFF(offN, nxt); }
            const unsigned q00 = last ? offN[0][0] : offC[0][0], q01 = last ? offN[0][1] : offC[0][1], q10 = last ? offN[1][0] : offC[1][0], q11 = last ? offN[1][1] : offC[1][1];
            PG8_LDB(B0, 0, 0); PG8_LDB(B1, 0, 1); PG8_SCHED; PG8_LDA(At, 0, 0); PG8_STAGEA(PG8_SA(1, 1), a1, offC[1][0], offC[1][1]);
            PG8_WAIT_V(8); PG8_WAIT_L(0); PG8_BAR; PG8_MMA(0, 0, At, B0); PG8_MMA(0, 1, At, B1); PG8_BAR; PG8_SCHED;
            PG8_LDA(At, 0, 1); PG8_STAGEB(PG8_SB(0, 0), b2); PG8_STAGEB(PG8_SB(0, 1), b2 + hstepB); PG8_STAGEA(PG8_SA(0, 0), a2, q00, q01);
            PG8_WAIT_V(8); PG8_WAIT_L(0); PG8_BAR; PG8_MMA(1, 0, At, B0); PG8_MMA(1, 1, At, B1); PG8_BAR; PG8_SCHED;
            PG8_LDB(B0, 1, 0); PG8_LDB(B1, 1, 1); PG8_SCHED; PG8_LDA(At, 1, 0); PG8_STAGEA(PG8_SA(0, 1), a2, q10, q11);
            PG8_WAIT_V(8); PG8_WAIT_L(0); PG8_BAR; PG8_MMA(0, 0, At, B0); PG8_MMA(0, 1, At, B1); PG8_BAR; PG8_SCHED;
            PG8_LDA(At, 1, 1); PG8_STAGEB(PG8_SB(1, 0), b3); PG8_STAGEB(PG8_SB(1, 1), b3 + hstepB); PG8_STAGEA(PG8_SA(1, 0), a3, q00, q01);
            PG8_WAIT_V(8); PG8_WAIT_L(0); PG8_BAR; PG8_MMA(1, 0, At, B0); PG8_MMA(1, 1, At, B1); PG8_BAR; PG8_SCHED;
        }
        if (wr == 0) PG8_BAR;
        E(acc, cur, wr, wc, fr, fq);
        if (!has_next) break;
#pragma unroll
        for (int a = 0; a < 2; ++a)
#pragma unroll
            for (int b = 0; b < 2; ++b)
#pragma unroll
                for (int m = 0; m < 4; ++m)
#pragma unroll
                    for (int n = 0; n < 2; ++n) acc[a][b][m][n] = (f32x4){0.f, 0.f, 0.f, 0.f};
        cur = nxt; cA = nA; cB = nB; ++ui;
#pragma unroll
        for (int h = 0; h < 2; ++h)
#pragma unroll
            for (int i = 0; i < 2; ++i) offC[h][i] = offN[h][i];
        if (wr == 1) PG8_BAR;
    }
    PG8_WAIT_V(0);
    PG8_BAR;
#undef PG8_SETOFF
#undef PG8_SA
#undef PG8_SB
#undef PG8_STAGEA
#undef PG8_STAGEB
#undef PG8_LDA
#undef PG8_LDB
#undef PG8_MMA
#undef PG8_WAIT_V
#undef PG8_WAIT_L
#undef PG8_BAR
#undef PG8_SCHED
}
}

#define XB_TMO      128
#define XB_XCNT(j)  (256  + 64 * (j))
#define XB_XSUB(j)  (1280 + 64 * (j))
#define XB_XGEN(j)  (2304 + 64 * (j))
#define XB_TOP      3328
#define XB_TOPGEN   3392
#define XCD_BAR_WORDS 3456
#define XB_SPIN_CAP (1u << 18)
__device__ __forceinline__ unsigned xb_ld(unsigned* p)              { return __hip_atomic_load(p, __ATOMIC_RELAXED, __HIP_MEMORY_SCOPE_AGENT); }
__device__ __forceinline__ unsigned xb_add(unsigned* p, unsigned v) { return __hip_atomic_fetch_add(p, v, __ATOMIC_RELAXED, __HIP_MEMORY_SCOPE_AGENT); }
__device__ __forceinline__ unsigned xb_xcc_id() { return (unsigned)__builtin_amdgcn_s_getreg((3 << 11) | 20) & 0xFu; }
#define XB_SPIN(cond, bar) do { unsigned _sp = 0; while (cond) { __builtin_amdgcn_s_sleep(1); \
    if ((++_sp & 255u) == 0u) { if (xb_ld(&(bar)[XB_TMO])) break; if (_sp > XB_SPIN_CAP) { atomicAdd(&(bar)[XB_TMO], 1u); break; } } } } while (0)
struct XcdBarrier { unsigned* bar; unsigned x; volatile LAS unsigned* st; };
__device__ __forceinline__ XcdBarrier xcd_barrier_post(unsigned* bar, volatile LAS unsigned* st) {
    XcdBarrier b; b.bar = bar; b.x = xb_xcc_id(); b.st = st;
    if (threadIdx.x == 0) (void)xb_add(&bar[XB_XCNT(b.x)], 1u);
    return b;
}
__device__ __forceinline__ void xcd_barrier_complete(unsigned* bar, unsigned x, unsigned& nloc, unsigned& nx) {
    const unsigned G = gridDim.x * gridDim.y * gridDim.z;
    unsigned sum, cnt, mine, sp = 0u;
    for (;;) {
        sum = 0u; cnt = 0u; mine = 0u;
#pragma unroll
        for (unsigned j = 0; j < 16; ++j) { const unsigned c = xb_ld(&bar[XB_XCNT(j)]); sum += c; cnt += (c > 0u) ? 1u : 0u; mine = (j == x) ? c : mine; }
        if (sum == G) break;
        __builtin_amdgcn_s_sleep(1);
        if ((++sp & 255u) == 0u) { if (xb_ld(&bar[XB_TMO])) break; if (sp > XB_SPIN_CAP) { atomicAdd(&bar[XB_TMO], 1u); break; } }
    }
    nloc = mine > 0u ? mine : 1u; nx = cnt > 0u ? cnt : 1u;
}
__device__ __forceinline__ void xcd_barrier(const XcdBarrier& b) {
    asm volatile("s_waitcnt vmcnt(0)" ::: "memory");
    __syncthreads();
    if (threadIdx.x == 0) {
        unsigned* bar = b.bar;
        __builtin_amdgcn_s_waitcnt(0);
        unsigned nloc = b.st[0], nx = b.st[1];
        if (nloc == 0u) { xcd_barrier_complete(bar, b.x, nloc, nx); b.st[0] = nloc; b.st[1] = nx; }
        const unsigned old = xb_add(&bar[XB_XSUB(b.x)], 1u);
        const unsigned gen = old / nloc;
        if (old + 1u == (gen + 1u) * nloc) {
            __builtin_amdgcn_fence(__ATOMIC_RELEASE, "agent");
            asm volatile("s_waitcnt vmcnt(0)" ::: "memory");
            const unsigned og = xb_add(&bar[XB_TOP], 1u);
            const unsigned tg = og / nx;
            if (og + 1u == (tg + 1u) * nx) xb_add(&bar[XB_TOPGEN], 1u);
            else XB_SPIN(xb_ld(&bar[XB_TOPGEN]) == tg, bar);
            __builtin_amdgcn_fence(__ATOMIC_ACQUIRE, "agent");
            xb_add(&bar[XB_XGEN(b.x)], 1u);
            asm volatile("s_waitcnt vmcnt(0)" ::: "memory");
        } else {
            XB_SPIN(xb_ld(&bar[XB_XGEN(b.x)]) == gen, bar);
            __builtin_amdgcn_fence(__ATOMIC_ACQUIRE, "agent");
            asm volatile("s_waitcnt vmcnt(0)" ::: "memory");
        }
    }
    __syncthreads();
}

struct Args { const float* in[38]; float* out; unsigned char* ws; int ph_lo, ph_hi, li, pad; };
struct Frame {
    LAS unsigned char* lds;
    int tid, lane, wave, G, gw, NGW;
    long gt, NGT;
};
enum { I_X = 0, I_META, I_NORM_MIX0, I_WIN0, I_CONVW, I_CONVB, I_GAW, I_GAB, I_GXW, I_GXB, I_LAM, I_LRE, I_LIM, I_LDT, I_BRE, I_BIM, I_CRE, I_CIM, I_SD, I_GLUW, I_GLUB, I_WOUT0, I_NORM_FFN0,
       I_FG, I_FU, I_FD, I_NORM_MIX1, I_WIN1, I_GW2, I_GB, I_GNORM, I_WOUT1, I_NORM_FFN1, I_ROUTER, I_MG, I_MU, I_MD, I_FNORM };

struct SchedStatic {
    int nM, nN, G, c; const char* A; const char* B; size_t aStep, bStep; int aColDiv; size_t aColStep;
    __device__ __forceinline__ bool next(int i, pg8::Unit& u) const {
        int pm, pn; if (!pg8::static_tile(i, G, c, nM, nN, pm, pn)) return false;
        u.pm = pm; u.pn = pn; u.slot = i; u.a = A + (size_t)pm * aStep + (aColDiv ? (size_t)(pn / aColDiv) * aColStep : 0); u.b = B + (size_t)pn * bStep; return true;
    }
};
struct SchedList {
    int n; const LAS int* meta; const char* A; const char* B; size_t aStep, bTile, bExpert;
    __device__ __forceinline__ bool next(int i, pg8::Unit& u) const {
        if (i >= n) return false;
        const int pm = meta[i * 4 + 0], pn = meta[i * 4 + 1], e = meta[i * 4 + 2];
        u.pm = pm; u.pn = pn; u.slot = i; u.a = A + (size_t)pm * aStep; u.b = B + (size_t)e * bExpert + (size_t)pn * bTile; return true;
    }
};

#define EPI_ROWS(ai, m) ((ai) * 128 + wr * 64 + (m) * 16 + fr)
#define EPI_COLP(bj) ((bj) * 128 + wc * 32 + 8 * fq)
#define EPI_COLN(bj, n) ((bj) * 128 + wc * 32 + 16 * (n) + 4 * fq)
typedef const f32x4 (&AccRef)[2][2][4][2];
__device__ __forceinline__ v4u pack8(f32x4 a, f32x4 b) { v4u w; w.x = pg8::cvt_pk_bf16(a[0], a[1]); w.y = pg8::cvt_pk_bf16(a[2], a[3]); w.z = pg8::cvt_pk_bf16(b[0], b[1]); w.w = pg8::cvt_pk_bf16(b[2], b[3]); return w; }

struct EpiWin0 {
    static constexpr bool PERM = true; bf16 *G, *XR, *U;
    __device__ __forceinline__ void operator()(AccRef acc, const pg8::Unit& u, int wr, int wc, int fr, int fq) const {
        const int pn = u.pn; bf16* base; int ld, c0;
        if (pn < 4) { base = G; ld = 1024; c0 = pn * 256; } else if (pn < 8) { base = XR; ld = 1024; c0 = (pn - 4) * 256; } else { base = U; ld = 512; c0 = (pn - 8) * 256; }
#pragma unroll
        for (int ai = 0; ai < 2; ++ai)
#pragma unroll
            for (int m = 0; m < 4; ++m) { bf16* rowp = base + (size_t)(u.pm * 256 + EPI_ROWS(ai, m)) * ld + c0;
#pragma unroll
                for (int bj = 0; bj < 2; ++bj) { f32x4 v0 = acc[ai][bj][m][0], v1 = acc[ai][bj][m][1];
                    if (pn < 4) {
#pragma unroll
                        for (int j = 0; j < 4; ++j) { v0[j] = gelu_tanh(v0[j]); v1[j] = gelu_tanh(v1[j]); } }
                    *(v4u*)(rowp + EPI_COLP(bj)) = pack8(v0, v1); } }
    }
};
struct EpiGates {
    static constexpr bool PERM = true; const float *gab, *gxb, *sp8; const bf16* XC; float* A; bf16* BX;
    __device__ __forceinline__ void operator()(AccRef acc, const pg8::Unit& u, int wr, int wc, int fr, int fq) const {
        const int ch0 = (u.pn >> 1) * 256 + (u.pn & 1) * 128 + wc * 32 + 8 * fq;
        f32x4 ba[2], bx[2], sp[2];
#pragma unroll
        for (int n = 0; n < 2; ++n) { ba[n] = *(const f32x4*)(gab + ch0 + 4 * n); bx[n] = *(const f32x4*)(gxb + ch0 + 4 * n); sp[n] = *(const f32x4*)(sp8 + ch0 + 4 * n); }
#pragma unroll
        for (int ai = 0; ai < 2; ++ai)
#pragma unroll
            for (int m = 0; m < 4; ++m) { const size_t ro = (size_t)(u.pm * 256 + EPI_ROWS(ai, m)) * 1024 + ch0;
                const v4u xw = *(const v4u*)(XC + ro); const float xv[8] = {bflo(xw.x), bfhi(xw.x), bflo(xw.y), bfhi(xw.y), bflo(xw.z), bfhi(xw.z), bflo(xw.w), bfhi(xw.w)};
                f32x4 av[2], bv[2];
#pragma unroll
                for (int n = 0; n < 2; ++n)
#pragma unroll
                    for (int j = 0; j < 4; ++j) { const float r = sigmoidf_(acc[ai][0][m][n][j] + ba[n][j]), ig = sigmoidf_(acc[ai][1][m][n][j] + bx[n][j]);
                        const float la = -r * sp[n][j]; av[n][j] = __expf(la); bv[n][j] = __builtin_amdgcn_sqrtf(fmaxf(one_minus_exp(2.0f * la), 0.0f)) * ig * xv[4 * n + j]; }
                *(f32x4*)(A + ro) = av[0]; *(f32x4*)(A + ro + 4) = av[1]; *(v4u*)(BX + ro) = pack8(bv[0], bv[1]); asm volatile("" ::: "memory"); }
    }
};
struct EpiGlu {
    static constexpr bool PERM = true; const float* glub; const bf16* GS; bf16* AOUT;
    __device__ __forceinline__ void operator()(AccRef acc, const pg8::Unit& u, int wr, int wc, int fr, int fq) const {
#pragma unroll
        for (int bj = 0; bj < 2; ++bj) { const int c = u.pn * 256 + EPI_COLP(bj); const f32x4 b0 = *(const f32x4*)(glub + c), b1 = *(const f32x4*)(glub + c + 4);
#pragma unroll
            for (int ai = 0; ai < 2; ++ai)
#pragma unroll
                for (int m = 0; m < 4; ++m) { const size_t row = (size_t)(u.pm * 256 + EPI_ROWS(ai, m));
                    const v4u gw = *(const v4u*)(GS + row * 512 + c); const float gv[8] = {bflo(gw.x), bfhi(gw.x), bflo(gw.y), bfhi(gw.y), bflo(gw.z), bfhi(gw.z), bflo(gw.w), bfhi(gw.w)};
                    f32x4 v0, v1;
#pragma unroll
                    for (int j = 0; j < 4; ++j) { v0[j] = gv[j] * sigmoidf_(acc[ai][bj][m][0][j] + b0[j]); v1[j] = gv[4 + j] * sigmoidf_(acc[ai][bj][m][1][j] + b1[j]); }
                    *(v4u*)(AOUT + row * 1536 + 1024 + c) = pack8(v0, v1); } }
    }
};
struct EpiResid {
    static constexpr bool PERM = false; const float* src; float* dst; float* hmeta;
    __device__ __forceinline__ void operator()(AccRef acc, const pg8::Unit& u, int wr, int wc, int fr, int fq) const {
        const bool meta = u.pm >= NPR; const float* s = meta ? hmeta : src + (size_t)u.pm * 256 * 1024; float* d = meta ? hmeta : dst + (size_t)u.pm * 256 * 1024;
#pragma unroll
        for (int ai = 0; ai < 2; ++ai)
#pragma unroll
            for (int m = 0; m < 4; ++m) { const size_t ro = (size_t)EPI_ROWS(ai, m) * 1024 + u.pn * 256;
#pragma unroll
                for (int bj = 0; bj < 2; ++bj)
#pragma unroll
                    for (int n = 0; n < 2; ++n) { const size_t o = ro + EPI_COLN(bj, n); *(f32x4*)(d + o) = *(const f32x4*)(s + o) + acc[ai][bj][m][n]; } }
    }
};
struct EpiSwiglu {
    static constexpr bool PERM = true; bf16* H; int ld;
    __device__ __forceinline__ void operator()(AccRef acc, const pg8::Unit& u, int wr, int wc, int fr, int fq) const {
        const int c = u.pn * 128 + wc * 32 + 8 * fq;
#pragma unroll
        for (int ai = 0; ai < 2; ++ai)
#pragma unroll
            for (int m = 0; m < 4; ++m) { f32x4 v0, v1;
#pragma unroll
                for (int j = 0; j < 4; ++j) { v0[j] = siluf_(acc[ai][0][m][0][j]) * acc[ai][1][m][0][j]; v1[j] = siluf_(acc[ai][0][m][1][j]) * acc[ai][1][m][1][j]; }
                *(v4u*)(H + (size_t)(u.pm * 256 + EPI_ROWS(ai, m)) * ld + c) = pack8(v0, v1); }
    }
};
struct EpiWin1 {
    static constexpr bool PERM = true; bf16 *Q, *K, *V, *GATE; float* LG; const float* gb;
    __device__ __forceinline__ void operator()(AccRef acc, const pg8::Unit& u, int wr, int wc, int fr, int fq) const {
        const int pn = u.pn;
#pragma unroll
        for (int ai = 0; ai < 2; ++ai)
#pragma unroll
            for (int m = 0; m < 4; ++m) { const size_t row = (size_t)(u.pm * 256 + EPI_ROWS(ai, m));
#pragma unroll
                for (int bj = 0; bj < 2; ++bj) { f32x4 v0 = acc[ai][bj][m][0], v1 = acc[ai][bj][m][1]; const int cc = EPI_COLP(bj);
                    if (pn < 2) { v0 = v0 * 0.08838834764831845f; v1 = v1 * 0.08838834764831845f; *(v4u*)(Q + row * 512 + pn * 256 + cc) = pack8(v0, v1); }
                    else if (pn < 4) { *(v4u*)(K + row * 512 + (pn - 2) * 256 + cc) = pack8(v0, v1); }
                    else if (pn < 8) { *(v4u*)(V + row * 1024 + (pn - 4) * 256 + cc) = pack8(v0, v1); }
                    else if (pn < 12) {
#pragma unroll
                        for (int j = 0; j < 4; ++j) { v0[j] = siluf_(v0[j]); v1[j] = siluf_(v1[j]); }
                        *(v4u*)(GATE + row * 1024 + (pn - 8) * 256 + cc) = pack8(v0, v1); }
                    else { const int c = (pn - 12) * 256 + cc; const f32x4 b0 = *(const f32x4*)(gb + c), b1 = *(const f32x4*)(gb + c + 4);
#pragma unroll
                        for (int j = 0; j < 4; ++j) { v0[j] = logsigmoidf_(v0[j] + b0[j]) * 0.0625f; v1[j] = logsigmoidf_(v1[j] + b1[j]) * 0.0625f; }
                        *(f32x4*)(LG + row * 512 + c) = v0; *(f32x4*)(LG + row * 512 + c + 4) = v1; } } }
    }
};
struct EpiMoeDown {
    static constexpr bool PERM = false; float* out; const LAS int* toks; const LAS float* wts;
    __device__ __forceinline__ void operator()(AccRef acc, const pg8::Unit& u, int wr, int wc, int fr, int fq) const {
#pragma unroll
        for (int ai = 0; ai < 2; ++ai)
#pragma unroll
            for (int m = 0; m < 4; ++m) { const int rl = u.slot * 256 + EPI_ROWS(ai, m); const int tok = toks[rl]; const float w = wts[rl];
                if (tok >= 0) { float* d = out + (size_t)tok * 1024 + u.pn * 256;
#pragma unroll
                    for (int bj = 0; bj < 2; ++bj)
#pragma unroll
                        for (int n = 0; n < 2; ++n) { float* p = d + EPI_COLN(bj, n); *(f32x4*)p = *(const f32x4*)p + acc[ai][bj][m][n] * w; } } }
    }
};

__device__ __forceinline__ void tr_item(const float* W, int ldw, int col, int k0, bf16* WT, int ldt, int drow, LAS float* scr, int lane) {
#pragma unroll 8
    for (int i = 0; i < 32; ++i) { const int kk = 2 * i + (lane >> 5); scr[kk * 33 + (lane & 31)] = W[(size_t)(k0 + kk) * ldw + col + (lane & 31)]; }
    LDS_WAIT(); asm volatile("" ::: "memory");
    const int c = lane & 7;
#pragma unroll
    for (int j = 0; j < 4; ++j) { const int n = (lane >> 3) + 8 * j; const LAS float* s = scr + (8 * c) * 33 + n;
        v4u o; o.x = pk2(s[0 * 33], s[1 * 33]); o.y = pk2(s[2 * 33], s[3 * 33]); o.z = pk2(s[4 * 33], s[5 * 33]); o.w = pk2(s[6 * 33], s[7 * 33]);
        *(v4u*)(WT + (size_t)(drow + n) * ldt + k0 + 8 * c) = o; }
    LDS_WAIT(); asm volatile("" ::: "memory");
}
struct TrJob { const float* W; int ldw, col0, K, N; bf16* WT; int blk, bstride, add; };
__device__ __forceinline__ bool tr_try(int& r, const TrJob& j, LAS float* scr, int lane) {
    const int nblk = j.N / 32, items = (j.K / 64) * nblk;
    if (r >= items) { r -= items; return false; }
    const int kb = r / nblk, n0 = (r % nblk) * 32;
    tr_item(j.W, j.ldw, j.col0 + n0, kb * 64, j.WT, j.K, (n0 / j.blk) * j.bstride + (n0 % j.blk) + j.add, scr, lane);
    return true;
}
__device__ __forceinline__ void norm_row_bf16(const float* xrow, const float* gain, bf16* orow, int lane) {
    const f32x4* xr = (const f32x4*)xrow + lane; const f32x4* gr = (const f32x4*)gain + lane;
    f32x4 v[4]; float s = 0.f;
#pragma unroll
    for (int j = 0; j < 4; ++j) { v[j] = xr[64 * j]; s += (v[j].x * v[j].x + v[j].y * v[j].y) + (v[j].z * v[j].z + v[j].w * v[j].w); }
    const float rstd = 1.0f / sqrtf(wave_sum(s) * (1.0f / 1024.0f) + EPS);
    v2u* o8 = (v2u*)orow + lane;
#pragma unroll
    for (int j = 0; j < 4; ++j) { const f32x4 g = gr[64 * j]; v2u w; w.x = pk2(v[j].x * rstd * g.x, v[j].y * rstd * g.y); w.y = pk2(v[j].z * rstd * g.z, v[j].w * rstd * g.w); o8[64 * j] = w; }
}
__device__ __forceinline__ const float* hrow_c(const float* out, const float* hmeta, int r) { return r < TR ? out + (size_t)r * 1024 : hmeta + (size_t)(r - TR) * 1024; }

__device__ __forceinline__ void p0_prologue(const Frame& F, const Args& a, unsigned char* ws) {
    LAS float* scr = (LAS float*)(F.lds + RING_OFF + F.wave * 16384);
    const float* const* in = a.in;
    constexpr int BIG = 1 << 30;
    for (int it = F.gw; ; it += F.NGW) {
        int r = it;
        { TrJob j{in[I_WIN0], EV_IN, 0, 1024, EV_IN, (bf16*)(ws + WS_WIN0), BIG, 0, 0}; if (tr_try(r, j, scr, F.lane)) continue; }
        bool done = false;
        for (int h = 0; h < 4 && !done; ++h) {
            { TrJob j{in[I_GAW] + (size_t)h * 65536, 256, 0, 256, 256, (bf16*)(ws + WS_GW) + (size_t)h * 512 * 256, 128, 256, 0}; if (tr_try(r, j, scr, F.lane)) { done = true; break; } }
            { TrJob j{in[I_GXW] + (size_t)h * 65536, 256, 0, 256, 256, (bf16*)(ws + WS_GW) + (size_t)h * 512 * 256, 128, 256, 128}; if (tr_try(r, j, scr, F.lane)) { done = true; break; } }
        }
        if (done) continue;
        { TrJob j{in[I_GLUW], 512, 0, 512, 512, (bf16*)(ws + WS_GLUW), BIG, 0, 0}; if (tr_try(r, j, scr, F.lane)) continue; }
        { TrJob j{in[I_WOUT0], 1024, 0, EV_MIX, 1024, (bf16*)(ws + WS_WOUT0), BIG, 0, 0}; if (tr_try(r, j, scr, F.lane)) continue; }
        { TrJob j{in[I_FG], FF0, 0, 1024, FF0, (bf16*)(ws + WS_WUP0), 128, 256, 0}; if (tr_try(r, j, scr, F.lane)) continue; }
        { TrJob j{in[I_FU], FF0, 0, 1024, FF0, (bf16*)(ws + WS_WUP0), 128, 256, 128}; if (tr_try(r, j, scr, F.lane)) continue; }
        { TrJob j{in[I_FD], 1024, 0, FF0, 1024, (bf16*)(ws + WS_WDN0), BIG, 0, 0}; if (tr_try(r, j, scr, F.lane)) continue; }
        { TrJob j{in[I_WIN1], OD_IN, 0, 1024, 3072, (bf16*)(ws + WS_WIN1), BIG, 0, 0}; if (tr_try(r, j, scr, F.lane)) continue; }
        { TrJob j{in[I_WOUT1], 1024, 0, 1024, 1024, (bf16*)(ws + WS_WOUT1), BIG, 0, 0}; if (tr_try(r, j, scr, F.lane)) continue; }
        break;
    }
    for (long i = F.gt; i < 512L * 1024; i += F.NGT) { const int j = (int)(i >> 10), k = (int)(i & 1023); const float* wr_ = in[I_WIN1] + (size_t)k * OD_IN + 3072; const float* w2 = in[I_GW2] + j; float s = 0.f;
#pragma unroll
        for (int r = 0; r < 16; ++r) s += wr_[r] * w2[r * 512];
        ((bf16*)(ws + WS_WIN1))[(size_t)(3072 + j) * 1024 + k] = (bf16)f2bf(s); }
    float* tab = (float*)(ws + WS_TAB);
    for (long i = F.gt; i < NG * NS; i += F.NGT) { const int g = (int)i / NS;
        const double lr = in[I_LRE][i], li = in[I_LIM][i], dt = exp((double)in[I_LDT][g]);
        const double mag = exp(dt * lr), ar = mag * cos(dt * li), ai = mag * sin(dt * li), den = lr * lr + li * li, nr = ar - 1.0;
        const double zr = (nr * lr + ai * li) / den, zi = (ai * lr - nr * li) / den;
        const double m64 = exp(64.0 * dt * lr);
        ((float*)((char*)tab + TB_AR))[i] = (float)ar; ((float*)((char*)tab + TB_AI))[i] = (float)ai;
        ((float*)((char*)tab + TB_AR64))[i] = (float)(m64 * cos(64.0 * dt * li)); ((float*)((char*)tab + TB_AI64))[i] = (float)(m64 * sin(64.0 * dt * li));
        for (int h = 0; h < 16; ++h) { const double br = in[I_BRE][i * 16 + h], bi = in[I_BIM][i * 16 + h];
            ((float*)((char*)tab + TB_BBR))[i * 16 + h] = (float)(zr * br - zi * bi); ((float*)((char*)tab + TB_BBI))[i * 16 + h] = (float)(zr * bi + zi * br); } }
    for (long i = F.gt; i < 1024; i += F.NGT) { const float lam = in[I_LAM][i]; ((float*)((char*)tab + TB_SP8))[i] = 8.0f * log1pf(expf(-lam)); }
    bf16* HN = (bf16*)(ws + WS_HN); float* hmeta = (float*)(ws + WS_HMETA);
    for (int m = F.gw; m < TR + NMETA; m += F.NGW) { const float* src = m < TR ? in[I_X] + (size_t)m * 1024 : in[I_META] + (size_t)(m - TR) * 1024; norm_row_bf16(src, in[I_NORM_MIX0], HN + (size_t)m * 1024, F.lane); }
    for (long i = F.gt; i < NMETA * 1024; i += F.NGT) hmeta[i] = in[I_META][i];
}
__device__ __forceinline__ void norm_phase(const Frame& F, const float* out, const float* hmeta, const float* gain, bf16* HN, int nrows) {
    for (int m = F.gw; m < nrows; m += F.NGW) norm_row_bf16(hrow_c(out, hmeta, m), gain, HN + (size_t)m * 1024, F.lane);
}
__device__ __forceinline__ int seq_prev(int row, int back) {
    if (row >= TR) { const int i = row - TR - back; return i >= 0 ? TR + i : -1; }
    const int t = row & (SEQ - 1); return t >= back ? row - back : TR + NMETA + (t - back);
}
__device__ __forceinline__ void conv_phase(const Frame& F, const bf16* XR, const float* cw, const float* cb, bf16* XC) {
    for (long i = F.gt; i < (long)(TR + NMETA) * 128; i += F.NGT) { const int row = (int)(i >> 7), c = (int)(i & 127) * 8;
        float acc[8];
#pragma unroll
        for (int j = 0; j < 8; ++j) acc[j] = cb[c + j];
#pragma unroll
        for (int k = 0; k < 4; ++k) { const int src = seq_prev(row, 3 - k); if (src < 0) continue;
            const v4u w = *(const v4u*)(XR + (size_t)src * 1024 + c); const float xv[8] = {bflo(w.x), bfhi(w.x), bflo(w.y), bfhi(w.y), bflo(w.z), bfhi(w.z), bflo(w.w), bfhi(w.w)};
            const f32x4 w0 = *(const f32x4*)(cw + k * 1024 + c), w1 = *(const f32x4*)(cw + k * 1024 + c + 4);
#pragma unroll
            for (int j = 0; j < 4; ++j) { acc[j] += w0[j] * xv[j]; acc[4 + j] += w1[j] * xv[4 + j]; } }
        v4u o; o.x = pk2(acc[0], acc[1]); o.y = pk2(acc[2], acc[3]); o.z = pk2(acc[4], acc[5]); o.w = pk2(acc[6], acc[7]);
        *(v4u*)(XC + (size_t)row * 1024 + c) = o; }
}
template <bool FINAL>
__device__ __forceinline__ void ssm_wave(const unsigned char* ws, const float* cre, const float* cim, const float* sd, const bf16* U, bf16* GS, int g, int row0, int ntok, float& hr, float& hi, int lane) {
    const float* tab = (const float*)(ws + WS_TAB); const int gn = g * NS + lane;
    const float ar = ((const float*)((const char*)tab + TB_AR))[gn], ai = ((const float*)((const char*)tab + TB_AI))[gn];
    float bbr[16], bbi[16];
#pragma unroll
    for (int q = 0; q < 4; ++q) { const f32x4 a = ((const f32x4*)((const char*)tab + TB_BBR))[gn * 4 + q], b = ((const f32x4*)((const char*)tab + TB_BBI))[gn * 4 + q];
#pragma unroll
        for (int j = 0; j < 4; ++j) { bbr[4 * q + j] = a[j]; bbi[4 * q + j] = b[j]; } }
    float cr[16], ci[16], dv[16];
    if (FINAL) {
#pragma unroll
        for (int o = 0; o < 16; ++o) { cr[o] = cre[(g * 16 + o) * NS + lane]; ci[o] = cim[(g * 16 + o) * NS + lane]; dv[o] = lane == 0 ? sd[g * 16 + o] : 0.f; } }
    for (int t = 0; t < ntok; ++t) { const size_t row = (size_t)(row0 + t);
        const v4u w0 = *(const v4u*)(U + row * 512 + g * 16), w1 = *(const v4u*)(U + row * 512 + g * 16 + 8);
        const float u[16] = {bflo(w0.x), bfhi(w0.x), bflo(w0.y), bfhi(w0.y), bflo(w0.z), bfhi(w0.z), bflo(w0.w), bfhi(w0.w), bflo(w1.x), bfhi(w1.x), bflo(w1.y), bfhi(w1.y), bflo(w1.z), bfhi(w1.z), bflo(w1.w), bfhi(w1.w)};
        float xr = 0.f, xi = 0.f;
#pragma unroll
        for (int h = 0; h < 16; ++h) { xr += bbr[h] * u[h]; xi += bbi[h] * u[h]; }
        const float nr = ar * hr - ai * hi + xr, ni = ar * hi + ai * hr + xi; hr = nr; hi = ni;
        if (FINAL) {
            float p[16];
#pragma unroll
            for (int o = 0; o < 16; ++o) p[o] = cr[o] * hr - ci[o] * hi + dv[o] * u[o];
            float q8[8];
#pragma unroll
            for (int i = 0; i < 8; ++i) { const bool up = (lane & 32) != 0; const float keep = up ? p[i + 8] : p[i], send = up ? p[i] : p[i + 8]; q8[i] = keep + __shfl_xor(send, 32); }
            float q4[4];
#pragma unroll
            for (int i = 0; i < 4; ++i) { const bool up = (lane & 16) != 0; const float keep = up ? q8[i + 4] : q8[i], send = up ? q8[i] : q8[i + 4]; q4[i] = keep + __shfl_xor(send, 16); }
            float q2[2];
#pragma unroll
            for (int i = 0; i < 2; ++i) { const bool up = (lane & 8) != 0; const float keep = up ? q4[i + 2] : q4[i], send = up ? q4[i] : q4[i + 2]; q2[i] = keep + __shfl_xor(send, 8); }
            float y; { const bool up = (lane & 4) != 0; const float keep = up ? q2[1] : q2[0], send = up ? q2[0] : q2[1]; y = keep + __shfl_xor(send, 4); }
            y += __shfl_xor(y, 2); y += __shfl_xor(y, 1);
            const int o = ((lane >> 5) & 1) * 8 + ((lane >> 4) & 1) * 4 + ((lane >> 3) & 1) * 2 + ((lane >> 2) & 1);
            if ((lane & 3) == 0) GS[row * 512 + g * 16 + o] = (bf16)f2bf(gelu_tanh(y));
        }
    }
}
__device__ __forceinline__ void ssm_l1_phase(const Frame& F, const unsigned char* ws, const bf16* U, float* SSE) {
    for (int it = F.gw; it < NB * NCH * NG; it += F.NGW) { const int g = it % NG, bc = it / NG;
        float hr = 0.f, hi = 0.f; ssm_wave<false>(ws, nullptr, nullptr, nullptr, U, nullptr, g, bc * 64, 64, hr, hi, F.lane);
        ((f32x2*)SSE)[(size_t)it * NS + F.lane] = (f32x2){hr, hi}; }
}
__device__ __forceinline__ void lru_l1_phase(const Frame& F, const float* A, const bf16* BX, float* PEND, float* HEND) {
    for (long i = F.gt; i < (long)NB * NCH * 1024; i += F.NGT) { const int ch = (int)(i & 1023), bc = (int)(i >> 10); const size_t r0 = (size_t)bc * 64;
        float P = 1.f, H = 0.f;
#pragma unroll 8
        for (int t = 0; t < 64; ++t) { const float a = A[(r0 + t) * 1024 + ch], bx = bf2f(BX[(r0 + t) * 1024 + ch]); P *= a; H = a * H + bx; }
        PEND[i] = P; HEND[i] = H; }
}
__device__ __forceinline__ void carry_phase(const Frame& F, const unsigned char* ws, const float* A, const bf16* BX, const float* PEND, const float* HEND, float* CIN, const bf16* U, const float* SSE, float* SSIN) {
    if (F.gt < NB * 1024) { const int ch = (int)F.gt & 1023, b = (int)F.gt >> 10; float H = 0.f;
        for (int i = 0; i < NMETA; ++i) { const size_t r = (size_t)(RM0 + i); H = A[r * 1024 + ch] * H + bf2f(BX[r * 1024 + ch]); }
#pragma unroll 8
        for (int c = 0; c < NCH; ++c) { const size_t o = ((size_t)b * NCH + c) * 1024 + ch; const float p = PEND[o], he = HEND[o]; CIN[o] = H; H = he + p * H; }
    } else if (F.gt >= 8 * 512 && F.gt < 8 * 512 + NB * NG * NS) { const int id = (int)F.gt - 8 * 512, n = id % NS, g = (id / NS) % NG, b = id / (NS * NG), gn = g * NS + n;
        const float* tab = (const float*)(ws + WS_TAB);
        const float ar = ((const float*)((const char*)tab + TB_AR))[gn], ai = ((const float*)((const char*)tab + TB_AI))[gn], ar64 = ((const float*)((const char*)tab + TB_AR64))[gn], ai64 = ((const float*)((const char*)tab + TB_AI64))[gn];
        float hr = 0.f, hi = 0.f;
        for (int i = 0; i < NMETA; ++i) { float xr = 0.f, xi = 0.f;
            for (int h = 0; h < 16; ++h) { const float u = bf2f(U[(size_t)(RM0 + i) * 512 + g * 16 + h]); xr += ((const float*)((const char*)tab + TB_BBR))[gn * 16 + h] * u; xi += ((const float*)((const char*)tab + TB_BBI))[gn * 16 + h] * u; }
            const float nr = ar * hr - ai * hi + xr, ni = ar * hi + ai * hr + xi; hr = nr; hi = ni; }
#pragma unroll 8
        for (int c = 0; c < NCH; ++c) { const size_t o = (((size_t)b * NCH + c) * NG + g) * NS + n; const f32x2 e = ((const f32x2*)SSE)[o]; ((f32x2*)SSIN)[o] = (f32x2){hr, hi};
            const float nr = ar64 * hr - ai64 * hi + e.x, ni = ar64 * hi + ai64 * hr + e.y; hr = nr; hi = ni; }
    }
}
__device__ __forceinline__ void mix0_final_phase(const Frame& F, const unsigned char* ws, const float* A, const bf16* BX, const float* CIN, const bf16* G, bf16* AOUT, const float* cre, const float* cim, const float* sd, const bf16* U, const float* SSIN, bf16* GS) {
    for (long i = F.gt; i < (long)NB * NCH * 1024 + 1024; i += F.NGT) { const int ch = (int)(i & 1023), bc = (int)(i >> 10); const bool meta = bc >= NB * NCH;
        const size_t r0 = meta ? (size_t)RM0 : (size_t)bc * 64; const int nt = meta ? NMETA : 64; float H = meta ? 0.f : CIN[i];
        for (int t = 0; t < nt; ++t) { const size_t r = r0 + t; H = A[r * 1024 + ch] * H + bf2f(BX[r * 1024 + ch]); AOUT[r * 1536 + ch] = (bf16)f2bf(bf2f(G[r * 1024 + ch]) * H); } }
    for (int it = F.gw; it < NB * NCH * NG + NG; it += F.NGW) { const bool meta = it >= NB * NCH * NG; const int g = it % NG, bc = it / NG;
        float hr = 0.f, hi = 0.f; if (!meta) { const f32x2 s = ((const f32x2*)SSIN)[(size_t)it * NS + F.lane]; hr = s.x; hi = s.y; }
        ssm_wave<true>(ws, cre, cim, sd, U, GS, g, meta ? RM0 : bc * 64, meta ? NMETA : 64, hr, hi, F.lane); }
}

template <class Fn> __device__ __forceinline__ bf16x8 frag8(Fn f) { bf16x8 r;
#pragma unroll
    for (int j = 0; j < 8; ++j) r[j] = (short)f(j);
    return r; }
constexpr int GL_LB = 0, GL_QT = 32768, GL_KT = 50176, GL_KH = 67584, GL_VT = 86016, GL_GM = 120832, GL_BL = 121344, GL_SSQ = 121856;
constexpr int PQ = 136, PKH = 144, PV = 272, PATT = 72;
#define TR_FRAG(dst, base, off, rows4) do { v2u _lo, _hi; \
    asm volatile("ds_read_b64_tr_b16 %0, %2 offset:%c3\n\tds_read_b64_tr_b16 %1, %2 offset:%c4\n\ts_waitcnt lgkmcnt(0)" : "=&v"(_lo), "=&v"(_hi) : "v"(base), "i"(off), "i"((off) + (rows4)) : "memory"); \
    const v4u _w = {_lo.x, _lo.y, _hi.x, _hi.y}; dst = __builtin_bit_cast(bf16x8, _w); } while (0)
__device__ __forceinline__ unsigned lds_addr(const LAS void* p) { return (unsigned)(unsigned long)p; }
template <bool FINAL>
__device__ __forceinline__ void gla_item(const Frame& F, int b, int h, int s, const bf16* Q, const bf16* K, const bf16* V, const bf16* GATE, const float* LG, const float* gnorm, float* GDS, float* GAM, bf16* AOUT2) {
    LAS float* LB = (LAS float*)(F.lds + GL_LB); LAS bf16* ATT = (LAS bf16*)(F.lds + GL_LB);
    LAS bf16* QT = (LAS bf16*)(F.lds + GL_QT); LAS bf16* KT = (LAS bf16*)(F.lds + GL_KT); LAS bf16* KH = (LAS bf16*)(F.lds + GL_KH); LAS bf16* VT = (LAS bf16*)(F.lds + GL_VT);
    LAS float* GM = (LAS float*)(F.lds + GL_GM); LAS float* BL = (LAS float*)(F.lds + GL_BL); LAS float* SSQ = (LAS float*)(F.lds + GL_SSQ);
    const int tid = F.tid, w = F.wave, lane = F.lane, fr = lane & 15, h4 = lane >> 4, tq = fr >> 2, tp = fr & 3;
    const int bh = b * GH + h; const size_t sbase = ((size_t)(bh * NSEG + s) * 128) * 256;
    const unsigned vtr = lds_addr(VT) + (unsigned)((8 * h4 + tq) * PV + 32 * w + 4 * tp) * 2u;
    const unsigned ktr = lds_addr(KH) + (unsigned)((8 * h4 + tq) * PKH + 4 * tp) * 2u;
    f32x4 S[8][2];
#pragma unroll
    for (int kb = 0; kb < 8; ++kb)
#pragma unroll
        for (int vb = 0; vb < 2; ++vb)
#pragma unroll
            for (int r = 0; r < 4; ++r) S[kb][vb][r] = FINAL ? GDS[sbase + (size_t)(16 * kb + 4 * h4 + r) * 256 + 32 * w + 16 * vb + fr] : 0.f;
    float gsum = 0.f;
#pragma nounroll
    for (int c = 0; c < SEGC; ++c) {
        const size_t row0 = (size_t)b * SEQ + (size_t)(s * SEGC + c) * 64;
        int lz = 0; asm volatile("" : "+v"(lz));
        const int tidl = tid + lz, frl = fr + lz, h4l = h4 + lz;
#pragma unroll
        for (int j = 0; j < 4; ++j) { const int i = tidl + 512 * j, t = i >> 5, k4 = (i & 31) * 4; *(LAS f32x4*)(LB + t * 128 + k4) = *(const f32x4*)(LG + (row0 + t) * 512 + h * 128 + k4); }
        __syncthreads();
        if (tid < 128) { float run = 0.f;
#pragma unroll 8
            for (int t = 0; t < 64; ++t) { run += LB[t * 128 + tid]; LB[t * 128 + tid] = run; }
            BL[tid] = run; GM[tid] = __expf(run); gsum += run; }
        __syncthreads();
#pragma unroll
        for (int j = 0; j < 2; ++j) { const int i = tidl + 512 * j, t = i >> 4, k8 = (i & 15) * 8; const size_t go = (row0 + t) * 512 + h * 128 + k8;
            const v4u kw = *(const v4u*)(K + go); const float kv[8] = {bflo(kw.x), bfhi(kw.x), bflo(kw.y), bfhi(kw.y), bflo(kw.z), bfhi(kw.z), bflo(kw.w), bfhi(kw.w)};
            float bb[8], kh[8];
#pragma unroll
            for (int e = 0; e < 8; ++e) { bb[e] = LB[t * 128 + k8 + e]; kh[e] = kv[e] * __expf(BL[k8 + e] - bb[e]); }
            v4u o; o.x = pk2(kh[0], kh[1]); o.y = pk2(kh[2], kh[3]); o.z = pk2(kh[4], kh[5]); o.w = pk2(kh[6], kh[7]); *(LAS v4u*)(KH + t * PKH + k8) = o;
            if (FINAL) { const v4u qw = *(const v4u*)(Q + go); const float qv[8] = {bflo(qw.x), bfhi(qw.x), bflo(qw.y), bfhi(qw.y), bflo(qw.z), bfhi(qw.z), bflo(qw.w), bfhi(qw.w)};
                float qt[8], kt[8];
#pragma unroll
                for (int e = 0; e < 8; ++e) { qt[e] = qv[e] * __expf(bb[e]); kt[e] = kv[e] * __expf(-bb[e]); }
                v4u oq; oq.x = pk2(qt[0], qt[1]); oq.y = pk2(qt[2], qt[3]); oq.z = pk2(qt[4], qt[5]); oq.w = pk2(qt[6], qt[7]); *(LAS v4u*)(QT + t * PQ + k8) = oq;
                v4u ok; ok.x = pk2(kt[0], kt[1]); ok.y = pk2(kt[2], kt[3]); ok.z = pk2(kt[4], kt[5]); ok.w = pk2(kt[6], kt[7]); *(LAS v4u*)(KT + t * PQ + k8) = ok; } }
#pragma unroll
        for (int j = 0; j < 4; ++j) { const int i = tidl + 512 * j, t = i >> 5, c8 = (i & 31) * 8; *(LAS v4u*)(VT + t * PV + c8) = *(const v4u*)(V + (row0 + t) * 1024 + h * 256 + c8); }
        __syncthreads();
        f32x4 o[4][2];
        if (FINAL) {
            { const int tb = w >> 1;
#pragma unroll
              for (int q = 0; q < 2; ++q) { const int sb = 2 * (w & 1) + q; f32x4 acc = {0.f, 0.f, 0.f, 0.f};
                if (sb <= tb) {
#pragma unroll
                    for (int ks = 0; ks < 4; ++ks) { const bf16x8 a = *(const LAS bf16x8*)(QT + (16 * tb + fr) * PQ + 32 * ks + 8 * h4), bq = *(const LAS bf16x8*)(KT + (16 * sb + fr) * PQ + 32 * ks + 8 * h4);
                        acc = __builtin_amdgcn_mfma_f32_16x16x32_bf16(a, bq, acc, 0, 0, 0); } }
#pragma unroll
                for (int r = 0; r < 4; ++r) { const int tl = 4 * h4 + r; const float val = (sb < tb || (sb == tb && fr <= tl)) ? acc[r] : 0.f; ATT[(16 * tb + tl) * PATT + 16 * sb + fr] = (bf16)f2bf(val); } } }
            __syncthreads();
#pragma unroll
            for (int tb = 0; tb < 4; ++tb)
#pragma unroll
                for (int vb = 0; vb < 2; ++vb) o[tb][vb] = (f32x4){0.f, 0.f, 0.f, 0.f};
#pragma unroll
            for (int ss = 0; ss < 2; ++ss) { bf16x8 bv[2];
#pragma unroll
                for (int vb = 0; vb < 2; ++vb) TR_FRAG(bv[vb], vtr, (32 * ss * PV + 16 * vb) * 2, 4 * PV * 2);
#pragma unroll
                for (int tb = 0; tb < 4; ++tb) { if (ss == 1 && tb < 2) continue;
                    const bf16x8 a = *(const LAS bf16x8*)(ATT + (16 * tb + fr) * PATT + 32 * ss + 8 * h4);
#pragma unroll
                    for (int vb = 0; vb < 2; ++vb) o[tb][vb] = __builtin_amdgcn_mfma_f32_16x16x32_bf16(a, bv[vb], o[tb][vb], 0, 0, 0); } }
#pragma unroll
            for (int i = 0; i < 4; ++i) { bf16x8 bs[2];
#pragma unroll
                for (int vb = 0; vb < 2; ++vb) { v4u wv; wv.x = pk2(S[2 * i][vb][0], S[2 * i][vb][1]); wv.y = pk2(S[2 * i][vb][2], S[2 * i][vb][3]); wv.z = pk2(S[2 * i + 1][vb][0], S[2 * i + 1][vb][1]); wv.w = pk2(S[2 * i + 1][vb][2], S[2 * i + 1][vb][3]); bs[vb] = __builtin_bit_cast(bf16x8, wv); }
#pragma unroll
                for (int tb = 0; tb < 4; ++tb) { const LAS bf16* qp = QT + (16 * tb + fr) * PQ + 32 * i + 4 * h4; const v2u a_lo = *(const LAS v2u*)qp, a_hi = *(const LAS v2u*)(qp + 16);
                    const v4u aw = {a_lo.x, a_lo.y, a_hi.x, a_hi.y}; const bf16x8 a = __builtin_bit_cast(bf16x8, aw);
#pragma unroll
                    for (int vb = 0; vb < 2; ++vb) o[tb][vb] = __builtin_amdgcn_mfma_f32_16x16x32_bf16(a, bs[vb], o[tb][vb], 0, 0, 0); } }
        }
        if (FINAL) {
#pragma unroll
            for (int tb = 0; tb < 4; ++tb)
#pragma unroll
                for (int r = 0; r < 4; ++r) { float q = o[tb][0][r] * o[tb][0][r] + o[tb][1][r] * o[tb][1][r];
                    q += __shfl_xor(q, 1); q += __shfl_xor(q, 2); q += __shfl_xor(q, 4); q += __shfl_xor(q, 8);
                    if (fr == 0) SSQ[w * 64 + 16 * tb + 4 * h4 + r] = q; }
            __syncthreads();
#pragma unroll
            for (int tb = 0; tb < 4; ++tb)
#pragma unroll
                for (int r = 0; r < 4; ++r) { const int t = 16 * tb + 4 * h4l + r; float tot = 0.f;
#pragma unroll
                    for (int ww = 0; ww < 8; ++ww) tot += SSQ[ww * 64 + t];
                    const float rstd = __builtin_amdgcn_rsqf(tot * (1.0f / 256.0f) + EPS);
#pragma unroll
                    for (int vb = 0; vb < 2; ++vb) { const int col = h * 256 + 32 * w + 16 * vb + frl; const size_t go = (row0 + t) * 1024 + col;
                        AOUT2[go] = (bf16)f2bf(o[tb][vb][r] * rstd * gnorm[col] * bf2f(GATE[go])); } asm volatile("" ::: "memory"); }
        }
#pragma unroll
        for (int kb = 0; kb < 8; ++kb) { const f32x4 gm = *(const LAS f32x4*)(GM + 16 * kb + 4 * h4);
#pragma unroll
            for (int vb = 0; vb < 2; ++vb) S[kb][vb] = S[kb][vb] * gm; }
#pragma unroll
        for (int ts = 0; ts < 2; ++ts) { bf16x8 bv[2];
#pragma unroll
            for (int vb = 0; vb < 2; ++vb) TR_FRAG(bv[vb], vtr, (32 * ts * PV + 16 * vb) * 2, 4 * PV * 2);
#pragma unroll
            for (int kb = 0; kb < 8; ++kb) { bf16x8 a; TR_FRAG(a, ktr, (32 * ts * PKH + 16 * kb) * 2, 4 * PKH * 2);
#pragma unroll
                for (int vb = 0; vb < 2; ++vb) S[kb][vb] = __builtin_amdgcn_mfma_f32_16x16x32_bf16(a, bv[vb], S[kb][vb], 0, 0, 0); } }
        __syncthreads();
    }
    if (!FINAL) {
#pragma unroll
        for (int kb = 0; kb < 8; ++kb)
#pragma unroll
            for (int vb = 0; vb < 2; ++vb)
#pragma unroll
                for (int r = 0; r < 4; ++r) GDS[sbase + (size_t)(16 * kb + 4 * h4 + r) * 256 + 32 * w + 16 * vb + fr] = S[kb][vb][r];
        if (tid < 128) GAM[(size_t)(bh * NSEG + s) * 128 + tid] = __expf(gsum);
    }
}
__device__ __forceinline__ void gla_l2_phase(const Frame& F, const bf16* K, const bf16* V, const float* LG, float* GDS, const float* GAM) {
    for (long idx = F.gt; idx < (long)NB * GH * 128 * 64; idx += F.NGT) { const int v4 = (int)(idx & 63), k = (int)(idx >> 6) & 127, bh = (int)(idx >> 13), h = bh & 3;
        float bc[16]; float run = 0.f;
#pragma unroll
        for (int i = 0; i < NMETA; ++i) { run += LG[(size_t)(RM0 + i) * 512 + h * 128 + k]; bc[i] = run; }
        f32x4 carry = {0.f, 0.f, 0.f, 0.f};
#pragma unroll
        for (int i = 0; i < NMETA; ++i) { const float wk = __expf(run - bc[i]) * bf2f(K[(size_t)(RM0 + i) * 512 + h * 128 + k]); const v2u vw = *(const v2u*)(V + (size_t)(RM0 + i) * 1024 + h * 256 + 4 * v4);
            carry += (f32x4){bflo(vw.x), bfhi(vw.x), bflo(vw.y), bfhi(vw.y)} * wk; }
        for (int s = 0; s < NSEG; ++s) { f32x4* p = (f32x4*)(GDS + ((size_t)(bh * NSEG + s) * 128 + k) * 256 + 4 * v4); const f32x4 tmp = *p; *p = carry; carry = carry * GAM[(size_t)(bh * NSEG + s) * 128 + k] + tmp; }
    }
}

__device__ __forceinline__ void router_phase(const Frame& F, const Args& a, unsigned char* ws) {
    const float* const* in = a.in; unsigned* ctl = (unsigned*)(ws + WS_CTL); bf16* HNM = (bf16*)(ws + WS_HNM); int* tokinfo = (int*)(ws + WS_TOKINFO);
    const float* gain = in[I_NORM_FFN1]; const float* RW = in[I_ROUTER]; const int lane = F.lane;
    for (int m = F.gw; m < TR; m += F.NGW) {
        const f32x4* xr = (const f32x4*)(a.out + (size_t)m * 1024) + lane; const f32x4* gr = (const f32x4*)gain + lane;
        f32x4 v[4]; float s = 0.f;
#pragma unroll
        for (int j = 0; j < 4; ++j) { v[j] = xr[64 * j]; s += (v[j].x * v[j].x + v[j].y * v[j].y) + (v[j].z * v[j].z + v[j].w * v[j].w); }
        const float rstd = 1.0f / sqrtf(wave_sum(s) * (1.0f / 1024.0f) + EPS);
        float p[8] = {0.f, 0.f, 0.f, 0.f, 0.f, 0.f, 0.f, 0.f};
        v2u* o8 = (v2u*)(HNM + (size_t)m * 1024) + lane;
#pragma unroll
        for (int j = 0; j < 4; ++j) { const f32x4 g = gr[64 * j]; const f32x4 y = v[j] * rstd * g;
            v2u wv; wv.x = pk2(y.x, y.y); wv.y = pk2(y.z, y.w); o8[64 * j] = wv;
#pragma unroll
            for (int e4 = 0; e4 < 4; ++e4) { const int d = 4 * (lane + 64 * j) + e4; const f32x4 r0 = *(const f32x4*)(RW + d * 8), r1 = *(const f32x4*)(RW + d * 8 + 4);
#pragma unroll
                for (int e = 0; e < 4; ++e) { p[e] += y[e4] * r0[e]; p[4 + e] += y[e4] * r1[e]; } } }
        float q4[4];
#pragma unroll
        for (int i = 0; i < 4; ++i) { const bool up = (lane & 32) != 0; const float keep = up ? p[i + 4] : p[i], send = up ? p[i] : p[i + 4]; q4[i] = keep + __shfl_xor(send, 32); }
        float q2[2];
#pragma unroll
        for (int i = 0; i < 2; ++i) { const bool up = (lane & 16) != 0; const float keep = up ? q4[i + 2] : q4[i], send = up ? q4[i] : q4[i + 2]; q2[i] = keep + __shfl_xor(send, 16); }
        float y; { const bool up = (lane & 8) != 0; const float keep = up ? q2[1] : q2[0], send = up ? q2[0] : q2[1]; y = keep + __shfl_xor(send, 8); }
        y += __shfl_xor(y, 4); y += __shfl_xor(y, 2); y += __shfl_xor(y, 1);
        float lg[8];
#pragma unroll
        for (int e = 0; e < 8; ++e) lg[e] = __shfl(y, ((e >> 2) & 1) * 32 + ((e >> 1) & 1) * 16 + (e & 1) * 8);
        int i0 = 0; float v0 = lg[0];
#pragma unroll
        for (int e = 1; e < 8; ++e) if (lg[e] > v0) { v0 = lg[e]; i0 = e; }
        int i1 = -1; float v1 = -3.0e38f;
#pragma unroll
        for (int e = 0; e < 8; ++e) if (e != i0 && lg[e] > v1) { v1 = lg[e]; i1 = e; }
        if (lane == 0) { const float w0 = 1.0f / (1.0f + __expf(v1 - v0)), w1 = 1.0f - w0;
            const unsigned p0 = __hip_atomic_fetch_add(ctl + CW_CNT + i0, 1u, RLX_AGENT), p1 = __hip_atomic_fetch_add(ctl + CW_CNT + 8 + i1, 1u, RLX_AGENT);
            *(v4u*)(tokinfo + (size_t)m * 4) = (v4u){(unsigned)i0, p0, __builtin_bit_cast(unsigned, w0), 0u};
            *(v4u*)(tokinfo + (size_t)(TR + m) * 4) = (v4u){(unsigned)i1, p1, __builtin_bit_cast(unsigned, w1), 0u}; }
    }
    LAS float* scr = (LAS float*)(F.lds + RING_OFF + F.wave * 16384);
    constexpr int IG = 16 * 112, ID = 56 * 32, IE = 2 * IG + ID;
    bf16* WGU = (bf16*)(ws + WS_WMOE); bf16* WD = WGU + (size_t)NE * 7168 * 1024;
    for (int it = F.gw; it < NE * IE; it += F.NGW) { const int e = it / IE; int r = it % IE;
        { TrJob j{in[I_MG] + (size_t)e * 1024 * FFE, FFE, 0, 1024, FFE, WGU + (size_t)e * 7168 * 1024, 128, 256, 0}; if (tr_try(r, j, scr, lane)) continue; }
        { TrJob j{in[I_MU] + (size_t)e * 1024 * FFE, FFE, 0, 1024, FFE, WGU + (size_t)e * 7168 * 1024, 128, 256, 128}; if (tr_try(r, j, scr, lane)) continue; }
        { TrJob j{in[I_MD] + (size_t)e * FFE * 1024, 1024, 0, FFE, 1024, WD + (size_t)e * 1024 * FFE, 1 << 30, 0, 0}; tr_try(r, j, scr, lane); }
    }
}
__device__ __forceinline__ void moe_lists_phase(const Frame& F, unsigned char* ws) {
    unsigned* ctl = (unsigned*)(ws + WS_CTL); LAS int* L = (LAS int*)(F.lds + TABL_OFF);
    const int* tokinfo = (const int*)(ws + WS_TOKINFO); int* rowtok = (int*)(ws + WS_ROWTOK); float* roww = (float*)(ws + WS_ROWW);
    int* pexp = (int*)(ws + WS_TAB + TB_PEXP); int* npan = (int*)(ws + WS_TAB + TB_NPAN);
    if (F.tid < 16) L[F.tid] = (int)__hip_atomic_load(ctl + CW_CNT + F.tid, RLX_AGENT);
    __syncthreads();
    if (F.tid == 0) { for (int s = 0; s < 2; ++s) { int acc = 0; for (int e = 0; e < 8; ++e) { L[16 + s * 8 + e] = acc; acc += (L[s * 8 + e] + 255) & ~255; } L[32 + s] = acc >> 8; } }
    __syncthreads();
    if (blockIdx.x == 0) { if (F.tid < 2) npan[F.tid] = L[32 + F.tid];
        if (F.tid < 16) { const int s = F.tid >> 3, base = L[16 + F.tid], n = (L[F.tid] + 255) >> 8; for (int p = 0; p < n; ++p) pexp[s * MPAN + (base >> 8) + p] = F.tid & 7; } }
    for (long i = F.gt; i < 2L * TR; i += F.NGT) { const int s = (int)(i >= TR), tok = (int)(i - (long)s * TR); const v4u inf = *(const v4u*)(tokinfo + i * 4);
        const int row = L[16 + s * 8 + (int)inf.x] + (int)inf.y; rowtok[(size_t)s * MROWS + row] = tok; const unsigned wb = inf.z; roww[(size_t)s * MROWS + row] = __uint_as_float(wb); }
    for (long i = F.gt; i < 16L * 256; i += F.NGT) { const int se = (int)(i >> 8), r = (int)(i & 255), s = se >> 3, cnt = L[se], base = L[16 + se], pad = ((cnt + 255) & ~255) - cnt;
        if (r < pad) { rowtok[(size_t)s * MROWS + base + cnt + r] = -1; roww[(size_t)s * MROWS + base + cnt + r] = 0.f; } }
}

constexpr int N_PHASES = 25;
__global__ void __launch_bounds__(512, 2) mk_fwd(Args args) {
    extern __shared__ __attribute__((aligned(16))) unsigned char lds_raw[];
    Frame F; F.lds = (LAS unsigned char*)lds_raw; F.tid = threadIdx.x; F.lane = F.tid & 63; F.wave = __builtin_amdgcn_readfirstlane(F.tid >> 6); F.G = gridDim.x;
    F.gw = blockIdx.x * 8 + F.wave; F.NGW = F.G * 8; F.gt = (long)blockIdx.x * 512 + F.tid; F.NGT = (long)F.G * 512;
    unsigned char* ws = args.ws; const float* const* in = args.in; float* out = args.out;
    volatile LAS unsigned* MISC = (volatile LAS unsigned*)(F.lds + MISC_OFF);
    if (F.tid < 32) MISC[F.tid] = 0u;
    __syncthreads();
#if !MK_PER_PHASE
    XcdBarrier bar = xcd_barrier_post((unsigned*)(ws + WS_CTL) + CW_BAR, MISC + 8);
#define GRID_BAR() xcd_barrier(bar)
#else
#define GRID_BAR() do { } while (0)
#endif
    const int lo = args.ph_lo, hi = args.ph_hi;
#ifndef MK_MASK
#define MK_MASK 0xFFFFFFFFu
#endif
#ifndef MK_STOP
#define MK_STOP 99
#endif
#define IN(k) ((((MK_MASK) >> (k)) & 1u) && ((k) <= MK_STOP || (k) == 24) && lo <= (k) && (k) < hi)
#define SEAM(k) do { if (IN(k) && IN((k) + 1)) GRID_BAR(); } while (0)
    const int cu = (int)blockIdx.x;
    LAS unsigned char* ring = F.lds + RING_OFF;
    const LAS int* notab = (const LAS int*)(F.lds + TABL_OFF);
    float* hmeta = (float*)(ws + WS_HMETA);
    bf16* HN = (bf16*)(ws + WS_HN);
    constexpr size_t P1K = (size_t)256 * 1024 * 2;

    if (IN(0)) { p0_prologue(F, args, ws); } SEAM(0);
    if (IN(1)) { SchedStatic S{NPA, 10, F.G, cu, (const char*)HN, (const char*)(ws + WS_WIN0), P1K, P1K, 0, 0}; EpiWin0 E{(bf16*)(ws + WS_G), (bf16*)(ws + WS_XRBX), (bf16*)(ws + WS_U)};
        pg8::gemm_phase<EpiWin0, SchedStatic, false>(ring, 1024, 1024, S, E, notab); } SEAM(1);
    if (IN(2)) { conv_phase(F, (const bf16*)(ws + WS_XRBX), in[I_CONVW], in[I_CONVB], (bf16*)(ws + WS_XC)); ssm_l1_phase(F, ws, (const bf16*)(ws + WS_U), (float*)(ws + WS_SSE)); } SEAM(2);
    if (IN(3)) { SchedStatic S{NPA, 8, F.G, cu, (const char*)(ws + WS_XC), (const char*)(ws + WS_GW), P1K, (size_t)256 * 256 * 2, 2, (size_t)256 * 2};
        EpiGates E{in[I_GAB], in[I_GXB], (const float*)(ws + WS_TAB + TB_SP8), (const bf16*)(ws + WS_XC), (float*)(ws + WS_A), (bf16*)(ws + WS_XRBX)};
        pg8::gemm_phase<EpiGates, SchedStatic, false>(ring, 256, 1024, S, E, notab); } SEAM(3);
    if (IN(4)) { lru_l1_phase(F, (const float*)(ws + WS_A), (const bf16*)(ws + WS_XRBX), (float*)(ws + WS_PEND), (float*)(ws + WS_HEND)); } SEAM(4);
    if (IN(5)) { carry_phase(F, ws, (const float*)(ws + WS_A), (const bf16*)(ws + WS_XRBX), (const float*)(ws + WS_PEND), (const float*)(ws + WS_HEND), (float*)(ws + WS_CIN), (const bf16*)(ws + WS_U), (const float*)(ws + WS_SSE), (float*)(ws + WS_SSIN)); } SEAM(5);
    if (IN(6)) { mix0_final_phase(F, ws, (const float*)(ws + WS_A), (const bf16*)(ws + WS_XRBX), (const float*)(ws + WS_CIN), (const bf16*)(ws + WS_G), (bf16*)(ws + WS_AOUT), in[I_CRE], in[I_CIM], in[I_SD], (const bf16*)(ws + WS_U), (const float*)(ws + WS_SSIN), (bf16*)(ws + WS_GS)); } SEAM(6);
    if (IN(7)) { SchedStatic S{NPA, 2, F.G, cu, (const char*)(ws + WS_GS), (const char*)(ws + WS_GLUW), (size_t)256 * 512 * 2, (size_t)256 * 512 * 2, 0, 0}; EpiGlu E{in[I_GLUB], (const bf16*)(ws + WS_GS), (bf16*)(ws + WS_AOUT)};
        pg8::gemm_phase<EpiGlu, SchedStatic, false>(ring, 512, 512, S, E, notab); } SEAM(7);
    if (IN(8)) { SchedStatic S{NPA, 4, F.G, cu, (const char*)(ws + WS_AOUT), (const char*)(ws + WS_WOUT0), (size_t)256 * 1536 * 2, (size_t)256 * 1536 * 2, 0, 0}; EpiResid E{in[I_X], out, hmeta};
        pg8::gemm_phase<EpiResid, SchedStatic, false>(ring, 1536, 1536, S, E, notab); } SEAM(8);
    if (IN(9)) { norm_phase(F, out, hmeta, in[I_NORM_FFN0], HN, TR + NMETA); } SEAM(9);
    if (IN(10)) { SchedStatic S{NPA, 24, F.G, cu, (const char*)HN, (const char*)(ws + WS_WUP0), P1K, P1K, 0, 0}; EpiSwiglu E{(bf16*)(ws + WS_HID0), FF0};
        pg8::gemm_phase<EpiSwiglu, SchedStatic, false>(ring, 1024, 1024, S, E, notab); } SEAM(10);
    if (IN(11)) { SchedStatic S{NPA, 4, F.G, cu, (const char*)(ws + WS_HID0), (const char*)(ws + WS_WDN0), (size_t)256 * FF0 * 2, (size_t)256 * FF0 * 2, 0, 0}; EpiResid E{out, out, hmeta};
        pg8::gemm_phase<EpiResid, SchedStatic, false>(ring, FF0, FF0, S, E, notab); } SEAM(11);
    if (IN(12)) { norm_phase(F, out, hmeta, in[I_NORM_MIX1], HN, TR + NMETA); } SEAM(12);
    if (IN(13)) { SchedStatic S{NPA, 14, F.G, cu, (const char*)HN, (const char*)(ws + WS_WIN1), P1K, P1K, 0, 0}; EpiWin1 E{(bf16*)(ws + WS_Q), (bf16*)(ws + WS_K), (bf16*)(ws + WS_V), (bf16*)(ws + WS_GATE), (float*)(ws + WS_LG), in[I_GB]};
        pg8::gemm_phase<EpiWin1, SchedStatic, false>(ring, 1024, 1024, S, E, notab); } SEAM(13);
    if (IN(14)) { for (int it = cu; it < NB * GH * NSEG; it += F.G) gla_item<false>(F, it >> 6, (it >> 4) & 3, it & 15, (const bf16*)(ws + WS_Q), (const bf16*)(ws + WS_K), (const bf16*)(ws + WS_V), (const bf16*)(ws + WS_GATE), (const float*)(ws + WS_LG), in[I_GNORM], (float*)(ws + WS_GDS), (float*)(ws + WS_TAB + TB_GAM), (bf16*)(ws + WS_AOUT2)); } SEAM(14);
    if (IN(15)) { gla_l2_phase(F, (const bf16*)(ws + WS_K), (const bf16*)(ws + WS_V), (const float*)(ws + WS_LG), (float*)(ws + WS_GDS), (const float*)(ws + WS_TAB + TB_GAM)); } SEAM(15);
    if (IN(16)) { for (int it = cu; it < NB * GH * NSEG; it += F.G) gla_item<true>(F, it >> 6, (it >> 4) & 3, it & 15, (const bf16*)(ws + WS_Q), (const bf16*)(ws + WS_K), (const bf16*)(ws + WS_V), (const bf16*)(ws + WS_GATE), (const float*)(ws + WS_LG), in[I_GNORM], (float*)(ws + WS_GDS), (float*)(ws + WS_TAB + TB_GAM), (bf16*)(ws + WS_AOUT2)); } SEAM(16);
    if (IN(17)) { SchedStatic S{NPR, 4, F.G, cu, (const char*)(ws + WS_AOUT2), (const char*)(ws + WS_WOUT1), P1K, P1K, 0, 0}; EpiResid E{out, out, hmeta};
        pg8::gemm_phase<EpiResid, SchedStatic, false>(ring, 1024, 1024, S, E, notab); } SEAM(17);
    if (IN(18)) { router_phase(F, args, ws); } SEAM(18);
    if (IN(19)) { moe_lists_phase(F, ws); } SEAM(19);
#define MOE_PHASES(pu, pd, slot) \
    if (IN(pu)) { const int np = ((const int*)(ws + WS_TAB + TB_NPAN))[slot], nun = np * 28; LAS int* meta = (LAS int*)(F.lds + TABL_OFF); LAS int* tokt = (LAS int*)(F.lds + TABL_OFF + 512); \
        const int* pexp = (const int*)(ws + WS_TAB + TB_PEXP) + (slot) * MPAN; const int* rowtok = (const int*)(ws + WS_ROWTOK) + (size_t)(slot) * MROWS; int nmy = 0; \
        __syncthreads(); \
        for (int i = 0; (long)i * F.G + cu < nun && i < 20; ++i) { const int Lq = i * F.G + cu, p = Lq / 28, n = Lq % 28; if (F.tid == 0) { meta[i * 4] = p; meta[i * 4 + 1] = n; meta[i * 4 + 2] = pexp[p]; meta[i * 4 + 3] = 0; } \
            if (F.tid < 256) tokt[i * 256 + F.tid] = rowtok[p * 256 + F.tid]; ++nmy; } \
        __syncthreads(); \
        SchedList S{nmy, meta, (const char*)(ws + WS_HNM), (const char*)(ws + WS_WMOE), 0, P1K, (size_t)7168 * 1024 * 2}; EpiSwiglu E{(bf16*)(ws + WS_HIDM), FFE}; \
        pg8::gemm_phase<EpiSwiglu, SchedList, true>(ring, 1024, 1024, S, E, tokt); } SEAM(pu); \
    if (IN(pd)) { const int np = ((const int*)(ws + WS_TAB + TB_NPAN))[slot], nun = np * 4; LAS int* meta = (LAS int*)(F.lds + TABL_OFF); LAS int* tokt = (LAS int*)(F.lds + TABL_OFF + 512); LAS float* wtt = (LAS float*)(F.lds + TABL_OFF + 512 + 4096); \
        const int* pexp = (const int*)(ws + WS_TAB + TB_PEXP) + (slot) * MPAN; const int* rowtok = (const int*)(ws + WS_ROWTOK) + (size_t)(slot) * MROWS; const float* roww = (const float*)(ws + WS_ROWW) + (size_t)(slot) * MROWS; int nmy = 0; \
        __syncthreads(); \
        for (int i = 0; (long)i * F.G + cu < nun && i < 4; ++i) { const int Lq = i * F.G + cu, p = Lq / 4, n = Lq % 4; if (F.tid == 0) { meta[i * 4] = p; meta[i * 4 + 1] = n; meta[i * 4 + 2] = pexp[p]; meta[i * 4 + 3] = 0; } \
            if (F.tid < 256) { tokt[i * 256 + F.tid] = rowtok[p * 256 + F.tid]; wtt[i * 256 + F.tid] = roww[p * 256 + F.tid]; } ++nmy; } \
        __syncthreads(); \
        SchedList S{nmy, meta, (const char*)(ws + WS_HIDM), (const char*)(ws + WS_WMOE) + (size_t)NE * 7168 * 1024 * 2, (size_t)256 * FFE * 2, (size_t)256 * FFE * 2, (size_t)1024 * FFE * 2}; EpiMoeDown E{out, tokt, wtt}; \
        pg8::gemm_phase<EpiMoeDown, SchedList, false>(ring, FFE, FFE, S, E, tokt); } SEAM(pd);
    MOE_PHASES(20, 21, 0)
    MOE_PHASES(22, 23, 1)
    if (IN(24)) { for (int m = F.gw; m < TR; m += F.NGW) { float* row = out + (size_t)m * 1024; f32x4* xr = (f32x4*)row + F.lane; const f32x4* xs = (MK_STOP < 8) ? (const f32x4*)(in[I_X] + (size_t)m * 1024) + F.lane : xr; const f32x4* gr = (const f32x4*)in[I_FNORM] + F.lane;
            f32x4 v[4]; float s = 0.f;
#pragma unroll
            for (int j = 0; j < 4; ++j) { v[j] = xs[64 * j]; s += (v[j].x * v[j].x + v[j].y * v[j].y) + (v[j].z * v[j].z + v[j].w * v[j].w); }
            const float rstd = 1.0f / sqrtf(wave_sum(s) * (1.0f / 1024.0f) + EPS);
#pragma unroll
            for (int j = 0; j < 4; ++j) xr[64 * j] = v[j] * rstd * gr[64 * j]; }
#ifdef MK_READOUT
        __syncthreads();
        { float val = 0.f;
          const int* npan_ = (const int*)(ws + WS_TAB + TB_NPAN); const unsigned* ctl_ = (const unsigned*)(ws + WS_CTL); const int* rowtok_ = (const int*)(ws + WS_ROWTOK); const float* roww_ = (const float*)(ws + WS_ROWW); const bf16* hid_ = (const bf16*)(ws + WS_HIDM);
          if (MK_READOUT == 1) val = (float)npan_[0];
          if (MK_READOUT == 2) val = (float)ctl_[CW_CNT + 0] * 0.01f;
          if (MK_READOUT == 3) { int c = 0; for (int i = 0; i < 2048; ++i) c += rowtok_[i] >= 0; val = (float)c * 0.01f; }
          if (MK_READOUT == 4) { float a = 0.f; for (int i = 0; i < 2048; ++i) a += fabsf(bf2f(hid_[(size_t)i * 3584 + (i & 1023)])); val = a * 0.01f; }
          if (MK_READOUT == 5) { float a = 0.f; for (int i = 0; i < 2048; ++i) a += roww_[i]; val = a * 0.01f; }
          if (MK_READOUT == 6) { const float* ti = (const float*)(ws + WS_TOKINFO); float a = 0.f; for (int i = 0; i < 2048; ++i) a += ti[i * 4 + 2]; val = a * 0.01f; }
          if (MK_READOUT == 7) { const int* ti = (const int*)(ws + WS_TOKINFO); int a = 0; for (int i = 0; i < 2048; ++i) a += ti[i * 4 + 0]; val = (float)a * 0.01f; }
          if (MK_READOUT == 8) { float a = 0.f; for (int i = 0; i < 2048; ++i) { const float x = bf2f(hid_[(size_t)i * 3584 + (i & 1023)]); a += (x == x && fabsf(x) < 1e30f) ? 0.f : 1.f; } val = a * 0.01f; }
          if (MK_READOUT == 9) { int c = 0; for (int i = 0; i < 2048; ++i) c += (rowtok_[i] >= 0 && rowtok_[i] < TR); val = (float)c * 0.01f; }
          if (MK_READOUT == 10) { int c = 0; for (int i = 0; i < 2048; ++i) c += (roww_[i] > 0.f && roww_[i] <= 1.0f); val = (float)c * 0.01f; }
          if (MK_READOUT == 11) { float a = 0.f; for (int i = 0; i < 2048; ++i) a += (float)rowtok_[i]; val = a * 1e-6f; }
          if (val != val) val = 400.f;
          const float cst = sqrtf(fmaxf(val, 0.f));
          for (int m = F.gw; m < TR; m += F.NGW) { f32x4* xr = (f32x4*)(out + (size_t)m * 1024) + F.lane;
            for (int j = 0; j < 4; ++j) xr[64 * j] = (f32x4){cst, cst, cst, cst}; } }
#endif
    }
#undef IN
#undef SEAM
}

extern "C" void kernel_launch(void* const* d_in, const int* in_sizes, int n_in, void* d_out, int out_size, void* d_ws, size_t ws_size, hipStream_t stream) {
    static int grid = 0;
    if (grid == 0) {
        if (n_in != 38 || out_size != TR * D || ws_size < WS_END) { fprintf(stderr, "kernel_launch: unexpected problem shape (n_in %d, out %d, ws %zu); nothing launched\n", n_in, out_size, ws_size); grid = -1; return; }
        int dev = 0, cus = 0, per_cu = 0;
        if (hipGetDevice(&dev) != hipSuccess || hipDeviceGetAttribute(&cus, hipDeviceAttributeMultiprocessorCount, dev) != hipSuccess) { grid = -1; return; }
        if (hipFuncSetAttribute((const void*)mk_fwd, hipFuncAttributeMaxDynamicSharedMemorySize, LDS_BYTES) != hipSuccess) { fprintf(stderr, "kernel_launch: hipFuncSetAttribute failed\n"); grid = -1; return; }
        if (hipOccupancyMaxActiveBlocksPerMultiprocessor(&per_cu, (const void*)mk_fwd, 512, LDS_BYTES) != hipSuccess || per_cu < 1) fprintf(stderr, "kernel_launch: note: occupancy query reports %d workgroups per CU\n", per_cu);
        (void)hipGetLastError();
        grid = cus;
    }
    if (grid < 0) return;
    (void)hipMemsetAsync((char*)d_ws + WS_CTL, 0, CTL_ZERO_BYTES, stream);
    Args a{};
    for (int i = 0; i < 38; ++i) a.in[i] = (const float*)d_in[i];
    a.out = (float*)d_out; a.ws = (unsigned char*)d_ws; a.li = 0; a.pad = 0;
#if MK_PER_PHASE
    for (int k = 0; k < N_PHASES; ++k) { a.ph_lo = k; a.ph_hi = k + 1; hipLaunchKernelGGL(mk_fwd, dim3(grid), dim3(512), LDS_BYTES, stream, a); }
#else
    a.ph_lo = 0; a.ph_hi = N_PHASES; hipLaunchKernelGGL(mk_fwd, dim3(grid), dim3(512), LDS_BYTES, stream, a);
#endif
}
```

```cpp
#include <hip/hip_runtime.h>
#include <cstdio>
#include <cstdint>

#ifndef MK_PER_PHASE
#define MK_PER_PHASE 0
#endif

#define GAS __attribute__((address_space(1)))
#define LAS __attribute__((address_space(3)))
typedef unsigned short bf16;
typedef unsigned v4u __attribute__((ext_vector_type(4)));
typedef unsigned v2u __attribute__((ext_vector_type(2)));
typedef float f32x4 __attribute__((ext_vector_type(4)));
typedef float f32x2 __attribute__((ext_vector_type(2)));
typedef short bf16x8 __attribute__((ext_vector_type(8)));

constexpr int D = 1024, NB = 4, SEQ = 8192, NMETA = 16;
constexpr int TR = NB * SEQ;
constexpr int RM0 = TR;
constexpr int NPR = 128, NPA = 129;
constexpr int RALL = NPA * 256;
constexpr int LRUW = 1024, SSMW = 512, NG = 32, NS = 64, EV_IN = 2560, EV_MIX = 1536, FF0 = 3072;
constexpr int GK = 512, GV = 1024, GH = 4, GDK = 128, GDV = 256, OD_INP = 3584  , OD_IN = 3088;
constexpr int NE = 8, FFE = 3584, MROWS = 34816  , MPAN = 136;
constexpr float EPS = 1e-6f;
constexpr int NCH = 128;
constexpr int NSEG = 16, SEGC = 8;

constexpr size_t MiB = 1u << 20;
constexpr size_t WS_CTL = 0, CTL_ZERO_BYTES = 1 * MiB;
constexpr size_t WS_TAB = 1 * MiB;
constexpr size_t WS_WIN0 = 2 * MiB, WS_GW = 7 * MiB, WS_GLUW = 8 * MiB, WS_WOUT0 = 9 * MiB, WS_WUP0 = 12 * MiB, WS_WDN0 = 24 * MiB, WS_WIN1 = 30 * MiB, WS_WOUT1 = 37 * MiB;
constexpr size_t WS_PEND = 40 * MiB, WS_HEND = 42 * MiB, WS_CIN = 44 * MiB, WS_SSE = 46 * MiB, WS_SSIN = 54 * MiB, WS_GDS = 62 * MiB, WS_HMETA = 94 * MiB;
constexpr size_t WS_G = 96 * MiB, WS_U = 161 * MiB, WS_A = 194 * MiB, WS_XRBX = 323 * MiB, WS_HN = 388 * MiB, WS_AOUT = 388 * MiB, WS_XC = 453 * MiB, WS_GS = 485 * MiB;
constexpr size_t WS_HID0 = 96 * MiB;
constexpr size_t WS_Q = 96 * MiB, WS_K = 129 * MiB, WS_V = 162 * MiB, WS_GATE = 227 * MiB, WS_LG = 292 * MiB, WS_AOUT2 = 453 * MiB;
constexpr size_t WS_HNM = 40 * MiB, WS_WMOE = 105 * MiB, WS_HIDM = 273 * MiB, WS_TOKINFO = 511 * MiB, WS_ROWTOK = 512 * MiB, WS_ROWW = 512 * MiB + 512 * 1024, WS_END = 513 * MiB;
constexpr size_t TB_BBR = 0, TB_BBI = 131072, TB_AR = 262144, TB_AI = 270336, TB_AR64 = 278528, TB_AI64 = 286720, TB_SP8 = 294912, TB_GAM = 299008  , TB_PEXP = 430080  , TB_NPAN = 432128;
constexpr int CW_TMO = 0, CW_CODE = 1, CW_CNT = 64  , CW_BAR = 4096;

constexpr int RING_OFF = 0, RING_BYTES = 131072;
constexpr int TABL_OFF = RING_BYTES, TABL_BYTES = 24576;
constexpr int MISC_OFF = TABL_OFF + TABL_BYTES;
constexpr int LDS_BYTES = MISC_OFF + 128;

#define RLX_AGENT __ATOMIC_RELAXED, __HIP_MEMORY_SCOPE_AGENT
#define LDS_WAIT() asm volatile("s_waitcnt lgkmcnt(0)" ::: "memory")
#define VM_WAIT() asm volatile("s_waitcnt vmcnt(0)" ::: "memory")
__device__ __forceinline__ unsigned f2bf(float f) { unsigned u = __builtin_bit_cast(unsigned, f); return (u + 0x7fffu + ((u >> 16) & 1u)) >> 16; }
__device__ __forceinline__ unsigned pk2(float lo, float hi) { return f2bf(lo) | (f2bf(hi) << 16); }
__device__ __forceinline__ float bf2f(unsigned b) { return __builtin_bit_cast(float, b << 16); }
__device__ __forceinline__ float bflo(unsigned w) { return __builtin_bit_cast(float, w << 16); }
__device__ __forceinline__ float bfhi(unsigned w) { return __builtin_bit_cast(float, w & 0xffff0000u); }
__device__ __forceinline__ float rcpf_(float x) { return __builtin_amdgcn_rcpf(x); }
__device__ __forceinline__ float sigmoidf_(float x) { return rcpf_(1.0f + __expf(-x)); }
__device__ __forceinline__ float siluf_(float x) { return x * rcpf_(1.0f + __expf(-x)); }
__device__ __forceinline__ float gelu_tanh(float x) { const float u = 0.7978845608028654f * (x + 0.044715f * x * x * x); return x * rcpf_(1.0f + __expf(-2.0f * u)); }
__device__ __forceinline__ float one_minus_exp(float x) { const float p = -x * (1.0f + 0.5f * x * (1.0f + (1.0f / 3.0f) * x * (1.0f + 0.25f * x * (1.0f + 0.2f * x * (1.0f + (1.0f / 6.0f) * x))))); return x > -0.25f ? p : 1.0f - __expf(x); }
__device__ __forceinline__ float logsigmoidf_(float x) { return fminf(x, 0.0f) - log1pf(__expf(-fabsf(x))); }
__device__ __forceinline__ float wave_sum(float v) {
#pragma unroll
    for (int o = 1; o < 64; o <<= 1) v += __shfl_xor(v, o);
    return v;
}

namespace pg8 {
constexpr int BM = 256, BK = 64, HALF = 128, HTB = HALF * BK * 2, STAGE_BYTES = 8 * HTB, NXCD = 8, WGM = 8;
__host__ __device__ __forceinline__ int lds_byte(int r, int c) { const int st = (r >> 4) * 2 + (c >> 5), rr = r & 15, cc = c & 31, ob = rr * 64 + cc * 2; return st * 1024 + (ob ^ (((ob >> 9) & 1) << 5)); }
__host__ __device__ __forceinline__ void stage_rc(int b, int& R, int& C) { const int st = b / 1024, sb = b % 1024, swz = sb ^ (((sb >> 9) & 1) << 5); R = (st >> 1) * 16 + swz / 64; C = (st & 1) * 32 + (swz % 64) / 2; }
__host__ __device__ __forceinline__ int perm32(int rho) { const int n = rho >> 4, i = rho & 15; return 8 * (i >> 2) + 4 * n + (i & 3); }

struct Unit { int pm, pn, slot; const char* a; const char* b; };
__device__ __forceinline__ bool static_tile(int i, int G, int c, int nM, int nN, int& pm, int& pn) {
    const int nwg = nM * nN; const long L = (long)i * G + c; if (L >= nwg) return false;
    int wgid = (int)L; { const int q = nwg / NXCD, r = nwg % NXCD, xcd = wgid % NXCD, off = wgid / NXCD; wgid = (xcd < r ? xcd * (q + 1) : r * (q + 1) + (xcd - r) * q) + off; }
    const int nig = WGM * nN, gid = wgid / nig, fm = gid * WGM, gsz = (nM - fm) < WGM ? (nM - fm) : WGM;
    pm = fm + ((wgid % nig) % gsz); pn = (wgid % nig) / gsz; return true;
}
__device__ __forceinline__ unsigned cvt_pk_bf16(float lo, float hi) { unsigned r; asm volatile("v_cvt_pk_bf16_f32 %0, %1, %2" : "=v"(r) : "v"(lo), "v"(hi)); return r; }

template <class Epi, class Sched, bool GATHER>
__device__ __forceinline__ void gemm_phase(LAS unsigned char* lds, const int K, const int lda, const Sched& S, const Epi& E, const LAS int* gtab) {
    const int tid = threadIdx.x, wid = __builtin_amdgcn_readfirstlane(tid >> 6), lane = tid & 63, wr = wid >> 2, wc = wid & 3, fr = lane & 15, fq = lane >> 4;
    int nt = K / BK; asm volatile("" : "+s"(nt));
    int RA[2], CA[2]; unsigned voffB[2];
#pragma unroll
    for (int i = 0; i < 2; ++i) { int R, C; stage_rc(tid * 16 + i * 8192, R, C); const int Rb = Epi::PERM ? ((R & ~31) + perm32(R & 31)) : R;
        RA[i] = R; CA[i] = C; voffB[i] = (unsigned)(Rb * K + C) * 2u; }
    const size_t kstep = (size_t)(BK * 2);
    const size_t hstepB = (size_t)HALF * K * 2;
    const unsigned ldsw = (unsigned)wid * 1024u;
    const int aoff = lds_byte(wr * 64 + fr, fq * 8), boff = lds_byte(wc * 32 + fr, fq * 8);
    unsigned offC[2][2], offN[2][2];
#define PG8_SETOFF(dst, unit) do { _Pragma("unroll") for (int _h = 0; _h < 2; ++_h) _Pragma("unroll") for (int _i = 0; _i < 2; ++_i) { \
        if constexpr (GATHER) { int _t = gtab[(unit).slot * 256 + _h * HALF + RA[_i]]; _t = _t < 0 ? 0 : _t; dst[_h][_i] = ((unsigned)_t * (unsigned)lda + (unsigned)CA[_i]) * 2u; } \
        else dst[_h][_i] = ((unsigned)(_h * HALF + RA[_i]) * (unsigned)lda + (unsigned)CA[_i]) * 2u; } } while (0)
#define PG8_SA(b, h) (((b) * 2 + (h)) * HTB)
#define PG8_SB(b, h) ((4 + (b) * 2 + (h)) * HTB)
#define PG8_STAGEB(bufoff, gbase) do { _Pragma("unroll") for (int _i = 0; _i < 2; ++_i) \
        __builtin_amdgcn_global_load_lds((const unsigned*)((const char*)(gbase) + voffB[_i]), (LAS unsigned*)(lds + (bufoff) + ldsw + _i * 8192), 16, 0, 0); } while (0)
#define PG8_STAGEA(bufoff, gbase, o0, o1) do { \
        __builtin_amdgcn_global_load_lds((const unsigned*)((const char*)(gbase) + (o0)), (LAS unsigned*)(lds + (bufoff) + ldsw), 16, 0, 0); \
        __builtin_amdgcn_global_load_lds((const unsigned*)((const char*)(gbase) + (o1)), (LAS unsigned*)(lds + (bufoff) + ldsw + 8192), 16, 0, 0); } while (0)
#define PG8_LDA(dst, b, h) do { _Pragma("unroll") for (int m = 0; m < 4; ++m) _Pragma("unroll") for (int k = 0; k < 2; ++k) dst[m][k] = *(const LAS bf16x8*)(lds + PG8_SA(b, h) + aoff + m * 2048 + k * 1024); } while (0)
#define PG8_LDB(dst, b, h) do { _Pragma("unroll") for (int n = 0; n < 2; ++n) _Pragma("unroll") for (int k = 0; k < 2; ++k) dst[n][k] = *(const LAS bf16x8*)(lds + PG8_SB(b, h) + boff + n * 2048 + k * 1024); } while (0)
#define PG8_MMA(ai, bj, At, Bt) do { __builtin_amdgcn_s_setprio(1); _Pragma("unroll") for (int m = 0; m < 4; ++m) _Pragma("unroll") for (int n = 0; n < 2; ++n) _Pragma("unroll") for (int k = 0; k < 2; ++k) \
        acc[ai][bj][m][n] = __builtin_amdgcn_mfma_f32_16x16x32_bf16(Bt[n][k], At[m][k], acc[ai][bj][m][n], 0, 0, 0); __builtin_amdgcn_s_setprio(0); } while (0)
#define PG8_WAIT_V(n) asm volatile("s_waitcnt vmcnt(" #n ")" ::: "memory")
#define PG8_WAIT_L(n) asm volatile("s_waitcnt lgkmcnt(" #n ")" ::: "memory")
#define PG8_BAR __builtin_amdgcn_s_barrier()
#define PG8_SCHED __builtin_amdgcn_sched_barrier(0)
    Unit cur, nxt; int ui = 0;
    if (!S.next(0, cur)) return;
    f32x4 acc[2][2][4][2];
#pragma unroll
    for (int a = 0; a < 2; ++a)
#pragma unroll
        for (int b = 0; b < 2; ++b)
#pragma unroll
            for (int m = 0; m < 4; ++m)
#pragma unroll
                for (int n = 0; n < 2; ++n) acc[a][b][m][n] = (f32x4){0.f, 0.f, 0.f, 0.f};
    bf16x8 At[4][2], B0[2][2], B1[2][2];
    const char* cA = cur.a; const char* cB = cur.b;
    PG8_SETOFF(offC, cur);
    PG8_STAGEB(PG8_SB(0, 0), cB); PG8_STAGEB(PG8_SB(0, 1), cB + hstepB); PG8_STAGEA(PG8_SA(0, 0), cA, offC[0][0], offC[0][1]); PG8_STAGEA(PG8_SA(0, 1), cA, offC[1][0], offC[1][1]);
    if (wr == 1) PG8_BAR;
    PG8_WAIT_V(2); PG8_BAR;
    PG8_STAGEB(PG8_SB(1, 0), cB + kstep); PG8_STAGEA(PG8_SA(1, 0), cA + kstep, offC[0][0], offC[0][1]); PG8_STAGEB(PG8_SB(1, 1), cB + hstepB + kstep);
    PG8_WAIT_V(6); PG8_BAR;
    for (;;) {
        const bool has_next = S.next(ui + 1, nxt);
        const char* nA = has_next ? nxt.a : cA; const char* nB = has_next ? nxt.b : cB;
#pragma unroll
        for (int h = 0; h < 2; ++h)
#pragma unroll
            for (int i = 0; i < 2; ++i) offN[h][i] = offC[h][i];
        for (int t = 0; t < nt; t += 2) {
            const bool last = (t == nt - 2);
            const char* a1 = cA + (size_t)(t + 1) * kstep;
            const char* a2 = last ? nA : cA + (size_t)(t + 2) * kstep; const char* b2 = last ? nB : cB + (size_t)(t + 2) * kstep;
            const char* a3 = a2 + kstep; const char* b3 = b2 + kstep;
            if constexpr (GATHER) { if (last && has_next) PG8_SETOFF(offN, nxt); }
            const unsigned q00 = last ? offN[0][0] : offC[0][0], q01 = last ? offN[0][1] : offC[0][1], q10 = last ? offN[1][0] : offC[1][0], q11 = last ? offN[1][1] : offC[1][1];
            PG8_LDB(B0, 0, 0); PG8_LDB(B1, 0, 1); PG8_SCHED; PG8_LDA(At, 0, 0); PG8_STAGEA(PG8_SA(1, 1), a1, offC[1][0], offC[1][1]);
            PG8_WAIT_V(8); PG8_WAIT_L(0); PG8_BAR; PG8_MMA(0, 0, At, B0); PG8_MMA(0, 1, At, B1); PG8_BAR; PG8_SCHED;
            PG8_LDA(At, 0, 1); PG8_STAGEB(PG8_SB(0, 0), b2); PG8_STAGEB(PG8_SB(0, 1), b2 + hstepB); PG8_STAGEA(PG8_SA(0, 0), a2, q00, q01);
            PG8_WAIT_V(8); PG8_WAIT_L(0); PG8_BAR; PG8_MMA(1, 0, At, B0); PG8_MMA(1, 1, At, B1); PG8_BAR; PG8_SCHED;
            PG8_LDB(B0, 1, 0); PG8_LDB(B1, 1, 1); PG8_SCHED; PG8_LDA(At, 1, 0); PG8_STAGEA(PG8_SA(0, 1), a2, q10, q11);
            PG8_WAIT_V(8); PG8_WAIT_L(0); PG8_BAR; PG8_MMA(0, 0, At, B0); PG8_MMA(0, 1, At, B1); PG8_BAR; PG8_SCHED;
            PG8_LDA(At, 1, 1); PG8_STAGEB(PG8_SB(1, 0), b3); PG8_STAGEB(PG8_SB(1, 1), b3 + hstepB); PG8_STAGEA(PG8_SA(1, 0), a3, q00, q01);
            PG8_WAIT_V(8); PG8_WAIT_L(0); PG8_BAR; PG8_MMA(1, 0, At, B0); PG8_MMA(1, 1, At, B1); PG8_BAR; PG8_SCHED;
        }
        if (wr == 0) PG8_BAR;
        E(acc, cur, wr, wc, fr, fq);
        if (!has_next) break;
#pragma unroll
        for (int a = 0; a < 2; ++a)
#pragma unroll
            for (int b = 0; b < 2; ++b)
#pragma unroll
                for (int m = 0; m < 4; ++m)
#pragma unroll
                    for (int n = 0; n < 2; ++n) acc[a][b][m][n] = (f32x4){0.f, 0.f, 0.f, 0.f};
        cur = nxt; cA = nA; cB = nB; ++ui;
#pragma unroll
        for (int h = 0; h < 2; ++h)
#pragma unroll
            for (int i = 0; i < 2; ++i) offC[h][i] = offN[h][i];
        if (wr == 1) PG8_BAR;
    }
    PG8_WAIT_V(0);
    PG8_BAR;
#undef PG8_SETOFF
#undef PG8_SA
#undef PG8_SB
#undef PG8_STAGEA
#undef PG8_STAGEB
#undef PG8_LDA
#undef PG8_LDB
#undef PG8_MMA
#undef PG8_WAIT_V
#undef PG8_WAIT_L
#undef PG8_BAR
#undef PG8_SCHED
}
}

#define XB_TMO      128
#define XB_XCNT(j)  (256  + 64 * (j))
#define XB_XSUB(j)  (1280 + 64 * (j))
#define XB_XGEN(j)  (2304 + 64 * (j))
#define XB_TOP      3328
#define XB_TOPGEN   3392
#define XCD_BAR_WORDS 3456
#define XB_SPIN_CAP (1u << 18)
__device__ __forceinline__ unsigned xb_ld(unsigned* p)              { return __hip_atomic_load(p, __ATOMIC_RELAXED, __HIP_MEMORY_SCOPE_AGENT); }
__device__ __forceinline__ unsigned xb_add(unsigned* p, unsigned v) { return __hip_atomic_fetch_add(p, v, __ATOMIC_RELAXED, __HIP_MEMORY_SCOPE_AGENT); }
__device__ __forceinline__ unsigned xb_xcc_id() { return (unsigned)__builtin_amdgcn_s_getreg((3 << 11) | 20) & 0xFu; }
#define XB_SPIN(cond, bar) do { unsigned _sp = 0; while (cond) { __builtin_amdgcn_s_sleep(1); \
    if ((++_sp & 255u) == 0u) { if (xb_ld(&(bar)[XB_TMO])) break; if (_sp > XB_SPIN_CAP) { atomicAdd(&(bar)[XB_TMO], 1u); break; } } } } while (0)
struct XcdBarrier { unsigned* bar; unsigned x; volatile LAS unsigned* st; };
__device__ __forceinline__ XcdBarrier xcd_barrier_post(unsigned* bar, volatile LAS unsigned* st) {
    XcdBarrier b; b.bar = bar; b.x = xb_xcc_id(); b.st = st;
    if (threadIdx.x == 0) (void)xb_add(&bar[XB_XCNT(b.x)], 1u);
    return b;
}
__device__ __forceinline__ void xcd_barrier_complete(unsigned* bar, unsigned x, unsigned& nloc, unsigned& nx) {
    const unsigned G = gridDim.x * gridDim.y * gridDim.z;
    unsigned sum, cnt, mine, sp = 0u;
    for (;;) {
        sum = 0u; cnt = 0u; mine = 0u;
#pragma unroll
        for (unsigned j = 0; j < 16; ++j) { const unsigned c = xb_ld(&bar[XB_XCNT(j)]); sum += c; cnt += (c > 0u) ? 1u : 0u; mine = (j == x) ? c : mine; }
        if (sum == G) break;
        __builtin_amdgcn_s_sleep(1);
        if ((++sp & 255u) == 0u) { if (xb_ld(&bar[XB_TMO])) break; if (sp > XB_SPIN_CAP) { atomicAdd(&bar[XB_TMO], 1u); break; } }
    }
    nloc = mine > 0u ? mine : 1u; nx = cnt > 0u ? cnt : 1u;
}
__device__ __forceinline__ void xcd_barrier(const XcdBarrier& b) {
    asm volatile("s_waitcnt vmcnt(0)" ::: "memory");
    __syncthreads();
    if (threadIdx.x == 0) {
        unsigned* bar = b.bar;
        __builtin_amdgcn_s_waitcnt(0);
        unsigned nloc = b.st[0], nx = b.st[1];
        if (nloc == 0u) { xcd_barrier_complete(bar, b.x, nloc, nx); b.st[0] = nloc; b.st[1] = nx; }
        const unsigned old = xb_add(&bar[XB_XSUB(b.x)], 1u);
        const unsigned gen = old / nloc;
        if (old + 1u == (gen + 1u) * nloc) {
            __builtin_amdgcn_fence(__ATOMIC_RELEASE, "agent");
            asm volatile("s_waitcnt vmcnt(0)" ::: "memory");
            const unsigned og = xb_add(&bar[XB_TOP], 1u);
            const unsigned tg = og / nx;
            if (og + 1u == (tg + 1u) * nx) xb_add(&bar[XB_TOPGEN], 1u);
            else XB_SPIN(xb_ld(&bar[XB_TOPGEN]) == tg, bar);
            __builtin_amdgcn_fence(__ATOMIC_ACQUIRE, "agent");
            xb_add(&bar[XB_XGEN(b.x)], 1u);
            asm volatile("s_waitcnt vmcnt(0)" ::: "memory");
        } else {
            XB_SPIN(xb_ld(&bar[XB_XGEN(b.x)]) == gen, bar);
            __builtin_amdgcn_fence(__ATOMIC_ACQUIRE, "agent");
            asm volatile("s_waitcnt vmcnt(0)" ::: "memory");
        }
    }
    __syncthreads();
}

struct Args { const float* in[38]; float* out; unsigned char* ws; int ph_lo, ph_hi, li, pad; };
struct Frame {
    LAS unsigned char* lds;
    int tid, lane, wave, G, gw, NGW;
    long gt, NGT;
};
enum { I_X = 0, I_META, I_NORM_MIX0, I_WIN0, I_CONVW, I_CONVB, I_GAW, I_GAB, I_GXW, I_GXB, I_LAM, I_LRE, I_LIM, I_LDT, I_BRE, I_BIM, I_CRE, I_CIM, I_SD, I_GLUW, I_GLUB, I_WOUT0, I_NORM_FFN0,
       I_FG, I_FU, I_FD, I_NORM_MIX1, I_WIN1, I_GW2, I_GB, I_GNORM, I_WOUT1, I_NORM_FFN1, I_ROUTER, I_MG, I_MU, I_MD, I_FNORM };

struct SchedStatic {
    int nM, nN, G, c; const char* A; const char* B; size_t aStep, bStep; int aColDiv; size_t aColStep;
    __device__ __forceinline__ bool next(int i, pg8::Unit& u) const {
        int pm, pn; if (!pg8::static_tile(i, G, c, nM, nN, pm, pn)) return false;
        u.pm = pm; u.pn = pn; u.slot = i; u.a = A + (size_t)pm * aStep + (aColDiv ? (size_t)(pn / aColDiv) * aColStep : 0); u.b = B + (size_t)pn * bStep; return true;
    }
};
struct SchedList {
    int n; const LAS int* meta; const char* A; const char* B; size_t aStep, bTile, bExpert;
    __device__ __forceinline__ bool next(int i, pg8::Unit& u) const {
        if (i >= n) return false;
        const int pm = meta[i * 4 + 0], pn = meta[i * 4 + 1], e = meta[i * 4 + 2];
        u.pm = pm; u.pn = pn; u.slot = i; u.a = A + (size_t)pm * aStep; u.b = B + (size_t)e * bExpert + (size_t)pn * bTile; return true;
    }
};

#define EPI_ROWS(ai, m) ((ai) * 128 + wr * 64 + (m) * 16 + fr)
#define EPI_COLP(bj) ((bj) * 128 + wc * 32 + 8 * fq)
#define EPI_COLN(bj, n) ((bj) * 128 + wc * 32 + 16 * (n) + 4 * fq)
typedef const f32x4 (&AccRef)[2][2][4][2];
__device__ __forceinline__ v4u pack8(f32x4 a, f32x4 b) { v4u w; w.x = pg8::cvt_pk_bf16(a[0], a[1]); w.y = pg8::cvt_pk_bf16(a[2], a[3]); w.z = pg8::cvt_pk_bf16(b[0], b[1]); w.w = pg8::cvt_pk_bf16(b[2], b[3]); return w; }

struct EpiWin0 {
    static constexpr bool PERM = true; bf16 *G, *XR, *U;
    __device__ __forceinline__ void operator()(AccRef acc, const pg8::Unit& u, int wr, int wc, int fr, int fq) const {
        const int pn = u.pn; bf16* base; int ld, c0;
        if (pn < 4) { base = G; ld = 1024; c0 = pn * 256; } else if (pn < 8) { base = XR; ld = 1024; c0 = (pn - 4) * 256; } else { base = U; ld = 512; c0 = (pn - 8) * 256; }
#pragma unroll
        for (int ai = 0; ai < 2; ++ai)
#pragma unroll
            for (int m = 0; m < 4; ++m) { bf16* rowp = base + (size_t)(u.pm * 256 + EPI_ROWS(ai, m)) * ld + c0;
#pragma unroll
                for (int bj = 0; bj < 2; ++bj) { f32x4 v0 = acc[ai][bj][m][0], v1 = acc[ai][bj][m][1];
                    if (pn < 4) {
#pragma unroll
                        for (int j = 0; j < 4; ++j) { v0[j] = gelu_tanh(v0[j]); v1[j] = gelu_tanh(v1[j]); } }
                    *(v4u*)(rowp + EPI_COLP(bj)) = pack8(v0, v1); } }
    }
};
struct EpiGates {
    static constexpr bool PERM = true; const float *gab, *gxb, *sp8; const bf16* XC; float* A; bf16* BX;
    __device__ __forceinline__ void operator()(AccRef acc, const pg8::Unit& u, int wr, int wc, int fr, int fq) const {
        const int ch0 = (u.pn >> 1) * 256 + (u.pn & 1) * 128 + wc * 32 + 8 * fq;
        f32x4 ba[2], bx[2], sp[2];
#pragma unroll
        for (int n = 0; n < 2; ++n) { ba[n] = *(const f32x4*)(gab + ch0 + 4 * n); bx[n] = *(const f32x4*)(gxb + ch0 + 4 * n); sp[n] = *(const f32x4*)(sp8 + ch0 + 4 * n); }
#pragma unroll
        for (int ai = 0; ai < 2; ++ai)
#pragma unroll
            for (int m = 0; m < 4; ++m) { const size_t ro = (size_t)(u.pm * 256 + EPI_ROWS(ai, m)) * 1024 + ch0;
                const v4u xw = *(const v4u*)(XC + ro); const float xv[8] = {bflo(xw.x), bfhi(xw.x), bflo(xw.y), bfhi(xw.y), bflo(xw.z), bfhi(xw.z), bflo(xw.w), bfhi(xw.w)};
                f32x4 av[2], bv[2];
#pragma unroll
                for (int n = 0; n < 2; ++n)
#pragma unroll
                    for (int j = 0; j < 4; ++j) { const float r = sigmoidf_(acc[ai][0][m][n][j] + ba[n][j]), ig = sigmoidf_(acc[ai][1][m][n][j] + bx[n][j]);
                        const float la = -r * sp[n][j]; av[n][j] = __expf(la); bv[n][j] = __builtin_amdgcn_sqrtf(fmaxf(one_minus_exp(2.0f * la), 0.0f)) * ig * xv[4 * n + j]; }
                *(f32x4*)(A + ro) = av[0]; *(f32x4*)(A + ro + 4) = av[1]; *(v4u*)(BX + ro) = pack8(bv[0], bv[1]); asm volatile("" ::: "memory"); }
    }
};
struct EpiGlu {
    static constexpr bool PERM = true; const float* glub; const bf16* GS; bf16* AOUT;
    __device__ __forceinline__ void operator()(AccRef acc, const pg8::Unit& u, int wr, int wc, int fr, int fq) const {
#pragma unroll
        for (int bj = 0; bj < 2; ++bj) { const int c = u.pn * 256 + EPI_COLP(bj); const f32x4 b0 = *(const f32x4*)(glub + c), b1 = *(const f32x4*)(glub + c + 4);
#pragma unroll
            for (int ai = 0; ai < 2; ++ai)
#pragma unroll
                for (int m = 0; m < 4; ++m) { const size_t row = (size_t)(u.pm * 256 + EPI_ROWS(ai, m));
                    const v4u gw = *(const v4u*)(GS + row * 512 + c); const float gv[8] = {bflo(gw.x), bfhi(gw.x), bflo(gw.y), bfhi(gw.y), bflo(gw.z), bfhi(gw.z), bflo(gw.w), bfhi(gw.w)};
                    f32x4 v0, v1;
#pragma unroll
                    for (int j = 0; j < 4; ++j) { v0[j] = gv[j] * sigmoidf_(acc[ai][bj][m][0][j] + b0[j]); v1[j] = gv[4 + j] * sigmoidf_(acc[ai][bj][m][1][j] + b1[j]); }
                    *(v4u*)(AOUT + row * 1536 + 1024 + c) = pack8(v0, v1); } }
    }
};
struct EpiResid {
    static constexpr bool PERM = false; const float* src; float* dst; float* hmeta;
    __device__ __forceinline__ void operator()(AccRef acc, const pg8::Unit& u, int wr, int wc, int fr, int fq) const {
        const bool meta = u.pm >= NPR; const float* s = meta ? hmeta : src + (size_t)u.pm * 256 * 1024; float* d = meta ? hmeta : dst + (size_t)u.pm * 256 * 1024;
#pragma unroll
        for (int ai = 0; ai < 2; ++ai)
#pragma unroll
            for (int m = 0; m < 4; ++m) { const size_t ro = (size_t)EPI_ROWS(ai, m) * 1024 + u.pn * 256;
#pragma unroll
                for (int bj = 0; bj < 2; ++bj)
#pragma unroll
                    for (int n = 0; n < 2; ++n) { const size_t o = ro + EPI_COLN(bj, n); *(f32x4*)(d + o) = *(const f32x4*)(s + o) + acc[ai][bj][m][n]; } }
    }
};
struct EpiSwiglu {
    static constexpr bool PERM = true; bf16* H; int ld;
    __device__ __forceinline__ void operator()(AccRef acc, const pg8::Unit& u, int wr, int wc, int fr, int fq) const {
        const int c = u.pn * 128 + wc * 32 + 8 * fq;
#pragma unroll
        for (int ai = 0; ai < 2; ++ai)
#pragma unroll
            for (int m = 0; m < 4; ++m) { f32x4 v0, v1;
#pragma unroll
                for (int j = 0; j < 4; ++j) { v0[j] = siluf_(acc[ai][0][m][0][j]) * acc[ai][1][m][0][j]; v1[j] = siluf_(acc[ai][0][m][1][j]) * acc[ai][1][m][1][j]; }
                *(v4u*)(H + (size_t)(u.pm * 256 + EPI_ROWS(ai, m)) * ld + c) = pack8(v0, v1); }
    }
};
struct EpiWin1 {
    static constexpr bool PERM = true; bf16 *Q, *K, *V, *GATE; float* LG; const float* gb;
    __device__ __forceinline__ void operator()(AccRef acc, const pg8::Unit& u, int wr, int wc, int fr, int fq) const {
        const int pn = u.pn;
#pragma unroll
        for (int ai = 0; ai < 2; ++ai)
#pragma unroll
            for (int m = 0; m < 4; ++m) { const size_t row = (size_t)(u.pm * 256 + EPI_ROWS(ai, m));
#pragma unroll
                for (int bj = 0; bj < 2; ++bj) { f32x4 v0 = acc[ai][bj][m][0], v1 = acc[ai][bj][m][1]; const int cc = EPI_COLP(bj);
                    if (pn < 2) { v0 = v0 * 0.08838834764831845f; v1 = v1 * 0.08838834764831845f; *(v4u*)(Q + row * 512 + pn * 256 + cc) = pack8(v0, v1); }
                    else if (pn < 4) { *(v4u*)(K + row * 512 + (pn - 2) * 256 + cc) = pack8(v0, v1); }
                    else if (pn < 8) { *(v4u*)(V + row * 1024 + (pn - 4) * 256 + cc) = pack8(v0, v1); }
                    else if (pn < 12) {
#pragma unroll
                        for (int j = 0; j < 4; ++j) { v0[j] = siluf_(v0[j]); v1[j] = siluf_(v1[j]); }
                        *(v4u*)(GATE + row * 1024 + (pn - 8) * 256 + cc) = pack8(v0, v1); }
                    else { const int c = (pn - 12) * 256 + cc; const f32x4 b0 = *(const f32x4*)(gb + c), b1 = *(const f32x4*)(gb + c + 4);
#pragma unroll
                        for (int j = 0; j < 4; ++j) { v0[j] = logsigmoidf_(v0[j] + b0[j]) * 0.0625f; v1[j] = logsigmoidf_(v1[j] + b1[j]) * 0.0625f; }
                        *(f32x4*)(LG + row * 512 + c) = v0; *(f32x4*)(LG + row * 512 + c + 4) = v1; } } }
    }
};
struct EpiMoeDown {
    static constexpr bool PERM = false; float* out; const LAS int* toks; const LAS float* wts;
    __device__ __forceinline__ void operator()(AccRef acc, const pg8::Unit& u, int wr, int wc, int fr, int fq) const {
#pragma unroll
        for (int ai = 0; ai < 2; ++ai)
#pragma unroll
            for (int m = 0; m < 4; ++m) { const int rl = u.slot * 256 + EPI_ROWS(ai, m); const int tok = toks[rl]; const float w = wts[rl];
                if (tok >= 0) { float* d = out + (size_t)tok * 1024 + u.pn * 256;
#pragma unroll
                    for (int bj = 0; bj < 2; ++bj)
#pragma unroll
                        for (int n = 0; n < 2; ++n) { float* p = d + EPI_COLN(bj, n); *(f32x4*)p = *(const f32x4*)p + acc[ai][bj][m][n] * w; } } }
    }
};

__device__ __forceinline__ void tr_item(const float* W, int ldw, int col, int k0, bf16* WT, int ldt, int drow, LAS float* scr, int lane) {
#pragma unroll 8
    for (int i = 0; i < 32; ++i) { const int kk = 2 * i + (lane >> 5); scr[kk * 33 + (lane & 31)] = W[(size_t)(k0 + kk) * ldw + col + (lane & 31)]; }
    LDS_WAIT(); asm volatile("" ::: "memory");
    const int c = lane & 7;
#pragma unroll
    for (int j = 0; j < 4; ++j) { const int n = (lane >> 3) + 8 * j; const LAS float* s = scr + (8 * c) * 33 + n;
        v4u o; o.x = pk2(s[0 * 33], s[1 * 33]); o.y = pk2(s[2 * 33], s[3 * 33]); o.z = pk2(s[4 * 33], s[5 * 33]); o.w = pk2(s[6 * 33], s[7 * 33]);
        *(v4u*)(WT + (size_t)(drow + n) * ldt + k0 + 8 * c) = o; }
    LDS_WAIT(); asm volatile("" ::: "memory");
}
struct TrJob { const float* W; int ldw, col0, K, N; bf16* WT; int blk, bstride, add; };
__device__ __forceinline__ bool tr_try(int& r, const TrJob& j, LAS float* scr, int lane) {
    const int nblk = j.N / 32, items = (j.K / 64) * nblk;
    if (r >= items) { r -= items; return false; }
    const int kb = r / nblk, n0 = (r % nblk) * 32;
    tr_item(j.W, j.ldw, j.col0 + n0, kb * 64, j.WT, j.K, (n0 / j.blk) * j.bstride + (n0 % j.blk) + j.add, scr, lane);
    return true;
}
__device__ __forceinline__ void norm_row_bf16(const float* xrow, const float* gain, bf16* orow, int lane) {
    const f32x4* xr = (const f32x4*)xrow + lane; const f32x4* gr = (const f32x4*)gain + lane;
    f32x4 v[4]; float s = 0.f;
#pragma unroll
    for (int j = 0; j < 4; ++j) { v[j] = xr[64 * j]; s += (v[j].x * v[j].x + v[j].y * v[j].y) + (v[j].z * v[j].z + v[j].w * v[j].w); }
    const float rstd = 1.0f / sqrtf(wave_sum(s) * (1.0f / 1024.0f) + EPS);
    v2u* o8 = (v2u*)orow + lane;
#pragma unroll
    for (int j = 0; j < 4; ++j) { const f32x4 g = gr[64 * j]; v2u w; w.x = pk2(v[j].x * rstd * g.x, v[j].y * rstd * g.y); w.y = pk2(v[j].z * rstd * g.z, v[j].w * rstd * g.w); o8[64 * j] = w; }
}
__device__ __forceinline__ const float* hrow_c(const float* out, const float* hmeta, int r) { return r < TR ? out + (size_t)r * 1024 : hmeta + (size_t)(r - TR) * 1024; }

__device__ __forceinline__ void p0_prologue(const Frame& F, const Args& a, unsigned char* ws) {
    LAS float* scr = (LAS float*)(F.lds + RING_OFF + F.wave * 16384);
    const float* const* in = a.in;
    constexpr int BIG = 1 << 30;
    for (int it = F.gw; ; it += F.NGW) {
        int r = it;
        { TrJob j{in[I_WIN0], EV_IN, 0, 1024, EV_IN, (bf16*)(ws + WS_WIN0), BIG, 0, 0}; if (tr_try(r, j, scr, F.lane)) continue; }
        bool done = false;
        for (int h = 0; h < 4 && !done; ++h) {
            { TrJob j{in[I_GAW] + (size_t)h * 65536, 256, 0, 256, 256, (bf16*)(ws + WS_GW) + (size_t)h * 512 * 256, 128, 256, 0}; if (tr_try(r, j, scr, F.lane)) { done = true; break; } }
            { TrJob j{in[I_GXW] + (size_t)h * 65536, 256, 0, 256, 256, (bf16*)(ws + WS_GW) + (size_t)h * 512 * 256, 128, 256, 128}; if (tr_try(r, j, scr, F.lane)) { done = true; break; } }
        }
        if (done) continue;
        { TrJob j{in[I_GLUW], 512, 0, 512, 512, (bf16*)(ws + WS_GLUW), BIG, 0, 0}; if (tr_try(r, j, scr, F.lane)) continue; }
        { TrJob j{in[I_WOUT0], 1024, 0, EV_MIX, 1024, (bf16*)(ws + WS_WOUT0), BIG, 0, 0}; if (tr_try(r, j, scr, F.lane)) continue; }
        { TrJob j{in[I_FG], FF0, 0, 1024, FF0, (bf16*)(ws + WS_WUP0), 128, 256, 0}; if (tr_try(r, j, scr, F.lane)) continue; }
        { TrJob j{in[I_FU], FF0, 0, 1024, FF0, (bf16*)(ws + WS_WUP0), 128, 256, 128}; if (tr_try(r, j, scr, F.lane)) continue; }
        { TrJob j{in[I_FD], 1024, 0, FF0, 1024, (bf16*)(ws + WS_WDN0), BIG, 0, 0}; if (tr_try(r, j, scr, F.lane)) continue; }
        { TrJob j{in[I_WIN1], OD_IN, 0, 1024, 3072, (bf16*)(ws + WS_WIN1), BIG, 0, 0}; if (tr_try(r, j, scr, F.lane)) continue; }
        { TrJob j{in[I_WOUT1], 1024, 0, 1024, 1024, (bf16*)(ws + WS_WOUT1), BIG, 0, 0}; if (tr_try(r, j, scr, F.lane)) continue; }
        break;
    }
    for (long i = F.gt; i < 512L * 1024; i += F.NGT) { const int j = (int)(i >> 10), k = (int)(i & 1023); const float* wr_ = in[I_WIN1] + (size_t)k * OD_IN + 3072; const float* w2 = in[I_GW2] + j; float s = 0.f;
#pragma unroll
        for (int r = 0; r < 16; ++r) s += wr_[r] * w2[r * 512];
        ((bf16*)(ws + WS_WIN1))[(size_t)(3072 + j) * 1024 + k] = (bf16)f2bf(s); }
    float* tab = (float*)(ws + WS_TAB);
    for (long i = F.gt; i < NG * NS; i += F.NGT) { const int g = (int)i / NS;
        const double lr = in[I_LRE][i], li = in[I_LIM][i], dt = exp((double)in[I_LDT][g]);
        const double mag = exp(dt * lr), ar = mag * cos(dt * li), ai = mag * sin(dt * li), den = lr * lr + li * li, nr = ar - 1.0;
        const double zr = (nr * lr + ai * li) / den, zi = (ai * lr - nr * li) / den;
        const double m64 = exp(64.0 * dt * lr);
        ((float*)((char*)tab + TB_AR))[i] = (float)ar; ((float*)((char*)tab + TB_AI))[i] = (float)ai;
        ((float*)((char*)tab + TB_AR64))[i] = (float)(m64 * cos(64.0 * dt * li)); ((float*)((char*)tab + TB_AI64))[i] = (float)(m64 * sin(64.0 * dt * li));
        for (int h = 0; h < 16; ++h) { const double br = in[I_BRE][i * 16 + h], bi = in[I_BIM][i * 16 + h];
            ((float*)((char*)tab + TB_BBR))[i * 16 + h] = (float)(zr * br - zi * bi); ((float*)((char*)tab + TB_BBI))[i * 16 + h] = (float)(zr * bi + zi * br); } }
    for (long i = F.gt; i < 1024; i += F.NGT) { const float lam = in[I_LAM][i]; ((float*)((char*)tab + TB_SP8))[i] = 8.0f * log1pf(expf(-lam)); }
    bf16* HN = (bf16*)(ws + WS_HN); float* hmeta = (float*)(ws + WS_HMETA);
    for (int m = F.gw; m < TR + NMETA; m += F.NGW) { const float* src = m < TR ? in[I_X] + (size_t)m * 1024 : in[I_META] + (size_t)(m - TR) * 1024; norm_row_bf16(src, in[I_NORM_MIX0], HN + (size_t)m * 1024, F.lane); }
    for (long i = F.gt; i < NMETA * 1024; i += F.NGT) hmeta[i] = in[I_META][i];
}
__device__ __forceinline__ void norm_phase(const Frame& F, const float* out, const float* hmeta, const float* gain, bf16* HN, int nrows) {
    for (int m = F.gw; m < nrows; m += F.NGW) norm_row_bf16(hrow_c(out, hmeta, m), gain, HN + (size_t)m * 1024, F.lane);
}
__device__ __forceinline__ int seq_prev(int row, int back) {
    if (row >= TR) { const int i = row - TR - back; return i >= 0 ? TR + i : -1; }
    const int t = row & (SEQ - 1); return t >= back ? row - back : TR + NMETA + (t - back);
}
__device__ __forceinline__ void conv_phase(const Frame& F, const bf16* XR, const float* cw, const float* cb, bf16* XC) {
    for (long i = F.gt; i < (long)(TR + NMETA) * 128; i += F.NGT) { const int row = (int)(i >> 7), c = (int)(i & 127) * 8;
        float acc[8];
#pragma unroll
        for (int j = 0; j < 8; ++j) acc[j] = cb[c + j];
#pragma unroll
        for (int k = 0; k < 4; ++k) { const int src = seq_prev(row, 3 - k); if (src < 0) continue;
            const v4u w = *(const v4u*)(XR + (size_t)src * 1024 + c); const float xv[8] = {bflo(w.x), bfhi(w.x), bflo(w.y), bfhi(w.y), bflo(w.z), bfhi(w.z), bflo(w.w), bfhi(w.w)};
            const f32x4 w0 = *(const f32x4*)(cw + k * 1024 + c), w1 = *(const f32x4*)(cw + k * 1024 + c + 4);
#pragma unroll
            for (int j = 0; j < 4; ++j) { acc[j] += w0[j] * xv[j]; acc[4 + j] += w1[j] * xv[4 + j]; } }
        v4u o; o.x = pk2(acc[0], acc[1]); o.y = pk2(acc[2], acc[3]); o.z = pk2(acc[4], acc[5]); o.w = pk2(acc[6], acc[7]);
        *(v4u*)(XC + (size_t)row * 1024 + c) = o; }
}
constexpr int SSM_HP = 68;
constexpr int SSM_WLDS = 2048 + 16 * SSM_HP * 4;
template <bool FINAL>
__device__ __forceinline__ void ssm_wave(const unsigned char* ws, const float* cre, const float* cim, const float* sd, const bf16* U, bf16* GS, int g, int row0, int ntok, float& hr, float& hi, int lane, LAS unsigned char* wl) {
    LAS v4u* ub = (LAS v4u*)wl; LAS unsigned* hb = (LAS unsigned*)(wl + 2048);
    const float* tab = (const float*)(ws + WS_TAB); const int gn = g * NS + lane, fr = lane & 15, fq = lane >> 4;
    const float ar = ((const float*)((const char*)tab + TB_AR))[gn], ai = ((const float*)((const char*)tab + TB_AI))[gn];
    float bbr[16], bbi[16];
#pragma unroll
    for (int q = 0; q < 4; ++q) { const f32x4 a = ((const f32x4*)((const char*)tab + TB_BBR))[gn * 4 + q], b = ((const f32x4*)((const char*)tab + TB_BBI))[gn * 4 + q];
#pragma unroll
        for (int j = 0; j < 4; ++j) { bbr[4 * q + j] = a[j]; bbi[4 * q + j] = b[j]; } }
    bf16x8 ca[4]; f32x4 dv = {0.f, 0.f, 0.f, 0.f};
    if (FINAL) {
#pragma unroll
        for (int ks = 0; ks < 4; ++ks) { const int n0 = 16 * ks + 4 * fq; const f32x4 cr = *(const f32x4*)(cre + (g * 16 + fr) * NS + n0), ci = *(const f32x4*)(cim + (g * 16 + fr) * NS + n0);
            v4u w; w.x = pk2(cr[0], -ci[0]); w.y = pk2(cr[1], -ci[1]); w.z = pk2(cr[2], -ci[2]); w.w = pk2(cr[3], -ci[3]); ca[ks] = __builtin_bit_cast(bf16x8, w); }
        dv = *(const f32x4*)(sd + g * 16 + 4 * fq); }
    if (lane < ntok) { const bf16* up = U + (size_t)(row0 + lane) * 512 + g * 16; ub[lane * 2] = *(const v4u*)up; ub[lane * 2 + 1] = *(const v4u*)(up + 8); }
    LDS_WAIT(); asm volatile("" ::: "memory");
    for (int t0 = 0; t0 < ntok; t0 += 16) {
#pragma unroll 4
        for (int tl = 0; tl < 16; ++tl) { const int t = t0 + tl;
            const v4u w0 = ub[t * 2], w1 = ub[t * 2 + 1];
            const float u[16] = {bflo(w0.x), bfhi(w0.x), bflo(w0.y), bfhi(w0.y), bflo(w0.z), bfhi(w0.z), bflo(w0.w), bfhi(w0.w), bflo(w1.x), bfhi(w1.x), bflo(w1.y), bfhi(w1.y), bflo(w1.z), bfhi(w1.z), bflo(w1.w), bfhi(w1.w)};
            float xr = 0.f, xi = 0.f;
#pragma unroll
            for (int h = 0; h < 16; ++h) { xr += bbr[h] * u[h]; xi += bbi[h] * u[h]; }
            const float nr = ar * hr - ai * hi + xr, ni = ar * hi + ai * hr + xi; hr = nr; hi = ni;
            if (FINAL) hb[tl * SSM_HP + lane] = pk2(hr, hi); }
        if (FINAL) {
            asm volatile("" ::: "memory");
            f32x4 y = {0.f, 0.f, 0.f, 0.f};
#pragma unroll
            for (int ks = 0; ks < 4; ++ks) { const bf16x8 hbf = *(const LAS bf16x8*)(hb + fr * SSM_HP + 16 * ks + 4 * fq); y = __builtin_amdgcn_mfma_f32_16x16x32_bf16(ca[ks], hbf, y, 0, 0, 0); }
            const v2u uw = *(const LAS v2u*)((const LAS unsigned char*)ub + (t0 + fr) * 32 + fq * 8);
            const float o0 = gelu_tanh(y[0] + dv[0] * bflo(uw.x)), o1 = gelu_tanh(y[1] + dv[1] * bfhi(uw.x)), o2 = gelu_tanh(y[2] + dv[2] * bflo(uw.y)), o3 = gelu_tanh(y[3] + dv[3] * bfhi(uw.y));
            v2u ow; ow.x = pk2(o0, o1); ow.y = pk2(o2, o3);
            *(v2u*)(GS + (size_t)(row0 + t0 + fr) * 512 + g * 16 + 4 * fq) = ow;
            asm volatile("" ::: "memory"); }
    }
    LDS_WAIT(); asm volatile("" ::: "memory");
}
__device__ __forceinline__ void ssm_l1_phase(const Frame& F, const unsigned char* ws, const bf16* U, float* SSE) {
    for (int it = F.gw; it < NB * NCH * NG; it += F.NGW) { const int g = it % NG, bc = it / NG;
        float hr = 0.f, hi = 0.f; ssm_wave<false>(ws, nullptr, nullptr, nullptr, U, nullptr, g, bc * 64, 64, hr, hi, F.lane, F.lds + RING_OFF + F.wave * SSM_WLDS);
        ((f32x2*)SSE)[(size_t)it * NS + F.lane] = (f32x2){hr, hi}; }
}
__device__ __forceinline__ void lru_l1_phase(const Frame& F, const float* A, const bf16* BX, float* PEND, float* HEND) {
    for (long i = F.gt; i < (long)NB * NCH * 512; i += F.NGT) { const int ch = (int)(i & 511) * 2, bc = (int)(i >> 9); const size_t r0 = (size_t)bc * 64;
        f32x2 P = {1.f, 1.f}, H = {0.f, 0.f};
        for (int t0 = 0; t0 < 64; t0 += 8) { f32x2 a[8]; unsigned bx[8];
#pragma unroll
            for (int t = 0; t < 8; ++t) { a[t] = *(const f32x2*)(A + (r0 + t0 + t) * 1024 + ch); bx[t] = *(const unsigned*)(BX + (r0 + t0 + t) * 1024 + ch); }
#pragma unroll
            for (int t = 0; t < 8; ++t) { P = P * a[t]; H = a[t] * H + (f32x2){bflo(bx[t]), bfhi(bx[t])}; } }
        *(f32x2*)(PEND + (size_t)bc * 1024 + ch) = P; *(f32x2*)(HEND + (size_t)bc * 1024 + ch) = H; }
}
__device__ __forceinline__ void carry_phase(const Frame& F, const unsigned char* ws, const float* A, const bf16* BX, const float* PEND, const float* HEND, float* CIN, const bf16* U, const float* SSE, float* SSIN) {
    if (F.gt < NB * 1024) { const int ch = (int)F.gt & 1023, b = (int)F.gt >> 10; float H = 0.f;
        for (int i = 0; i < NMETA; ++i) { const size_t r = (size_t)(RM0 + i); H = A[r * 1024 + ch] * H + bf2f(BX[r * 1024 + ch]); }
#pragma unroll 8
        for (int c = 0; c < NCH; ++c) { const size_t o = ((size_t)b * NCH + c) * 1024 + ch; const float p = PEND[o], he = HEND[o]; CIN[o] = H; H = he + p * H; }
    } else if (F.gt >= 8 * 512 && F.gt < 8 * 512 + NB * NG * NS) { const int id = (int)F.gt - 8 * 512, n = id % NS, g = (id / NS) % NG, b = id / (NS * NG), gn = g * NS + n;
        const float* tab = (const float*)(ws + WS_TAB);
        const float ar = ((const float*)((const char*)tab + TB_AR))[gn], ai = ((const float*)((const char*)tab + TB_AI))[gn], ar64 = ((const float*)((const char*)tab + TB_AR64))[gn], ai64 = ((const float*)((const char*)tab + TB_AI64))[gn];
        float hr = 0.f, hi = 0.f;
        for (int i = 0; i < NMETA; ++i) { float xr = 0.f, xi = 0.f;
            for (int h = 0; h < 16; ++h) { const float u = bf2f(U[(size_t)(RM0 + i) * 512 + g * 16 + h]); xr += ((const float*)((const char*)tab + TB_BBR))[gn * 16 + h] * u; xi += ((const float*)((const char*)tab + TB_BBI))[gn * 16 + h] * u; }
            const float nr = ar * hr - ai * hi + xr, ni = ar * hi + ai * hr + xi; hr = nr; hi = ni; }
#pragma unroll 8
        for (int c = 0; c < NCH; ++c) { const size_t o = (((size_t)b * NCH + c) * NG + g) * NS + n; const f32x2 e = ((const f32x2*)SSE)[o]; ((f32x2*)SSIN)[o] = (f32x2){hr, hi};
            const float nr = ar64 * hr - ai64 * hi + e.x, ni = ar64 * hi + ai64 * hr + e.y; hr = nr; hi = ni; }
    }
}
__device__ __forceinline__ void mix0_final_phase(const Frame& F, const unsigned char* ws, const float* A, const bf16* BX, const float* CIN, const bf16* G, bf16* AOUT, const float* cre, const float* cim, const float* sd, const bf16* U, const float* SSIN, bf16* GS) {
    for (long i = F.gt; i < (long)NB * NCH * 512 + 512; i += F.NGT) { const int ch = (int)(i & 511) * 2, bc = (int)(i >> 9); const bool meta = bc >= NB * NCH;
        const size_t r0 = meta ? (size_t)RM0 : (size_t)bc * 64; const int nt = meta ? NMETA : 64; f32x2 H = {0.f, 0.f}; if (!meta) H = *(const f32x2*)(CIN + (size_t)bc * 1024 + ch);
        for (int t0 = 0; t0 < nt; t0 += 8) { f32x2 a[8]; unsigned bx[8], gg[8];
#pragma unroll
            for (int t = 0; t < 8; ++t) { const size_t r = r0 + t0 + t; a[t] = *(const f32x2*)(A + r * 1024 + ch); bx[t] = *(const unsigned*)(BX + r * 1024 + ch); gg[t] = *(const unsigned*)(G + r * 1024 + ch); }
#pragma unroll
            for (int t = 0; t < 8; ++t) { H = a[t] * H + (f32x2){bflo(bx[t]), bfhi(bx[t])}; *(unsigned*)(AOUT + (r0 + t0 + t) * 1536 + ch) = pk2(bflo(gg[t]) * H.x, bfhi(gg[t]) * H.y); } } }
    for (int it = F.gw; it < NB * NCH * NG + NG; it += F.NGW) { const bool meta = it >= NB * NCH * NG; const int g = it % NG, bc = it / NG;
        float hr = 0.f, hi = 0.f; if (!meta) { const f32x2 s = ((const f32x2*)SSIN)[(size_t)it * NS + F.lane]; hr = s.x; hi = s.y; }
        ssm_wave<true>(ws, cre, cim, sd, U, GS, g, meta ? RM0 : bc * 64, meta ? NMETA : 64, hr, hi, F.lane, F.lds + RING_OFF + F.wave * SSM_WLDS); }
}


template <int NACC>
__device__ __forceinline__ void meta_tile(const Frame& F, const bf16* A16, int lda, int K, const bf16* const (&Brow)[NACC], int ldb, f32x4 (&out)[NACC]) {
    LAS f32x4* red = (LAS f32x4*)(F.lds + RING_OFF);
    const int lane = F.lane, fr = lane & 15, fq = lane >> 4, w = F.wave, ks = K / 8;
    f32x4 acc[NACC];
#pragma unroll
    for (int a = 0; a < NACC; ++a) acc[a] = (f32x4){0.f, 0.f, 0.f, 0.f};
    for (int k0 = w * ks; k0 < (w + 1) * ks; k0 += 32) {
        const bf16x8 af = *(const bf16x8*)(A16 + (size_t)fr * lda + k0 + 8 * fq);
#pragma unroll
        for (int a = 0; a < NACC; ++a) { const bf16x8 bfz = *(const bf16x8*)(Brow[a] + (size_t)fr * ldb + k0 + 8 * fq); acc[a] = __builtin_amdgcn_mfma_f32_16x16x32_bf16(bfz, af, acc[a], 0, 0, 0); } }
    __syncthreads();
#pragma unroll
    for (int a = 0; a < NACC; ++a) red[(w * NACC + a) * 64 + lane] = acc[a];
    __syncthreads();
#pragma unroll
    for (int a = 0; a < NACC; ++a) { f32x4 sacc = red[a * 64 + lane];
#pragma unroll
        for (int ww = 1; ww < 8; ++ww) sacc += red[(ww * NACC + a) * 64 + lane];
        out[a] = sacc; }
}
template <class Fn> __device__ __forceinline__ bf16x8 frag8(Fn f) { bf16x8 r;
#pragma unroll
    for (int j = 0; j < 8; ++j) r[j] = (short)f(j);
    return r; }
constexpr int GL_LB = 0, GL_QT = 32768, GL_KT = 50176, GL_KH = 67584, GL_VT = 86016, GL_GM = 120832, GL_BL = 121344, GL_SSQ = 121856;
constexpr int PQ = 136, PKH = 144, PV = 272, PATT = 72;
#define TR_FRAG(dst, base, off, rows4) do { v2u _lo, _hi; \
    asm volatile("ds_read_b64_tr_b16 %0, %2 offset:%c3\n\tds_read_b64_tr_b16 %1, %2 offset:%c4\n\ts_waitcnt lgkmcnt(0)" : "=&v"(_lo), "=&v"(_hi) : "v"(base), "i"(off), "i"((off) + (rows4)) : "memory"); \
    const v4u _w = {_lo.x, _lo.y, _hi.x, _hi.y}; dst = __builtin_bit_cast(bf16x8, _w); } while (0)
__device__ __forceinline__ unsigned lds_addr(const LAS void* p) { return (unsigned)(unsigned long)p; }
template <bool FINAL>
__device__ __forceinline__ void gla_item(const Frame& F, int b, int h, int s, const bf16* Q, const bf16* K, const bf16* V, const bf16* GATE, const float* LG, const float* gnorm, float* GDS, float* GAM, bf16* AOUT2) {
    LAS float* LB = (LAS float*)(F.lds + GL_LB); LAS bf16* ATT = (LAS bf16*)(F.lds + GL_LB);
    LAS bf16* QT = (LAS bf16*)(F.lds + GL_QT); LAS bf16* KT = (LAS bf16*)(F.lds + GL_KT); LAS bf16* KH = (LAS bf16*)(F.lds + GL_KH); LAS bf16* VT = (LAS bf16*)(F.lds + GL_VT);
    LAS float* GM = (LAS float*)(F.lds + GL_GM); LAS float* BL = (LAS float*)(F.lds + GL_BL); LAS float* SSQ = (LAS float*)(F.lds + GL_SSQ);
    const int tid = F.tid, w = F.wave, lane = F.lane, fr = lane & 15, h4 = lane >> 4, tq = fr >> 2, tp = fr & 3;
    const int bh = b * GH + h; const size_t sbase = ((size_t)(bh * NSEG + s) * 128) * 256;
    const unsigned vtr = lds_addr(VT) + (unsigned)((8 * h4 + tq) * PV + 32 * w + 4 * tp) * 2u;
    const unsigned ktr = lds_addr(KH) + (unsigned)((8 * h4 + tq) * PKH + 4 * tp) * 2u;
    f32x4 S[8][2];
#pragma unroll
    for (int kb = 0; kb < 8; ++kb)
#pragma unroll
        for (int vb = 0; vb < 2; ++vb)
#pragma unroll
            for (int r = 0; r < 4; ++r) S[kb][vb][r] = FINAL ? GDS[sbase + (size_t)(16 * kb + 4 * h4 + r) * 256 + 32 * w + 16 * vb + fr] : 0.f;
    float gsum = 0.f;
#pragma nounroll
    for (int c = 0; c < SEGC; ++c) {
        const size_t row0 = (size_t)b * SEQ + (size_t)(s * SEGC + c) * 64;
        int lz = 0; asm volatile("" : "+v"(lz));
        const int tidl = tid + lz, frl = fr + lz, h4l = h4 + lz;
#pragma unroll
        for (int j = 0; j < 4; ++j) { const int i = tidl + 512 * j, t = i >> 5, k4 = (i & 31) * 4; *(LAS f32x4*)(LB + t * 128 + k4) = *(const f32x4*)(LG + (row0 + t) * 512 + h * 128 + k4); }
        __syncthreads();
        if (tid < 128) { float run = 0.f;
#pragma unroll 8
            for (int t = 0; t < 64; ++t) { run += LB[t * 128 + tid]; LB[t * 128 + tid] = run; }
            BL[tid] = run; GM[tid] = __expf(run); gsum += run; }
        __syncthreads();
#pragma unroll
        for (int j = 0; j < 2; ++j) { const int i = tidl + 512 * j, t = i >> 4, k8 = (i & 15) * 8; const size_t go = (row0 + t) * 512 + h * 128 + k8;
            const v4u kw = *(const v4u*)(K + go); const float kv[8] = {bflo(kw.x), bfhi(kw.x), bflo(kw.y), bfhi(kw.y), bflo(kw.z), bfhi(kw.z), bflo(kw.w), bfhi(kw.w)};
            float bb[8], kh[8];
#pragma unroll
            for (int e = 0; e < 8; ++e) { bb[e] = LB[t * 128 + k8 + e]; kh[e] = kv[e] * __expf(BL[k8 + e] - bb[e]); }
            v4u o; o.x = pk2(kh[0], kh[1]); o.y = pk2(kh[2], kh[3]); o.z = pk2(kh[4], kh[5]); o.w = pk2(kh[6], kh[7]); *(LAS v4u*)(KH + t * PKH + k8) = o;
            if (FINAL) { const v4u qw = *(const v4u*)(Q + go); const float qv[8] = {bflo(qw.x), bfhi(qw.x), bflo(qw.y), bfhi(qw.y), bflo(qw.z), bfhi(qw.z), bflo(qw.w), bfhi(qw.w)};
                float qt[8], kt[8];
#pragma unroll
                for (int e = 0; e < 8; ++e) { qt[e] = qv[e] * __expf(bb[e]); kt[e] = kv[e] * __expf(-bb[e]); }
                v4u oq; oq.x = pk2(qt[0], qt[1]); oq.y = pk2(qt[2], qt[3]); oq.z = pk2(qt[4], qt[5]); oq.w = pk2(qt[6], qt[7]); *(LAS v4u*)(QT + t * PQ + k8) = oq;
                v4u ok; ok.x = pk2(kt[0], kt[1]); ok.y = pk2(kt[2], kt[3]); ok.z = pk2(kt[4], kt[5]); ok.w = pk2(kt[6], kt[7]); *(LAS v4u*)(KT + t * PQ + k8) = ok; } }
#pragma unroll
        for (int j = 0; j < 4; ++j) { const int i = tidl + 512 * j, t = i >> 5, c8 = (i & 31) * 8; *(LAS v4u*)(VT + t * PV + c8) = *(const v4u*)(V + (row0 + t) * 1024 + h * 256 + c8); }
        __syncthreads();
        f32x4 o[4][2];
        if (FINAL) {
            { const int tb = w >> 1;
#pragma unroll
              for (int q = 0; q < 2; ++q) { const int sb = 2 * (w & 1) + q; f32x4 acc = {0.f, 0.f, 0.f, 0.f};
                if (sb <= tb) {
#pragma unroll
                    for (int ks = 0; ks < 4; ++ks) { const bf16x8 a = *(const LAS bf16x8*)(QT + (16 * tb + fr) * PQ + 32 * ks + 8 * h4), bq = *(const LAS bf16x8*)(KT + (16 * sb + fr) * PQ + 32 * ks + 8 * h4);
                        acc = __builtin_amdgcn_mfma_f32_16x16x32_bf16(a, bq, acc, 0, 0, 0); } }
#pragma unroll
                for (int r = 0; r < 4; ++r) { const int tl = 4 * h4 + r; const float val = (sb < tb || (sb == tb && fr <= tl)) ? acc[r] : 0.f; ATT[(16 * tb + tl) * PATT + 16 * sb + fr] = (bf16)f2bf(val); } } }
            __syncthreads();
#pragma unroll
            for (int tb = 0; tb < 4; ++tb)
#pragma unroll
                for (int vb = 0; vb < 2; ++vb) o[tb][vb] = (f32x4){0.f, 0.f, 0.f, 0.f};
#pragma unroll
            for (int ss = 0; ss < 2; ++ss) { bf16x8 bv[2];
#pragma unroll
                for (int vb = 0; vb < 2; ++vb) TR_FRAG(bv[vb], vtr, (32 * ss * PV + 16 * vb) * 2, 4 * PV * 2);
#pragma unroll
                for (int tb = 0; tb < 4; ++tb) { if (ss == 1 && tb < 2) continue;
                    const bf16x8 a = *(const LAS bf16x8*)(ATT + (16 * tb + fr) * PATT + 32 * ss + 8 * h4);
#pragma unroll
                    for (int vb = 0; vb < 2; ++vb) o[tb][vb] = __builtin_amdgcn_mfma_f32_16x16x32_bf16(a, bv[vb], o[tb][vb], 0, 0, 0); } }
#pragma unroll
            for (int i = 0; i < 4; ++i) { bf16x8 bs[2];
#pragma unroll
                for (int vb = 0; vb < 2; ++vb) { v4u wv; wv.x = pk2(S[2 * i][vb][0], S[2 * i][vb][1]); wv.y = pk2(S[2 * i][vb][2], S[2 * i][vb][3]); wv.z = pk2(S[2 * i + 1][vb][0], S[2 * i + 1][vb][1]); wv.w = pk2(S[2 * i + 1][vb][2], S[2 * i + 1][vb][3]); bs[vb] = __builtin_bit_cast(bf16x8, wv); }
#pragma unroll
                for (int tb = 0; tb < 4; ++tb) { const LAS bf16* qp = QT + (16 * tb + fr) * PQ + 32 * i + 4 * h4; const v2u a_lo = *(const LAS v2u*)qp, a_hi = *(const LAS v2u*)(qp + 16);
                    const v4u aw = {a_lo.x, a_lo.y, a_hi.x, a_hi.y}; const bf16x8 a = __builtin_bit_cast(bf16x8, aw);
#pragma unroll
                    for (int vb = 0; vb < 2; ++vb) o[tb][vb] = __builtin_amdgcn_mfma_f32_16x16x32_bf16(a, bs[vb], o[tb][vb], 0, 0, 0); } }
        }
        if (FINAL) {
#pragma unroll
            for (int tb = 0; tb < 4; ++tb)
#pragma unroll
                for (int r = 0; r < 4; ++r) { float q = o[tb][0][r] * o[tb][0][r] + o[tb][1][r] * o[tb][1][r];
                    q += __shfl_xor(q, 1); q += __shfl_xor(q, 2); q += __shfl_xor(q, 4); q += __shfl_xor(q, 8);
                    if (fr == 0) SSQ[w * 64 + 16 * tb + 4 * h4 + r] = q; }
            __syncthreads();
#pragma unroll
            for (int tb = 0; tb < 4; ++tb)
#pragma unroll
                for (int r = 0; r < 4; ++r) { const int t = 16 * tb + 4 * h4l + r; float tot = 0.f;
#pragma unroll
                    for (int ww = 0; ww < 8; ++ww) tot += SSQ[ww * 64 + t];
                    const float rstd = __builtin_amdgcn_rsqf(tot * (1.0f / 256.0f) + EPS);
#pragma unroll
                    for (int vb = 0; vb < 2; ++vb) { const int col = h * 256 + 32 * w + 16 * vb + frl; const size_t go = (row0 + t) * 1024 + col;
                        AOUT2[go] = (bf16)f2bf(o[tb][vb][r] * rstd * gnorm[col] * bf2f(GATE[go])); } asm volatile("" ::: "memory"); }
        }
#pragma unroll
        for (int kb = 0; kb < 8; ++kb) { const f32x4 gm = *(const LAS f32x4*)(GM + 16 * kb + 4 * h4);
#pragma unroll
            for (int vb = 0; vb < 2; ++vb) S[kb][vb] = S[kb][vb] * gm; }
#pragma unroll
        for (int ts = 0; ts < 2; ++ts) { bf16x8 bv[2];
#pragma unroll
            for (int vb = 0; vb < 2; ++vb) TR_FRAG(bv[vb], vtr, (32 * ts * PV + 16 * vb) * 2, 4 * PV * 2);
#pragma unroll
            for (int kb = 0; kb < 8; ++kb) { bf16x8 a; TR_FRAG(a, ktr, (32 * ts * PKH + 16 * kb) * 2, 4 * PKH * 2);
#pragma unroll
                for (int vb = 0; vb < 2; ++vb) S[kb][vb] = __builtin_amdgcn_mfma_f32_16x16x32_bf16(a, bv[vb], S[kb][vb], 0, 0, 0); } }
        __syncthreads();
    }
    if (!FINAL) {
#pragma unroll
        for (int kb = 0; kb < 8; ++kb)
#pragma unroll
            for (int vb = 0; vb < 2; ++vb)
#pragma unroll
                for (int r = 0; r < 4; ++r) GDS[sbase + (size_t)(16 * kb + 4 * h4 + r) * 256 + 32 * w + 16 * vb + fr] = S[kb][vb][r];
        if (tid < 128) GAM[(size_t)(bh * NSEG + s) * 128 + tid] = __expf(gsum);
    }
}
__device__ __forceinline__ void gla_l2_phase(const Frame& F, const bf16* K, const bf16* V, const float* LG, float* GDS, const float* GAM) {
    for (long idx = F.gt; idx < (long)NB * GH * 128 * 64; idx += F.NGT) { const int v4 = (int)(idx & 63), k = (int)(idx >> 6) & 127, bh = (int)(idx >> 13), h = bh & 3;
        float bc[16]; float run = 0.f;
#pragma unroll
        for (int i = 0; i < NMETA; ++i) { run += LG[(size_t)(RM0 + i) * 512 + h * 128 + k]; bc[i] = run; }
        f32x4 carry = {0.f, 0.f, 0.f, 0.f};
#pragma unroll
        for (int i = 0; i < NMETA; ++i) { const float wk = __expf(run - bc[i]) * bf2f(K[(size_t)(RM0 + i) * 512 + h * 128 + k]); const v2u vw = *(const v2u*)(V + (size_t)(RM0 + i) * 1024 + h * 256 + 4 * v4);
            carry += (f32x4){bflo(vw.x), bfhi(vw.x), bflo(vw.y), bfhi(vw.y)} * wk; }
        for (int s = 0; s < NSEG; ++s) { f32x4* p = (f32x4*)(GDS + ((size_t)(bh * NSEG + s) * 128 + k) * 256 + 4 * v4); const f32x4 tmp = *p; *p = carry; carry = carry * GAM[(size_t)(bh * NSEG + s) * 128 + k] + tmp; }
    }
}

__device__ __forceinline__ void router_phase(const Frame& F, const Args& a, unsigned char* ws) {
    const float* const* in = a.in; unsigned* ctl = (unsigned*)(ws + WS_CTL); bf16* HNM = (bf16*)(ws + WS_HNM); int* tokinfo = (int*)(ws + WS_TOKINFO);
    const float* gain = in[I_NORM_FFN1]; const float* RW = in[I_ROUTER]; const int lane = F.lane;
    for (int m = F.gw; m < TR; m += F.NGW) {
        const f32x4* xr = (const f32x4*)(a.out + (size_t)m * 1024) + lane; const f32x4* gr = (const f32x4*)gain + lane;
        f32x4 v[4]; float s = 0.f;
#pragma unroll
        for (int j = 0; j < 4; ++j) { v[j] = xr[64 * j]; s += (v[j].x * v[j].x + v[j].y * v[j].y) + (v[j].z * v[j].z + v[j].w * v[j].w); }
        const float rstd = 1.0f / sqrtf(wave_sum(s) * (1.0f / 1024.0f) + EPS);
        float p[8] = {0.f, 0.f, 0.f, 0.f, 0.f, 0.f, 0.f, 0.f};
        v2u* o8 = (v2u*)(HNM + (size_t)m * 1024) + lane;
#pragma unroll
        for (int j = 0; j < 4; ++j) { const f32x4 g = gr[64 * j]; const f32x4 y = v[j] * rstd * g;
            v2u wv; wv.x = pk2(y.x, y.y); wv.y = pk2(y.z, y.w); o8[64 * j] = wv;
#pragma unroll
            for (int e4 = 0; e4 < 4; ++e4) { const int d = 4 * (lane + 64 * j) + e4; const f32x4 r0 = *(const f32x4*)(RW + d * 8), r1 = *(const f32x4*)(RW + d * 8 + 4);
#pragma unroll
                for (int e = 0; e < 4; ++e) { p[e] += y[e4] * r0[e]; p[4 + e] += y[e4] * r1[e]; } } }
        float q4[4];
#pragma unroll
        for (int i = 0; i < 4; ++i) { const bool up = (lane & 32) != 0; const float keep = up ? p[i + 4] : p[i], send = up ? p[i] : p[i + 4]; q4[i] = keep + __shfl_xor(send, 32); }
        float q2[2];
#pragma unroll
        for (int i = 0; i < 2; ++i) { const bool up = (lane & 16) != 0; const float keep = up ? q4[i + 2] : q4[i], send = up ? q4[i] : q4[i + 2]; q2[i] = keep + __shfl_xor(send, 16); }
        float y; { const bool up = (lane & 8) != 0; const float keep = up ? q2[1] : q2[0], send = up ? q2[0] : q2[1]; y = keep + __shfl_xor(send, 8); }
        y += __shfl_xor(y, 4); y += __shfl_xor(y, 2); y += __shfl_xor(y, 1);
        float lg[8];
#pragma unroll
        for (int e = 0; e < 8; ++e) lg[e] = __shfl(y, ((e >> 2) & 1) * 32 + ((e >> 1) & 1) * 16 + (e & 1) * 8);
        int i0 = 0; float v0 = lg[0];
#pragma unroll
        for (int e = 1; e < 8; ++e) if (lg[e] > v0) { v0 = lg[e]; i0 = e; }
        int i1 = -1; float v1 = -3.0e38f;
#pragma unroll
        for (int e = 0; e < 8; ++e) if (e != i0 && lg[e] > v1) { v1 = lg[e]; i1 = e; }
        if (lane == 0) { const float w0 = 1.0f / (1.0f + __expf(v1 - v0)), w1 = 1.0f - w0;
            const unsigned p0 = __hip_atomic_fetch_add(ctl + CW_CNT + i0, 1u, RLX_AGENT), p1 = __hip_atomic_fetch_add(ctl + CW_CNT + 8 + i1, 1u, RLX_AGENT);
            *(v4u*)(tokinfo + (size_t)m * 4) = (v4u){(unsigned)i0, p0, __builtin_bit_cast(unsigned, w0), 0u};
            *(v4u*)(tokinfo + (size_t)(TR + m) * 4) = (v4u){(unsigned)i1, p1, __builtin_bit_cast(unsigned, w1), 0u}; }
    }
    LAS float* scr = (LAS float*)(F.lds + RING_OFF + F.wave * 16384);
    constexpr int IG = 16 * 112, ID = 56 * 32, IE = 2 * IG + ID;
    bf16* WGU = (bf16*)(ws + WS_WMOE); bf16* WD = WGU + (size_t)NE * 7168 * 1024;
    for (int it = F.gw; it < NE * IE; it += F.NGW) { const int e = it / IE; int r = it % IE;
        { TrJob j{in[I_MG] + (size_t)e * 1024 * FFE, FFE, 0, 1024, FFE, WGU + (size_t)e * 7168 * 1024, 128, 256, 0}; if (tr_try(r, j, scr, lane)) continue; }
        { TrJob j{in[I_MU] + (size_t)e * 1024 * FFE, FFE, 0, 1024, FFE, WGU + (size_t)e * 7168 * 1024, 128, 256, 128}; if (tr_try(r, j, scr, lane)) continue; }
        { TrJob j{in[I_MD] + (size_t)e * FFE * 1024, 1024, 0, FFE, 1024, WD + (size_t)e * 1024 * FFE, 1 << 30, 0, 0}; tr_try(r, j, scr, lane); }
    }
}
__device__ __forceinline__ void moe_lists_phase(const Frame& F, unsigned char* ws) {
    unsigned* ctl = (unsigned*)(ws + WS_CTL); LAS int* L = (LAS int*)(F.lds + TABL_OFF);
    const int* tokinfo = (const int*)(ws + WS_TOKINFO); int* rowtok = (int*)(ws + WS_ROWTOK); float* roww = (float*)(ws + WS_ROWW);
    int* pexp = (int*)(ws + WS_TAB + TB_PEXP); int* npan = (int*)(ws + WS_TAB + TB_NPAN);
    if (F.tid < 16) L[F.tid] = (int)__hip_atomic_load(ctl + CW_CNT + F.tid, RLX_AGENT);
    __syncthreads();
    if (F.tid == 0) { for (int s = 0; s < 2; ++s) { int acc = 0; for (int e = 0; e < 8; ++e) { L[16 + s * 8 + e] = acc; acc += (L[s * 8 + e] + 255) & ~255; } L[32 + s] = acc >> 8; } }
    __syncthreads();
    if (blockIdx.x == 0) { if (F.tid < 2) npan[F.tid] = L[32 + F.tid];
        if (F.tid < 16) { const int s = F.tid >> 3, base = L[16 + F.tid], n = (L[F.tid] + 255) >> 8; for (int p = 0; p < n; ++p) pexp[s * MPAN + (base >> 8) + p] = F.tid & 7; } }
    for (long i = F.gt; i < 2L * TR; i += F.NGT) { const int s = (int)(i >= TR), tok = (int)(i - (long)s * TR); const v4u inf = *(const v4u*)(tokinfo + i * 4);
        const int row = L[16 + s * 8 + (int)inf.x] + (int)inf.y; rowtok[(size_t)s * MROWS + row] = tok; const unsigned wb = inf.z; roww[(size_t)s * MROWS + row] = __uint_as_float(wb); }
    for (long i = F.gt; i < 16L * 256; i += F.NGT) { const int se = (int)(i >> 8), r = (int)(i & 255), s = se >> 3, cnt = L[se], base = L[16 + se], pad = ((cnt + 255) & ~255) - cnt;
        if (r < pad) { rowtok[(size_t)s * MROWS + base + cnt + r] = -1; roww[(size_t)s * MROWS + base + cnt + r] = 0.f; } }
}

constexpr int N_PHASES = 25;
__global__ void __launch_bounds__(512, 2) mk_fwd(Args args) {
    extern __shared__ __attribute__((aligned(16))) unsigned char lds_raw[];
    Frame F; F.lds = (LAS unsigned char*)lds_raw; F.tid = threadIdx.x; F.lane = F.tid & 63; F.wave = __builtin_amdgcn_readfirstlane(F.tid >> 6); F.G = gridDim.x;
    F.gw = blockIdx.x * 8 + F.wave; F.NGW = F.G * 8; F.gt = (long)blockIdx.x * 512 + F.tid; F.NGT = (long)F.G * 512;
    unsigned char* ws = args.ws; const float* const* in = args.in; float* out = args.out;
    volatile LAS unsigned* MISC = (volatile LAS unsigned*)(F.lds + MISC_OFF);
    if (F.tid < 32) MISC[F.tid] = 0u;
    __syncthreads();
#if !MK_PER_PHASE
    XcdBarrier bar = xcd_barrier_post((unsigned*)(ws + WS_CTL) + CW_BAR, MISC + 8);
#define GRID_BAR() xcd_barrier(bar)
#else
#define GRID_BAR() do { } while (0)
#endif
    const int lo = args.ph_lo, hi = args.ph_hi;
#ifndef MK_MASK
#define MK_MASK 0xFFFFFFFFu
#endif
#ifndef MK_STOP
#define MK_STOP 99
#endif
#define IN(k) ((((MK_MASK) >> (k)) & 1u) && ((k) <= MK_STOP || (k) == 24) && lo <= (k) && (k) < hi)
#define SEAM(k) do { if (IN(k) && IN((k) + 1)) GRID_BAR(); } while (0)
    const int cu = (int)blockIdx.x;
    LAS unsigned char* ring = F.lds + RING_OFF;
    const LAS int* notab = (const LAS int*)(F.lds + TABL_OFF);
    float* hmeta = (float*)(ws + WS_HMETA);
    bf16* HN = (bf16*)(ws + WS_HN);
    constexpr size_t P1K = (size_t)256 * 1024 * 2;

    if (IN(0)) { p0_prologue(F, args, ws); } SEAM(0);
    if (IN(1)) { SchedStatic S{NPR, 10, F.G, cu, (const char*)HN, (const char*)(ws + WS_WIN0), P1K, P1K, 0, 0}; EpiWin0 E{(bf16*)(ws + WS_G), (bf16*)(ws + WS_XRBX), (bf16*)(ws + WS_U)};
        pg8::gemm_phase<EpiWin0, SchedStatic, false>(ring, 1024, 1024, S, E, notab);
        for (int t = cu; t < EV_IN / 16; t += F.G) { const int n0 = t * 16; const bf16* const br[1] = {(const bf16*)(ws + WS_WIN0) + (size_t)n0 * 1024}; f32x4 o[1];
            meta_tile<1>(F, HN + (size_t)RM0 * 1024, 1024, 1024, br, 1024, o);
            if (F.wave == 0) { const int row = RM0 + (F.lane & 15), c = n0 + 4 * (F.lane >> 4); f32x4 v = o[0];
                if (c < 1024) { for (int j = 0; j < 4; ++j) v[j] = gelu_tanh(v[j]); *(v2u*)((bf16*)(ws + WS_G) + (size_t)row * 1024 + c) = (v2u){pk2(v[0], v[1]), pk2(v[2], v[3])}; }
                else if (c < 2048) *(v2u*)((bf16*)(ws + WS_XRBX) + (size_t)row * 1024 + c - 1024) = (v2u){pk2(v[0], v[1]), pk2(v[2], v[3])};
                else *(v2u*)((bf16*)(ws + WS_U) + (size_t)row * 512 + c - 2048) = (v2u){pk2(v[0], v[1]), pk2(v[2], v[3])}; } } } SEAM(1);
    if (IN(2)) { conv_phase(F, (const bf16*)(ws + WS_XRBX), in[I_CONVW], in[I_CONVB], (bf16*)(ws + WS_XC)); ssm_l1_phase(F, ws, (const bf16*)(ws + WS_U), (float*)(ws + WS_SSE)); } SEAM(2);
    if (IN(3)) { SchedStatic S{NPR, 8, F.G, cu, (const char*)(ws + WS_XC), (const char*)(ws + WS_GW), P1K, (size_t)256 * 256 * 2, 2, (size_t)256 * 2};
        EpiGates E{in[I_GAB], in[I_GXB], (const float*)(ws + WS_TAB + TB_SP8), (const bf16*)(ws + WS_XC), (float*)(ws + WS_A), (bf16*)(ws + WS_XRBX)};
        pg8::gemm_phase<EpiGates, SchedStatic, false>(ring, 256, 1024, S, E, notab);
        for (int t = cu; t < 64; t += F.G) { const int ch0 = t * 16, h = ch0 >> 8, cl = ch0 & 255;
            const bf16* gwb = (const bf16*)(ws + WS_GW) + (size_t)h * 512 * 256 + (size_t)((cl >> 7) * 256 + (cl & 127)) * 256; const bf16* const br[2] = {gwb, gwb + 128 * 256}; f32x4 o[2];
            meta_tile<2>(F, (const bf16*)(ws + WS_XC) + (size_t)RM0 * 1024 + h * 256, 1024, 256, br, 256, o);
            if (F.wave == 0) { const int row = RM0 + (F.lane & 15), ch = ch0 + 4 * (F.lane >> 4); const size_t ro = (size_t)row * 1024 + ch;
                const f32x4 ba = *(const f32x4*)(in[I_GAB] + ch), bx = *(const f32x4*)(in[I_GXB] + ch), sp = *(const f32x4*)((const float*)(ws + WS_TAB + TB_SP8) + ch);
                const v2u xw = *(const v2u*)((const bf16*)(ws + WS_XC) + ro); const float xv[4] = {bflo(xw.x), bfhi(xw.x), bflo(xw.y), bfhi(xw.y)}; f32x4 av, bv;
                for (int j = 0; j < 4; ++j) { const float r = sigmoidf_(o[0][j] + ba[j]), ig = sigmoidf_(o[1][j] + bx[j]), la = -r * sp[j]; av[j] = __expf(la); bv[j] = __builtin_amdgcn_sqrtf(fmaxf(one_minus_exp(2.0f * la), 0.0f)) * ig * xv[j]; }
                *(f32x4*)((float*)(ws + WS_A) + ro) = av; *(v2u*)((bf16*)(ws + WS_XRBX) + ro) = (v2u){pk2(bv[0], bv[1]), pk2(bv[2], bv[3])}; } } } SEAM(3);
    if (IN(4)) { lru_l1_phase(F, (const float*)(ws + WS_A), (const bf16*)(ws + WS_XRBX), (float*)(ws + WS_PEND), (float*)(ws + WS_HEND)); } SEAM(4);
    if (IN(5)) { carry_phase(F, ws, (const float*)(ws + WS_A), (const bf16*)(ws + WS_XRBX), (const float*)(ws + WS_PEND), (const float*)(ws + WS_HEND), (float*)(ws + WS_CIN), (const bf16*)(ws + WS_U), (const float*)(ws + WS_SSE), (float*)(ws + WS_SSIN)); } SEAM(5);
    if (IN(6)) { mix0_final_phase(F, ws, (const float*)(ws + WS_A), (const bf16*)(ws + WS_XRBX), (const float*)(ws + WS_CIN), (const bf16*)(ws + WS_G), (bf16*)(ws + WS_AOUT), in[I_CRE], in[I_CIM], in[I_SD], (const bf16*)(ws + WS_U), (const float*)(ws + WS_SSIN), (bf16*)(ws + WS_GS)); } SEAM(6);
    if (IN(7)) { SchedStatic S{NPR, 2, F.G, cu, (const char*)(ws + WS_GS), (const char*)(ws + WS_GLUW), (size_t)256 * 512 * 2, (size_t)256 * 512 * 2, 0, 0}; EpiGlu E{in[I_GLUB], (const bf16*)(ws + WS_GS), (bf16*)(ws + WS_AOUT)};
        pg8::gemm_phase<EpiGlu, SchedStatic, false>(ring, 512, 512, S, E, notab);
        for (int t = cu; t < 32; t += F.G) { const int n0 = t * 16; const bf16* const br[1] = {(const bf16*)(ws + WS_GLUW) + (size_t)n0 * 512}; f32x4 o[1];
            meta_tile<1>(F, (const bf16*)(ws + WS_GS) + (size_t)RM0 * 512, 512, 512, br, 512, o);
            if (F.wave == 0) { const int row = RM0 + (F.lane & 15), c = n0 + 4 * (F.lane >> 4); const f32x4 b = *(const f32x4*)(in[I_GLUB] + c);
                const v2u gw = *(const v2u*)((const bf16*)(ws + WS_GS) + (size_t)row * 512 + c); const float gv[4] = {bflo(gw.x), bfhi(gw.x), bflo(gw.y), bfhi(gw.y)}; float v[4];
                for (int j = 0; j < 4; ++j) v[j] = gv[j] * sigmoidf_(o[0][j] + b[j]);
                *(v2u*)((bf16*)(ws + WS_AOUT) + (size_t)row * 1536 + 1024 + c) = (v2u){pk2(v[0], v[1]), pk2(v[2], v[3])}; } } } SEAM(7);
    if (IN(8)) { SchedStatic S{NPR, 4, F.G, cu, (const char*)(ws + WS_AOUT), (const char*)(ws + WS_WOUT0), (size_t)256 * 1536 * 2, (size_t)256 * 1536 * 2, 0, 0}; EpiResid E{in[I_X], out, hmeta};
        pg8::gemm_phase<EpiResid, SchedStatic, false>(ring, 1536, 1536, S, E, notab);
        for (int t = cu; t < 64; t += F.G) { const int n0 = t * 16; const bf16* const br[1] = {(const bf16*)(ws + WS_WOUT0) + (size_t)n0 * 1536}; f32x4 o[1];
            meta_tile<1>(F, (const bf16*)(ws + WS_AOUT) + (size_t)RM0 * 1536, 1536, 1536, br, 1536, o);
            if (F.wave == 0) { float* p = hmeta + (size_t)(F.lane & 15) * 1024 + n0 + 4 * (F.lane >> 4); *(f32x4*)p = *(const f32x4*)p + o[0]; } } } SEAM(8);
    if (IN(9)) { norm_phase(F, out, hmeta, in[I_NORM_FFN0], HN, TR + NMETA); } SEAM(9);
    if (IN(10)) { SchedStatic S{NPR, 24, F.G, cu, (const char*)HN, (const char*)(ws + WS_WUP0), P1K, P1K, 0, 0}; EpiSwiglu E{(bf16*)(ws + WS_HID0), FF0};
        pg8::gemm_phase<EpiSwiglu, SchedStatic, false>(ring, 1024, 1024, S, E, notab);
        for (int t = cu; t < FF0 / 16; t += F.G) { const int u0 = t * 16; const bf16* gb = (const bf16*)(ws + WS_WUP0) + (size_t)((u0 >> 7) * 256 + (u0 & 127)) * 1024; const bf16* const br[2] = {gb, gb + 128 * 1024}; f32x4 o[2];
            meta_tile<2>(F, HN + (size_t)RM0 * 1024, 1024, 1024, br, 1024, o);
            if (F.wave == 0) { const int row = RM0 + (F.lane & 15), c = u0 + 4 * (F.lane >> 4); float v[4]; for (int j = 0; j < 4; ++j) v[j] = siluf_(o[0][j]) * o[1][j];
                *(v2u*)((bf16*)(ws + WS_HID0) + (size_t)row * FF0 + c) = (v2u){pk2(v[0], v[1]), pk2(v[2], v[3])}; } } } SEAM(10);
    if (IN(11)) { SchedStatic S{NPR, 4, F.G, cu, (const char*)(ws + WS_HID0), (const char*)(ws + WS_WDN0), (size_t)256 * FF0 * 2, (size_t)256 * FF0 * 2, 0, 0}; EpiResid E{out, out, hmeta};
        pg8::gemm_phase<EpiResid, SchedStatic, false>(ring, FF0, FF0, S, E, notab);
        for (int t = cu; t < 64; t += F.G) { const int n0 = t * 16; const bf16* const br[1] = {(const bf16*)(ws + WS_WDN0) + (size_t)n0 * FF0}; f32x4 o[1];
            meta_tile<1>(F, (const bf16*)(ws + WS_HID0) + (size_t)RM0 * FF0, FF0, FF0, br, FF0, o);
            if (F.wave == 0) { float* p = hmeta + (size_t)(F.lane & 15) * 1024 + n0 + 4 * (F.lane >> 4); *(f32x4*)p = *(const f32x4*)p + o[0]; } } } SEAM(11);
    if (IN(12)) { norm_phase(F, out, hmeta, in[I_NORM_MIX1], HN, TR + NMETA); } SEAM(12);
    if (IN(13)) { SchedStatic S{NPR, 14, F.G, cu, (const char*)HN, (const char*)(ws + WS_WIN1), P1K, P1K, 0, 0}; EpiWin1 E{(bf16*)(ws + WS_Q), (bf16*)(ws + WS_K), (bf16*)(ws + WS_V), (bf16*)(ws + WS_GATE), (float*)(ws + WS_LG), in[I_GB]};
        pg8::gemm_phase<EpiWin1, SchedStatic, false>(ring, 1024, 1024, S, E, notab);
        for (int t = cu; t < 128; t += F.G) { const int n0 = t < 32 ? 512 + t * 16 : (t < 96 ? 1024 + (t - 32) * 16 : 3072 + (t - 96) * 16); const bf16* const br[1] = {(const bf16*)(ws + WS_WIN1) + (size_t)n0 * 1024}; f32x4 o[1];
            meta_tile<1>(F, HN + (size_t)RM0 * 1024, 1024, 1024, br, 1024, o);
            if (F.wave == 0) { const int row = RM0 + (F.lane & 15), c = n0 + 4 * (F.lane >> 4); const f32x4 v = o[0];
                if (c < 1024) *(v2u*)((bf16*)(ws + WS_K) + (size_t)row * 512 + c - 512) = (v2u){pk2(v[0], v[1]), pk2(v[2], v[3])};
                else if (c < 2048) *(v2u*)((bf16*)(ws + WS_V) + (size_t)row * 1024 + c - 1024) = (v2u){pk2(v[0], v[1]), pk2(v[2], v[3])};
                else { const f32x4 b = *(const f32x4*)(in[I_GB] + c - 3072); f32x4 l; for (int j = 0; j < 4; ++j) l[j] = logsigmoidf_(v[j] + b[j]) * 0.0625f; *(f32x4*)((float*)(ws + WS_LG) + (size_t)row * 512 + c - 3072) = l; } } } } SEAM(13);
    if (IN(14)) { for (int it = cu; it < NB * GH * NSEG; it += F.G) gla_item<false>(F, it >> 6, (it >> 4) & 3, it & 15, (const bf16*)(ws + WS_Q), (const bf16*)(ws + WS_K), (const bf16*)(ws + WS_V), (const bf16*)(ws + WS_GATE), (const float*)(ws + WS_LG), in[I_GNORM], (float*)(ws + WS_GDS), (float*)(ws + WS_TAB + TB_GAM), (bf16*)(ws + WS_AOUT2)); } SEAM(14);
    if (IN(15)) { gla_l2_phase(F, (const bf16*)(ws + WS_K), (const bf16*)(ws + WS_V), (const float*)(ws + WS_LG), (float*)(ws + WS_GDS), (const float*)(ws + WS_TAB + TB_GAM)); } SEAM(15);
    if (IN(16)) { for (int it = cu; it < NB * GH * NSEG; it += F.G) gla_item<true>(F, it >> 6, (it >> 4) & 3, it & 15, (const bf16*)(ws + WS_Q), (const bf16*)(ws + WS_K), (const bf16*)(ws + WS_V), (const bf16*)(ws + WS_GATE), (const float*)(ws + WS_LG), in[I_GNORM], (float*)(ws + WS_GDS), (float*)(ws + WS_TAB + TB_GAM), (bf16*)(ws + WS_AOUT2)); } SEAM(16);
    if (IN(17)) { SchedStatic S{NPR, 4, F.G, cu, (const char*)(ws + WS_AOUT2), (const char*)(ws + WS_WOUT1), P1K, P1K, 0, 0}; EpiResid E{out, out, hmeta};
        pg8::gemm_phase<EpiResid, SchedStatic, false>(ring, 1024, 1024, S, E, notab); } SEAM(17);
    if (IN(18)) { router_phase(F, args, ws); } SEAM(18);
    if (IN(19)) { moe_lists_phase(F, ws); } SEAM(19);
#define MOE_PHASES(pu, pd, slot) \
    if (IN(pu)) { const int np = ((const int*)(ws + WS_TAB + TB_NPAN))[slot], nun = np * 28; LAS int* meta = (LAS int*)(F.lds + TABL_OFF); LAS int* tokt = (LAS int*)(F.lds + TABL_OFF + 512); \
        const int* pexp = (const int*)(ws + WS_TAB + TB_PEXP) + (slot) * MPAN; const int* rowtok = (const int*)(ws + WS_ROWTOK) + (size_t)(slot) * MROWS; int nmy = 0; \
        __syncthreads(); \
        for (int i = 0; (long)i * F.G + cu < nun && i < 20; ++i) { const int Lq = i * F.G + cu, p = Lq / 28, n = Lq % 28; if (F.tid == 0) { meta[i * 4] = p; meta[i * 4 + 1] = n; meta[i * 4 + 2] = pexp[p]; meta[i * 4 + 3] = 0; } \
            if (F.tid < 256) tokt[i * 256 + F.tid] = rowtok[p * 256 + F.tid]; ++nmy; } \
        __syncthreads(); \
        SchedList S{nmy, meta, (const char*)(ws + WS_HNM), (const char*)(ws + WS_WMOE), 0, P1K, (size_t)7168 * 1024 * 2}; EpiSwiglu E{(bf16*)(ws + WS_HIDM), FFE}; \
        pg8::gemm_phase<EpiSwiglu, SchedList, true>(ring, 1024, 1024, S, E, tokt); } SEAM(pu); \
    if (IN(pd)) { const int np = ((const int*)(ws + WS_TAB + TB_NPAN))[slot], nun = np * 4; LAS int* meta = (LAS int*)(F.lds + TABL_OFF); LAS int* tokt = (LAS int*)(F.lds + TABL_OFF + 512); LAS float* wtt = (LAS float*)(F.lds + TABL_OFF + 512 + 4096); \
        const int* pexp = (const int*)(ws + WS_TAB + TB_PEXP) + (slot) * MPAN; const int* rowtok = (const int*)(ws + WS_ROWTOK) + (size_t)(slot) * MROWS; const float* roww = (const float*)(ws + WS_ROWW) + (size_t)(slot) * MROWS; int nmy = 0; \
        __syncthreads(); \
        for (int i = 0; (long)i * F.G + cu < nun && i < 4; ++i) { const int Lq = i * F.G + cu, p = Lq / 4, n = Lq % 4; if (F.tid == 0) { meta[i * 4] = p; meta[i * 4 + 1] = n; meta[i * 4 + 2] = pexp[p]; meta[i * 4 + 3] = 0; } \
            if (F.tid < 256) { tokt[i * 256 + F.tid] = rowtok[p * 256 + F.tid]; wtt[i * 256 + F.tid] = roww[p * 256 + F.tid]; } ++nmy; } \
        __syncthreads(); \
        SchedList S{nmy, meta, (const char*)(ws + WS_HIDM), (const char*)(ws + WS_WMOE) + (size_t)NE * 7168 * 1024 * 2, (size_t)256 * FFE * 2, (size_t)256 * FFE * 2, (size_t)1024 * FFE * 2}; EpiMoeDown E{out, tokt, wtt}; \
        pg8::gemm_phase<EpiMoeDown, SchedList, false>(ring, FFE, FFE, S, E, tokt); } SEAM(pd);
    MOE_PHASES(20, 21, 0)
    MOE_PHASES(22, 23, 1)
    if (IN(24)) { for (int m = F.gw; m < TR; m += F.NGW) { float* row = out + (size_t)m * 1024; f32x4* xr = (f32x4*)row + F.lane; const f32x4* xs = (MK_STOP < 8) ? (const f32x4*)(in[I_X] + (size_t)m * 1024) + F.lane : xr; const f32x4* gr = (const f32x4*)in[I_FNORM] + F.lane;
            f32x4 v[4]; float s = 0.f;
#pragma unroll
            for (int j = 0; j < 4; ++j) { v[j] = xs[64 * j]; s += (v[j].x * v[j].x + v[j].y * v[j].y) + (v[j].z * v[j].z + v[j].w * v[j].w); }
            const float rstd = 1.0f / sqrtf(wave_sum(s) * (1.0f / 1024.0f) + EPS);
#pragma unroll
            for (int j = 0; j < 4; ++j) xr[64 * j] = v[j] * rstd * gr[64 * j]; }
#ifdef MK_READOUT
        __syncthreads();
        { float val = 0.f;
          const int* npan_ = (const int*)(ws + WS_TAB + TB_NPAN); const unsigned* ctl_ = (const unsigned*)(ws + WS_CTL); const int* rowtok_ = (const int*)(ws + WS_ROWTOK); const float* roww_ = (const float*)(ws + WS_ROWW); const bf16* hid_ = (const bf16*)(ws + WS_HIDM);
          if (MK_READOUT == 1) val = (float)npan_[0];
          if (MK_READOUT == 2) val = (float)ctl_[CW_CNT + 0] * 0.01f;
          if (MK_READOUT == 3) { int c = 0; for (int i = 0; i < 2048; ++i) c += rowtok_[i] >= 0; val = (float)c * 0.01f; }
          if (MK_READOUT == 4) { float a = 0.f; for (int i = 0; i < 2048; ++i) a += fabsf(bf2f(hid_[(size_t)i * 3584 + (i & 1023)])); val = a * 0.01f; }
          if (MK_READOUT == 5) { float a = 0.f; for (int i = 0; i < 2048; ++i) a += roww_[i]; val = a * 0.01f; }
          if (MK_READOUT == 6) { const float* ti = (const float*)(ws + WS_TOKINFO); float a = 0.f; for (int i = 0; i < 2048; ++i) a += ti[i * 4 + 2]; val = a * 0.01f; }
          if (MK_READOUT == 7) { const int* ti = (const int*)(ws + WS_TOKINFO); int a = 0; for (int i = 0; i < 2048; ++i) a += ti[i * 4 + 0]; val = (float)a * 0.01f; }
          if (MK_READOUT == 8) { float a = 0.f; for (int i = 0; i < 2048; ++i) { const float x = bf2f(hid_[(size_t)i * 3584 + (i & 1023)]); a += (x == x && fabsf(x) < 1e30f) ? 0.f : 1.f; } val = a * 0.01f; }
          if (MK_READOUT == 9) { int c = 0; for (int i = 0; i < 2048; ++i) c += (rowtok_[i] >= 0 && rowtok_[i] < TR); val = (float)c * 0.01f; }
          if (MK_READOUT == 10) { int c = 0; for (int i = 0; i < 2048; ++i) c += (roww_[i] > 0.f && roww_[i] <= 1.0f); val = (float)c * 0.01f; }
          if (MK_READOUT == 11) { float a = 0.f; for (int i = 0; i < 2048; ++i) a += (float)rowtok_[i]; val = a * 1e-6f; }
          if (val != val) val = 400.f;
          const float cst = sqrtf(fmaxf(val, 0.f));
          for (int m = F.gw; m < TR; m += F.NGW) { f32x4* xr = (f32x4*)(out + (size_t)m * 1024) + F.lane;
            for (int j = 0; j < 4; ++j) xr[64 * j] = (f32x4){cst, cst, cst, cst}; } }
#endif
    }
#undef IN
#undef SEAM
}

extern "C" void kernel_launch(void* const* d_in, const int* in_sizes, int n_in, void* d_out, int out_size, void* d_ws, size_t ws_size, hipStream_t stream) {
    static int grid = 0;
    if (grid == 0) {
        if (n_in != 38 || out_size != TR * D || ws_size < WS_END) { fprintf(stderr, "kernel_launch: unexpected problem shape (n_in %d, out %d, ws %zu); nothing launched\n", n_in, out_size, ws_size); grid = -1; return; }
        int dev = 0, cus = 0, per_cu = 0;
        if (hipGetDevice(&dev) != hipSuccess || hipDeviceGetAttribute(&cus, hipDeviceAttributeMultiprocessorCount, dev) != hipSuccess) { grid = -1; return; }
        if (hipFuncSetAttribute((const void*)mk_fwd, hipFuncAttributeMaxDynamicSharedMemorySize, LDS_BYTES) != hipSuccess) { fprintf(stderr, "kernel_launch: hipFuncSetAttribute failed\n"); grid = -1; return; }
        if (hipOccupancyMaxActiveBlocksPerMultiprocessor(&per_cu, (const void*)mk_fwd, 512, LDS_BYTES) != hipSuccess || per_cu < 1) fprintf(stderr, "kernel_launch: note: occupancy query reports %d workgroups per CU\n", per_cu);
        (void)hipGetLastError();
        grid = cus;
    }
    if (grid < 0) return;
    (void)hipMemsetAsync((char*)d_ws + WS_CTL, 0, CTL_ZERO_BYTES, stream);
    Args a{};
    for (int i = 0; i < 38; ++i) a.in[i] = (const float*)d_in[i];
    a.out = (float*)d_out; a.ws = (unsigned char*)d_ws; a.li = 0; a.pad = 0;
#if MK_PER_PHASE
    for (int k = 0; k < N_PHASES; ++k) { a.ph_lo = k; a.ph_hi = k + 1; hipLaunchKernelGGL(mk_fwd, dim3(grid), dim3(512), LDS_BYTES, stream, a); }
#else
    a.ph_lo = 0; a.ph_hi = N_PHASES; hipLaunchKernelGGL(mk_fwd, dim3(grid), dim3(512), LDS_BYTES, stream, a);
#endif
}
```

```cpp
#include <hip/hip_runtime.h>
#include <cstdio>
#include <cstdint>

#ifndef MK_PER_PHASE
#define MK_PER_PHASE 0
#endif

#define GAS __attribute__((address_space(1)))
#define LAS __attribute__((address_space(3)))
typedef unsigned short bf16;
typedef unsigned v4u __attribute__((ext_vector_type(4)));
typedef unsigned v2u __attribute__((ext_vector_type(2)));
typedef float f32x4 __attribute__((ext_vector_type(4)));
typedef float f32x2 __attribute__((ext_vector_type(2)));
typedef short bf16x8 __attribute__((ext_vector_type(8)));

constexpr int D = 1024, NB = 4, SEQ = 8192, NMETA = 16;
constexpr int TR = NB * SEQ;
constexpr int RM0 = TR;
constexpr int NPR = 128, NPA = 129;
constexpr int RALL = NPA * 256;
constexpr int LRUW = 1024, SSMW = 512, NG = 32, NS = 64, EV_IN = 2560, EV_MIX = 1536, FF0 = 3072;
constexpr int GK = 512, GV = 1024, GH = 4, GDK = 128, GDV = 256, OD_INP = 3584  , OD_IN = 3088;
constexpr int NE = 8, FFE = 3584, MROWS = 34816  , MPAN = 136;
constexpr float EPS = 1e-6f;
constexpr int NCH = 128;
constexpr int NSEG = 16, SEGC = 8;

constexpr size_t MiB = 1u << 20;
constexpr size_t WS_CTL = 0, CTL_ZERO_BYTES = 1 * MiB;
constexpr size_t WS_TAB = 1 * MiB;
constexpr size_t WS_WIN0 = 2 * MiB, WS_GW = 7 * MiB, WS_GLUW = 8 * MiB, WS_WOUT0 = 9 * MiB, WS_WUP0 = 12 * MiB, WS_WDN0 = 24 * MiB, WS_WIN1 = 30 * MiB, WS_WOUT1 = 37 * MiB;
constexpr size_t WS_PEND = 40 * MiB, WS_HEND = 42 * MiB, WS_CIN = 44 * MiB, WS_SSE = 46 * MiB, WS_SSIN = 54 * MiB, WS_GDS = 62 * MiB, WS_HMETA = 94 * MiB;
constexpr size_t WS_G = 96 * MiB, WS_U = 161 * MiB, WS_A = 194 * MiB, WS_XRBX = 323 * MiB, WS_HN = 388 * MiB, WS_AOUT = 388 * MiB, WS_XC = 453 * MiB, WS_GS = 485 * MiB;
constexpr size_t WS_HID0 = 96 * MiB;
constexpr size_t WS_Q = 96 * MiB, WS_K = 129 * MiB, WS_V = 162 * MiB, WS_GATE = 227 * MiB, WS_LG = 292 * MiB, WS_AOUT2 = 453 * MiB;
constexpr size_t WS_SLAB = 2 * MiB  , WS_HNM = 40 * MiB, WS_WMOE = 105 * MiB, WS_HIDM = 273 * MiB, WS_TOKINFO = 511 * MiB, WS_ROWTOK = 512 * MiB, WS_ROWW = 512 * MiB + 512 * 1024, WS_END = 513 * MiB;
constexpr size_t TB_BBR = 0, TB_BBI = 131072, TB_AR = 262144, TB_AI = 270336, TB_AR64 = 278528, TB_AI64 = 286720, TB_SP8 = 294912, TB_GAM = 299008  , TB_PEXP = 430080  , TB_NPAN = 432128;
constexpr int CW_TMO = 0, CW_CODE = 1, CW_CNT = 64  , CW_BAR = 4096;

constexpr int RING_OFF = 0, RING_BYTES = 131072;
constexpr int TABL_OFF = RING_BYTES, TABL_BYTES = 24576;
constexpr int MISC_OFF = TABL_OFF + TABL_BYTES;
constexpr int LDS_BYTES = MISC_OFF + 128;

#define RLX_AGENT __ATOMIC_RELAXED, __HIP_MEMORY_SCOPE_AGENT
#define LDS_WAIT() asm volatile("s_waitcnt lgkmcnt(0)" ::: "memory")
#define VM_WAIT() asm volatile("s_waitcnt vmcnt(0)" ::: "memory")
__device__ __forceinline__ unsigned f2bf(float f) { unsigned u = __builtin_bit_cast(unsigned, f); return (u + 0x7fffu + ((u >> 16) & 1u)) >> 16; }
__device__ __forceinline__ unsigned pk2(float lo, float hi) { return f2bf(lo) | (f2bf(hi) << 16); }
__device__ __forceinline__ float bf2f(unsigned b) { return __builtin_bit_cast(float, b << 16); }
__device__ __forceinline__ float bflo(unsigned w) { return __builtin_bit_cast(float, w << 16); }
__device__ __forceinline__ float bfhi(unsigned w) { return __builtin_bit_cast(float, w & 0xffff0000u); }
__device__ __forceinline__ float rcpf_(float x) { return __builtin_amdgcn_rcpf(x); }
__device__ __forceinline__ float sigmoidf_(float x) { return rcpf_(1.0f + __expf(-x)); }
__device__ __forceinline__ float siluf_(float x) { return x * rcpf_(1.0f + __expf(-x)); }
__device__ __forceinline__ float gelu_tanh(float x) { const float u = 0.7978845608028654f * (x + 0.044715f * x * x * x); return x * rcpf_(1.0f + __expf(-2.0f * u)); }
__device__ __forceinline__ float one_minus_exp(float x) { const float p = -x * (1.0f + 0.5f * x * (1.0f + (1.0f / 3.0f) * x * (1.0f + 0.25f * x * (1.0f + 0.2f * x * (1.0f + (1.0f / 6.0f) * x))))); return x > -0.25f ? p : 1.0f - __expf(x); }
__device__ __forceinline__ float logsigmoidf_(float x) { return fminf(x, 0.0f) - log1pf(__expf(-fabsf(x))); }
__device__ __forceinline__ float wave_sum(float v) {
#pragma unroll
    for (int o = 1; o < 64; o <<= 1) v += __shfl_xor(v, o);
    return v;
}

namespace pg8 {
constexpr int BM = 256, BK = 64, HALF = 128, HTB = HALF * BK * 2, STAGE_BYTES = 8 * HTB, NXCD = 8, WGM = 8;
__host__ __device__ __forceinline__ int lds_byte(int r, int c) { const int st = (r >> 4) * 2 + (c >> 5), rr = r & 15, cc = c & 31, ob = rr * 64 + cc * 2; return st * 1024 + (ob ^ (((ob >> 9) & 1) << 5)); }
__host__ __device__ __forceinline__ void stage_rc(int b, int& R, int& C) { const int st = b / 1024, sb = b % 1024, swz = sb ^ (((sb >> 9) & 1) << 5); R = (st >> 1) * 16 + swz / 64; C = (st & 1) * 32 + (swz % 64) / 2; }
__host__ __device__ __forceinline__ int perm32(int rho) { const int n = rho >> 4, i = rho & 15; return 8 * (i >> 2) + 4 * n + (i & 3); }

struct Unit { int pm, pn, slot; const char* a; const char* b; };
__device__ __forceinline__ bool static_tile(int i, int G, int c, int nM, int nN, int& pm, int& pn) {
    const int nwg = nM * nN; const long L = (long)i * G + c; if (L >= nwg) return false;
    int wgid = (int)L; { const int q = nwg / NXCD, r = nwg % NXCD, xcd = wgid % NXCD, off = wgid / NXCD; wgid = (xcd < r ? xcd * (q + 1) : r * (q + 1) + (xcd - r) * q) + off; }
    const int nig = WGM * nN, gid = wgid / nig, fm = gid * WGM, gsz = (nM - fm) < WGM ? (nM - fm) : WGM;
    pm = fm + ((wgid % nig) % gsz); pn = (wgid % nig) / gsz; return true;
}
__device__ __forceinline__ unsigned cvt_pk_bf16(float lo, float hi) { unsigned r; asm volatile("v_cvt_pk_bf16_f32 %0, %1, %2" : "=v"(r) : "v"(lo), "v"(hi)); return r; }

template <class Epi, class Sched, bool GATHER>
__device__ __forceinline__ void gemm_phase(LAS unsigned char* lds, const int K, const int lda, const Sched& S, const Epi& E, const LAS int* gtab, const int ldb_ = 0) {
    const int tid = threadIdx.x, wid = __builtin_amdgcn_readfirstlane(tid >> 6), lane = tid & 63, wr = wid >> 2, wc = wid & 3, fr = lane & 15, fq = lane >> 4;
    int nt = K / BK; asm volatile("" : "+s"(nt));
    int RA[2], CA[2]; unsigned voffB[2];
#pragma unroll
    for (int i = 0; i < 2; ++i) { int R, C; stage_rc(tid * 16 + i * 8192, R, C); const int Rb = Epi::PERM ? ((R & ~31) + perm32(R & 31)) : R;
        RA[i] = R; CA[i] = C; voffB[i] = (unsigned)(Rb * (ldb_ ? ldb_ : K) + C) * 2u; }
    const size_t kstep = (size_t)(BK * 2);
    const size_t hstepB = (size_t)HALF * (ldb_ ? ldb_ : K) * 2;
    const unsigned ldsw = (unsigned)wid * 1024u;
    const int aoff = lds_byte(wr * 64 + fr, fq * 8), boff = lds_byte(wc * 32 + fr, fq * 8);
    unsigned offC[2][2], offN[2][2];
#define PG8_SETOFF(dst, unit) do { _Pragma("unroll") for (int _h = 0; _h < 2; ++_h) _Pragma("unroll") for (int _i = 0; _i < 2; ++_i) { \
        if constexpr (GATHER) { int _t = gtab[(unit).slot * 256 + _h * HALF + RA[_i]]; _t = _t < 0 ? 0 : _t; dst[_h][_i] = ((unsigned)_t * (unsigned)lda + (unsigned)CA[_i]) * 2u; } \
        else dst[_h][_i] = ((unsigned)(_h * HALF + RA[_i]) * (unsigned)lda + (unsigned)CA[_i]) * 2u; } } while (0)
#define PG8_SA(b, h) (((b) * 2 + (h)) * HTB)
#define PG8_SB(b, h) ((4 + (b) * 2 + (h)) * HTB)
#define PG8_STAGEB(bufoff, gbase) do { _Pragma("unroll") for (int _i = 0; _i < 2; ++_i) \
        __builtin_amdgcn_global_load_lds((const unsigned*)((const char*)(gbase) + voffB[_i]), (LAS unsigned*)(lds + (bufoff) + ldsw + _i * 8192), 16, 0, 0); } while (0)
#define PG8_STAGEA(bufoff, gbase, o0, o1) do { \
        __builtin_amdgcn_global_load_lds((const unsigned*)((const char*)(gbase) + (o0)), (LAS unsigned*)(lds + (bufoff) + ldsw), 16, 0, 0); \
        __builtin_amdgcn_global_load_lds((const unsigned*)((const char*)(gbase) + (o1)), (LAS unsigned*)(lds + (bufoff) + ldsw + 8192), 16, 0, 0); } while (0)
#define PG8_LDA(dst, b, h) do { _Pragma("unroll") for (int m = 0; m < 4; ++m) _Pragma("unroll") for (int k = 0; k < 2; ++k) dst[m][k] = *(const LAS bf16x8*)(lds + PG8_SA(b, h) + aoff + m * 2048 + k * 1024); } while (0)
#define PG8_LDB(dst, b, h) do { _Pragma("unroll") for (int n = 0; n < 2; ++n) _Pragma("unroll") for (int k = 0; k < 2; ++k) dst[n][k] = *(const LAS bf16x8*)(lds + PG8_SB(b, h) + boff + n * 2048 + k * 1024); } while (0)
#define PG8_MMA(ai, bj, At, Bt) do { __builtin_amdgcn_s_setprio(1); _Pragma("unroll") for (int m = 0; m < 4; ++m) _Pragma("unroll") for (int n = 0; n < 2; ++n) _Pragma("unroll") for (int k = 0; k < 2; ++k) \
        acc[ai][bj][m][n] = __builtin_amdgcn_mfma_f32_16x16x32_bf16(Bt[n][k], At[m][k], acc[ai][bj][m][n], 0, 0, 0); __builtin_amdgcn_s_setprio(0); } while (0)
#define PG8_WAIT_V(n) asm volatile("s_waitcnt vmcnt(" #n ")" ::: "memory")
#define PG8_WAIT_L(n) asm volatile("s_waitcnt lgkmcnt(" #n ")" ::: "memory")
#define PG8_BAR __builtin_amdgcn_s_barrier()
#define PG8_SCHED __builtin_amdgcn_sched_barrier(0)
    Unit cur, nxt; int ui = 0;
    if (!S.next(0, cur)) return;
    f32x4 acc[2][2][4][2];
#pragma unroll
    for (int a = 0; a < 2; ++a)
#pragma unroll
        for (int b = 0; b < 2; ++b)
#pragma unroll
            for (int m = 0; m < 4; ++m)
#pragma unroll
                for (int n = 0; n < 2; ++n) acc[a][b][m][n] = (f32x4){0.f, 0.f, 0.f, 0.f};
    bf16x8 At[4][2], B0[2][2], B1[2][2];
    const char* cA = cur.a; const char* cB = cur.b;
    PG8_SETOFF(offC, cur);
    PG8_STAGEB(PG8_SB(0, 0), cB); PG8_STAGEB(PG8_SB(0, 1), cB + hstepB); PG8_STAGEA(PG8_SA(0, 0), cA, offC[0][0], offC[0][1]); PG8_STAGEA(PG8_SA(0, 1), cA, offC[1][0], offC[1][1]);
    if (wr == 1) PG8_BAR;
    PG8_WAIT_V(2); PG8_BAR;
    PG8_STAGEB(PG8_SB(1, 0), cB + kstep); PG8_STAGEA(PG8_SA(1, 0), cA + kstep, offC[0][0], offC[0][1]); PG8_STAGEB(PG8_SB(1, 1), cB + hstepB + kstep);
    PG8_WAIT_V(6); PG8_BAR;
    for (;;) {
        const bool has_next = S.next(ui + 1, nxt);
        const char* nA = has_next ? nxt.a : cA; const char* nB = has_next ? nxt.b : cB;
        if constexpr (GATHER) {
#pragma unroll
        for (int h = 0; h < 2; ++h)
#pragma unroll
            for (int i = 0; i < 2; ++i) offN[h][i] = offC[h][i]; }
        for (int t = 0; t < nt; t += 2) {
            const bool last = (t == nt - 2);
            const char* a1 = cA + (size_t)(t + 1) * kstep;
            const char* a2 = last ? nA : cA + (size_t)(t + 2) * kstep; const char* b2 = last ? nB : cB + (size_t)(t + 2) * kstep;
            const char* a3 = a2 + kstep; const char* b3 = b2 + kstep;
            if constexpr (GATHER) { if (last && has_next) PG8_SETOFF(offN, nxt); }
            unsigned q00 = offC[0][0], q01 = offC[0][1], q10 = offC[1][0], q11 = offC[1][1];
            if constexpr (GATHER) { q00 = last ? offN[0][0] : q00; q01 = last ? offN[0][1] : q01; q10 = last ? offN[1][0] : q10; q11 = last ? offN[1][1] : q11; }
            PG8_LDB(B0, 0, 0); PG8_LDB(B1, 0, 1); PG8_SCHED; PG8_LDA(At, 0, 0); PG8_STAGEA(PG8_SA(1, 1), a1, offC[1][0], offC[1][1]);
            PG8_WAIT_V(8); PG8_WAIT_L(0); PG8_BAR; PG8_MMA(0, 0, At, B0); PG8_MMA(0, 1, At, B1); PG8_BAR; PG8_SCHED;
            PG8_LDA(At, 0, 1); PG8_STAGEB(PG8_SB(0, 0), b2); PG8_STAGEB(PG8_SB(0, 1), b2 + hstepB); PG8_STAGEA(PG8_SA(0, 0), a2, q00, q01);
            PG8_WAIT_V(8); PG8_WAIT_L(0); PG8_BAR; PG8_MMA(1, 0, At, B0); PG8_MMA(1, 1, At, B1); PG8_BAR; PG8_SCHED;
            PG8_LDB(B0, 1, 0); PG8_LDB(B1, 1, 1); PG8_SCHED; PG8_LDA(At, 1, 0); PG8_STAGEA(PG8_SA(0, 1), a2, q10, q11);
            PG8_WAIT_V(8); PG8_WAIT_L(0); PG8_BAR; PG8_MMA(0, 0, At, B0); PG8_MMA(0, 1, At, B1); PG8_BAR; PG8_SCHED;
            PG8_LDA(At, 1, 1); PG8_STAGEB(PG8_SB(1, 0), b3); PG8_STAGEB(PG8_SB(1, 1), b3 + hstepB); PG8_STAGEA(PG8_SA(1, 0), a3, q00, q01);
            PG8_WAIT_V(8); PG8_WAIT_L(0); PG8_BAR; PG8_MMA(1, 0, At, B0); PG8_MMA(1, 1, At, B1); PG8_BAR; PG8_SCHED;
        }
        if (wr == 0) PG8_BAR;
        E(acc, cur, wr, wc, fr, fq);
        if (!has_next) break;
#pragma unroll
        for (int a = 0; a < 2; ++a)
#pragma unroll
            for (int b = 0; b < 2; ++b)
#pragma unroll
                for (int m = 0; m < 4; ++m)
#pragma unroll
                    for (int n = 0; n < 2; ++n) acc[a][b][m][n] = (f32x4){0.f, 0.f, 0.f, 0.f};
        cur = nxt; cA = nA; cB = nB; ++ui;
        if constexpr (GATHER) {
#pragma unroll
        for (int h = 0; h < 2; ++h)
#pragma unroll
            for (int i = 0; i < 2; ++i) offC[h][i] = offN[h][i]; }
        if (wr == 1) PG8_BAR;
    }
    PG8_WAIT_V(0);
    PG8_BAR;
#undef PG8_SETOFF
#undef PG8_SA
#undef PG8_SB
#undef PG8_STAGEA
#undef PG8_STAGEB
#undef PG8_LDA
#undef PG8_LDB
#undef PG8_MMA
#undef PG8_WAIT_V
#undef PG8_WAIT_L
#undef PG8_BAR
#undef PG8_SCHED
}
}

#define XB_TMO      128
#define XB_XCNT(j)  (256  + 64 * (j))
#define XB_XSUB(j)  (1280 + 64 * (j))
#define XB_XGEN(j)  (2304 + 64 * (j))
#define XB_TOP      3328
#define XB_TOPGEN   3392
#define XCD_BAR_WORDS 3456
#define XB_SPIN_CAP (1u << 18)
__device__ __forceinline__ unsigned xb_ld(unsigned* p)              { return __hip_atomic_load(p, __ATOMIC_RELAXED, __HIP_MEMORY_SCOPE_AGENT); }
__device__ __forceinline__ unsigned xb_add(unsigned* p, unsigned v) { return __hip_atomic_fetch_add(p, v, __ATOMIC_RELAXED, __HIP_MEMORY_SCOPE_AGENT); }
__device__ __forceinline__ unsigned xb_xcc_id() { return (unsigned)__builtin_amdgcn_s_getreg((3 << 11) | 20) & 0xFu; }
#define XB_SPIN(cond, bar) do { unsigned _sp = 0; while (cond) { __builtin_amdgcn_s_sleep(1); \
    if ((++_sp & 255u) == 0u) { if (xb_ld(&(bar)[XB_TMO])) break; if (_sp > XB_SPIN_CAP) { atomicAdd(&(bar)[XB_TMO], 1u); break; } } } } while (0)
struct XcdBarrier { unsigned* bar; unsigned x; volatile LAS unsigned* st; };
__device__ __forceinline__ XcdBarrier xcd_barrier_post(unsigned* bar, volatile LAS unsigned* st) {
    XcdBarrier b; b.bar = bar; b.x = xb_xcc_id(); b.st = st;
    if (threadIdx.x == 0) (void)xb_add(&bar[XB_XCNT(b.x)], 1u);
    return b;
}
__device__ __forceinline__ void xcd_barrier_complete(unsigned* bar, unsigned x, unsigned& nloc, unsigned& nx) {
    const unsigned G = gridDim.x * gridDim.y * gridDim.z;
    unsigned sum, cnt, mine, sp = 0u;
    for (;;) {
        sum = 0u; cnt = 0u; mine = 0u;
#pragma unroll
        for (unsigned j = 0; j < 16; ++j) { const unsigned c = xb_ld(&bar[XB_XCNT(j)]); sum += c; cnt += (c > 0u) ? 1u : 0u; mine = (j == x) ? c : mine; }
        if (sum == G) break;
        __builtin_amdgcn_s_sleep(1);
        if ((++sp & 255u) == 0u) { if (xb_ld(&bar[XB_TMO])) break; if (sp > XB_SPIN_CAP) { atomicAdd(&bar[XB_TMO], 1u); break; } }
    }
    nloc = mine > 0u ? mine : 1u; nx = cnt > 0u ? cnt : 1u;
}
__device__ __forceinline__ void xcd_barrier(const XcdBarrier& b) {
    asm volatile("s_waitcnt vmcnt(0)" ::: "memory");
    __syncthreads();
    if (threadIdx.x == 0) {
        unsigned* bar = b.bar;
        __builtin_amdgcn_s_waitcnt(0);
        unsigned nloc = b.st[0], nx = b.st[1];
        if (nloc == 0u) { xcd_barrier_complete(bar, b.x, nloc, nx); b.st[0] = nloc; b.st[1] = nx; }
        const unsigned old = xb_add(&bar[XB_XSUB(b.x)], 1u);
        const unsigned gen = old / nloc;
        if (old + 1u == (gen + 1u) * nloc) {
            __builtin_amdgcn_fence(__ATOMIC_RELEASE, "agent");
            asm volatile("s_waitcnt vmcnt(0)" ::: "memory");
            const unsigned og = xb_add(&bar[XB_TOP], 1u);
            const unsigned tg = og / nx;
            if (og + 1u == (tg + 1u) * nx) xb_add(&bar[XB_TOPGEN], 1u);
            else XB_SPIN(xb_ld(&bar[XB_TOPGEN]) == tg, bar);
            __builtin_amdgcn_fence(__ATOMIC_ACQUIRE, "agent");
            xb_add(&bar[XB_XGEN(b.x)], 1u);
            asm volatile("s_waitcnt vmcnt(0)" ::: "memory");
        } else {
            XB_SPIN(xb_ld(&bar[XB_XGEN(b.x)]) == gen, bar);
            __builtin_amdgcn_fence(__ATOMIC_ACQUIRE, "agent");
            asm volatile("s_waitcnt vmcnt(0)" ::: "memory");
        }
    }
    __syncthreads();
}

struct Args { const float* in[38]; float* out; unsigned char* ws; int ph_lo, ph_hi, li, pad; };
struct Frame {
    LAS unsigned char* lds;
    int tid, lane, wave, G, gw, NGW;
    int gt, NGT;
};
enum { I_X = 0, I_META, I_NORM_MIX0, I_WIN0, I_CONVW, I_CONVB, I_GAW, I_GAB, I_GXW, I_GXB, I_LAM, I_LRE, I_LIM, I_LDT, I_BRE, I_BIM, I_CRE, I_CIM, I_SD, I_GLUW, I_GLUB, I_WOUT0, I_NORM_FFN0,
       I_FG, I_FU, I_FD, I_NORM_MIX1, I_WIN1, I_GW2, I_GB, I_GNORM, I_WOUT1, I_NORM_FFN1, I_ROUTER, I_MG, I_MU, I_MD, I_FNORM };

struct SchedStatic {
    int nM, nN, G, c; const char* A; const char* B; size_t aStep, bStep; int aColDiv; size_t aColStep;
    __device__ __forceinline__ bool next(int i, pg8::Unit& u) const {
        int pm, pn; if (!pg8::static_tile(i, G, c, nM, nN, pm, pn)) return false;
        u.pm = pm; u.pn = pn; u.slot = i; u.a = A + (size_t)pm * aStep + (aColDiv ? (size_t)(pn / aColDiv) * aColStep : 0); u.b = B + (size_t)pn * bStep; return true;
    }
};
struct SchedList {
    int n; const LAS int* meta; const char* A; const char* B; size_t aStep, bTile, bExpert;
    __device__ __forceinline__ bool next(int i, pg8::Unit& u) const {
        if (i >= n) return false;
        const int pm = meta[i * 4 + 0], pn = meta[i * 4 + 1], e = meta[i * 4 + 2];
        u.pm = pm; u.pn = pn; u.slot = i; const int ko = meta[i * 4 + 3]; u.a = A + (size_t)pm * aStep + (size_t)ko * 2; u.b = B + (size_t)e * bExpert + (size_t)pn * bTile + (size_t)ko * 2; return true;
    }
};

#define EPI_ROWS(ai, m) ((ai) * 128 + wr * 64 + (m) * 16 + fr)
#define EPI_COLP(bj) ((bj) * 128 + wc * 32 + 8 * fq)
#define EPI_COLN(bj, n) ((bj) * 128 + wc * 32 + 16 * (n) + 4 * fq)
typedef const f32x4 (&AccRef)[2][2][4][2];
__device__ __forceinline__ void unpack8(v4u w, f32x4& a, f32x4& b) { a = (f32x4){bflo(w.x), bfhi(w.x), bflo(w.y), bfhi(w.y)}; b = (f32x4){bflo(w.z), bfhi(w.z), bflo(w.w), bfhi(w.w)}; }
__device__ __forceinline__ v4u pack8(f32x4 a, f32x4 b) { v4u w; w.x = pg8::cvt_pk_bf16(a[0], a[1]); w.y = pg8::cvt_pk_bf16(a[2], a[3]); w.z = pg8::cvt_pk_bf16(b[0], b[1]); w.w = pg8::cvt_pk_bf16(b[2], b[3]); return w; }

struct EpiWin0 {
    static constexpr bool PERM = true; bf16 *G, *XR, *U;
    __device__ __forceinline__ void operator()(AccRef acc, const pg8::Unit& u, int wr, int wc, int fr, int fq) const {
        const int pn = u.pn; bf16* base; int ld, c0;
        if (pn < 4) { base = G; ld = 1024; c0 = pn * 256; } else if (pn < 8) { base = XR; ld = 1024; c0 = (pn - 4) * 256; } else { base = U; ld = 512; c0 = (pn - 8) * 256; }
#pragma unroll
        for (int ai = 0; ai < 2; ++ai)
#pragma unroll
            for (int m = 0; m < 4; ++m) { bf16* rowp = base + (size_t)(u.pm * 256 + EPI_ROWS(ai, m)) * ld + c0;
#pragma unroll
                for (int bj = 0; bj < 2; ++bj) { f32x4 v0 = acc[ai][bj][m][0], v1 = acc[ai][bj][m][1];
                    if (pn < 4) {
#pragma unroll
                        for (int j = 0; j < 4; ++j) { v0[j] = gelu_tanh(v0[j]); v1[j] = gelu_tanh(v1[j]); } }
                    *(v4u*)(rowp + EPI_COLP(bj)) = pack8(v0, v1); } }
    }
};
struct EpiGates {
    static constexpr bool PERM = true; const float *gab, *gxb, *sp8; const bf16* XC; bf16* A; bf16* BX;
    __device__ __forceinline__ void operator()(AccRef acc, const pg8::Unit& u, int wr, int wc, int fr, int fq) const {
        const int ch0 = (u.pn >> 1) * 256 + (u.pn & 1) * 128 + wc * 32 + 8 * fq;
        f32x4 ba[2], bx[2], sp[2];
#pragma unroll
        for (int n = 0; n < 2; ++n) { ba[n] = *(const f32x4*)(gab + ch0 + 4 * n); bx[n] = *(const f32x4*)(gxb + ch0 + 4 * n); sp[n] = *(const f32x4*)(sp8 + ch0 + 4 * n); }
#pragma unroll
        for (int ai = 0; ai < 2; ++ai)
#pragma unroll
            for (int m = 0; m < 4; ++m) { const size_t ro = (size_t)(u.pm * 256 + EPI_ROWS(ai, m)) * 1024 + ch0;
                const v4u xw = *(const v4u*)(XC + ro); const float xv[8] = {bflo(xw.x), bfhi(xw.x), bflo(xw.y), bfhi(xw.y), bflo(xw.z), bfhi(xw.z), bflo(xw.w), bfhi(xw.w)};
                f32x4 av[2], bv[2];
#pragma unroll
                for (int n = 0; n < 2; ++n)
#pragma unroll
                    for (int j = 0; j < 4; ++j) { const float r = sigmoidf_(acc[ai][0][m][n][j] + ba[n][j]), ig = sigmoidf_(acc[ai][1][m][n][j] + bx[n][j]);
                        const float la = -r * sp[n][j]; av[n][j] = la; bv[n][j] = __builtin_amdgcn_sqrtf(fmaxf(one_minus_exp(2.0f * la), 0.0f)) * ig * xv[4 * n + j]; }
                *(v4u*)(A + ro) = pack8(av[0], av[1]); *(v4u*)(BX + ro) = pack8(bv[0], bv[1]); asm volatile("" ::: "memory"); }
    }
};
struct EpiGlu {
    static constexpr bool PERM = true; const float* glub; const bf16* GS; bf16* AOUT;
    __device__ __forceinline__ void operator()(AccRef acc, const pg8::Unit& u, int wr, int wc, int fr, int fq) const {
#pragma unroll
        for (int bj = 0; bj < 2; ++bj) { const int c = u.pn * 256 + EPI_COLP(bj); const f32x4 b0 = *(const f32x4*)(glub + c), b1 = *(const f32x4*)(glub + c + 4);
#pragma unroll
            for (int ai = 0; ai < 2; ++ai)
#pragma unroll
                for (int m = 0; m < 4; ++m) { const size_t row = (size_t)(u.pm * 256 + EPI_ROWS(ai, m));
                    const v4u gw = *(const v4u*)(GS + row * 512 + c); const float gv[8] = {bflo(gw.x), bfhi(gw.x), bflo(gw.y), bfhi(gw.y), bflo(gw.z), bfhi(gw.z), bflo(gw.w), bfhi(gw.w)};
                    f32x4 v0, v1;
#pragma unroll
                    for (int j = 0; j < 4; ++j) { v0[j] = gv[j] * sigmoidf_(acc[ai][bj][m][0][j] + b0[j]); v1[j] = gv[4 + j] * sigmoidf_(acc[ai][bj][m][1][j] + b1[j]); }
                    *(v4u*)(AOUT + row * 1536 + 1024 + c) = pack8(v0, v1); } }
    }
};
struct EpiResid {
    static constexpr bool PERM = true; const float* xsrc; bf16* hb;
    __device__ __forceinline__ void operator()(AccRef acc, const pg8::Unit& u, int wr, int wc, int fr, int fq) const {
#pragma unroll
        for (int ai = 0; ai < 2; ++ai)
#pragma unroll
            for (int m = 0; m < 4; ++m) { const size_t ro = (size_t)(u.pm * 256 + EPI_ROWS(ai, m)) * 1024 + u.pn * 256;
#pragma unroll
                for (int bj = 0; bj < 2; ++bj) { const size_t o = ro + EPI_COLP(bj); f32x4 v0, v1;
                    if (xsrc) { v0 = *(const f32x4*)(xsrc + o); v1 = *(const f32x4*)(xsrc + o + 4); } else unpack8(*(const v4u*)(hb + o), v0, v1);
                    *(v4u*)(hb + o) = pack8(v0 + acc[ai][bj][m][0], v1 + acc[ai][bj][m][1]); } }
    }
};
struct EpiSwiglu {
    static constexpr bool PERM = true; bf16* H; int ld;
    __device__ __forceinline__ void operator()(AccRef acc, const pg8::Unit& u, int wr, int wc, int fr, int fq) const {
        const int c = u.pn * 128 + wc * 32 + 8 * fq;
#pragma unroll
        for (int ai = 0; ai < 2; ++ai)
#pragma unroll
            for (int m = 0; m < 4; ++m) { f32x4 v0, v1;
#pragma unroll
                for (int j = 0; j < 4; ++j) { v0[j] = siluf_(acc[ai][0][m][0][j]) * acc[ai][1][m][0][j]; v1[j] = siluf_(acc[ai][0][m][1][j]) * acc[ai][1][m][1][j]; }
                *(v4u*)(H + (size_t)(u.pm * 256 + EPI_ROWS(ai, m)) * ld + c) = pack8(v0, v1); }
    }
};
struct EpiWin1 {
    static constexpr bool PERM = true; bf16 *Q, *K, *V, *GATE; float* LG; const float* gb;
    __device__ __forceinline__ void operator()(AccRef acc, const pg8::Unit& u, int wr, int wc, int fr, int fq) const {
        const int pn = u.pn;
#pragma unroll
        for (int ai = 0; ai < 2; ++ai)
#pragma unroll
            for (int m = 0; m < 4; ++m) { const size_t row = (size_t)(u.pm * 256 + EPI_ROWS(ai, m));
#pragma unroll
                for (int bj = 0; bj < 2; ++bj) { f32x4 v0 = acc[ai][bj][m][0], v1 = acc[ai][bj][m][1]; const int cc = EPI_COLP(bj);
                    if (pn < 2) { v0 = v0 * 0.08838834764831845f; v1 = v1 * 0.08838834764831845f; *(v4u*)(Q + row * 512 + pn * 256 + cc) = pack8(v0, v1); }
                    else if (pn < 4) { *(v4u*)(K + row * 512 + (pn - 2) * 256 + cc) = pack8(v0, v1); }
                    else if (pn < 8) { *(v4u*)(V + row * 1024 + (pn - 4) * 256 + cc) = pack8(v0, v1); }
                    else if (pn < 12) {
#pragma unroll
                        for (int j = 0; j < 4; ++j) { v0[j] = siluf_(v0[j]); v1[j] = siluf_(v1[j]); }
                        *(v4u*)(GATE + row * 1024 + (pn - 8) * 256 + cc) = pack8(v0, v1); }
                    else { const int c = (pn - 12) * 256 + cc; const f32x4 b0 = *(const f32x4*)(gb + c), b1 = *(const f32x4*)(gb + c + 4);
#pragma unroll
                        for (int j = 0; j < 4; ++j) { v0[j] = logsigmoidf_(v0[j] + b0[j]) * 0.0625f; v1[j] = logsigmoidf_(v1[j] + b1[j]) * 0.0625f; }
                        *(f32x4*)(LG + row * 512 + c) = v0; *(f32x4*)(LG + row * 512 + c + 4) = v1; } } }
    }
};
struct EpiMoeDown {
    static constexpr bool PERM = true; bf16* hb; const LAS int* toks; const LAS float* wts;
    __device__ __forceinline__ void operator()(AccRef acc, const pg8::Unit& u, int wr, int wc, int fr, int fq) const {
#pragma unroll
        for (int ai = 0; ai < 2; ++ai)
#pragma unroll
            for (int m = 0; m < 4; ++m) { const int rl = u.slot * 256 + EPI_ROWS(ai, m); const int tok = toks[rl]; const float w = wts[rl];
                if (tok >= 0) { bf16* d = hb + (size_t)tok * 1024 + u.pn * 256;
#pragma unroll
                    for (int bj = 0; bj < 2; ++bj) { bf16* p = d + EPI_COLP(bj); f32x4 v0, v1; unpack8(*(const v4u*)p, v0, v1); *(v4u*)p = pack8(v0 + acc[ai][bj][m][0] * w, v1 + acc[ai][bj][m][1] * w); } } }
    }
};
struct EpiSlab {
    static constexpr bool PERM = false; float* slab; const LAS int* meta;
    __device__ __forceinline__ void operator()(AccRef acc, const pg8::Unit& u, int wr, int wc, int fr, int fq) const {
        const int sl = meta[u.slot * 4 + 3] / 896; float* base = slab + ((size_t)(sl * 8 + (u.pm - 128)) * 256) * 1024 + u.pn * 256;
#pragma unroll
        for (int ai = 0; ai < 2; ++ai)
#pragma unroll
            for (int m = 0; m < 4; ++m) { float* d = base + (size_t)EPI_ROWS(ai, m) * 1024;
#pragma unroll
                for (int bj = 0; bj < 2; ++bj)
#pragma unroll
                    for (int n = 0; n < 2; ++n) *(f32x4*)(d + EPI_COLN(bj, n)) = acc[ai][bj][m][n]; }
    }
};

__device__ __forceinline__ void tr_item(const float* W, int ldw, int col, int k0, bf16* WT, int ldt, int drow, LAS float* scr, int lane) {
#pragma unroll 8
    for (int i = 0; i < 32; ++i) { const int kk = 2 * i + (lane >> 5); scr[kk * 33 + (lane & 31)] = W[(size_t)(k0 + kk) * ldw + col + (lane & 31)]; }
    LDS_WAIT(); asm volatile("" ::: "memory");
    const int c = lane & 7;
#pragma unroll
    for (int j = 0; j < 4; ++j) { const int n = (lane >> 3) + 8 * j; const LAS float* s = scr + (8 * c) * 33 + n;
        v4u o; o.x = pk2(s[0 * 33], s[1 * 33]); o.y = pk2(s[2 * 33], s[3 * 33]); o.z = pk2(s[4 * 33], s[5 * 33]); o.w = pk2(s[6 * 33], s[7 * 33]);
        *(v4u*)(WT + (size_t)(drow + n) * ldt + k0 + 8 * c) = o; }
    LDS_WAIT(); asm volatile("" ::: "memory");
}
struct TrJob { const float* W; int ldw, col0, K, N; bf16* WT; int blk, bstride, add; };
__device__ __forceinline__ bool tr_try(int& r, const TrJob& j, LAS float* scr, int lane) {
    const int nblk = j.N / 32, items = (j.K / 64) * nblk;
    if (r >= items) { r -= items; return false; }
    const int kb = r / nblk, n0 = (r % nblk) * 32;
    tr_item(j.W, j.ldw, j.col0 + n0, kb * 64, j.WT, j.K, (n0 / j.blk) * j.bstride + (n0 % j.blk) + j.add, scr, lane);
    return true;
}
__device__ __forceinline__ void norm_row_bf16(const float* xrow, const float* gain, bf16* orow, int lane) {
    const f32x4* xr = (const f32x4*)xrow + lane; const f32x4* gr = (const f32x4*)gain + lane;
    f32x4 v[4]; float s = 0.f;
#pragma unroll
    for (int j = 0; j < 4; ++j) { v[j] = xr[64 * j]; s += (v[j].x * v[j].x + v[j].y * v[j].y) + (v[j].z * v[j].z + v[j].w * v[j].w); }
    const float rstd = 1.0f / sqrtf(wave_sum(s) * (1.0f / 1024.0f) + EPS);
    v2u* o8 = (v2u*)orow + lane;
#pragma unroll
    for (int j = 0; j < 4; ++j) { const f32x4 g = gr[64 * j]; v2u w; w.x = pk2(v[j].x * rstd * g.x, v[j].y * rstd * g.y); w.y = pk2(v[j].z * rstd * g.z, v[j].w * rstd * g.w); o8[64 * j] = w; }
}
__device__ __forceinline__ void norm_row_b2b(const bf16* hrow, const float* gain, bf16* orow, int lane) {
    f32x4 v[4]; unpack8(*(const v4u*)(hrow + 8 * lane), v[0], v[1]); unpack8(*(const v4u*)(hrow + 512 + 8 * lane), v[2], v[3]); float s = 0.f;
#pragma unroll
    for (int j = 0; j < 4; ++j) s += (v[j].x * v[j].x + v[j].y * v[j].y) + (v[j].z * v[j].z + v[j].w * v[j].w);
    const float rstd = 1.0f / sqrtf(wave_sum(s) * (1.0f / 1024.0f) + EPS);
    const f32x4 g0 = *(const f32x4*)(gain + 8 * lane), g1 = *(const f32x4*)(gain + 8 * lane + 4), g2 = *(const f32x4*)(gain + 512 + 8 * lane), g3 = *(const f32x4*)(gain + 512 + 8 * lane + 4);
    *(v4u*)(orow + 8 * lane) = pack8(v[0] * rstd * g0, v[1] * rstd * g1); *(v4u*)(orow + 512 + 8 * lane) = pack8(v[2] * rstd * g2, v[3] * rstd * g3);
}

__device__ __forceinline__ void p0_prologue(const Frame& F, const Args& a, unsigned char* ws) {
    LAS float* scr = (LAS float*)(F.lds + RING_OFF + F.wave * 16384);
    const float* const* in = a.in;
    constexpr int BIG = 1 << 30;
    for (int it = F.gw; ; it += F.NGW) {
        int r = it;
        { TrJob j{in[I_WIN0], EV_IN, 0, 1024, EV_IN, (bf16*)(ws + WS_WIN0), BIG, 0, 0}; if (tr_try(r, j, scr, F.lane)) continue; }
        bool done = false;
        for (int h = 0; h < 4 && !done; ++h) {
            { TrJob j{in[I_GAW] + (size_t)h * 65536, 256, 0, 256, 256, (bf16*)(ws + WS_GW) + (size_t)h * 512 * 256, 128, 256, 0}; if (tr_try(r, j, scr, F.lane)) { done = true; break; } }
            { TrJob j{in[I_GXW] + (size_t)h * 65536, 256, 0, 256, 256, (bf16*)(ws + WS_GW) + (size_t)h * 512 * 256, 128, 256, 128}; if (tr_try(r, j, scr, F.lane)) { done = true; break; } }
        }
        if (done) continue;
        { TrJob j{in[I_GLUW], 512, 0, 512, 512, (bf16*)(ws + WS_GLUW), BIG, 0, 0}; if (tr_try(r, j, scr, F.lane)) continue; }
        { TrJob j{in[I_WOUT0], 1024, 0, EV_MIX, 1024, (bf16*)(ws + WS_WOUT0), BIG, 0, 0}; if (tr_try(r, j, scr, F.lane)) continue; }
        { TrJob j{in[I_FG], FF0, 0, 1024, FF0, (bf16*)(ws + WS_WUP0), 128, 256, 0}; if (tr_try(r, j, scr, F.lane)) continue; }
        { TrJob j{in[I_FU], FF0, 0, 1024, FF0, (bf16*)(ws + WS_WUP0), 128, 256, 128}; if (tr_try(r, j, scr, F.lane)) continue; }
        { TrJob j{in[I_FD], 1024, 0, FF0, 1024, (bf16*)(ws + WS_WDN0), BIG, 0, 0}; if (tr_try(r, j, scr, F.lane)) continue; }
        { TrJob j{in[I_WIN1], OD_IN, 0, 1024, 3072, (bf16*)(ws + WS_WIN1), BIG, 0, 0}; if (tr_try(r, j, scr, F.lane)) continue; }
        { TrJob j{in[I_WOUT1], 1024, 0, 1024, 1024, (bf16*)(ws + WS_WOUT1), BIG, 0, 0}; if (tr_try(r, j, scr, F.lane)) continue; }
        break;
    }
    for (long i = F.gt; i < 512L * 1024; i += F.NGT) { const int j = (int)(i >> 10), k = (int)(i & 1023); const float* wr_ = in[I_WIN1] + (size_t)k * OD_IN + 3072; const float* w2 = in[I_GW2] + j; float s = 0.f;
#pragma unroll
        for (int r = 0; r < 16; ++r) s += wr_[r] * w2[r * 512];
        ((bf16*)(ws + WS_WIN1))[(size_t)(3072 + j) * 1024 + k] = (bf16)f2bf(s); }
    float* tab = (float*)(ws + WS_TAB);
    for (long i = F.gt; i < NG * NS; i += F.NGT) { const int g = (int)i / NS;
        const double lr = in[I_LRE][i], li = in[I_LIM][i], dt = exp((double)in[I_LDT][g]);
        const double mag = exp(dt * lr), ar = mag * cos(dt * li), ai = mag * sin(dt * li), den = lr * lr + li * li, nr = ar - 1.0;
        const double zr = (nr * lr + ai * li) / den, zi = (ai * lr - nr * li) / den;
        const double m64 = exp(64.0 * dt * lr);
        ((float*)((char*)tab + TB_AR))[i] = (float)ar; ((float*)((char*)tab + TB_AI))[i] = (float)ai;
        ((float*)((char*)tab + TB_AR64))[i] = (float)(m64 * cos(64.0 * dt * li)); ((float*)((char*)tab + TB_AI64))[i] = (float)(m64 * sin(64.0 * dt * li));
        for (int h = 0; h < 16; ++h) { const double br = in[I_BRE][i * 16 + h], bi = in[I_BIM][i * 16 + h];
            ((float*)((char*)tab + TB_BBR))[i * 16 + h] = (float)(zr * br - zi * bi); ((float*)((char*)tab + TB_BBI))[i * 16 + h] = (float)(zr * bi + zi * br); } }
    for (long i = F.gt; i < 1024; i += F.NGT) { const float lam = in[I_LAM][i]; ((float*)((char*)tab + TB_SP8))[i] = 8.0f * log1pf(expf(-lam)); }
    bf16* HN = (bf16*)(ws + WS_HN); float* hmeta = (float*)(ws + WS_HMETA);
    for (int m = F.gw; m < TR + NMETA; m += F.NGW) { const float* src = m < TR ? in[I_X] + (size_t)m * 1024 : in[I_META] + (size_t)(m - TR) * 1024; norm_row_bf16(src, in[I_NORM_MIX0], HN + (size_t)m * 1024, F.lane); }
    for (long i = F.gt; i < NMETA * 1024; i += F.NGT) hmeta[i] = in[I_META][i];
}
__device__ __forceinline__ void norm_phase(const Frame& F, const bf16* HB, const float* hmeta, const float* gain, bf16* HN, int nrows) {
    for (int m = F.gw; m < nrows; m += F.NGW) { if (m < TR) norm_row_b2b(HB + (size_t)m * 1024, gain, HN + (size_t)m * 1024, F.lane); else norm_row_bf16(hmeta + (size_t)(m - TR) * 1024, gain, HN + (size_t)m * 1024, F.lane); }
}
__device__ __forceinline__ int seq_prev(int row, int back) {
    if (row >= TR) { const int i = row - TR - back; return i >= 0 ? TR + i : -1; }
    const int t = row & (SEQ - 1); return t >= back ? row - back : TR + NMETA + (t - back);
}
__device__ __forceinline__ void conv_phase(const Frame& F, const bf16* XR, const float* cw, const float* cb, bf16* XC) {
    for (long i = F.gt; i < (long)(TR + NMETA) * 128; i += F.NGT) { const int row = (int)(i >> 7), c = (int)(i & 127) * 8;
        float acc[8];
#pragma unroll
        for (int j = 0; j < 8; ++j) acc[j] = cb[c + j];
#pragma unroll
        for (int k = 0; k < 4; ++k) { const int src = seq_prev(row, 3 - k); if (src < 0) continue;
            const v4u w = *(const v4u*)(XR + (size_t)src * 1024 + c); const float xv[8] = {bflo(w.x), bfhi(w.x), bflo(w.y), bfhi(w.y), bflo(w.z), bfhi(w.z), bflo(w.w), bfhi(w.w)};
            const f32x4 w0 = *(const f32x4*)(cw + k * 1024 + c), w1 = *(const f32x4*)(cw + k * 1024 + c + 4);
#pragma unroll
            for (int j = 0; j < 4; ++j) { acc[j] += w0[j] * xv[j]; acc[4 + j] += w1[j] * xv[4 + j]; } }
        v4u o; o.x = pk2(acc[0], acc[1]); o.y = pk2(acc[2], acc[3]); o.z = pk2(acc[4], acc[5]); o.w = pk2(acc[6], acc[7]);
        *(v4u*)(XC + (size_t)row * 1024 + c) = o; }
}
constexpr int SSM_HP = 68;
constexpr int SSM_WLDS = 4096 + 16 * SSM_HP * 4;
template <bool FINAL>
__device__ __forceinline__ void ssm_wave(const unsigned char* ws, const float* cre, const float* cim, const float* sd, const bf16* U, bf16* GS, int g, int row0, int ntok, float& hr, float& hi, int lane, LAS unsigned char* wl) {
    LAS f32x4* ub = (LAS f32x4*)wl; LAS unsigned* hb = (LAS unsigned*)(wl + 4096);
    const float* tab = (const float*)(ws + WS_TAB); const int gn = g * NS + lane, fr = lane & 15, fq = lane >> 4;
    const float ar = ((const float*)((const char*)tab + TB_AR))[gn], ai = ((const float*)((const char*)tab + TB_AI))[gn];
    f32x2 bb[16];
#pragma unroll
    for (int q = 0; q < 4; ++q) { const f32x4 a = ((const f32x4*)((const char*)tab + TB_BBR))[gn * 4 + q], b = ((const f32x4*)((const char*)tab + TB_BBI))[gn * 4 + q];
#pragma unroll
        for (int j = 0; j < 4; ++j) bb[4 * q + j] = (f32x2){a[j], b[j]}; }
    bf16x8 ca[4]; f32x4 dv = {0.f, 0.f, 0.f, 0.f};
    if (FINAL) {
#pragma unroll
        for (int ks = 0; ks < 4; ++ks) { const int n0 = 16 * ks + 4 * fq; const f32x4 cr = *(const f32x4*)(cre + (g * 16 + fr) * NS + n0), ci = *(const f32x4*)(cim + (g * 16 + fr) * NS + n0);
            v4u w; w.x = pk2(cr[0], -ci[0]); w.y = pk2(cr[1], -ci[1]); w.z = pk2(cr[2], -ci[2]); w.w = pk2(cr[3], -ci[3]); ca[ks] = __builtin_bit_cast(bf16x8, w); }
        dv = *(const f32x4*)(sd + g * 16 + 4 * fq); }
    if (lane < ntok) { const bf16* up = U + (size_t)(row0 + lane) * 512 + g * 16; const v4u w0 = *(const v4u*)up, w1 = *(const v4u*)(up + 8);
        ub[lane * 4 + 0] = (f32x4){bflo(w0.x), bfhi(w0.x), bflo(w0.y), bfhi(w0.y)}; ub[lane * 4 + 1] = (f32x4){bflo(w0.z), bfhi(w0.z), bflo(w0.w), bfhi(w0.w)};
        ub[lane * 4 + 2] = (f32x4){bflo(w1.x), bfhi(w1.x), bflo(w1.y), bfhi(w1.y)}; ub[lane * 4 + 3] = (f32x4){bflo(w1.z), bfhi(w1.z), bflo(w1.w), bfhi(w1.w)}; }
    LDS_WAIT(); asm volatile("" ::: "memory");
    for (int t0 = 0; t0 < ntok; t0 += 16) {
#pragma unroll 4
        for (int tl = 0; tl < 16; ++tl) { const int t = t0 + tl;
            const f32x4 u0 = ub[t * 4], u1 = ub[t * 4 + 1], u2 = ub[t * 4 + 2], u3 = ub[t * 4 + 3];
            f32x2 x = {0.f, 0.f};
#pragma unroll
            for (int h = 0; h < 4; ++h) { x += bb[h] * u0[h]; x += bb[4 + h] * u1[h]; x += bb[8 + h] * u2[h]; x += bb[12 + h] * u3[h]; }
            const float nr = ar * hr - ai * hi + x.x, ni = ar * hi + ai * hr + x.y; hr = nr; hi = ni;
            if (FINAL) hb[tl * SSM_HP + lane] = pk2(hr, hi); }
        if (FINAL) {
            asm volatile("" ::: "memory");
            f32x4 y = {0.f, 0.f, 0.f, 0.f};
#pragma unroll
            for (int ks = 0; ks < 4; ++ks) { const bf16x8 hbf = *(const LAS bf16x8*)(hb + fr * SSM_HP + 16 * ks + 4 * fq); y = __builtin_amdgcn_mfma_f32_16x16x32_bf16(ca[ks], hbf, y, 0, 0, 0); }
            const f32x4 uw = ub[(t0 + fr) * 4 + fq];
            const float o0 = gelu_tanh(y[0] + dv[0] * uw[0]), o1 = gelu_tanh(y[1] + dv[1] * uw[1]), o2 = gelu_tanh(y[2] + dv[2] * uw[2]), o3 = gelu_tanh(y[3] + dv[3] * uw[3]);
            v2u ow; ow.x = pk2(o0, o1); ow.y = pk2(o2, o3);
            *(v2u*)(GS + (size_t)(row0 + t0 + fr) * 512 + g * 16 + 4 * fq) = ow;
            asm volatile("" ::: "memory"); }
    }
    LDS_WAIT(); asm volatile("" ::: "memory");
}
__device__ __forceinline__ void ssm_l1_phase(const Frame& F, const unsigned char* ws, const bf16* U, float* SSE) {
    for (int it = F.gw; it < NB * NCH * NG; it += F.NGW) { const int g = it % NG, bc = it / NG;
        float hr = 0.f, hi = 0.f; ssm_wave<false>(ws, nullptr, nullptr, nullptr, U, nullptr, g, bc * 64, 64, hr, hi, F.lane, F.lds + RING_OFF + F.wave * SSM_WLDS);
        ((f32x2*)SSE)[(size_t)it * NS + F.lane] = (f32x2){hr, hi}; }
}
__device__ __forceinline__ void lru_l1_phase(const Frame& F, const bf16* A, const bf16* BX, float* PEND, float* HEND) {
    for (long i = F.gt; i < (long)NB * NCH * 512; i += F.NGT) { const int ch = (int)(i & 511) * 2, bc = (int)(i >> 9); const size_t r0 = (size_t)bc * 64;
        f32x2 P = {0.f, 0.f}, H = {0.f, 0.f};
        for (int t0 = 0; t0 < 64; t0 += 8) { unsigned la[8], bx[8];
#pragma unroll
            for (int t = 0; t < 8; ++t) { la[t] = *(const unsigned*)(A + (r0 + t0 + t) * 1024 + ch); bx[t] = *(const unsigned*)(BX + (r0 + t0 + t) * 1024 + ch); }
#pragma unroll
            for (int t = 0; t < 8; ++t) { const f32x2 l2 = {bflo(la[t]), bfhi(la[t])}; P += l2; H = (f32x2){__expf(l2.x), __expf(l2.y)} * H + (f32x2){bflo(bx[t]), bfhi(bx[t])}; } }
        P = (f32x2){__expf(P.x), __expf(P.y)};
        *(f32x2*)(PEND + (size_t)bc * 1024 + ch) = P; *(f32x2*)(HEND + (size_t)bc * 1024 + ch) = H; }
}
__device__ __forceinline__ void carry_phase(const Frame& F, const unsigned char* ws, const bf16* A, const bf16* BX, const float* PEND, const float* HEND, float* CIN, const bf16* U, const float* SSE, float* SSIN) {
    if (F.gt < NB * 1024) { const int ch = (int)F.gt & 1023, b = (int)F.gt >> 10; float H = 0.f;
        for (int i = 0; i < NMETA; ++i) { const size_t r = (size_t)(RM0 + i); H = __expf(bf2f(A[r * 1024 + ch])) * H + bf2f(BX[r * 1024 + ch]); }
        for (int c0 = 0; c0 < NCH; c0 += 32) { float pp[32], hh[32];
#pragma unroll
            for (int c = 0; c < 32; ++c) { const size_t o = ((size_t)b * NCH + c0 + c) * 1024 + ch; pp[c] = PEND[o]; hh[c] = HEND[o]; }
#pragma unroll
            for (int c = 0; c < 32; ++c) { const size_t o = ((size_t)b * NCH + c0 + c) * 1024 + ch; CIN[o] = H; H = hh[c] + pp[c] * H; } }
    } else if (F.gt >= 8 * 512 && F.gt < 8 * 512 + NB * NG * NS) { const int id = (int)F.gt - 8 * 512, n = id % NS, g = (id / NS) % NG, b = id / (NS * NG), gn = g * NS + n;
        const float* tab = (const float*)(ws + WS_TAB);
        const float ar = ((const float*)((const char*)tab + TB_AR))[gn], ai = ((const float*)((const char*)tab + TB_AI))[gn], ar64 = ((const float*)((const char*)tab + TB_AR64))[gn], ai64 = ((const float*)((const char*)tab + TB_AI64))[gn];
        float hr = 0.f, hi = 0.f;
        for (int i = 0; i < NMETA; ++i) { float xr = 0.f, xi = 0.f;
            for (int h = 0; h < 16; ++h) { const float u = bf2f(U[(size_t)(RM0 + i) * 512 + g * 16 + h]); xr += ((const float*)((const char*)tab + TB_BBR))[gn * 16 + h] * u; xi += ((const float*)((const char*)tab + TB_BBI))[gn * 16 + h] * u; }
            const float nr = ar * hr - ai * hi + xr, ni = ar * hi + ai * hr + xi; hr = nr; hi = ni; }
        for (int c0 = 0; c0 < NCH; c0 += 32) { f32x2 ee[32];
#pragma unroll
            for (int c = 0; c < 32; ++c) ee[c] = ((const f32x2*)SSE)[(((size_t)b * NCH + c0 + c) * NG + g) * NS + n];
#pragma unroll
            for (int c = 0; c < 32; ++c) { ((f32x2*)SSIN)[(((size_t)b * NCH + c0 + c) * NG + g) * NS + n] = (f32x2){hr, hi};
                const float nr = ar64 * hr - ai64 * hi + ee[c].x, ni = ar64 * hi + ai64 * hr + ee[c].y; hr = nr; hi = ni; } }
    }
}
__device__ __forceinline__ void mix0_final_phase(const Frame& F, const unsigned char* ws, const bf16* A, const bf16* BX, const float* CIN, const bf16* G, bf16* AOUT, const float* cre, const float* cim, const float* sd, const bf16* U, const float* SSIN, bf16* GS) {
    for (int pass = 0; pass < 2; ++pass) {
      if ((pass ^ (F.wave & 1)) == 0) {
    for (long i = F.gt; i < (long)NB * NCH * 512 + 512; i += F.NGT) { const int ch = (int)(i & 511) * 2, bc = (int)(i >> 9); const bool meta = bc >= NB * NCH;
        const size_t r0 = meta ? (size_t)RM0 : (size_t)bc * 64; const int nt = meta ? NMETA : 64; f32x2 H = {0.f, 0.f}; if (!meta) H = *(const f32x2*)(CIN + (size_t)bc * 1024 + ch);
        for (int t0 = 0; t0 < nt; t0 += 8) { unsigned la[8], bx[8], gg[8];
#pragma unroll
            for (int t = 0; t < 8; ++t) { const size_t r = r0 + t0 + t; la[t] = *(const unsigned*)(A + r * 1024 + ch); bx[t] = *(const unsigned*)(BX + r * 1024 + ch); gg[t] = *(const unsigned*)(G + r * 1024 + ch); }
#pragma unroll
            for (int t = 0; t < 8; ++t) { H = (f32x2){__expf(bflo(la[t])), __expf(bfhi(la[t]))} * H + (f32x2){bflo(bx[t]), bfhi(bx[t])}; *(unsigned*)(AOUT + (r0 + t0 + t) * 1536 + ch) = pk2(bflo(gg[t]) * H.x, bfhi(gg[t]) * H.y); } } }
      } else {
    for (int it = F.gw; it < NB * NCH * NG + NG; it += F.NGW) { const bool meta = it >= NB * NCH * NG; const int g = it % NG, bc = it / NG;
        float hr = 0.f, hi = 0.f; if (!meta) { const f32x2 s = ((const f32x2*)SSIN)[(size_t)it * NS + F.lane]; hr = s.x; hi = s.y; }
        ssm_wave<true>(ws, cre, cim, sd, U, GS, g, meta ? RM0 : bc * 64, meta ? NMETA : 64, hr, hi, F.lane, F.lds + RING_OFF + F.wave * SSM_WLDS); }
      }
    }
}
template <int NACC>
__device__ __forceinline__ void meta_tile(const Frame& F, const bf16* A16, int lda, int K, const bf16* const (&Brow)[NACC], int ldb, f32x4 (&out)[NACC]) {
    LAS f32x4* red = (LAS f32x4*)(F.lds + RING_OFF);
    const int lane = F.lane, fr = lane & 15, fq = lane >> 4, w = F.wave, ks = K / 8;
    f32x4 acc[NACC];
#pragma unroll
    for (int a = 0; a < NACC; ++a) acc[a] = (f32x4){0.f, 0.f, 0.f, 0.f};
    for (int k0 = w * ks; k0 < (w + 1) * ks; k0 += 32) {
        const bf16x8 af = *(const bf16x8*)(A16 + (size_t)fr * lda + k0 + 8 * fq);
#pragma unroll
        for (int a = 0; a < NACC; ++a) { const bf16x8 bfz = *(const bf16x8*)(Brow[a] + (size_t)fr * ldb + k0 + 8 * fq); acc[a] = __builtin_amdgcn_mfma_f32_16x16x32_bf16(bfz, af, acc[a], 0, 0, 0); } }
    __syncthreads();
#pragma unroll
    for (int a = 0; a < NACC; ++a) red[(w * NACC + a) * 64 + lane] = acc[a];
    __syncthreads();
#pragma unroll
    for (int a = 0; a < NACC; ++a) { f32x4 sacc = red[a * 64 + lane];
#pragma unroll
        for (int ww = 1; ww < 8; ++ww) sacc += red[(ww * NACC + a) * 64 + lane];
        out[a] = sacc; }
}
template <class Fn> __device__ __forceinline__ bf16x8 frag8(Fn f) { bf16x8 r;
#pragma unroll
    for (int j = 0; j < 8; ++j) r[j] = (short)f(j);
    return r; }
constexpr int GL_LB = 0, GL_QT = 32768, GL_KT = 50176, GL_KH = 67584, GL_VT = 86016, GL_GM = 120832, GL_BL = 121344, GL_SSQ = 121856;
constexpr int PQ = 136, PKH = 144, PV = 272, PATT = 72;
#define TR_FRAG(dst, base, off, rows4) do { v2u _lo, _hi; \
    asm volatile("ds_read_b64_tr_b16 %0, %2 offset:%c3\n\tds_read_b64_tr_b16 %1, %2 offset:%c4\n\ts_waitcnt lgkmcnt(0)" : "=&v"(_lo), "=&v"(_hi) : "v"(base), "i"(off), "i"((off) + (rows4)) : "memory"); \
    const v4u _w = {_lo.x, _lo.y, _hi.x, _hi.y}; dst = __builtin_bit_cast(bf16x8, _w); } while (0)
__device__ __forceinline__ unsigned lds_addr(const LAS void* p) { return (unsigned)(unsigned long)p; }
template <bool FINAL>
__device__ __forceinline__ void gla_item(const Frame& F, int b, int h, int s, const bf16* Q, const bf16* K, const bf16* V, const bf16* GATE, const float* LG, const float* gnorm, float* GDS, float* GAM, bf16* AOUT2) {
    LAS float* LB = (LAS float*)(F.lds + GL_LB); LAS bf16* ATT = (LAS bf16*)(F.lds + GL_LB);
    LAS bf16* QT = (LAS bf16*)(F.lds + GL_QT); LAS bf16* KT = (LAS bf16*)(F.lds + GL_KT); LAS bf16* KH = (LAS bf16*)(F.lds + GL_KH); LAS bf16* VT = (LAS bf16*)(F.lds + GL_VT);
    LAS float* GM = (LAS float*)(F.lds + GL_GM); LAS float* BL = (LAS float*)(F.lds + GL_BL); LAS float* SSQ = (LAS float*)(F.lds + GL_SSQ);
    const int tid = F.tid, w = F.wave, lane = F.lane, fr = lane & 15, h4 = lane >> 4, tq = fr >> 2, tp = fr & 3;
    const int bh = b * GH + h; const size_t sbase = ((size_t)(bh * NSEG + s) * 128) * 256;
    const unsigned vtr = lds_addr(VT) + (unsigned)((8 * h4 + tq) * PV + 32 * w + 4 * tp) * 2u;
    const unsigned ktr = lds_addr(KH) + (unsigned)((8 * h4 + tq) * PKH + 4 * tp) * 2u;
    f32x4 S[8][2];
#pragma unroll
    for (int kb = 0; kb < 8; ++kb)
#pragma unroll
        for (int vb = 0; vb < 2; ++vb)
#pragma unroll
            for (int r = 0; r < 4; ++r) S[kb][vb][r] = FINAL ? GDS[sbase + (size_t)(16 * kb + 4 * h4 + r) * 256 + 32 * w + 16 * vb + fr] : 0.f;
    float gsum = 0.f;
#pragma nounroll
    for (int c = 0; c < SEGC; ++c) {
        const size_t row0 = (size_t)b * SEQ + (size_t)(s * SEGC + c) * 64;
        int lz = 0; asm volatile("" : "+v"(lz));
        const int tidl = tid + lz, frl = fr + lz, h4l = h4 + lz;
#pragma unroll
        for (int j = 0; j < 4; ++j) { const int i = tidl + 512 * j, t = i >> 5, k4 = (i & 31) * 4; *(LAS f32x4*)(LB + t * 128 + k4) = *(const f32x4*)(LG + (row0 + t) * 512 + h * 128 + k4); }
        __syncthreads();
        if (tid < 128) { float run = 0.f;
#pragma unroll 8
            for (int t = 0; t < 64; ++t) { run += LB[t * 128 + tid]; LB[t * 128 + tid] = run; }
            BL[tid] = run; GM[tid] = __expf(run); gsum += run; }
        __syncthreads();
#pragma unroll
        for (int j = 0; j < 2; ++j) { const int i = tidl + 512 * j, t = i >> 4, k8 = (i & 15) * 8; const size_t go = (row0 + t) * 512 + h * 128 + k8;
            const v4u kw = *(const v4u*)(K + go); const float kv[8] = {bflo(kw.x), bfhi(kw.x), bflo(kw.y), bfhi(kw.y), bflo(kw.z), bfhi(kw.z), bflo(kw.w), bfhi(kw.w)};
            float bb[8], kh[8];
#pragma unroll
            for (int e = 0; e < 8; ++e) { bb[e] = LB[t * 128 + k8 + e]; kh[e] = kv[e] * __expf(BL[k8 + e] - bb[e]); }
            v4u o; o.x = pk2(kh[0], kh[1]); o.y = pk2(kh[2], kh[3]); o.z = pk2(kh[4], kh[5]); o.w = pk2(kh[6], kh[7]); *(LAS v4u*)(KH + t * PKH + k8) = o;
            if (FINAL) { const v4u qw = *(const v4u*)(Q + go); const float qv[8] = {bflo(qw.x), bfhi(qw.x), bflo(qw.y), bfhi(qw.y), bflo(qw.z), bfhi(qw.z), bflo(qw.w), bfhi(qw.w)};
                float qt[8], kt[8];
#pragma unroll
                for (int e = 0; e < 8; ++e) { qt[e] = qv[e] * __expf(bb[e]); kt[e] = kv[e] * __expf(-bb[e]); }
                v4u oq; oq.x = pk2(qt[0], qt[1]); oq.y = pk2(qt[2], qt[3]); oq.z = pk2(qt[4], qt[5]); oq.w = pk2(qt[6], qt[7]); *(LAS v4u*)(QT + t * PQ + k8) = oq;
                v4u ok; ok.x = pk2(kt[0], kt[1]); ok.y = pk2(kt[2], kt[3]); ok.z = pk2(kt[4], kt[5]); ok.w = pk2(kt[6], kt[7]); *(LAS v4u*)(KT + t * PQ + k8) = ok; } }
#pragma unroll
        for (int j = 0; j < 4; ++j) { const int i = tidl + 512 * j, t = i >> 5, c8 = (i & 31) * 8; *(LAS v4u*)(VT + t * PV + c8) = *(const v4u*)(V + (row0 + t) * 1024 + h * 256 + c8); }
        __syncthreads();
        f32x4 o[4][2];
        if (FINAL) {
            { const int tb = w >> 1;
#pragma unroll
              for (int q = 0; q < 2; ++q) { const int sb = 2 * (w & 1) + q; f32x4 acc = {0.f, 0.f, 0.f, 0.f};
                if (sb <= tb) {
#pragma unroll
                    for (int ks = 0; ks < 4; ++ks) { const bf16x8 a = *(const LAS bf16x8*)(QT + (16 * tb + fr) * PQ + 32 * ks + 8 * h4), bq = *(const LAS bf16x8*)(KT + (16 * sb + fr) * PQ + 32 * ks + 8 * h4);
                        acc = __builtin_amdgcn_mfma_f32_16x16x32_bf16(a, bq, acc, 0, 0, 0); } }
#pragma unroll
                for (int r = 0; r < 4; ++r) { const int tl = 4 * h4 + r; const float val = (sb < tb || (sb == tb && fr <= tl)) ? acc[r] : 0.f; ATT[(16 * tb + tl) * PATT + 16 * sb + fr] = (bf16)f2bf(val); } } }
            __syncthreads();
#pragma unroll
            for (int tb = 0; tb < 4; ++tb)
#pragma unroll
                for (int vb = 0; vb < 2; ++vb) o[tb][vb] = (f32x4){0.f, 0.f, 0.f, 0.f};
#pragma unroll
            for (int ss = 0; ss < 2; ++ss) { bf16x8 bv[2];
#pragma unroll
                for (int vb = 0; vb < 2; ++vb) TR_FRAG(bv[vb], vtr, (32 * ss * PV + 16 * vb) * 2, 4 * PV * 2);
#pragma unroll
                for (int tb = 0; tb < 4; ++tb) { if (ss == 1 && tb < 2) continue;
                    const bf16x8 a = *(const LAS bf16x8*)(ATT + (16 * tb + fr) * PATT + 32 * ss + 8 * h4);
#pragma unroll
                    for (int vb = 0; vb < 2; ++vb) o[tb][vb] = __builtin_amdgcn_mfma_f32_16x16x32_bf16(a, bv[vb], o[tb][vb], 0, 0, 0); } }
#pragma unroll
            for (int i = 0; i < 4; ++i) { bf16x8 bs[2];
#pragma unroll
                for (int vb = 0; vb < 2; ++vb) { v4u wv; wv.x = pk2(S[2 * i][vb][0], S[2 * i][vb][1]); wv.y = pk2(S[2 * i][vb][2], S[2 * i][vb][3]); wv.z = pk2(S[2 * i + 1][vb][0], S[2 * i + 1][vb][1]); wv.w = pk2(S[2 * i + 1][vb][2], S[2 * i + 1][vb][3]); bs[vb] = __builtin_bit_cast(bf16x8, wv); }
#pragma unroll
                for (int tb = 0; tb < 4; ++tb) { const LAS bf16* qp = QT + (16 * tb + fr) * PQ + 32 * i + 4 * h4; const v2u a_lo = *(const LAS v2u*)qp, a_hi = *(const LAS v2u*)(qp + 16);
                    const v4u aw = {a_lo.x, a_lo.y, a_hi.x, a_hi.y}; const bf16x8 a = __builtin_bit_cast(bf16x8, aw);
#pragma unroll
                    for (int vb = 0; vb < 2; ++vb) o[tb][vb] = __builtin_amdgcn_mfma_f32_16x16x32_bf16(a, bs[vb], o[tb][vb], 0, 0, 0); } }
        }
        if (FINAL) {
#pragma unroll
            for (int tb = 0; tb < 4; ++tb)
#pragma unroll
                for (int r = 0; r < 4; ++r) { float q = o[tb][0][r] * o[tb][0][r] + o[tb][1][r] * o[tb][1][r];
                    q += __shfl_xor(q, 1); q += __shfl_xor(q, 2); q += __shfl_xor(q, 4); q += __shfl_xor(q, 8);
                    if (fr == 0) SSQ[w * 64 + 16 * tb + 4 * h4 + r] = q; }
            __syncthreads();
#pragma unroll
            for (int tb = 0; tb < 4; ++tb)
#pragma unroll
                for (int r = 0; r < 4; ++r) { const int t = 16 * tb + 4 * h4l + r; float tot = 0.f;
#pragma unroll
                    for (int ww = 0; ww < 8; ++ww) tot += SSQ[ww * 64 + t];
                    const float rstd = __builtin_amdgcn_rsqf(tot * (1.0f / 256.0f) + EPS);
#pragma unroll
                    for (int vb = 0; vb < 2; ++vb) { const int col = h * 256 + 32 * w + 16 * vb + frl; const size_t go = (row0 + t) * 1024 + col;
                        AOUT2[go] = (bf16)f2bf(o[tb][vb][r] * rstd * gnorm[col] * bf2f(GATE[go])); } asm volatile("" ::: "memory"); }
        }
#pragma unroll
        for (int kb = 0; kb < 8; ++kb) { const f32x4 gm = *(const LAS f32x4*)(GM + 16 * kb + 4 * h4);
#pragma unroll
            for (int vb = 0; vb < 2; ++vb) S[kb][vb] = S[kb][vb] * gm; }
#pragma unroll
        for (int ts = 0; ts < 2; ++ts) { bf16x8 bv[2];
#pragma unroll
            for (int vb = 0; vb < 2; ++vb) TR_FRAG(bv[vb], vtr, (32 * ts * PV + 16 * vb) * 2, 4 * PV * 2);
#pragma unroll
            for (int kb = 0; kb < 8; ++kb) { bf16x8 a; TR_FRAG(a, ktr, (32 * ts * PKH + 16 * kb) * 2, 4 * PKH * 2);
#pragma unroll
                for (int vb = 0; vb < 2; ++vb) S[kb][vb] = __builtin_amdgcn_mfma_f32_16x16x32_bf16(a, bv[vb], S[kb][vb], 0, 0, 0); } }
        __syncthreads();
    }
    if (!FINAL) {
#pragma unroll
        for (int kb = 0; kb < 8; ++kb)
#pragma unroll
            for (int vb = 0; vb < 2; ++vb)
#pragma unroll
                for (int r = 0; r < 4; ++r) GDS[sbase + (size_t)(16 * kb + 4 * h4 + r) * 256 + 32 * w + 16 * vb + fr] = S[kb][vb][r];
        if (tid < 128) GAM[(size_t)(bh * NSEG + s) * 128 + tid] = __expf(gsum);
    }
}
__device__ __forceinline__ void gla_l2_phase(const Frame& F, const bf16* K, const bf16* V, const float* LG, float* GDS, const float* GAM) {
    for (long idx = F.gt; idx < (long)NB * GH * 128 * 64; idx += F.NGT) { const int v4 = (int)(idx & 63), k = (int)(idx >> 6) & 127, bh = (int)(idx >> 13), h = bh & 3;
        float bc[16]; float run = 0.f;
#pragma unroll
        for (int i = 0; i < NMETA; ++i) { run += LG[(size_t)(RM0 + i) * 512 + h * 128 + k]; bc[i] = run; }
        f32x4 carry = {0.f, 0.f, 0.f, 0.f};
#pragma unroll
        for (int i = 0; i < NMETA; ++i) { const float wk = __expf(run - bc[i]) * bf2f(K[(size_t)(RM0 + i) * 512 + h * 128 + k]); const v2u vw = *(const v2u*)(V + (size_t)(RM0 + i) * 1024 + h * 256 + 4 * v4);
            carry += (f32x4){bflo(vw.x), bfhi(vw.x), bflo(vw.y), bfhi(vw.y)} * wk; }
        f32x4 ds[NSEG]; float gm[NSEG];
#pragma unroll
        for (int s = 0; s < NSEG; ++s) { ds[s] = *(const f32x4*)(GDS + ((size_t)(bh * NSEG + s) * 128 + k) * 256 + 4 * v4); gm[s] = GAM[(size_t)(bh * NSEG + s) * 128 + k]; }
#pragma unroll
        for (int s = 0; s < NSEG; ++s) { *(f32x4*)(GDS + ((size_t)(bh * NSEG + s) * 128 + k) * 256 + 4 * v4) = carry; carry = carry * gm[s] + ds[s]; }
    }
}

__device__ __forceinline__ void router_phase(const Frame& F, const Args& a, unsigned char* ws) {
    const float* const* in = a.in; unsigned* ctl = (unsigned*)(ws + WS_CTL); bf16* HNM = (bf16*)(ws + WS_HNM); int* tokinfo = (int*)(ws + WS_TOKINFO);
    const float* gain = in[I_NORM_FFN1]; const float* RW = in[I_ROUTER]; const int lane = F.lane; const bf16* HB = (const bf16*)((const char*)a.out + 64 * MiB);
    LAS unsigned* cnt = (LAS unsigned*)(F.lds + TABL_OFF);
    if (F.tid < 32) cnt[F.tid] = 0u;
    __syncthreads();
    const int per = (TR + F.G - 1) / F.G, m0 = (int)blockIdx.x * per, m1 = (m0 + per < TR) ? m0 + per : TR;
    int my_e0 = 0, my_e1 = 0; unsigned my_p0 = 0, my_p1 = 0; float my_w0 = 0.f;
    int jt = 0;
    for (int m = m0 + F.wave; m < m1; m += 8, ++jt) {
        const bf16* hrow = HB + (size_t)m * 1024;
        f32x4 v[4]; unpack8(*(const v4u*)(hrow + 8 * lane), v[0], v[1]); unpack8(*(const v4u*)(hrow + 512 + 8 * lane), v[2], v[3]); float s = 0.f;
#pragma unroll
        for (int j = 0; j < 4; ++j) s += (v[j].x * v[j].x + v[j].y * v[j].y) + (v[j].z * v[j].z + v[j].w * v[j].w);
        const float rstd = 1.0f / sqrtf(wave_sum(s) * (1.0f / 1024.0f) + EPS);
        float p[8] = {0.f, 0.f, 0.f, 0.f, 0.f, 0.f, 0.f, 0.f};
        f32x4 yv[4];
#pragma unroll
        for (int j = 0; j < 4; ++j) { const int d0 = (j >> 1) * 512 + 8 * lane + (j & 1) * 4; const f32x4 g = *(const f32x4*)(gain + d0); const f32x4 y = v[j] * rstd * g; yv[j] = y;
#pragma unroll
            for (int e4 = 0; e4 < 4; ++e4) { const int d = d0 + e4; const f32x4 r0 = *(const f32x4*)(RW + d * 8), r1 = *(const f32x4*)(RW + d * 8 + 4);
#pragma unroll
                for (int e = 0; e < 4; ++e) { p[e] += y[e4] * r0[e]; p[4 + e] += y[e4] * r1[e]; } } }
        *(v4u*)(HNM + (size_t)m * 1024 + 8 * lane) = pack8(yv[0], yv[1]); *(v4u*)(HNM + (size_t)m * 1024 + 512 + 8 * lane) = pack8(yv[2], yv[3]);
        float q4[4];
#pragma unroll
        for (int i = 0; i < 4; ++i) { const bool up = (lane & 32) != 0; const float keep = up ? p[i + 4] : p[i], send = up ? p[i] : p[i + 4]; q4[i] = keep + __shfl_xor(send, 32); }
        float q2[2];
#pragma unroll
        for (int i = 0; i < 2; ++i) { const bool up = (lane & 16) != 0; const float keep = up ? q4[i + 2] : q4[i], send = up ? q4[i] : q4[i + 2]; q2[i] = keep + __shfl_xor(send, 16); }
        float y; { const bool up = (lane & 8) != 0; const float keep = up ? q2[1] : q2[0], send = up ? q2[0] : q2[1]; y = keep + __shfl_xor(send, 8); }
        y += __shfl_xor(y, 4); y += __shfl_xor(y, 2); y += __shfl_xor(y, 1);
        float lg[8];
#pragma unroll
        for (int e = 0; e < 8; ++e) lg[e] = __shfl(y, ((e >> 2) & 1) * 32 + ((e >> 1) & 1) * 16 + (e & 1) * 8);
        int i0 = 0; float v0 = lg[0];
#pragma unroll
        for (int e = 1; e < 8; ++e) if (lg[e] > v0) { v0 = lg[e]; i0 = e; }
        int i1 = -1; float v1 = -3.0e38f;
#pragma unroll
        for (int e = 0; e < 8; ++e) if (e != i0 && lg[e] > v1) { v1 = lg[e]; i1 = e; }
        if (i1 < 0) i1 = (i0 + 1) & 7;
        if (lane == jt) { my_e0 = i0; my_e1 = i1; my_w0 = 1.0f / (1.0f + __expf(v1 - v0)); my_p0 = atomicAdd((unsigned*)(cnt + i0), 1u); my_p1 = atomicAdd((unsigned*)(cnt + 8 + i1), 1u); }
    }
    __syncthreads();
    if (F.tid < 16) cnt[16 + F.tid] = __hip_atomic_fetch_add(ctl + CW_CNT + F.tid, cnt[F.tid], RLX_AGENT);
    __syncthreads();
    if (lane < jt) { const int m = m0 + F.wave + 8 * lane; const float w1 = 1.0f - my_w0;
        *(v4u*)(tokinfo + (size_t)m * 4) = (v4u){(unsigned)my_e0, cnt[16 + my_e0] + my_p0, __float_as_uint(my_w0), 0u};
        *(v4u*)(tokinfo + (size_t)(TR + m) * 4) = (v4u){(unsigned)my_e1, cnt[24 + my_e1] + my_p1, __float_as_uint(w1), 0u}; }
    LAS float* scr = (LAS float*)(F.lds + RING_OFF + F.wave * 16384);
    constexpr int IG = 16 * 112, ID = 56 * 32, IE = 2 * IG + ID;
    bf16* WGU = (bf16*)(ws + WS_WMOE); bf16* WD = WGU + (size_t)NE * 7168 * 1024;
    for (int it = F.gw; it < NE * IE; it += F.NGW) { const int e = it / IE; int r = it % IE;
        { TrJob j{in[I_MG] + (size_t)e * 1024 * FFE, FFE, 0, 1024, FFE, WGU + (size_t)e * 7168 * 1024, 128, 256, 0}; if (tr_try(r, j, scr, lane)) continue; }
        { TrJob j{in[I_MU] + (size_t)e * 1024 * FFE, FFE, 0, 1024, FFE, WGU + (size_t)e * 7168 * 1024, 128, 256, 128}; if (tr_try(r, j, scr, lane)) continue; }
        { TrJob j{in[I_MD] + (size_t)e * FFE * 1024, 1024, 0, FFE, 1024, WD + (size_t)e * 1024 * FFE, 1 << 30, 0, 0}; tr_try(r, j, scr, lane); }
    }
}
__device__ __forceinline__ void moe_lists_phase(const Frame& F, unsigned char* ws) {
    unsigned* ctl = (unsigned*)(ws + WS_CTL); LAS int* L = (LAS int*)(F.lds + TABL_OFF);
    const int* tokinfo = (const int*)(ws + WS_TOKINFO); int* rowtok = (int*)(ws + WS_ROWTOK); float* roww = (float*)(ws + WS_ROWW);
    int* pexp = (int*)(ws + WS_TAB + TB_PEXP); int* npan = (int*)(ws + WS_TAB + TB_NPAN);
    if (F.tid < 16) L[F.tid] = (int)__hip_atomic_load(ctl + CW_CNT + F.tid, RLX_AGENT);
    __syncthreads();
    if (F.tid == 0) { for (int s = 0; s < 2; ++s) { int acc = 0; for (int e = 0; e < 8; ++e) { L[16 + s * 8 + e] = acc; acc += (L[s * 8 + e] + 255) & ~255; } L[32 + s] = acc >> 8; } }
    __syncthreads();
    if (blockIdx.x == 0) { if (F.tid < 2) npan[F.tid] = L[32 + F.tid];
        if (F.tid < 16) { const int s = F.tid >> 3, base = L[16 + F.tid], n = (L[F.tid] + 255) >> 8; for (int p = 0; p < n; ++p) pexp[s * MPAN + (base >> 8) + p] = F.tid & 7; } }
    for (long i = F.gt; i < 2L * TR; i += F.NGT) { const int s = (int)(i >= TR), tok = (int)(i - (long)s * TR); const v4u inf = *(const v4u*)(tokinfo + i * 4);
        const int row = L[16 + s * 8 + (int)inf.x] + (int)inf.y; rowtok[(size_t)s * MROWS + row] = tok; const unsigned wb = inf.z; roww[(size_t)s * MROWS + row] = __uint_as_float(wb); }
    for (long i = F.gt; i < 16L * 256; i += F.NGT) { const int se = (int)(i >> 8), r = (int)(i & 255), s = se >> 3, cnt = L[se], base = L[16 + se], pad = ((cnt + 255) & ~255) - cnt;
        if (r < pad) { rowtok[(size_t)s * MROWS + base + cnt + r] = -1; roww[(size_t)s * MROWS + base + cnt + r] = 0.f; } }
}

constexpr int N_PHASES = 25;
__global__ void __launch_bounds__(512, 2) mk_fwd(Args args) {
    extern __shared__ __attribute__((aligned(16))) unsigned char lds_raw[];
    Frame F; F.lds = (LAS unsigned char*)lds_raw; F.tid = threadIdx.x; F.lane = F.tid & 63; F.wave = __builtin_amdgcn_readfirstlane(F.tid >> 6); F.G = gridDim.x;
    F.gw = blockIdx.x * 8 + F.wave; F.NGW = F.G * 8; F.gt = (int)blockIdx.x * 512 + F.tid; F.NGT = F.G * 512;
    unsigned char* ws = args.ws; const float* const* in = args.in; float* out = args.out;
    volatile LAS unsigned* MISC = (volatile LAS unsigned*)(F.lds + MISC_OFF);
    if (F.tid < 32) MISC[F.tid] = 0u;
    __syncthreads();
#if !MK_PER_PHASE
    XcdBarrier bar = xcd_barrier_post((unsigned*)(ws + WS_CTL) + CW_BAR, MISC + 8);
#define GRID_BAR() xcd_barrier(bar)
#else
#define GRID_BAR() do { } while (0)
#endif
    const int lo = args.ph_lo, hi = args.ph_hi;
#ifndef MK_MASK
#define MK_MASK 0xFFFFFFFFu
#endif
#ifndef MK_STOP
#define MK_STOP 99
#endif
#define IN(k) ((((MK_MASK) >> (k)) & 1u) && ((k) <= MK_STOP || (k) == 24) && lo <= (k) && (k) < hi)
#define SEAM(k) do { if (IN(k) && IN((k) + 1)) GRID_BAR(); asm volatile("" : "+v"(F.tid), "+v"(F.lane), "+v"(F.gt)); } while (0)
    const int cu = (int)blockIdx.x;
    LAS unsigned char* ring = F.lds + RING_OFF;
    const LAS int* notab = (const LAS int*)(F.lds + TABL_OFF);
    float* hmeta = (float*)(ws + WS_HMETA);
    bf16* HB = (bf16*)((char*)out + 64 * MiB);
    bf16* HN = (bf16*)(ws + WS_HN);
    constexpr size_t P1K = (size_t)256 * 1024 * 2;

    if (IN(0)) { p0_prologue(F, args, ws); } SEAM(0);
    if (IN(1)) { SchedStatic S{NPR, 10, F.G, cu, (const char*)HN, (const char*)(ws + WS_WIN0), P1K, P1K, 0, 0}; EpiWin0 E{(bf16*)(ws + WS_G), (bf16*)(ws + WS_XRBX), (bf16*)(ws + WS_U)};
        pg8::gemm_phase<EpiWin0, SchedStatic, false>(ring, 1024, 1024, S, E, notab);
        for (int t = cu; t < EV_IN / 16; t += F.G) { const int n0 = t * 16; const bf16* const br[1] = {(const bf16*)(ws + WS_WIN0) + (size_t)n0 * 1024}; f32x4 o[1];
            meta_tile<1>(F, HN + (size_t)RM0 * 1024, 1024, 1024, br, 1024, o);
            if (F.wave == 0) { const int row = RM0 + (F.lane & 15), c = n0 + 4 * (F.lane >> 4); f32x4 v = o[0];
                if (c < 1024) { for (int j = 0; j < 4; ++j) v[j] = gelu_tanh(v[j]); *(v2u*)((bf16*)(ws + WS_G) + (size_t)row * 1024 + c) = (v2u){pk2(v[0], v[1]), pk2(v[2], v[3])}; }
                else if (c < 2048) *(v2u*)((bf16*)(ws + WS_XRBX) + (size_t)row * 1024 + c - 1024) = (v2u){pk2(v[0], v[1]), pk2(v[2], v[3])};
                else *(v2u*)((bf16*)(ws + WS_U) + (size_t)row * 512 + c - 2048) = (v2u){pk2(v[0], v[1]), pk2(v[2], v[3])}; } } } SEAM(1);
    if (IN(2)) { for (int pass = 0; pass < 2; ++pass) { if ((pass ^ (F.wave & 1)) == 0) conv_phase(F, (const bf16*)(ws + WS_XRBX), in[I_CONVW], in[I_CONVB], (bf16*)(ws + WS_XC)); else ssm_l1_phase(F, ws, (const bf16*)(ws + WS_U), (float*)(ws + WS_SSE)); } } SEAM(2);
    if (IN(3)) { SchedStatic S{NPR, 8, F.G, cu, (const char*)(ws + WS_XC), (const char*)(ws + WS_GW), P1K, (size_t)256 * 256 * 2, 2, (size_t)256 * 2};
        EpiGates E{in[I_GAB], in[I_GXB], (const float*)(ws + WS_TAB + TB_SP8), (const bf16*)(ws + WS_XC), (bf16*)(ws + WS_A), (bf16*)(ws + WS_XRBX)};
        pg8::gemm_phase<EpiGates, SchedStatic, false>(ring, 256, 1024, S, E, notab);
        for (int t = cu; t < 64; t += F.G) { const int ch0 = t * 16, h = ch0 >> 8, cl = ch0 & 255;
            const bf16* gwb = (const bf16*)(ws + WS_GW) + (size_t)h * 512 * 256 + (size_t)((cl >> 7) * 256 + (cl & 127)) * 256; const bf16* const br[2] = {gwb, gwb + 128 * 256}; f32x4 o[2];
            meta_tile<2>(F, (const bf16*)(ws + WS_XC) + (size_t)RM0 * 1024 + h * 256, 1024, 256, br, 256, o);
            if (F.wave == 0) { const int row = RM0 + (F.lane & 15), ch = ch0 + 4 * (F.lane >> 4); const size_t ro = (size_t)row * 1024 + ch;
                const f32x4 ba = *(const f32x4*)(in[I_GAB] + ch), bx = *(const f32x4*)(in[I_GXB] + ch), sp = *(const f32x4*)((const float*)(ws + WS_TAB + TB_SP8) + ch);
                const v2u xw = *(const v2u*)((const bf16*)(ws + WS_XC) + ro); const float xv[4] = {bflo(xw.x), bfhi(xw.x), bflo(xw.y), bfhi(xw.y)}; f32x4 av, bv;
                for (int j = 0; j < 4; ++j) { const float r = sigmoidf_(o[0][j] + ba[j]), ig = sigmoidf_(o[1][j] + bx[j]), la = -r * sp[j]; av[j] = la; bv[j] = __builtin_amdgcn_sqrtf(fmaxf(one_minus_exp(2.0f * la), 0.0f)) * ig * xv[j]; }
                *(v2u*)((bf16*)(ws + WS_A) + ro) = (v2u){pk2(av[0], av[1]), pk2(av[2], av[3])}; *(v2u*)((bf16*)(ws + WS_XRBX) + ro) = (v2u){pk2(bv[0], bv[1]), pk2(bv[2], bv[3])}; } } } SEAM(3);
    if (IN(4)) { lru_l1_phase(F, (const bf16*)(ws + WS_A), (const bf16*)(ws + WS_XRBX), (float*)(ws + WS_PEND), (float*)(ws + WS_HEND)); } SEAM(4);
    if (IN(5)) { carry_phase(F, ws, (const bf16*)(ws + WS_A), (const bf16*)(ws + WS_XRBX), (const float*)(ws + WS_PEND), (const float*)(ws + WS_HEND), (float*)(ws + WS_CIN), (const bf16*)(ws + WS_U), (const float*)(ws + WS_SSE), (float*)(ws + WS_SSIN)); } SEAM(5);
    if (IN(6)) { mix0_final_phase(F, ws, (const bf16*)(ws + WS_A), (const bf16*)(ws + WS_XRBX), (const float*)(ws + WS_CIN), (const bf16*)(ws + WS_G), (bf16*)(ws + WS_AOUT), in[I_CRE], in[I_CIM], in[I_SD], (const bf16*)(ws + WS_U), (const float*)(ws + WS_SSIN), (bf16*)(ws + WS_GS)); } SEAM(6);
    if (IN(7)) { SchedStatic S{NPR, 2, F.G, cu, (const char*)(ws + WS_GS), (const char*)(ws + WS_GLUW), (size_t)256 * 512 * 2, (size_t)256 * 512 * 2, 0, 0}; EpiGlu E{in[I_GLUB], (const bf16*)(ws + WS_GS), (bf16*)(ws + WS_AOUT)};
        pg8::gemm_phase<EpiGlu, SchedStatic, false>(ring, 512, 512, S, E, notab);
        for (int t = cu; t < 32; t += F.G) { const int n0 = t * 16; const bf16* const br[1] = {(const bf16*)(ws + WS_GLUW) + (size_t)n0 * 512}; f32x4 o[1];
            meta_tile<1>(F, (const bf16*)(ws + WS_GS) + (size_t)RM0 * 512, 512, 512, br, 512, o);
            if (F.wave == 0) { const int row = RM0 + (F.lane & 15), c = n0 + 4 * (F.lane >> 4); const f32x4 b = *(const f32x4*)(in[I_GLUB] + c);
                const v2u gw = *(const v2u*)((const bf16*)(ws + WS_GS) + (size_t)row * 512 + c); const float gv[4] = {bflo(gw.x), bfhi(gw.x), bflo(gw.y), bfhi(gw.y)}; float v[4];
                for (int j = 0; j < 4; ++j) v[j] = gv[j] * sigmoidf_(o[0][j] + b[j]);
                *(v2u*)((bf16*)(ws + WS_AOUT) + (size_t)row * 1536 + 1024 + c) = (v2u){pk2(v[0], v[1]), pk2(v[2], v[3])}; } } } SEAM(7);
    if (IN(8)) { SchedStatic S{NPR, 4, F.G, cu, (const char*)(ws + WS_AOUT), (const char*)(ws + WS_WOUT0), (size_t)256 * 1536 * 2, (size_t)256 * 1536 * 2, 0, 0}; EpiResid E{in[I_X], HB};
        pg8::gemm_phase<EpiResid, SchedStatic, false>(ring, 1536, 1536, S, E, notab);
        for (int t = cu; t < 64; t += F.G) { const int n0 = t * 16; const bf16* const br[1] = {(const bf16*)(ws + WS_WOUT0) + (size_t)n0 * 1536}; f32x4 o[1];
            meta_tile<1>(F, (const bf16*)(ws + WS_AOUT) + (size_t)RM0 * 1536, 1536, 1536, br, 1536, o);
            if (F.wave == 0) { float* p = hmeta + (size_t)(F.lane & 15) * 1024 + n0 + 4 * (F.lane >> 4); *(f32x4*)p = *(const f32x4*)p + o[0]; } } } SEAM(8);
    if (IN(9)) { norm_phase(F, HB, hmeta, in[I_NORM_FFN0], HN, TR + NMETA); } SEAM(9);
    if (IN(10)) { SchedStatic S{NPR, 24, F.G, cu, (const char*)HN, (const char*)(ws + WS_WUP0), P1K, P1K, 0, 0}; EpiSwiglu E{(bf16*)(ws + WS_HID0), FF0};
        pg8::gemm_phase<EpiSwiglu, SchedStatic, false>(ring, 1024, 1024, S, E, notab);
        for (int t = cu; t < FF0 / 16; t += F.G) { const int u0 = t * 16; const bf16* gb = (const bf16*)(ws + WS_WUP0) + (size_t)((u0 >> 7) * 256 + (u0 & 127)) * 1024; const bf16* const br[2] = {gb, gb + 128 * 1024}; f32x4 o[2];
            meta_tile<2>(F, HN + (size_t)RM0 * 1024, 1024, 1024, br, 1024, o);
            if (F.wave == 0) { const int row = RM0 + (F.lane & 15), c = u0 + 4 * (F.lane >> 4); float v[4]; for (int j = 0; j < 4; ++j) v[j] = siluf_(o[0][j]) * o[1][j];
                *(v2u*)((bf16*)(ws + WS_HID0) + (size_t)row * FF0 + c) = (v2u){pk2(v[0], v[1]), pk2(v[2], v[3])}; } } } SEAM(10);
    if (IN(11)) { SchedStatic S{NPR, 4, F.G, cu, (const char*)(ws + WS_HID0), (const char*)(ws + WS_WDN0), (size_t)256 * FF0 * 2, (size_t)256 * FF0 * 2, 0, 0}; EpiResid E{nullptr, HB};
        pg8::gemm_phase<EpiResid, SchedStatic, false>(ring, FF0, FF0, S, E, notab);
        for (int t = cu; t < 64; t += F.G) { const int n0 = t * 16; const bf16* const br[1] = {(const bf16*)(ws + WS_WDN0) + (size_t)n0 * FF0}; f32x4 o[1];
            meta_tile<1>(F, (const bf16*)(ws + WS_HID0) + (size_t)RM0 * FF0, FF0, FF0, br, FF0, o);
            if (F.wave == 0) { float* p = hmeta + (size_t)(F.lane & 15) * 1024 + n0 + 4 * (F.lane >> 4); *(f32x4*)p = *(const f32x4*)p + o[0]; } } } SEAM(11);
    if (IN(12)) { norm_phase(F, HB, hmeta, in[I_NORM_MIX1], HN, TR + NMETA); } SEAM(12);
    if (IN(13)) { SchedStatic S{NPR, 14, F.G, cu, (const char*)HN, (const char*)(ws + WS_WIN1), P1K, P1K, 0, 0}; EpiWin1 E{(bf16*)(ws + WS_Q), (bf16*)(ws + WS_K), (bf16*)(ws + WS_V), (bf16*)(ws + WS_GATE), (float*)(ws + WS_LG), in[I_GB]};
        pg8::gemm_phase<EpiWin1, SchedStatic, false>(ring, 1024, 1024, S, E, notab);
        for (int t = cu; t < 128; t += F.G) { const int n0 = t < 32 ? 512 + t * 16 : (t < 96 ? 1024 + (t - 32) * 16 : 3072 + (t - 96) * 16); const bf16* const br[1] = {(const bf16*)(ws + WS_WIN1) + (size_t)n0 * 1024}; f32x4 o[1];
            meta_tile<1>(F, HN + (size_t)RM0 * 1024, 1024, 1024, br, 1024, o);
            if (F.wave == 0) { const int row = RM0 + (F.lane & 15), c = n0 + 4 * (F.lane >> 4); const f32x4 v = o[0];
                if (c < 1024) *(v2u*)((bf16*)(ws + WS_K) + (size_t)row * 512 + c - 512) = (v2u){pk2(v[0], v[1]), pk2(v[2], v[3])};
                else if (c < 2048) *(v2u*)((bf16*)(ws + WS_V) + (size_t)row * 1024 + c - 1024) = (v2u){pk2(v[0], v[1]), pk2(v[2], v[3])};
                else { const f32x4 b = *(const f32x4*)(in[I_GB] + c - 3072); f32x4 l; for (int j = 0; j < 4; ++j) l[j] = logsigmoidf_(v[j] + b[j]) * 0.0625f; *(f32x4*)((float*)(ws + WS_LG) + (size_t)row * 512 + c - 3072) = l; } } } } SEAM(13);
    if (IN(14)) { for (int it = cu; it < NB * GH * NSEG; it += F.G) gla_item<false>(F, it >> 6, (it >> 4) & 3, it & 15, (const bf16*)(ws + WS_Q), (const bf16*)(ws + WS_K), (const bf16*)(ws + WS_V), (const bf16*)(ws + WS_GATE), (const float*)(ws + WS_LG), in[I_GNORM], (float*)(ws + WS_GDS), (float*)(ws + WS_TAB + TB_GAM), (bf16*)(ws + WS_AOUT2)); } SEAM(14);
    if (IN(15)) { gla_l2_phase(F, (const bf16*)(ws + WS_K), (const bf16*)(ws + WS_V), (const float*)(ws + WS_LG), (float*)(ws + WS_GDS), (const float*)(ws + WS_TAB + TB_GAM)); } SEAM(15);
    if (IN(16)) { for (int it = cu; it < NB * GH * NSEG; it += F.G) gla_item<true>(F, it >> 6, (it >> 4) & 3, it & 15, (const bf16*)(ws + WS_Q), (const bf16*)(ws + WS_K), (const bf16*)(ws + WS_V), (const bf16*)(ws + WS_GATE), (const float*)(ws + WS_LG), in[I_GNORM], (float*)(ws + WS_GDS), (float*)(ws + WS_TAB + TB_GAM), (bf16*)(ws + WS_AOUT2)); } SEAM(16);
    if (IN(17)) { SchedStatic S{NPR, 4, F.G, cu, (const char*)(ws + WS_AOUT2), (const char*)(ws + WS_WOUT1), P1K, P1K, 0, 0}; EpiResid E{nullptr, HB};
        pg8::gemm_phase<EpiResid, SchedStatic, false>(ring, 1024, 1024, S, E, notab); } SEAM(17);
    if (IN(18)) { router_phase(F, args, ws); } SEAM(18);
    if (IN(19)) { moe_lists_phase(F, ws); } SEAM(19);
#define MOE_PHASES(pu, pd, slot) \
    if (IN(pu)) { const int np = ((const int*)(ws + WS_TAB + TB_NPAN))[slot], nun = np * 28; LAS int* meta = (LAS int*)(F.lds + TABL_OFF); LAS int* tokt = (LAS int*)(F.lds + TABL_OFF + 512); \
        const int* pexp = (const int*)(ws + WS_TAB + TB_PEXP) + (slot) * MPAN; const int* rowtok = (const int*)(ws + WS_ROWTOK) + (size_t)(slot) * MROWS; int nmy = 0; \
        __syncthreads(); \
        for (int i = 0; (long)i * F.G + cu < nun && i < 20; ++i) { const int Lq = i * F.G + cu, p = Lq / 28, n = Lq % 28; if (F.tid == 0) { meta[i * 4] = p; meta[i * 4 + 1] = n; meta[i * 4 + 2] = pexp[p]; meta[i * 4 + 3] = 0; } \
            if (F.tid < 256) tokt[i * 256 + F.tid] = rowtok[p * 256 + F.tid]; ++nmy; } \
        __syncthreads(); \
        SchedList S{nmy, meta, (const char*)(ws + WS_HNM), (const char*)(ws + WS_WMOE), 0, P1K, (size_t)7168 * 1024 * 2}; EpiSwiglu E{(bf16*)(ws + WS_HIDM), FFE}; \
        pg8::gemm_phase<EpiSwiglu, SchedList, true>(ring, 1024, 1024, S, E, tokt); } SEAM(pu); \
    if (IN(pd)) { const int np = ((const int*)(ws + WS_TAB + TB_NPAN))[slot], nun = np * 4, nfull = nun < 512 ? nun : 512, nrem = nun - nfull; LAS int* meta = (LAS int*)(F.lds + TABL_OFF); LAS int* tokt = (LAS int*)(F.lds + TABL_OFF + 512); LAS float* wtt = (LAS float*)(F.lds + TABL_OFF + 512 + 4096); \
        const int* pexp = (const int*)(ws + WS_TAB + TB_PEXP) + (slot) * MPAN; const int* rowtok = (const int*)(ws + WS_ROWTOK) + (size_t)(slot) * MROWS; const float* roww = (const float*)(ws + WS_ROWW) + (size_t)(slot) * MROWS; int nmy = 0; \
        __syncthreads(); \
        for (int i = 0; (long)i * F.G + cu < nfull && i < 3; ++i) { const int Lq = i * F.G + cu, p = Lq / 4, n = Lq % 4; if (F.tid == 0) { meta[i * 4] = p; meta[i * 4 + 1] = n; meta[i * 4 + 2] = pexp[p]; meta[i * 4 + 3] = 0; } \
            if (F.tid < 256) { tokt[i * 256 + F.tid] = rowtok[p * 256 + F.tid]; wtt[i * 256 + F.tid] = roww[p * 256 + F.tid]; } ++nmy; } \
        const bool slice = cu < nrem * 4;                   \
        if (slice && F.tid == 0) { const int Lq = 512 + cu / 4, p = Lq / 4, n = Lq % 4; meta[12] = p; meta[13] = n; meta[14] = pexp[p]; meta[15] = (cu & 3) * 896; } \
        __syncthreads(); \
        { SchedList S{nmy, meta, (const char*)(ws + WS_HIDM), (const char*)(ws + WS_WMOE) + (size_t)NE * 7168 * 1024 * 2, (size_t)256 * FFE * 2, (size_t)256 * FFE * 2, (size_t)1024 * FFE * 2}; EpiMoeDown E{HB, tokt, wtt}; \
          pg8::gemm_phase<EpiMoeDown, SchedList, false>(ring, FFE, FFE, S, E, tokt); } \
        { SchedList S{slice ? 1 : 0, meta + 12, (const char*)(ws + WS_HIDM), (const char*)(ws + WS_WMOE) + (size_t)NE * 7168 * 1024 * 2, (size_t)256 * FFE * 2, (size_t)256 * FFE * 2, (size_t)1024 * FFE * 2}; EpiSlab E{(float*)(ws + WS_SLAB), meta + 12}; \
          pg8::gemm_phase<EpiSlab, SchedList, false>(ring, 896, FFE, S, E, tokt, FFE); } } SEAM(pd);
    MOE_PHASES(20, 21, 0)
    if (IN(22)) { const int np0 = ((const int*)(ws + WS_TAB + TB_NPAN))[0]; const int nrow = (np0 - 128) * 256; const float* slab = (const float*)(ws + WS_SLAB); const int* rowtok = (const int*)(ws + WS_ROWTOK); const float* roww = (const float*)(ws + WS_ROWW);
        for (long i = F.gt; i < (long)nrow * 128; i += F.NGT) { const int r = (int)(i >> 7), c8 = (int)(i & 127) * 8; const int tok = rowtok[TR + r];
            if (tok >= 0) { const float w = roww[TR + r]; f32x4 s0 = *(const f32x4*)(slab + (size_t)r * 1024 + c8), s1 = *(const f32x4*)(slab + (size_t)r * 1024 + c8 + 4);
#pragma unroll
                for (int sl = 1; sl < 4; ++sl) { s0 += *(const f32x4*)(slab + ((size_t)sl * 2048 + r) * 1024 + c8); s1 += *(const f32x4*)(slab + ((size_t)sl * 2048 + r) * 1024 + c8 + 4); }
                bf16* d = HB + (size_t)tok * 1024 + c8; f32x4 v0, v1; unpack8(*(const v4u*)d, v0, v1); *(v4u*)d = pack8(v0 + s0 * w, v1 + s1 * w); } } }
    MOE_PHASES(22, 23, 1)
    if (IN(24)) { LAS int* Lb = (LAS int*)(F.lds + TABL_OFF); const unsigned* ctl_ = (const unsigned*)(ws + WS_CTL);
        __syncthreads();
        if (F.tid == 0) { int acc = 0; for (int e = 0; e < 8; ++e) { Lb[e] = acc; acc += ((int)__hip_atomic_load(ctl_ + CW_CNT + 8 + e, RLX_AGENT) + 255) & ~255; } }
        __syncthreads();
        const int* tokinfo1 = (const int*)(ws + WS_TOKINFO) + (size_t)TR * 4; const float* slab = (const float*)(ws + WS_SLAB); const float* fg = in[I_FNORM]; const int lane = F.lane;
        const f32x4 g0 = *(const f32x4*)(fg + 8 * lane), g1 = *(const f32x4*)(fg + 8 * lane + 4), g2 = *(const f32x4*)(fg + 512 + 8 * lane), g3 = *(const f32x4*)(fg + 512 + 8 * lane + 4);
#define FIN_ROW(m, wa, wb) do { f32x4 v[4]; unpack8(wa, v[0], v[1]); unpack8(wb, v[2], v[3]); \
            { const v4u inf = *(const v4u*)(tokinfo1 + (size_t)(m) * 4); const unsigned ex = inf.x, ps = inf.y, wbits = inf.z; const int r1 = Lb[ex] + (int)ps - TR; \
              if (r1 >= 0) { const float w = __uint_as_float(wbits); \
                _Pragma("unroll") for (int sl = 0; sl < 4; ++sl) { const float* sp = slab + ((size_t)sl * 2048 + r1) * 1024; \
                    v[0] += *(const f32x4*)(sp + 8 * lane) * w; v[1] += *(const f32x4*)(sp + 8 * lane + 4) * w; v[2] += *(const f32x4*)(sp + 512 + 8 * lane) * w; v[3] += *(const f32x4*)(sp + 512 + 8 * lane + 4) * w; } } } \
            float s_ = 0.f; _Pragma("unroll") for (int j = 0; j < 4; ++j) s_ += (v[j].x * v[j].x + v[j].y * v[j].y) + (v[j].z * v[j].z + v[j].w * v[j].w); \
            const float rstd = 1.0f / sqrtf(wave_sum(s_) * (1.0f / 1024.0f) + EPS); float* orow = out + (size_t)(m) * 1024; \
            *(f32x4*)(orow + 8 * lane) = v[0] * rstd * g0; *(f32x4*)(orow + 8 * lane + 4) = v[1] * rstd * g1; *(f32x4*)(orow + 512 + 8 * lane) = v[2] * rstd * g2; *(f32x4*)(orow + 512 + 8 * lane + 4) = v[3] * rstd * g3; } while (0)
        for (int m = F.gw; m < TR / 2; m += F.NGW) { const v4u wa = *(const v4u*)(HB + (size_t)m * 1024 + 8 * lane), wb = *(const v4u*)(HB + (size_t)m * 1024 + 512 + 8 * lane); FIN_ROW(m, wa, wb); }
        v4u ra[8], rb[8];
        for (int base = TR / 2; base < TR; base += 8 * F.NGW) {
#pragma unroll
            for (int j = 0; j < 8; ++j) { const int m = base + F.gw + j * F.NGW; if (m < TR) { ra[j] = *(const v4u*)(HB + (size_t)m * 1024 + 8 * lane); rb[j] = *(const v4u*)(HB + (size_t)m * 1024 + 512 + 8 * lane); } }
            GRID_BAR();
#pragma unroll
            for (int j = 0; j < 8; ++j) { const int m = base + F.gw + j * F.NGW; if (m < TR) FIN_ROW(m, ra[j], rb[j]); }
        }
#undef FIN_ROW
    }
#undef IN
#undef SEAM
}

extern "C" void kernel_launch(void* const* d_in, const int* in_sizes, int n_in, void* d_out, int out_size, void* d_ws, size_t ws_size, hipStream_t stream) {
    static int grid = 0;
    if (grid == 0) {
        if (n_in != 38 || out_size != TR * D || ws_size < WS_END) { fprintf(stderr, "kernel_launch: unexpected problem shape (n_in %d, out %d, ws %zu); nothing launched\n", n_in, out_size, ws_size); grid = -1; return; }
        int dev = 0, cus = 0, per_cu = 0;
        if (hipGetDevice(&dev) != hipSuccess || hipDeviceGetAttribute(&cus, hipDeviceAttributeMultiprocessorCount, dev) != hipSuccess) { grid = -1; return; }
        if (hipFuncSetAttribute((const void*)mk_fwd, hipFuncAttributeMaxDynamicSharedMemorySize, LDS_BYTES) != hipSuccess) { fprintf(stderr, "kernel_launch: hipFuncSetAttribute failed\n"); grid = -1; return; }
        if (hipOccupancyMaxActiveBlocksPerMultiprocessor(&per_cu, (const void*)mk_fwd, 512, LDS_BYTES) != hipSuccess || per_cu < 1) fprintf(stderr, "kernel_launch: note: occupancy query reports %d workgroups per CU\n", per_cu);
        (void)hipGetLastError();
        grid = cus;
    }
    if (grid < 0) return;
    (void)hipMemsetAsync((char*)d_ws + WS_CTL, 0, CTL_ZERO_BYTES, stream);
    Args a{};
    for (int i = 0; i < 38; ++i) a.in[i] = (const float*)d_in[i];
    a.out = (float*)d_out; a.ws = (unsigned char*)d_ws; a.li = 0; a.pad = 0;
#if MK_PER_PHASE
    for (int k = 0; k < N_PHASES; ++k) { a.ph_lo = k; a.ph_hi = k + 1; hipLaunchKernelGGL(mk_fwd, dim3(grid), dim3(512), LDS_BYTES, stream, a); }
#else
    a.ph_lo = 0; a.ph_hi = N_PHASES; hipLaunchKernelGGL(mk_fwd, dim3(grid), dim3(512), LDS_BYTES, stream, a);
#endif
}
```

```cpp
#include <hip/hip_runtime.h>
#include <cstdio>
#include <cstdint>

#ifndef MK_PER_PHASE
#define MK_PER_PHASE 0
#endif

#define GAS __attribute__((address_space(1)))
#define LAS __attribute__((address_space(3)))
typedef unsigned short bf16;
typedef unsigned v4u __attribute__((ext_vector_type(4)));
typedef unsigned v2u __attribute__((ext_vector_type(2)));
typedef float f32x4 __attribute__((ext_vector_type(4)));
typedef float f32x2 __attribute__((ext_vector_type(2)));
typedef short bf16x8 __attribute__((ext_vector_type(8)));

constexpr int D = 1024, NB = 4, SEQ = 8192, NMETA = 16;
constexpr int TR = NB * SEQ;
constexpr int RM0 = TR;
constexpr int NPR = 128, NPA = 129;
constexpr int RALL = NPA * 256;
constexpr int LRUW = 1024, SSMW = 512, NG = 32, NS = 64, EV_IN = 2560, EV_MIX = 1536, FF0 = 3072;
constexpr int GK = 512, GV = 1024, GH = 4, GDK = 128, GDV = 256, OD_INP = 3584  , OD_IN = 3088;
constexpr int NE = 8, FFE = 3584, MROWS = 34816  , MPAN = 136;
constexpr float EPS = 1e-6f;
constexpr int NCH = 128;
constexpr int NSEG = 16, SEGC = 8;

constexpr size_t MiB = 1u << 20;
constexpr size_t WS_CTL = 0, CTL_ZERO_BYTES = 1 * MiB;
constexpr size_t WS_TAB = 1 * MiB;
constexpr size_t WS_WIN0 = 2 * MiB, WS_GW = 7 * MiB, WS_GLUW = 8 * MiB, WS_WOUT0 = 9 * MiB, WS_WUP0 = 12 * MiB, WS_WDN0 = 24 * MiB, WS_WIN1 = 30 * MiB, WS_WOUT1 = 37 * MiB;
constexpr size_t WS_PEND = 40 * MiB, WS_HEND = 42 * MiB, WS_CIN = 44 * MiB, WS_SSE = 46 * MiB, WS_SSIN = 54 * MiB, WS_GDS = 62 * MiB, WS_HMETA = 94 * MiB;
constexpr size_t WS_G = 96 * MiB, WS_U = 161 * MiB, WS_A = 194 * MiB, WS_XRBX = 323 * MiB, WS_HN = 388 * MiB, WS_AOUT = 388 * MiB, WS_XC = 453 * MiB, WS_GS = 485 * MiB;
constexpr size_t WS_HID0 = 96 * MiB;
constexpr size_t WS_WE = 62 * MiB;
constexpr size_t WS_Q = 96 * MiB, WS_K = 129 * MiB, WS_V = 162 * MiB, WS_GATE = 227 * MiB, WS_LG = 292 * MiB, WS_AOUT2 = 453 * MiB;
constexpr size_t WS_SLAB = 2 * MiB  , WS_HNM = 40 * MiB, WS_WMOE = 105 * MiB, WS_HIDM = 273 * MiB, WS_TOKINFO = 511 * MiB, WS_ROWTOK = 512 * MiB, WS_ROWW = 512 * MiB + 512 * 1024, WS_END = 513 * MiB;
constexpr size_t TB_BBR = 0, TB_BBI = 131072, TB_AR = 262144, TB_AI = 270336, TB_AR64 = 278528, TB_AI64 = 286720, TB_SP8 = 294912, TB_GAM = 299008  , TB_PEXP = 430080  , TB_NPAN = 432128;
constexpr int CW_TMO = 0, CW_CODE = 1, CW_CNT = 64  , CW_BAR = 4096;

constexpr int RING_OFF = 0, RING_BYTES = 131072;
constexpr int TABL_OFF = RING_BYTES, TABL_BYTES = 24576;
constexpr int MISC_OFF = TABL_OFF + TABL_BYTES;
constexpr int LDS_BYTES = MISC_OFF + 128;

#define RLX_AGENT __ATOMIC_RELAXED, __HIP_MEMORY_SCOPE_AGENT
#define LDS_WAIT() asm volatile("s_waitcnt lgkmcnt(0)" ::: "memory")
#define VM_WAIT() asm volatile("s_waitcnt vmcnt(0)" ::: "memory")
__device__ __forceinline__ unsigned f2bf(float f) { unsigned u = __builtin_bit_cast(unsigned, f); return (u + 0x7fffu + ((u >> 16) & 1u)) >> 16; }
__device__ __forceinline__ unsigned pk2(float lo, float hi) { return f2bf(lo) | (f2bf(hi) << 16); }
__device__ __forceinline__ float bf2f(unsigned b) { return __builtin_bit_cast(float, b << 16); }
__device__ __forceinline__ float bflo(unsigned w) { return __builtin_bit_cast(float, w << 16); }
__device__ __forceinline__ float bfhi(unsigned w) { return __builtin_bit_cast(float, w & 0xffff0000u); }
__device__ __forceinline__ float rcpf_(float x) { return __builtin_amdgcn_rcpf(x); }
__device__ __forceinline__ float sigmoidf_(float x) { return rcpf_(1.0f + __expf(-x)); }
__device__ __forceinline__ float siluf_(float x) { return x * rcpf_(1.0f + __expf(-x)); }
__device__ __forceinline__ float gelu_tanh(float x) { const float u = 0.7978845608028654f * (x + 0.044715f * x * x * x); return x * rcpf_(1.0f + __expf(-2.0f * u)); }
__device__ __forceinline__ float one_minus_exp(float x) { const float p = -x * (1.0f + 0.5f * x * (1.0f + (1.0f / 3.0f) * x * (1.0f + 0.25f * x * (1.0f + 0.2f * x * (1.0f + (1.0f / 6.0f) * x))))); return x > -0.25f ? p : 1.0f - __expf(x); }
__device__ __forceinline__ float logsigmoidf_(float x) { return fminf(x, 0.0f) - log1pf(__expf(-fabsf(x))); }
__device__ __forceinline__ float wave_sum(float v) {
#pragma unroll
    for (int o = 1; o < 64; o <<= 1) v += __shfl_xor(v, o);
    return v;
}

namespace pg8 {
constexpr int BM = 256, BK = 64, HALF = 128, HTB = HALF * BK * 2, STAGE_BYTES = 8 * HTB, NXCD = 8, WGM = 8;
__host__ __device__ __forceinline__ int lds_byte(int r, int c) { const int st = (r >> 4) * 2 + (c >> 5), rr = r & 15, cc = c & 31, ob = rr * 64 + cc * 2; return st * 1024 + (ob ^ (((ob >> 9) & 1) << 5)); }
__host__ __device__ __forceinline__ void stage_rc(int b, int& R, int& C) { const int st = b / 1024, sb = b % 1024, swz = sb ^ (((sb >> 9) & 1) << 5); R = (st >> 1) * 16 + swz / 64; C = (st & 1) * 32 + (swz % 64) / 2; }
__host__ __device__ __forceinline__ int perm32(int rho) { const int n = rho >> 4, i = rho & 15; return 8 * (i >> 2) + 4 * n + (i & 3); }

struct Unit { int pm, pn, slot; const char* a; const char* b; };
__device__ __forceinline__ bool static_tile(int i, int G, int c, int nM, int nN, int& pm, int& pn) {
    const int nwg = nM * nN; const long L = (long)i * G + c; if (L >= nwg) return false;
    int wgid = (int)L; { const int q = nwg / NXCD, r = nwg % NXCD, xcd = wgid % NXCD, off = wgid / NXCD; wgid = (xcd < r ? xcd * (q + 1) : r * (q + 1) + (xcd - r) * q) + off; }
    const int nig = WGM * nN, gid = wgid / nig, fm = gid * WGM, gsz = (nM - fm) < WGM ? (nM - fm) : WGM;
    pm = fm + ((wgid % nig) % gsz); pn = (wgid % nig) / gsz; return true;
}
__device__ __forceinline__ unsigned cvt_pk_bf16(float lo, float hi) { unsigned r; asm volatile("v_cvt_pk_bf16_f32 %0, %1, %2" : "=v"(r) : "v"(lo), "v"(hi)); return r; }

template <class Epi, class Sched, bool GATHER>
__device__ __forceinline__ void gemm_phase(LAS unsigned char* lds, const int K, const int lda, const Sched& S, const Epi& E, const LAS int* gtab, const int ldb_ = 0) {
    const int tid = threadIdx.x, wid = __builtin_amdgcn_readfirstlane(tid >> 6), lane = tid & 63, wr = wid >> 2, wc = wid & 3, fr = lane & 15, fq = lane >> 4;
    int nt = K / BK; asm volatile("" : "+s"(nt));
    int RA[2], CA[2]; unsigned voffB[2];
#pragma unroll
    for (int i = 0; i < 2; ++i) { int R, C; stage_rc(tid * 16 + i * 8192, R, C); const int Rb = Epi::PERM ? ((R & ~31) + perm32(R & 31)) : R;
        RA[i] = R; CA[i] = C; voffB[i] = (unsigned)(Rb * (ldb_ ? ldb_ : K) + C) * 2u; }
    const size_t kstep = (size_t)(BK * 2);
    const size_t hstepB = (size_t)HALF * (ldb_ ? ldb_ : K) * 2;
    const unsigned ldsw = (unsigned)wid * 1024u;
    const int aoff = lds_byte(wr * 64 + fr, fq * 8), boff = lds_byte(wc * 32 + fr, fq * 8);
    unsigned offC[2][2], offN[2][2];
#define PG8_SETOFF(dst, unit) do { _Pragma("unroll") for (int _h = 0; _h < 2; ++_h) _Pragma("unroll") for (int _i = 0; _i < 2; ++_i) { \
        if constexpr (GATHER) { int _t = gtab[(unit).slot * 256 + _h * HALF + RA[_i]]; _t = _t < 0 ? 0 : _t; dst[_h][_i] = ((unsigned)_t * (unsigned)lda + (unsigned)CA[_i]) * 2u; } \
        else dst[_h][_i] = ((unsigned)(_h * HALF + RA[_i]) * (unsigned)lda + (unsigned)CA[_i]) * 2u; } } while (0)
#define PG8_SA(b, h) (((b) * 2 + (h)) * HTB)
#define PG8_SB(b, h) ((4 + (b) * 2 + (h)) * HTB)
#define PG8_STAGEB(bufoff, gbase) do { _Pragma("unroll") for (int _i = 0; _i < 2; ++_i) \
        __builtin_amdgcn_global_load_lds((const unsigned*)((const char*)(gbase) + voffB[_i]), (LAS unsigned*)(lds + (bufoff) + ldsw + _i * 8192), 16, 0, 0); } while (0)
#define PG8_STAGEA(bufoff, gbase, o0, o1) do { \
        __builtin_amdgcn_global_load_lds((const unsigned*)((const char*)(gbase) + (o0)), (LAS unsigned*)(lds + (bufoff) + ldsw), 16, 0, 0); \
        __builtin_amdgcn_global_load_lds((const unsigned*)((const char*)(gbase) + (o1)), (LAS unsigned*)(lds + (bufoff) + ldsw + 8192), 16, 0, 0); } while (0)
#define PG8_LDA(dst, b, h) do { _Pragma("unroll") for (int m = 0; m < 4; ++m) _Pragma("unroll") for (int k = 0; k < 2; ++k) dst[m][k] = *(const LAS bf16x8*)(lds + PG8_SA(b, h) + aoff + m * 2048 + k * 1024); } while (0)
#define PG8_LDB(dst, b, h) do { _Pragma("unroll") for (int n = 0; n < 2; ++n) _Pragma("unroll") for (int k = 0; k < 2; ++k) dst[n][k] = *(const LAS bf16x8*)(lds + PG8_SB(b, h) + boff + n * 2048 + k * 1024); } while (0)
#define PG8_MMA(ai, bj, At, Bt) do { __builtin_amdgcn_s_setprio(1); _Pragma("unroll") for (int m = 0; m < 4; ++m) _Pragma("unroll") for (int n = 0; n < 2; ++n) _Pragma("unroll") for (int k = 0; k < 2; ++k) \
        acc[ai][bj][m][n] = __builtin_amdgcn_mfma_f32_16x16x32_bf16(Bt[n][k], At[m][k], acc[ai][bj][m][n], 0, 0, 0); __builtin_amdgcn_s_setprio(0); } while (0)
#define PG8_WAIT_V(n) asm volatile("s_waitcnt vmcnt(" #n ")" ::: "memory")
#define PG8_WAIT_L(n) asm volatile("s_waitcnt lgkmcnt(" #n ")" ::: "memory")
#define PG8_BAR __builtin_amdgcn_s_barrier()
#define PG8_SCHED __builtin_amdgcn_sched_barrier(0)
    Unit cur, nxt; int ui = 0;
    if (!S.next(0, cur)) return;
    f32x4 acc[2][2][4][2];
#pragma unroll
    for (int a = 0; a < 2; ++a)
#pragma unroll
        for (int b = 0; b < 2; ++b)
#pragma unroll
            for (int m = 0; m < 4; ++m)
#pragma unroll
                for (int n = 0; n < 2; ++n) acc[a][b][m][n] = (f32x4){0.f, 0.f, 0.f, 0.f};
    bf16x8 At[4][2], B0[2][2], B1[2][2];
    const char* cA = cur.a; const char* cB = cur.b;
    PG8_SETOFF(offC, cur);
    PG8_STAGEB(PG8_SB(0, 0), cB); PG8_STAGEB(PG8_SB(0, 1), cB + hstepB); PG8_STAGEA(PG8_SA(0, 0), cA, offC[0][0], offC[0][1]); PG8_STAGEA(PG8_SA(0, 1), cA, offC[1][0], offC[1][1]);
    if (wr == 1) PG8_BAR;
    PG8_WAIT_V(2); PG8_BAR;
    PG8_STAGEB(PG8_SB(1, 0), cB + kstep); PG8_STAGEA(PG8_SA(1, 0), cA + kstep, offC[0][0], offC[0][1]); PG8_STAGEB(PG8_SB(1, 1), cB + hstepB + kstep);
    PG8_WAIT_V(6); PG8_BAR;
    for (;;) {
        const bool has_next = S.next(ui + 1, nxt);
        const char* nA = has_next ? nxt.a : cA; const char* nB = has_next ? nxt.b : cB;
        if constexpr (GATHER) {
#pragma unroll
        for (int h = 0; h < 2; ++h)
#pragma unroll
            for (int i = 0; i < 2; ++i) offN[h][i] = offC[h][i]; }
        for (int t = 0; t < nt; t += 2) {
            const bool last = (t == nt - 2);
            const char* a1 = cA + (size_t)(t + 1) * kstep;
            const char* a2 = last ? nA : cA + (size_t)(t + 2) * kstep; const char* b2 = last ? nB : cB + (size_t)(t + 2) * kstep;
            const char* a3 = a2 + kstep; const char* b3 = b2 + kstep;
            if constexpr (GATHER) { if (last && has_next) PG8_SETOFF(offN, nxt); }
            unsigned q00 = offC[0][0], q01 = offC[0][1], q10 = offC[1][0], q11 = offC[1][1];
            if constexpr (GATHER) { q00 = last ? offN[0][0] : q00; q01 = last ? offN[0][1] : q01; q10 = last ? offN[1][0] : q10; q11 = last ? offN[1][1] : q11; }
            PG8_LDB(B0, 0, 0); PG8_LDB(B1, 0, 1); PG8_SCHED; PG8_LDA(At, 0, 0); PG8_STAGEA(PG8_SA(1, 1), a1, offC[1][0], offC[1][1]);
            PG8_WAIT_V(8); PG8_WAIT_L(0); PG8_BAR; PG8_MMA(0, 0, At, B0); PG8_MMA(0, 1, At, B1); PG8_BAR; PG8_SCHED;
            PG8_LDA(At, 0, 1); PG8_STAGEB(PG8_SB(0, 0), b2); PG8_STAGEB(PG8_SB(0, 1), b2 + hstepB); PG8_STAGEA(PG8_SA(0, 0), a2, q00, q01);
            PG8_WAIT_V(8); PG8_WAIT_L(0); PG8_BAR; PG8_MMA(1, 0, At, B0); PG8_MMA(1, 1, At, B1); PG8_BAR; PG8_SCHED;
            PG8_LDB(B0, 1, 0); PG8_LDB(B1, 1, 1); PG8_SCHED; PG8_LDA(At, 1, 0); PG8_STAGEA(PG8_SA(0, 1), a2, q10, q11);
            PG8_WAIT_V(8); PG8_WAIT_L(0); PG8_BAR; PG8_MMA(0, 0, At, B0); PG8_MMA(0, 1, At, B1); PG8_BAR; PG8_SCHED;
            PG8_LDA(At, 1, 1); PG8_STAGEB(PG8_SB(1, 0), b3); PG8_STAGEB(PG8_SB(1, 1), b3 + hstepB); PG8_STAGEA(PG8_SA(1, 0), a3, q00, q01);
            PG8_WAIT_V(8); PG8_WAIT_L(0); PG8_BAR; PG8_MMA(1, 0, At, B0); PG8_MMA(1, 1, At, B1); PG8_BAR; PG8_SCHED;
        }
        if (wr == 0) PG8_BAR;
        E(acc, cur, wr, wc, fr, fq);
        if (!has_next) break;
#pragma unroll
        for (int a = 0; a < 2; ++a)
#pragma unroll
            for (int b = 0; b < 2; ++b)
#pragma unroll
                for (int m = 0; m < 4; ++m)
#pragma unroll
                    for (int n = 0; n < 2; ++n) acc[a][b][m][n] = (f32x4){0.f, 0.f, 0.f, 0.f};
        cur = nxt; cA = nA; cB = nB; ++ui;
        if constexpr (GATHER) {
#pragma unroll
        for (int h = 0; h < 2; ++h)
#pragma unroll
            for (int i = 0; i < 2; ++i) offC[h][i] = offN[h][i]; }
        if (wr == 1) PG8_BAR;
    }
    PG8_WAIT_V(0);
    PG8_BAR;
#undef PG8_SETOFF
#undef PG8_SA
#undef PG8_SB
#undef PG8_STAGEA
#undef PG8_STAGEB
#undef PG8_LDA
#undef PG8_LDB
#undef PG8_MMA
#undef PG8_WAIT_V
#undef PG8_WAIT_L
#undef PG8_BAR
#undef PG8_SCHED
}
}

#define XB_TMO      128
#define XB_XCNT(j)  (256  + 64 * (j))
#define XB_XSUB(j)  (1280 + 64 * (j))
#define XB_XGEN(j)  (2304 + 64 * (j))
#define XB_TOP      3328
#define XB_TOPGEN   3392
#define XCD_BAR_WORDS 3456
#define XB_SPIN_CAP (1u << 18)
__device__ __forceinline__ unsigned xb_ld(unsigned* p)              { return __hip_atomic_load(p, __ATOMIC_RELAXED, __HIP_MEMORY_SCOPE_AGENT); }
__device__ __forceinline__ unsigned xb_add(unsigned* p, unsigned v) { return __hip_atomic_fetch_add(p, v, __ATOMIC_RELAXED, __HIP_MEMORY_SCOPE_AGENT); }
__device__ __forceinline__ unsigned xb_xcc_id() { return (unsigned)__builtin_amdgcn_s_getreg((3 << 11) | 20) & 0xFu; }
#define XB_SPIN(cond, bar) do { unsigned _sp = 0; while (cond) { __builtin_amdgcn_s_sleep(1); \
    if ((++_sp & 255u) == 0u) { if (xb_ld(&(bar)[XB_TMO])) break; if (_sp > XB_SPIN_CAP) { atomicAdd(&(bar)[XB_TMO], 1u); break; } } } } while (0)
struct XcdBarrier { unsigned* bar; unsigned x; volatile LAS unsigned* st; };
__device__ __forceinline__ XcdBarrier xcd_barrier_post(unsigned* bar, volatile LAS unsigned* st) {
    XcdBarrier b; b.bar = bar; b.x = xb_xcc_id(); b.st = st;
    if (threadIdx.x == 0) (void)xb_add(&bar[XB_XCNT(b.x)], 1u);
    return b;
}
__device__ __forceinline__ void xcd_barrier_complete(unsigned* bar, unsigned x, unsigned& nloc, unsigned& nx) {
    const unsigned G = gridDim.x * gridDim.y * gridDim.z;
    unsigned sum, cnt, mine, sp = 0u;
    for (;;) {
        sum = 0u; cnt = 0u; mine = 0u;
#pragma unroll
        for (unsigned j = 0; j < 16; ++j) { const unsigned c = xb_ld(&bar[XB_XCNT(j)]); sum += c; cnt += (c > 0u) ? 1u : 0u; mine = (j == x) ? c : mine; }
        if (sum == G) break;
        __builtin_amdgcn_s_sleep(1);
        if ((++sp & 255u) == 0u) { if (xb_ld(&bar[XB_TMO])) break; if (sp > XB_SPIN_CAP) { atomicAdd(&bar[XB_TMO], 1u); break; } }
    }
    nloc = mine > 0u ? mine : 1u; nx = cnt > 0u ? cnt : 1u;
}
__device__ __forceinline__ void xcd_barrier(const XcdBarrier& b) {
    asm volatile("s_waitcnt vmcnt(0)" ::: "memory");
    __syncthreads();
    if (threadIdx.x == 0) {
        unsigned* bar = b.bar;
        __builtin_amdgcn_s_waitcnt(0);
        unsigned nloc = b.st[0], nx = b.st[1];
        if (nloc == 0u) { xcd_barrier_complete(bar, b.x, nloc, nx); b.st[0] = nloc; b.st[1] = nx; }
        const unsigned old = xb_add(&bar[XB_XSUB(b.x)], 1u);
        const unsigned gen = old / nloc;
        if (old + 1u == (gen + 1u) * nloc) {
            __builtin_amdgcn_fence(__ATOMIC_RELEASE, "agent");
            asm volatile("s_waitcnt vmcnt(0)" ::: "memory");
            const unsigned og = xb_add(&bar[XB_TOP], 1u);
            const unsigned tg = og / nx;
            if (og + 1u == (tg + 1u) * nx) xb_add(&bar[XB_TOPGEN], 1u);
            else XB_SPIN(xb_ld(&bar[XB_TOPGEN]) == tg, bar);
            __builtin_amdgcn_fence(__ATOMIC_ACQUIRE, "agent");
            xb_add(&bar[XB_XGEN(b.x)], 1u);
            asm volatile("s_waitcnt vmcnt(0)" ::: "memory");
        } else {
            XB_SPIN(xb_ld(&bar[XB_XGEN(b.x)]) == gen, bar);
            __builtin_amdgcn_fence(__ATOMIC_ACQUIRE, "agent");
            asm volatile("s_waitcnt vmcnt(0)" ::: "memory");
        }
    }
    __syncthreads();
}

struct Args { const float* in[38]; float* out; unsigned char* ws; int ph_lo, ph_hi, li, pad; };
struct Frame {
    LAS unsigned char* lds;
    int tid, lane, wave, G, gw, NGW;
    int gt, NGT;
};
enum { I_X = 0, I_META, I_NORM_MIX0, I_WIN0, I_CONVW, I_CONVB, I_GAW, I_GAB, I_GXW, I_GXB, I_LAM, I_LRE, I_LIM, I_LDT, I_BRE, I_BIM, I_CRE, I_CIM, I_SD, I_GLUW, I_GLUB, I_WOUT0, I_NORM_FFN0,
       I_FG, I_FU, I_FD, I_NORM_MIX1, I_WIN1, I_GW2, I_GB, I_GNORM, I_WOUT1, I_NORM_FFN1, I_ROUTER, I_MG, I_MU, I_MD, I_FNORM };

struct SchedStatic {
    int nM, nN, G, c; const char* A; const char* B; size_t aStep, bStep; int aColDiv; size_t aColStep;
    __device__ __forceinline__ bool next(int i, pg8::Unit& u) const {
        int pm, pn; if (!pg8::static_tile(i, G, c, nM, nN, pm, pn)) return false;
        u.pm = pm; u.pn = pn; u.slot = i; u.a = A + (size_t)pm * aStep + (aColDiv ? (size_t)(pn / aColDiv) * aColStep : 0); u.b = B + (size_t)pn * bStep; return true;
    }
};
struct SchedList {
    int n; const LAS int* meta; const char* A; const char* B; size_t aStep, bTile, bExpert;
    __device__ __forceinline__ bool next(int i, pg8::Unit& u) const {
        if (i >= n) return false;
        const int pm = meta[i * 4 + 0], pn = meta[i * 4 + 1], e = meta[i * 4 + 2];
        u.pm = pm; u.pn = pn; u.slot = i; const int ko = meta[i * 4 + 3]; u.a = A + (size_t)pm * aStep + (size_t)ko * 2; u.b = B + (size_t)e * bExpert + (size_t)pn * bTile + (size_t)ko * 2; return true;
    }
};

#define EPI_ROWS(ai, m) ((ai) * 128 + wr * 64 + (m) * 16 + fr)
#define EPI_COLP(bj) ((bj) * 128 + wc * 32 + 8 * fq)
#define EPI_COLN(bj, n) ((bj) * 128 + wc * 32 + 16 * (n) + 4 * fq)
typedef const f32x4 (&AccRef)[2][2][4][2];
__device__ __forceinline__ void unpack8(v4u w, f32x4& a, f32x4& b) { a = (f32x4){bflo(w.x), bfhi(w.x), bflo(w.y), bfhi(w.y)}; b = (f32x4){bflo(w.z), bfhi(w.z), bflo(w.w), bfhi(w.w)}; }
__device__ __forceinline__ v4u pack8(f32x4 a, f32x4 b) { v4u w; w.x = pg8::cvt_pk_bf16(a[0], a[1]); w.y = pg8::cvt_pk_bf16(a[2], a[3]); w.z = pg8::cvt_pk_bf16(b[0], b[1]); w.w = pg8::cvt_pk_bf16(b[2], b[3]); return w; }

struct EpiWin0 {
    static constexpr bool PERM = true; bf16 *G, *XR, *U;
    __device__ __forceinline__ void operator()(AccRef acc, const pg8::Unit& u, int wr, int wc, int fr, int fq) const {
        const int pn = u.pn; bf16* base; int ld, c0;
        if (pn < 4) { base = G; ld = 1024; c0 = pn * 256; } else if (pn < 8) { base = XR; ld = 1024; c0 = (pn - 4) * 256; } else { base = U; ld = 512; c0 = (pn - 8) * 256; }
#pragma unroll
        for (int ai = 0; ai < 2; ++ai)
#pragma unroll
            for (int m = 0; m < 4; ++m) { bf16* rowp = base + (size_t)(u.pm * 256 + EPI_ROWS(ai, m)) * ld + c0;
#pragma unroll
                for (int bj = 0; bj < 2; ++bj) { f32x4 v0 = acc[ai][bj][m][0], v1 = acc[ai][bj][m][1];
                    if (pn < 4) {
#pragma unroll
                        for (int j = 0; j < 4; ++j) { v0[j] = gelu_tanh(v0[j]); v1[j] = gelu_tanh(v1[j]); } }
                    *(v4u*)(rowp + EPI_COLP(bj)) = pack8(v0, v1); } }
    }
};
struct EpiGates {
    static constexpr bool PERM = true; const float *gab, *gxb, *sp8; const bf16* XC; bf16* A; bf16* BX;
    __device__ __forceinline__ void operator()(AccRef acc, const pg8::Unit& u, int wr, int wc, int fr, int fq) const {
        const int ch0 = (u.pn >> 1) * 256 + (u.pn & 1) * 128 + wc * 32 + 8 * fq;
        f32x4 ba[2], bx[2], sp[2];
#pragma unroll
        for (int n = 0; n < 2; ++n) { ba[n] = *(const f32x4*)(gab + ch0 + 4 * n); bx[n] = *(const f32x4*)(gxb + ch0 + 4 * n); sp[n] = *(const f32x4*)(sp8 + ch0 + 4 * n); }
#pragma unroll
        for (int ai = 0; ai < 2; ++ai)
#pragma unroll
            for (int m = 0; m < 4; ++m) { const size_t ro = (size_t)(u.pm * 256 + EPI_ROWS(ai, m)) * 1024 + ch0;
                const v4u xw = *(const v4u*)(XC + ro); const float xv[8] = {bflo(xw.x), bfhi(xw.x), bflo(xw.y), bfhi(xw.y), bflo(xw.z), bfhi(xw.z), bflo(xw.w), bfhi(xw.w)};
                f32x4 av[2], bv[2];
#pragma unroll
                for (int n = 0; n < 2; ++n)
#pragma unroll
                    for (int j = 0; j < 4; ++j) { const float r = sigmoidf_(acc[ai][0][m][n][j] + ba[n][j]), ig = sigmoidf_(acc[ai][1][m][n][j] + bx[n][j]);
                        const float la = -r * sp[n][j], aa = __expf(la); av[n][j] = la; bv[n][j] = __builtin_amdgcn_sqrtf(fmaxf(__builtin_fmaf(-aa, aa, 1.0f), 0.0f)) * ig * xv[4 * n + j]; }
                *(v4u*)(A + ro) = pack8(av[0], av[1]); *(v4u*)(BX + ro) = pack8(bv[0], bv[1]); asm volatile("" ::: "memory"); }
    }
};
struct EpiGlu {
    static constexpr bool PERM = true; const float* glub; const bf16* GS; bf16* AOUT;
    __device__ __forceinline__ void operator()(AccRef acc, const pg8::Unit& u, int wr, int wc, int fr, int fq) const {
#pragma unroll
        for (int bj = 0; bj < 2; ++bj) { const int c = u.pn * 256 + EPI_COLP(bj); const f32x4 b0 = *(const f32x4*)(glub + c), b1 = *(const f32x4*)(glub + c + 4);
#pragma unroll
            for (int ai = 0; ai < 2; ++ai)
#pragma unroll
                for (int m = 0; m < 4; ++m) { const size_t row = (size_t)(u.pm * 256 + EPI_ROWS(ai, m));
                    const v4u gw = *(const v4u*)(GS + row * 512 + c); const float gv[8] = {bflo(gw.x), bfhi(gw.x), bflo(gw.y), bfhi(gw.y), bflo(gw.z), bfhi(gw.z), bflo(gw.w), bfhi(gw.w)};
                    f32x4 v0, v1;
#pragma unroll
                    for (int j = 0; j < 4; ++j) { v0[j] = gv[j] * sigmoidf_(acc[ai][bj][m][0][j] + b0[j]); v1[j] = gv[4 + j] * sigmoidf_(acc[ai][bj][m][1][j] + b1[j]); }
                    *(v4u*)(AOUT + row * 1536 + 1024 + c) = pack8(v0, v1); } }
    }
};
struct EpiResid {
    static constexpr bool PERM = true; const float* xsrc; bf16* hb;
    __device__ __forceinline__ void operator()(AccRef acc, const pg8::Unit& u, int wr, int wc, int fr, int fq) const {
#pragma unroll
        for (int ai = 0; ai < 2; ++ai)
#pragma unroll
            for (int m = 0; m < 4; ++m) { const size_t ro = (size_t)(u.pm * 256 + EPI_ROWS(ai, m)) * 1024 + u.pn * 256;
#pragma unroll
                for (int bj = 0; bj < 2; ++bj) { const size_t o = ro + EPI_COLP(bj); f32x4 v0, v1;
                    if (xsrc) { v0 = *(const f32x4*)(xsrc + o); v1 = *(const f32x4*)(xsrc + o + 4); } else unpack8(*(const v4u*)(hb + o), v0, v1);
                    *(v4u*)(hb + o) = pack8(v0 + acc[ai][bj][m][0], v1 + acc[ai][bj][m][1]); } }
    }
};
struct EpiSwiglu {
    static constexpr bool PERM = true; bf16* H; int ld;
    __device__ __forceinline__ void operator()(AccRef acc, const pg8::Unit& u, int wr, int wc, int fr, int fq) const {
        const int c = u.pn * 128 + wc * 32 + 8 * fq;
#pragma unroll
        for (int ai = 0; ai < 2; ++ai)
#pragma unroll
            for (int m = 0; m < 4; ++m) { f32x4 v0, v1;
#pragma unroll
                for (int j = 0; j < 4; ++j) { v0[j] = siluf_(acc[ai][0][m][0][j]) * acc[ai][1][m][0][j]; v1[j] = siluf_(acc[ai][0][m][1][j]) * acc[ai][1][m][1][j]; }
                *(v4u*)(H + (size_t)(u.pm * 256 + EPI_ROWS(ai, m)) * ld + c) = pack8(v0, v1); }
    }
};
struct EpiWin1 {
    static constexpr bool PERM = true; bf16 *Q, *K, *V, *GATE; float* LG; const float* gb;
    __device__ __forceinline__ void operator()(AccRef acc, const pg8::Unit& u, int wr, int wc, int fr, int fq) const {
        const int pn = u.pn;
#pragma unroll
        for (int ai = 0; ai < 2; ++ai)
#pragma unroll
            for (int m = 0; m < 4; ++m) { const size_t row = (size_t)(u.pm * 256 + EPI_ROWS(ai, m));
#pragma unroll
                for (int bj = 0; bj < 2; ++bj) { f32x4 v0 = acc[ai][bj][m][0], v1 = acc[ai][bj][m][1]; const int cc = EPI_COLP(bj);
                    if (pn < 2) { v0 = v0 * 0.08838834764831845f; v1 = v1 * 0.08838834764831845f; *(v4u*)(Q + row * 512 + pn * 256 + cc) = pack8(v0, v1); }
                    else if (pn < 4) { *(v4u*)(K + row * 512 + (pn - 2) * 256 + cc) = pack8(v0, v1); }
                    else if (pn < 8) { *(v4u*)(V + row * 1024 + (pn - 4) * 256 + cc) = pack8(v0, v1); }
                    else if (pn < 12) {
#pragma unroll
                        for (int j = 0; j < 4; ++j) { v0[j] = siluf_(v0[j]); v1[j] = siluf_(v1[j]); }
                        *(v4u*)(GATE + row * 1024 + (pn - 8) * 256 + cc) = pack8(v0, v1); }
                    else { const int c = (pn - 12) * 256 + cc; const f32x4 b0 = *(const f32x4*)(gb + c), b1 = *(const f32x4*)(gb + c + 4);
#pragma unroll
                        for (int j = 0; j < 4; ++j) { v0[j] = logsigmoidf_(v0[j] + b0[j]) * 0.0625f; v1[j] = logsigmoidf_(v1[j] + b1[j]) * 0.0625f; }
                        *(f32x4*)(LG + row * 512 + c) = v0; *(f32x4*)(LG + row * 512 + c + 4) = v1; } } }
    }
};
struct EpiMoeDown {
    static constexpr bool PERM = true; bf16* hb; const LAS int* toks; const LAS float* wts;
    __device__ __forceinline__ void operator()(AccRef acc, const pg8::Unit& u, int wr, int wc, int fr, int fq) const {
#pragma unroll
        for (int ai = 0; ai < 2; ++ai)
#pragma unroll
            for (int m = 0; m < 4; ++m) { const int rl = u.slot * 256 + EPI_ROWS(ai, m); const int tok = toks[rl]; const float w = wts[rl];
                if (tok >= 0) { bf16* d = hb + (size_t)tok * 1024 + u.pn * 256;
#pragma unroll
                    for (int bj = 0; bj < 2; ++bj) { bf16* p = d + EPI_COLP(bj); f32x4 v0, v1; unpack8(*(const v4u*)p, v0, v1); *(v4u*)p = pack8(v0 + acc[ai][bj][m][0] * w, v1 + acc[ai][bj][m][1] * w); } } }
    }
};
struct EpiSlab {
    static constexpr bool PERM = false; float* slab; const LAS int* meta;
    __device__ __forceinline__ void operator()(AccRef acc, const pg8::Unit& u, int wr, int wc, int fr, int fq) const {
        const int sl = meta[u.slot * 4 + 3] / 896; float* base = slab + ((size_t)(sl * 8 + (u.pm - 128)) * 256) * 1024 + u.pn * 256;
#pragma unroll
        for (int ai = 0; ai < 2; ++ai)
#pragma unroll
            for (int m = 0; m < 4; ++m) { float* d = base + (size_t)EPI_ROWS(ai, m) * 1024;
#pragma unroll
                for (int bj = 0; bj < 2; ++bj)
#pragma unroll
                    for (int n = 0; n < 2; ++n) *(f32x4*)(d + EPI_COLN(bj, n)) = acc[ai][bj][m][n]; }
    }
};

__device__ __forceinline__ void tr_item(const float* W, int ldw, int col, int k0, bf16* WT, int ldt, int drow, LAS float* scr, int lane) {
#pragma unroll 8
    for (int i = 0; i < 32; ++i) { const int kk = 2 * i + (lane >> 5); scr[kk * 33 + (lane & 31)] = W[(size_t)(k0 + kk) * ldw + col + (lane & 31)]; }
    LDS_WAIT(); asm volatile("" ::: "memory");
    const int c = lane & 7;
#pragma unroll
    for (int j = 0; j < 4; ++j) { const int n = (lane >> 3) + 8 * j; const LAS float* s = scr + (8 * c) * 33 + n;
        v4u o; o.x = pk2(s[0 * 33], s[1 * 33]); o.y = pk2(s[2 * 33], s[3 * 33]); o.z = pk2(s[4 * 33], s[5 * 33]); o.w = pk2(s[6 * 33], s[7 * 33]);
        *(v4u*)(WT + (size_t)(drow + n) * ldt + k0 + 8 * c) = o; }
    LDS_WAIT(); asm volatile("" ::: "memory");
}
struct TrJob { const float* W; int ldw, col0, K, N; bf16* WT; int blk, bstride, add; };
__device__ __forceinline__ bool tr_try(int& r, const TrJob& j, LAS float* scr, int lane) {
    const int nblk = j.N / 32, items = (j.K / 64) * nblk;
    if (r >= items) { r -= items; return false; }
    const int kb = r / nblk, n0 = (r % nblk) * 32;
    tr_item(j.W, j.ldw, j.col0 + n0, kb * 64, j.WT, j.K, (n0 / j.blk) * j.bstride + (n0 % j.blk) + j.add, scr, lane);
    return true;
}
__device__ __forceinline__ void norm_row_bf16(const float* xrow, const float* gain, bf16* orow, int lane) {
    const f32x4* xr = (const f32x4*)xrow + lane; const f32x4* gr = (const f32x4*)gain + lane;
    f32x4 v[4]; float s = 0.f;
#pragma unroll
    for (int j = 0; j < 4; ++j) { v[j] = xr[64 * j]; s += (v[j].x * v[j].x + v[j].y * v[j].y) + (v[j].z * v[j].z + v[j].w * v[j].w); }
    const float rstd = 1.0f / sqrtf(wave_sum(s) * (1.0f / 1024.0f) + EPS);
    v2u* o8 = (v2u*)orow + lane;
#pragma unroll
    for (int j = 0; j < 4; ++j) { const f32x4 g = gr[64 * j]; v2u w; w.x = pk2(v[j].x * rstd * g.x, v[j].y * rstd * g.y); w.y = pk2(v[j].z * rstd * g.z, v[j].w * rstd * g.w); o8[64 * j] = w; }
}
__device__ __forceinline__ void norm_row_b2b(const bf16* hrow, const float* gain, bf16* orow, int lane) {
    f32x4 v[4]; unpack8(*(const v4u*)(hrow + 8 * lane), v[0], v[1]); unpack8(*(const v4u*)(hrow + 512 + 8 * lane), v[2], v[3]); float s = 0.f;
#pragma unroll
    for (int j = 0; j < 4; ++j) s += (v[j].x * v[j].x + v[j].y * v[j].y) + (v[j].z * v[j].z + v[j].w * v[j].w);
    const float rstd = 1.0f / sqrtf(wave_sum(s) * (1.0f / 1024.0f) + EPS);
    const f32x4 g0 = *(const f32x4*)(gain + 8 * lane), g1 = *(const f32x4*)(gain + 8 * lane + 4), g2 = *(const f32x4*)(gain + 512 + 8 * lane), g3 = *(const f32x4*)(gain + 512 + 8 * lane + 4);
    *(v4u*)(orow + 8 * lane) = pack8(v[0] * rstd * g0, v[1] * rstd * g1); *(v4u*)(orow + 512 + 8 * lane) = pack8(v[2] * rstd * g2, v[3] * rstd * g3);
}

__device__ __forceinline__ void p0_prologue(const Frame& F, const Args& a, unsigned char* ws) {
    LAS float* scr = (LAS float*)(F.lds + RING_OFF + F.wave * 16384);
    const float* const* in = a.in;
    constexpr int BIG = 1 << 30;
    for (int it = F.gw; ; it += F.NGW) {
        int r = it;
        { TrJob j{in[I_WIN0], EV_IN, 0, 1024, EV_IN, (bf16*)(ws + WS_WIN0), BIG, 0, 0}; if (tr_try(r, j, scr, F.lane)) continue; }
        bool done = false;
        for (int h = 0; h < 4 && !done; ++h) {
            { TrJob j{in[I_GAW] + (size_t)h * 65536, 256, 0, 256, 256, (bf16*)(ws + WS_GW) + (size_t)h * 512 * 256, 128, 256, 0}; if (tr_try(r, j, scr, F.lane)) { done = true; break; } }
            { TrJob j{in[I_GXW] + (size_t)h * 65536, 256, 0, 256, 256, (bf16*)(ws + WS_GW) + (size_t)h * 512 * 256, 128, 256, 128}; if (tr_try(r, j, scr, F.lane)) { done = true; break; } }
        }
        if (done) continue;
        { TrJob j{in[I_GLUW], 512, 0, 512, 512, (bf16*)(ws + WS_GLUW), BIG, 0, 0}; if (tr_try(r, j, scr, F.lane)) continue; }
        { TrJob j{in[I_WOUT0], 1024, 0, EV_MIX, 1024, (bf16*)(ws + WS_WOUT0), BIG, 0, 0}; if (tr_try(r, j, scr, F.lane)) continue; }
        { TrJob j{in[I_FG], FF0, 0, 1024, FF0, (bf16*)(ws + WS_WUP0), 128, 256, 0}; if (tr_try(r, j, scr, F.lane)) continue; }
        { TrJob j{in[I_FU], FF0, 0, 1024, FF0, (bf16*)(ws + WS_WUP0), 128, 256, 128}; if (tr_try(r, j, scr, F.lane)) continue; }
        { TrJob j{in[I_FD], 1024, 0, FF0, 1024, (bf16*)(ws + WS_WDN0), BIG, 0, 0}; if (tr_try(r, j, scr, F.lane)) continue; }
        { TrJob j{in[I_WIN1], OD_IN, 0, 1024, 3072, (bf16*)(ws + WS_WIN1), BIG, 0, 0}; if (tr_try(r, j, scr, F.lane)) continue; }
        { TrJob j{in[I_WOUT1], 1024, 0, 1024, 1024, (bf16*)(ws + WS_WOUT1), BIG, 0, 0}; if (tr_try(r, j, scr, F.lane)) continue; }
        break;
    }
    for (long i = F.gt; i < 512L * 1024; i += F.NGT) { const int j = (int)(i >> 10), k = (int)(i & 1023); const float* wr_ = in[I_WIN1] + (size_t)k * OD_IN + 3072; const float* w2 = in[I_GW2] + j; float s = 0.f;
#pragma unroll
        for (int r = 0; r < 16; ++r) s += wr_[r] * w2[r * 512];
        ((bf16*)(ws + WS_WIN1))[(size_t)(3072 + j) * 1024 + k] = (bf16)f2bf(s); }
    float* tab = (float*)(ws + WS_TAB);
    for (long i = F.gt; i < NG * NS; i += F.NGT) { const int g = (int)i / NS;
        const double lr = in[I_LRE][i], li = in[I_LIM][i], dt = exp((double)in[I_LDT][g]);
        const double mag = exp(dt * lr), ar = mag * cos(dt * li), ai = mag * sin(dt * li), den = lr * lr + li * li, nr = ar - 1.0;
        const double zr = (nr * lr + ai * li) / den, zi = (ai * lr - nr * li) / den;
        const double m64 = exp(64.0 * dt * lr);
        ((float*)((char*)tab + TB_AR))[i] = (float)ar; ((float*)((char*)tab + TB_AI))[i] = (float)ai;
        ((float*)((char*)tab + TB_AR64))[i] = (float)(m64 * cos(64.0 * dt * li)); ((float*)((char*)tab + TB_AI64))[i] = (float)(m64 * sin(64.0 * dt * li));
        for (int h = 0; h < 16; ++h) { const double br = in[I_BRE][i * 16 + h], bi = in[I_BIM][i * 16 + h];
            ((float*)((char*)tab + TB_BBR))[i * 16 + h] = (float)(zr * br - zi * bi); ((float*)((char*)tab + TB_BBI))[i * 16 + h] = (float)(zr * bi + zi * br); } }
    for (long idx = F.gt; idx < (long)NG * NS * 64; idx += F.NGT) { const int i = (int)(idx & 63), gn = (int)(idx >> 6), g = gn / NS, n = gn % NS;
        const double lr = in[I_LRE][gn], li = in[I_LIM][gn], dt = exp((double)in[I_LDT][g]);
        const double mag1 = exp(dt * lr), ar1 = mag1 * cos(dt * li), ai1 = mag1 * sin(dt * li), den = lr * lr + li * li, nr1 = ar1 - 1.0;
        const double zr = (nr1 * lr + ai1 * li) / den, zi = (ai1 * lr - nr1 * li) / den;
        const double pw = (double)(63 - i), pm = exp(pw * dt * lr), pr = pm * cos(pw * dt * li), pi_ = pm * sin(pw * dt * li);
        bf16* wre = (bf16*)(ws + WS_WE) + ((size_t)g * 128 + 2 * n) * 1024 + i * 16; bf16* wim = wre + 1024;
        for (int h = 0; h < 16; ++h) { const double br = in[I_BRE][(size_t)gn * 16 + h], bi = in[I_BIM][(size_t)gn * 16 + h]; const double bbr = zr * br - zi * bi, bbi = zr * bi + zi * br;
            wre[h] = (bf16)f2bf((float)(pr * bbr - pi_ * bbi)); wim[h] = (bf16)f2bf((float)(pr * bbi + pi_ * bbr)); } }
    for (long i = F.gt; i < 1024; i += F.NGT) { const float lam = in[I_LAM][i]; ((float*)((char*)tab + TB_SP8))[i] = 8.0f * log1pf(expf(-lam)); }
    bf16* HN = (bf16*)(ws + WS_HN); float* hmeta = (float*)(ws + WS_HMETA);
    { const float* gain0 = in[I_NORM_MIX0]; const int lane = F.lane; f32x4 gg[4];
#pragma unroll
      for (int j = 0; j < 4; ++j) gg[j] = ((const f32x4*)gain0)[lane + 64 * j];
      for (int m = F.gw; m < TR; m += 4 * F.NGW) { f32x4 xv[4][4];
#pragma unroll
        for (int q = 0; q < 4; ++q) { const int mm = m + q * F.NGW; if (mm < TR) {
#pragma unroll
            for (int j = 0; j < 4; ++j) xv[q][j] = ((const f32x4*)(in[I_X] + (size_t)mm * 1024))[lane + 64 * j]; } }
#pragma unroll
        for (int q = 0; q < 4; ++q) { const int mm = m + q * F.NGW; if (mm < TR) { float sq = 0.f;
#pragma unroll
            for (int j = 0; j < 4; ++j) sq += (xv[q][j].x * xv[q][j].x + xv[q][j].y * xv[q][j].y) + (xv[q][j].z * xv[q][j].z + xv[q][j].w * xv[q][j].w);
            const float rstd = 1.0f / sqrtf(wave_sum(sq) * (1.0f / 1024.0f) + EPS); v2u* o8 = (v2u*)(HN + (size_t)mm * 1024) + lane;
#pragma unroll
            for (int j = 0; j < 4; ++j) { const f32x4 y = xv[q][j] * rstd * gg[j]; o8[64 * j] = (v2u){pk2(y.x, y.y), pk2(y.z, y.w)}; } } } }
      for (int m = TR + F.gw; m < TR + NMETA; m += F.NGW) norm_row_bf16(in[I_META] + (size_t)(m - TR) * 1024, gain0, HN + (size_t)m * 1024, lane); }
    for (long i = F.gt; i < NMETA * 1024; i += F.NGT) hmeta[i] = in[I_META][i];
}
__device__ __forceinline__ void norm_phase(const Frame& F, const bf16* HB, const float* hmeta, const float* gain, bf16* HN, int nrows) {
    const int lane = F.lane; const f32x4 g0 = *(const f32x4*)(gain + 8 * lane), g1 = *(const f32x4*)(gain + 8 * lane + 4), g2 = *(const f32x4*)(gain + 512 + 8 * lane), g3 = *(const f32x4*)(gain + 512 + 8 * lane + 4);
    for (int m = F.gw; m < TR; m += 4 * F.NGW) { v4u xa[4], xb[4];
#pragma unroll
        for (int q = 0; q < 4; ++q) { const int mm = m + q * F.NGW; if (mm < TR) { xa[q] = *(const v4u*)(HB + (size_t)mm * 1024 + 8 * lane); xb[q] = *(const v4u*)(HB + (size_t)mm * 1024 + 512 + 8 * lane); } }
#pragma unroll
        for (int q = 0; q < 4; ++q) { const int mm = m + q * F.NGW; if (mm < TR) { f32x4 v[4]; unpack8(xa[q], v[0], v[1]); unpack8(xb[q], v[2], v[3]); float sq = 0.f;
#pragma unroll
            for (int j = 0; j < 4; ++j) sq += (v[j].x * v[j].x + v[j].y * v[j].y) + (v[j].z * v[j].z + v[j].w * v[j].w);
            const float rstd = 1.0f / sqrtf(wave_sum(sq) * (1.0f / 1024.0f) + EPS);
            *(v4u*)(HN + (size_t)mm * 1024 + 8 * lane) = pack8(v[0] * rstd * g0, v[1] * rstd * g1); *(v4u*)(HN + (size_t)mm * 1024 + 512 + 8 * lane) = pack8(v[2] * rstd * g2, v[3] * rstd * g3); } } }
    for (int m = TR + F.gw; m < nrows; m += F.NGW) norm_row_bf16(hmeta + (size_t)(m - TR) * 1024, gain, HN + (size_t)m * 1024, F.lane);
}
__device__ __forceinline__ int seq_prev(int row, int back) {
    if (row >= TR) { const int i = row - TR - back; return i >= 0 ? TR + i : -1; }
    const int t = row & (SEQ - 1); return t >= back ? row - back : TR + NMETA + (t - back);
}
__device__ __forceinline__ void conv_phase(const Frame& F, const bf16* XR, const float* cw, const float* cb, bf16* XC) {
    for (long i = F.gt; i < (long)(TR / 32 + 1) * 128; i += F.NGT) { const int c = (int)(i & 127) * 8, st = (int)(i >> 7); const bool meta = st >= TR / 32; const int r0 = meta ? RM0 : st * 32, nr = meta ? NMETA : 32;
        f32x4 w[4][2]; f32x4 b0 = *(const f32x4*)(cb + c), b1 = *(const f32x4*)(cb + c + 4);
#pragma unroll
        for (int k = 0; k < 4; ++k) { w[k][0] = *(const f32x4*)(cw + k * 1024 + c); w[k][1] = *(const f32x4*)(cw + k * 1024 + c + 4); }
        f32x4 h[3][2];
#pragma unroll
        for (int k = 0; k < 3; ++k) { const int src = seq_prev(r0, 3 - k); if (src >= 0) unpack8(*(const v4u*)(XR + (size_t)src * 1024 + c), h[k][0], h[k][1]); else { h[k][0] = (f32x4){0.f, 0.f, 0.f, 0.f}; h[k][1] = h[k][0]; } }
        for (int t0 = 0; t0 < nr; t0 += 8) { v4u x[8];
#pragma unroll
            for (int t = 0; t < 8; ++t) x[t] = *(const v4u*)(XR + (size_t)(r0 + t0 + t) * 1024 + c);
#pragma unroll
            for (int t = 0; t < 8; ++t) { f32x4 c0, c1; unpack8(x[t], c0, c1);
                const f32x4 o0 = b0 + w[0][0] * h[0][0] + w[1][0] * h[1][0] + w[2][0] * h[2][0] + w[3][0] * c0, o1 = b1 + w[0][1] * h[0][1] + w[1][1] * h[1][1] + w[2][1] * h[2][1] + w[3][1] * c1;
                *(v4u*)(XC + (size_t)(r0 + t0 + t) * 1024 + c) = pack8(o0, o1);
                h[0][0] = h[1][0]; h[0][1] = h[1][1]; h[1][0] = h[2][0]; h[1][1] = h[2][1]; h[2][0] = c0; h[2][1] = c1; } } }
}
constexpr int SSM_HP = 68;
constexpr int SSM_WLDS = 4096 + 16 * SSM_HP * 4;
template <bool FINAL>
__device__ __forceinline__ void ssm_wave(const unsigned char* ws, const float* cre, const float* cim, const float* sd, const bf16* U, bf16* GS, int g, int row0, int ntok, float& hr, float& hi, int lane, LAS unsigned char* wl) {
    LAS f32x4* ub = (LAS f32x4*)wl; LAS unsigned* hb = (LAS unsigned*)(wl + 4096);
    const float* tab = (const float*)(ws + WS_TAB); const int gn = g * NS + lane, fr = lane & 15, fq = lane >> 4;
    const float ar = ((const float*)((const char*)tab + TB_AR))[gn], ai = ((const float*)((const char*)tab + TB_AI))[gn];
    f32x2 bb[16];
#pragma unroll
    for (int q = 0; q < 4; ++q) { const f32x4 a = ((const f32x4*)((const char*)tab + TB_BBR))[gn * 4 + q], b = ((const f32x4*)((const char*)tab + TB_BBI))[gn * 4 + q];
#pragma unroll
        for (int j = 0; j < 4; ++j) bb[4 * q + j] = (f32x2){a[j], b[j]}; }
    bf16x8 ca[4]; f32x4 dv = {0.f, 0.f, 0.f, 0.f};
    if (FINAL) {
#pragma unroll
        for (int ks = 0; ks < 4; ++ks) { const int n0 = 16 * ks + 4 * fq; const f32x4 cr = *(const f32x4*)(cre + (g * 16 + fr) * NS + n0), ci = *(const f32x4*)(cim + (g * 16 + fr) * NS + n0);
            v4u w; w.x = pk2(cr[0], -ci[0]); w.y = pk2(cr[1], -ci[1]); w.z = pk2(cr[2], -ci[2]); w.w = pk2(cr[3], -ci[3]); ca[ks] = __builtin_bit_cast(bf16x8, w); }
        dv = *(const f32x4*)(sd + g * 16 + 4 * fq); }
    if (lane < ntok) { const bf16* up = U + (size_t)(row0 + lane) * 512 + g * 16; const v4u w0 = *(const v4u*)up, w1 = *(const v4u*)(up + 8);
        ub[lane * 4 + 0] = (f32x4){bflo(w0.x), bfhi(w0.x), bflo(w0.y), bfhi(w0.y)}; ub[lane * 4 + 1] = (f32x4){bflo(w0.z), bfhi(w0.z), bflo(w0.w), bfhi(w0.w)};
        ub[lane * 4 + 2] = (f32x4){bflo(w1.x), bfhi(w1.x), bflo(w1.y), bfhi(w1.y)}; ub[lane * 4 + 3] = (f32x4){bflo(w1.z), bfhi(w1.z), bflo(w1.w), bfhi(w1.w)}; }
    LDS_WAIT(); asm volatile("" ::: "memory");
    for (int t0 = 0; t0 < ntok; t0 += 16) {
#pragma unroll 4
        for (int tl = 0; tl < 16; ++tl) { const int t = t0 + tl;
            const f32x4 u0 = ub[t * 4], u1 = ub[t * 4 + 1], u2 = ub[t * 4 + 2], u3 = ub[t * 4 + 3];
            f32x2 x = {0.f, 0.f};
#pragma unroll
            for (int h = 0; h < 4; ++h) { x += bb[h] * u0[h]; x += bb[4 + h] * u1[h]; x += bb[8 + h] * u2[h]; x += bb[12 + h] * u3[h]; }
            const float nr = ar * hr - ai * hi + x.x, ni = ar * hi + ai * hr + x.y; hr = nr; hi = ni;
            if (FINAL) hb[tl * SSM_HP + lane] = pk2(hr, hi); }
        if (FINAL) {
            asm volatile("" ::: "memory");
            f32x4 y = {0.f, 0.f, 0.f, 0.f};
#pragma unroll
            for (int ks = 0; ks < 4; ++ks) { const bf16x8 hbf = *(const LAS bf16x8*)(hb + fr * SSM_HP + 16 * ks + 4 * fq); y = __builtin_amdgcn_mfma_f32_16x16x32_bf16(ca[ks], hbf, y, 0, 0, 0); }
            const f32x4 uw = ub[(t0 + fr) * 4 + fq];
            const float o0 = gelu_tanh(y[0] + dv[0] * uw[0]), o1 = gelu_tanh(y[1] + dv[1] * uw[1]), o2 = gelu_tanh(y[2] + dv[2] * uw[2]), o3 = gelu_tanh(y[3] + dv[3] * uw[3]);
            v2u ow; ow.x = pk2(o0, o1); ow.y = pk2(o2, o3);
            *(v2u*)(GS + (size_t)(row0 + t0 + fr) * 512 + g * 16 + 4 * fq) = ow;
            asm volatile("" ::: "memory"); }
    }
    LDS_WAIT(); asm volatile("" ::: "memory");
}
__device__ __forceinline__ void ssm_l1_phase(const Frame& F, const unsigned char* ws, const bf16* U, float* SSE) {
    const int lane = F.lane, fr = lane & 15, fq = lane >> 4;
    for (int it = F.gw; it < NG * 32; it += F.NGW) { const int g = it >> 5, cb = it & 31, bc = cb * 16 + fr;
        const bf16* ap = (const bf16*)(ws + WS_WE) + ((size_t)g * 128 + fr) * 1024 + 8 * fq;
        const bf16* bp = U + ((size_t)bc * 64 + (fq >> 1)) * 512 + g * 16 + 8 * (fq & 1);
        f32x4 acc[8];
#pragma unroll
        for (int rb = 0; rb < 8; ++rb) acc[rb] = (f32x4){0.f, 0.f, 0.f, 0.f};
#pragma unroll 2
        for (int ks = 0; ks < 32; ++ks) { const bf16x8 bfr = *(const bf16x8*)(bp + (size_t)ks * 2 * 512);
#pragma unroll
            for (int rb = 0; rb < 8; ++rb) { const bf16x8 afr = *(const bf16x8*)(ap + (size_t)rb * 16 * 1024 + ks * 32); acc[rb] = __builtin_amdgcn_mfma_f32_16x16x32_bf16(afr, bfr, acc[rb], 0, 0, 0); } }
#pragma unroll
        for (int rb = 0; rb < 8; ++rb) *(f32x4*)(SSE + (((size_t)bc * NG + g) * NS + 8 * rb + 2 * fq) * 2) = acc[rb]; }
}
__device__ __forceinline__ void lru_l1_phase(const Frame& F, const bf16* A, const bf16* BX, float* PEND, float* HEND) {
    for (long i = F.gt; i < (long)NB * NCH * 128; i += F.NGT) { const int ch = (int)(i & 127) * 8, bc = (int)(i >> 7); const size_t r0 = (size_t)bc * 64;
        f32x4 P0 = {0.f, 0.f, 0.f, 0.f}, P1 = P0, H0 = P0, H1 = P0;
        for (int t0 = 0; t0 < 64; t0 += 8) { v4u la[8], bx[8];
#pragma unroll
            for (int t = 0; t < 8; ++t) { la[t] = *(const v4u*)(A + (r0 + t0 + t) * 1024 + ch); bx[t] = *(const v4u*)(BX + (r0 + t0 + t) * 1024 + ch); }
#pragma unroll
            for (int t = 0; t < 8; ++t) { f32x4 l0, l1, b0, b1; unpack8(la[t], l0, l1); unpack8(bx[t], b0, b1); P0 += l0; P1 += l1;
#pragma unroll
                for (int j = 0; j < 4; ++j) { H0[j] = __expf(l0[j]) * H0[j] + b0[j]; H1[j] = __expf(l1[j]) * H1[j] + b1[j]; } } }
#pragma unroll
        for (int j = 0; j < 4; ++j) { P0[j] = __expf(P0[j]); P1[j] = __expf(P1[j]); }
        float* pp = PEND + (size_t)bc * 1024 + ch; float* hp = HEND + (size_t)bc * 1024 + ch; *(f32x4*)pp = P0; *(f32x4*)(pp + 4) = P1; *(f32x4*)hp = H0; *(f32x4*)(hp + 4) = H1; }
}
__device__ __forceinline__ void carry_phase(const Frame& F, const unsigned char* ws, const bf16* A, const bf16* BX, const float* PEND, const float* HEND, float* CIN, const bf16* U, const float* SSE, float* SSIN) {
    if (F.gt < NB * 1024) { const int ch = (int)F.gt & 1023, b = (int)F.gt >> 10; float H = 0.f;
        for (int i = 0; i < NMETA; ++i) { const size_t r = (size_t)(RM0 + i); H = __expf(bf2f(A[r * 1024 + ch])) * H + bf2f(BX[r * 1024 + ch]); }
        for (int c0 = 0; c0 < NCH; c0 += 32) { float pp[32], hh[32];
#pragma unroll
            for (int c = 0; c < 32; ++c) { const size_t o = ((size_t)b * NCH + c0 + c) * 1024 + ch; pp[c] = PEND[o]; hh[c] = HEND[o]; }
#pragma unroll
            for (int c = 0; c < 32; ++c) { const size_t o = ((size_t)b * NCH + c0 + c) * 1024 + ch; CIN[o] = H; H = hh[c] + pp[c] * H; } }
    } else if (F.gt >= 8 * 512 && F.gt < 8 * 512 + NB * NG * NS) { const int id = (int)F.gt - 8 * 512, n = id % NS, g = (id / NS) % NG, b = id / (NS * NG), gn = g * NS + n;
        const float* tab = (const float*)(ws + WS_TAB);
        const float ar = ((const float*)((const char*)tab + TB_AR))[gn], ai = ((const float*)((const char*)tab + TB_AI))[gn], ar64 = ((const float*)((const char*)tab + TB_AR64))[gn], ai64 = ((const float*)((const char*)tab + TB_AI64))[gn];
        float hr = 0.f, hi = 0.f;
        for (int i = 0; i < NMETA; ++i) { float xr = 0.f, xi = 0.f;
            for (int h = 0; h < 16; ++h) { const float u = bf2f(U[(size_t)(RM0 + i) * 512 + g * 16 + h]); xr += ((const float*)((const char*)tab + TB_BBR))[gn * 16 + h] * u; xi += ((const float*)((const char*)tab + TB_BBI))[gn * 16 + h] * u; }
            const float nr = ar * hr - ai * hi + xr, ni = ar * hi + ai * hr + xi; hr = nr; hi = ni; }
        for (int c0 = 0; c0 < NCH; c0 += 32) { f32x2 ee[32];
#pragma unroll
            for (int c = 0; c < 32; ++c) ee[c] = ((const f32x2*)SSE)[(((size_t)b * NCH + c0 + c) * NG + g) * NS + n];
#pragma unroll
            for (int c = 0; c < 32; ++c) { ((f32x2*)SSIN)[(((size_t)b * NCH + c0 + c) * NG + g) * NS + n] = (f32x2){hr, hi};
                const float nr = ar64 * hr - ai64 * hi + ee[c].x, ni = ar64 * hi + ai64 * hr + ee[c].y; hr = nr; hi = ni; } }
    }
}
__device__ __forceinline__ void mix0_final_phase(const Frame& F, const unsigned char* ws, const bf16* A, const bf16* BX, const float* CIN, const bf16* G, bf16* AOUT, const float* cre, const float* cim, const float* sd, const bf16* U, const float* SSIN, bf16* GS) {
    for (int pass = 0; pass < 2; ++pass) {
      if ((pass ^ (F.wave & 1)) == 0) {
    for (long i = F.gt; i < (long)NB * NCH * 128 + 128; i += F.NGT) { const int ch = (int)(i & 127) * 8, bc = (int)(i >> 7); const bool meta = bc >= NB * NCH;
        const size_t r0 = meta ? (size_t)RM0 : (size_t)bc * 64; const int nt = meta ? NMETA : 64; f32x4 H0 = {0.f, 0.f, 0.f, 0.f}, H1 = H0;
        if (!meta) { H0 = *(const f32x4*)(CIN + (size_t)bc * 1024 + ch); H1 = *(const f32x4*)(CIN + (size_t)bc * 1024 + ch + 4); }
        for (int t0 = 0; t0 < nt; t0 += 8) { v4u la[8], bx[8], gg[8];
#pragma unroll
            for (int t = 0; t < 8; ++t) { const size_t r = r0 + t0 + t; la[t] = *(const v4u*)(A + r * 1024 + ch); bx[t] = *(const v4u*)(BX + r * 1024 + ch); gg[t] = *(const v4u*)(G + r * 1024 + ch); }
#pragma unroll
            for (int t = 0; t < 8; ++t) { f32x4 l0, l1, b0, b1, g0, g1; unpack8(la[t], l0, l1); unpack8(bx[t], b0, b1); unpack8(gg[t], g0, g1);
#pragma unroll
                for (int j = 0; j < 4; ++j) { H0[j] = __expf(l0[j]) * H0[j] + b0[j]; H1[j] = __expf(l1[j]) * H1[j] + b1[j]; }
                *(v4u*)(AOUT + (r0 + t0 + t) * 1536 + ch) = pack8(g0 * H0, g1 * H1); } } }
      } else {
    for (int it = F.gw; it < NB * NCH * NG + NG; it += F.NGW) { const bool meta = it >= NB * NCH * NG; const int g = it % NG, bc = it / NG;
        float hr = 0.f, hi = 0.f; if (!meta) { const f32x2 s = ((const f32x2*)SSIN)[(size_t)it * NS + F.lane]; hr = s.x; hi = s.y; }
        ssm_wave<true>(ws, cre, cim, sd, U, GS, g, meta ? RM0 : bc * 64, meta ? NMETA : 64, hr, hi, F.lane, F.lds + RING_OFF + F.wave * SSM_WLDS); }
      }
    }
}
template <int NACC>
__device__ __forceinline__ void meta_tile(const Frame& F, const bf16* A16, int lda, int K, const bf16* const (&Brow)[NACC], int ldb, f32x4 (&out)[NACC]) {
    LAS f32x4* red = (LAS f32x4*)(F.lds + RING_OFF);
    const int lane = F.lane, fr = lane & 15, fq = lane >> 4, w = F.wave, ks = K / 8;
    f32x4 acc[NACC];
#pragma unroll
    for (int a = 0; a < NACC; ++a) acc[a] = (f32x4){0.f, 0.f, 0.f, 0.f};
    for (int k0 = w * ks; k0 < (w + 1) * ks; k0 += 32) {
        const bf16x8 af = *(const bf16x8*)(A16 + (size_t)fr * lda + k0 + 8 * fq);
#pragma unroll
        for (int a = 0; a < NACC; ++a) { const bf16x8 bfz = *(const bf16x8*)(Brow[a] + (size_t)fr * ldb + k0 + 8 * fq); acc[a] = __builtin_amdgcn_mfma_f32_16x16x32_bf16(bfz, af, acc[a], 0, 0, 0); } }
    __syncthreads();
#pragma unroll
    for (int a = 0; a < NACC; ++a) red[(w * NACC + a) * 64 + lane] = acc[a];
    __syncthreads();
#pragma unroll
    for (int a = 0; a < NACC; ++a) { f32x4 sacc = red[a * 64 + lane];
#pragma unroll
        for (int ww = 1; ww < 8; ++ww) sacc += red[(ww * NACC + a) * 64 + lane];
        out[a] = sacc; }
}
template <class Fn> __device__ __forceinline__ bf16x8 frag8(Fn f) { bf16x8 r;
#pragma unroll
    for (int j = 0; j < 8; ++j) r[j] = (short)f(j);
    return r; }
constexpr int GL_LB = 0, GL_QT = 32768, GL_KT = 50176, GL_KH = 67584, GL_VT = 86016, GL_GM = 120832, GL_BL = 121344, GL_SSQ = 121856;
constexpr int PQ = 136, PKH = 144, PV = 272, PATT = 72, POT = 264;
#define TR_FRAG(dst, base, off, rows4) do { v2u _lo, _hi; \
    asm volatile("ds_read_b64_tr_b16 %0, %2 offset:%c3\n\tds_read_b64_tr_b16 %1, %2 offset:%c4\n\ts_waitcnt lgkmcnt(0)" : "=&v"(_lo), "=&v"(_hi) : "v"(base), "i"(off), "i"((off) + (rows4)) : "memory"); \
    const v4u _w = {_lo.x, _lo.y, _hi.x, _hi.y}; dst = __builtin_bit_cast(bf16x8, _w); } while (0)
__device__ __forceinline__ unsigned lds_addr(const LAS void* p) { return (unsigned)(unsigned long)p; }
template <bool FINAL>
__device__ __forceinline__ void gla_item(const Frame& F, int b, int h, int s, const bf16* Q, const bf16* K, const bf16* V, const bf16* GATE, const float* LG, const float* gnorm, float* GDS, float* GAM, bf16* AOUT2) {
    LAS float* LB = (LAS float*)(F.lds + GL_LB); LAS bf16* ATT = (LAS bf16*)(F.lds + GL_LB);
    LAS bf16* QT = (LAS bf16*)(F.lds + GL_QT); LAS bf16* KT = (LAS bf16*)(F.lds + GL_KT); LAS bf16* KH = (LAS bf16*)(F.lds + GL_KH); LAS bf16* VT = (LAS bf16*)(F.lds + GL_VT);
    LAS float* GM = (LAS float*)(F.lds + GL_GM); LAS float* BL = (LAS float*)(F.lds + GL_BL); LAS float* SSQ = (LAS float*)(F.lds + GL_SSQ);
    const int tid = F.tid, w = F.wave, lane = F.lane, fr = lane & 15, h4 = lane >> 4, tq = fr >> 2, tp = fr & 3;
    const int bh = b * GH + h; const size_t sbase = ((size_t)(bh * NSEG + s) * 128) * 256;
    const unsigned vtr = lds_addr(VT) + (unsigned)((8 * h4 + tq) * PV + 32 * w + 4 * tp) * 2u;
    const unsigned ktr = lds_addr(KH) + (unsigned)((8 * h4 + tq) * PKH + 4 * tp) * 2u;
    f32x4 S[8][2];
#pragma unroll
    for (int kb = 0; kb < 8; ++kb)
#pragma unroll
        for (int vb = 0; vb < 2; ++vb)
#pragma unroll
            for (int r = 0; r < 4; ++r) S[kb][vb][r] = FINAL ? GDS[sbase + (size_t)(16 * kb + 4 * h4 + r) * 256 + 32 * w + 16 * vb + fr] : 0.f;
    float gsum = 0.f;
#pragma nounroll
    for (int c = 0; c < SEGC; ++c) {
        const size_t row0 = (size_t)b * SEQ + (size_t)(s * SEGC + c) * 64;
        int lz = 0; asm volatile("" : "+v"(lz));
        const int tidl = tid + lz, frl = fr + lz, h4l = h4 + lz;
#pragma unroll
        for (int j = 0; j < 4; ++j) { const int i = tidl + 512 * j, t = i >> 5, k4 = (i & 31) * 4; *(LAS f32x4*)(LB + t * 128 + k4) = *(const f32x4*)(LG + (row0 + t) * 512 + h * 128 + k4); }
        v4u kwr[2];
#pragma unroll
        for (int j = 0; j < 2; ++j) { const int i = tidl + 512 * j, t = i >> 4, k8 = (i & 15) * 8; const size_t go = (row0 + t) * 512 + h * 128 + k8; if (!FINAL) kwr[j] = *(const v4u*)(K + go); }
#pragma unroll
        for (int j = 0; j < 4; ++j) { const int i = tidl + 512 * j, t = i >> 5, c8 = (i & 31) * 8; *(LAS v4u*)(VT + t * PV + c8) = *(const v4u*)(V + (row0 + t) * 1024 + h * 256 + c8); }
        __syncthreads();
        if (tid < 128) { float run = 0.f;
#pragma unroll 8
            for (int t = 0; t < 64; ++t) { run += LB[t * 128 + tid]; LB[t * 128 + tid] = run; }
            BL[tid] = run; GM[tid] = __expf(run); gsum += run; }
        __syncthreads();
#pragma unroll
        for (int j = 0; j < 2; ++j) { const int i = tidl + 512 * j, t = i >> 4, k8 = (i & 15) * 8; const size_t go = (row0 + t) * 512 + h * 128 + k8;
            const v4u kw = FINAL ? *(const v4u*)(K + go) : kwr[j]; const float kv[8] = {bflo(kw.x), bfhi(kw.x), bflo(kw.y), bfhi(kw.y), bflo(kw.z), bfhi(kw.z), bflo(kw.w), bfhi(kw.w)};
            float bb[8], kh[8];
#pragma unroll
            for (int e = 0; e < 8; ++e) { bb[e] = LB[t * 128 + k8 + e]; kh[e] = kv[e] * __expf(BL[k8 + e] - bb[e]); }
            v4u o; o.x = pk2(kh[0], kh[1]); o.y = pk2(kh[2], kh[3]); o.z = pk2(kh[4], kh[5]); o.w = pk2(kh[6], kh[7]); *(LAS v4u*)(KH + t * PKH + k8) = o;
            if (FINAL) { const v4u qw = *(const v4u*)(Q + go); const float qv[8] = {bflo(qw.x), bfhi(qw.x), bflo(qw.y), bfhi(qw.y), bflo(qw.z), bfhi(qw.z), bflo(qw.w), bfhi(qw.w)};
                float qt[8], kt[8];
#pragma unroll
                for (int e = 0; e < 8; ++e) { qt[e] = qv[e] * __expf(bb[e]); kt[e] = kv[e] * __expf(-bb[e]); }
                v4u oq; oq.x = pk2(qt[0], qt[1]); oq.y = pk2(qt[2], qt[3]); oq.z = pk2(qt[4], qt[5]); oq.w = pk2(qt[6], qt[7]); *(LAS v4u*)(QT + t * PQ + k8) = oq;
                v4u ok; ok.x = pk2(kt[0], kt[1]); ok.y = pk2(kt[2], kt[3]); ok.z = pk2(kt[4], kt[5]); ok.w = pk2(kt[6], kt[7]); *(LAS v4u*)(KT + t * PQ + k8) = ok; } }
        __syncthreads();
        f32x4 o[4][2];
        if (FINAL) {
            { const int tb = w >> 1;
#pragma unroll
              for (int q = 0; q < 2; ++q) { const int sb = 2 * (w & 1) + q; f32x4 acc = {0.f, 0.f, 0.f, 0.f};
                if (sb <= tb) {
#pragma unroll
                    for (int ks = 0; ks < 4; ++ks) { const bf16x8 a = *(const LAS bf16x8*)(QT + (16 * tb + fr) * PQ + 32 * ks + 8 * h4), bq = *(const LAS bf16x8*)(KT + (16 * sb + fr) * PQ + 32 * ks + 8 * h4);
                        acc = __builtin_amdgcn_mfma_f32_16x16x32_bf16(a, bq, acc, 0, 0, 0); } }
#pragma unroll
                for (int r = 0; r < 4; ++r) { const int tl = 4 * h4 + r; const float val = (sb < tb || (sb == tb && fr <= tl)) ? acc[r] : 0.f; ATT[(16 * tb + tl) * PATT + 16 * sb + fr] = (bf16)f2bf(val); } } }
            __syncthreads();
#pragma unroll
            for (int tb = 0; tb < 4; ++tb)
#pragma unroll
                for (int vb = 0; vb < 2; ++vb) o[tb][vb] = (f32x4){0.f, 0.f, 0.f, 0.f};
#pragma unroll
            for (int ss = 0; ss < 2; ++ss) { bf16x8 bv[2];
#pragma unroll
                for (int vb = 0; vb < 2; ++vb) TR_FRAG(bv[vb], vtr, (32 * ss * PV + 16 * vb) * 2, 4 * PV * 2);
#pragma unroll
                for (int tb = 0; tb < 4; ++tb) { if (ss == 1 && tb < 2) continue;
                    const bf16x8 a = *(const LAS bf16x8*)(ATT + (16 * tb + fr) * PATT + 32 * ss + 8 * h4);
#pragma unroll
                    for (int vb = 0; vb < 2; ++vb) o[tb][vb] = __builtin_amdgcn_mfma_f32_16x16x32_bf16(a, bv[vb], o[tb][vb], 0, 0, 0); } }
#pragma unroll
            for (int i = 0; i < 4; ++i) { bf16x8 bs[2];
#pragma unroll
                for (int vb = 0; vb < 2; ++vb) { v4u wv; wv.x = pk2(S[2 * i][vb][0], S[2 * i][vb][1]); wv.y = pk2(S[2 * i][vb][2], S[2 * i][vb][3]); wv.z = pk2(S[2 * i + 1][vb][0], S[2 * i + 1][vb][1]); wv.w = pk2(S[2 * i + 1][vb][2], S[2 * i + 1][vb][3]); bs[vb] = __builtin_bit_cast(bf16x8, wv); }
#pragma unroll
                for (int tb = 0; tb < 4; ++tb) { const LAS bf16* qp = QT + (16 * tb + fr) * PQ + 32 * i + 4 * h4; const v2u a_lo = *(const LAS v2u*)qp, a_hi = *(const LAS v2u*)(qp + 16);
                    const v4u aw = {a_lo.x, a_lo.y, a_hi.x, a_hi.y}; const bf16x8 a = __builtin_bit_cast(bf16x8, aw);
#pragma unroll
                    for (int vb = 0; vb < 2; ++vb) o[tb][vb] = __builtin_amdgcn_mfma_f32_16x16x32_bf16(a, bs[vb], o[tb][vb], 0, 0, 0); } }
        }
        if (FINAL) {
#pragma unroll
            for (int tb = 0; tb < 4; ++tb)
#pragma unroll
                for (int r = 0; r < 4; ++r) { float q = o[tb][0][r] * o[tb][0][r] + o[tb][1][r] * o[tb][1][r];
                    q += __shfl_xor(q, 1); q += __shfl_xor(q, 2); q += __shfl_xor(q, 4); q += __shfl_xor(q, 8);
                    if (fr == 0) SSQ[w * 64 + 16 * tb + 4 * h4 + r] = q; }
            __syncthreads();
            { LAS bf16* OT = QT; const float gn0 = gnorm[h * 256 + 32 * w + frl], gn1 = gnorm[h * 256 + 32 * w + 16 + frl];
#pragma unroll
              for (int tb = 0; tb < 4; ++tb)
#pragma unroll
                for (int r = 0; r < 4; ++r) { const int t = 16 * tb + 4 * h4 + r; float tot = 0.f;
#pragma unroll
                    for (int ww = 0; ww < 8; ++ww) tot += SSQ[ww * 64 + t];
                    const float rstd = __builtin_amdgcn_rsqf(tot * (1.0f / 256.0f) + EPS);
                    OT[t * POT + 32 * w + fr] = (bf16)f2bf(o[tb][0][r] * rstd * gn0); OT[t * POT + 32 * w + 16 + fr] = (bf16)f2bf(o[tb][1][r] * rstd * gn1); asm volatile("" ::: "memory"); }
              __syncthreads();
#pragma unroll 2
              for (int j = 0; j < 4; ++j) { const int i = tidl + 512 * j, t = i >> 5, c8 = (i & 31) * 8; const size_t go = (row0 + t) * 1024 + h * 256 + c8;
                  f32x4 a0, a1, g0, g1; unpack8(*(const LAS v4u*)(OT + t * POT + c8), a0, a1); unpack8(*(const v4u*)(GATE + go), g0, g1); *(v4u*)(AOUT2 + go) = pack8(a0 * g0, a1 * g1); } }
        }
#pragma unroll
        for (int kb = 0; kb < 8; ++kb) { const f32x4 gm = *(const LAS f32x4*)(GM + 16 * kb + 4 * h4);
#pragma unroll
            for (int vb = 0; vb < 2; ++vb) S[kb][vb] = S[kb][vb] * gm; }
#pragma unroll
        for (int ts = 0; ts < 2; ++ts) { bf16x8 bv[2];
#pragma unroll
            for (int vb = 0; vb < 2; ++vb) TR_FRAG(bv[vb], vtr, (32 * ts * PV + 16 * vb) * 2, 4 * PV * 2);
#pragma unroll
            for (int kb = 0; kb < 8; ++kb) { bf16x8 a; TR_FRAG(a, ktr, (32 * ts * PKH + 16 * kb) * 2, 4 * PKH * 2);
#pragma unroll
                for (int vb = 0; vb < 2; ++vb) S[kb][vb] = __builtin_amdgcn_mfma_f32_16x16x32_bf16(a, bv[vb], S[kb][vb], 0, 0, 0); } }
        __syncthreads();
    }
    if (!FINAL) {
#pragma unroll
        for (int kb = 0; kb < 8; ++kb)
#pragma unroll
            for (int vb = 0; vb < 2; ++vb)
#pragma unroll
                for (int r = 0; r < 4; ++r) GDS[sbase + (size_t)(16 * kb + 4 * h4 + r) * 256 + 32 * w + 16 * vb + fr] = S[kb][vb][r];
        if (tid < 128) GAM[(size_t)(bh * NSEG + s) * 128 + tid] = __expf(gsum);
    }
}
__device__ __forceinline__ void gla_l2_phase(const Frame& F, const bf16* K, const bf16* V, const float* LG, float* GDS, const float* GAM) {
    for (long idx = F.gt; idx < (long)NB * GH * 128 * 64; idx += F.NGT) { const int v4 = (int)(idx & 63), k = (int)(idx >> 6) & 127, bh = (int)(idx >> 13), h = bh & 3;
        float bc[16]; float run = 0.f;
#pragma unroll
        for (int i = 0; i < NMETA; ++i) { run += LG[(size_t)(RM0 + i) * 512 + h * 128 + k]; bc[i] = run; }
        f32x4 carry = {0.f, 0.f, 0.f, 0.f};
#pragma unroll
        for (int i = 0; i < NMETA; ++i) { const float wk = __expf(run - bc[i]) * bf2f(K[(size_t)(RM0 + i) * 512 + h * 128 + k]); const v2u vw = *(const v2u*)(V + (size_t)(RM0 + i) * 1024 + h * 256 + 4 * v4);
            carry += (f32x4){bflo(vw.x), bfhi(vw.x), bflo(vw.y), bfhi(vw.y)} * wk; }
        f32x4 ds[NSEG]; float gm[NSEG];
#pragma unroll
        for (int s = 0; s < NSEG; ++s) { ds[s] = *(const f32x4*)(GDS + ((size_t)(bh * NSEG + s) * 128 + k) * 256 + 4 * v4); gm[s] = GAM[(size_t)(bh * NSEG + s) * 128 + k]; }
#pragma unroll
        for (int s = 0; s < NSEG; ++s) { *(f32x4*)(GDS + ((size_t)(bh * NSEG + s) * 128 + k) * 256 + 4 * v4) = carry; carry = carry * gm[s] + ds[s]; }
    }
}

__device__ __forceinline__ void router_phase(const Frame& F, const Args& a, unsigned char* ws) {
    const float* const* in = a.in; unsigned* ctl = (unsigned*)(ws + WS_CTL); bf16* HNM = (bf16*)(ws + WS_HNM); int* tokinfo = (int*)(ws + WS_TOKINFO);
    const float* gain = in[I_NORM_FFN1]; const float* RW = in[I_ROUTER]; const int lane = F.lane; const bf16* HB = (const bf16*)((const char*)a.out + 64 * MiB);
    LAS unsigned* cnt = (LAS unsigned*)(F.lds + TABL_OFF);
    if (F.tid < 32) cnt[F.tid] = 0u;
    __syncthreads();
    const int per = (TR + F.G - 1) / F.G, m0 = (int)blockIdx.x * per, m1 = (m0 + per < TR) ? m0 + per : TR;
    int my_e0 = 0, my_e1 = 0; unsigned my_p0 = 0, my_p1 = 0; float my_w0 = 0.f;
    int jt = 0;
    v4u nxa = {0u, 0u, 0u, 0u}, nxb = nxa; if (m0 + F.wave < m1) { const bf16* hr0 = HB + (size_t)(m0 + F.wave) * 1024; nxa = *(const v4u*)(hr0 + 8 * lane); nxb = *(const v4u*)(hr0 + 512 + 8 * lane); }
    for (int m = m0 + F.wave; m < m1; m += 8, ++jt) {
        f32x4 v[4]; unpack8(nxa, v[0], v[1]); unpack8(nxb, v[2], v[3]); float s = 0.f;
        if (m + 8 < m1) { const bf16* hr1 = HB + (size_t)(m + 8) * 1024; nxa = *(const v4u*)(hr1 + 8 * lane); nxb = *(const v4u*)(hr1 + 512 + 8 * lane); }
#pragma unroll
        for (int j = 0; j < 4; ++j) s += (v[j].x * v[j].x + v[j].y * v[j].y) + (v[j].z * v[j].z + v[j].w * v[j].w);
        const float rstd = 1.0f / sqrtf(wave_sum(s) * (1.0f / 1024.0f) + EPS);
        float p[8] = {0.f, 0.f, 0.f, 0.f, 0.f, 0.f, 0.f, 0.f};
        f32x4 yv[4];
#pragma unroll
        for (int j = 0; j < 4; ++j) { const int d0 = (j >> 1) * 512 + 8 * lane + (j & 1) * 4; const f32x4 g = *(const f32x4*)(gain + d0); const f32x4 y = v[j] * rstd * g; yv[j] = y;
#pragma unroll
            for (int e4 = 0; e4 < 4; ++e4) { const int d = d0 + e4; const f32x4 r0 = *(const f32x4*)(RW + d * 8), r1 = *(const f32x4*)(RW + d * 8 + 4);
#pragma unroll
                for (int e = 0; e < 4; ++e) { p[e] += y[e4] * r0[e]; p[4 + e] += y[e4] * r1[e]; } } }
        *(v4u*)(HNM + (size_t)m * 1024 + 8 * lane) = pack8(yv[0], yv[1]); *(v4u*)(HNM + (size_t)m * 1024 + 512 + 8 * lane) = pack8(yv[2], yv[3]);
        float q4[4];
#pragma unroll
        for (int i = 0; i < 4; ++i) { const bool up = (lane & 32) != 0; const float keep = up ? p[i + 4] : p[i], send = up ? p[i] : p[i + 4]; q4[i] = keep + __shfl_xor(send, 32); }
        float q2[2];
#pragma unroll
        for (int i = 0; i < 2; ++i) { const bool up = (lane & 16) != 0; const float keep = up ? q4[i + 2] : q4[i], send = up ? q4[i] : q4[i + 2]; q2[i] = keep + __shfl_xor(send, 16); }
        float y; { const bool up = (lane & 8) != 0; const float keep = up ? q2[1] : q2[0], send = up ? q2[0] : q2[1]; y = keep + __shfl_xor(send, 8); }
        y += __shfl_xor(y, 4); y += __shfl_xor(y, 2); y += __shfl_xor(y, 1);
        float lg[8];
#pragma unroll
        for (int e = 0; e < 8; ++e) lg[e] = __shfl(y, ((e >> 2) & 1) * 32 + ((e >> 1) & 1) * 16 + (e & 1) * 8);
        int i0 = 0; float v0 = lg[0];
#pragma unroll
        for (int e = 1; e < 8; ++e) if (lg[e] > v0) { v0 = lg[e]; i0 = e; }
        int i1 = -1; float v1 = -3.0e38f;
#pragma unroll
        for (int e = 0; e < 8; ++e) if (e != i0 && lg[e] > v1) { v1 = lg[e]; i1 = e; }
        if (i1 < 0) i1 = (i0 + 1) & 7;
        if (lane == jt) { my_e0 = i0; my_e1 = i1; my_w0 = 1.0f / (1.0f + __expf(v1 - v0)); my_p0 = atomicAdd((unsigned*)(cnt + i0), 1u); my_p1 = atomicAdd((unsigned*)(cnt + 8 + i1), 1u); }
    }
    __syncthreads();
    if (F.tid < 16) cnt[16 + F.tid] = __hip_atomic_fetch_add(ctl + CW_CNT + F.tid, cnt[F.tid], RLX_AGENT);
    __syncthreads();
    if (lane < jt) { const int m = m0 + F.wave + 8 * lane; const float w1 = 1.0f - my_w0;
        *(v4u*)(tokinfo + (size_t)m * 4) = (v4u){(unsigned)my_e0, cnt[16 + my_e0] + my_p0, __float_as_uint(my_w0), 0u};
        *(v4u*)(tokinfo + (size_t)(TR + m) * 4) = (v4u){(unsigned)my_e1, cnt[24 + my_e1] + my_p1, __float_as_uint(w1), 0u}; }
    LAS float* scr = (LAS float*)(F.lds + RING_OFF + F.wave * 16384);
    constexpr int IG = 16 * 112, ID = 56 * 32, IE = 2 * IG + ID;
    bf16* WGU = (bf16*)(ws + WS_WMOE); bf16* WD = WGU + (size_t)NE * 7168 * 1024;
    for (int it = F.gw; it < NE * IE; it += F.NGW) { const int e = it / IE; int r = it % IE;
        { TrJob j{in[I_MG] + (size_t)e * 1024 * FFE, FFE, 0, 1024, FFE, WGU + (size_t)e * 7168 * 1024, 128, 256, 0}; if (tr_try(r, j, scr, lane)) continue; }
        { TrJob j{in[I_MU] + (size_t)e * 1024 * FFE, FFE, 0, 1024, FFE, WGU + (size_t)e * 7168 * 1024, 128, 256, 128}; if (tr_try(r, j, scr, lane)) continue; }
        { TrJob j{in[I_MD] + (size_t)e * FFE * 1024, 1024, 0, FFE, 1024, WD + (size_t)e * 1024 * FFE, 1 << 30, 0, 0}; tr_try(r, j, scr, lane); }
    }
}
__device__ __forceinline__ void moe_lists_phase(const Frame& F, unsigned char* ws) {
    unsigned* ctl = (unsigned*)(ws + WS_CTL); LAS int* L = (LAS int*)(F.lds + TABL_OFF);
    const int* tokinfo = (const int*)(ws + WS_TOKINFO); int* rowtok = (int*)(ws + WS_ROWTOK); float* roww = (float*)(ws + WS_ROWW);
    int* pexp = (int*)(ws + WS_TAB + TB_PEXP); int* npan = (int*)(ws + WS_TAB + TB_NPAN);
    if (F.tid < 16) L[F.tid] = (int)__hip_atomic_load(ctl + CW_CNT + F.tid, RLX_AGENT);
    __syncthreads();
    if (F.tid == 0) { for (int s = 0; s < 2; ++s) { int acc = 0; for (int e = 0; e < 8; ++e) { L[16 + s * 8 + e] = acc; acc += (L[s * 8 + e] + 255) & ~255; } L[32 + s] = acc >> 8; } }
    __syncthreads();
    if (blockIdx.x == 0) { if (F.tid < 2) npan[F.tid] = L[32 + F.tid];
        if (F.tid < 16) { const int s = F.tid >> 3, base = L[16 + F.tid], n = (L[F.tid] + 255) >> 8; for (int p = 0; p < n; ++p) pexp[s * MPAN + (base >> 8) + p] = F.tid & 7; } }
    for (long i = F.gt; i < 2L * TR; i += F.NGT) { const int s = (int)(i >= TR), tok = (int)(i - (long)s * TR); const v4u inf = *(const v4u*)(tokinfo + i * 4);
        const int row = L[16 + s * 8 + (int)inf.x] + (int)inf.y; rowtok[(size_t)s * MROWS + row] = tok; const unsigned wb = inf.z; roww[(size_t)s * MROWS + row] = __uint_as_float(wb); }
    for (long i = F.gt; i < 16L * 256; i += F.NGT) { const int se = (int)(i >> 8), r = (int)(i & 255), s = se >> 3, cnt = L[se], base = L[16 + se], pad = ((cnt + 255) & ~255) - cnt;
        if (r < pad) { rowtok[(size_t)s * MROWS + base + cnt + r] = -1; roww[(size_t)s * MROWS + base + cnt + r] = 0.f; } }
}

constexpr int N_PHASES = 25;
__global__ void __launch_bounds__(512, 2) mk_fwd(Args args) {
    extern __shared__ __attribute__((aligned(16))) unsigned char lds_raw[];
    Frame F; F.lds = (LAS unsigned char*)lds_raw; F.tid = threadIdx.x; F.lane = F.tid & 63; F.wave = __builtin_amdgcn_readfirstlane(F.tid >> 6); F.G = gridDim.x;
    F.gw = blockIdx.x * 8 + F.wave; F.NGW = F.G * 8; F.gt = (int)blockIdx.x * 512 + F.tid; F.NGT = F.G * 512;
    unsigned char* ws = args.ws; const float* const* in = args.in; float* out = args.out;
    volatile LAS unsigned* MISC = (volatile LAS unsigned*)(F.lds + MISC_OFF);
    if (F.tid < 32) MISC[F.tid] = 0u;
    __syncthreads();
#if !MK_PER_PHASE
    XcdBarrier bar = xcd_barrier_post((unsigned*)(ws + WS_CTL) + CW_BAR, MISC + 8);
#define GRID_BAR() xcd_barrier(bar)
#else
#define GRID_BAR() do { } while (0)
#endif
    const int lo = args.ph_lo, hi = args.ph_hi;
#ifndef MK_MASK
#define MK_MASK 0xFFFFFFFFu
#endif
#ifndef MK_STOP
#define MK_STOP 99
#endif
#define IN(k) ((((MK_MASK) >> (k)) & 1u) && ((k) <= MK_STOP || (k) == 24) && lo <= (k) && (k) < hi)
#define SEAM(k) do { if (IN(k) && IN((k) + 1)) GRID_BAR(); asm volatile("" : "+v"(F.tid), "+v"(F.lane), "+v"(F.gt)); } while (0)
    const int cu = (int)blockIdx.x;
    LAS unsigned char* ring = F.lds + RING_OFF;
    const LAS int* notab = (const LAS int*)(F.lds + TABL_OFF);
    float* hmeta = (float*)(ws + WS_HMETA);
    bf16* HB = (bf16*)((char*)out + 64 * MiB);
    bf16* HN = (bf16*)(ws + WS_HN);
    constexpr size_t P1K = (size_t)256 * 1024 * 2;

    if (IN(0)) { p0_prologue(F, args, ws); } SEAM(0);
    if (IN(1)) { SchedStatic S{NPR, 10, F.G, cu, (const char*)HN, (const char*)(ws + WS_WIN0), P1K, P1K, 0, 0}; EpiWin0 E{(bf16*)(ws + WS_G), (bf16*)(ws + WS_XRBX), (bf16*)(ws + WS_U)};
        pg8::gemm_phase<EpiWin0, SchedStatic, false>(ring, 1024, 1024, S, E, notab);
        for (int t = cu; t < EV_IN / 16; t += F.G) { const int n0 = t * 16; const bf16* const br[1] = {(const bf16*)(ws + WS_WIN0) + (size_t)n0 * 1024}; f32x4 o[1];
            meta_tile<1>(F, HN + (size_t)RM0 * 1024, 1024, 1024, br, 1024, o);
            if (F.wave == 0) { const int row = RM0 + (F.lane & 15), c = n0 + 4 * (F.lane >> 4); f32x4 v = o[0];
                if (c < 1024) { for (int j = 0; j < 4; ++j) v[j] = gelu_tanh(v[j]); *(v2u*)((bf16*)(ws + WS_G) + (size_t)row * 1024 + c) = (v2u){pk2(v[0], v[1]), pk2(v[2], v[3])}; }
                else if (c < 2048) *(v2u*)((bf16*)(ws + WS_XRBX) + (size_t)row * 1024 + c - 1024) = (v2u){pk2(v[0], v[1]), pk2(v[2], v[3])};
                else *(v2u*)((bf16*)(ws + WS_U) + (size_t)row * 512 + c - 2048) = (v2u){pk2(v[0], v[1]), pk2(v[2], v[3])}; } } } SEAM(1);
    if (IN(2)) { for (int pass = 0; pass < 2; ++pass) { if ((pass ^ (F.wave & 1)) == 0) conv_phase(F, (const bf16*)(ws + WS_XRBX), in[I_CONVW], in[I_CONVB], (bf16*)(ws + WS_XC)); else ssm_l1_phase(F, ws, (const bf16*)(ws + WS_U), (float*)(ws + WS_SSE)); } } SEAM(2);
    if (IN(3)) { SchedStatic S{NPR, 8, F.G, cu, (const char*)(ws + WS_XC), (const char*)(ws + WS_GW), P1K, (size_t)256 * 256 * 2, 2, (size_t)256 * 2};
        EpiGates E{in[I_GAB], in[I_GXB], (const float*)(ws + WS_TAB + TB_SP8), (const bf16*)(ws + WS_XC), (bf16*)(ws + WS_A), (bf16*)(ws + WS_XRBX)};
        pg8::gemm_phase<EpiGates, SchedStatic, false>(ring, 256, 1024, S, E, notab);
        for (int t = cu; t < 64; t += F.G) { const int ch0 = t * 16, h = ch0 >> 8, cl = ch0 & 255;
            const bf16* gwb = (const bf16*)(ws + WS_GW) + (size_t)h * 512 * 256 + (size_t)((cl >> 7) * 256 + (cl & 127)) * 256; const bf16* const br[2] = {gwb, gwb + 128 * 256}; f32x4 o[2];
            meta_tile<2>(F, (const bf16*)(ws + WS_XC) + (size_t)RM0 * 1024 + h * 256, 1024, 256, br, 256, o);
            if (F.wave == 0) { const int row = RM0 + (F.lane & 15), ch = ch0 + 4 * (F.lane >> 4); const size_t ro = (size_t)row * 1024 + ch;
                const f32x4 ba = *(const f32x4*)(in[I_GAB] + ch), bx = *(const f32x4*)(in[I_GXB] + ch), sp = *(const f32x4*)((const float*)(ws + WS_TAB + TB_SP8) + ch);
                const v2u xw = *(const v2u*)((const bf16*)(ws + WS_XC) + ro); const float xv[4] = {bflo(xw.x), bfhi(xw.x), bflo(xw.y), bfhi(xw.y)}; f32x4 av, bv;
                for (int j = 0; j < 4; ++j) { const float r = sigmoidf_(o[0][j] + ba[j]), ig = sigmoidf_(o[1][j] + bx[j]), la = -r * sp[j]; av[j] = la; bv[j] = __builtin_amdgcn_sqrtf(fmaxf(one_minus_exp(2.0f * la), 0.0f)) * ig * xv[j]; }
                *(v2u*)((bf16*)(ws + WS_A) + ro) = (v2u){pk2(av[0], av[1]), pk2(av[2], av[3])}; *(v2u*)((bf16*)(ws + WS_XRBX) + ro) = (v2u){pk2(bv[0], bv[1]), pk2(bv[2], bv[3])}; } } } SEAM(3);
    if (IN(4)) { lru_l1_phase(F, (const bf16*)(ws + WS_A), (const bf16*)(ws + WS_XRBX), (float*)(ws + WS_PEND), (float*)(ws + WS_HEND)); } SEAM(4);
    if (IN(5)) { carry_phase(F, ws, (const bf16*)(ws + WS_A), (const bf16*)(ws + WS_XRBX), (const float*)(ws + WS_PEND), (const float*)(ws + WS_HEND), (float*)(ws + WS_CIN), (const bf16*)(ws + WS_U), (const float*)(ws + WS_SSE), (float*)(ws + WS_SSIN)); } SEAM(5);
    if (IN(6)) { mix0_final_phase(F, ws, (const bf16*)(ws + WS_A), (const bf16*)(ws + WS_XRBX), (const float*)(ws + WS_CIN), (const bf16*)(ws + WS_G), (bf16*)(ws + WS_AOUT), in[I_CRE], in[I_CIM], in[I_SD], (const bf16*)(ws + WS_U), (const float*)(ws + WS_SSIN), (bf16*)(ws + WS_GS)); } SEAM(6);
    if (IN(7)) { SchedStatic S{NPR, 2, F.G, cu, (const char*)(ws + WS_GS), (const char*)(ws + WS_GLUW), (size_t)256 * 512 * 2, (size_t)256 * 512 * 2, 0, 0}; EpiGlu E{in[I_GLUB], (const bf16*)(ws + WS_GS), (bf16*)(ws + WS_AOUT)};
        pg8::gemm_phase<EpiGlu, SchedStatic, false>(ring, 512, 512, S, E, notab);
        for (int t = cu; t < 32; t += F.G) { const int n0 = t * 16; const bf16* const br[1] = {(const bf16*)(ws + WS_GLUW) + (size_t)n0 * 512}; f32x4 o[1];
            meta_tile<1>(F, (const bf16*)(ws + WS_GS) + (size_t)RM0 * 512, 512, 512, br, 512, o);
            if (F.wave == 0) { const int row = RM0 + (F.lane & 15), c = n0 + 4 * (F.lane >> 4); const f32x4 b = *(const f32x4*)(in[I_GLUB] + c);
                const v2u gw = *(const v2u*)((const bf16*)(ws + WS_GS) + (size_t)row * 512 + c); const float gv[4] = {bflo(gw.x), bfhi(gw.x), bflo(gw.y), bfhi(gw.y)}; float v[4];
                for (int j = 0; j < 4; ++j) v[j] = gv[j] * sigmoidf_(o[0][j] + b[j]);
                *(v2u*)((bf16*)(ws + WS_AOUT) + (size_t)row * 1536 + 1024 + c) = (v2u){pk2(v[0], v[1]), pk2(v[2], v[3])}; } } } SEAM(7);
    if (IN(8)) { SchedStatic S{NPR, 4, F.G, cu, (const char*)(ws + WS_AOUT), (const char*)(ws + WS_WOUT0), (size_t)256 * 1536 * 2, (size_t)256 * 1536 * 2, 0, 0}; EpiResid E{in[I_X], HB};
        pg8::gemm_phase<EpiResid, SchedStatic, false>(ring, 1536, 1536, S, E, notab);
        for (int t = cu; t < 64; t += F.G) { const int n0 = t * 16; const bf16* const br[1] = {(const bf16*)(ws + WS_WOUT0) + (size_t)n0 * 1536}; f32x4 o[1];
            meta_tile<1>(F, (const bf16*)(ws + WS_AOUT) + (size_t)RM0 * 1536, 1536, 1536, br, 1536, o);
            if (F.wave == 0) { float* p = hmeta + (size_t)(F.lane & 15) * 1024 + n0 + 4 * (F.lane >> 4); *(f32x4*)p = *(const f32x4*)p + o[0]; } } } SEAM(8);
    if (IN(9)) { norm_phase(F, HB, hmeta, in[I_NORM_FFN0], HN, TR + NMETA); } SEAM(9);
    if (IN(10)) { SchedStatic S{NPR, 24, F.G, cu, (const char*)HN, (const char*)(ws + WS_WUP0), P1K, P1K, 0, 0}; EpiSwiglu E{(bf16*)(ws + WS_HID0), FF0};
        pg8::gemm_phase<EpiSwiglu, SchedStatic, false>(ring, 1024, 1024, S, E, notab);
        for (int t = cu; t < FF0 / 16; t += F.G) { const int u0 = t * 16; const bf16* gb = (const bf16*)(ws + WS_WUP0) + (size_t)((u0 >> 7) * 256 + (u0 & 127)) * 1024; const bf16* const br[2] = {gb, gb + 128 * 1024}; f32x4 o[2];
            meta_tile<2>(F, HN + (size_t)RM0 * 1024, 1024, 1024, br, 1024, o);
            if (F.wave == 0) { const int row = RM0 + (F.lane & 15), c = u0 + 4 * (F.lane >> 4); float v[4]; for (int j = 0; j < 4; ++j) v[j] = siluf_(o[0][j]) * o[1][j];
                *(v2u*)((bf16*)(ws + WS_HID0) + (size_t)row * FF0 + c) = (v2u){pk2(v[0], v[1]), pk2(v[2], v[3])}; } } } SEAM(10);
    if (IN(11)) { SchedStatic S{NPR, 4, F.G, cu, (const char*)(ws + WS_HID0), (const char*)(ws + WS_WDN0), (size_t)256 * FF0 * 2, (size_t)256 * FF0 * 2, 0, 0}; EpiResid E{nullptr, HB};
        pg8::gemm_phase<EpiResid, SchedStatic, false>(ring, FF0, FF0, S, E, notab);
        for (int t = cu; t < 64; t += F.G) { const int n0 = t * 16; const bf16* const br[1] = {(const bf16*)(ws + WS_WDN0) + (size_t)n0 * FF0}; f32x4 o[1];
            meta_tile<1>(F, (const bf16*)(ws + WS_HID0) + (size_t)RM0 * FF0, FF0, FF0, br, FF0, o);
            if (F.wave == 0) { float* p = hmeta + (size_t)(F.lane & 15) * 1024 + n0 + 4 * (F.lane >> 4); *(f32x4*)p = *(const f32x4*)p + o[0]; } } } SEAM(11);
    if (IN(12)) { norm_phase(F, HB, hmeta, in[I_NORM_MIX1], HN, TR + NMETA); } SEAM(12);
    if (IN(13)) { SchedStatic S{NPR, 14, F.G, cu, (const char*)HN, (const char*)(ws + WS_WIN1), P1K, P1K, 0, 0}; EpiWin1 E{(bf16*)(ws + WS_Q), (bf16*)(ws + WS_K), (bf16*)(ws + WS_V), (bf16*)(ws + WS_GATE), (float*)(ws + WS_LG), in[I_GB]};
        pg8::gemm_phase<EpiWin1, SchedStatic, false>(ring, 1024, 1024, S, E, notab);
        for (int t = cu; t < 128; t += F.G) { const int n0 = t < 32 ? 512 + t * 16 : (t < 96 ? 1024 + (t - 32) * 16 : 3072 + (t - 96) * 16); const bf16* const br[1] = {(const bf16*)(ws + WS_WIN1) + (size_t)n0 * 1024}; f32x4 o[1];
            meta_tile<1>(F, HN + (size_t)RM0 * 1024, 1024, 1024, br, 1024, o);
            if (F.wave == 0) { const int row = RM0 + (F.lane & 15), c = n0 + 4 * (F.lane >> 4); const f32x4 v = o[0];
                if (c < 1024) *(v2u*)((bf16*)(ws + WS_K) + (size_t)row * 512 + c - 512) = (v2u){pk2(v[0], v[1]), pk2(v[2], v[3])};
                else if (c < 2048) *(v2u*)((bf16*)(ws + WS_V) + (size_t)row * 1024 + c - 1024) = (v2u){pk2(v[0], v[1]), pk2(v[2], v[3])};
                else { const f32x4 b = *(const f32x4*)(in[I_GB] + c - 3072); f32x4 l; for (int j = 0; j < 4; ++j) l[j] = logsigmoidf_(v[j] + b[j]) * 0.0625f; *(f32x4*)((float*)(ws + WS_LG) + (size_t)row * 512 + c - 3072) = l; } } } } SEAM(13);
    if (IN(14)) { for (int it = cu; it < NB * GH * NSEG; it += F.G) gla_item<false>(F, it >> 6, (it >> 4) & 3, it & 15, (const bf16*)(ws + WS_Q), (const bf16*)(ws + WS_K), (const bf16*)(ws + WS_V), (const bf16*)(ws + WS_GATE), (const float*)(ws + WS_LG), in[I_GNORM], (float*)(ws + WS_GDS), (float*)(ws + WS_TAB + TB_GAM), (bf16*)(ws + WS_AOUT2)); } SEAM(14);
    if (IN(15)) { gla_l2_phase(F, (const bf16*)(ws + WS_K), (const bf16*)(ws + WS_V), (const float*)(ws + WS_LG), (float*)(ws + WS_GDS), (const float*)(ws + WS_TAB + TB_GAM)); } SEAM(15);
    if (IN(16)) { for (int it = cu; it < NB * GH * NSEG; it += F.G) gla_item<true>(F, it >> 6, (it >> 4) & 3, it & 15, (const bf16*)(ws + WS_Q), (const bf16*)(ws + WS_K), (const bf16*)(ws + WS_V), (const bf16*)(ws + WS_GATE), (const float*)(ws + WS_LG), in[I_GNORM], (float*)(ws + WS_GDS), (float*)(ws + WS_TAB + TB_GAM), (bf16*)(ws + WS_AOUT2)); } SEAM(16);
    if (IN(17)) { SchedStatic S{NPR, 4, F.G, cu, (const char*)(ws + WS_AOUT2), (const char*)(ws + WS_WOUT1), P1K, P1K, 0, 0}; EpiResid E{nullptr, HB};
        pg8::gemm_phase<EpiResid, SchedStatic, false>(ring, 1024, 1024, S, E, notab); } SEAM(17);
    if (IN(18)) { router_phase(F, args, ws); } SEAM(18);
    if (IN(19)) { moe_lists_phase(F, ws); } SEAM(19);
#define MOE_PHASES(pu, pd, slot) \
    if (IN(pu)) { const int np = ((const int*)(ws + WS_TAB + TB_NPAN))[slot], nun = np * 28; LAS int* meta = (LAS int*)(F.lds + TABL_OFF); LAS int* tokt = (LAS int*)(F.lds + TABL_OFF + 512); \
        const int* pexp = (const int*)(ws + WS_TAB + TB_PEXP) + (slot) * MPAN; const int* rowtok = (const int*)(ws + WS_ROWTOK) + (size_t)(slot) * MROWS; int nmy = 0; \
        __syncthreads(); \
        for (int i = 0; (long)i * F.G + cu < nun && i < 20; ++i) { const int Lq = i * F.G + cu, p = Lq / 28, n = Lq % 28; if (F.tid == 0) { meta[i * 4] = p; meta[i * 4 + 1] = n; meta[i * 4 + 2] = pexp[p]; meta[i * 4 + 3] = 0; } \
            if (F.tid < 256) tokt[i * 256 + F.tid] = rowtok[p * 256 + F.tid]; ++nmy; } \
        __syncthreads(); \
        SchedList S{nmy, meta, (const char*)(ws + WS_HNM), (const char*)(ws + WS_WMOE), 0, P1K, (size_t)7168 * 1024 * 2}; EpiSwiglu E{(bf16*)(ws + WS_HIDM), FFE}; \
        pg8::gemm_phase<EpiSwiglu, SchedList, true>(ring, 1024, 1024, S, E, tokt); } SEAM(pu); \
    if (IN(pd)) { const int np = ((const int*)(ws + WS_TAB + TB_NPAN))[slot], nun = np * 4, nfull = nun < 512 ? nun : 512, nrem = nun - nfull; LAS int* meta = (LAS int*)(F.lds + TABL_OFF); LAS int* tokt = (LAS int*)(F.lds + TABL_OFF + 512); LAS float* wtt = (LAS float*)(F.lds + TABL_OFF + 512 + 4096); \
        const int* pexp = (const int*)(ws + WS_TAB + TB_PEXP) + (slot) * MPAN; const int* rowtok = (const int*)(ws + WS_ROWTOK) + (size_t)(slot) * MROWS; const float* roww = (const float*)(ws + WS_ROWW) + (size_t)(slot) * MROWS; int nmy = 0; \
        __syncthreads(); \
        for (int i = 0; (long)i * F.G + cu < nfull && i < 3; ++i) { const int Lq = i * F.G + cu, p = Lq / 4, n = Lq % 4; if (F.tid == 0) { meta[i * 4] = p; meta[i * 4 + 1] = n; meta[i * 4 + 2] = pexp[p]; meta[i * 4 + 3] = 0; } \
            if (F.tid < 256) { tokt[i * 256 + F.tid] = rowtok[p * 256 + F.tid]; wtt[i * 256 + F.tid] = roww[p * 256 + F.tid]; } ++nmy; } \
        const bool slice = cu < nrem * 4;                   \
        if (slice && F.tid == 0) { const int Lq = 512 + cu / 4, p = Lq / 4, n = Lq % 4; meta[12] = p; meta[13] = n; meta[14] = pexp[p]; meta[15] = (cu & 3) * 896; } \
        __syncthreads(); \
        { SchedList S{nmy, meta, (const char*)(ws + WS_HIDM), (const char*)(ws + WS_WMOE) + (size_t)NE * 7168 * 1024 * 2, (size_t)256 * FFE * 2, (size_t)256 * FFE * 2, (size_t)1024 * FFE * 2}; EpiMoeDown E{HB, tokt, wtt}; \
          pg8::gemm_phase<EpiMoeDown, SchedList, false>(ring, FFE, FFE, S, E, tokt); } \
        { SchedList S{slice ? 1 : 0, meta + 12, (const char*)(ws + WS_HIDM), (const char*)(ws + WS_WMOE) + (size_t)NE * 7168 * 1024 * 2, (size_t)256 * FFE * 2, (size_t)256 * FFE * 2, (size_t)1024 * FFE * 2}; EpiSlab E{(float*)(ws + WS_SLAB), meta + 12}; \
          pg8::gemm_phase<EpiSlab, SchedList, false>(ring, 896, FFE, S, E, tokt, FFE); } } SEAM(pd);
    MOE_PHASES(20, 21, 0)
    if (IN(22)) { const int np0 = ((const int*)(ws + WS_TAB + TB_NPAN))[0]; const int nrow = (np0 - 128) * 256; const float* slab = (const float*)(ws + WS_SLAB); const int* rowtok = (const int*)(ws + WS_ROWTOK); const float* roww = (const float*)(ws + WS_ROWW);
        for (long i = F.gt; i < (long)nrow * 128; i += F.NGT) { const int r = (int)(i >> 7), c8 = (int)(i & 127) * 8; const int tok = rowtok[TR + r];
            if (tok >= 0) { const float w = roww[TR + r]; f32x4 s0 = *(const f32x4*)(slab + (size_t)r * 1024 + c8), s1 = *(const f32x4*)(slab + (size_t)r * 1024 + c8 + 4);
#pragma unroll
                for (int sl = 1; sl < 4; ++sl) { s0 += *(const f32x4*)(slab + ((size_t)sl * 2048 + r) * 1024 + c8); s1 += *(const f32x4*)(slab + ((size_t)sl * 2048 + r) * 1024 + c8 + 4); }
                bf16* d = HB + (size_t)tok * 1024 + c8; f32x4 v0, v1; unpack8(*(const v4u*)d, v0, v1); *(v4u*)d = pack8(v0 + s0 * w, v1 + s1 * w); } } }
    MOE_PHASES(22, 23, 1)
    if (IN(24)) { LAS int* Lb = (LAS int*)(F.lds + TABL_OFF); const unsigned* ctl_ = (const unsigned*)(ws + WS_CTL);
        __syncthreads();
        if (F.tid == 0) { int acc = 0; for (int e = 0; e < 8; ++e) { Lb[e] = acc; acc += ((int)__hip_atomic_load(ctl_ + CW_CNT + 8 + e, RLX_AGENT) + 255) & ~255; } }
        __syncthreads();
        const int* tokinfo1 = (const int*)(ws + WS_TOKINFO) + (size_t)TR * 4; const float* slab = (const float*)(ws + WS_SLAB); const float* fg = in[I_FNORM]; const int lane = F.lane;
        const f32x4 g0 = *(const f32x4*)(fg + 8 * lane), g1 = *(const f32x4*)(fg + 8 * lane + 4), g2 = *(const f32x4*)(fg + 512 + 8 * lane), g3 = *(const f32x4*)(fg + 512 + 8 * lane + 4);
#define FIN_ROW(m, wa, wb) do { f32x4 v[4]; unpack8(wa, v[0], v[1]); unpack8(wb, v[2], v[3]); \
            { const v4u inf = *(const v4u*)(tokinfo1 + (size_t)(m) * 4); const unsigned ex = inf.x, ps = inf.y, wbits = inf.z; const int r1 = Lb[ex] + (int)ps - TR; \
              if (r1 >= 0) { const float w = __uint_as_float(wbits); \
                _Pragma("unroll") for (int sl = 0; sl < 4; ++sl) { const float* sp = slab + ((size_t)sl * 2048 + r1) * 1024; \
                    v[0] += *(const f32x4*)(sp + 8 * lane) * w; v[1] += *(const f32x4*)(sp + 8 * lane + 4) * w; v[2] += *(const f32x4*)(sp + 512 + 8 * lane) * w; v[3] += *(const f32x4*)(sp + 512 + 8 * lane + 4) * w; } } } \
            float s_ = 0.f; _Pragma("unroll") for (int j = 0; j < 4; ++j) s_ += (v[j].x * v[j].x + v[j].y * v[j].y) + (v[j].z * v[j].z + v[j].w * v[j].w); \
            const float rstd = 1.0f / sqrtf(wave_sum(s_) * (1.0f / 1024.0f) + EPS); float* orow = out + (size_t)(m) * 1024; \
            *(f32x4*)(orow + 8 * lane) = v[0] * rstd * g0; *(f32x4*)(orow + 8 * lane + 4) = v[1] * rstd * g1; *(f32x4*)(orow + 512 + 8 * lane) = v[2] * rstd * g2; *(f32x4*)(orow + 512 + 8 * lane + 4) = v[3] * rstd * g3; } while (0)
        for (int m = F.gw; m < TR / 2; m += 2 * F.NGW) { const int m2 = m + F.NGW; const v4u wa = *(const v4u*)(HB + (size_t)m * 1024 + 8 * lane), wb = *(const v4u*)(HB + (size_t)m * 1024 + 512 + 8 * lane);
            v4u wc = wa, wd = wb; if (m2 < TR / 2) { wc = *(const v4u*)(HB + (size_t)m2 * 1024 + 8 * lane); wd = *(const v4u*)(HB + (size_t)m2 * 1024 + 512 + 8 * lane); }
            FIN_ROW(m, wa, wb); if (m2 < TR / 2) FIN_ROW(m2, wc, wd); }
        v4u ra[8], rb[8];
        for (int base = TR / 2; base < TR; base += 8 * F.NGW) {
#pragma unroll
            for (int j = 0; j < 8; ++j) { const int m = base + F.gw + j * F.NGW; if (m < TR) { ra[j] = *(const v4u*)(HB + (size_t)m * 1024 + 8 * lane); rb[j] = *(const v4u*)(HB + (size_t)m * 1024 + 512 + 8 * lane); } }
            GRID_BAR();
#pragma unroll
            for (int j = 0; j < 8; ++j) { const int m = base + F.gw + j * F.NGW; if (m < TR) FIN_ROW(m, ra[j], rb[j]); }
        }
#undef FIN_ROW
    }
#undef IN
#undef SEAM
}

extern "C" void kernel_launch(void* const* d_in, const int* in_sizes, int n_in, void* d_out, int out_size, void* d_ws, size_t ws_size, hipStream_t stream) {
    static int grid = 0;
    if (grid == 0) {
        if (n_in != 38 || out_size != TR * D || ws_size < WS_END) { fprintf(stderr, "kernel_launch: unexpected problem shape (n_in %d, out %d, ws %zu); nothing launched\n", n_in, out_size, ws_size); grid = -1; return; }
        int dev = 0, cus = 0, per_cu = 0;
        if (hipGetDevice(&dev) != hipSuccess || hipDeviceGetAttribute(&cus, hipDeviceAttributeMultiprocessorCount, dev) != hipSuccess) { grid = -1; return; }
        if (hipFuncSetAttribute((const void*)mk_fwd, hipFuncAttributeMaxDynamicSharedMemorySize, LDS_BYTES) != hipSuccess) { fprintf(stderr, "kernel_launch: hipFuncSetAttribute failed\n"); grid = -1; return; }
        if (hipOccupancyMaxActiveBlocksPerMultiprocessor(&per_cu, (const void*)mk_fwd, 512, LDS_BYTES) != hipSuccess || per_cu < 1) fprintf(stderr, "kernel_launch: note: occupancy query reports %d workgroups per CU\n", per_cu);
        (void)hipGetLastError();
        grid = cus;
    }
    if (grid < 0) return;
    (void)hipMemsetAsync((char*)d_ws + WS_CTL, 0, CTL_ZERO_BYTES, stream);
    Args a{};
    for (int i = 0; i < 38; ++i) a.in[i] = (const float*)d_in[i];
    a.out = (float*)d_out; a.ws = (unsigned char*)d_ws; a.li = 0; a.pad = 0;
#if MK_PER_PHASE
    for (int k = 0; k < N_PHASES; ++k) { a.ph_lo = k; a.ph_hi = k + 1; hipLaunchKernelGGL(mk_fwd, dim3(grid), dim3(512), LDS_BYTES, stream, a); }
#else
    a.ph_lo = 0; a.ph_hi = N_PHASES; hipLaunchKernelGGL(mk_fwd, dim3(grid), dim3(512), LDS_BYTES, stream, a);
#endif
}
```

```cpp
#include <hip/hip_runtime.h>
#include <cstdio>
#include <cstdint>

#ifndef MK_PER_PHASE
#define MK_PER_PHASE 0
#endif

#define GAS __attribute__((address_space(1)))
#define LAS __attribute__((address_space(3)))
typedef unsigned short bf16;
typedef unsigned v4u __attribute__((ext_vector_type(4)));
typedef unsigned v2u __attribute__((ext_vector_type(2)));
typedef float f32x4 __attribute__((ext_vector_type(4)));
typedef float f32x2 __attribute__((ext_vector_type(2)));
typedef short bf16x8 __attribute__((ext_vector_type(8)));

constexpr int D = 1024, NB = 4, SEQ = 8192, NMETA = 16;
constexpr int TR = NB * SEQ;
constexpr int RM0 = TR;
constexpr int NPR = 128, NPA = 129;
constexpr int RALL = NPA * 256;
constexpr int LRUW = 1024, SSMW = 512, NG = 32, NS = 64, EV_IN = 2560, EV_MIX = 1536, FF0 = 3072;
constexpr int GK = 512, GV = 1024, GH = 4, GDK = 128, GDV = 256, OD_INP = 3584  , OD_IN = 3088;
constexpr int NE = 8, FFE = 3584, MROWS = 34816  , MPAN = 136;
constexpr float EPS = 1e-6f;
constexpr int NCH = 128;
constexpr int NSEG = 16, SEGC = 8;

constexpr size_t MiB = 1u << 20;
constexpr size_t WS_CTL = 0, CTL_ZERO_BYTES = 1 * MiB;
constexpr size_t WS_TAB = 1 * MiB;
constexpr size_t WS_WIN0 = 2 * MiB, WS_GW = 7 * MiB, WS_GLUW = 8 * MiB, WS_WOUT0 = 9 * MiB, WS_WUP0 = 12 * MiB, WS_WDN0 = 24 * MiB, WS_WIN1 = 30 * MiB, WS_WOUT1 = 37 * MiB;
constexpr size_t WS_PEND = 40 * MiB, WS_HEND = 42 * MiB, WS_CIN = 44 * MiB, WS_SSE = 46 * MiB, WS_SSIN = 54 * MiB, WS_GDS = 62 * MiB, WS_HMETA = 94 * MiB;
constexpr size_t WS_G = 96 * MiB, WS_U = 161 * MiB, WS_A = 194 * MiB, WS_XRBX = 323 * MiB, WS_HN = 388 * MiB, WS_AOUT = 388 * MiB, WS_XC = 453 * MiB, WS_GS = 485 * MiB;
constexpr size_t WS_HID0 = 96 * MiB;
constexpr size_t WS_WE = 62 * MiB;
constexpr size_t WS_Q = 96 * MiB, WS_K = 129 * MiB, WS_V = 162 * MiB, WS_GATE = 227 * MiB, WS_LG = 292 * MiB, WS_AOUT2 = 453 * MiB;
constexpr size_t WS_SLAB = 2 * MiB  , WS_HNM = 40 * MiB, WS_WMOE = 105 * MiB, WS_HIDM = 273 * MiB, WS_TOKINFO = 511 * MiB, WS_ROWTOK = 512 * MiB, WS_ROWW = 512 * MiB + 512 * 1024, WS_END = 513 * MiB;
constexpr size_t TB_BBR = 0, TB_BBI = 131072, TB_AR = 262144, TB_AI = 270336, TB_AR64 = 278528, TB_AI64 = 286720, TB_SP8 = 294912, TB_GAM = 299008  , TB_PEXP = 430080  , TB_NPAN = 432128;
constexpr int CW_TMO = 0, CW_CODE = 1, CW_CNT = 64  , CW_BAR = 4096;

constexpr int RING_OFF = 0, RING_BYTES = 131072;
constexpr int TABL_OFF = RING_BYTES, TABL_BYTES = 24576;
constexpr int MISC_OFF = TABL_OFF + TABL_BYTES;
constexpr int LDS_BYTES = MISC_OFF + 128;

#define RLX_AGENT __ATOMIC_RELAXED, __HIP_MEMORY_SCOPE_AGENT
#define LDS_WAIT() asm volatile("s_waitcnt lgkmcnt(0)" ::: "memory")
#define VM_WAIT() asm volatile("s_waitcnt vmcnt(0)" ::: "memory")
__device__ __forceinline__ unsigned f2bf(float f) { unsigned u = __builtin_bit_cast(unsigned, f); return (u + 0x7fffu + ((u >> 16) & 1u)) >> 16; }
__device__ __forceinline__ unsigned pk2(float lo, float hi) { return f2bf(lo) | (f2bf(hi) << 16); }
__device__ __forceinline__ float bf2f(unsigned b) { return __builtin_bit_cast(float, b << 16); }
__device__ __forceinline__ float bflo(unsigned w) { return __builtin_bit_cast(float, w << 16); }
__device__ __forceinline__ float bfhi(unsigned w) { return __builtin_bit_cast(float, w & 0xffff0000u); }
__device__ __forceinline__ float rcpf_(float x) { return __builtin_amdgcn_rcpf(x); }
__device__ __forceinline__ float sigmoidf_(float x) { return rcpf_(1.0f + __expf(-x)); }
__device__ __forceinline__ float siluf_(float x) { return x * rcpf_(1.0f + __expf(-x)); }
__device__ __forceinline__ float gelu_tanh(float x) { const float u = 0.7978845608028654f * (x + 0.044715f * x * x * x); return x * rcpf_(1.0f + __expf(-2.0f * u)); }
__device__ __forceinline__ float one_minus_exp(float x) { const float p = -x * (1.0f + 0.5f * x * (1.0f + (1.0f / 3.0f) * x * (1.0f + 0.25f * x * (1.0f + 0.2f * x * (1.0f + (1.0f / 6.0f) * x))))); return x > -0.25f ? p : 1.0f - __expf(x); }
__device__ __forceinline__ float logsigmoidf_(float x) { return fminf(x, 0.0f) - log1pf(__expf(-fabsf(x))); }
__device__ __forceinline__ float wave_sum(float v) {
#pragma unroll
    for (int o = 1; o < 64; o <<= 1) v += __shfl_xor(v, o);
    return v;
}

namespace pg8 {
constexpr int BM = 256, BK = 64, HALF = 128, HTB = HALF * BK * 2, STAGE_BYTES = 8 * HTB, NXCD = 8, WGM = 8;
__host__ __device__ __forceinline__ int lds_byte(int r, int c) { const int st = (r >> 4) * 2 + (c >> 5), rr = r & 15, cc = c & 31, ob = rr * 64 + cc * 2; return st * 1024 + (ob ^ (((ob >> 9) & 1) << 5)); }
__host__ __device__ __forceinline__ void stage_rc(int b, int& R, int& C) { const int st = b / 1024, sb = b % 1024, swz = sb ^ (((sb >> 9) & 1) << 5); R = (st >> 1) * 16 + swz / 64; C = (st & 1) * 32 + (swz % 64) / 2; }
__host__ __device__ __forceinline__ int perm32(int rho) { const int n = rho >> 4, i = rho & 15; return 8 * (i >> 2) + 4 * n + (i & 3); }

struct Unit { int pm, pn, slot; const char* a; const char* b; };
__device__ __forceinline__ bool static_tile(int i, int G, int c, int nM, int nN, int& pm, int& pn) {
    const int nwg = nM * nN; const long L = (long)i * G + c; if (L >= nwg) return false;
    int wgid = (int)L; { const int q = nwg / NXCD, r = nwg % NXCD, xcd = wgid % NXCD, off = wgid / NXCD; wgid = (xcd < r ? xcd * (q + 1) : r * (q + 1) + (xcd - r) * q) + off; }
    const int nig = WGM * nN, gid = wgid / nig, fm = gid * WGM, gsz = (nM - fm) < WGM ? (nM - fm) : WGM;
    pm = fm + ((wgid % nig) % gsz); pn = (wgid % nig) / gsz; return true;
}
__device__ __forceinline__ unsigned cvt_pk_bf16(float lo, float hi) { unsigned r; asm volatile("v_cvt_pk_bf16_f32 %0, %1, %2" : "=v"(r) : "v"(lo), "v"(hi)); return r; }

template <class Epi, class Sched, bool GATHER>
__device__ __forceinline__ void gemm_phase(LAS unsigned char* lds, const int K, const int lda, const Sched& S, const Epi& E, const LAS int* gtab, const int ldb_ = 0) {
    const int tid = threadIdx.x, wid = __builtin_amdgcn_readfirstlane(tid >> 6), lane = tid & 63, wr = wid >> 2, wc = wid & 3, fr = lane & 15, fq = lane >> 4;
    int nt = K / BK; asm volatile("" : "+s"(nt));
    int RA[2], CA[2]; unsigned voffB[2];
#pragma unroll
    for (int i = 0; i < 2; ++i) { int R, C; stage_rc(tid * 16 + i * 8192, R, C); const int Rb = Epi::PERM ? ((R & ~31) + perm32(R & 31)) : R;
        RA[i] = R; CA[i] = C; voffB[i] = (unsigned)(Rb * (ldb_ ? ldb_ : K) + C) * 2u; }
    const size_t kstep = (size_t)(BK * 2);
    const size_t hstepB = (size_t)HALF * (ldb_ ? ldb_ : K) * 2;
    const unsigned ldsw = (unsigned)wid * 1024u;
    const int aoff = lds_byte(wr * 64 + fr, fq * 8), boff = lds_byte(wc * 32 + fr, fq * 8);
    unsigned offC[2][2], offN[2][2];
#define PG8_SETOFF(dst, unit) do { _Pragma("unroll") for (int _h = 0; _h < 2; ++_h) _Pragma("unroll") for (int _i = 0; _i < 2; ++_i) { \
        if constexpr (GATHER) { int _t = gtab[(unit).slot * 256 + _h * HALF + RA[_i]]; _t = _t < 0 ? 0 : _t; dst[_h][_i] = ((unsigned)_t * (unsigned)lda + (unsigned)CA[_i]) * 2u; } \
        else dst[_h][_i] = ((unsigned)(_h * HALF + RA[_i]) * (unsigned)lda + (unsigned)CA[_i]) * 2u; } } while (0)
#define PG8_SA(b, h) (((b) * 2 + (h)) * HTB)
#define PG8_SB(b, h) ((4 + (b) * 2 + (h)) * HTB)
#define PG8_STAGEB(bufoff, gbase) do { _Pragma("unroll") for (int _i = 0; _i < 2; ++_i) \
        __builtin_amdgcn_global_load_lds((const unsigned*)((const char*)(gbase) + voffB[_i]), (LAS unsigned*)(lds + (bufoff) + ldsw + _i * 8192), 16, 0, 0); } while (0)
#define PG8_STAGEA(bufoff, gbase, o0, o1) do { \
        __builtin_amdgcn_global_load_lds((const unsigned*)((const char*)(gbase) + (o0)), (LAS unsigned*)(lds + (bufoff) + ldsw), 16, 0, 0); \
        __builtin_amdgcn_global_load_lds((const unsigned*)((const char*)(gbase) + (o1)), (LAS unsigned*)(lds + (bufoff) + ldsw + 8192), 16, 0, 0); } while (0)
#define PG8_LDA(dst, b, h) do { _Pragma("unroll") for (int m = 0; m < 4; ++m) _Pragma("unroll") for (int k = 0; k < 2; ++k) dst[m][k] = *(const LAS bf16x8*)(lds + PG8_SA(b, h) + aoff + m * 2048 + k * 1024); } while (0)
#define PG8_LDB(dst, b, h) do { _Pragma("unroll") for (int n = 0; n < 2; ++n) _Pragma("unroll") for (int k = 0; k < 2; ++k) dst[n][k] = *(const LAS bf16x8*)(lds + PG8_SB(b, h) + boff + n * 2048 + k * 1024); } while (0)
#define PG8_MMA(ai, bj, At, Bt) do { __builtin_amdgcn_s_setprio(1); _Pragma("unroll") for (int m = 0; m < 4; ++m) _Pragma("unroll") for (int n = 0; n < 2; ++n) _Pragma("unroll") for (int k = 0; k < 2; ++k) \
        acc[ai][bj][m][n] = __builtin_amdgcn_mfma_f32_16x16x32_bf16(Bt[n][k], At[m][k], acc[ai][bj][m][n], 0, 0, 0); __builtin_amdgcn_s_setprio(0); } while (0)
#define PG8_WAIT_V(n) asm volatile("s_waitcnt vmcnt(" #n ")" ::: "memory")
#define PG8_WAIT_L(n) asm volatile("s_waitcnt lgkmcnt(" #n ")" ::: "memory")
#define PG8_BAR __builtin_amdgcn_s_barrier()
#define PG8_SCHED __builtin_amdgcn_sched_barrier(0)
    Unit cur, nxt; int ui = 0;
    if (!S.next(0, cur)) return;
    f32x4 acc[2][2][4][2];
#pragma unroll
    for (int a = 0; a < 2; ++a)
#pragma unroll
        for (int b = 0; b < 2; ++b)
#pragma unroll
            for (int m = 0; m < 4; ++m)
#pragma unroll
                for (int n = 0; n < 2; ++n) acc[a][b][m][n] = (f32x4){0.f, 0.f, 0.f, 0.f};
    bf16x8 At[4][2], B0[2][2], B1[2][2];
    const char* cA = cur.a; const char* cB = cur.b;
    PG8_SETOFF(offC, cur);
    PG8_STAGEB(PG8_SB(0, 0), cB); PG8_STAGEB(PG8_SB(0, 1), cB + hstepB); PG8_STAGEA(PG8_SA(0, 0), cA, offC[0][0], offC[0][1]); PG8_STAGEA(PG8_SA(0, 1), cA, offC[1][0], offC[1][1]);
    if (wr == 1) PG8_BAR;
    PG8_WAIT_V(2); PG8_BAR;
    PG8_STAGEB(PG8_SB(1, 0), cB + kstep); PG8_STAGEA(PG8_SA(1, 0), cA + kstep, offC[0][0], offC[0][1]); PG8_STAGEB(PG8_SB(1, 1), cB + hstepB + kstep);
    PG8_WAIT_V(6); PG8_BAR;
    for (;;) {
        const bool has_next = S.next(ui + 1, nxt);
        const char* nA = has_next ? nxt.a : cA; const char* nB = has_next ? nxt.b : cB;
        if constexpr (GATHER) {
#pragma unroll
        for (int h = 0; h < 2; ++h)
#pragma unroll
            for (int i = 0; i < 2; ++i) offN[h][i] = offC[h][i]; }
        for (int t = 0; t < nt; t += 2) {
            const bool last = (t == nt - 2);
            const char* a1 = cA + (size_t)(t + 1) * kstep;
            const char* a2 = last ? nA : cA + (size_t)(t + 2) * kstep; const char* b2 = last ? nB : cB + (size_t)(t + 2) * kstep;
            const char* a3 = a2 + kstep; const char* b3 = b2 + kstep;
            if constexpr (GATHER) { if (last && has_next) PG8_SETOFF(offN, nxt); }
            unsigned q00 = offC[0][0], q01 = offC[0][1], q10 = offC[1][0], q11 = offC[1][1];
            if constexpr (GATHER) { q00 = last ? offN[0][0] : q00; q01 = last ? offN[0][1] : q01; q10 = last ? offN[1][0] : q10; q11 = last ? offN[1][1] : q11; }
            PG8_LDB(B0, 0, 0); PG8_LDB(B1, 0, 1); PG8_SCHED; PG8_LDA(At, 0, 0); PG8_STAGEA(PG8_SA(1, 1), a1, offC[1][0], offC[1][1]);
            PG8_WAIT_V(8); PG8_WAIT_L(0); PG8_BAR; PG8_MMA(0, 0, At, B0); PG8_MMA(0, 1, At, B1); PG8_BAR; PG8_SCHED;
            PG8_LDA(At, 0, 1); PG8_STAGEB(PG8_SB(0, 0), b2); PG8_STAGEB(PG8_SB(0, 1), b2 + hstepB); PG8_STAGEA(PG8_SA(0, 0), a2, q00, q01);
            PG8_WAIT_V(8); PG8_WAIT_L(0); PG8_BAR; PG8_MMA(1, 0, At, B0); PG8_MMA(1, 1, At, B1); PG8_BAR; PG8_SCHED;
            PG8_LDB(B0, 1, 0); PG8_LDB(B1, 1, 1); PG8_SCHED; PG8_LDA(At, 1, 0); PG8_STAGEA(PG8_SA(0, 1), a2, q10, q11);
            PG8_WAIT_V(8); PG8_WAIT_L(0); PG8_BAR; PG8_MMA(0, 0, At, B0); PG8_MMA(0, 1, At, B1); PG8_BAR; PG8_SCHED;
            PG8_LDA(At, 1, 1); PG8_STAGEB(PG8_SB(1, 0), b3); PG8_STAGEB(PG8_SB(1, 1), b3 + hstepB); PG8_STAGEA(PG8_SA(1, 0), a3, q00, q01);
            PG8_WAIT_V(8); PG8_WAIT_L(0); PG8_BAR; PG8_MMA(1, 0, At, B0); PG8_MMA(1, 1, At, B1); PG8_BAR; PG8_SCHED;
        }
        if (wr == 0) PG8_BAR;
        E(acc, cur, wr, wc, fr, fq);
        if (!has_next) break;
#pragma unroll
        for (int a = 0; a < 2; ++a)
#pragma unroll
            for (int b = 0; b < 2; ++b)
#pragma unroll
                for (int m = 0; m < 4; ++m)
#pragma unroll
                    for (int n = 0; n < 2; ++n) acc[a][b][m][n] = (f32x4){0.f, 0.f, 0.f, 0.f};
        cur = nxt; cA = nA; cB = nB; ++ui;
        if constexpr (GATHER) {
#pragma unroll
        for (int h = 0; h < 2; ++h)
#pragma unroll
            for (int i = 0; i < 2; ++i) offC[h][i] = offN[h][i]; }
        if (wr == 1) PG8_BAR;
    }
    PG8_WAIT_V(0);
    PG8_BAR;
#undef PG8_SETOFF
#undef PG8_SA
#undef PG8_SB
#undef PG8_STAGEA
#undef PG8_STAGEB
#undef PG8_LDA
#undef PG8_LDB
#undef PG8_MMA
#undef PG8_WAIT_V
#undef PG8_WAIT_L
#undef PG8_BAR
#undef PG8_SCHED
}
}

#define XB_TMO      128
#define XB_XCNT(j)  (256  + 64 * (j))
#define XB_XSUB(j)  (1280 + 64 * (j))
#define XB_XGEN(j)  (2304 + 64 * (j))
#define XB_TOP      3328
#define XB_TOPGEN   3392
#define XCD_BAR_WORDS 3456
#define XB_SPIN_CAP (1u << 18)
__device__ __forceinline__ unsigned xb_ld(unsigned* p)              { return __hip_atomic_load(p, __ATOMIC_RELAXED, __HIP_MEMORY_SCOPE_AGENT); }
__device__ __forceinline__ unsigned xb_add(unsigned* p, unsigned v) { return __hip_atomic_fetch_add(p, v, __ATOMIC_RELAXED, __HIP_MEMORY_SCOPE_AGENT); }
__device__ __forceinline__ unsigned xb_xcc_id() { return (unsigned)__builtin_amdgcn_s_getreg((3 << 11) | 20) & 0xFu; }
#define XB_SPIN(cond, bar) do { unsigned _sp = 0; while (cond) { __builtin_amdgcn_s_sleep(1); \
    if ((++_sp & 255u) == 0u) { if (xb_ld(&(bar)[XB_TMO])) break; if (_sp > XB_SPIN_CAP) { atomicAdd(&(bar)[XB_TMO], 1u); break; } } } } while (0)
struct XcdBarrier { unsigned* bar; unsigned x; volatile LAS unsigned* st; };
__device__ __forceinline__ XcdBarrier xcd_barrier_post(unsigned* bar, volatile LAS unsigned* st) {
    XcdBarrier b; b.bar = bar; b.x = xb_xcc_id(); b.st = st;
    if (threadIdx.x == 0) (void)xb_add(&bar[XB_XCNT(b.x)], 1u);
    return b;
}
__device__ __forceinline__ void xcd_barrier_complete(unsigned* bar, unsigned x, unsigned& nloc, unsigned& nx) {
    const unsigned G = gridDim.x * gridDim.y * gridDim.z;
    unsigned sum, cnt, mine, sp = 0u;
    for (;;) {
        sum = 0u; cnt = 0u; mine = 0u;
#pragma unroll
        for (unsigned j = 0; j < 16; ++j) { const unsigned c = xb_ld(&bar[XB_XCNT(j)]); sum += c; cnt += (c > 0u) ? 1u : 0u; mine = (j == x) ? c : mine; }
        if (sum == G) break;
        __builtin_amdgcn_s_sleep(1);
        if ((++sp & 255u) == 0u) { if (xb_ld(&bar[XB_TMO])) break; if (sp > XB_SPIN_CAP) { atomicAdd(&bar[XB_TMO], 1u); break; } }
    }
    nloc = mine > 0u ? mine : 1u; nx = cnt > 0u ? cnt : 1u;
}
__device__ __forceinline__ void xcd_barrier(const XcdBarrier& b) {
    asm volatile("s_waitcnt vmcnt(0)" ::: "memory");
    __syncthreads();
    if (threadIdx.x == 0) {
        unsigned* bar = b.bar;
        __builtin_amdgcn_s_waitcnt(0);
        unsigned nloc = b.st[0], nx = b.st[1];
        if (nloc == 0u) { xcd_barrier_complete(bar, b.x, nloc, nx); b.st[0] = nloc; b.st[1] = nx; }
        const unsigned old = xb_add(&bar[XB_XSUB(b.x)], 1u);
        const unsigned gen = old / nloc;
        if (old + 1u == (gen + 1u) * nloc) {
            __builtin_amdgcn_fence(__ATOMIC_RELEASE, "agent");
            asm volatile("s_waitcnt vmcnt(0)" ::: "memory");
            const unsigned og = xb_add(&bar[XB_TOP], 1u);
            const unsigned tg = og / nx;
            if (og + 1u == (tg + 1u) * nx) xb_add(&bar[XB_TOPGEN], 1u);
            else XB_SPIN(xb_ld(&bar[XB_TOPGEN]) == tg, bar);
            __builtin_amdgcn_fence(__ATOMIC_ACQUIRE, "agent");
            xb_add(&bar[XB_XGEN(b.x)], 1u);
            asm volatile("s_waitcnt vmcnt(0)" ::: "memory");
        } else {
            XB_SPIN(xb_ld(&bar[XB_XGEN(b.x)]) == gen, bar);
            __builtin_amdgcn_fence(__ATOMIC_ACQUIRE, "agent");
            asm volatile("s_waitcnt vmcnt(0)" ::: "memory");
        }
    }
    __syncthreads();
}

struct Args { const float* in[38]; float* out; unsigned char* ws; int ph_lo, ph_hi, li, pad; };
struct Frame {
    LAS unsigned char* lds;
    int tid, lane, wave, G, gw, NGW;
    int gt, NGT;
};
enum { I_X = 0, I_META, I_NORM_MIX0, I_WIN0, I_CONVW, I_CONVB, I_GAW, I_GAB, I_GXW, I_GXB, I_LAM, I_LRE, I_LIM, I_LDT, I_BRE, I_BIM, I_CRE, I_CIM, I_SD, I_GLUW, I_GLUB, I_WOUT0, I_NORM_FFN0,
       I_FG, I_FU, I_FD, I_NORM_MIX1, I_WIN1, I_GW2, I_GB, I_GNORM, I_WOUT1, I_NORM_FFN1, I_ROUTER, I_MG, I_MU, I_MD, I_FNORM };

struct SchedStatic {
    int nM, nN, G, c; const char* A; const char* B; size_t aStep, bStep; int aColDiv; size_t aColStep;
    __device__ __forceinline__ bool next(int i, pg8::Unit& u) const {
        int pm, pn; if (!pg8::static_tile(i, G, c, nM, nN, pm, pn)) return false;
        u.pm = pm; u.pn = pn; u.slot = i; u.a = A + (size_t)pm * aStep + (aColDiv ? (size_t)(pn / aColDiv) * aColStep : 0); u.b = B + (size_t)pn * bStep; return true;
    }
};
struct SchedList {
    int n; const LAS int* meta; const char* A; const char* B; size_t aStep, bTile, bExpert;
    __device__ __forceinline__ bool next(int i, pg8::Unit& u) const {
        if (i >= n) return false;
        const int pm = meta[i * 4 + 0], pn = meta[i * 4 + 1], e = meta[i * 4 + 2];
        u.pm = pm; u.pn = pn; u.slot = i; const int ko = meta[i * 4 + 3]; u.a = A + (size_t)pm * aStep + (size_t)ko * 2; u.b = B + (size_t)e * bExpert + (size_t)pn * bTile + (size_t)ko * 2; return true;
    }
};

#define EPI_ROWS(ai, m) ((ai) * 128 + wr * 64 + (m) * 16 + fr)
#define EPI_COLP(bj) ((bj) * 128 + wc * 32 + 8 * fq)
#define EPI_COLN(bj, n) ((bj) * 128 + wc * 32 + 16 * (n) + 4 * fq)
typedef const f32x4 (&AccRef)[2][2][4][2];
__device__ __forceinline__ void unpack8(v4u w, f32x4& a, f32x4& b) { a = (f32x4){bflo(w.x), bfhi(w.x), bflo(w.y), bfhi(w.y)}; b = (f32x4){bflo(w.z), bfhi(w.z), bflo(w.w), bfhi(w.w)}; }
__device__ __forceinline__ v4u pack8(f32x4 a, f32x4 b) { v4u w; w.x = pg8::cvt_pk_bf16(a[0], a[1]); w.y = pg8::cvt_pk_bf16(a[2], a[3]); w.z = pg8::cvt_pk_bf16(b[0], b[1]); w.w = pg8::cvt_pk_bf16(b[2], b[3]); return w; }

struct EpiWin0 {
    static constexpr bool PERM = true; bf16 *G, *XR, *U;
    __device__ __forceinline__ void operator()(AccRef acc, const pg8::Unit& u, int wr, int wc, int fr, int fq) const {
        const int pn = u.pn; bf16* base; int ld, c0;
        if (pn < 4) { base = G; ld = 1024; c0 = pn * 256; } else if (pn < 8) { base = XR; ld = 1024; c0 = (pn - 4) * 256; } else { base = U; ld = 512; c0 = (pn - 8) * 256; }
#pragma unroll
        for (int ai = 0; ai < 2; ++ai)
#pragma unroll
            for (int m = 0; m < 4; ++m) { bf16* rowp = base + (size_t)(u.pm * 256 + EPI_ROWS(ai, m)) * ld + c0;
#pragma unroll
                for (int bj = 0; bj < 2; ++bj) { f32x4 v0 = acc[ai][bj][m][0], v1 = acc[ai][bj][m][1];
                    if (pn < 4) {
#pragma unroll
                        for (int j = 0; j < 4; ++j) { v0[j] = gelu_tanh(v0[j]); v1[j] = gelu_tanh(v1[j]); } }
                    *(v4u*)(rowp + EPI_COLP(bj)) = pack8(v0, v1); } }
    }
};
struct EpiGates {
    static constexpr bool PERM = true; const float *gab, *gxb, *sp8; const bf16* XC; bf16* A; bf16* BX;
    __device__ __forceinline__ void operator()(AccRef acc, const pg8::Unit& u, int wr, int wc, int fr, int fq) const {
        const int ch0 = (u.pn >> 1) * 256 + (u.pn & 1) * 128 + wc * 32 + 8 * fq;
        f32x4 ba[2], bx[2], sp[2];
#pragma unroll
        for (int n = 0; n < 2; ++n) { ba[n] = *(const f32x4*)(gab + ch0 + 4 * n); bx[n] = *(const f32x4*)(gxb + ch0 + 4 * n); sp[n] = *(const f32x4*)(sp8 + ch0 + 4 * n); }
#pragma unroll
        for (int ai = 0; ai < 2; ++ai)
#pragma unroll
            for (int m = 0; m < 4; ++m) { const size_t ro = (size_t)(u.pm * 256 + EPI_ROWS(ai, m)) * 1024 + ch0;
                const v4u xw = *(const v4u*)(XC + ro); const float xv[8] = {bflo(xw.x), bfhi(xw.x), bflo(xw.y), bfhi(xw.y), bflo(xw.z), bfhi(xw.z), bflo(xw.w), bfhi(xw.w)};
                f32x4 av[2], bv[2];
#pragma unroll
                for (int n = 0; n < 2; ++n)
#pragma unroll
                    for (int j = 0; j < 4; ++j) { const float r = sigmoidf_(acc[ai][0][m][n][j] + ba[n][j]), ig = sigmoidf_(acc[ai][1][m][n][j] + bx[n][j]);
                        const float la = -r * sp[n][j], aa = __expf(la); av[n][j] = la; bv[n][j] = __builtin_amdgcn_sqrtf(fmaxf(__builtin_fmaf(-aa, aa, 1.0f), 0.0f)) * ig * xv[4 * n + j]; }
                *(v4u*)(A + ro) = pack8(av[0], av[1]); *(v4u*)(BX + ro) = pack8(bv[0], bv[1]); asm volatile("" ::: "memory"); }
    }
};
struct EpiGlu {
    static constexpr bool PERM = true; const float* glub; const bf16* GS; bf16* AOUT;
    __device__ __forceinline__ void operator()(AccRef acc, const pg8::Unit& u, int wr, int wc, int fr, int fq) const {
#pragma unroll
        for (int bj = 0; bj < 2; ++bj) { const int c = u.pn * 256 + EPI_COLP(bj); const f32x4 b0 = *(const f32x4*)(glub + c), b1 = *(const f32x4*)(glub + c + 4);
#pragma unroll
            for (int ai = 0; ai < 2; ++ai)
#pragma unroll
                for (int m = 0; m < 4; ++m) { const size_t row = (size_t)(u.pm * 256 + EPI_ROWS(ai, m));
                    const v4u gw = *(const v4u*)(GS + row * 512 + c); const float gv[8] = {bflo(gw.x), bfhi(gw.x), bflo(gw.y), bfhi(gw.y), bflo(gw.z), bfhi(gw.z), bflo(gw.w), bfhi(gw.w)};
                    f32x4 v0, v1;
#pragma unroll
                    for (int j = 0; j < 4; ++j) { v0[j] = gv[j] * sigmoidf_(acc[ai][bj][m][0][j] + b0[j]); v1[j] = gv[4 + j] * sigmoidf_(acc[ai][bj][m][1][j] + b1[j]); }
                    *(v4u*)(AOUT + row * 1536 + 1024 + c) = pack8(v0, v1); } }
    }
};
struct EpiResid {
    static constexpr bool PERM = true; const float* xsrc; bf16* hb;
    __device__ __forceinline__ void operator()(AccRef acc, const pg8::Unit& u, int wr, int wc, int fr, int fq) const {
#pragma unroll
        for (int ai = 0; ai < 2; ++ai)
#pragma unroll
            for (int m = 0; m < 4; ++m) { const size_t ro = (size_t)(u.pm * 256 + EPI_ROWS(ai, m)) * 1024 + u.pn * 256;
#pragma unroll
                for (int bj = 0; bj < 2; ++bj) { const size_t o = ro + EPI_COLP(bj); f32x4 v0, v1;
                    if (xsrc) { v0 = *(const f32x4*)(xsrc + o); v1 = *(const f32x4*)(xsrc + o + 4); } else unpack8(*(const v4u*)(hb + o), v0, v1);
                    *(v4u*)(hb + o) = pack8(v0 + acc[ai][bj][m][0], v1 + acc[ai][bj][m][1]); } }
    }
};
struct EpiSwiglu {
    static constexpr bool PERM = true; bf16* H; int ld;
    __device__ __forceinline__ void operator()(AccRef acc, const pg8::Unit& u, int wr, int wc, int fr, int fq) const {
        const int c = u.pn * 128 + wc * 32 + 8 * fq;
#pragma unroll
        for (int ai = 0; ai < 2; ++ai)
#pragma unroll
            for (int m = 0; m < 4; ++m) { f32x4 v0, v1;
#pragma unroll
                for (int j = 0; j < 4; ++j) { v0[j] = siluf_(acc[ai][0][m][0][j]) * acc[ai][1][m][0][j]; v1[j] = siluf_(acc[ai][0][m][1][j]) * acc[ai][1][m][1][j]; }
                *(v4u*)(H + (size_t)(u.pm * 256 + EPI_ROWS(ai, m)) * ld + c) = pack8(v0, v1); }
    }
};
struct EpiWin1 {
    static constexpr bool PERM = true; bf16 *Q, *K, *V, *GATE; float* LG; const float* gb;
    __device__ __forceinline__ void operator()(AccRef acc, const pg8::Unit& u, int wr, int wc, int fr, int fq) const {
        const int pn = u.pn;
#pragma unroll
        for (int ai = 0; ai < 2; ++ai)
#pragma unroll
            for (int m = 0; m < 4; ++m) { const size_t row = (size_t)(u.pm * 256 + EPI_ROWS(ai, m));
#pragma unroll
                for (int bj = 0; bj < 2; ++bj) { f32x4 v0 = acc[ai][bj][m][0], v1 = acc[ai][bj][m][1]; const int cc = EPI_COLP(bj);
                    if (pn < 2) { v0 = v0 * 0.08838834764831845f; v1 = v1 * 0.08838834764831845f; *(v4u*)(Q + row * 512 + pn * 256 + cc) = pack8(v0, v1); }
                    else if (pn < 4) { *(v4u*)(K + row * 512 + (pn - 2) * 256 + cc) = pack8(v0, v1); }
                    else if (pn < 8) { *(v4u*)(V + row * 1024 + (pn - 4) * 256 + cc) = pack8(v0, v1); }
                    else if (pn < 12) {
#pragma unroll
                        for (int j = 0; j < 4; ++j) { v0[j] = siluf_(v0[j]); v1[j] = siluf_(v1[j]); }
                        *(v4u*)(GATE + row * 1024 + (pn - 8) * 256 + cc) = pack8(v0, v1); }
                    else { const int c = (pn - 12) * 256 + cc; const f32x4 b0 = *(const f32x4*)(gb + c), b1 = *(const f32x4*)(gb + c + 4);
#pragma unroll
                        for (int j = 0; j < 4; ++j) { v0[j] = logsigmoidf_(v0[j] + b0[j]) * 0.0625f; v1[j] = logsigmoidf_(v1[j] + b1[j]) * 0.0625f; }
                        *(f32x4*)(LG + row * 512 + c) = v0; *(f32x4*)(LG + row * 512 + c + 4) = v1; } } }
    }
};
struct EpiMoeDown {
    static constexpr bool PERM = true; bf16* hb; const LAS int* toks; const LAS float* wts;
    __device__ __forceinline__ void operator()(AccRef acc, const pg8::Unit& u, int wr, int wc, int fr, int fq) const {
#pragma unroll
        for (int ai = 0; ai < 2; ++ai)
#pragma unroll
            for (int m = 0; m < 4; ++m) { const int rl = u.slot * 256 + EPI_ROWS(ai, m); const int tok = toks[rl]; const float w = wts[rl];
                if (tok >= 0) { bf16* d = hb + (size_t)tok * 1024 + u.pn * 256;
#pragma unroll
                    for (int bj = 0; bj < 2; ++bj) { bf16* p = d + EPI_COLP(bj); f32x4 v0, v1; unpack8(*(const v4u*)p, v0, v1); *(v4u*)p = pack8(v0 + acc[ai][bj][m][0] * w, v1 + acc[ai][bj][m][1] * w); } } }
    }
};
struct EpiSlab {
    static constexpr bool PERM = false; float* slab; const LAS int* meta;
    __device__ __forceinline__ void operator()(AccRef acc, const pg8::Unit& u, int wr, int wc, int fr, int fq) const {
        const int sl = meta[u.slot * 4 + 3] / 896; float* base = slab + ((size_t)(sl * 8 + (u.pm - 128)) * 256) * 1024 + u.pn * 256;
#pragma unroll
        for (int ai = 0; ai < 2; ++ai)
#pragma unroll
            for (int m = 0; m < 4; ++m) { float* d = base + (size_t)EPI_ROWS(ai, m) * 1024;
#pragma unroll
                for (int bj = 0; bj < 2; ++bj)
#pragma unroll
                    for (int n = 0; n < 2; ++n) *(f32x4*)(d + EPI_COLN(bj, n)) = acc[ai][bj][m][n]; }
    }
};

__device__ __forceinline__ void tr_item(const float* W, int ldw, int col, int k0, bf16* WT, int ldt, int drow, LAS float* scr, int lane) {
#pragma unroll 8
    for (int i = 0; i < 32; ++i) { const int kk = 2 * i + (lane >> 5); scr[kk * 33 + (lane & 31)] = W[(size_t)(k0 + kk) * ldw + col + (lane & 31)]; }
    LDS_WAIT(); asm volatile("" ::: "memory");
    const int c = lane & 7;
#pragma unroll
    for (int j = 0; j < 4; ++j) { const int n = (lane >> 3) + 8 * j; const LAS float* s = scr + (8 * c) * 33 + n;
        v4u o; o.x = pk2(s[0 * 33], s[1 * 33]); o.y = pk2(s[2 * 33], s[3 * 33]); o.z = pk2(s[4 * 33], s[5 * 33]); o.w = pk2(s[6 * 33], s[7 * 33]);
        *(v4u*)(WT + (size_t)(drow + n) * ldt + k0 + 8 * c) = o; }
    LDS_WAIT(); asm volatile("" ::: "memory");
}
struct TrJob { const float* W; int ldw, col0, K, N; bf16* WT; int blk, bstride, add; };
__device__ __forceinline__ bool tr_try(int& r, const TrJob& j, LAS float* scr, int lane) {
    const int nblk = j.N / 32, items = (j.K / 64) * nblk;
    if (r >= items) { r -= items; return false; }
    const int kb = r / nblk, n0 = (r % nblk) * 32;
    tr_item(j.W, j.ldw, j.col0 + n0, kb * 64, j.WT, j.K, (n0 / j.blk) * j.bstride + (n0 % j.blk) + j.add, scr, lane);
    return true;
}
__device__ __forceinline__ void norm_row_bf16(const float* xrow, const float* gain, bf16* orow, int lane) {
    const f32x4* xr = (const f32x4*)xrow + lane; const f32x4* gr = (const f32x4*)gain + lane;
    f32x4 v[4]; float s = 0.f;
#pragma unroll
    for (int j = 0; j < 4; ++j) { v[j] = xr[64 * j]; s += (v[j].x * v[j].x + v[j].y * v[j].y) + (v[j].z * v[j].z + v[j].w * v[j].w); }
    const float rstd = 1.0f / sqrtf(wave_sum(s) * (1.0f / 1024.0f) + EPS);
    v2u* o8 = (v2u*)orow + lane;
#pragma unroll
    for (int j = 0; j < 4; ++j) { const f32x4 g = gr[64 * j]; v2u w; w.x = pk2(v[j].x * rstd * g.x, v[j].y * rstd * g.y); w.y = pk2(v[j].z * rstd * g.z, v[j].w * rstd * g.w); o8[64 * j] = w; }
}
__device__ __forceinline__ void norm_row_b2b(const bf16* hrow, const float* gain, bf16* orow, int lane) {
    f32x4 v[4]; unpack8(*(const v4u*)(hrow + 8 * lane), v[0], v[1]); unpack8(*(const v4u*)(hrow + 512 + 8 * lane), v[2], v[3]); float s = 0.f;
#pragma unroll
    for (int j = 0; j < 4; ++j) s += (v[j].x * v[j].x + v[j].y * v[j].y) + (v[j].z * v[j].z + v[j].w * v[j].w);
    const float rstd = 1.0f / sqrtf(wave_sum(s) * (1.0f / 1024.0f) + EPS);
    const f32x4 g0 = *(const f32x4*)(gain + 8 * lane), g1 = *(const f32x4*)(gain + 8 * lane + 4), g2 = *(const f32x4*)(gain + 512 + 8 * lane), g3 = *(const f32x4*)(gain + 512 + 8 * lane + 4);
    *(v4u*)(orow + 8 * lane) = pack8(v[0] * rstd * g0, v[1] * rstd * g1); *(v4u*)(orow + 512 + 8 * lane) = pack8(v[2] * rstd * g2, v[3] * rstd * g3);
}

__device__ __forceinline__ void p0_prologue(const Frame& F, const Args& a, unsigned char* ws) {
    LAS float* scr = (LAS float*)(F.lds + RING_OFF + F.wave * 16384);
    const float* const* in = a.in;
    constexpr int BIG = 1 << 30;
    for (int it = F.gw; ; it += F.NGW) {
        int r = it;
        { TrJob j{in[I_WIN0], EV_IN, 0, 1024, EV_IN, (bf16*)(ws + WS_WIN0), BIG, 0, 0}; if (tr_try(r, j, scr, F.lane)) continue; }
        bool done = false;
        for (int h = 0; h < 4 && !done; ++h) {
            { TrJob j{in[I_GAW] + (size_t)h * 65536, 256, 0, 256, 256, (bf16*)(ws + WS_GW) + (size_t)h * 512 * 256, 128, 256, 0}; if (tr_try(r, j, scr, F.lane)) { done = true; break; } }
            { TrJob j{in[I_GXW] + (size_t)h * 65536, 256, 0, 256, 256, (bf16*)(ws + WS_GW) + (size_t)h * 512 * 256, 128, 256, 128}; if (tr_try(r, j, scr, F.lane)) { done = true; break; } }
        }
        if (done) continue;
        { TrJob j{in[I_GLUW], 512, 0, 512, 512, (bf16*)(ws + WS_GLUW), BIG, 0, 0}; if (tr_try(r, j, scr, F.lane)) continue; }
        { TrJob j{in[I_WOUT0], 1024, 0, EV_MIX, 1024, (bf16*)(ws + WS_WOUT0), BIG, 0, 0}; if (tr_try(r, j, scr, F.lane)) continue; }
        { TrJob j{in[I_FG], FF0, 0, 1024, FF0, (bf16*)(ws + WS_WUP0), 128, 256, 0}; if (tr_try(r, j, scr, F.lane)) continue; }
        { TrJob j{in[I_FU], FF0, 0, 1024, FF0, (bf16*)(ws + WS_WUP0), 128, 256, 128}; if (tr_try(r, j, scr, F.lane)) continue; }
        { TrJob j{in[I_FD], 1024, 0, FF0, 1024, (bf16*)(ws + WS_WDN0), BIG, 0, 0}; if (tr_try(r, j, scr, F.lane)) continue; }
        { TrJob j{in[I_WIN1], OD_IN, 0, 1024, 3072, (bf16*)(ws + WS_WIN1), BIG, 0, 0}; if (tr_try(r, j, scr, F.lane)) continue; }
        { TrJob j{in[I_WOUT1], 1024, 0, 1024, 1024, (bf16*)(ws + WS_WOUT1), BIG, 0, 0}; if (tr_try(r, j, scr, F.lane)) continue; }
        break;
    }
    for (long i = F.gt; i < 512L * 1024; i += F.NGT) { const int j = (int)(i >> 10), k = (int)(i & 1023); const float* wr_ = in[I_WIN1] + (size_t)k * OD_IN + 3072; const float* w2 = in[I_GW2] + j; float s = 0.f;
#pragma unroll
        for (int r = 0; r < 16; ++r) s += wr_[r] * w2[r * 512];
        ((bf16*)(ws + WS_WIN1))[(size_t)(3072 + j) * 1024 + k] = (bf16)f2bf(s); }
    float* tab = (float*)(ws + WS_TAB);
    for (long i = F.gt; i < NG * NS; i += F.NGT) { const int g = (int)i / NS;
        const double lr = in[I_LRE][i], li = in[I_LIM][i], dt = exp((double)in[I_LDT][g]);
        const double mag = exp(dt * lr), ar = mag * cos(dt * li), ai = mag * sin(dt * li), den = lr * lr + li * li, nr = ar - 1.0;
        const double zr = (nr * lr + ai * li) / den, zi = (ai * lr - nr * li) / den;
        const double m64 = exp(64.0 * dt * lr);
        ((float*)((char*)tab + TB_AR))[i] = (float)ar; ((float*)((char*)tab + TB_AI))[i] = (float)ai;
        ((float*)((char*)tab + TB_AR64))[i] = (float)(m64 * cos(64.0 * dt * li)); ((float*)((char*)tab + TB_AI64))[i] = (float)(m64 * sin(64.0 * dt * li));
        for (int h = 0; h < 16; ++h) { const double br = in[I_BRE][i * 16 + h], bi = in[I_BIM][i * 16 + h];
            ((float*)((char*)tab + TB_BBR))[i * 16 + h] = (float)(zr * br - zi * bi); ((float*)((char*)tab + TB_BBI))[i * 16 + h] = (float)(zr * bi + zi * br); } }
    for (long idx = F.gt; idx < (long)NG * NS * 64; idx += F.NGT) { const int i = (int)(idx & 63), gn = (int)(idx >> 6), g = gn / NS, n = gn % NS;
        const double lr = in[I_LRE][gn], li = in[I_LIM][gn], dt = exp((double)in[I_LDT][g]);
        const double mag1 = exp(dt * lr), ar1 = mag1 * cos(dt * li), ai1 = mag1 * sin(dt * li), den = lr * lr + li * li, nr1 = ar1 - 1.0;
        const double zr = (nr1 * lr + ai1 * li) / den, zi = (ai1 * lr - nr1 * li) / den;
        const double pw = (double)(63 - i), pm = exp(pw * dt * lr), pr = pm * cos(pw * dt * li), pi_ = pm * sin(pw * dt * li);
        bf16* wre = (bf16*)(ws + WS_WE) + ((size_t)g * 128 + 2 * n) * 1024 + i * 16; bf16* wim = wre + 1024;
        for (int h = 0; h < 16; ++h) { const double br = in[I_BRE][(size_t)gn * 16 + h], bi = in[I_BIM][(size_t)gn * 16 + h]; const double bbr = zr * br - zi * bi, bbi = zr * bi + zi * br;
            wre[h] = (bf16)f2bf((float)(pr * bbr - pi_ * bbi)); wim[h] = (bf16)f2bf((float)(pr * bbi + pi_ * bbr)); } }
    for (long i = F.gt; i < 1024; i += F.NGT) { const float lam = in[I_LAM][i]; ((float*)((char*)tab + TB_SP8))[i] = 8.0f * log1pf(expf(-lam)); }
    bf16* HN = (bf16*)(ws + WS_HN); float* hmeta = (float*)(ws + WS_HMETA);
    { const float* gain0 = in[I_NORM_MIX0]; const int lane = F.lane; f32x4 gg[4];
#pragma unroll
      for (int j = 0; j < 4; ++j) gg[j] = ((const f32x4*)gain0)[lane + 64 * j];
      for (int m = F.gw; m < TR; m += 4 * F.NGW) { f32x4 xv[4][4];
#pragma unroll
        for (int q = 0; q < 4; ++q) { const int mm = m + q * F.NGW; if (mm < TR) {
#pragma unroll
            for (int j = 0; j < 4; ++j) xv[q][j] = ((const f32x4*)(in[I_X] + (size_t)mm * 1024))[lane + 64 * j]; } }
#pragma unroll
        for (int q = 0; q < 4; ++q) { const int mm = m + q * F.NGW; if (mm < TR) { float sq = 0.f;
#pragma unroll
            for (int j = 0; j < 4; ++j) sq += (xv[q][j].x * xv[q][j].x + xv[q][j].y * xv[q][j].y) + (xv[q][j].z * xv[q][j].z + xv[q][j].w * xv[q][j].w);
            const float rstd = 1.0f / sqrtf(wave_sum(sq) * (1.0f / 1024.0f) + EPS); v2u* o8 = (v2u*)(HN + (size_t)mm * 1024) + lane;
#pragma unroll
            for (int j = 0; j < 4; ++j) { const f32x4 y = xv[q][j] * rstd * gg[j]; o8[64 * j] = (v2u){pk2(y.x, y.y), pk2(y.z, y.w)}; } } } }
      for (int m = TR + F.gw; m < TR + NMETA; m += F.NGW) norm_row_bf16(in[I_META] + (size_t)(m - TR) * 1024, gain0, HN + (size_t)m * 1024, lane); }
    for (long i = F.gt; i < NMETA * 1024; i += F.NGT) hmeta[i] = in[I_META][i];
}
__device__ __forceinline__ void norm_phase(const Frame& F, const bf16* HB, const float* hmeta, const float* gain, bf16* HN, int nrows) {
    const int lane = F.lane; const f32x4 g0 = *(const f32x4*)(gain + 8 * lane), g1 = *(const f32x4*)(gain + 8 * lane + 4), g2 = *(const f32x4*)(gain + 512 + 8 * lane), g3 = *(const f32x4*)(gain + 512 + 8 * lane + 4);
    for (int m = F.gw; m < TR; m += 4 * F.NGW) { v4u xa[4], xb[4];
#pragma unroll
        for (int q = 0; q < 4; ++q) { const int mm = m + q * F.NGW; if (mm < TR) { xa[q] = *(const v4u*)(HB + (size_t)mm * 1024 + 8 * lane); xb[q] = *(const v4u*)(HB + (size_t)mm * 1024 + 512 + 8 * lane); } }
#pragma unroll
        for (int q = 0; q < 4; ++q) { const int mm = m + q * F.NGW; if (mm < TR) { f32x4 v[4]; unpack8(xa[q], v[0], v[1]); unpack8(xb[q], v[2], v[3]); float sq = 0.f;
#pragma unroll
            for (int j = 0; j < 4; ++j) sq += (v[j].x * v[j].x + v[j].y * v[j].y) + (v[j].z * v[j].z + v[j].w * v[j].w);
            const float rstd = 1.0f / sqrtf(wave_sum(sq) * (1.0f / 1024.0f) + EPS);
            *(v4u*)(HN + (size_t)mm * 1024 + 8 * lane) = pack8(v[0] * rstd * g0, v[1] * rstd * g1); *(v4u*)(HN + (size_t)mm * 1024 + 512 + 8 * lane) = pack8(v[2] * rstd * g2, v[3] * rstd * g3); } } }
    for (int m = TR + F.gw; m < nrows; m += F.NGW) norm_row_bf16(hmeta + (size_t)(m - TR) * 1024, gain, HN + (size_t)m * 1024, F.lane);
}
__device__ __forceinline__ int seq_prev(int row, int back) {
    if (row >= TR) { const int i = row - TR - back; return i >= 0 ? TR + i : -1; }
    const int t = row & (SEQ - 1); return t >= back ? row - back : TR + NMETA + (t - back);
}
__device__ __forceinline__ void conv_phase(const Frame& F, const bf16* XR, const float* cw, const float* cb, bf16* XC) {
    for (long i = F.gt; i < (long)(TR / 32 + 1) * 128; i += F.NGT) { const int c = (int)(i & 127) * 8, st = (int)(i >> 7); const bool meta = st >= TR / 32; const int r0 = meta ? RM0 : st * 32, nr = meta ? NMETA : 32;
        f32x4 w[4][2]; f32x4 b0 = *(const f32x4*)(cb + c), b1 = *(const f32x4*)(cb + c + 4);
#pragma unroll
        for (int k = 0; k < 4; ++k) { w[k][0] = *(const f32x4*)(cw + k * 1024 + c); w[k][1] = *(const f32x4*)(cw + k * 1024 + c + 4); }
        f32x4 h[3][2];
#pragma unroll
        for (int k = 0; k < 3; ++k) { const int src = seq_prev(r0, 3 - k); if (src >= 0) unpack8(*(const v4u*)(XR + (size_t)src * 1024 + c), h[k][0], h[k][1]); else { h[k][0] = (f32x4){0.f, 0.f, 0.f, 0.f}; h[k][1] = h[k][0]; } }
        for (int t0 = 0; t0 < nr; t0 += 8) { v4u x[8];
#pragma unroll
            for (int t = 0; t < 8; ++t) x[t] = *(const v4u*)(XR + (size_t)(r0 + t0 + t) * 1024 + c);
#pragma unroll
            for (int t = 0; t < 8; ++t) { f32x4 c0, c1; unpack8(x[t], c0, c1);
                const f32x4 o0 = b0 + w[0][0] * h[0][0] + w[1][0] * h[1][0] + w[2][0] * h[2][0] + w[3][0] * c0, o1 = b1 + w[0][1] * h[0][1] + w[1][1] * h[1][1] + w[2][1] * h[2][1] + w[3][1] * c1;
                *(v4u*)(XC + (size_t)(r0 + t0 + t) * 1024 + c) = pack8(o0, o1);
                h[0][0] = h[1][0]; h[0][1] = h[1][1]; h[1][0] = h[2][0]; h[1][1] = h[2][1]; h[2][0] = c0; h[2][1] = c1; } } }
}
constexpr int SSM_HP = 68, SSM_XP = 132;
constexpr int SSM_WLDS = 16 * SSM_XP * 4 + 16 * SSM_HP * 4;
struct SsmTab { float ar, ai; bf16x8 axf[8]; bf16x8 ca[4]; f32x4 dv; };
__device__ __forceinline__ void ssm_tab_load(SsmTab& T, const unsigned char* ws, const float* cre, const float* cim, const float* sd, int g, int lane) {
    const float* tab = (const float*)(ws + WS_TAB); const int gn = g * NS + lane, fr = lane & 15, fq = lane >> 4;
    T.ar = ((const float*)((const char*)tab + TB_AR))[gn]; T.ai = ((const float*)((const char*)tab + TB_AI))[gn];
#pragma unroll
    for (int rb = 0; rb < 8; ++rb) { const int r = 16 * rb + fr, n = r >> 1; const float* src = (const float*)((const char*)tab + ((r & 1) ? TB_BBI : TB_BBR)) + (size_t)(g * NS + n) * 16 + 8 * (fq & 1);
        v4u w = pack8(*(const f32x4*)src, *(const f32x4*)(src + 4)); if (fq >= 2) w = (v4u){0u, 0u, 0u, 0u}; T.axf[rb] = __builtin_bit_cast(bf16x8, w); }
#pragma unroll
    for (int ks = 0; ks < 4; ++ks) { const int n0 = 16 * ks + 4 * fq; const f32x4 cr = *(const f32x4*)(cre + (g * 16 + fr) * NS + n0), ci = *(const f32x4*)(cim + (g * 16 + fr) * NS + n0);
        v4u w; w.x = pk2(cr[0], -ci[0]); w.y = pk2(cr[1], -ci[1]); w.z = pk2(cr[2], -ci[2]); w.w = pk2(cr[3], -ci[3]); T.ca[ks] = __builtin_bit_cast(bf16x8, w); }
    T.dv = *(const f32x4*)(sd + g * 16 + 4 * fq);
}
__device__ __forceinline__ void ssm_wave(const SsmTab& T, const bf16* U, bf16* GS, int g, int row0, int ntok, float& hr, float& hi, int lane, LAS unsigned char* wl) {
    LAS float* xb = (LAS float*)wl; LAS unsigned* hb = (LAS unsigned*)(wl + 16 * SSM_XP * 4);
    const int fr = lane & 15, fq = lane >> 4; const float ar = T.ar, ai = T.ai;
    const f32x4 dv = T.dv;
    const bf16* ubase = U + (size_t)(row0 + fr) * 512 + g * 16;
    v4u bnx = {0u, 0u, 0u, 0u}; if (fq < 2) bnx = *(const v4u*)(ubase + 8 * fq);
    v2u unx = *(const v2u*)(ubase + 4 * fq);
    for (int t0 = 0; t0 < ntok; t0 += 16) {
        const v4u bw = bnx; const v2u uw = unx;
        if (t0 + 16 < ntok) { const bf16* un = ubase + (size_t)(t0 + 16) * 512; if (fq < 2) bnx = *(const v4u*)(un + 8 * fq); unx = *(const v2u*)(un + 4 * fq); }
        const bf16x8 bfr = __builtin_bit_cast(bf16x8, bw);
#pragma unroll
        for (int rb = 0; rb < 8; ++rb) { const f32x4 xa = __builtin_amdgcn_mfma_f32_16x16x32_bf16(T.axf[rb], bfr, (f32x4){0.f, 0.f, 0.f, 0.f}, 0, 0, 0); *(LAS f32x4*)(xb + fr * SSM_XP + 16 * rb + 4 * fq) = xa; }
        asm volatile("" ::: "memory");
#pragma unroll 4
        for (int tl = 0; tl < 16; ++tl) { const f32x2 x = *(const LAS f32x2*)(xb + tl * SSM_XP + 2 * lane);
            const float nr = ar * hr - ai * hi + x.x, ni = ar * hi + ai * hr + x.y; hr = nr; hi = ni;
            hb[tl * SSM_HP + lane] = pg8::cvt_pk_bf16(hr, hi); }
        asm volatile("" ::: "memory");
        f32x4 y = {0.f, 0.f, 0.f, 0.f};
#pragma unroll
        for (int ks = 0; ks < 4; ++ks) { const bf16x8 hbf = *(const LAS bf16x8*)(hb + fr * SSM_HP + 16 * ks + 4 * fq); y = __builtin_amdgcn_mfma_f32_16x16x32_bf16(T.ca[ks], hbf, y, 0, 0, 0); }
        const float o0 = gelu_tanh(y[0] + dv[0] * bflo(uw.x)), o1 = gelu_tanh(y[1] + dv[1] * bfhi(uw.x)), o2 = gelu_tanh(y[2] + dv[2] * bflo(uw.y)), o3 = gelu_tanh(y[3] + dv[3] * bfhi(uw.y));
        *(v2u*)(GS + (size_t)(row0 + t0 + fr) * 512 + g * 16 + 4 * fq) = (v2u){pk2(o0, o1), pk2(o2, o3)};
        asm volatile("" ::: "memory");
    }
    LDS_WAIT(); asm volatile("" ::: "memory");
}
__device__ __forceinline__ void ssm_l1_phase(const Frame& F, const unsigned char* ws, const bf16* U, float* SSE) {
    const int lane = F.lane, fr = lane & 15, fq = lane >> 4;
    for (int it = F.gw; it < NG * 32; it += F.NGW) { const int g = it >> 5, cb = it & 31, bc = cb * 16 + fr;
        const bf16* ap = (const bf16*)(ws + WS_WE) + ((size_t)g * 128 + fr) * 1024 + 8 * fq;
        const bf16* bp = U + ((size_t)bc * 64 + (fq >> 1)) * 512 + g * 16 + 8 * (fq & 1);
        f32x4 acc[8];
#pragma unroll
        for (int rb = 0; rb < 8; ++rb) acc[rb] = (f32x4){0.f, 0.f, 0.f, 0.f};
#pragma unroll 2
        for (int ks = 0; ks < 32; ++ks) { const bf16x8 bfr = *(const bf16x8*)(bp + (size_t)ks * 2 * 512);
#pragma unroll
            for (int rb = 0; rb < 8; ++rb) { const bf16x8 afr = *(const bf16x8*)(ap + (size_t)rb * 16 * 1024 + ks * 32); acc[rb] = __builtin_amdgcn_mfma_f32_16x16x32_bf16(afr, bfr, acc[rb], 0, 0, 0); } }
#pragma unroll
        for (int rb = 0; rb < 8; ++rb) *(f32x4*)(SSE + (((size_t)bc * NG + g) * NS + 8 * rb + 2 * fq) * 2) = acc[rb]; }
}
__device__ __forceinline__ void lru_l1_phase(const Frame& F, const bf16* A, const bf16* BX, float* PEND, float* HEND) {
    for (long i = F.gt; i < (long)NB * NCH * 128; i += F.NGT) { const int ch = (int)(i & 127) * 8, bc = (int)(i >> 7); const size_t r0 = (size_t)bc * 64;
        f32x4 P0 = {0.f, 0.f, 0.f, 0.f}, P1 = P0, H0 = P0, H1 = P0;
        for (int t0 = 0; t0 < 64; t0 += 8) { v4u la[8], bx[8];
#pragma unroll
            for (int t = 0; t < 8; ++t) { la[t] = *(const v4u*)(A + (r0 + t0 + t) * 1024 + ch); bx[t] = *(const v4u*)(BX + (r0 + t0 + t) * 1024 + ch); }
#pragma unroll
            for (int t = 0; t < 8; ++t) { f32x4 l0, l1, b0, b1; unpack8(la[t], l0, l1); unpack8(bx[t], b0, b1); P0 += l0; P1 += l1;
#pragma unroll
                for (int j = 0; j < 4; ++j) { H0[j] = __expf(l0[j]) * H0[j] + b0[j]; H1[j] = __expf(l1[j]) * H1[j] + b1[j]; } } }
#pragma unroll
        for (int j = 0; j < 4; ++j) { P0[j] = __expf(P0[j]); P1[j] = __expf(P1[j]); }
        float* pp = PEND + (size_t)bc * 1024 + ch; float* hp = HEND + (size_t)bc * 1024 + ch; *(f32x4*)pp = P0; *(f32x4*)(pp + 4) = P1; *(f32x4*)hp = H0; *(f32x4*)(hp + 4) = H1; }
}
__device__ __forceinline__ void carry_phase(const Frame& F, const unsigned char* ws, const bf16* A, const bf16* BX, const float* PEND, const float* HEND, float* CIN, const bf16* U, const float* SSE, float* SSIN) {
    if (F.gt < NB * 1024) { const int ch = (int)F.gt & 1023, b = (int)F.gt >> 10; float H = 0.f;
        for (int i = 0; i < NMETA; ++i) { const size_t r = (size_t)(RM0 + i); H = __expf(bf2f(A[r * 1024 + ch])) * H + bf2f(BX[r * 1024 + ch]); }
        for (int c0 = 0; c0 < NCH; c0 += 32) { float pp[32], hh[32];
#pragma unroll
            for (int c = 0; c < 32; ++c) { const size_t o = ((size_t)b * NCH + c0 + c) * 1024 + ch; pp[c] = PEND[o]; hh[c] = HEND[o]; }
#pragma unroll
            for (int c = 0; c < 32; ++c) { const size_t o = ((size_t)b * NCH + c0 + c) * 1024 + ch; CIN[o] = H; H = hh[c] + pp[c] * H; } }
    } else if (F.gt >= 8 * 512 && F.gt < 8 * 512 + NB * NG * NS) { const int id = (int)F.gt - 8 * 512, n = id % NS, g = (id / NS) % NG, b = id / (NS * NG), gn = g * NS + n;
        const float* tab = (const float*)(ws + WS_TAB);
        const float ar = ((const float*)((const char*)tab + TB_AR))[gn], ai = ((const float*)((const char*)tab + TB_AI))[gn], ar64 = ((const float*)((const char*)tab + TB_AR64))[gn], ai64 = ((const float*)((const char*)tab + TB_AI64))[gn];
        float hr = 0.f, hi = 0.f;
        for (int i = 0; i < NMETA; ++i) { float xr = 0.f, xi = 0.f;
            for (int h = 0; h < 16; ++h) { const float u = bf2f(U[(size_t)(RM0 + i) * 512 + g * 16 + h]); xr += ((const float*)((const char*)tab + TB_BBR))[gn * 16 + h] * u; xi += ((const float*)((const char*)tab + TB_BBI))[gn * 16 + h] * u; }
            const float nr = ar * hr - ai * hi + xr, ni = ar * hi + ai * hr + xi; hr = nr; hi = ni; }
        for (int c0 = 0; c0 < NCH; c0 += 32) { f32x2 ee[32];
#pragma unroll
            for (int c = 0; c < 32; ++c) ee[c] = ((const f32x2*)SSE)[(((size_t)b * NCH + c0 + c) * NG + g) * NS + n];
#pragma unroll
            for (int c = 0; c < 32; ++c) { ((f32x2*)SSIN)[(((size_t)b * NCH + c0 + c) * NG + g) * NS + n] = (f32x2){hr, hi};
                const float nr = ar64 * hr - ai64 * hi + ee[c].x, ni = ar64 * hi + ai64 * hr + ee[c].y; hr = nr; hi = ni; } }
    }
}
__device__ __forceinline__ void mix0_final_phase(const Frame& F, const unsigned char* ws, const bf16* A, const bf16* BX, const float* CIN, const bf16* G, bf16* AOUT, const float* cre, const float* cim, const float* sd, const bf16* U, const float* SSIN, bf16* GS) {
    for (int pass = 0; pass < 2; ++pass) {
      if ((pass ^ (F.wave & 1)) == 0) {
    for (long i = F.gt; i < (long)NB * NCH * 128 + 128; i += F.NGT) { const int ch = (int)(i & 127) * 8, bc = (int)(i >> 7); const bool meta = bc >= NB * NCH;
        const size_t r0 = meta ? (size_t)RM0 : (size_t)bc * 64; const int nt = meta ? NMETA : 64; f32x4 H0 = {0.f, 0.f, 0.f, 0.f}, H1 = H0;
        if (!meta) { H0 = *(const f32x4*)(CIN + (size_t)bc * 1024 + ch); H1 = *(const f32x4*)(CIN + (size_t)bc * 1024 + ch + 4); }
        for (int t0 = 0; t0 < nt; t0 += 8) { v4u la[8], bx[8], gg[8];
#pragma unroll
            for (int t = 0; t < 8; ++t) { const size_t r = r0 + t0 + t; la[t] = *(const v4u*)(A + r * 1024 + ch); bx[t] = *(const v4u*)(BX + r * 1024 + ch); gg[t] = *(const v4u*)(G + r * 1024 + ch); }
#pragma unroll
            for (int t = 0; t < 8; ++t) { f32x4 l0, l1, b0, b1, g0, g1; unpack8(la[t], l0, l1); unpack8(bx[t], b0, b1); unpack8(gg[t], g0, g1);
#pragma unroll
                for (int j = 0; j < 4; ++j) { H0[j] = __expf(l0[j]) * H0[j] + b0[j]; H1[j] = __expf(l1[j]) * H1[j] + b1[j]; }
                *(v4u*)(AOUT + (r0 + t0 + t) * 1536 + ch) = pack8(g0 * H0, g1 * H1); } } }
      } else {
    { SsmTab T; int gcur = -1;
    for (int it = F.gw; it < NB * NCH * NG + NG; it += F.NGW) { const bool meta = it >= NB * NCH * NG; const int g = it % NG, bc = it / NG;
        if (g != gcur) { ssm_tab_load(T, ws, cre, cim, sd, g, F.lane); gcur = g; }
        float hr = 0.f, hi = 0.f; if (!meta) { const f32x2 s = ((const f32x2*)SSIN)[(size_t)it * NS + F.lane]; hr = s.x; hi = s.y; }
        ssm_wave(T, U, GS, g, meta ? RM0 : bc * 64, meta ? NMETA : 64, hr, hi, F.lane, F.lds + RING_OFF + F.wave * SSM_WLDS); } }
      }
    }
}
template <int NACC>
__device__ __forceinline__ void meta_tile(const Frame& F, const bf16* A16, int lda, int K, const bf16* const (&Brow)[NACC], int ldb, f32x4 (&out)[NACC]) {
    LAS f32x4* red = (LAS f32x4*)(F.lds + RING_OFF);
    const int lane = F.lane, fr = lane & 15, fq = lane >> 4, w = F.wave, ks = K / 8;
    f32x4 acc[NACC];
#pragma unroll
    for (int a = 0; a < NACC; ++a) acc[a] = (f32x4){0.f, 0.f, 0.f, 0.f};
    for (int k0 = w * ks; k0 < (w + 1) * ks; k0 += 32) {
        const bf16x8 af = *(const bf16x8*)(A16 + (size_t)fr * lda + k0 + 8 * fq);
#pragma unroll
        for (int a = 0; a < NACC; ++a) { const bf16x8 bfz = *(const bf16x8*)(Brow[a] + (size_t)fr * ldb + k0 + 8 * fq); acc[a] = __builtin_amdgcn_mfma_f32_16x16x32_bf16(bfz, af, acc[a], 0, 0, 0); } }
    __syncthreads();
#pragma unroll
    for (int a = 0; a < NACC; ++a) red[(w * NACC + a) * 64 + lane] = acc[a];
    __syncthreads();
#pragma unroll
    for (int a = 0; a < NACC; ++a) { f32x4 sacc = red[a * 64 + lane];
#pragma unroll
        for (int ww = 1; ww < 8; ++ww) sacc += red[(ww * NACC + a) * 64 + lane];
        out[a] = sacc; }
}
template <class Fn> __device__ __forceinline__ bf16x8 frag8(Fn f) { bf16x8 r;
#pragma unroll
    for (int j = 0; j < 8; ++j) r[j] = (short)f(j);
    return r; }
constexpr int GL_LB = 0, GL_QT = 32768, GL_KT = 50176, GL_KH = 67584, GL_VT = 86016, GL_GM = 120832, GL_BL = 121344, GL_SSQ = 121856;
constexpr int PQ = 136, PKH = 144, PV = 272, PATT = 72, POT = 264;
#define TR_FRAG(dst, base, off, rows4) do { v2u _lo, _hi; \
    asm volatile("ds_read_b64_tr_b16 %0, %2 offset:%c3\n\tds_read_b64_tr_b16 %1, %2 offset:%c4\n\ts_waitcnt lgkmcnt(0)" : "=&v"(_lo), "=&v"(_hi) : "v"(base), "i"(off), "i"((off) + (rows4)) : "memory"); \
    const v4u _w = {_lo.x, _lo.y, _hi.x, _hi.y}; dst = __builtin_bit_cast(bf16x8, _w); } while (0)
__device__ __forceinline__ unsigned lds_addr(const LAS void* p) { return (unsigned)(unsigned long)p; }
template <bool FINAL>
__device__ __forceinline__ void gla_item(const Frame& F, int b, int h, int s, const bf16* Q, const bf16* K, const bf16* V, const bf16* GATE, const float* LG, const float* gnorm, float* GDS, float* GAM, bf16* AOUT2) {
    LAS float* LB = (LAS float*)(F.lds + GL_LB); LAS bf16* ATT = (LAS bf16*)(F.lds + GL_LB);
    LAS bf16* QT = (LAS bf16*)(F.lds + GL_QT); LAS bf16* KT = (LAS bf16*)(F.lds + GL_KT); LAS bf16* KH = (LAS bf16*)(F.lds + GL_KH); LAS bf16* VT = (LAS bf16*)(F.lds + GL_VT);
    LAS float* GM = (LAS float*)(F.lds + GL_GM); LAS float* BL = (LAS float*)(F.lds + GL_BL); LAS float* SSQ = (LAS float*)(F.lds + GL_SSQ);
    const int tid = F.tid, w = F.wave, lane = F.lane, fr = lane & 15, h4 = lane >> 4, tq = fr >> 2, tp = fr & 3;
    const int bh = b * GH + h; const size_t sbase = ((size_t)(bh * NSEG + s) * 128) * 256;
    const unsigned vtr = lds_addr(VT) + (unsigned)((8 * h4 + tq) * PV + 32 * w + 4 * tp) * 2u;
    const unsigned ktr = lds_addr(KH) + (unsigned)((8 * h4 + tq) * PKH + 4 * tp) * 2u;
    f32x4 S[8][2];
#pragma unroll
    for (int kb = 0; kb < 8; ++kb)
#pragma unroll
        for (int vb = 0; vb < 2; ++vb)
#pragma unroll
            for (int r = 0; r < 4; ++r) S[kb][vb][r] = FINAL ? GDS[sbase + (size_t)(16 * kb + 4 * h4 + r) * 256 + 32 * w + 16 * vb + fr] : 0.f;
    float gsum = 0.f;
#pragma nounroll
    for (int c = 0; c < SEGC; ++c) {
        const size_t row0 = (size_t)b * SEQ + (size_t)(s * SEGC + c) * 64;
        int lz = 0; asm volatile("" : "+v"(lz));
        const int tidl = tid + lz, frl = fr + lz, h4l = h4 + lz;
#pragma unroll
        for (int j = 0; j < 4; ++j) { const int i = tidl + 512 * j, t = i >> 5, k4 = (i & 31) * 4; *(LAS f32x4*)(LB + t * 128 + k4) = *(const f32x4*)(LG + (row0 + t) * 512 + h * 128 + k4); }
        v4u kwr[2];
#pragma unroll
        for (int j = 0; j < 2; ++j) { const int i = tidl + 512 * j, t = i >> 4, k8 = (i & 15) * 8; const size_t go = (row0 + t) * 512 + h * 128 + k8; if (!FINAL) kwr[j] = *(const v4u*)(K + go); }
#pragma unroll
        for (int j = 0; j < 4; ++j) { const int i = tidl + 512 * j, t = i >> 5, c8 = (i & 31) * 8; *(LAS v4u*)(VT + t * PV + c8) = *(const v4u*)(V + (row0 + t) * 1024 + h * 256 + c8); }
        __syncthreads();
        if (tid < 128) { float run = 0.f;
#pragma unroll 8
            for (int t = 0; t < 64; ++t) { run += LB[t * 128 + tid]; LB[t * 128 + tid] = run; }
            BL[tid] = run; GM[tid] = __expf(run); gsum += run; }
        __syncthreads();
#pragma unroll
        for (int j = 0; j < 2; ++j) { const int i = tidl + 512 * j, t = i >> 4, k8 = (i & 15) * 8; const size_t go = (row0 + t) * 512 + h * 128 + k8;
            const v4u kw = FINAL ? *(const v4u*)(K + go) : kwr[j]; const float kv[8] = {bflo(kw.x), bfhi(kw.x), bflo(kw.y), bfhi(kw.y), bflo(kw.z), bfhi(kw.z), bflo(kw.w), bfhi(kw.w)};
            float bb[8], kh[8];
#pragma unroll
            for (int e = 0; e < 8; ++e) { bb[e] = LB[t * 128 + k8 + e]; kh[e] = kv[e] * __expf(BL[k8 + e] - bb[e]); }
            v4u o; o.x = pk2(kh[0], kh[1]); o.y = pk2(kh[2], kh[3]); o.z = pk2(kh[4], kh[5]); o.w = pk2(kh[6], kh[7]); *(LAS v4u*)(KH + t * PKH + k8) = o;
            if (FINAL) { const v4u qw = *(const v4u*)(Q + go); const float qv[8] = {bflo(qw.x), bfhi(qw.x), bflo(qw.y), bfhi(qw.y), bflo(qw.z), bfhi(qw.z), bflo(qw.w), bfhi(qw.w)};
                float qt[8], kt[8];
#pragma unroll
                for (int e = 0; e < 8; ++e) { qt[e] = qv[e] * __expf(bb[e]); kt[e] = kv[e] * __expf(-bb[e]); }
                v4u oq; oq.x = pk2(qt[0], qt[1]); oq.y = pk2(qt[2], qt[3]); oq.z = pk2(qt[4], qt[5]); oq.w = pk2(qt[6], qt[7]); *(LAS v4u*)(QT + t * PQ + k8) = oq;
                v4u ok; ok.x = pk2(kt[0], kt[1]); ok.y = pk2(kt[2], kt[3]); ok.z = pk2(kt[4], kt[5]); ok.w = pk2(kt[6], kt[7]); *(LAS v4u*)(KT + t * PQ + k8) = ok; } }
        __syncthreads();
        f32x4 o[4][2];
        if (FINAL) {
            { const int tb = w >> 1;
#pragma unroll
              for (int q = 0; q < 2; ++q) { const int sb = 2 * (w & 1) + q; f32x4 acc = {0.f, 0.f, 0.f, 0.f};
                if (sb <= tb) {
#pragma unroll
                    for (int ks = 0; ks < 4; ++ks) { const bf16x8 a = *(const LAS bf16x8*)(QT + (16 * tb + fr) * PQ + 32 * ks + 8 * h4), bq = *(const LAS bf16x8*)(KT + (16 * sb + fr) * PQ + 32 * ks + 8 * h4);
                        acc = __builtin_amdgcn_mfma_f32_16x16x32_bf16(a, bq, acc, 0, 0, 0); } }
#pragma unroll
                for (int r = 0; r < 4; ++r) { const int tl = 4 * h4 + r; const float val = (sb < tb || (sb == tb && fr <= tl)) ? acc[r] : 0.f; ATT[(16 * tb + tl) * PATT + 16 * sb + fr] = (bf16)f2bf(val); } } }
            __syncthreads();
#pragma unroll
            for (int tb = 0; tb < 4; ++tb)
#pragma unroll
                for (int vb = 0; vb < 2; ++vb) o[tb][vb] = (f32x4){0.f, 0.f, 0.f, 0.f};
#pragma unroll
            for (int ss = 0; ss < 2; ++ss) { bf16x8 bv[2];
#pragma unroll
                for (int vb = 0; vb < 2; ++vb) TR_FRAG(bv[vb], vtr, (32 * ss * PV + 16 * vb) * 2, 4 * PV * 2);
#pragma unroll
                for (int tb = 0; tb < 4; ++tb) { if (ss == 1 && tb < 2) continue;
                    const bf16x8 a = *(const LAS bf16x8*)(ATT + (16 * tb + fr) * PATT + 32 * ss + 8 * h4);
#pragma unroll
                    for (int vb = 0; vb < 2; ++vb) o[tb][vb] = __builtin_amdgcn_mfma_f32_16x16x32_bf16(a, bv[vb], o[tb][vb], 0, 0, 0); } }
#pragma unroll
            for (int i = 0; i < 4; ++i) { bf16x8 bs[2];
#pragma unroll
                for (int vb = 0; vb < 2; ++vb) { v4u wv; wv.x = pk2(S[2 * i][vb][0], S[2 * i][vb][1]); wv.y = pk2(S[2 * i][vb][2], S[2 * i][vb][3]); wv.z = pk2(S[2 * i + 1][vb][0], S[2 * i + 1][vb][1]); wv.w = pk2(S[2 * i + 1][vb][2], S[2 * i + 1][vb][3]); bs[vb] = __builtin_bit_cast(bf16x8, wv); }
#pragma unroll
                for (int tb = 0; tb < 4; ++tb) { const LAS bf16* qp = QT + (16 * tb + fr) * PQ + 32 * i + 4 * h4; const v2u a_lo = *(const LAS v2u*)qp, a_hi = *(const LAS v2u*)(qp + 16);
                    const v4u aw = {a_lo.x, a_lo.y, a_hi.x, a_hi.y}; const bf16x8 a = __builtin_bit_cast(bf16x8, aw);
#pragma unroll
                    for (int vb = 0; vb < 2; ++vb) o[tb][vb] = __builtin_amdgcn_mfma_f32_16x16x32_bf16(a, bs[vb], o[tb][vb], 0, 0, 0); } }
        }
        if (FINAL) {
#pragma unroll
            for (int tb = 0; tb < 4; ++tb)
#pragma unroll
                for (int r = 0; r < 4; ++r) { float q = o[tb][0][r] * o[tb][0][r] + o[tb][1][r] * o[tb][1][r];
                    q += __shfl_xor(q, 1); q += __shfl_xor(q, 2); q += __shfl_xor(q, 4); q += __shfl_xor(q, 8);
                    if (fr == 0) SSQ[w * 64 + 16 * tb + 4 * h4 + r] = q; }
            __syncthreads();
            { LAS bf16* OT = QT; const float gn0 = gnorm[h * 256 + 32 * w + frl], gn1 = gnorm[h * 256 + 32 * w + 16 + frl];
#pragma unroll
              for (int tb = 0; tb < 4; ++tb)
#pragma unroll
                for (int r = 0; r < 4; ++r) { const int t = 16 * tb + 4 * h4 + r; float tot = 0.f;
#pragma unroll
                    for (int ww = 0; ww < 8; ++ww) tot += SSQ[ww * 64 + t];
                    const float rstd = __builtin_amdgcn_rsqf(tot * (1.0f / 256.0f) + EPS);
                    OT[t * POT + 32 * w + fr] = (bf16)f2bf(o[tb][0][r] * rstd * gn0); OT[t * POT + 32 * w + 16 + fr] = (bf16)f2bf(o[tb][1][r] * rstd * gn1); asm volatile("" ::: "memory"); }
              __syncthreads();
#pragma unroll 2
              for (int j = 0; j < 4; ++j) { const int i = tidl + 512 * j, t = i >> 5, c8 = (i & 31) * 8; const size_t go = (row0 + t) * 1024 + h * 256 + c8;
                  f32x4 a0, a1, g0, g1; unpack8(*(const LAS v4u*)(OT + t * POT + c8), a0, a1); unpack8(*(const v4u*)(GATE + go), g0, g1); *(v4u*)(AOUT2 + go) = pack8(a0 * g0, a1 * g1); } }
        }
#pragma unroll
        for (int kb = 0; kb < 8; ++kb) { const f32x4 gm = *(const LAS f32x4*)(GM + 16 * kb + 4 * h4);
#pragma unroll
            for (int vb = 0; vb < 2; ++vb) S[kb][vb] = S[kb][vb] * gm; }
#pragma unroll
        for (int ts = 0; ts < 2; ++ts) { bf16x8 bv[2];
#pragma unroll
            for (int vb = 0; vb < 2; ++vb) TR_FRAG(bv[vb], vtr, (32 * ts * PV + 16 * vb) * 2, 4 * PV * 2);
#pragma unroll
            for (int kb = 0; kb < 8; ++kb) { bf16x8 a; TR_FRAG(a, ktr, (32 * ts * PKH + 16 * kb) * 2, 4 * PKH * 2);
#pragma unroll
                for (int vb = 0; vb < 2; ++vb) S[kb][vb] = __builtin_amdgcn_mfma_f32_16x16x32_bf16(a, bv[vb], S[kb][vb], 0, 0, 0); } }
        __syncthreads();
    }
    if (!FINAL) {
#pragma unroll
        for (int kb = 0; kb < 8; ++kb)
#pragma unroll
            for (int vb = 0; vb < 2; ++vb)
#pragma unroll
                for (int r = 0; r < 4; ++r) GDS[sbase + (size_t)(16 * kb + 4 * h4 + r) * 256 + 32 * w + 16 * vb + fr] = S[kb][vb][r];
        if (tid < 128) GAM[(size_t)(bh * NSEG + s) * 128 + tid] = __expf(gsum);
    }
}
__device__ __forceinline__ void gla_l2_phase(const Frame& F, const bf16* K, const bf16* V, const float* LG, float* GDS, const float* GAM) {
    for (long idx = F.gt; idx < (long)NB * GH * 128 * 64; idx += F.NGT) { const int v4 = (int)(idx & 63), k = (int)(idx >> 6) & 127, bh = (int)(idx >> 13), h = bh & 3;
        float bc[16]; float run = 0.f;
#pragma unroll
        for (int i = 0; i < NMETA; ++i) { run += LG[(size_t)(RM0 + i) * 512 + h * 128 + k]; bc[i] = run; }
        f32x4 carry = {0.f, 0.f, 0.f, 0.f};
#pragma unroll
        for (int i = 0; i < NMETA; ++i) { const float wk = __expf(run - bc[i]) * bf2f(K[(size_t)(RM0 + i) * 512 + h * 128 + k]); const v2u vw = *(const v2u*)(V + (size_t)(RM0 + i) * 1024 + h * 256 + 4 * v4);
            carry += (f32x4){bflo(vw.x), bfhi(vw.x), bflo(vw.y), bfhi(vw.y)} * wk; }
        f32x4 ds[NSEG]; float gm[NSEG];
#pragma unroll
        for (int s = 0; s < NSEG; ++s) { ds[s] = *(const f32x4*)(GDS + ((size_t)(bh * NSEG + s) * 128 + k) * 256 + 4 * v4); gm[s] = GAM[(size_t)(bh * NSEG + s) * 128 + k]; }
#pragma unroll
        for (int s = 0; s < NSEG; ++s) { *(f32x4*)(GDS + ((size_t)(bh * NSEG + s) * 128 + k) * 256 + 4 * v4) = carry; carry = carry * gm[s] + ds[s]; }
    }
}

__device__ __forceinline__ void router_phase(const Frame& F, const Args& a, unsigned char* ws) {
    const float* const* in = a.in; unsigned* ctl = (unsigned*)(ws + WS_CTL); bf16* HNM = (bf16*)(ws + WS_HNM); int* tokinfo = (int*)(ws + WS_TOKINFO);
    const float* gain = in[I_NORM_FFN1]; const float* RW = in[I_ROUTER]; const int lane = F.lane; const bf16* HB = (const bf16*)((const char*)a.out + 64 * MiB);
    LAS unsigned* cnt = (LAS unsigned*)(F.lds + TABL_OFF);
    if (F.tid < 32) cnt[F.tid] = 0u;
    __syncthreads();
    const int per = (TR + F.G - 1) / F.G, m0 = (int)blockIdx.x * per, m1 = (m0 + per < TR) ? m0 + per : TR;
    int my_e0 = 0, my_e1 = 0; unsigned my_p0 = 0, my_p1 = 0; float my_w0 = 0.f;
    int jt = 0;
    v4u nxa = {0u, 0u, 0u, 0u}, nxb = nxa; if (m0 + F.wave < m1) { const bf16* hr0 = HB + (size_t)(m0 + F.wave) * 1024; nxa = *(const v4u*)(hr0 + 8 * lane); nxb = *(const v4u*)(hr0 + 512 + 8 * lane); }
    for (int m = m0 + F.wave; m < m1; m += 8, ++jt) {
        f32x4 v[4]; unpack8(nxa, v[0], v[1]); unpack8(nxb, v[2], v[3]); float s = 0.f;
        if (m + 8 < m1) { const bf16* hr1 = HB + (size_t)(m + 8) * 1024; nxa = *(const v4u*)(hr1 + 8 * lane); nxb = *(const v4u*)(hr1 + 512 + 8 * lane); }
#pragma unroll
        for (int j = 0; j < 4; ++j) s += (v[j].x * v[j].x + v[j].y * v[j].y) + (v[j].z * v[j].z + v[j].w * v[j].w);
        const float rstd = 1.0f / sqrtf(wave_sum(s) * (1.0f / 1024.0f) + EPS);
        float p[8] = {0.f, 0.f, 0.f, 0.f, 0.f, 0.f, 0.f, 0.f};
        f32x4 yv[4];
#pragma unroll
        for (int j = 0; j < 4; ++j) { const int d0 = (j >> 1) * 512 + 8 * lane + (j & 1) * 4; const f32x4 g = *(const f32x4*)(gain + d0); const f32x4 y = v[j] * rstd * g; yv[j] = y;
#pragma unroll
            for (int e4 = 0; e4 < 4; ++e4) { const int d = d0 + e4; const f32x4 r0 = *(const f32x4*)(RW + d * 8), r1 = *(const f32x4*)(RW + d * 8 + 4);
#pragma unroll
                for (int e = 0; e < 4; ++e) { p[e] += y[e4] * r0[e]; p[4 + e] += y[e4] * r1[e]; } } }
        *(v4u*)(HNM + (size_t)m * 1024 + 8 * lane) = pack8(yv[0], yv[1]); *(v4u*)(HNM + (size_t)m * 1024 + 512 + 8 * lane) = pack8(yv[2], yv[3]);
        float q4[4];
#pragma unroll
        for (int i = 0; i < 4; ++i) { const bool up = (lane & 32) != 0; const float keep = up ? p[i + 4] : p[i], send = up ? p[i] : p[i + 4]; q4[i] = keep + __shfl_xor(send, 32); }
        float q2[2];
#pragma unroll
        for (int i = 0; i < 2; ++i) { const bool up = (lane & 16) != 0; const float keep = up ? q4[i + 2] : q4[i], send = up ? q4[i] : q4[i + 2]; q2[i] = keep + __shfl_xor(send, 16); }
        float y; { const bool up = (lane & 8) != 0; const float keep = up ? q2[1] : q2[0], send = up ? q2[0] : q2[1]; y = keep + __shfl_xor(send, 8); }
        y += __shfl_xor(y, 4); y += __shfl_xor(y, 2); y += __shfl_xor(y, 1);
        float lg[8];
#pragma unroll
        for (int e = 0; e < 8; ++e) lg[e] = __shfl(y, ((e >> 2) & 1) * 32 + ((e >> 1) & 1) * 16 + (e & 1) * 8);
        int i0 = 0; float v0 = lg[0];
#pragma unroll
        for (int e = 1; e < 8; ++e) if (lg[e] > v0) { v0 = lg[e]; i0 = e; }
        int i1 = -1; float v1 = -3.0e38f;
#pragma unroll
        for (int e = 0; e < 8; ++e) if (e != i0 && lg[e] > v1) { v1 = lg[e]; i1 = e; }
        if (i1 < 0) i1 = (i0 + 1) & 7;
        if (lane == jt) { my_e0 = i0; my_e1 = i1; my_w0 = 1.0f / (1.0f + __expf(v1 - v0)); my_p0 = atomicAdd((unsigned*)(cnt + i0), 1u); my_p1 = atomicAdd((unsigned*)(cnt + 8 + i1), 1u); }
    }
    __syncthreads();
    if (F.tid < 16) cnt[16 + F.tid] = __hip_atomic_fetch_add(ctl + CW_CNT + F.tid, cnt[F.tid], RLX_AGENT);
    __syncthreads();
    if (lane < jt) { const int m = m0 + F.wave + 8 * lane; const float w1 = 1.0f - my_w0;
        *(v4u*)(tokinfo + (size_t)m * 4) = (v4u){(unsigned)my_e0, cnt[16 + my_e0] + my_p0, __float_as_uint(my_w0), 0u};
        *(v4u*)(tokinfo + (size_t)(TR + m) * 4) = (v4u){(unsigned)my_e1, cnt[24 + my_e1] + my_p1, __float_as_uint(w1), 0u}; }
    LAS float* scr = (LAS float*)(F.lds + RING_OFF + F.wave * 16384);
    constexpr int IG = 16 * 112, ID = 56 * 32, IE = 2 * IG + ID;
    bf16* WGU = (bf16*)(ws + WS_WMOE); bf16* WD = WGU + (size_t)NE * 7168 * 1024;
    for (int it = F.gw; it < NE * IE; it += F.NGW) { const int e = it / IE; int r = it % IE;
        { TrJob j{in[I_MG] + (size_t)e * 1024 * FFE, FFE, 0, 1024, FFE, WGU + (size_t)e * 7168 * 1024, 128, 256, 0}; if (tr_try(r, j, scr, lane)) continue; }
        { TrJob j{in[I_MU] + (size_t)e * 1024 * FFE, FFE, 0, 1024, FFE, WGU + (size_t)e * 7168 * 1024, 128, 256, 128}; if (tr_try(r, j, scr, lane)) continue; }
        { TrJob j{in[I_MD] + (size_t)e * FFE * 1024, 1024, 0, FFE, 1024, WD + (size_t)e * 1024 * FFE, 1 << 30, 0, 0}; tr_try(r, j, scr, lane); }
    }
}
__device__ __forceinline__ void moe_lists_phase(const Frame& F, unsigned char* ws) {
    unsigned* ctl = (unsigned*)(ws + WS_CTL); LAS int* L = (LAS int*)(F.lds + TABL_OFF);
    const int* tokinfo = (const int*)(ws + WS_TOKINFO); int* rowtok = (int*)(ws + WS_ROWTOK); float* roww = (float*)(ws + WS_ROWW);
    int* pexp = (int*)(ws + WS_TAB + TB_PEXP); int* npan = (int*)(ws + WS_TAB + TB_NPAN);
    if (F.tid < 16) L[F.tid] = (int)__hip_atomic_load(ctl + CW_CNT + F.tid, RLX_AGENT);
    __syncthreads();
    if (F.tid == 0) { for (int s = 0; s < 2; ++s) { int acc = 0; for (int e = 0; e < 8; ++e) { L[16 + s * 8 + e] = acc; acc += (L[s * 8 + e] + 255) & ~255; } L[32 + s] = acc >> 8; } }
    __syncthreads();
    if (blockIdx.x == 0) { if (F.tid < 2) npan[F.tid] = L[32 + F.tid];
        if (F.tid < 16) { const int s = F.tid >> 3, base = L[16 + F.tid], n = (L[F.tid] + 255) >> 8; for (int p = 0; p < n; ++p) pexp[s * MPAN + (base >> 8) + p] = F.tid & 7; } }
    for (long i = F.gt; i < 2L * TR; i += F.NGT) { const int s = (int)(i >= TR), tok = (int)(i - (long)s * TR); const v4u inf = *(const v4u*)(tokinfo + i * 4);
        const int row = L[16 + s * 8 + (int)inf.x] + (int)inf.y; rowtok[(size_t)s * MROWS + row] = tok; const unsigned wb = inf.z; roww[(size_t)s * MROWS + row] = __uint_as_float(wb); }
    for (long i = F.gt; i < 16L * 256; i += F.NGT) { const int se = (int)(i >> 8), r = (int)(i & 255), s = se >> 3, cnt = L[se], base = L[16 + se], pad = ((cnt + 255) & ~255) - cnt;
        if (r < pad) { rowtok[(size_t)s * MROWS + base + cnt + r] = -1; roww[(size_t)s * MROWS + base + cnt + r] = 0.f; } }
}

constexpr int N_PHASES = 25;
__global__ void __launch_bounds__(512, 2) mk_fwd(Args args) {
    extern __shared__ __attribute__((aligned(16))) unsigned char lds_raw[];
    Frame F; F.lds = (LAS unsigned char*)lds_raw; F.tid = threadIdx.x; F.lane = F.tid & 63; F.wave = __builtin_amdgcn_readfirstlane(F.tid >> 6); F.G = gridDim.x;
    F.gw = blockIdx.x * 8 + F.wave; F.NGW = F.G * 8; F.gt = (int)blockIdx.x * 512 + F.tid; F.NGT = F.G * 512;
    unsigned char* ws = args.ws; const float* const* in = args.in; float* out = args.out;
    volatile LAS unsigned* MISC = (volatile LAS unsigned*)(F.lds + MISC_OFF);
    if (F.tid < 32) MISC[F.tid] = 0u;
    __syncthreads();
#if !MK_PER_PHASE
    XcdBarrier bar = xcd_barrier_post((unsigned*)(ws + WS_CTL) + CW_BAR, MISC + 8);
#define GRID_BAR() xcd_barrier(bar)
#else
#define GRID_BAR() do { } while (0)
#endif
    const int lo = args.ph_lo, hi = args.ph_hi;
#ifndef MK_MASK
#define MK_MASK 0xFFFFFFFFu
#endif
#ifndef MK_STOP
#define MK_STOP 99
#endif
#define IN(k) ((((MK_MASK) >> (k)) & 1u) && ((k) <= MK_STOP || (k) == 24) && lo <= (k) && (k) < hi)
#define SEAM(k) do { if (IN(k) && IN((k) + 1)) GRID_BAR(); asm volatile("" : "+v"(F.tid), "+v"(F.lane), "+v"(F.gt)); } while (0)
    const int cu = (int)blockIdx.x;
    LAS unsigned char* ring = F.lds + RING_OFF;
    const LAS int* notab = (const LAS int*)(F.lds + TABL_OFF);
    float* hmeta = (float*)(ws + WS_HMETA);
    bf16* HB = (bf16*)((char*)out + 64 * MiB);
    bf16* HN = (bf16*)(ws + WS_HN);
    constexpr size_t P1K = (size_t)256 * 1024 * 2;

    if (IN(0)) { p0_prologue(F, args, ws); } SEAM(0);
    if (IN(1)) { SchedStatic S{NPR, 10, F.G, cu, (const char*)HN, (const char*)(ws + WS_WIN0), P1K, P1K, 0, 0}; EpiWin0 E{(bf16*)(ws + WS_G), (bf16*)(ws + WS_XRBX), (bf16*)(ws + WS_U)};
        pg8::gemm_phase<EpiWin0, SchedStatic, false>(ring, 1024, 1024, S, E, notab);
        for (int t = cu; t < EV_IN / 16; t += F.G) { const int n0 = t * 16; const bf16* const br[1] = {(const bf16*)(ws + WS_WIN0) + (size_t)n0 * 1024}; f32x4 o[1];
            meta_tile<1>(F, HN + (size_t)RM0 * 1024, 1024, 1024, br, 1024, o);
            if (F.wave == 0) { const int row = RM0 + (F.lane & 15), c = n0 + 4 * (F.lane >> 4); f32x4 v = o[0];
                if (c < 1024) { for (int j = 0; j < 4; ++j) v[j] = gelu_tanh(v[j]); *(v2u*)((bf16*)(ws + WS_G) + (size_t)row * 1024 + c) = (v2u){pk2(v[0], v[1]), pk2(v[2], v[3])}; }
                else if (c < 2048) *(v2u*)((bf16*)(ws + WS_XRBX) + (size_t)row * 1024 + c - 1024) = (v2u){pk2(v[0], v[1]), pk2(v[2], v[3])};
                else *(v2u*)((bf16*)(ws + WS_U) + (size_t)row * 512 + c - 2048) = (v2u){pk2(v[0], v[1]), pk2(v[2], v[3])}; } } } SEAM(1);
    if (IN(2)) { for (int pass = 0; pass < 2; ++pass) { if ((pass ^ (F.wave & 1)) == 0) conv_phase(F, (const bf16*)(ws + WS_XRBX), in[I_CONVW], in[I_CONVB], (bf16*)(ws + WS_XC)); else ssm_l1_phase(F, ws, (const bf16*)(ws + WS_U), (float*)(ws + WS_SSE)); } } SEAM(2);
    if (IN(3)) { SchedStatic S{NPR, 8, F.G, cu, (const char*)(ws + WS_XC), (const char*)(ws + WS_GW), P1K, (size_t)256 * 256 * 2, 2, (size_t)256 * 2};
        EpiGates E{in[I_GAB], in[I_GXB], (const float*)(ws + WS_TAB + TB_SP8), (const bf16*)(ws + WS_XC), (bf16*)(ws + WS_A), (bf16*)(ws + WS_XRBX)};
        pg8::gemm_phase<EpiGates, SchedStatic, false>(ring, 256, 1024, S, E, notab);
        for (int t = cu; t < 64; t += F.G) { const int ch0 = t * 16, h = ch0 >> 8, cl = ch0 & 255;
            const bf16* gwb = (const bf16*)(ws + WS_GW) + (size_t)h * 512 * 256 + (size_t)((cl >> 7) * 256 + (cl & 127)) * 256; const bf16* const br[2] = {gwb, gwb + 128 * 256}; f32x4 o[2];
            meta_tile<2>(F, (const bf16*)(ws + WS_XC) + (size_t)RM0 * 1024 + h * 256, 1024, 256, br, 256, o);
            if (F.wave == 0) { const int row = RM0 + (F.lane & 15), ch = ch0 + 4 * (F.lane >> 4); const size_t ro = (size_t)row * 1024 + ch;
                const f32x4 ba = *(const f32x4*)(in[I_GAB] + ch), bx = *(const f32x4*)(in[I_GXB] + ch), sp = *(const f32x4*)((const float*)(ws + WS_TAB + TB_SP8) + ch);
                const v2u xw = *(const v2u*)((const bf16*)(ws + WS_XC) + ro); const float xv[4] = {bflo(xw.x), bfhi(xw.x), bflo(xw.y), bfhi(xw.y)}; f32x4 av, bv;
                for (int j = 0; j < 4; ++j) { const float r = sigmoidf_(o[0][j] + ba[j]), ig = sigmoidf_(o[1][j] + bx[j]), la = -r * sp[j]; av[j] = la; bv[j] = __builtin_amdgcn_sqrtf(fmaxf(one_minus_exp(2.0f * la), 0.0f)) * ig * xv[j]; }
                *(v2u*)((bf16*)(ws + WS_A) + ro) = (v2u){pk2(av[0], av[1]), pk2(av[2], av[3])}; *(v2u*)((bf16*)(ws + WS_XRBX) + ro) = (v2u){pk2(bv[0], bv[1]), pk2(bv[2], bv[3])}; } } } SEAM(3);
    if (IN(4)) { lru_l1_phase(F, (const bf16*)(ws + WS_A), (const bf16*)(ws + WS_XRBX), (float*)(ws + WS_PEND), (float*)(ws + WS_HEND)); } SEAM(4);
    if (IN(5)) { carry_phase(F, ws, (const bf16*)(ws + WS_A), (const bf16*)(ws + WS_XRBX), (const float*)(ws + WS_PEND), (const float*)(ws + WS_HEND), (float*)(ws + WS_CIN), (const bf16*)(ws + WS_U), (const float*)(ws + WS_SSE), (float*)(ws + WS_SSIN)); } SEAM(5);
    if (IN(6)) { mix0_final_phase(F, ws, (const bf16*)(ws + WS_A), (const bf16*)(ws + WS_XRBX), (const float*)(ws + WS_CIN), (const bf16*)(ws + WS_G), (bf16*)(ws + WS_AOUT), in[I_CRE], in[I_CIM], in[I_SD], (const bf16*)(ws + WS_U), (const float*)(ws + WS_SSIN), (bf16*)(ws + WS_GS)); } SEAM(6);
    if (IN(7)) { SchedStatic S{NPR, 2, F.G, cu, (const char*)(ws + WS_GS), (const char*)(ws + WS_GLUW), (size_t)256 * 512 * 2, (size_t)256 * 512 * 2, 0, 0}; EpiGlu E{in[I_GLUB], (const bf16*)(ws + WS_GS), (bf16*)(ws + WS_AOUT)};
        pg8::gemm_phase<EpiGlu, SchedStatic, false>(ring, 512, 512, S, E, notab);
        for (int t = cu; t < 32; t += F.G) { const int n0 = t * 16; const bf16* const br[1] = {(const bf16*)(ws + WS_GLUW) + (size_t)n0 * 512}; f32x4 o[1];
            meta_tile<1>(F, (const bf16*)(ws + WS_GS) + (size_t)RM0 * 512, 512, 512, br, 512, o);
            if (F.wave == 0) { const int row = RM0 + (F.lane & 15), c = n0 + 4 * (F.lane >> 4); const f32x4 b = *(const f32x4*)(in[I_GLUB] + c);
                const v2u gw = *(const v2u*)((const bf16*)(ws + WS_GS) + (size_t)row * 512 + c); const float gv[4] = {bflo(gw.x), bfhi(gw.x), bflo(gw.y), bfhi(gw.y)}; float v[4];
                for (int j = 0; j < 4; ++j) v[j] = gv[j] * sigmoidf_(o[0][j] + b[j]);
                *(v2u*)((bf16*)(ws + WS_AOUT) + (size_t)row * 1536 + 1024 + c) = (v2u){pk2(v[0], v[1]), pk2(v[2], v[3])}; } } } SEAM(7);
    if (IN(8)) { SchedStatic S{NPR, 4, F.G, cu, (const char*)(ws + WS_AOUT), (const char*)(ws + WS_WOUT0), (size_t)256 * 1536 * 2, (size_t)256 * 1536 * 2, 0, 0}; EpiResid E{in[I_X], HB};
        pg8::gemm_phase<EpiResid, SchedStatic, false>(ring, 1536, 1536, S, E, notab);
        for (int t = cu; t < 64; t += F.G) { const int n0 = t * 16; const bf16* const br[1] = {(const bf16*)(ws + WS_WOUT0) + (size_t)n0 * 1536}; f32x4 o[1];
            meta_tile<1>(F, (const bf16*)(ws + WS_AOUT) + (size_t)RM0 * 1536, 1536, 1536, br, 1536, o);
            if (F.wave == 0) { float* p = hmeta + (size_t)(F.lane & 15) * 1024 + n0 + 4 * (F.lane >> 4); *(f32x4*)p = *(const f32x4*)p + o[0]; } } } SEAM(8);
    if (IN(9)) { norm_phase(F, HB, hmeta, in[I_NORM_FFN0], HN, TR + NMETA); } SEAM(9);
    if (IN(10)) { SchedStatic S{NPR, 24, F.G, cu, (const char*)HN, (const char*)(ws + WS_WUP0), P1K, P1K, 0, 0}; EpiSwiglu E{(bf16*)(ws + WS_HID0), FF0};
        pg8::gemm_phase<EpiSwiglu, SchedStatic, false>(ring, 1024, 1024, S, E, notab);
        for (int t = cu; t < FF0 / 16; t += F.G) { const int u0 = t * 16; const bf16* gb = (const bf16*)(ws + WS_WUP0) + (size_t)((u0 >> 7) * 256 + (u0 & 127)) * 1024; const bf16* const br[2] = {gb, gb + 128 * 1024}; f32x4 o[2];
            meta_tile<2>(F, HN + (size_t)RM0 * 1024, 1024, 1024, br, 1024, o);
            if (F.wave == 0) { const int row = RM0 + (F.lane & 15), c = u0 + 4 * (F.lane >> 4); float v[4]; for (int j = 0; j < 4; ++j) v[j] = siluf_(o[0][j]) * o[1][j];
                *(v2u*)((bf16*)(ws + WS_HID0) + (size_t)row * FF0 + c) = (v2u){pk2(v[0], v[1]), pk2(v[2], v[3])}; } } } SEAM(10);
    if (IN(11)) { SchedStatic S{NPR, 4, F.G, cu, (const char*)(ws + WS_HID0), (const char*)(ws + WS_WDN0), (size_t)256 * FF0 * 2, (size_t)256 * FF0 * 2, 0, 0}; EpiResid E{nullptr, HB};
        pg8::gemm_phase<EpiResid, SchedStatic, false>(ring, FF0, FF0, S, E, notab);
        for (int t = cu; t < 64; t += F.G) { const int n0 = t * 16; const bf16* const br[1] = {(const bf16*)(ws + WS_WDN0) + (size_t)n0 * FF0}; f32x4 o[1];
            meta_tile<1>(F, (const bf16*)(ws + WS_HID0) + (size_t)RM0 * FF0, FF0, FF0, br, FF0, o);
            if (F.wave == 0) { float* p = hmeta + (size_t)(F.lane & 15) * 1024 + n0 + 4 * (F.lane >> 4); *(f32x4*)p = *(const f32x4*)p + o[0]; } } } SEAM(11);
    if (IN(12)) { norm_phase(F, HB, hmeta, in[I_NORM_MIX1], HN, TR + NMETA); } SEAM(12);
    if (IN(13)) { SchedStatic S{NPR, 14, F.G, cu, (const char*)HN, (const char*)(ws + WS_WIN1), P1K, P1K, 0, 0}; EpiWin1 E{(bf16*)(ws + WS_Q), (bf16*)(ws + WS_K), (bf16*)(ws + WS_V), (bf16*)(ws + WS_GATE), (float*)(ws + WS_LG), in[I_GB]};
        pg8::gemm_phase<EpiWin1, SchedStatic, false>(ring, 1024, 1024, S, E, notab);
        for (int t = cu; t < 128; t += F.G) { const int n0 = t < 32 ? 512 + t * 16 : (t < 96 ? 1024 + (t - 32) * 16 : 3072 + (t - 96) * 16); const bf16* const br[1] = {(const bf16*)(ws + WS_WIN1) + (size_t)n0 * 1024}; f32x4 o[1];
            meta_tile<1>(F, HN + (size_t)RM0 * 1024, 1024, 1024, br, 1024, o);
            if (F.wave == 0) { const int row = RM0 + (F.lane & 15), c = n0 + 4 * (F.lane >> 4); const f32x4 v = o[0];
                if (c < 1024) *(v2u*)((bf16*)(ws + WS_K) + (size_t)row * 512 + c - 512) = (v2u){pk2(v[0], v[1]), pk2(v[2], v[3])};
                else if (c < 2048) *(v2u*)((bf16*)(ws + WS_V) + (size_t)row * 1024 + c - 1024) = (v2u){pk2(v[0], v[1]), pk2(v[2], v[3])};
                else { const f32x4 b = *(const f32x4*)(in[I_GB] + c - 3072); f32x4 l; for (int j = 0; j < 4; ++j) l[j] = logsigmoidf_(v[j] + b[j]) * 0.0625f; *(f32x4*)((float*)(ws + WS_LG) + (size_t)row * 512 + c - 3072) = l; } } } } SEAM(13);
    if (IN(14)) { for (int it = cu; it < NB * GH * NSEG; it += F.G) gla_item<false>(F, it >> 6, (it >> 4) & 3, it & 15, (const bf16*)(ws + WS_Q), (const bf16*)(ws + WS_K), (const bf16*)(ws + WS_V), (const bf16*)(ws + WS_GATE), (const float*)(ws + WS_LG), in[I_GNORM], (float*)(ws + WS_GDS), (float*)(ws + WS_TAB + TB_GAM), (bf16*)(ws + WS_AOUT2)); } SEAM(14);
    if (IN(15)) { gla_l2_phase(F, (const bf16*)(ws + WS_K), (const bf16*)(ws + WS_V), (const float*)(ws + WS_LG), (float*)(ws + WS_GDS), (const float*)(ws + WS_TAB + TB_GAM)); } SEAM(15);
    if (IN(16)) { for (int it = cu; it < NB * GH * NSEG; it += F.G) gla_item<true>(F, it >> 6, (it >> 4) & 3, it & 15, (const bf16*)(ws + WS_Q), (const bf16*)(ws + WS_K), (const bf16*)(ws + WS_V), (const bf16*)(ws + WS_GATE), (const float*)(ws + WS_LG), in[I_GNORM], (float*)(ws + WS_GDS), (float*)(ws + WS_TAB + TB_GAM), (bf16*)(ws + WS_AOUT2)); } SEAM(16);
    if (IN(17)) { SchedStatic S{NPR, 4, F.G, cu, (const char*)(ws + WS_AOUT2), (const char*)(ws + WS_WOUT1), P1K, P1K, 0, 0}; EpiResid E{nullptr, HB};
        pg8::gemm_phase<EpiResid, SchedStatic, false>(ring, 1024, 1024, S, E, notab); } SEAM(17);
    if (IN(18)) { router_phase(F, args, ws); } SEAM(18);
    if (IN(19)) { moe_lists_phase(F, ws); } SEAM(19);
#define MOE_PHASES(pu, pd, slot) \
    if (IN(pu)) { const int np = ((const int*)(ws + WS_TAB + TB_NPAN))[slot], nun = np * 28; LAS int* meta = (LAS int*)(F.lds + TABL_OFF); LAS int* tokt = (LAS int*)(F.lds + TABL_OFF + 512); \
        const int* pexp = (const int*)(ws + WS_TAB + TB_PEXP) + (slot) * MPAN; const int* rowtok = (const int*)(ws + WS_ROWTOK) + (size_t)(slot) * MROWS; int nmy = 0; \
        __syncthreads(); \
        for (int i = 0; (long)i * F.G + cu < nun && i < 20; ++i) { const int Lq = i * F.G + cu, p = Lq / 28, n = Lq % 28; if (F.tid == 0) { meta[i * 4] = p; meta[i * 4 + 1] = n; meta[i * 4 + 2] = pexp[p]; meta[i * 4 + 3] = 0; } \
            if (F.tid < 256) tokt[i * 256 + F.tid] = rowtok[p * 256 + F.tid]; ++nmy; } \
        __syncthreads(); \
        SchedList S{nmy, meta, (const char*)(ws + WS_HNM), (const char*)(ws + WS_WMOE), 0, P1K, (size_t)7168 * 1024 * 2}; EpiSwiglu E{(bf16*)(ws + WS_HIDM), FFE}; \
        pg8::gemm_phase<EpiSwiglu, SchedList, true>(ring, 1024, 1024, S, E, tokt); } SEAM(pu); \
    if (IN(pd)) { const int np = ((const int*)(ws + WS_TAB + TB_NPAN))[slot], nun = np * 4, nfull = nun < 512 ? nun : 512, nrem = nun - nfull; LAS int* meta = (LAS int*)(F.lds + TABL_OFF); LAS int* tokt = (LAS int*)(F.lds + TABL_OFF + 512); LAS float* wtt = (LAS float*)(F.lds + TABL_OFF + 512 + 4096); \
        const int* pexp = (const int*)(ws + WS_TAB + TB_PEXP) + (slot) * MPAN; const int* rowtok = (const int*)(ws + WS_ROWTOK) + (size_t)(slot) * MROWS; const float* roww = (const float*)(ws + WS_ROWW) + (size_t)(slot) * MROWS; int nmy = 0; \
        __syncthreads(); \
        for (int i = 0; (long)i * F.G + cu < nfull && i < 3; ++i) { const int Lq = i * F.G + cu, p = Lq / 4, n = Lq % 4; if (F.tid == 0) { meta[i * 4] = p; meta[i * 4 + 1] = n; meta[i * 4 + 2] = pexp[p]; meta[i * 4 + 3] = 0; } \
            if (F.tid < 256) { tokt[i * 256 + F.tid] = rowtok[p * 256 + F.tid]; wtt[i * 256 + F.tid] = roww[p * 256 + F.tid]; } ++nmy; } \
        const bool slice = cu < nrem * 4;                   \
        if (slice && F.tid == 0) { const int Lq = 512 + cu / 4, p = Lq / 4, n = Lq % 4; meta[12] = p; meta[13] = n; meta[14] = pexp[p]; meta[15] = (cu & 3) * 896; } \
        __syncthreads(); \
        { SchedList S{nmy, meta, (const char*)(ws + WS_HIDM), (const char*)(ws + WS_WMOE) + (size_t)NE * 7168 * 1024 * 2, (size_t)256 * FFE * 2, (size_t)256 * FFE * 2, (size_t)1024 * FFE * 2}; EpiMoeDown E{HB, tokt, wtt}; \
          pg8::gemm_phase<EpiMoeDown, SchedList, false>(ring, FFE, FFE, S, E, tokt); } \
        { SchedList S{slice ? 1 : 0, meta + 12, (const char*)(ws + WS_HIDM), (const char*)(ws + WS_WMOE) + (size_t)NE * 7168 * 1024 * 2, (size_t)256 * FFE * 2, (size_t)256 * FFE * 2, (size_t)1024 * FFE * 2}; EpiSlab E{(float*)(ws + WS_SLAB), meta + 12}; \
          pg8::gemm_phase<EpiSlab, SchedList, false>(ring, 896, FFE, S, E, tokt, FFE); } } SEAM(pd);
    MOE_PHASES(20, 21, 0)
    if (IN(22)) { const int np0 = ((const int*)(ws + WS_TAB + TB_NPAN))[0]; const int nrow = (np0 - 128) * 256; const float* slab = (const float*)(ws + WS_SLAB); const int* rowtok = (const int*)(ws + WS_ROWTOK); const float* roww = (const float*)(ws + WS_ROWW);
        for (long i = F.gt; i < (long)nrow * 128; i += F.NGT) { const int r = (int)(i >> 7), c8 = (int)(i & 127) * 8; const int tok = rowtok[TR + r];
            if (tok >= 0) { const float w = roww[TR + r]; f32x4 s0 = *(const f32x4*)(slab + (size_t)r * 1024 + c8), s1 = *(const f32x4*)(slab + (size_t)r * 1024 + c8 + 4);
#pragma unroll
                for (int sl = 1; sl < 4; ++sl) { s0 += *(const f32x4*)(slab + ((size_t)sl * 2048 + r) * 1024 + c8); s1 += *(const f32x4*)(slab + ((size_t)sl * 2048 + r) * 1024 + c8 + 4); }
                bf16* d = HB + (size_t)tok * 1024 + c8; f32x4 v0, v1; unpack8(*(const v4u*)d, v0, v1); *(v4u*)d = pack8(v0 + s0 * w, v1 + s1 * w); } } }
    MOE_PHASES(22, 23, 1)
    if (IN(24)) { LAS int* Lb = (LAS int*)(F.lds + TABL_OFF); const unsigned* ctl_ = (const unsigned*)(ws + WS_CTL);
        __syncthreads();
        if (F.tid == 0) { int acc = 0; for (int e = 0; e < 8; ++e) { Lb[e] = acc; acc += ((int)__hip_atomic_load(ctl_ + CW_CNT + 8 + e, RLX_AGENT) + 255) & ~255; } }
        __syncthreads();
        const int* tokinfo1 = (const int*)(ws + WS_TOKINFO) + (size_t)TR * 4; const float* slab = (const float*)(ws + WS_SLAB); const float* fg = in[I_FNORM]; const int lane = F.lane;
        const f32x4 g0 = *(const f32x4*)(fg + 8 * lane), g1 = *(const f32x4*)(fg + 8 * lane + 4), g2 = *(const f32x4*)(fg + 512 + 8 * lane), g3 = *(const f32x4*)(fg + 512 + 8 * lane + 4);
#define FIN_ROW(m, wa, wb) do { f32x4 v[4]; unpack8(wa, v[0], v[1]); unpack8(wb, v[2], v[3]); \
            { const v4u inf = *(const v4u*)(tokinfo1 + (size_t)(m) * 4); const unsigned ex = inf.x, ps = inf.y, wbits = inf.z; const int r1 = Lb[ex] + (int)ps - TR; \
              if (r1 >= 0) { const float w = __uint_as_float(wbits); \
                _Pragma("unroll") for (int sl = 0; sl < 4; ++sl) { const float* sp = slab + ((size_t)sl * 2048 + r1) * 1024; \
                    v[0] += *(const f32x4*)(sp + 8 * lane) * w; v[1] += *(const f32x4*)(sp + 8 * lane + 4) * w; v[2] += *(const f32x4*)(sp + 512 + 8 * lane) * w; v[3] += *(const f32x4*)(sp + 512 + 8 * lane + 4) * w; } } } \
            float s_ = 0.f; _Pragma("unroll") for (int j = 0; j < 4; ++j) s_ += (v[j].x * v[j].x + v[j].y * v[j].y) + (v[j].z * v[j].z + v[j].w * v[j].w); \
            const float rstd = 1.0f / sqrtf(wave_sum(s_) * (1.0f / 1024.0f) + EPS); float* orow = out + (size_t)(m) * 1024; \
            *(f32x4*)(orow + 8 * lane) = v[0] * rstd * g0; *(f32x4*)(orow + 8 * lane + 4) = v[1] * rstd * g1; *(f32x4*)(orow + 512 + 8 * lane) = v[2] * rstd * g2; *(f32x4*)(orow + 512 + 8 * lane + 4) = v[3] * rstd * g3; } while (0)
        for (int m = F.gw; m < TR / 2; m += 2 * F.NGW) { const int m2 = m + F.NGW; const v4u wa = *(const v4u*)(HB + (size_t)m * 1024 + 8 * lane), wb = *(const v4u*)(HB + (size_t)m * 1024 + 512 + 8 * lane);
            v4u wc = wa, wd = wb; if (m2 < TR / 2) { wc = *(const v4u*)(HB + (size_t)m2 * 1024 + 8 * lane); wd = *(const v4u*)(HB + (size_t)m2 * 1024 + 512 + 8 * lane); }
            FIN_ROW(m, wa, wb); if (m2 < TR / 2) FIN_ROW(m2, wc, wd); }
        v4u ra[8], rb[8];
        for (int base = TR / 2; base < TR; base += 8 * F.NGW) {
#pragma unroll
            for (int j = 0; j < 8; ++j) { const int m = base + F.gw + j * F.NGW; if (m < TR) { ra[j] = *(const v4u*)(HB + (size_t)m * 1024 + 8 * lane); rb[j] = *(const v4u*)(HB + (size_t)m * 1024 + 512 + 8 * lane); } }
            GRID_BAR();
#pragma unroll
            for (int j = 0; j < 8; ++j) { const int m = base + F.gw + j * F.NGW; if (m < TR) FIN_ROW(m, ra[j], rb[j]); }
        }
#undef FIN_ROW
    }
#undef IN
#undef SEAM
}

extern "C" void kernel_launch(void* const* d_in, const int* in_sizes, int n_in, void* d_out, int out_size, void* d_ws, size_t ws_size, hipStream_t stream) {
    static int grid = 0;
    if (grid == 0) {
        if (n_in != 38 || out_size != TR * D || ws_size < WS_END) { fprintf(stderr, "kernel_launch: unexpected problem shape (n_in %d, out %d, ws %zu); nothing launched\n", n_in, out_size, ws_size); grid = -1; return; }
        int dev = 0, cus = 0, per_cu = 0;
        if (hipGetDevice(&dev) != hipSuccess || hipDeviceGetAttribute(&cus, hipDeviceAttributeMultiprocessorCount, dev) != hipSuccess) { grid = -1; return; }
        if (hipFuncSetAttribute((const void*)mk_fwd, hipFuncAttributeMaxDynamicSharedMemorySize, LDS_BYTES) != hipSuccess) { fprintf(stderr, "kernel_launch: hipFuncSetAttribute failed\n"); grid = -1; return; }
        if (hipOccupancyMaxActiveBlocksPerMultiprocessor(&per_cu, (const void*)mk_fwd, 512, LDS_BYTES) != hipSuccess || per_cu < 1) fprintf(stderr, "kernel_launch: note: occupancy query reports %d workgroups per CU\n", per_cu);
        (void)hipGetLastError();
        grid = cus;
    }
    if (grid < 0) return;
    (void)hipMemsetAsync((char*)d_ws + WS_CTL, 0, CTL_ZERO_BYTES, stream);
    Args a{};
    for (int i = 0; i < 38; ++i) a.in[i] = (const float*)d_in[i];
    a.out = (float*)d_out; a.ws = (unsigned char*)d_ws; a.li = 0; a.pad = 0;
#if MK_PER_PHASE
    for (int k = 0; k < N_PHASES; ++k) { a.ph_lo = k; a.ph_hi = k + 1; hipLaunchKernelGGL(mk_fwd, dim3(grid), dim3(512), LDS_BYTES, stream, a); }
#else
    a.ph_lo = 0; a.ph_hi = N_PHASES; hipLaunchKernelGGL(mk_fwd, dim3(grid), dim3(512), LDS_BYTES, stream, a);
#endif
}
```

```cpp
#include <hip/hip_runtime.h>
#include <cstdio>
#include <cstdint>

#ifndef MK_PER_PHASE
#define MK_PER_PHASE 0
#endif

#define GAS __attribute__((address_space(1)))
#define LAS __attribute__((address_space(3)))
typedef unsigned short bf16;
typedef unsigned v4u __attribute__((ext_vector_type(4)));
typedef unsigned v2u __attribute__((ext_vector_type(2)));
typedef float f32x4 __attribute__((ext_vector_type(4)));
typedef float f32x2 __attribute__((ext_vector_type(2)));
typedef short bf16x8 __attribute__((ext_vector_type(8)));

constexpr int D = 1024, NB = 4, SEQ = 8192, NMETA = 16;
constexpr int TR = NB * SEQ;
constexpr int RM0 = TR;
constexpr int NPR = 128, NPA = 129;
constexpr int RALL = NPA * 256;
constexpr int LRUW = 1024, SSMW = 512, NG = 32, NS = 64, EV_IN = 2560, EV_MIX = 1536, FF0 = 3072;
constexpr int GK = 512, GV = 1024, GH = 4, GDK = 128, GDV = 256, OD_INP = 3584  , OD_IN = 3088;
constexpr int NE = 8, FFE = 3584, MROWS = 34816  , MPAN = 136;
constexpr float EPS = 1e-6f;
constexpr int NCH = 128;
constexpr int NSEG = 16, SEGC = 8;

constexpr size_t MiB = 1u << 20;
constexpr size_t WS_CTL = 0, CTL_ZERO_BYTES = 32768;
constexpr size_t WS_TAB = 1 * MiB;
constexpr size_t WS_WIN0 = 2 * MiB, WS_GW = 7 * MiB, WS_GLUW = 8 * MiB, WS_WOUT0 = 9 * MiB, WS_WUP0 = 12 * MiB, WS_WDN0 = 24 * MiB, WS_WIN1 = 30 * MiB, WS_WOUT1 = 37 * MiB;
constexpr size_t WS_PEND = 40 * MiB, WS_HEND = 42 * MiB, WS_CIN = 44 * MiB, WS_SSE = 46 * MiB, WS_SSIN = 54 * MiB, WS_GDS = 62 * MiB, WS_HMETA = 94 * MiB;
constexpr size_t WS_G = 96 * MiB, WS_U = 161 * MiB, WS_A = 194 * MiB, WS_XRBX = 323 * MiB, WS_HN = 388 * MiB, WS_AOUT = 388 * MiB, WS_XC = 453 * MiB, WS_GS = 485 * MiB;
constexpr size_t WS_HID0 = 96 * MiB;
constexpr size_t WS_WE = 62 * MiB;
constexpr size_t WS_Q = 96 * MiB, WS_K = 129 * MiB, WS_V = 162 * MiB, WS_GATE = 227 * MiB, WS_LG = 292 * MiB, WS_AOUT2 = 453 * MiB;
constexpr size_t WS_SLAB = 2 * MiB  , WS_HNM = 40 * MiB, WS_WMOE = 105 * MiB, WS_HIDM = 273 * MiB, WS_TOKINFO = 511 * MiB, WS_ROWTOK = 512 * MiB, WS_ROWW = 512 * MiB + 512 * 1024, WS_END = 513 * MiB;
constexpr size_t TB_BBR = 0, TB_BBI = 131072, TB_AR = 262144, TB_AI = 270336, TB_AR64 = 278528, TB_AI64 = 286720, TB_SP8 = 294912, TB_GAM = 299008  , TB_PEXP = 430080  , TB_NPAN = 432128;
constexpr int CW_TMO = 0, CW_CODE = 1, CW_CNT = 64  , CW_BAR = 4096;

constexpr int RING_OFF = 0, RING_BYTES = 131072;
constexpr int TABL_OFF = RING_BYTES, TABL_BYTES = 24576;
constexpr int MISC_OFF = TABL_OFF + TABL_BYTES;
constexpr int LDS_BYTES = MISC_OFF + 128;

#define RLX_AGENT __ATOMIC_RELAXED, __HIP_MEMORY_SCOPE_AGENT
#define LDS_WAIT() asm volatile("s_waitcnt lgkmcnt(0)" ::: "memory")
#define VM_WAIT() asm volatile("s_waitcnt vmcnt(0)" ::: "memory")
__device__ __forceinline__ unsigned f2bf(float f) { unsigned u = __builtin_bit_cast(unsigned, f); return (u + 0x7fffu + ((u >> 16) & 1u)) >> 16; }
__device__ __forceinline__ unsigned pk2(float lo, float hi) { unsigned r; asm("v_cvt_pk_bf16_f32 %0, %1, %2" : "=v"(r) : "v"(lo), "v"(hi)); return r; }
__device__ __forceinline__ float bf2f(unsigned b) { return __builtin_bit_cast(float, b << 16); }
__device__ __forceinline__ float bflo(unsigned w) { return __builtin_bit_cast(float, w << 16); }
__device__ __forceinline__ float bfhi(unsigned w) { return __builtin_bit_cast(float, w & 0xffff0000u); }
__device__ __forceinline__ float rcpf_(float x) { return __builtin_amdgcn_rcpf(x); }
__device__ __forceinline__ float sigmoidf_(float x) { return rcpf_(1.0f + __expf(-x)); }
__device__ __forceinline__ float siluf_(float x) { return x * rcpf_(1.0f + __expf(-x)); }
__device__ __forceinline__ float gelu_tanh(float x) { const float u = 0.7978845608028654f * (x + 0.044715f * x * x * x); return x * rcpf_(1.0f + __expf(-2.0f * u)); }
__device__ __forceinline__ float one_minus_exp(float x) { const float p = -x * (1.0f + 0.5f * x * (1.0f + (1.0f / 3.0f) * x * (1.0f + 0.25f * x * (1.0f + 0.2f * x * (1.0f + (1.0f / 6.0f) * x))))); return x > -0.25f ? p : 1.0f - __expf(x); }
__device__ __forceinline__ float logsigmoidf_(float x) { return fminf(x, 0.0f) - __logf(1.0f + __expf(-fabsf(x))); }
__device__ __forceinline__ float wave_sum(float v) {
#pragma unroll
    for (int o = 1; o < 64; o <<= 1) v += __shfl_xor(v, o);
    return v;
}

namespace pg8 {
constexpr int BM = 256, BK = 64, HALF = 128, HTB = HALF * BK * 2, STAGE_BYTES = 8 * HTB, NXCD = 8, WGM = 8;
__host__ __device__ __forceinline__ int lds_byte(int r, int c) { const int st = (r >> 4) * 2 + (c >> 5), rr = r & 15, cc = c & 31, ob = rr * 64 + cc * 2; return st * 1024 + (ob ^ (((ob >> 9) & 1) << 5)); }
__host__ __device__ __forceinline__ void stage_rc(int b, int& R, int& C) { const int st = b / 1024, sb = b % 1024, swz = sb ^ (((sb >> 9) & 1) << 5); R = (st >> 1) * 16 + swz / 64; C = (st & 1) * 32 + (swz % 64) / 2; }
__host__ __device__ __forceinline__ int perm32(int rho) { const int n = rho >> 4, i = rho & 15; return 8 * (i >> 2) + 4 * n + (i & 3); }

struct Unit { int pm, pn, slot; const char* a; const char* b; };
__device__ __forceinline__ bool static_tile(int i, int G, int c, int nM, int nN, int& pm, int& pn) {
    const int nwg = nM * nN; const long L = (long)i * G + c; if (L >= nwg) return false;
    int wgid = (int)L; { const int q = nwg / NXCD, r = nwg % NXCD, xcd = wgid % NXCD, off = wgid / NXCD; wgid = (xcd < r ? xcd * (q + 1) : r * (q + 1) + (xcd - r) * q) + off; }
    const int nig = WGM * nN, gid = wgid / nig, fm = gid * WGM, gsz = (nM - fm) < WGM ? (nM - fm) : WGM;
    pm = fm + ((wgid % nig) % gsz); pn = (wgid % nig) / gsz; return true;
}
__device__ __forceinline__ unsigned cvt_pk_bf16(float lo, float hi) { unsigned r; asm volatile("v_cvt_pk_bf16_f32 %0, %1, %2" : "=v"(r) : "v"(lo), "v"(hi)); return r; }

template <class Epi, class Sched, bool GATHER>
__device__ __forceinline__ void gemm_phase(LAS unsigned char* lds, const int K, const int lda, const Sched& S, const Epi& E, const LAS int* gtab, const int ldb_ = 0) {
    const int tid = threadIdx.x, wid = __builtin_amdgcn_readfirstlane(tid >> 6), lane = tid & 63, wr = wid >> 2, wc = wid & 3, fr = lane & 15, fq = lane >> 4;
    int nt = K / BK; asm volatile("" : "+s"(nt));
    int RA[2], CA[2]; unsigned voffB[2];
#pragma unroll
    for (int i = 0; i < 2; ++i) { int R, C; stage_rc(tid * 16 + i * 8192, R, C); const int Rb = Epi::PERM ? ((R & ~31) + perm32(R & 31)) : R;
        RA[i] = R; CA[i] = C; voffB[i] = (unsigned)(Rb * (ldb_ ? ldb_ : K) + C) * 2u; }
    const size_t kstep = (size_t)(BK * 2);
    const size_t hstepB = (size_t)HALF * (ldb_ ? ldb_ : K) * 2;
    const unsigned ldsw = (unsigned)wid * 1024u;
    const int aoff = lds_byte(wr * 64 + fr, fq * 8), boff = lds_byte(wc * 32 + fr, fq * 8);
    unsigned offC[2][2], offN[2][2];
#define PG8_SETOFF(dst, unit) do { _Pragma("unroll") for (int _h = 0; _h < 2; ++_h) _Pragma("unroll") for (int _i = 0; _i < 2; ++_i) { \
        if constexpr (GATHER) { int _t = gtab[(unit).slot * 256 + _h * HALF + RA[_i]]; _t = _t < 0 ? 0 : _t; dst[_h][_i] = ((unsigned)_t * (unsigned)lda + (unsigned)CA[_i]) * 2u; } \
        else dst[_h][_i] = ((unsigned)(_h * HALF + RA[_i]) * (unsigned)lda + (unsigned)CA[_i]) * 2u; } } while (0)
#define PG8_SA(b, h) (((b) * 2 + (h)) * HTB)
#define PG8_SB(b, h) ((4 + (b) * 2 + (h)) * HTB)
#define PG8_STAGEB(bufoff, gbase) do { _Pragma("unroll") for (int _i = 0; _i < 2; ++_i) \
        __builtin_amdgcn_global_load_lds((const unsigned*)((const char*)(gbase) + voffB[_i]), (LAS unsigned*)(lds + (bufoff) + ldsw + _i * 8192), 16, 0, 0); } while (0)
#define PG8_STAGEA(bufoff, gbase, o0, o1) do { \
        __builtin_amdgcn_global_load_lds((const unsigned*)((const char*)(gbase) + (o0)), (LAS unsigned*)(lds + (bufoff) + ldsw), 16, 0, 0); \
        __builtin_amdgcn_global_load_lds((const unsigned*)((const char*)(gbase) + (o1)), (LAS unsigned*)(lds + (bufoff) + ldsw + 8192), 16, 0, 0); } while (0)
#define PG8_LDA(dst, b, h) do { _Pragma("unroll") for (int m = 0; m < 4; ++m) _Pragma("unroll") for (int k = 0; k < 2; ++k) dst[m][k] = *(const LAS bf16x8*)(lds + PG8_SA(b, h) + aoff + m * 2048 + k * 1024); } while (0)
#define PG8_LDB(dst, b, h) do { _Pragma("unroll") for (int n = 0; n < 2; ++n) _Pragma("unroll") for (int k = 0; k < 2; ++k) dst[n][k] = *(const LAS bf16x8*)(lds + PG8_SB(b, h) + boff + n * 2048 + k * 1024); } while (0)
#define PG8_MMA(ai, bj, At, Bt) do { __builtin_amdgcn_s_setprio(1); _Pragma("unroll") for (int m = 0; m < 4; ++m) _Pragma("unroll") for (int n = 0; n < 2; ++n) _Pragma("unroll") for (int k = 0; k < 2; ++k) \
        acc[ai][bj][m][n] = __builtin_amdgcn_mfma_f32_16x16x32_bf16(Bt[n][k], At[m][k], acc[ai][bj][m][n], 0, 0, 0); __builtin_amdgcn_s_setprio(0); } while (0)
#define PG8_WAIT_V(n) asm volatile("s_waitcnt vmcnt(" #n ")" ::: "memory")
#define PG8_WAIT_L(n) asm volatile("s_waitcnt lgkmcnt(" #n ")" ::: "memory")
#define PG8_BAR __builtin_amdgcn_s_barrier()
#define PG8_SCHED __builtin_amdgcn_sched_barrier(0)
    Unit cur, nxt; int ui = 0;
    if (!S.next(0, cur)) return;
    f32x4 acc[2][2][4][2];
#pragma unroll
    for (int a = 0; a < 2; ++a)
#pragma unroll
        for (int b = 0; b < 2; ++b)
#pragma unroll
            for (int m = 0; m < 4; ++m)
#pragma unroll
                for (int n = 0; n < 2; ++n) acc[a][b][m][n] = (f32x4){0.f, 0.f, 0.f, 0.f};
    bf16x8 At[4][2], B0[2][2], B1[2][2];
    const char* cA = cur.a; const char* cB = cur.b;
    PG8_SETOFF(offC, cur);
    PG8_STAGEB(PG8_SB(0, 0), cB); PG8_STAGEB(PG8_SB(0, 1), cB + hstepB); PG8_STAGEA(PG8_SA(0, 0), cA, offC[0][0], offC[0][1]); PG8_STAGEA(PG8_SA(0, 1), cA, offC[1][0], offC[1][1]);
    if (wr == 1) PG8_BAR;
    PG8_WAIT_V(2); PG8_BAR;
    PG8_STAGEB(PG8_SB(1, 0), cB + kstep); PG8_STAGEA(PG8_SA(1, 0), cA + kstep, offC[0][0], offC[0][1]); PG8_STAGEB(PG8_SB(1, 1), cB + hstepB + kstep);
    PG8_WAIT_V(6); PG8_BAR;
    for (;;) {
        const bool has_next = S.next(ui + 1, nxt);
        const char* nA = has_next ? nxt.a : cA; const char* nB = has_next ? nxt.b : cB;
        if constexpr (GATHER) {
#pragma unroll
        for (int h = 0; h < 2; ++h)
#pragma unroll
            for (int i = 0; i < 2; ++i) offN[h][i] = offC[h][i]; }
        for (int t = 0; t < nt; t += 2) {
            const bool last = (t == nt - 2);
            const char* a1 = cA + (size_t)(t + 1) * kstep;
            const char* a2 = last ? nA : cA + (size_t)(t + 2) * kstep; const char* b2 = last ? nB : cB + (size_t)(t + 2) * kstep;
            const char* a3 = a2 + kstep; const char* b3 = b2 + kstep;
            if constexpr (GATHER) { if (last && has_next) PG8_SETOFF(offN, nxt); }
            unsigned q00 = offC[0][0], q01 = offC[0][1], q10 = offC[1][0], q11 = offC[1][1];
            if constexpr (GATHER) { q00 = last ? offN[0][0] : q00; q01 = last ? offN[0][1] : q01; q10 = last ? offN[1][0] : q10; q11 = last ? offN[1][1] : q11; }
            PG8_LDB(B0, 0, 0); PG8_LDB(B1, 0, 1); PG8_SCHED; PG8_LDA(At, 0, 0); PG8_STAGEA(PG8_SA(1, 1), a1, offC[1][0], offC[1][1]);
            PG8_WAIT_V(8); PG8_WAIT_L(0); PG8_BAR; PG8_MMA(0, 0, At, B0); PG8_MMA(0, 1, At, B1); PG8_BAR; PG8_SCHED;
            PG8_LDA(At, 0, 1); PG8_STAGEB(PG8_SB(0, 0), b2); PG8_STAGEB(PG8_SB(0, 1), b2 + hstepB); PG8_STAGEA(PG8_SA(0, 0), a2, q00, q01);
            PG8_WAIT_V(8); PG8_WAIT_L(0); PG8_BAR; PG8_MMA(1, 0, At, B0); PG8_MMA(1, 1, At, B1); PG8_BAR; PG8_SCHED;
            PG8_LDB(B0, 1, 0); PG8_LDB(B1, 1, 1); PG8_SCHED; PG8_LDA(At, 1, 0); PG8_STAGEA(PG8_SA(0, 1), a2, q10, q11);
            PG8_WAIT_V(8); PG8_WAIT_L(0); PG8_BAR; PG8_MMA(0, 0, At, B0); PG8_MMA(0, 1, At, B1); PG8_BAR; PG8_SCHED;
            PG8_LDA(At, 1, 1); PG8_STAGEB(PG8_SB(1, 0), b3); PG8_STAGEB(PG8_SB(1, 1), b3 + hstepB); PG8_STAGEA(PG8_SA(1, 0), a3, q00, q01);
            PG8_WAIT_V(8); PG8_WAIT_L(0); PG8_BAR; PG8_MMA(1, 0, At, B0); PG8_MMA(1, 1, At, B1); PG8_BAR; PG8_SCHED;
        }
        if (wr == 0) PG8_BAR;
        E(acc, cur, wr, wc, fr, fq);
        if (!has_next) break;
#pragma unroll
        for (int a = 0; a < 2; ++a)
#pragma unroll
            for (int b = 0; b < 2; ++b)
#pragma unroll
                for (int m = 0; m < 4; ++m)
#pragma unroll
                    for (int n = 0; n < 2; ++n) acc[a][b][m][n] = (f32x4){0.f, 0.f, 0.f, 0.f};
        cur = nxt; cA = nA; cB = nB; ++ui;
        if constexpr (GATHER) {
#pragma unroll
        for (int h = 0; h < 2; ++h)
#pragma unroll
            for (int i = 0; i < 2; ++i) offC[h][i] = offN[h][i]; }
        if (wr == 1) PG8_BAR;
    }
    PG8_WAIT_V(0);
    PG8_BAR;
#undef PG8_SETOFF
#undef PG8_SA
#undef PG8_SB
#undef PG8_STAGEA
#undef PG8_STAGEB
#undef PG8_LDA
#undef PG8_LDB
#undef PG8_MMA
#undef PG8_WAIT_V
#undef PG8_WAIT_L
#undef PG8_BAR
#undef PG8_SCHED
}
}

#define XB_TMO      128
#define XB_XCNT(j)  (256  + 64 * (j))
#define XB_XSUB(j)  (1280 + 64 * (j))
#define XB_XGEN(j)  (2304 + 64 * (j))
#define XB_TOP      3328
#define XB_TOPGEN   3392
#define XCD_BAR_WORDS 3456
#define XB_SPIN_CAP (1u << 18)
__device__ __forceinline__ unsigned xb_ld(unsigned* p)              { return __hip_atomic_load(p, __ATOMIC_RELAXED, __HIP_MEMORY_SCOPE_AGENT); }
__device__ __forceinline__ unsigned xb_add(unsigned* p, unsigned v) { return __hip_atomic_fetch_add(p, v, __ATOMIC_RELAXED, __HIP_MEMORY_SCOPE_AGENT); }
__device__ __forceinline__ unsigned xb_xcc_id() { return (unsigned)__builtin_amdgcn_s_getreg((3 << 11) | 20) & 0xFu; }
#define XB_SPIN(cond, bar) do { unsigned _sp = 0; while (cond) { __builtin_amdgcn_s_sleep(1); \
    if ((++_sp & 255u) == 0u) { if (xb_ld(&(bar)[XB_TMO])) break; if (_sp > XB_SPIN_CAP) { atomicAdd(&(bar)[XB_TMO], 1u); break; } } } } while (0)
struct XcdBarrier { unsigned* bar; unsigned x; volatile LAS unsigned* st; };
__device__ __forceinline__ XcdBarrier xcd_barrier_post(unsigned* bar, volatile LAS unsigned* st) {
    XcdBarrier b; b.bar = bar; b.x = xb_xcc_id(); b.st = st;
    if (threadIdx.x == 0) (void)xb_add(&bar[XB_XCNT(b.x)], 1u);
    return b;
}
__device__ __forceinline__ void xcd_barrier_complete(unsigned* bar, unsigned x, unsigned& nloc, unsigned& nx) {
    const unsigned G = gridDim.x * gridDim.y * gridDim.z;
    unsigned sum, cnt, mine, sp = 0u;
    for (;;) {
        sum = 0u; cnt = 0u; mine = 0u;
#pragma unroll
        for (unsigned j = 0; j < 16; ++j) { const unsigned c = xb_ld(&bar[XB_XCNT(j)]); sum += c; cnt += (c > 0u) ? 1u : 0u; mine = (j == x) ? c : mine; }
        if (sum == G) break;
        __builtin_amdgcn_s_sleep(1);
        if ((++sp & 255u) == 0u) { if (xb_ld(&bar[XB_TMO])) break; if (sp > XB_SPIN_CAP) { atomicAdd(&bar[XB_TMO], 1u); break; } }
    }
    nloc = mine > 0u ? mine : 1u; nx = cnt > 0u ? cnt : 1u;
}
__device__ __forceinline__ void xcd_barrier(const XcdBarrier& b) {
    asm volatile("s_waitcnt vmcnt(0)" ::: "memory");
    __syncthreads();
    if (threadIdx.x == 0) {
        unsigned* bar = b.bar;
        __builtin_amdgcn_s_waitcnt(0);
        unsigned nloc = b.st[0], nx = b.st[1];
        if (nloc == 0u) { xcd_barrier_complete(bar, b.x, nloc, nx); b.st[0] = nloc; b.st[1] = nx; }
        const unsigned old = xb_add(&bar[XB_XSUB(b.x)], 1u);
        const unsigned gen = old / nloc;
        if (old + 1u == (gen + 1u) * nloc) {
            __builtin_amdgcn_fence(__ATOMIC_RELEASE, "agent");
            asm volatile("s_waitcnt vmcnt(0)" ::: "memory");
            const unsigned og = xb_add(&bar[XB_TOP], 1u);
            const unsigned tg = og / nx;
            if (og + 1u == (tg + 1u) * nx) xb_add(&bar[XB_TOPGEN], 1u);
            else XB_SPIN(xb_ld(&bar[XB_TOPGEN]) == tg, bar);
            __builtin_amdgcn_fence(__ATOMIC_ACQUIRE, "agent");
            xb_add(&bar[XB_XGEN(b.x)], 1u);
            asm volatile("s_waitcnt vmcnt(0)" ::: "memory");
        } else {
            XB_SPIN(xb_ld(&bar[XB_XGEN(b.x)]) == gen, bar);
            __builtin_amdgcn_fence(__ATOMIC_ACQUIRE, "agent");
            asm volatile("s_waitcnt vmcnt(0)" ::: "memory");
        }
    }
    __syncthreads();
}

struct Args { const float* in[38]; float* out; unsigned char* ws; int ph_lo, ph_hi, li, pad; };
struct Frame {
    LAS unsigned char* lds;
    int tid, lane, wave, G, gw, NGW;
    int gt, NGT;
};
enum { I_X = 0, I_META, I_NORM_MIX0, I_WIN0, I_CONVW, I_CONVB, I_GAW, I_GAB, I_GXW, I_GXB, I_LAM, I_LRE, I_LIM, I_LDT, I_BRE, I_BIM, I_CRE, I_CIM, I_SD, I_GLUW, I_GLUB, I_WOUT0, I_NORM_FFN0,
       I_FG, I_FU, I_FD, I_NORM_MIX1, I_WIN1, I_GW2, I_GB, I_GNORM, I_WOUT1, I_NORM_FFN1, I_ROUTER, I_MG, I_MU, I_MD, I_FNORM };

struct SchedStatic {
    int nM, nN, G, c; const char* A; const char* B; size_t aStep, bStep; int aColDiv; size_t aColStep;
    __device__ __forceinline__ bool next(int i, pg8::Unit& u) const {
        int pm, pn; if (!pg8::static_tile(i, G, c, nM, nN, pm, pn)) return false;
        u.pm = pm; u.pn = pn; u.slot = i; u.a = A + (size_t)pm * aStep + (aColDiv ? (size_t)(pn / aColDiv) * aColStep : 0); u.b = B + (size_t)pn * bStep; return true;
    }
};
struct SchedList {
    int n; const LAS int* meta; const char* A; const char* B; size_t aStep, bTile, bExpert;
    __device__ __forceinline__ bool next(int i, pg8::Unit& u) const {
        if (i >= n) return false;
        const int pm = meta[i * 4 + 0], pn = meta[i * 4 + 1], e = meta[i * 4 + 2];
        u.pm = pm; u.pn = pn; u.slot = i; const int ko = meta[i * 4 + 3]; u.a = A + (size_t)pm * aStep + (size_t)ko * 2; u.b = B + (size_t)e * bExpert + (size_t)pn * bTile + (size_t)ko * 2; return true;
    }
};

#define EPI_ROWS(ai, m) ((ai) * 128 + wr * 64 + (m) * 16 + fr)
#define EPI_COLP(bj) ((bj) * 128 + wc * 32 + 8 * fq)
#define EPI_COLN(bj, n) ((bj) * 128 + wc * 32 + 16 * (n) + 4 * fq)
typedef const f32x4 (&AccRef)[2][2][4][2];
__device__ __forceinline__ void unpack8(v4u w, f32x4& a, f32x4& b) { a = (f32x4){bflo(w.x), bfhi(w.x), bflo(w.y), bfhi(w.y)}; b = (f32x4){bflo(w.z), bfhi(w.z), bflo(w.w), bfhi(w.w)}; }
__device__ __forceinline__ v4u pack8(f32x4 a, f32x4 b) { v4u w; w.x = pg8::cvt_pk_bf16(a[0], a[1]); w.y = pg8::cvt_pk_bf16(a[2], a[3]); w.z = pg8::cvt_pk_bf16(b[0], b[1]); w.w = pg8::cvt_pk_bf16(b[2], b[3]); return w; }

struct EpiWin0 {
    static constexpr bool PERM = true; bf16 *G, *XR, *U;
    __device__ __forceinline__ void operator()(AccRef acc, const pg8::Unit& u, int wr, int wc, int fr, int fq) const {
        const int pn = u.pn; bf16* base; int ld, c0;
        if (pn < 4) { base = G; ld = 1024; c0 = pn * 256; } else if (pn < 8) { base = XR; ld = 1024; c0 = (pn - 4) * 256; } else { base = U; ld = 512; c0 = (pn - 8) * 256; }
#pragma unroll
        for (int ai = 0; ai < 2; ++ai)
#pragma unroll
            for (int m = 0; m < 4; ++m) { bf16* rowp = base + (size_t)(u.pm * 256 + EPI_ROWS(ai, m)) * ld + c0;
#pragma unroll
                for (int bj = 0; bj < 2; ++bj) { f32x4 v0 = acc[ai][bj][m][0], v1 = acc[ai][bj][m][1];
                    if (pn < 4) {
#pragma unroll
                        for (int j = 0; j < 4; ++j) { v0[j] = gelu_tanh(v0[j]); v1[j] = gelu_tanh(v1[j]); } }
                    *(v4u*)(rowp + EPI_COLP(bj)) = pack8(v0, v1); } }
    }
};
struct EpiGates {
    static constexpr bool PERM = true; const float *gab, *gxb, *sp8; const bf16* XC; bf16* A; bf16* BX;
    __device__ __forceinline__ void operator()(AccRef acc, const pg8::Unit& u, int wr, int wc, int fr, int fq) const {
        const int ch0 = (u.pn >> 1) * 256 + (u.pn & 1) * 128 + wc * 32 + 8 * fq;
        f32x4 ba[2], bx[2], sp[2];
#pragma unroll
        for (int n = 0; n < 2; ++n) { ba[n] = *(const f32x4*)(gab + ch0 + 4 * n); bx[n] = *(const f32x4*)(gxb + ch0 + 4 * n); sp[n] = *(const f32x4*)(sp8 + ch0 + 4 * n); }
#pragma unroll
        for (int ai = 0; ai < 2; ++ai)
#pragma unroll
            for (int m = 0; m < 4; ++m) { const size_t ro = (size_t)(u.pm * 256 + EPI_ROWS(ai, m)) * 1024 + ch0;
                const v4u xw = *(const v4u*)(XC + ro); const float xv[8] = {bflo(xw.x), bfhi(xw.x), bflo(xw.y), bfhi(xw.y), bflo(xw.z), bfhi(xw.z), bflo(xw.w), bfhi(xw.w)};
                f32x4 av[2], bv[2];
#pragma unroll
                for (int n = 0; n < 2; ++n)
#pragma unroll
                    for (int j = 0; j < 4; ++j) { const float r = sigmoidf_(acc[ai][0][m][n][j] + ba[n][j]), ig = sigmoidf_(acc[ai][1][m][n][j] + bx[n][j]);
                        const float la = -r * sp[n][j], aa = __expf(la); av[n][j] = la; bv[n][j] = __builtin_amdgcn_sqrtf(fmaxf(__builtin_fmaf(-aa, aa, 1.0f), 0.0f)) * ig * xv[4 * n + j]; }
                *(v4u*)(A + ro) = pack8(av[0], av[1]); *(v4u*)(BX + ro) = pack8(bv[0], bv[1]); asm volatile("" ::: "memory"); }
    }
};
struct EpiGlu {
    static constexpr bool PERM = true; const float* glub; const bf16* GS; bf16* AOUT;
    __device__ __forceinline__ void operator()(AccRef acc, const pg8::Unit& u, int wr, int wc, int fr, int fq) const {
#pragma unroll
        for (int bj = 0; bj < 2; ++bj) { const int c = u.pn * 256 + EPI_COLP(bj); const f32x4 b0 = *(const f32x4*)(glub + c), b1 = *(const f32x4*)(glub + c + 4);
#pragma unroll
            for (int ai = 0; ai < 2; ++ai)
#pragma unroll
                for (int m = 0; m < 4; ++m) { const size_t row = (size_t)(u.pm * 256 + EPI_ROWS(ai, m));
                    const v4u gw = *(const v4u*)(GS + row * 512 + c); const float gv[8] = {bflo(gw.x), bfhi(gw.x), bflo(gw.y), bfhi(gw.y), bflo(gw.z), bfhi(gw.z), bflo(gw.w), bfhi(gw.w)};
                    f32x4 v0, v1;
#pragma unroll
                    for (int j = 0; j < 4; ++j) { v0[j] = gv[j] * sigmoidf_(acc[ai][bj][m][0][j] + b0[j]); v1[j] = gv[4 + j] * sigmoidf_(acc[ai][bj][m][1][j] + b1[j]); }
                    *(v4u*)(AOUT + row * 1536 + 1024 + c) = pack8(v0, v1); } }
    }
};
struct EpiResid {
    static constexpr bool PERM = true; const float* xsrc; bf16* hb;
    __device__ __forceinline__ void operator()(AccRef acc, const pg8::Unit& u, int wr, int wc, int fr, int fq) const {
#pragma unroll
        for (int ai = 0; ai < 2; ++ai)
#pragma unroll
            for (int m = 0; m < 4; ++m) { const size_t ro = (size_t)(u.pm * 256 + EPI_ROWS(ai, m)) * 1024 + u.pn * 256;
#pragma unroll
                for (int bj = 0; bj < 2; ++bj) { const size_t o = ro + EPI_COLP(bj); f32x4 v0, v1;
                    if (xsrc) { v0 = *(const f32x4*)(xsrc + o); v1 = *(const f32x4*)(xsrc + o + 4); } else unpack8(*(const v4u*)(hb + o), v0, v1);
                    *(v4u*)(hb + o) = pack8(v0 + acc[ai][bj][m][0], v1 + acc[ai][bj][m][1]); } }
    }
};
struct EpiSwiglu {
    static constexpr bool PERM = true; bf16* H; int ld;
    __device__ __forceinline__ void operator()(AccRef acc, const pg8::Unit& u, int wr, int wc, int fr, int fq) const {
        const int c = u.pn * 128 + wc * 32 + 8 * fq;
#pragma unroll
        for (int ai = 0; ai < 2; ++ai)
#pragma unroll
            for (int m = 0; m < 4; ++m) { f32x4 v0, v1;
#pragma unroll
                for (int j = 0; j < 4; ++j) { v0[j] = siluf_(acc[ai][0][m][0][j]) * acc[ai][1][m][0][j]; v1[j] = siluf_(acc[ai][0][m][1][j]) * acc[ai][1][m][1][j]; }
                *(v4u*)(H + (size_t)(u.pm * 256 + EPI_ROWS(ai, m)) * ld + c) = pack8(v0, v1); }
    }
};
struct EpiWin1 {
    static constexpr bool PERM = true; bf16 *Q, *K, *V, *GATE; float* LG; const float* gb;
    __device__ __forceinline__ void operator()(AccRef acc, const pg8::Unit& u, int wr, int wc, int fr, int fq) const {
        const int pn = u.pn;
#pragma unroll
        for (int ai = 0; ai < 2; ++ai)
#pragma unroll
            for (int m = 0; m < 4; ++m) { const size_t row = (size_t)(u.pm * 256 + EPI_ROWS(ai, m));
#pragma unroll
                for (int bj = 0; bj < 2; ++bj) { f32x4 v0 = acc[ai][bj][m][0], v1 = acc[ai][bj][m][1]; const int cc = EPI_COLP(bj);
                    if (pn < 2) { v0 = v0 * 0.08838834764831845f; v1 = v1 * 0.08838834764831845f; *(v4u*)(Q + row * 512 + pn * 256 + cc) = pack8(v0, v1); }
                    else if (pn < 4) { *(v4u*)(K + row * 512 + (pn - 2) * 256 + cc) = pack8(v0, v1); }
                    else if (pn < 8) { *(v4u*)(V + row * 1024 + (pn - 4) * 256 + cc) = pack8(v0, v1); }
                    else if (pn < 12) {
#pragma unroll
                        for (int j = 0; j < 4; ++j) { v0[j] = siluf_(v0[j]); v1[j] = siluf_(v1[j]); }
                        *(v4u*)(GATE + row * 1024 + (pn - 8) * 256 + cc) = pack8(v0, v1); }
                    else { const int c = (pn - 12) * 256 + cc; const f32x4 b0 = *(const f32x4*)(gb + c), b1 = *(const f32x4*)(gb + c + 4);
#pragma unroll
                        for (int j = 0; j < 4; ++j) { v0[j] = logsigmoidf_(v0[j] + b0[j]) * 0.0625f; v1[j] = logsigmoidf_(v1[j] + b1[j]) * 0.0625f; }
                        *(f32x4*)(LG + row * 512 + c) = v0; *(f32x4*)(LG + row * 512 + c + 4) = v1; } } }
    }
};
struct EpiMoeDown {
    static constexpr bool PERM = true; bf16* hb; const LAS int* toks; const LAS float* wts;
    __device__ __forceinline__ void operator()(AccRef acc, const pg8::Unit& u, int wr, int wc, int fr, int fq) const {
#pragma unroll
        for (int ai = 0; ai < 2; ++ai)
#pragma unroll
            for (int m = 0; m < 4; ++m) { const int rl = u.slot * 256 + EPI_ROWS(ai, m); const int tok = toks[rl]; const float w = wts[rl];
                if (tok >= 0) { bf16* d = hb + (size_t)tok * 1024 + u.pn * 256;
#pragma unroll
                    for (int bj = 0; bj < 2; ++bj) { bf16* p = d + EPI_COLP(bj); f32x4 v0, v1; unpack8(*(const v4u*)p, v0, v1); *(v4u*)p = pack8(v0 + acc[ai][bj][m][0] * w, v1 + acc[ai][bj][m][1] * w); } } }
    }
};
struct EpiSlab {
    static constexpr bool PERM = false; float* slab; const LAS int* meta;
    __device__ __forceinline__ void operator()(AccRef acc, const pg8::Unit& u, int wr, int wc, int fr, int fq) const {
        const int sl = meta[u.slot * 4 + 3] / 896; float* base = slab + ((size_t)(sl * 8 + (u.pm - 128)) * 256) * 1024 + u.pn * 256;
#pragma unroll
        for (int ai = 0; ai < 2; ++ai)
#pragma unroll
            for (int m = 0; m < 4; ++m) { float* d = base + (size_t)EPI_ROWS(ai, m) * 1024;
#pragma unroll
                for (int bj = 0; bj < 2; ++bj)
#pragma unroll
                    for (int n = 0; n < 2; ++n) *(f32x4*)(d + EPI_COLN(bj, n)) = acc[ai][bj][m][n]; }
    }
};

__device__ __forceinline__ void tr_item(const float* W, int ldw, int col, int k0, bf16* WT, int ldt, int drow, LAS float* scr, int lane) {
    float wv[32];
#pragma unroll
    for (int i = 0; i < 32; ++i) wv[i] = W[(size_t)(k0 + 2 * i + (lane >> 5)) * ldw + col + (lane & 31)];
#pragma unroll
    for (int i = 0; i < 32; ++i) scr[(2 * i + (lane >> 5)) * 33 + (lane & 31)] = wv[i];
    LDS_WAIT(); asm volatile("" ::: "memory");
    const int c = lane & 7;
#pragma unroll
    for (int j = 0; j < 4; ++j) { const int n = (lane >> 3) + 8 * j; const LAS float* s = scr + (8 * c) * 33 + n;
        v4u o; o.x = pk2(s[0 * 33], s[1 * 33]); o.y = pk2(s[2 * 33], s[3 * 33]); o.z = pk2(s[4 * 33], s[5 * 33]); o.w = pk2(s[6 * 33], s[7 * 33]);
        *(v4u*)(WT + (size_t)(drow + n) * ldt + k0 + 8 * c) = o; }
    LDS_WAIT(); asm volatile("" ::: "memory");
}
struct TrJob { const float* W; int ldw, col0, K, N; bf16* WT; int blk, bstride, add; };
__device__ __forceinline__ bool tr_try(int& r, const TrJob& j, LAS float* scr, int lane) {
    const int nblk = j.N / 32, items = (j.K / 64) * nblk;
    if (r >= items) { r -= items; return false; }
    const int kb = r / nblk, n0 = (r % nblk) * 32;
    tr_item(j.W, j.ldw, j.col0 + n0, kb * 64, j.WT, j.K, (n0 / j.blk) * j.bstride + (n0 % j.blk) + j.add, scr, lane);
    return true;
}
__device__ __forceinline__ void norm_row_bf16(const float* xrow, const float* gain, bf16* orow, int lane) {
    const f32x4* xr = (const f32x4*)xrow + lane; const f32x4* gr = (const f32x4*)gain + lane;
    f32x4 v[4]; float s = 0.f;
#pragma unroll
    for (int j = 0; j < 4; ++j) { v[j] = xr[64 * j]; s += (v[j].x * v[j].x + v[j].y * v[j].y) + (v[j].z * v[j].z + v[j].w * v[j].w); }
    const float rstd = 1.0f / sqrtf(wave_sum(s) * (1.0f / 1024.0f) + EPS);
    v2u* o8 = (v2u*)orow + lane;
#pragma unroll
    for (int j = 0; j < 4; ++j) { const f32x4 g = gr[64 * j]; v2u w; w.x = pk2(v[j].x * rstd * g.x, v[j].y * rstd * g.y); w.y = pk2(v[j].z * rstd * g.z, v[j].w * rstd * g.w); o8[64 * j] = w; }
}
__device__ __forceinline__ void norm_row_b2b(const bf16* hrow, const float* gain, bf16* orow, int lane) {
    f32x4 v[4]; unpack8(*(const v4u*)(hrow + 8 * lane), v[0], v[1]); unpack8(*(const v4u*)(hrow + 512 + 8 * lane), v[2], v[3]); float s = 0.f;
#pragma unroll
    for (int j = 0; j < 4; ++j) s += (v[j].x * v[j].x + v[j].y * v[j].y) + (v[j].z * v[j].z + v[j].w * v[j].w);
    const float rstd = 1.0f / sqrtf(wave_sum(s) * (1.0f / 1024.0f) + EPS);
    const f32x4 g0 = *(const f32x4*)(gain + 8 * lane), g1 = *(const f32x4*)(gain + 8 * lane + 4), g2 = *(const f32x4*)(gain + 512 + 8 * lane), g3 = *(const f32x4*)(gain + 512 + 8 * lane + 4);
    *(v4u*)(orow + 8 * lane) = pack8(v[0] * rstd * g0, v[1] * rstd * g1); *(v4u*)(orow + 512 + 8 * lane) = pack8(v[2] * rstd * g2, v[3] * rstd * g3);
}

__device__ __forceinline__ void p0_prologue(const Frame& F, const Args& a, unsigned char* ws) {
    LAS float* scr = (LAS float*)(F.lds + RING_OFF + F.wave * 16384);
    const float* const* in = a.in;
    constexpr int BIG = 1 << 30;
    for (int it = F.gw; ; it += F.NGW) {
        int r = it;
        { TrJob j{in[I_WIN0], EV_IN, 0, 1024, EV_IN, (bf16*)(ws + WS_WIN0), BIG, 0, 0}; if (tr_try(r, j, scr, F.lane)) continue; }
        bool done = false;
        for (int h = 0; h < 4 && !done; ++h) {
            { TrJob j{in[I_GAW] + (size_t)h * 65536, 256, 0, 256, 256, (bf16*)(ws + WS_GW) + (size_t)h * 512 * 256, 128, 256, 0}; if (tr_try(r, j, scr, F.lane)) { done = true; break; } }
            { TrJob j{in[I_GXW] + (size_t)h * 65536, 256, 0, 256, 256, (bf16*)(ws + WS_GW) + (size_t)h * 512 * 256, 128, 256, 128}; if (tr_try(r, j, scr, F.lane)) { done = true; break; } }
        }
        if (done) continue;
        { TrJob j{in[I_GLUW], 512, 0, 512, 512, (bf16*)(ws + WS_GLUW), BIG, 0, 0}; if (tr_try(r, j, scr, F.lane)) continue; }
        { TrJob j{in[I_WOUT0], 1024, 0, EV_MIX, 1024, (bf16*)(ws + WS_WOUT0), BIG, 0, 0}; if (tr_try(r, j, scr, F.lane)) continue; }
        { TrJob j{in[I_FG], FF0, 0, 1024, FF0, (bf16*)(ws + WS_WUP0), 128, 256, 0}; if (tr_try(r, j, scr, F.lane)) continue; }
        { TrJob j{in[I_FU], FF0, 0, 1024, FF0, (bf16*)(ws + WS_WUP0), 128, 256, 128}; if (tr_try(r, j, scr, F.lane)) continue; }
        { TrJob j{in[I_FD], 1024, 0, FF0, 1024, (bf16*)(ws + WS_WDN0), BIG, 0, 0}; if (tr_try(r, j, scr, F.lane)) continue; }
        { TrJob j{in[I_WIN1], OD_IN, 0, 1024, 3072, (bf16*)(ws + WS_WIN1), BIG, 0, 0}; if (tr_try(r, j, scr, F.lane)) continue; }
        { TrJob j{in[I_WOUT1], 1024, 0, 1024, 1024, (bf16*)(ws + WS_WOUT1), BIG, 0, 0}; if (tr_try(r, j, scr, F.lane)) continue; }
        break;
    }
    for (long i = F.gt; i < 512L * 1024; i += F.NGT) { const int j = (int)(i >> 10), k = (int)(i & 1023); const float* wr_ = in[I_WIN1] + (size_t)k * OD_IN + 3072; const float* w2 = in[I_GW2] + j; float s = 0.f;
#pragma unroll
        for (int r = 0; r < 16; ++r) s += wr_[r] * w2[r * 512];
        ((bf16*)(ws + WS_WIN1))[(size_t)(3072 + j) * 1024 + k] = (bf16)f2bf(s); }
    float* tab = (float*)(ws + WS_TAB);
    for (long i = F.gt; i < NG * NS; i += F.NGT) { const int g = (int)i / NS;
        const double lr = in[I_LRE][i], li = in[I_LIM][i], dt = exp((double)in[I_LDT][g]);
        const double mag = exp(dt * lr), ar = mag * cos(dt * li), ai = mag * sin(dt * li), den = lr * lr + li * li, nr = ar - 1.0;
        const double zr = (nr * lr + ai * li) / den, zi = (ai * lr - nr * li) / den;
        const double m64 = exp(64.0 * dt * lr);
        ((float*)((char*)tab + TB_AR))[i] = (float)ar; ((float*)((char*)tab + TB_AI))[i] = (float)ai;
        ((float*)((char*)tab + TB_AR64))[i] = (float)(m64 * cos(64.0 * dt * li)); ((float*)((char*)tab + TB_AI64))[i] = (float)(m64 * sin(64.0 * dt * li));
        for (int h = 0; h < 16; ++h) { const double br = in[I_BRE][i * 16 + h], bi = in[I_BIM][i * 16 + h];
            ((float*)((char*)tab + TB_BBR))[i * 16 + h] = (float)(zr * br - zi * bi); ((float*)((char*)tab + TB_BBI))[i * 16 + h] = (float)(zr * bi + zi * br); } }
    for (long idx = F.gt; idx < (long)NG * NS * 64; idx += F.NGT) { const int i = (int)(idx & 63), gn = (int)(idx >> 6), g = gn / NS, n = gn % NS;
        const double lr = in[I_LRE][gn], li = in[I_LIM][gn], dt = exp((double)in[I_LDT][g]);
        const double mag1 = exp(dt * lr), ar1 = mag1 * cos(dt * li), ai1 = mag1 * sin(dt * li), den = lr * lr + li * li, nr1 = ar1 - 1.0;
        const double zr = (nr1 * lr + ai1 * li) / den, zi = (ai1 * lr - nr1 * li) / den;
        const double pw = (double)(63 - i), pm = exp(pw * dt * lr), pr = pm * cos(pw * dt * li), pi_ = pm * sin(pw * dt * li);
        bf16* wre = (bf16*)(ws + WS_WE) + ((size_t)g * 128 + 2 * n) * 1024 + i * 16; bf16* wim = wre + 1024;
        for (int h = 0; h < 16; ++h) { const double br = in[I_BRE][(size_t)gn * 16 + h], bi = in[I_BIM][(size_t)gn * 16 + h]; const double bbr = zr * br - zi * bi, bbi = zr * bi + zi * br;
            wre[h] = (bf16)f2bf((float)(pr * bbr - pi_ * bbi)); wim[h] = (bf16)f2bf((float)(pr * bbi + pi_ * bbr)); } }
    for (long i = F.gt; i < 1024; i += F.NGT) { const float lam = in[I_LAM][i]; ((float*)((char*)tab + TB_SP8))[i] = 8.0f * log1pf(expf(-lam)); }
    bf16* HN = (bf16*)(ws + WS_HN); float* hmeta = (float*)(ws + WS_HMETA);
    { const float* gain0 = in[I_NORM_MIX0]; const int lane = F.lane; f32x4 gg[4];
#pragma unroll
      for (int j = 0; j < 4; ++j) gg[j] = ((const f32x4*)gain0)[lane + 64 * j];
      for (int m = F.gw; m < TR; m += 4 * F.NGW) { f32x4 xv[4][4];
#pragma unroll
        for (int q = 0; q < 4; ++q) { const int mm = m + q * F.NGW; if (mm < TR) {
#pragma unroll
            for (int j = 0; j < 4; ++j) xv[q][j] = ((const f32x4*)(in[I_X] + (size_t)mm * 1024))[lane + 64 * j]; } }
#pragma unroll
        for (int q = 0; q < 4; ++q) { const int mm = m + q * F.NGW; if (mm < TR) { float sq = 0.f;
#pragma unroll
            for (int j = 0; j < 4; ++j) sq += (xv[q][j].x * xv[q][j].x + xv[q][j].y * xv[q][j].y) + (xv[q][j].z * xv[q][j].z + xv[q][j].w * xv[q][j].w);
            const float rstd = 1.0f / sqrtf(wave_sum(sq) * (1.0f / 1024.0f) + EPS); v2u* o8 = (v2u*)(HN + (size_t)mm * 1024) + lane;
#pragma unroll
            for (int j = 0; j < 4; ++j) { const f32x4 y = xv[q][j] * rstd * gg[j]; o8[64 * j] = (v2u){pk2(y.x, y.y), pk2(y.z, y.w)}; } } } }
      for (int m = TR + F.gw; m < TR + NMETA; m += F.NGW) norm_row_bf16(in[I_META] + (size_t)(m - TR) * 1024, gain0, HN + (size_t)m * 1024, lane); }
    for (long i = F.gt; i < NMETA * 1024; i += F.NGT) hmeta[i] = in[I_META][i];
}
__device__ __forceinline__ void norm_phase(const Frame& F, const bf16* HB, const float* hmeta, const float* gain, bf16* HN, int nrows) {
    const int lane = F.lane; const f32x4 g0 = *(const f32x4*)(gain + 8 * lane), g1 = *(const f32x4*)(gain + 8 * lane + 4), g2 = *(const f32x4*)(gain + 512 + 8 * lane), g3 = *(const f32x4*)(gain + 512 + 8 * lane + 4);
    for (int m = F.gw; m < TR; m += 4 * F.NGW) { v4u xa[4], xb[4];
#pragma unroll
        for (int q = 0; q < 4; ++q) { const int mm = m + q * F.NGW; if (mm < TR) { xa[q] = *(const v4u*)(HB + (size_t)mm * 1024 + 8 * lane); xb[q] = *(const v4u*)(HB + (size_t)mm * 1024 + 512 + 8 * lane); } }
#pragma unroll
        for (int q = 0; q < 4; ++q) { const int mm = m + q * F.NGW; if (mm < TR) { f32x4 v[4]; unpack8(xa[q], v[0], v[1]); unpack8(xb[q], v[2], v[3]); float sq = 0.f;
#pragma unroll
            for (int j = 0; j < 4; ++j) sq += (v[j].x * v[j].x + v[j].y * v[j].y) + (v[j].z * v[j].z + v[j].w * v[j].w);
            const float rstd = 1.0f / sqrtf(wave_sum(sq) * (1.0f / 1024.0f) + EPS);
            *(v4u*)(HN + (size_t)mm * 1024 + 8 * lane) = pack8(v[0] * rstd * g0, v[1] * rstd * g1); *(v4u*)(HN + (size_t)mm * 1024 + 512 + 8 * lane) = pack8(v[2] * rstd * g2, v[3] * rstd * g3); } } }
    for (int m = TR + F.gw; m < nrows; m += F.NGW) norm_row_bf16(hmeta + (size_t)(m - TR) * 1024, gain, HN + (size_t)m * 1024, F.lane);
}
__device__ __forceinline__ int seq_prev(int row, int back) {
    if (row >= TR) { const int i = row - TR - back; return i >= 0 ? TR + i : -1; }
    const int t = row & (SEQ - 1); return t >= back ? row - back : TR + NMETA + (t - back);
}
__device__ __forceinline__ void conv_phase(const Frame& F, const bf16* XR, const float* cw, const float* cb, bf16* XC) {
    for (long i = F.gt; i < (long)(TR / 32 + 1) * 128; i += F.NGT) { const int c = (int)(i & 127) * 8, st = (int)(i >> 7); const bool meta = st >= TR / 32; const int r0 = meta ? RM0 : st * 32, nr = meta ? NMETA : 32;
        f32x4 w[4][2]; f32x4 b0 = *(const f32x4*)(cb + c), b1 = *(const f32x4*)(cb + c + 4);
#pragma unroll
        for (int k = 0; k < 4; ++k) { w[k][0] = *(const f32x4*)(cw + k * 1024 + c); w[k][1] = *(const f32x4*)(cw + k * 1024 + c + 4); }
        f32x4 h[3][2];
#pragma unroll
        for (int k = 0; k < 3; ++k) { const int src = seq_prev(r0, 3 - k); if (src >= 0) unpack8(*(const v4u*)(XR + (size_t)src * 1024 + c), h[k][0], h[k][1]); else { h[k][0] = (f32x4){0.f, 0.f, 0.f, 0.f}; h[k][1] = h[k][0]; } }
        for (int t0 = 0; t0 < nr; t0 += 8) { v4u x[8];
#pragma unroll
            for (int t = 0; t < 8; ++t) x[t] = *(const v4u*)(XR + (size_t)(r0 + t0 + t) * 1024 + c);
#pragma unroll
            for (int t = 0; t < 8; ++t) { f32x4 c0, c1; unpack8(x[t], c0, c1);
                const f32x4 o0 = b0 + w[0][0] * h[0][0] + w[1][0] * h[1][0] + w[2][0] * h[2][0] + w[3][0] * c0, o1 = b1 + w[0][1] * h[0][1] + w[1][1] * h[1][1] + w[2][1] * h[2][1] + w[3][1] * c1;
                *(v4u*)(XC + (size_t)(r0 + t0 + t) * 1024 + c) = pack8(o0, o1);
                h[0][0] = h[1][0]; h[0][1] = h[1][1]; h[1][0] = h[2][0]; h[1][1] = h[2][1]; h[2][0] = c0; h[2][1] = c1; } } }
}
constexpr int SSM_HP = 68, SSM_XP = 132;
constexpr int SSM_WLDS = 16 * SSM_XP * 4 + 16 * SSM_HP * 4;
struct SsmTab { float ar, ai; bf16x8 axf[8]; bf16x8 ca[4]; f32x4 dv; };
__device__ __forceinline__ void ssm_tab_load(SsmTab& T, const unsigned char* ws, const float* cre, const float* cim, const float* sd, int g, int lane) {
    const float* tab = (const float*)(ws + WS_TAB); const int gn = g * NS + lane, fr = lane & 15, fq = lane >> 4;
    T.ar = ((const float*)((const char*)tab + TB_AR))[gn]; T.ai = ((const float*)((const char*)tab + TB_AI))[gn];
#pragma unroll
    for (int rb = 0; rb < 8; ++rb) { const int r = 16 * rb + fr, n = r >> 1; const float* src = (const float*)((const char*)tab + ((r & 1) ? TB_BBI : TB_BBR)) + (size_t)(g * NS + n) * 16 + 8 * (fq & 1);
        v4u w = pack8(*(const f32x4*)src, *(const f32x4*)(src + 4)); if (fq >= 2) w = (v4u){0u, 0u, 0u, 0u}; T.axf[rb] = __builtin_bit_cast(bf16x8, w); }
#pragma unroll
    for (int ks = 0; ks < 4; ++ks) { const int n0 = 16 * ks + 4 * fq; const f32x4 cr = *(const f32x4*)(cre + (g * 16 + fr) * NS + n0), ci = *(const f32x4*)(cim + (g * 16 + fr) * NS + n0);
        v4u w; w.x = pk2(cr[0], -ci[0]); w.y = pk2(cr[1], -ci[1]); w.z = pk2(cr[2], -ci[2]); w.w = pk2(cr[3], -ci[3]); T.ca[ks] = __builtin_bit_cast(bf16x8, w); }
    T.dv = *(const f32x4*)(sd + g * 16 + 4 * fq);
}
__device__ __forceinline__ void ssm_wave(const SsmTab& T, const bf16* U, bf16* GS, int g, int row0, int ntok, float& hr, float& hi, int lane, LAS unsigned char* wl) {
    LAS float* xb = (LAS float*)wl; LAS unsigned* hb = (LAS unsigned*)(wl + 16 * SSM_XP * 4);
    const int fr = lane & 15, fq = lane >> 4; const float ar = T.ar, ai = T.ai;
    const f32x4 dv = T.dv;
    const bf16* ubase = U + (size_t)(row0 + fr) * 512 + g * 16;
    v4u bnx = {0u, 0u, 0u, 0u}; if (fq < 2) bnx = *(const v4u*)(ubase + 8 * fq);
    v2u unx = *(const v2u*)(ubase + 4 * fq);
    for (int t0 = 0; t0 < ntok; t0 += 16) {
        const v4u bw = bnx; const v2u uw = unx;
        if (t0 + 16 < ntok) { const bf16* un = ubase + (size_t)(t0 + 16) * 512; if (fq < 2) bnx = *(const v4u*)(un + 8 * fq); unx = *(const v2u*)(un + 4 * fq); }
        const bf16x8 bfr = __builtin_bit_cast(bf16x8, bw);
#pragma unroll
        for (int rb = 0; rb < 8; ++rb) { const f32x4 xa = __builtin_amdgcn_mfma_f32_16x16x32_bf16(T.axf[rb], bfr, (f32x4){0.f, 0.f, 0.f, 0.f}, 0, 0, 0); *(LAS f32x4*)(xb + fr * SSM_XP + 16 * rb + 4 * fq) = xa; }
        asm volatile("" ::: "memory");
#pragma unroll 4
        for (int tl = 0; tl < 16; ++tl) { const f32x2 x = *(const LAS f32x2*)(xb + tl * SSM_XP + 2 * lane);
            const float nr = ar * hr - ai * hi + x.x, ni = ar * hi + ai * hr + x.y; hr = nr; hi = ni;
            hb[tl * SSM_HP + lane] = pg8::cvt_pk_bf16(hr, hi); }
        asm volatile("" ::: "memory");
        f32x4 y = {0.f, 0.f, 0.f, 0.f};
#pragma unroll
        for (int ks = 0; ks < 4; ++ks) { const bf16x8 hbf = *(const LAS bf16x8*)(hb + fr * SSM_HP + 16 * ks + 4 * fq); y = __builtin_amdgcn_mfma_f32_16x16x32_bf16(T.ca[ks], hbf, y, 0, 0, 0); }
        const float o0 = gelu_tanh(y[0] + dv[0] * bflo(uw.x)), o1 = gelu_tanh(y[1] + dv[1] * bfhi(uw.x)), o2 = gelu_tanh(y[2] + dv[2] * bflo(uw.y)), o3 = gelu_tanh(y[3] + dv[3] * bfhi(uw.y));
        *(v2u*)(GS + (size_t)(row0 + t0 + fr) * 512 + g * 16 + 4 * fq) = (v2u){pk2(o0, o1), pk2(o2, o3)};
        asm volatile("" ::: "memory");
    }
    LDS_WAIT(); asm volatile("" ::: "memory");
}
__device__ __forceinline__ void ssm_l1_phase(const Frame& F, const unsigned char* ws, const bf16* U, float* SSE) {
    const int lane = F.lane, fr = lane & 15, fq = lane >> 4;
    for (int it = F.gw; it < NG * 32; it += F.NGW) { const int g = it >> 5, cb = it & 31, bc = cb * 16 + fr;
        const bf16* ap = (const bf16*)(ws + WS_WE) + ((size_t)g * 128 + fr) * 1024 + 8 * fq;
        const bf16* bp = U + ((size_t)bc * 64 + (fq >> 1)) * 512 + g * 16 + 8 * (fq & 1);
        f32x4 acc[8];
#pragma unroll
        for (int rb = 0; rb < 8; ++rb) acc[rb] = (f32x4){0.f, 0.f, 0.f, 0.f};
#pragma unroll 2
        for (int ks = 0; ks < 32; ++ks) { const bf16x8 bfr = *(const bf16x8*)(bp + (size_t)ks * 2 * 512);
#pragma unroll
            for (int rb = 0; rb < 8; ++rb) { const bf16x8 afr = *(const bf16x8*)(ap + (size_t)rb * 16 * 1024 + ks * 32); acc[rb] = __builtin_amdgcn_mfma_f32_16x16x32_bf16(afr, bfr, acc[rb], 0, 0, 0); } }
#pragma unroll
        for (int rb = 0; rb < 8; ++rb) *(f32x4*)(SSE + (((size_t)bc * NG + g) * NS + 8 * rb + 2 * fq) * 2) = acc[rb]; }
}
__device__ __forceinline__ void lru_l1_phase(const Frame& F, const bf16* A, const bf16* BX, float* PEND, float* HEND) {
    for (long i = F.gt; i < (long)NB * NCH * 128; i += F.NGT) { const int ch = (int)(i & 127) * 8, bc = (int)(i >> 7); const size_t r0 = (size_t)bc * 64;
        f32x4 P0 = {0.f, 0.f, 0.f, 0.f}, P1 = P0, H0 = P0, H1 = P0;
        for (int t0 = 0; t0 < 64; t0 += 8) { v4u la[8], bx[8];
#pragma unroll
            for (int t = 0; t < 8; ++t) { la[t] = *(const v4u*)(A + (r0 + t0 + t) * 1024 + ch); bx[t] = *(const v4u*)(BX + (r0 + t0 + t) * 1024 + ch); }
#pragma unroll
            for (int t = 0; t < 8; ++t) { f32x4 l0, l1, b0, b1; unpack8(la[t], l0, l1); unpack8(bx[t], b0, b1); P0 += l0; P1 += l1;
#pragma unroll
                for (int j = 0; j < 4; ++j) { H0[j] = __expf(l0[j]) * H0[j] + b0[j]; H1[j] = __expf(l1[j]) * H1[j] + b1[j]; } } }
#pragma unroll
        for (int j = 0; j < 4; ++j) { P0[j] = __expf(P0[j]); P1[j] = __expf(P1[j]); }
        float* pp = PEND + (size_t)bc * 1024 + ch; float* hp = HEND + (size_t)bc * 1024 + ch; *(f32x4*)pp = P0; *(f32x4*)(pp + 4) = P1; *(f32x4*)hp = H0; *(f32x4*)(hp + 4) = H1; }
}
__device__ __forceinline__ void carry_phase(const Frame& F, const unsigned char* ws, const bf16* A, const bf16* BX, const float* PEND, const float* HEND, float* CIN, const bf16* U, const float* SSE, float* SSIN) {
    if (F.gt < NB * 1024) { const int ch = (int)F.gt & 1023, b = (int)F.gt >> 10; float H = 0.f;
        for (int i = 0; i < NMETA; ++i) { const size_t r = (size_t)(RM0 + i); H = __expf(bf2f(A[r * 1024 + ch])) * H + bf2f(BX[r * 1024 + ch]); }
        for (int c0 = 0; c0 < NCH; c0 += 32) { float pp[32], hh[32];
#pragma unroll
            for (int c = 0; c < 32; ++c) { const size_t o = ((size_t)b * NCH + c0 + c) * 1024 + ch; pp[c] = PEND[o]; hh[c] = HEND[o]; }
#pragma unroll
            for (int c = 0; c < 32; ++c) { const size_t o = ((size_t)b * NCH + c0 + c) * 1024 + ch; CIN[o] = H; H = hh[c] + pp[c] * H; } }
    } else if (F.gt >= 8 * 512 && F.gt < 8 * 512 + NB * NG * NS) { const int id = (int)F.gt - 8 * 512, n = id % NS, g = (id / NS) % NG, b = id / (NS * NG), gn = g * NS + n;
        const float* tab = (const float*)(ws + WS_TAB);
        const float ar = ((const float*)((const char*)tab + TB_AR))[gn], ai = ((const float*)((const char*)tab + TB_AI))[gn], ar64 = ((const float*)((const char*)tab + TB_AR64))[gn], ai64 = ((const float*)((const char*)tab + TB_AI64))[gn];
        float hr = 0.f, hi = 0.f;
        for (int i = 0; i < NMETA; ++i) { float xr = 0.f, xi = 0.f;
            for (int h = 0; h < 16; ++h) { const float u = bf2f(U[(size_t)(RM0 + i) * 512 + g * 16 + h]); xr += ((const float*)((const char*)tab + TB_BBR))[gn * 16 + h] * u; xi += ((const float*)((const char*)tab + TB_BBI))[gn * 16 + h] * u; }
            const float nr = ar * hr - ai * hi + xr, ni = ar * hi + ai * hr + xi; hr = nr; hi = ni; }
        for (int c0 = 0; c0 < NCH; c0 += 32) { f32x2 ee[32];
#pragma unroll
            for (int c = 0; c < 32; ++c) ee[c] = ((const f32x2*)SSE)[(((size_t)b * NCH + c0 + c) * NG + g) * NS + n];
#pragma unroll
            for (int c = 0; c < 32; ++c) { ((f32x2*)SSIN)[(((size_t)b * NCH + c0 + c) * NG + g) * NS + n] = (f32x2){hr, hi};
                const float nr = ar64 * hr - ai64 * hi + ee[c].x, ni = ar64 * hi + ai64 * hr + ee[c].y; hr = nr; hi = ni; } }
    }
}
__device__ __forceinline__ void mix0_final_phase(const Frame& F, const unsigned char* ws, const bf16* A, const bf16* BX, const float* CIN, const bf16* G, bf16* AOUT, const float* cre, const float* cim, const float* sd, const bf16* U, const float* SSIN, bf16* GS) {
    for (int pass = 0; pass < 2; ++pass) {
      if ((pass ^ (F.wave & 1)) == 0) {
    for (long i = F.gt; i < (long)NB * NCH * 128 + 128; i += F.NGT) { const int ch = (int)(i & 127) * 8, bc = (int)(i >> 7); const bool meta = bc >= NB * NCH;
        const size_t r0 = meta ? (size_t)RM0 : (size_t)bc * 64; const int nt = meta ? NMETA : 64; f32x4 H0 = {0.f, 0.f, 0.f, 0.f}, H1 = H0;
        if (!meta) { H0 = *(const f32x4*)(CIN + (size_t)bc * 1024 + ch); H1 = *(const f32x4*)(CIN + (size_t)bc * 1024 + ch + 4); }
        for (int t0 = 0; t0 < nt; t0 += 8) { v4u la[8], bx[8], gg[8];
#pragma unroll
            for (int t = 0; t < 8; ++t) { const size_t r = r0 + t0 + t; la[t] = *(const v4u*)(A + r * 1024 + ch); bx[t] = *(const v4u*)(BX + r * 1024 + ch); gg[t] = *(const v4u*)(G + r * 1024 + ch); }
#pragma unroll
            for (int t = 0; t < 8; ++t) { f32x4 l0, l1, b0, b1, g0, g1; unpack8(la[t], l0, l1); unpack8(bx[t], b0, b1); unpack8(gg[t], g0, g1);
#pragma unroll
                for (int j = 0; j < 4; ++j) { H0[j] = __expf(l0[j]) * H0[j] + b0[j]; H1[j] = __expf(l1[j]) * H1[j] + b1[j]; }
                *(v4u*)(AOUT + (r0 + t0 + t) * 1536 + ch) = pack8(g0 * H0, g1 * H1); } } }
      } else {
    { SsmTab T; int gcur = -1;
    for (int it = F.gw; it < NB * NCH * NG + NG; it += F.NGW) { const bool meta = it >= NB * NCH * NG; const int g = it % NG, bc = it / NG;
        if (g != gcur) { ssm_tab_load(T, ws, cre, cim, sd, g, F.lane); gcur = g; }
        float hr = 0.f, hi = 0.f; if (!meta) { const f32x2 s = ((const f32x2*)SSIN)[(size_t)it * NS + F.lane]; hr = s.x; hi = s.y; }
        ssm_wave(T, U, GS, g, meta ? RM0 : bc * 64, meta ? NMETA : 64, hr, hi, F.lane, F.lds + RING_OFF + F.wave * SSM_WLDS); } }
      }
    }
}
template <int NACC>
__device__ __forceinline__ void meta_tile(const Frame& F, const bf16* A16, int lda, int K, const bf16* const (&Brow)[NACC], int ldb, f32x4 (&out)[NACC]) {
    LAS f32x4* red = (LAS f32x4*)(F.lds + RING_OFF);
    const int lane = F.lane, fr = lane & 15, fq = lane >> 4, w = F.wave, ks = K / 8;
    f32x4 acc[NACC];
#pragma unroll
    for (int a = 0; a < NACC; ++a) acc[a] = (f32x4){0.f, 0.f, 0.f, 0.f};
    for (int k0 = w * ks; k0 < (w + 1) * ks; k0 += 32) {
        const bf16x8 af = *(const bf16x8*)(A16 + (size_t)fr * lda + k0 + 8 * fq);
#pragma unroll
        for (int a = 0; a < NACC; ++a) { const bf16x8 bfz = *(const bf16x8*)(Brow[a] + (size_t)fr * ldb + k0 + 8 * fq); acc[a] = __builtin_amdgcn_mfma_f32_16x16x32_bf16(bfz, af, acc[a], 0, 0, 0); } }
    __syncthreads();
#pragma unroll
    for (int a = 0; a < NACC; ++a) red[(w * NACC + a) * 64 + lane] = acc[a];
    __syncthreads();
#pragma unroll
    for (int a = 0; a < NACC; ++a) { f32x4 sacc = red[a * 64 + lane];
#pragma unroll
        for (int ww = 1; ww < 8; ++ww) sacc += red[(ww * NACC + a) * 64 + lane];
        out[a] = sacc; }
}
template <class Fn> __device__ __forceinline__ bf16x8 frag8(Fn f) { bf16x8 r;
#pragma unroll
    for (int j = 0; j < 8; ++j) r[j] = (short)f(j);
    return r; }
constexpr int GL_LB = 0, GL_QT = 32768, GL_KT = 50176, GL_KH = 67584, GL_VT = 86016, GL_GM = 120832, GL_BL = 121344, GL_SSQ = 121856;
constexpr int PQ = 136, PKH = 144, PV = 272, PATT = 72, POT = 264;
#define TR_FRAG(dst, base, off, rows4) do { v2u _lo, _hi; \
    asm volatile("ds_read_b64_tr_b16 %0, %2 offset:%c3\n\tds_read_b64_tr_b16 %1, %2 offset:%c4\n\ts_waitcnt lgkmcnt(0)" : "=&v"(_lo), "=&v"(_hi) : "v"(base), "i"(off), "i"((off) + (rows4)) : "memory"); \
    const v4u _w = {_lo.x, _lo.y, _hi.x, _hi.y}; dst = __builtin_bit_cast(bf16x8, _w); } while (0)
__device__ __forceinline__ unsigned lds_addr(const LAS void* p) { return (unsigned)(unsigned long)p; }
template <bool FINAL>
__device__ __forceinline__ void gla_item(const Frame& F, int b, int h, int s, const bf16* Q, const bf16* K, const bf16* V, const bf16* GATE, const float* LG, const float* gnorm, float* GDS, float* GAM, bf16* AOUT2) {
    LAS float* LB = (LAS float*)(F.lds + GL_LB); LAS bf16* ATT = (LAS bf16*)(F.lds + GL_LB);
    LAS bf16* QT = (LAS bf16*)(F.lds + GL_QT); LAS bf16* KT = (LAS bf16*)(F.lds + GL_KT); LAS bf16* KH = (LAS bf16*)(F.lds + GL_KH); LAS bf16* VT = (LAS bf16*)(F.lds + GL_VT);
    LAS float* GM = (LAS float*)(F.lds + GL_GM); LAS float* BL = (LAS float*)(F.lds + GL_BL); LAS float* SSQ = (LAS float*)(F.lds + GL_SSQ);
    const int tid = F.tid, w = F.wave, lane = F.lane, fr = lane & 15, h4 = lane >> 4, tq = fr >> 2, tp = fr & 3;
    const int bh = b * GH + h; const size_t sbase = ((size_t)(bh * NSEG + s) * 128) * 256;
    const unsigned vtr = lds_addr(VT) + (unsigned)((8 * h4 + tq) * PV + 32 * w + 4 * tp) * 2u;
    const unsigned ktr = lds_addr(KH) + (unsigned)((8 * h4 + tq) * PKH + 4 * tp) * 2u;
    f32x4 S[8][2];
#pragma unroll
    for (int kb = 0; kb < 8; ++kb)
#pragma unroll
        for (int vb = 0; vb < 2; ++vb)
#pragma unroll
            for (int r = 0; r < 4; ++r) S[kb][vb][r] = FINAL ? GDS[sbase + (size_t)(16 * kb + 4 * h4 + r) * 256 + 32 * w + 16 * vb + fr] : 0.f;
    float gsum = 0.f;
#pragma nounroll
    for (int c = 0; c < SEGC; ++c) {
        const size_t row0 = (size_t)b * SEQ + (size_t)(s * SEGC + c) * 64;
        int lz = 0; asm volatile("" : "+v"(lz));
        const int tidl = tid + lz, frl = fr + lz, h4l = h4 + lz;
#pragma unroll
        for (int j = 0; j < 4; ++j) { const int i = tidl + 512 * j, t = i >> 5, k4 = (i & 31) * 4; *(LAS f32x4*)(LB + t * 128 + k4) = *(const f32x4*)(LG + (row0 + t) * 512 + h * 128 + k4); }
        v4u kwr[2];
#pragma unroll
        for (int j = 0; j < 2; ++j) { const int i = tidl + 512 * j, t = i >> 4, k8 = (i & 15) * 8; const size_t go = (row0 + t) * 512 + h * 128 + k8; if (!FINAL) kwr[j] = *(const v4u*)(K + go); }
#pragma unroll
        for (int j = 0; j < 4; ++j) { const int i = tidl + 512 * j, t = i >> 5, c8 = (i & 31) * 8; *(LAS v4u*)(VT + t * PV + c8) = *(const v4u*)(V + (row0 + t) * 1024 + h * 256 + c8); }
        __syncthreads();
        if (tid < 128) { float run = 0.f;
#pragma unroll 8
            for (int t = 0; t < 64; ++t) { run += LB[t * 128 + tid]; LB[t * 128 + tid] = run; }
            BL[tid] = run; GM[tid] = __expf(run); gsum += run; }
        __syncthreads();
#pragma unroll
        for (int j = 0; j < 2; ++j) { const int i = tidl + 512 * j, t = i >> 4, k8 = (i & 15) * 8; const size_t go = (row0 + t) * 512 + h * 128 + k8;
            const v4u kw = FINAL ? *(const v4u*)(K + go) : kwr[j]; const float kv[8] = {bflo(kw.x), bfhi(kw.x), bflo(kw.y), bfhi(kw.y), bflo(kw.z), bfhi(kw.z), bflo(kw.w), bfhi(kw.w)};
            float bb[8], kh[8];
#pragma unroll
            for (int e = 0; e < 8; ++e) { bb[e] = LB[t * 128 + k8 + e]; kh[e] = kv[e] * __expf(BL[k8 + e] - bb[e]); }
            v4u o; o.x = pk2(kh[0], kh[1]); o.y = pk2(kh[2], kh[3]); o.z = pk2(kh[4], kh[5]); o.w = pk2(kh[6], kh[7]); *(LAS v4u*)(KH + t * PKH + k8) = o;
            if (FINAL) { const v4u qw = *(const v4u*)(Q + go); const float qv[8] = {bflo(qw.x), bfhi(qw.x), bflo(qw.y), bfhi(qw.y), bflo(qw.z), bfhi(qw.z), bflo(qw.w), bfhi(qw.w)};
                float qt[8], kt[8];
#pragma unroll
                for (int e = 0; e < 8; ++e) { qt[e] = qv[e] * __expf(bb[e]); kt[e] = kv[e] * __expf(-bb[e]); }
                v4u oq; oq.x = pk2(qt[0], qt[1]); oq.y = pk2(qt[2], qt[3]); oq.z = pk2(qt[4], qt[5]); oq.w = pk2(qt[6], qt[7]); *(LAS v4u*)(QT + t * PQ + k8) = oq;
                v4u ok; ok.x = pk2(kt[0], kt[1]); ok.y = pk2(kt[2], kt[3]); ok.z = pk2(kt[4], kt[5]); ok.w = pk2(kt[6], kt[7]); *(LAS v4u*)(KT + t * PQ + k8) = ok; } }
        __syncthreads();
        f32x4 o[4][2];
        if (FINAL) {
            { const int tb = w >> 1;
#pragma unroll
              for (int q = 0; q < 2; ++q) { const int sb = 2 * (w & 1) + q; f32x4 acc = {0.f, 0.f, 0.f, 0.f};
                if (sb <= tb) {
#pragma unroll
                    for (int ks = 0; ks < 4; ++ks) { const bf16x8 a = *(const LAS bf16x8*)(QT + (16 * tb + fr) * PQ + 32 * ks + 8 * h4), bq = *(const LAS bf16x8*)(KT + (16 * sb + fr) * PQ + 32 * ks + 8 * h4);
                        acc = __builtin_amdgcn_mfma_f32_16x16x32_bf16(a, bq, acc, 0, 0, 0); } }
#pragma unroll
                for (int r = 0; r < 4; ++r) { const int tl = 4 * h4 + r; const float val = (sb < tb || (sb == tb && fr <= tl)) ? acc[r] : 0.f; ATT[(16 * tb + tl) * PATT + 16 * sb + fr] = (bf16)f2bf(val); } } }
            __syncthreads();
#pragma unroll
            for (int tb = 0; tb < 4; ++tb)
#pragma unroll
                for (int vb = 0; vb < 2; ++vb) o[tb][vb] = (f32x4){0.f, 0.f, 0.f, 0.f};
#pragma unroll
            for (int ss = 0; ss < 2; ++ss) { bf16x8 bv[2];
#pragma unroll
                for (int vb = 0; vb < 2; ++vb) TR_FRAG(bv[vb], vtr, (32 * ss * PV + 16 * vb) * 2, 4 * PV * 2);
#pragma unroll
                for (int tb = 0; tb < 4; ++tb) { if (ss == 1 && tb < 2) continue;
                    const bf16x8 a = *(const LAS bf16x8*)(ATT + (16 * tb + fr) * PATT + 32 * ss + 8 * h4);
#pragma unroll
                    for (int vb = 0; vb < 2; ++vb) o[tb][vb] = __builtin_amdgcn_mfma_f32_16x16x32_bf16(a, bv[vb], o[tb][vb], 0, 0, 0); } }
#pragma unroll
            for (int i = 0; i < 4; ++i) { bf16x8 bs[2];
#pragma unroll
                for (int vb = 0; vb < 2; ++vb) { v4u wv; wv.x = pk2(S[2 * i][vb][0], S[2 * i][vb][1]); wv.y = pk2(S[2 * i][vb][2], S[2 * i][vb][3]); wv.z = pk2(S[2 * i + 1][vb][0], S[2 * i + 1][vb][1]); wv.w = pk2(S[2 * i + 1][vb][2], S[2 * i + 1][vb][3]); bs[vb] = __builtin_bit_cast(bf16x8, wv); }
#pragma unroll
                for (int tb = 0; tb < 4; ++tb) { const LAS bf16* qp = QT + (16 * tb + fr) * PQ + 32 * i + 4 * h4; const v2u a_lo = *(const LAS v2u*)qp, a_hi = *(const LAS v2u*)(qp + 16);
                    const v4u aw = {a_lo.x, a_lo.y, a_hi.x, a_hi.y}; const bf16x8 a = __builtin_bit_cast(bf16x8, aw);
#pragma unroll
                    for (int vb = 0; vb < 2; ++vb) o[tb][vb] = __builtin_amdgcn_mfma_f32_16x16x32_bf16(a, bs[vb], o[tb][vb], 0, 0, 0); } }
        }
        if (FINAL) {
#pragma unroll
            for (int tb = 0; tb < 4; ++tb)
#pragma unroll
                for (int r = 0; r < 4; ++r) { float q = o[tb][0][r] * o[tb][0][r] + o[tb][1][r] * o[tb][1][r];
                    q += __shfl_xor(q, 1); q += __shfl_xor(q, 2); q += __shfl_xor(q, 4); q += __shfl_xor(q, 8);
                    if (fr == 0) SSQ[w * 64 + 16 * tb + 4 * h4 + r] = q; }
            __syncthreads();
            { LAS bf16* OT = QT; const float gn0 = gnorm[h * 256 + 32 * w + frl], gn1 = gnorm[h * 256 + 32 * w + 16 + frl];
#pragma unroll
              for (int tb = 0; tb < 4; ++tb)
#pragma unroll
                for (int r = 0; r < 4; ++r) { const int t = 16 * tb + 4 * h4 + r; float tot = 0.f;
#pragma unroll
                    for (int ww = 0; ww < 8; ++ww) tot += SSQ[ww * 64 + t];
                    const float rstd = __builtin_amdgcn_rsqf(tot * (1.0f / 256.0f) + EPS);
                    OT[t * POT + 32 * w + fr] = (bf16)f2bf(o[tb][0][r] * rstd * gn0); OT[t * POT + 32 * w + 16 + fr] = (bf16)f2bf(o[tb][1][r] * rstd * gn1); asm volatile("" ::: "memory"); }
              __syncthreads();
#pragma unroll 2
              for (int j = 0; j < 4; ++j) { const int i = tidl + 512 * j, t = i >> 5, c8 = (i & 31) * 8; const size_t go = (row0 + t) * 1024 + h * 256 + c8;
                  f32x4 a0, a1, g0, g1; unpack8(*(const LAS v4u*)(OT + t * POT + c8), a0, a1); unpack8(*(const v4u*)(GATE + go), g0, g1); *(v4u*)(AOUT2 + go) = pack8(a0 * g0, a1 * g1); } }
        }
#pragma unroll
        for (int kb = 0; kb < 8; ++kb) { const f32x4 gm = *(const LAS f32x4*)(GM + 16 * kb + 4 * h4);
#pragma unroll
            for (int vb = 0; vb < 2; ++vb) S[kb][vb] = S[kb][vb] * gm; }
#pragma unroll
        for (int ts = 0; ts < 2; ++ts) { bf16x8 bv[2];
#pragma unroll
            for (int vb = 0; vb < 2; ++vb) TR_FRAG(bv[vb], vtr, (32 * ts * PV + 16 * vb) * 2, 4 * PV * 2);
#pragma unroll
            for (int kb = 0; kb < 8; ++kb) { bf16x8 a; TR_FRAG(a, ktr, (32 * ts * PKH + 16 * kb) * 2, 4 * PKH * 2);
#pragma unroll
                for (int vb = 0; vb < 2; ++vb) S[kb][vb] = __builtin_amdgcn_mfma_f32_16x16x32_bf16(a, bv[vb], S[kb][vb], 0, 0, 0); } }
        __syncthreads();
    }
    if (!FINAL) {
#pragma unroll
        for (int kb = 0; kb < 8; ++kb)
#pragma unroll
            for (int vb = 0; vb < 2; ++vb)
#pragma unroll
                for (int r = 0; r < 4; ++r) GDS[sbase + (size_t)(16 * kb + 4 * h4 + r) * 256 + 32 * w + 16 * vb + fr] = S[kb][vb][r];
        if (tid < 128) GAM[(size_t)(bh * NSEG + s) * 128 + tid] = __expf(gsum);
    }
}
__device__ __forceinline__ void gla_l2_phase(const Frame& F, const bf16* K, const bf16* V, const float* LG, float* GDS, const float* GAM) {
    for (long idx = F.gt; idx < (long)NB * GH * 128 * 64; idx += F.NGT) { const int v4 = (int)(idx & 63), k = (int)(idx >> 6) & 127, bh = (int)(idx >> 13), h = bh & 3;
        float bc[16]; float run = 0.f;
#pragma unroll
        for (int i = 0; i < NMETA; ++i) { run += LG[(size_t)(RM0 + i) * 512 + h * 128 + k]; bc[i] = run; }
        f32x4 carry = {0.f, 0.f, 0.f, 0.f};
#pragma unroll
        for (int i = 0; i < NMETA; ++i) { const float wk = __expf(run - bc[i]) * bf2f(K[(size_t)(RM0 + i) * 512 + h * 128 + k]); const v2u vw = *(const v2u*)(V + (size_t)(RM0 + i) * 1024 + h * 256 + 4 * v4);
            carry += (f32x4){bflo(vw.x), bfhi(vw.x), bflo(vw.y), bfhi(vw.y)} * wk; }
        f32x4 ds[NSEG]; float gm[NSEG];
#pragma unroll
        for (int s = 0; s < NSEG; ++s) { ds[s] = *(const f32x4*)(GDS + ((size_t)(bh * NSEG + s) * 128 + k) * 256 + 4 * v4); gm[s] = GAM[(size_t)(bh * NSEG + s) * 128 + k]; }
#pragma unroll
        for (int s = 0; s < NSEG; ++s) { *(f32x4*)(GDS + ((size_t)(bh * NSEG + s) * 128 + k) * 256 + 4 * v4) = carry; carry = carry * gm[s] + ds[s]; }
    }
}

__device__ __forceinline__ void router_phase(const Frame& F, const Args& a, unsigned char* ws) {
    const float* const* in = a.in; unsigned* ctl = (unsigned*)(ws + WS_CTL); bf16* HNM = (bf16*)(ws + WS_HNM); int* tokinfo = (int*)(ws + WS_TOKINFO);
    const float* gain = in[I_NORM_FFN1]; const float* RW = in[I_ROUTER]; const int lane = F.lane; const bf16* HB = (const bf16*)((const char*)a.out + 64 * MiB);
    LAS unsigned* cnt = (LAS unsigned*)(F.lds + TABL_OFF);
    if (F.tid < 32) cnt[F.tid] = 0u;
    __syncthreads();
    const int per = (TR + F.G - 1) / F.G, m0 = (int)blockIdx.x * per, m1 = (m0 + per < TR) ? m0 + per : TR;
    int my_e0 = 0, my_e1 = 0; unsigned my_p0 = 0, my_p1 = 0; float my_w0 = 0.f;
    int jt = 0;
    v4u nxa = {0u, 0u, 0u, 0u}, nxb = nxa; if (m0 + F.wave < m1) { const bf16* hr0 = HB + (size_t)(m0 + F.wave) * 1024; nxa = *(const v4u*)(hr0 + 8 * lane); nxb = *(const v4u*)(hr0 + 512 + 8 * lane); }
    for (int m = m0 + F.wave; m < m1; m += 8, ++jt) {
        f32x4 v[4]; unpack8(nxa, v[0], v[1]); unpack8(nxb, v[2], v[3]); float s = 0.f;
        if (m + 8 < m1) { const bf16* hr1 = HB + (size_t)(m + 8) * 1024; nxa = *(const v4u*)(hr1 + 8 * lane); nxb = *(const v4u*)(hr1 + 512 + 8 * lane); }
#pragma unroll
        for (int j = 0; j < 4; ++j) s += (v[j].x * v[j].x + v[j].y * v[j].y) + (v[j].z * v[j].z + v[j].w * v[j].w);
        const float rstd = 1.0f / sqrtf(wave_sum(s) * (1.0f / 1024.0f) + EPS);
        float p[8] = {0.f, 0.f, 0.f, 0.f, 0.f, 0.f, 0.f, 0.f};
        f32x4 yv[4];
#pragma unroll
        for (int j = 0; j < 4; ++j) { const int d0 = (j >> 1) * 512 + 8 * lane + (j & 1) * 4; const f32x4 g = *(const f32x4*)(gain + d0); const f32x4 y = v[j] * rstd * g; yv[j] = y;
#pragma unroll
            for (int e4 = 0; e4 < 4; ++e4) { const int d = d0 + e4; const f32x4 r0 = *(const f32x4*)(RW + d * 8), r1 = *(const f32x4*)(RW + d * 8 + 4);
#pragma unroll
                for (int e = 0; e < 4; ++e) { p[e] += y[e4] * r0[e]; p[4 + e] += y[e4] * r1[e]; } } }
        *(v4u*)(HNM + (size_t)m * 1024 + 8 * lane) = pack8(yv[0], yv[1]); *(v4u*)(HNM + (size_t)m * 1024 + 512 + 8 * lane) = pack8(yv[2], yv[3]);
        float q4[4];
#pragma unroll
        for (int i = 0; i < 4; ++i) { const bool up = (lane & 32) != 0; const float keep = up ? p[i + 4] : p[i], send = up ? p[i] : p[i + 4]; q4[i] = keep + __shfl_xor(send, 32); }
        float q2[2];
#pragma unroll
        for (int i = 0; i < 2; ++i) { const bool up = (lane & 16) != 0; const float keep = up ? q4[i + 2] : q4[i], send = up ? q4[i] : q4[i + 2]; q2[i] = keep + __shfl_xor(send, 16); }
        float y; { const bool up = (lane & 8) != 0; const float keep = up ? q2[1] : q2[0], send = up ? q2[0] : q2[1]; y = keep + __shfl_xor(send, 8); }
        y += __shfl_xor(y, 4); y += __shfl_xor(y, 2); y += __shfl_xor(y, 1);
        float lg[8];
#pragma unroll
        for (int e = 0; e < 8; ++e) lg[e] = __shfl(y, ((e >> 2) & 1) * 32 + ((e >> 1) & 1) * 16 + (e & 1) * 8);
        int i0 = 0; float v0 = lg[0];
#pragma unroll
        for (int e = 1; e < 8; ++e) if (lg[e] > v0) { v0 = lg[e]; i0 = e; }
        int i1 = -1; float v1 = -3.0e38f;
#pragma unroll
        for (int e = 0; e < 8; ++e) if (e != i0 && lg[e] > v1) { v1 = lg[e]; i1 = e; }
        if (i1 < 0) i1 = (i0 + 1) & 7;
        if (lane == jt) { my_e0 = i0; my_e1 = i1; my_w0 = 1.0f / (1.0f + __expf(v1 - v0)); my_p0 = atomicAdd((unsigned*)(cnt + i0), 1u); my_p1 = atomicAdd((unsigned*)(cnt + 8 + i1), 1u); }
    }
    __syncthreads();
    if (F.tid < 16) cnt[16 + F.tid] = __hip_atomic_fetch_add(ctl + CW_CNT + F.tid, cnt[F.tid], RLX_AGENT);
    __syncthreads();
    if (lane < jt) { const int m = m0 + F.wave + 8 * lane; const float w1 = 1.0f - my_w0;
        *(v4u*)(tokinfo + (size_t)m * 4) = (v4u){(unsigned)my_e0, cnt[16 + my_e0] + my_p0, __float_as_uint(my_w0), 0u};
        *(v4u*)(tokinfo + (size_t)(TR + m) * 4) = (v4u){(unsigned)my_e1, cnt[24 + my_e1] + my_p1, __float_as_uint(w1), 0u}; }
    LAS float* scr = (LAS float*)(F.lds + RING_OFF + F.wave * 16384);
    constexpr int IG = 16 * 112, ID = 56 * 32, IE = 2 * IG + ID;
    bf16* WGU = (bf16*)(ws + WS_WMOE); bf16* WD = WGU + (size_t)NE * 7168 * 1024;
    for (int it = F.gw; it < NE * IE; it += F.NGW) { const int e = it / IE; int r = it % IE;
        { TrJob j{in[I_MG] + (size_t)e * 1024 * FFE, FFE, 0, 1024, FFE, WGU + (size_t)e * 7168 * 1024, 128, 256, 0}; if (tr_try(r, j, scr, lane)) continue; }
        { TrJob j{in[I_MU] + (size_t)e * 1024 * FFE, FFE, 0, 1024, FFE, WGU + (size_t)e * 7168 * 1024, 128, 256, 128}; if (tr_try(r, j, scr, lane)) continue; }
        { TrJob j{in[I_MD] + (size_t)e * FFE * 1024, 1024, 0, FFE, 1024, WD + (size_t)e * 1024 * FFE, 1 << 30, 0, 0}; tr_try(r, j, scr, lane); }
    }
}
__device__ __forceinline__ void moe_lists_phase(const Frame& F, unsigned char* ws) {
    unsigned* ctl = (unsigned*)(ws + WS_CTL); LAS int* L = (LAS int*)(F.lds + TABL_OFF);
    const int* tokinfo = (const int*)(ws + WS_TOKINFO); int* rowtok = (int*)(ws + WS_ROWTOK); float* roww = (float*)(ws + WS_ROWW);
    int* pexp = (int*)(ws + WS_TAB + TB_PEXP); int* npan = (int*)(ws + WS_TAB + TB_NPAN);
    if (F.tid < 16) L[F.tid] = (int)__hip_atomic_load(ctl + CW_CNT + F.tid, RLX_AGENT);
    __syncthreads();
    if (F.tid == 0) { for (int s = 0; s < 2; ++s) { int acc = 0; for (int e = 0; e < 8; ++e) { L[16 + s * 8 + e] = acc; acc += (L[s * 8 + e] + 255) & ~255; } L[32 + s] = acc >> 8; } }
    __syncthreads();
    if (blockIdx.x == 0) { if (F.tid < 2) npan[F.tid] = L[32 + F.tid];
        if (F.tid < 16) { const int s = F.tid >> 3, base = L[16 + F.tid], n = (L[F.tid] + 255) >> 8; for (int p = 0; p < n; ++p) pexp[s * MPAN + (base >> 8) + p] = F.tid & 7; } }
    for (long i = F.gt; i < 2L * TR; i += F.NGT) { const int s = (int)(i >= TR), tok = (int)(i - (long)s * TR); const v4u inf = *(const v4u*)(tokinfo + i * 4);
        const int row = L[16 + s * 8 + (int)inf.x] + (int)inf.y; rowtok[(size_t)s * MROWS + row] = tok; const unsigned wb = inf.z; roww[(size_t)s * MROWS + row] = __uint_as_float(wb); }
    for (long i = F.gt; i < 16L * 256; i += F.NGT) { const int se = (int)(i >> 8), r = (int)(i & 255), s = se >> 3, cnt = L[se], base = L[16 + se], pad = ((cnt + 255) & ~255) - cnt;
        if (r < pad) { rowtok[(size_t)s * MROWS + base + cnt + r] = -1; roww[(size_t)s * MROWS + base + cnt + r] = 0.f; } }
}

constexpr int N_PHASES = 25;
__global__ void __launch_bounds__(512, 2) mk_fwd(Args args) {
    extern __shared__ __attribute__((aligned(16))) unsigned char lds_raw[];
    Frame F; F.lds = (LAS unsigned char*)lds_raw; F.tid = threadIdx.x; F.lane = F.tid & 63; F.wave = __builtin_amdgcn_readfirstlane(F.tid >> 6); F.G = gridDim.x;
    F.gw = blockIdx.x * 8 + F.wave; F.NGW = F.G * 8; F.gt = (int)blockIdx.x * 512 + F.tid; F.NGT = F.G * 512;
    unsigned char* ws = args.ws; const float* const* in = args.in; float* out = args.out;
    volatile LAS unsigned* MISC = (volatile LAS unsigned*)(F.lds + MISC_OFF);
    if (F.tid < 32) MISC[F.tid] = 0u;
    __syncthreads();
#if !MK_PER_PHASE
    XcdBarrier bar = xcd_barrier_post((unsigned*)(ws + WS_CTL) + CW_BAR, MISC + 8);
#define GRID_BAR() xcd_barrier(bar)
#else
#define GRID_BAR() do { } while (0)
#endif
    const int lo = args.ph_lo, hi = args.ph_hi;
#ifndef MK_MASK
#define MK_MASK 0xFFFFFFFFu
#endif
#ifndef MK_STOP
#define MK_STOP 99
#endif
#define IN(k) ((((MK_MASK) >> (k)) & 1u) && ((k) <= MK_STOP || (k) == 24) && lo <= (k) && (k) < hi)
#define SEAM(k) do { if (IN(k) && IN((k) + 1)) GRID_BAR(); asm volatile("" : "+v"(F.tid), "+v"(F.lane), "+v"(F.gt)); } while (0)
    const int cu = (int)blockIdx.x;
    LAS unsigned char* ring = F.lds + RING_OFF;
    const LAS int* notab = (const LAS int*)(F.lds + TABL_OFF);
    float* hmeta = (float*)(ws + WS_HMETA);
    bf16* HB = (bf16*)((char*)out + 64 * MiB);
    bf16* HN = (bf16*)(ws + WS_HN);
    constexpr size_t P1K = (size_t)256 * 1024 * 2;

    if (IN(0)) { p0_prologue(F, args, ws); } SEAM(0);
    if (IN(1)) { SchedStatic S{NPR, 10, F.G, cu, (const char*)HN, (const char*)(ws + WS_WIN0), P1K, P1K, 0, 0}; EpiWin0 E{(bf16*)(ws + WS_G), (bf16*)(ws + WS_XRBX), (bf16*)(ws + WS_U)};
        pg8::gemm_phase<EpiWin0, SchedStatic, false>(ring, 1024, 1024, S, E, notab);
        for (int t = cu; t < EV_IN / 16; t += F.G) { const int n0 = t * 16; const bf16* const br[1] = {(const bf16*)(ws + WS_WIN0) + (size_t)n0 * 1024}; f32x4 o[1];
            meta_tile<1>(F, HN + (size_t)RM0 * 1024, 1024, 1024, br, 1024, o);
            if (F.wave == 0) { const int row = RM0 + (F.lane & 15), c = n0 + 4 * (F.lane >> 4); f32x4 v = o[0];
                if (c < 1024) { for (int j = 0; j < 4; ++j) v[j] = gelu_tanh(v[j]); *(v2u*)((bf16*)(ws + WS_G) + (size_t)row * 1024 + c) = (v2u){pk2(v[0], v[1]), pk2(v[2], v[3])}; }
                else if (c < 2048) *(v2u*)((bf16*)(ws + WS_XRBX) + (size_t)row * 1024 + c - 1024) = (v2u){pk2(v[0], v[1]), pk2(v[2], v[3])};
                else *(v2u*)((bf16*)(ws + WS_U) + (size_t)row * 512 + c - 2048) = (v2u){pk2(v[0], v[1]), pk2(v[2], v[3])}; } } } SEAM(1);
    if (IN(2)) { for (int pass = 0; pass < 2; ++pass) { if ((pass ^ (F.wave & 1)) == 0) conv_phase(F, (const bf16*)(ws + WS_XRBX), in[I_CONVW], in[I_CONVB], (bf16*)(ws + WS_XC)); else ssm_l1_phase(F, ws, (const bf16*)(ws + WS_U), (float*)(ws + WS_SSE)); } } SEAM(2);
    if (IN(3)) { SchedStatic S{NPR, 8, F.G, cu, (const char*)(ws + WS_XC), (const char*)(ws + WS_GW), P1K, (size_t)256 * 256 * 2, 2, (size_t)256 * 2};
        EpiGates E{in[I_GAB], in[I_GXB], (const float*)(ws + WS_TAB + TB_SP8), (const bf16*)(ws + WS_XC), (bf16*)(ws + WS_A), (bf16*)(ws + WS_XRBX)};
        pg8::gemm_phase<EpiGates, SchedStatic, false>(ring, 256, 1024, S, E, notab);
        for (int t = cu; t < 64; t += F.G) { const int ch0 = t * 16, h = ch0 >> 8, cl = ch0 & 255;
            const bf16* gwb = (const bf16*)(ws + WS_GW) + (size_t)h * 512 * 256 + (size_t)((cl >> 7) * 256 + (cl & 127)) * 256; const bf16* const br[2] = {gwb, gwb + 128 * 256}; f32x4 o[2];
            meta_tile<2>(F, (const bf16*)(ws + WS_XC) + (size_t)RM0 * 1024 + h * 256, 1024, 256, br, 256, o);
            if (F.wave == 0) { const int row = RM0 + (F.lane & 15), ch = ch0 + 4 * (F.lane >> 4); const size_t ro = (size_t)row * 1024 + ch;
                const f32x4 ba = *(const f32x4*)(in[I_GAB] + ch), bx = *(const f32x4*)(in[I_GXB] + ch), sp = *(const f32x4*)((const float*)(ws + WS_TAB + TB_SP8) + ch);
                const v2u xw = *(const v2u*)((const bf16*)(ws + WS_XC) + ro); const float xv[4] = {bflo(xw.x), bfhi(xw.x), bflo(xw.y), bfhi(xw.y)}; f32x4 av, bv;
                for (int j = 0; j < 4; ++j) { const float r = sigmoidf_(o[0][j] + ba[j]), ig = sigmoidf_(o[1][j] + bx[j]), la = -r * sp[j]; av[j] = la; bv[j] = __builtin_amdgcn_sqrtf(fmaxf(one_minus_exp(2.0f * la), 0.0f)) * ig * xv[j]; }
                *(v2u*)((bf16*)(ws + WS_A) + ro) = (v2u){pk2(av[0], av[1]), pk2(av[2], av[3])}; *(v2u*)((bf16*)(ws + WS_XRBX) + ro) = (v2u){pk2(bv[0], bv[1]), pk2(bv[2], bv[3])}; } } } SEAM(3);
    if (IN(4)) { lru_l1_phase(F, (const bf16*)(ws + WS_A), (const bf16*)(ws + WS_XRBX), (float*)(ws + WS_PEND), (float*)(ws + WS_HEND)); } SEAM(4);
    if (IN(5)) { carry_phase(F, ws, (const bf16*)(ws + WS_A), (const bf16*)(ws + WS_XRBX), (const float*)(ws + WS_PEND), (const float*)(ws + WS_HEND), (float*)(ws + WS_CIN), (const bf16*)(ws + WS_U), (const float*)(ws + WS_SSE), (float*)(ws + WS_SSIN)); } SEAM(5);
    if (IN(6)) { mix0_final_phase(F, ws, (const bf16*)(ws + WS_A), (const bf16*)(ws + WS_XRBX), (const float*)(ws + WS_CIN), (const bf16*)(ws + WS_G), (bf16*)(ws + WS_AOUT), in[I_CRE], in[I_CIM], in[I_SD], (const bf16*)(ws + WS_U), (const float*)(ws + WS_SSIN), (bf16*)(ws + WS_GS)); } SEAM(6);
    if (IN(7)) { SchedStatic S{NPR, 2, F.G, cu, (const char*)(ws + WS_GS), (const char*)(ws + WS_GLUW), (size_t)256 * 512 * 2, (size_t)256 * 512 * 2, 0, 0}; EpiGlu E{in[I_GLUB], (const bf16*)(ws + WS_GS), (bf16*)(ws + WS_AOUT)};
        pg8::gemm_phase<EpiGlu, SchedStatic, false>(ring, 512, 512, S, E, notab);
        for (int t = cu; t < 32; t += F.G) { const int n0 = t * 16; const bf16* const br[1] = {(const bf16*)(ws + WS_GLUW) + (size_t)n0 * 512}; f32x4 o[1];
            meta_tile<1>(F, (const bf16*)(ws + WS_GS) + (size_t)RM0 * 512, 512, 512, br, 512, o);
            if (F.wave == 0) { const int row = RM0 + (F.lane & 15), c = n0 + 4 * (F.lane >> 4); const f32x4 b = *(const f32x4*)(in[I_GLUB] + c);
                const v2u gw = *(const v2u*)((const bf16*)(ws + WS_GS) + (size_t)row * 512 + c); const float gv[4] = {bflo(gw.x), bfhi(gw.x), bflo(gw.y), bfhi(gw.y)}; float v[4];
                for (int j = 0; j < 4; ++j) v[j] = gv[j] * sigmoidf_(o[0][j] + b[j]);
                *(v2u*)((bf16*)(ws + WS_AOUT) + (size_t)row * 1536 + 1024 + c) = (v2u){pk2(v[0], v[1]), pk2(v[2], v[3])}; } } } SEAM(7);
    if (IN(8)) { SchedStatic S{NPR, 4, F.G, cu, (const char*)(ws + WS_AOUT), (const char*)(ws + WS_WOUT0), (size_t)256 * 1536 * 2, (size_t)256 * 1536 * 2, 0, 0}; EpiResid E{in[I_X], HB};
        pg8::gemm_phase<EpiResid, SchedStatic, false>(ring, 1536, 1536, S, E, notab);
        for (int t = cu; t < 64; t += F.G) { const int n0 = t * 16; const bf16* const br[1] = {(const bf16*)(ws + WS_WOUT0) + (size_t)n0 * 1536}; f32x4 o[1];
            meta_tile<1>(F, (const bf16*)(ws + WS_AOUT) + (size_t)RM0 * 1536, 1536, 1536, br, 1536, o);
            if (F.wave == 0) { float* p = hmeta + (size_t)(F.lane & 15) * 1024 + n0 + 4 * (F.lane >> 4); *(f32x4*)p = *(const f32x4*)p + o[0]; } } } SEAM(8);
    if (IN(9)) { norm_phase(F, HB, hmeta, in[I_NORM_FFN0], HN, TR + NMETA); } SEAM(9);
    if (IN(10)) { SchedStatic S{NPR, 24, F.G, cu, (const char*)HN, (const char*)(ws + WS_WUP0), P1K, P1K, 0, 0}; EpiSwiglu E{(bf16*)(ws + WS_HID0), FF0};
        pg8::gemm_phase<EpiSwiglu, SchedStatic, false>(ring, 1024, 1024, S, E, notab);
        for (int t = cu; t < FF0 / 16; t += F.G) { const int u0 = t * 16; const bf16* gb = (const bf16*)(ws + WS_WUP0) + (size_t)((u0 >> 7) * 256 + (u0 & 127)) * 1024; const bf16* const br[2] = {gb, gb + 128 * 1024}; f32x4 o[2];
            meta_tile<2>(F, HN + (size_t)RM0 * 1024, 1024, 1024, br, 1024, o);
            if (F.wave == 0) { const int row = RM0 + (F.lane & 15), c = u0 + 4 * (F.lane >> 4); float v[4]; for (int j = 0; j < 4; ++j) v[j] = siluf_(o[0][j]) * o[1][j];
                *(v2u*)((bf16*)(ws + WS_HID0) + (size_t)row * FF0 + c) = (v2u){pk2(v[0], v[1]), pk2(v[2], v[3])}; } } } SEAM(10);
    if (IN(11)) { SchedStatic S{NPR, 4, F.G, cu, (const char*)(ws + WS_HID0), (const char*)(ws + WS_WDN0), (size_t)256 * FF0 * 2, (size_t)256 * FF0 * 2, 0, 0}; EpiResid E{nullptr, HB};
        pg8::gemm_phase<EpiResid, SchedStatic, false>(ring, FF0, FF0, S, E, notab);
        for (int t = cu; t < 64; t += F.G) { const int n0 = t * 16; const bf16* const br[1] = {(const bf16*)(ws + WS_WDN0) + (size_t)n0 * FF0}; f32x4 o[1];
            meta_tile<1>(F, (const bf16*)(ws + WS_HID0) + (size_t)RM0 * FF0, FF0, FF0, br, FF0, o);
            if (F.wave == 0) { float* p = hmeta + (size_t)(F.lane & 15) * 1024 + n0 + 4 * (F.lane >> 4); *(f32x4*)p = *(const f32x4*)p + o[0]; } } } SEAM(11);
    if (IN(12)) { norm_phase(F, HB, hmeta, in[I_NORM_MIX1], HN, TR + NMETA); } SEAM(12);
    if (IN(13)) { SchedStatic S{NPR, 14, F.G, cu, (const char*)HN, (const char*)(ws + WS_WIN1), P1K, P1K, 0, 0}; EpiWin1 E{(bf16*)(ws + WS_Q), (bf16*)(ws + WS_K), (bf16*)(ws + WS_V), (bf16*)(ws + WS_GATE), (float*)(ws + WS_LG), in[I_GB]};
        pg8::gemm_phase<EpiWin1, SchedStatic, false>(ring, 1024, 1024, S, E, notab);
        for (int t = cu; t < 128; t += F.G) { const int n0 = t < 32 ? 512 + t * 16 : (t < 96 ? 1024 + (t - 32) * 16 : 3072 + (t - 96) * 16); const bf16* const br[1] = {(const bf16*)(ws + WS_WIN1) + (size_t)n0 * 1024}; f32x4 o[1];
            meta_tile<1>(F, HN + (size_t)RM0 * 1024, 1024, 1024, br, 1024, o);
            if (F.wave == 0) { const int row = RM0 + (F.lane & 15), c = n0 + 4 * (F.lane >> 4); const f32x4 v = o[0];
                if (c < 1024) *(v2u*)((bf16*)(ws + WS_K) + (size_t)row * 512 + c - 512) = (v2u){pk2(v[0], v[1]), pk2(v[2], v[3])};
                else if (c < 2048) *(v2u*)((bf16*)(ws + WS_V) + (size_t)row * 1024 + c - 1024) = (v2u){pk2(v[0], v[1]), pk2(v[2], v[3])};
                else { const f32x4 b = *(const f32x4*)(in[I_GB] + c - 3072); f32x4 l; for (int j = 0; j < 4; ++j) l[j] = logsigmoidf_(v[j] + b[j]) * 0.0625f; *(f32x4*)((float*)(ws + WS_LG) + (size_t)row * 512 + c - 3072) = l; } } } } SEAM(13);
    if (IN(14)) { for (int it = cu; it < NB * GH * NSEG; it += F.G) gla_item<false>(F, it >> 6, (it >> 4) & 3, it & 15, (const bf16*)(ws + WS_Q), (const bf16*)(ws + WS_K), (const bf16*)(ws + WS_V), (const bf16*)(ws + WS_GATE), (const float*)(ws + WS_LG), in[I_GNORM], (float*)(ws + WS_GDS), (float*)(ws + WS_TAB + TB_GAM), (bf16*)(ws + WS_AOUT2)); } SEAM(14);
    if (IN(15)) { gla_l2_phase(F, (const bf16*)(ws + WS_K), (const bf16*)(ws + WS_V), (const float*)(ws + WS_LG), (float*)(ws + WS_GDS), (const float*)(ws + WS_TAB + TB_GAM)); } SEAM(15);
    if (IN(16)) { for (int it = cu; it < NB * GH * NSEG; it += F.G) gla_item<true>(F, it >> 6, (it >> 4) & 3, it & 15, (const bf16*)(ws + WS_Q), (const bf16*)(ws + WS_K), (const bf16*)(ws + WS_V), (const bf16*)(ws + WS_GATE), (const float*)(ws + WS_LG), in[I_GNORM], (float*)(ws + WS_GDS), (float*)(ws + WS_TAB + TB_GAM), (bf16*)(ws + WS_AOUT2)); } SEAM(16);
    if (IN(17)) { SchedStatic S{NPR, 4, F.G, cu, (const char*)(ws + WS_AOUT2), (const char*)(ws + WS_WOUT1), P1K, P1K, 0, 0}; EpiResid E{nullptr, HB};
        pg8::gemm_phase<EpiResid, SchedStatic, false>(ring, 1024, 1024, S, E, notab); } SEAM(17);
    if (IN(18)) { router_phase(F, args, ws); } SEAM(18);
    if (IN(19)) { moe_lists_phase(F, ws); } SEAM(19);
#define MOE_PHASES(pu, pd, slot) \
    if (IN(pu)) { const int np = ((const int*)(ws + WS_TAB + TB_NPAN))[slot], nun = np * 28; LAS int* meta = (LAS int*)(F.lds + TABL_OFF); LAS int* tokt = (LAS int*)(F.lds + TABL_OFF + 512); \
        const int* pexp = (const int*)(ws + WS_TAB + TB_PEXP) + (slot) * MPAN; const int* rowtok = (const int*)(ws + WS_ROWTOK) + (size_t)(slot) * MROWS; int nmy = 0; \
        __syncthreads(); \
        for (int i = 0; (long)i * F.G + cu < nun && i < 20; ++i) { const int Lq = i * F.G + cu, p = Lq / 28, n = Lq % 28; if (F.tid == 0) { meta[i * 4] = p; meta[i * 4 + 1] = n; meta[i * 4 + 2] = pexp[p]; meta[i * 4 + 3] = 0; } \
            if (F.tid < 256) tokt[i * 256 + F.tid] = rowtok[p * 256 + F.tid]; ++nmy; } \
        __syncthreads(); \
        SchedList S{nmy, meta, (const char*)(ws + WS_HNM), (const char*)(ws + WS_WMOE), 0, P1K, (size_t)7168 * 1024 * 2}; EpiSwiglu E{(bf16*)(ws + WS_HIDM), FFE}; \
        pg8::gemm_phase<EpiSwiglu, SchedList, true>(ring, 1024, 1024, S, E, tokt); } SEAM(pu); \
    if (IN(pd)) { const int np = ((const int*)(ws + WS_TAB + TB_NPAN))[slot], nun = np * 4, nfull = nun < 512 ? nun : 512, nrem = nun - nfull; LAS int* meta = (LAS int*)(F.lds + TABL_OFF); LAS int* tokt = (LAS int*)(F.lds + TABL_OFF + 512); LAS float* wtt = (LAS float*)(F.lds + TABL_OFF + 512 + 4096); \
        const int* pexp = (const int*)(ws + WS_TAB + TB_PEXP) + (slot) * MPAN; const int* rowtok = (const int*)(ws + WS_ROWTOK) + (size_t)(slot) * MROWS; const float* roww = (const float*)(ws + WS_ROWW) + (size_t)(slot) * MROWS; int nmy = 0; \
        __syncthreads(); \
        for (int i = 0; (long)i * F.G + cu < nfull && i < 3; ++i) { const int Lq = i * F.G + cu, p = Lq / 4, n = Lq % 4; if (F.tid == 0) { meta[i * 4] = p; meta[i * 4 + 1] = n; meta[i * 4 + 2] = pexp[p]; meta[i * 4 + 3] = 0; } \
            if (F.tid < 256) { tokt[i * 256 + F.tid] = rowtok[p * 256 + F.tid]; wtt[i * 256 + F.tid] = roww[p * 256 + F.tid]; } ++nmy; } \
        const bool slice = cu < nrem * 4;                   \
        if (slice && F.tid == 0) { const int Lq = 512 + cu / 4, p = Lq / 4, n = Lq % 4; meta[12] = p; meta[13] = n; meta[14] = pexp[p]; meta[15] = (cu & 3) * 896; } \
        __syncthreads(); \
        { SchedList S{nmy, meta, (const char*)(ws + WS_HIDM), (const char*)(ws + WS_WMOE) + (size_t)NE * 7168 * 1024 * 2, (size_t)256 * FFE * 2, (size_t)256 * FFE * 2, (size_t)1024 * FFE * 2}; EpiMoeDown E{HB, tokt, wtt}; \
          pg8::gemm_phase<EpiMoeDown, SchedList, false>(ring, FFE, FFE, S, E, tokt); } \
        { SchedList S{slice ? 1 : 0, meta + 12, (const char*)(ws + WS_HIDM), (const char*)(ws + WS_WMOE) + (size_t)NE * 7168 * 1024 * 2, (size_t)256 * FFE * 2, (size_t)256 * FFE * 2, (size_t)1024 * FFE * 2}; EpiSlab E{(float*)(ws + WS_SLAB), meta + 12}; \
          pg8::gemm_phase<EpiSlab, SchedList, false>(ring, 896, FFE, S, E, tokt, FFE); } } SEAM(pd);
    MOE_PHASES(20, 21, 0)
    if (IN(22)) { const int np0 = ((const int*)(ws + WS_TAB + TB_NPAN))[0]; const int nrow = (np0 - 128) * 256; const float* slab = (const float*)(ws + WS_SLAB); const int* rowtok = (const int*)(ws + WS_ROWTOK); const float* roww = (const float*)(ws + WS_ROWW);
        for (long i = F.gt; i < (long)nrow * 128; i += F.NGT) { const int r = (int)(i >> 7), c8 = (int)(i & 127) * 8; const int tok = rowtok[TR + r];
            if (tok >= 0) { const float w = roww[TR + r]; f32x4 s0 = *(const f32x4*)(slab + (size_t)r * 1024 + c8), s1 = *(const f32x4*)(slab + (size_t)r * 1024 + c8 + 4);
#pragma unroll
                for (int sl = 1; sl < 4; ++sl) { s0 += *(const f32x4*)(slab + ((size_t)sl * 2048 + r) * 1024 + c8); s1 += *(const f32x4*)(slab + ((size_t)sl * 2048 + r) * 1024 + c8 + 4); }
                bf16* d = HB + (size_t)tok * 1024 + c8; f32x4 v0, v1; unpack8(*(const v4u*)d, v0, v1); *(v4u*)d = pack8(v0 + s0 * w, v1 + s1 * w); } } }
    MOE_PHASES(22, 23, 1)
    if (IN(24)) { LAS int* Lb = (LAS int*)(F.lds + TABL_OFF); const unsigned* ctl_ = (const unsigned*)(ws + WS_CTL);
        __syncthreads();
        if (F.tid == 0) { int acc = 0; for (int e = 0; e < 8; ++e) { Lb[e] = acc; acc += ((int)__hip_atomic_load(ctl_ + CW_CNT + 8 + e, RLX_AGENT) + 255) & ~255; } }
        __syncthreads();
        const int* tokinfo1 = (const int*)(ws + WS_TOKINFO) + (size_t)TR * 4; const float* slab = (const float*)(ws + WS_SLAB); const float* fg = in[I_FNORM]; const int lane = F.lane;
        const f32x4 g0 = *(const f32x4*)(fg + 8 * lane), g1 = *(const f32x4*)(fg + 8 * lane + 4), g2 = *(const f32x4*)(fg + 512 + 8 * lane), g3 = *(const f32x4*)(fg + 512 + 8 * lane + 4);
#define FIN_ROW(m, wa, wb) do { f32x4 v[4]; unpack8(wa, v[0], v[1]); unpack8(wb, v[2], v[3]); \
            { const v4u inf = *(const v4u*)(tokinfo1 + (size_t)(m) * 4); const unsigned ex = inf.x, ps = inf.y, wbits = inf.z; const int r1 = Lb[ex] + (int)ps - TR; \
              if (r1 >= 0) { const float w = __uint_as_float(wbits); \
                _Pragma("unroll") for (int sl = 0; sl < 4; ++sl) { const float* sp = slab + ((size_t)sl * 2048 + r1) * 1024; \
                    v[0] += *(const f32x4*)(sp + 8 * lane) * w; v[1] += *(const f32x4*)(sp + 8 * lane + 4) * w; v[2] += *(const f32x4*)(sp + 512 + 8 * lane) * w; v[3] += *(const f32x4*)(sp + 512 + 8 * lane + 4) * w; } } } \
            float s_ = 0.f; _Pragma("unroll") for (int j = 0; j < 4; ++j) s_ += (v[j].x * v[j].x + v[j].y * v[j].y) + (v[j].z * v[j].z + v[j].w * v[j].w); \
            const float rstd = 1.0f / sqrtf(wave_sum(s_) * (1.0f / 1024.0f) + EPS); float* orow = out + (size_t)(m) * 1024; \
            *(f32x4*)(orow + 8 * lane) = v[0] * rstd * g0; *(f32x4*)(orow + 8 * lane + 4) = v[1] * rstd * g1; *(f32x4*)(orow + 512 + 8 * lane) = v[2] * rstd * g2; *(f32x4*)(orow + 512 + 8 * lane + 4) = v[3] * rstd * g3; } while (0)
        for (int m = F.gw; m < TR / 2; m += 2 * F.NGW) { const int m2 = m + F.NGW; const v4u wa = *(const v4u*)(HB + (size_t)m * 1024 + 8 * lane), wb = *(const v4u*)(HB + (size_t)m * 1024 + 512 + 8 * lane);
            v4u wc = wa, wd = wb; if (m2 < TR / 2) { wc = *(const v4u*)(HB + (size_t)m2 * 1024 + 8 * lane); wd = *(const v4u*)(HB + (size_t)m2 * 1024 + 512 + 8 * lane); }
            FIN_ROW(m, wa, wb); if (m2 < TR / 2) FIN_ROW(m2, wc, wd); }
        v4u ra[8], rb[8];
        for (int base = TR / 2; base < TR; base += 8 * F.NGW) {
#pragma unroll
            for (int j = 0; j < 8; ++j) { const int m = base + F.gw + j * F.NGW; if (m < TR) { ra[j] = *(const v4u*)(HB + (size_t)m * 1024 + 8 * lane); rb[j] = *(const v4u*)(HB + (size_t)m * 1024 + 512 + 8 * lane); } }
            GRID_BAR();
#pragma unroll
            for (int j = 0; j < 8; ++j) { const int m = base + F.gw + j * F.NGW; if (m < TR) FIN_ROW(m, ra[j], rb[j]); }
        }
#undef FIN_ROW
    }
#undef IN
#undef SEAM
}

extern "C" void kernel_launch(void* const* d_in, const int* in_sizes, int n_in, void* d_out, int out_size, void* d_ws, size_t ws_size, hipStream_t stream) {
    static int grid = 0;
    if (grid == 0) {
        if (n_in != 38 || out_size != TR * D || ws_size < WS_END) { fprintf(stderr, "kernel_launch: unexpected problem shape (n_in %d, out %d, ws %zu); nothing launched\n", n_in, out_size, ws_size); grid = -1; return; }
        int dev = 0, cus = 0, per_cu = 0;
        if (hipGetDevice(&dev) != hipSuccess || hipDeviceGetAttribute(&cus, hipDeviceAttributeMultiprocessorCount, dev) != hipSuccess) { grid = -1; return; }
        if (hipFuncSetAttribute((const void*)mk_fwd, hipFuncAttributeMaxDynamicSharedMemorySize, LDS_BYTES) != hipSuccess) { fprintf(stderr, "kernel_launch: hipFuncSetAttribute failed\n"); grid = -1; return; }
        if (hipOccupancyMaxActiveBlocksPerMultiprocessor(&per_cu, (const void*)mk_fwd, 512, LDS_BYTES) != hipSuccess || per_cu < 1) fprintf(stderr, "kernel_launch: note: occupancy query reports %d workgroups per CU\n", per_cu);
        (void)hipGetLastError();
        grid = cus;
    }
    if (grid < 0) return;
    (void)hipMemsetAsync((char*)d_ws + WS_CTL, 0, CTL_ZERO_BYTES, stream);
    Args a{};
    for (int i = 0; i < 38; ++i) a.in[i] = (const float*)d_in[i];
    a.out = (float*)d_out; a.ws = (unsigned char*)d_ws; a.li = 0; a.pad = 0;
#if MK_PER_PHASE
    for (int k = 0; k < N_PHASES; ++k) { a.ph_lo = k; a.ph_hi = k + 1; hipLaunchKernelGGL(mk_fwd, dim3(grid), dim3(512), LDS_BYTES, stream, a); }
#else
    a.ph_lo = 0; a.ph_hi = N_PHASES; hipLaunchKernelGGL(mk_fwd, dim3(grid), dim3(512), LDS_BYTES, stream, a);
#endif
}
```

```cpp
#include <hip/hip_runtime.h>
#include <cstdio>
#include <cstdint>

#ifndef MK_PER_PHASE
#define MK_PER_PHASE 0
#endif

#define GAS __attribute__((address_space(1)))
#define LAS __attribute__((address_space(3)))
typedef unsigned short bf16;
typedef unsigned v4u __attribute__((ext_vector_type(4)));
typedef unsigned v2u __attribute__((ext_vector_type(2)));
typedef float f32x4 __attribute__((ext_vector_type(4)));
typedef float f32x2 __attribute__((ext_vector_type(2)));
typedef short bf16x8 __attribute__((ext_vector_type(8)));

constexpr int D = 1024, NB = 4, SEQ = 8192, NMETA = 16;
constexpr int TR = NB * SEQ;
constexpr int RM0 = TR;
constexpr int NPR = 128, NPA = 129;
constexpr int RALL = NPA * 256;
constexpr int LRUW = 1024, SSMW = 512, NG = 32, NS = 64, EV_IN = 2560, EV_MIX = 1536, FF0 = 3072;
constexpr int GK = 512, GV = 1024, GH = 4, GDK = 128, GDV = 256, OD_INP = 3584  , OD_IN = 3088;
constexpr int NE = 8, FFE = 3584, MROWS = 34816  , MPAN = 136;
constexpr float EPS = 1e-6f;
constexpr int NCH = 128;
constexpr int NSEG = 16, SEGC = 8;

constexpr size_t MiB = 1u << 20;
constexpr size_t WS_CTL = 0, CTL_ZERO_BYTES = 32768;
constexpr size_t WS_TAB = 1 * MiB;
constexpr size_t WS_WIN0 = 2 * MiB, WS_GW = 7 * MiB, WS_GLUW = 8 * MiB, WS_WOUT0 = 9 * MiB, WS_WUP0 = 12 * MiB, WS_WDN0 = 24 * MiB, WS_WIN1 = 30 * MiB, WS_WOUT1 = 37 * MiB;
constexpr size_t WS_PEND = 40 * MiB, WS_HEND = 42 * MiB, WS_CIN = 44 * MiB, WS_SSE = 46 * MiB, WS_SSIN = 54 * MiB, WS_GDS = 62 * MiB, WS_HMETA = 94 * MiB;
constexpr size_t WS_G = 96 * MiB, WS_U = 161 * MiB, WS_A = 194 * MiB, WS_XRBX = 323 * MiB, WS_HN = 388 * MiB, WS_AOUT = 388 * MiB, WS_XC = 453 * MiB, WS_GS = 485 * MiB;
constexpr size_t WS_HID0 = 96 * MiB;
constexpr size_t WS_WE = 62 * MiB;
constexpr size_t WS_Q = 96 * MiB, WS_K = 129 * MiB, WS_V = 162 * MiB, WS_GATE = 227 * MiB, WS_LG = 292 * MiB, WS_AOUT2 = 453 * MiB;
constexpr size_t WS_SLAB = 2 * MiB  , WS_HNM = 72 * MiB  , WS_WMOE = 105 * MiB  , WS_HIDM = 273 * MiB  , WS_TOKINFO = 511 * MiB, WS_ROWTOK = 512 * MiB, WS_ROWW = 512 * MiB + 512 * 1024, WS_END = 513 * MiB;
constexpr size_t TB_BBR = 0, TB_BBI = 131072, TB_AR = 262144, TB_AI = 270336, TB_AR64 = 278528, TB_AI64 = 286720, TB_SP8 = 294912, TB_GAM = 299008  , TB_PEXP = 430080  , TB_NPAN = 432128;
constexpr int CW_TMO = 0, CW_CODE = 1, CW_CNT = 64  , CW_BAR = 4096;

constexpr int RING_OFF = 0, RING_BYTES = 131072;
constexpr int TABL_OFF = RING_BYTES, TABL_BYTES = 24576;
constexpr int MISC_OFF = TABL_OFF + TABL_BYTES;
constexpr int LDS_BYTES = MISC_OFF + 128;

#define RLX_AGENT __ATOMIC_RELAXED, __HIP_MEMORY_SCOPE_AGENT
#define LDS_WAIT() asm volatile("s_waitcnt lgkmcnt(0)" ::: "memory")
#define VM_WAIT() asm volatile("s_waitcnt vmcnt(0)" ::: "memory")
__device__ __forceinline__ unsigned f2bf(float f) { unsigned u = __builtin_bit_cast(unsigned, f); return (u + 0x7fffu + ((u >> 16) & 1u)) >> 16; }
__device__ __forceinline__ unsigned pk2(float lo, float hi) { unsigned r; asm("v_cvt_pk_bf16_f32 %0, %1, %2" : "=v"(r) : "v"(lo), "v"(hi)); return r; }
typedef int v8i __attribute__((ext_vector_type(8)));
typedef int v4i __attribute__((ext_vector_type(4)));
__device__ __forceinline__ unsigned pk4_fp8(float a, float b, float c, float d) { int w = 0; w = __builtin_amdgcn_cvt_pk_fp8_f32(a, b, w, false); w = __builtin_amdgcn_cvt_pk_fp8_f32(c, d, w, true); return (unsigned)w; }
__device__ __forceinline__ float bf2f(unsigned b) { return __builtin_bit_cast(float, b << 16); }
__device__ __forceinline__ float bflo(unsigned w) { return __builtin_bit_cast(float, w << 16); }
__device__ __forceinline__ float bfhi(unsigned w) { return __builtin_bit_cast(float, w & 0xffff0000u); }
__device__ __forceinline__ float rcpf_(float x) { return __builtin_amdgcn_rcpf(x); }
__device__ __forceinline__ float sigmoidf_(float x) { return rcpf_(1.0f + __expf(-x)); }
__device__ __forceinline__ float siluf_(float x) { return x * rcpf_(1.0f + __expf(-x)); }
__device__ __forceinline__ float gelu_tanh(float x) { const float u = 0.7978845608028654f * (x + 0.044715f * x * x * x); return x * rcpf_(1.0f + __expf(-2.0f * u)); }
__device__ __forceinline__ float one_minus_exp(float x) { const float p = -x * (1.0f + 0.5f * x * (1.0f + (1.0f / 3.0f) * x * (1.0f + 0.25f * x * (1.0f + 0.2f * x * (1.0f + (1.0f / 6.0f) * x))))); return x > -0.25f ? p : 1.0f - __expf(x); }
__device__ __forceinline__ float logsigmoidf_(float x) { return fminf(x, 0.0f) - __logf(1.0f + __expf(-fabsf(x))); }
__device__ __forceinline__ float wave_sum(float v) {
#pragma unroll
    for (int o = 1; o < 64; o <<= 1) v += __shfl_xor(v, o);
    return v;
}

namespace pg8 {
constexpr int BM = 256, BK = 64, HALF = 128, HTB = HALF * BK * 2, STAGE_BYTES = 8 * HTB, NXCD = 8, WGM = 8;
__host__ __device__ __forceinline__ int lds_byte(int r, int c) { const int st = (r >> 4) * 2 + (c >> 5), rr = r & 15, cc = c & 31, ob = rr * 64 + cc * 2; return st * 1024 + (ob ^ (((ob >> 9) & 1) << 5)); }
__host__ __device__ __forceinline__ void stage_rc(int b, int& R, int& C) { const int st = b / 1024, sb = b % 1024, swz = sb ^ (((sb >> 9) & 1) << 5); R = (st >> 1) * 16 + swz / 64; C = (st & 1) * 32 + (swz % 64) / 2; }
__host__ __device__ __forceinline__ int perm32(int rho) { const int n = rho >> 4, i = rho & 15; return 8 * (i >> 2) + 4 * n + (i & 3); }

struct Unit { int pm, pn, slot; const char* a; const char* b; };
__device__ __forceinline__ bool static_tile(int i, int G, int c, int nM, int nN, int& pm, int& pn) {
    const int nwg = nM * nN; const long L = (long)i * G + c; if (L >= nwg) return false;
    int wgid = (int)L; { const int q = nwg / NXCD, r = nwg % NXCD, xcd = wgid % NXCD, off = wgid / NXCD; wgid = (xcd < r ? xcd * (q + 1) : r * (q + 1) + (xcd - r) * q) + off; }
    const int nig = WGM * nN, gid = wgid / nig, fm = gid * WGM, gsz = (nM - fm) < WGM ? (nM - fm) : WGM;
    pm = fm + ((wgid % nig) % gsz); pn = (wgid % nig) / gsz; return true;
}
__device__ __forceinline__ unsigned cvt_pk_bf16(float lo, float hi) { unsigned r; asm volatile("v_cvt_pk_bf16_f32 %0, %1, %2" : "=v"(r) : "v"(lo), "v"(hi)); return r; }

template <class Epi, class Sched, bool GATHER, bool FP8 = false>
__device__ __forceinline__ void gemm_phase(LAS unsigned char* lds, const int K, const int lda, const Sched& S, const Epi& E, const LAS int* gtab, const int ldb_ = 0) {
    const int tid = threadIdx.x, wid = __builtin_amdgcn_readfirstlane(tid >> 6), lane = tid & 63, wr = wid >> 2, wc = wid & 3, fr = lane & 15, fq = lane >> 4;
    int nt = K / BK; asm volatile("" : "+s"(nt));
    int RA[2], CA[2]; unsigned voffB[2];
#pragma unroll
    for (int i = 0; i < 2; ++i) { int R, C; stage_rc(tid * 16 + i * 8192, R, C); const int Rb = Epi::PERM ? ((R & ~31) + perm32(R & 31)) : R;
        RA[i] = R; CA[i] = C; voffB[i] = (unsigned)(Rb * (ldb_ ? ldb_ : K) + C) * 2u; }
    const size_t kstep = (size_t)(BK * 2);
    const size_t hstepB = (size_t)HALF * (ldb_ ? ldb_ : K) * 2;
    const unsigned ldsw = (unsigned)wid * 1024u;
    const int aoff = lds_byte(wr * 64 + fr, fq * 8), boff = lds_byte(wc * 32 + fr, fq * 8);
    unsigned offC[2][2], offN[2][2];
#define PG8_SETOFF(dst, unit) do { _Pragma("unroll") for (int _h = 0; _h < 2; ++_h) _Pragma("unroll") for (int _i = 0; _i < 2; ++_i) { \
        if constexpr (GATHER) { int _t = gtab[(unit).slot * 256 + _h * HALF + RA[_i]]; _t = _t < 0 ? 0 : _t; dst[_h][_i] = ((unsigned)_t * (unsigned)lda + (unsigned)CA[_i]) * 2u; } \
        else dst[_h][_i] = ((unsigned)(_h * HALF + RA[_i]) * (unsigned)lda + (unsigned)CA[_i]) * 2u; } } while (0)
#define PG8_SA(b, h) (((b) * 2 + (h)) * HTB)
#define PG8_SB(b, h) ((4 + (b) * 2 + (h)) * HTB)
#define PG8_STAGEB(bufoff, gbase) do { _Pragma("unroll") for (int _i = 0; _i < 2; ++_i) \
        __builtin_amdgcn_global_load_lds((const unsigned*)((const char*)(gbase) + voffB[_i]), (LAS unsigned*)(lds + (bufoff) + ldsw + _i * 8192), 16, 0, 0); } while (0)
#define PG8_STAGEA(bufoff, gbase, o0, o1) do { \
        __builtin_amdgcn_global_load_lds((const unsigned*)((const char*)(gbase) + (o0)), (LAS unsigned*)(lds + (bufoff) + ldsw), 16, 0, 0); \
        __builtin_amdgcn_global_load_lds((const unsigned*)((const char*)(gbase) + (o1)), (LAS unsigned*)(lds + (bufoff) + ldsw + 8192), 16, 0, 0); } while (0)
#define PG8_LDA(dst, b, h) do { _Pragma("unroll") for (int m = 0; m < 4; ++m) { const LAS v4i* _p = (const LAS v4i*)(lds + PG8_SA(b, h) + aoff + m * 2048); dst[m] = __builtin_shufflevector(_p[0], _p[64], 0, 1, 2, 3, 4, 5, 6, 7); } } while (0)
#define PG8_LDB(dst, b, h) do { _Pragma("unroll") for (int n = 0; n < 2; ++n) { const LAS v4i* _p = (const LAS v4i*)(lds + PG8_SB(b, h) + boff + n * 2048); dst[n] = __builtin_shufflevector(_p[0], _p[64], 0, 1, 2, 3, 4, 5, 6, 7); } } while (0)
#define PG8_HALF(x, k) __builtin_bit_cast(bf16x8, __builtin_shufflevector(x, x, 4 * (k), 4 * (k) + 1, 4 * (k) + 2, 4 * (k) + 3))
#define PG8_MMA(ai, bj, At, Bt) do { __builtin_amdgcn_s_setprio(1); _Pragma("unroll") for (int m = 0; m < 4; ++m) _Pragma("unroll") for (int n = 0; n < 2; ++n) { \
        if constexpr (FP8) asm volatile("v_mfma_scale_f32_16x16x128_f8f6f4 %0, %1, %2, %0, %3, %3 op_sel_hi:[0,0,0]" : "+v"(acc[ai][bj][m][n]) : "v"(Bt[n]), "v"(At[m]), "v"(one8));   \
        else { acc[ai][bj][m][n] = __builtin_amdgcn_mfma_f32_16x16x32_bf16(PG8_HALF(Bt[n], 0), PG8_HALF(At[m], 0), acc[ai][bj][m][n], 0, 0, 0); \
               acc[ai][bj][m][n] = __builtin_amdgcn_mfma_f32_16x16x32_bf16(PG8_HALF(Bt[n], 1), PG8_HALF(At[m], 1), acc[ai][bj][m][n], 0, 0, 0); } } __builtin_amdgcn_s_setprio(0); } while (0)
#define PG8_WAIT_V(n) asm volatile("s_waitcnt vmcnt(" #n ")" ::: "memory")
#define PG8_WAIT_L(n) asm volatile("s_waitcnt lgkmcnt(" #n ")" ::: "memory")
#define PG8_BAR __builtin_amdgcn_s_barrier()
#define PG8_SCHED __builtin_amdgcn_sched_barrier(0)
    Unit cur, nxt; int ui = 0;
    if (!S.next(0, cur)) return;
    f32x4 acc[2][2][4][2];
#pragma unroll
    for (int a = 0; a < 2; ++a)
#pragma unroll
        for (int b = 0; b < 2; ++b)
#pragma unroll
            for (int m = 0; m < 4; ++m)
#pragma unroll
                for (int n = 0; n < 2; ++n) acc[a][b][m][n] = (f32x4){0.f, 0.f, 0.f, 0.f};
    v8i At[4], B0[2], B1[2];
    int one8 = 0x7F7F7F7F; asm volatile("" : "+v"(one8));
    const char* cA = cur.a; const char* cB = cur.b;
    PG8_SETOFF(offC, cur);
    PG8_STAGEB(PG8_SB(0, 0), cB); PG8_STAGEB(PG8_SB(0, 1), cB + hstepB); PG8_STAGEA(PG8_SA(0, 0), cA, offC[0][0], offC[0][1]); PG8_STAGEA(PG8_SA(0, 1), cA, offC[1][0], offC[1][1]);
    if (wr == 1) PG8_BAR;
    PG8_WAIT_V(2); PG8_BAR;
    PG8_STAGEB(PG8_SB(1, 0), cB + kstep); PG8_STAGEA(PG8_SA(1, 0), cA + kstep, offC[0][0], offC[0][1]); PG8_STAGEB(PG8_SB(1, 1), cB + hstepB + kstep);
    PG8_WAIT_V(6); PG8_BAR;
    for (;;) {
        const bool has_next = S.next(ui + 1, nxt);
        const char* nA = has_next ? nxt.a : cA; const char* nB = has_next ? nxt.b : cB;
        if constexpr (GATHER) {
#pragma unroll
        for (int h = 0; h < 2; ++h)
#pragma unroll
            for (int i = 0; i < 2; ++i) offN[h][i] = offC[h][i]; }
        for (int t = 0; t < nt; t += 2) {
            const bool last = (t == nt - 2);
            const char* a1 = cA + (size_t)(t + 1) * kstep;
            const char* a2 = last ? nA : cA + (size_t)(t + 2) * kstep; const char* b2 = last ? nB : cB + (size_t)(t + 2) * kstep;
            const char* a3 = a2 + kstep; const char* b3 = b2 + kstep;
            if constexpr (GATHER) { if (last && has_next) PG8_SETOFF(offN, nxt); }
            unsigned q00 = offC[0][0], q01 = offC[0][1], q10 = offC[1][0], q11 = offC[1][1];
            if constexpr (GATHER) { q00 = last ? offN[0][0] : q00; q01 = last ? offN[0][1] : q01; q10 = last ? offN[1][0] : q10; q11 = last ? offN[1][1] : q11; }
            PG8_LDB(B0, 0, 0); PG8_LDB(B1, 0, 1); PG8_SCHED; PG8_LDA(At, 0, 0); PG8_STAGEA(PG8_SA(1, 1), a1, offC[1][0], offC[1][1]);
            PG8_WAIT_V(8); PG8_WAIT_L(0); PG8_BAR; PG8_MMA(0, 0, At, B0); PG8_MMA(0, 1, At, B1); PG8_BAR; PG8_SCHED;
            PG8_LDA(At, 0, 1); PG8_STAGEB(PG8_SB(0, 0), b2); PG8_STAGEB(PG8_SB(0, 1), b2 + hstepB); PG8_STAGEA(PG8_SA(0, 0), a2, q00, q01);
            PG8_WAIT_V(8); PG8_WAIT_L(0); PG8_BAR; PG8_MMA(1, 0, At, B0); PG8_MMA(1, 1, At, B1); PG8_BAR; PG8_SCHED;
            PG8_LDB(B0, 1, 0); PG8_LDB(B1, 1, 1); PG8_SCHED; PG8_LDA(At, 1, 0); PG8_STAGEA(PG8_SA(0, 1), a2, q10, q11);
            PG8_WAIT_V(8); PG8_WAIT_L(0); PG8_BAR; PG8_MMA(0, 0, At, B0); PG8_MMA(0, 1, At, B1); PG8_BAR; PG8_SCHED;
            PG8_LDA(At, 1, 1); PG8_STAGEB(PG8_SB(1, 0), b3); PG8_STAGEB(PG8_SB(1, 1), b3 + hstepB); PG8_STAGEA(PG8_SA(1, 0), a3, q00, q01);
            PG8_WAIT_V(8); PG8_WAIT_L(0); PG8_BAR; PG8_MMA(1, 0, At, B0); PG8_MMA(1, 1, At, B1); PG8_BAR; PG8_SCHED;
        }
        if (wr == 0) PG8_BAR;
        if constexpr (FP8) asm volatile("s_nop 15\n\ts_nop 15" ::: "memory");
        E(acc, cur, wr, wc, fr, fq);
        if (!has_next) break;
#pragma unroll
        for (int a = 0; a < 2; ++a)
#pragma unroll
            for (int b = 0; b < 2; ++b)
#pragma unroll
                for (int m = 0; m < 4; ++m)
#pragma unroll
                    for (int n = 0; n < 2; ++n) acc[a][b][m][n] = (f32x4){0.f, 0.f, 0.f, 0.f};
        cur = nxt; cA = nA; cB = nB; ++ui;
        if constexpr (GATHER) {
#pragma unroll
        for (int h = 0; h < 2; ++h)
#pragma unroll
            for (int i = 0; i < 2; ++i) offC[h][i] = offN[h][i]; }
        if (wr == 1) PG8_BAR;
    }
    PG8_WAIT_V(0);
    PG8_BAR;
#undef PG8_SETOFF
#undef PG8_SA
#undef PG8_SB
#undef PG8_STAGEA
#undef PG8_STAGEB
#undef PG8_LDA
#undef PG8_LDB
#undef PG8_MMA
#undef PG8_HALF
#undef PG8_WAIT_V
#undef PG8_WAIT_L
#undef PG8_BAR
#undef PG8_SCHED
}
}

#define XB_TMO      128
#define XB_XCNT(j)  (256  + 64 * (j))
#define XB_XSUB(j)  (1280 + 64 * (j))
#define XB_XGEN(j)  (2304 + 64 * (j))
#define XB_TOP      3328
#define XB_TOPGEN   3392
#define XCD_BAR_WORDS 3456
#define XB_SPIN_CAP (1u << 18)
__device__ __forceinline__ unsigned xb_ld(unsigned* p)              { return __hip_atomic_load(p, __ATOMIC_RELAXED, __HIP_MEMORY_SCOPE_AGENT); }
__device__ __forceinline__ unsigned xb_add(unsigned* p, unsigned v) { return __hip_atomic_fetch_add(p, v, __ATOMIC_RELAXED, __HIP_MEMORY_SCOPE_AGENT); }
__device__ __forceinline__ unsigned xb_xcc_id() { return (unsigned)__builtin_amdgcn_s_getreg((3 << 11) | 20) & 0xFu; }
#define XB_SPIN(cond, bar) do { unsigned _sp = 0; while (cond) { __builtin_amdgcn_s_sleep(1); \
    if ((++_sp & 255u) == 0u) { if (xb_ld(&(bar)[XB_TMO])) break; if (_sp > XB_SPIN_CAP) { atomicAdd(&(bar)[XB_TMO], 1u); break; } } } } while (0)
struct XcdBarrier { unsigned* bar; unsigned x; volatile LAS unsigned* st; };
__device__ __forceinline__ XcdBarrier xcd_barrier_post(unsigned* bar, volatile LAS unsigned* st) {
    XcdBarrier b; b.bar = bar; b.x = xb_xcc_id(); b.st = st;
    if (threadIdx.x == 0) (void)xb_add(&bar[XB_XCNT(b.x)], 1u);
    return b;
}
__device__ __forceinline__ void xcd_barrier_complete(unsigned* bar, unsigned x, unsigned& nloc, unsigned& nx) {
    const unsigned G = gridDim.x * gridDim.y * gridDim.z;
    unsigned sum, cnt, mine, sp = 0u;
    for (;;) {
        sum = 0u; cnt = 0u; mine = 0u;
#pragma unroll
        for (unsigned j = 0; j < 16; ++j) { const unsigned c = xb_ld(&bar[XB_XCNT(j)]); sum += c; cnt += (c > 0u) ? 1u : 0u; mine = (j == x) ? c : mine; }
        if (sum == G) break;
        __builtin_amdgcn_s_sleep(1);
        if ((++sp & 255u) == 0u) { if (xb_ld(&bar[XB_TMO])) break; if (sp > XB_SPIN_CAP) { atomicAdd(&bar[XB_TMO], 1u); break; } }
    }
    nloc = mine > 0u ? mine : 1u; nx = cnt > 0u ? cnt : 1u;
}
__device__ __forceinline__ void xcd_barrier(const XcdBarrier& b) {
    asm volatile("s_waitcnt vmcnt(0)" ::: "memory");
    __syncthreads();
    if (threadIdx.x == 0) {
        unsigned* bar = b.bar;
        __builtin_amdgcn_s_waitcnt(0);
        unsigned nloc = b.st[0], nx = b.st[1];
        if (nloc == 0u) { xcd_barrier_complete(bar, b.x, nloc, nx); b.st[0] = nloc; b.st[1] = nx; }
        const unsigned old = xb_add(&bar[XB_XSUB(b.x)], 1u);
        const unsigned gen = old / nloc;
        if (old + 1u == (gen + 1u) * nloc) {
            __builtin_amdgcn_fence(__ATOMIC_RELEASE, "agent");
            asm volatile("s_waitcnt vmcnt(0)" ::: "memory");
            const unsigned og = xb_add(&bar[XB_TOP], 1u);
            const unsigned tg = og / nx;
            if (og + 1u == (tg + 1u) * nx) xb_add(&bar[XB_TOPGEN], 1u);
            else XB_SPIN(xb_ld(&bar[XB_TOPGEN]) == tg, bar);
            __builtin_amdgcn_fence(__ATOMIC_ACQUIRE, "agent");
            xb_add(&bar[XB_XGEN(b.x)], 1u);
            asm volatile("s_waitcnt vmcnt(0)" ::: "memory");
        } else {
            XB_SPIN(xb_ld(&bar[XB_XGEN(b.x)]) == gen, bar);
            __builtin_amdgcn_fence(__ATOMIC_ACQUIRE, "agent");
            asm volatile("s_waitcnt vmcnt(0)" ::: "memory");
        }
    }
    __syncthreads();
}

struct Args { const float* in[38]; float* out; unsigned char* ws; int ph_lo, ph_hi, li, pad; };
struct Frame {
    LAS unsigned char* lds;
    int tid, lane, wave, G, gw, NGW;
    int gt, NGT;
};
enum { I_X = 0, I_META, I_NORM_MIX0, I_WIN0, I_CONVW, I_CONVB, I_GAW, I_GAB, I_GXW, I_GXB, I_LAM, I_LRE, I_LIM, I_LDT, I_BRE, I_BIM, I_CRE, I_CIM, I_SD, I_GLUW, I_GLUB, I_WOUT0, I_NORM_FFN0,
       I_FG, I_FU, I_FD, I_NORM_MIX1, I_WIN1, I_GW2, I_GB, I_GNORM, I_WOUT1, I_NORM_FFN1, I_ROUTER, I_MG, I_MU, I_MD, I_FNORM };

struct SchedStatic {
    int nM, nN, G, c; const char* A; const char* B; size_t aStep, bStep; int aColDiv; size_t aColStep;
    __device__ __forceinline__ bool next(int i, pg8::Unit& u) const {
        int pm, pn; if (!pg8::static_tile(i, G, c, nM, nN, pm, pn)) return false;
        u.pm = pm; u.pn = pn; u.slot = i; u.a = A + (size_t)pm * aStep + (aColDiv ? (size_t)(pn / aColDiv) * aColStep : 0); u.b = B + (size_t)pn * bStep; return true;
    }
};
struct SchedList {
    int n; const LAS int* meta; const char* A; const char* B; size_t aStep, bTile, bExpert;
    __device__ __forceinline__ bool next(int i, pg8::Unit& u) const {
        if (i >= n) return false;
        const int pm = meta[i * 4 + 0], pn = meta[i * 4 + 1], e = meta[i * 4 + 2];
        u.pm = pm; u.pn = pn; u.slot = i; const int ko = meta[i * 4 + 3]; u.a = A + (size_t)pm * aStep + (size_t)ko * 2; u.b = B + (size_t)e * bExpert + (size_t)pn * bTile + (size_t)ko * 2; return true;
    }
};

#define EPI_ROWS(ai, m) ((ai) * 128 + wr * 64 + (m) * 16 + fr)
#define EPI_COLP(bj) ((bj) * 128 + wc * 32 + 8 * fq)
#define EPI_COLN(bj, n) ((bj) * 128 + wc * 32 + 16 * (n) + 4 * fq)
typedef const f32x4 (&AccRef)[2][2][4][2];
__device__ __forceinline__ void unpack8(v4u w, f32x4& a, f32x4& b) { a = (f32x4){bflo(w.x), bfhi(w.x), bflo(w.y), bfhi(w.y)}; b = (f32x4){bflo(w.z), bfhi(w.z), bflo(w.w), bfhi(w.w)}; }
__device__ __forceinline__ v4u pack8(f32x4 a, f32x4 b) { v4u w; w.x = pg8::cvt_pk_bf16(a[0], a[1]); w.y = pg8::cvt_pk_bf16(a[2], a[3]); w.z = pg8::cvt_pk_bf16(b[0], b[1]); w.w = pg8::cvt_pk_bf16(b[2], b[3]); return w; }

struct EpiWin0 {
    static constexpr bool PERM = true; bf16 *G, *XR, *U;
    __device__ __forceinline__ void operator()(AccRef acc, const pg8::Unit& u, int wr, int wc, int fr, int fq) const {
        const int pn = u.pn; bf16* base; int ld, c0;
        if (pn < 4) { base = G; ld = 1024; c0 = pn * 256; } else if (pn < 8) { base = XR; ld = 1024; c0 = (pn - 4) * 256; } else { base = U; ld = 512; c0 = (pn - 8) * 256; }
#pragma unroll
        for (int ai = 0; ai < 2; ++ai)
#pragma unroll
            for (int m = 0; m < 4; ++m) { bf16* rowp = base + (size_t)(u.pm * 256 + EPI_ROWS(ai, m)) * ld + c0;
#pragma unroll
                for (int bj = 0; bj < 2; ++bj) { f32x4 v0 = acc[ai][bj][m][0], v1 = acc[ai][bj][m][1];
                    if (pn < 4) {
#pragma unroll
                        for (int j = 0; j < 4; ++j) { v0[j] = gelu_tanh(v0[j]); v1[j] = gelu_tanh(v1[j]); } }
                    *(v4u*)(rowp + EPI_COLP(bj)) = pack8(v0, v1); } }
    }
};
struct EpiGates {
    static constexpr bool PERM = true; const float *gab, *gxb, *sp8; const bf16* XC; bf16* A; bf16* BX;
    __device__ __forceinline__ void operator()(AccRef acc, const pg8::Unit& u, int wr, int wc, int fr, int fq) const {
        const int ch0 = (u.pn >> 1) * 256 + (u.pn & 1) * 128 + wc * 32 + 8 * fq;
        f32x4 ba[2], bx[2], sp[2];
#pragma unroll
        for (int n = 0; n < 2; ++n) { ba[n] = *(const f32x4*)(gab + ch0 + 4 * n); bx[n] = *(const f32x4*)(gxb + ch0 + 4 * n); sp[n] = *(const f32x4*)(sp8 + ch0 + 4 * n); }
#pragma unroll
        for (int ai = 0; ai < 2; ++ai)
#pragma unroll
            for (int m = 0; m < 4; ++m) { const size_t ro = (size_t)(u.pm * 256 + EPI_ROWS(ai, m)) * 1024 + ch0;
                const v4u xw = *(const v4u*)(XC + ro); const float xv[8] = {bflo(xw.x), bfhi(xw.x), bflo(xw.y), bfhi(xw.y), bflo(xw.z), bfhi(xw.z), bflo(xw.w), bfhi(xw.w)};
                f32x4 av[2], bv[2];
#pragma unroll
                for (int n = 0; n < 2; ++n)
#pragma unroll
                    for (int j = 0; j < 4; ++j) { const float r = sigmoidf_(acc[ai][0][m][n][j] + ba[n][j]), ig = sigmoidf_(acc[ai][1][m][n][j] + bx[n][j]);
                        const float la = -r * sp[n][j], aa = __expf(la); av[n][j] = la; bv[n][j] = __builtin_amdgcn_sqrtf(fmaxf(__builtin_fmaf(-aa, aa, 1.0f), 0.0f)) * ig * xv[4 * n + j]; }
                *(v4u*)(A + ro) = pack8(av[0], av[1]); *(v4u*)(BX + ro) = pack8(bv[0], bv[1]); asm volatile("" ::: "memory"); }
    }
};
struct EpiGlu {
    static constexpr bool PERM = true; const float* glub; const bf16* GS; bf16* AOUT;
    __device__ __forceinline__ void operator()(AccRef acc, const pg8::Unit& u, int wr, int wc, int fr, int fq) const {
#pragma unroll
        for (int bj = 0; bj < 2; ++bj) { const int c = u.pn * 256 + EPI_COLP(bj); const f32x4 b0 = *(const f32x4*)(glub + c), b1 = *(const f32x4*)(glub + c + 4);
#pragma unroll
            for (int ai = 0; ai < 2; ++ai)
#pragma unroll
                for (int m = 0; m < 4; ++m) { const size_t row = (size_t)(u.pm * 256 + EPI_ROWS(ai, m));
                    const v4u gw = *(const v4u*)(GS + row * 512 + c); const float gv[8] = {bflo(gw.x), bfhi(gw.x), bflo(gw.y), bfhi(gw.y), bflo(gw.z), bfhi(gw.z), bflo(gw.w), bfhi(gw.w)};
                    f32x4 v0, v1;
#pragma unroll
                    for (int j = 0; j < 4; ++j) { v0[j] = gv[j] * sigmoidf_(acc[ai][bj][m][0][j] + b0[j]); v1[j] = gv[4 + j] * sigmoidf_(acc[ai][bj][m][1][j] + b1[j]); }
                    *(v4u*)(AOUT + row * 1536 + 1024 + c) = pack8(v0, v1); } }
    }
};
struct EpiResid {
    static constexpr bool PERM = true; const float* xsrc; bf16* hb;
    __device__ __forceinline__ void operator()(AccRef acc, const pg8::Unit& u, int wr, int wc, int fr, int fq) const {
#pragma unroll
        for (int ai = 0; ai < 2; ++ai)
#pragma unroll
            for (int m = 0; m < 4; ++m) { const size_t ro = (size_t)(u.pm * 256 + EPI_ROWS(ai, m)) * 1024 + u.pn * 256;
#pragma unroll
                for (int bj = 0; bj < 2; ++bj) { const size_t o = ro + EPI_COLP(bj); f32x4 v0, v1;
                    if (xsrc) { v0 = *(const f32x4*)(xsrc + o); v1 = *(const f32x4*)(xsrc + o + 4); } else unpack8(*(const v4u*)(hb + o), v0, v1);
                    *(v4u*)(hb + o) = pack8(v0 + acc[ai][bj][m][0], v1 + acc[ai][bj][m][1]); } }
    }
};
struct EpiSwiglu {
    static constexpr bool PERM = true; bf16* H; int ld;
    __device__ __forceinline__ void operator()(AccRef acc, const pg8::Unit& u, int wr, int wc, int fr, int fq) const {
        const int c = u.pn * 128 + wc * 32 + 8 * fq;
#pragma unroll
        for (int ai = 0; ai < 2; ++ai)
#pragma unroll
            for (int m = 0; m < 4; ++m) { f32x4 v0, v1;
#pragma unroll
                for (int j = 0; j < 4; ++j) { v0[j] = siluf_(acc[ai][0][m][0][j]) * acc[ai][1][m][0][j]; v1[j] = siluf_(acc[ai][0][m][1][j]) * acc[ai][1][m][1][j]; }
                *(v4u*)(H + (size_t)(u.pm * 256 + EPI_ROWS(ai, m)) * ld + c) = pack8(v0, v1); }
    }
};
struct EpiWin1 {
    static constexpr bool PERM = true; bf16 *Q, *K, *V, *GATE; float* LG; const float* gb;
    __device__ __forceinline__ void operator()(AccRef acc, const pg8::Unit& u, int wr, int wc, int fr, int fq) const {
        const int pn = u.pn;
#pragma unroll
        for (int ai = 0; ai < 2; ++ai)
#pragma unroll
            for (int m = 0; m < 4; ++m) { const size_t row = (size_t)(u.pm * 256 + EPI_ROWS(ai, m));
#pragma unroll
                for (int bj = 0; bj < 2; ++bj) { f32x4 v0 = acc[ai][bj][m][0], v1 = acc[ai][bj][m][1]; const int cc = EPI_COLP(bj);
                    if (pn < 2) { v0 = v0 * 0.08838834764831845f; v1 = v1 * 0.08838834764831845f; *(v4u*)(Q + row * 512 + pn * 256 + cc) = pack8(v0, v1); }
                    else if (pn < 4) { *(v4u*)(K + row * 512 + (pn - 2) * 256 + cc) = pack8(v0, v1); }
                    else if (pn < 8) { *(v4u*)(V + row * 1024 + (pn - 4) * 256 + cc) = pack8(v0, v1); }
                    else if (pn < 12) {
#pragma unroll
                        for (int j = 0; j < 4; ++j) { v0[j] = siluf_(v0[j]); v1[j] = siluf_(v1[j]); }
                        *(v4u*)(GATE + row * 1024 + (pn - 8) * 256 + cc) = pack8(v0, v1); }
                    else { const int c = (pn - 12) * 256 + cc; const f32x4 b0 = *(const f32x4*)(gb + c), b1 = *(const f32x4*)(gb + c + 4);
#pragma unroll
                        for (int j = 0; j < 4; ++j) { v0[j] = logsigmoidf_(v0[j] + b0[j]) * 0.0625f; v1[j] = logsigmoidf_(v1[j] + b1[j]) * 0.0625f; }
                        *(f32x4*)(LG + row * 512 + c) = v0; *(f32x4*)(LG + row * 512 + c + 4) = v1; } } }
    }
};
struct EpiSwiglu8 {
    static constexpr bool PERM = true; unsigned char* H; int ld;
    __device__ __forceinline__ void operator()(AccRef acc, const pg8::Unit& u, int wr, int wc, int fr, int fq) const {
        const int c = u.pn * 128 + wc * 32 + 8 * fq; constexpr float SC = 1.0f / 32.0f;
#pragma unroll
        for (int ai = 0; ai < 2; ++ai)
#pragma unroll
            for (int m = 0; m < 4; ++m) { float v[8];
#pragma unroll
                for (int j = 0; j < 4; ++j) { v[j] = siluf_(acc[ai][0][m][0][j] * SC) * (acc[ai][1][m][0][j] * SC); v[4 + j] = siluf_(acc[ai][0][m][1][j] * SC) * (acc[ai][1][m][1][j] * SC); }
                *(v2u*)(H + (size_t)(u.pm * 256 + EPI_ROWS(ai, m)) * ld + c) = (v2u){pk4_fp8(v[0], v[1], v[2], v[3]), pk4_fp8(v[4], v[5], v[6], v[7])}; }
    }
};
struct EpiMoeDown {
    static constexpr bool PERM = true; bf16* hb; const LAS int* toks; const LAS float* wts;
    __device__ __forceinline__ void operator()(AccRef acc, const pg8::Unit& u, int wr, int wc, int fr, int fq) const {
#pragma unroll
        for (int ai = 0; ai < 2; ++ai)
#pragma unroll
            for (int m = 0; m < 4; ++m) { const int rl = u.slot * 256 + EPI_ROWS(ai, m); const int tok = toks[rl]; const float w = wts[rl] * (1.0f / 64.0f);
                if (tok >= 0) { bf16* d = hb + (size_t)tok * 1024 + u.pn * 256;
#pragma unroll
                    for (int bj = 0; bj < 2; ++bj) { bf16* p = d + EPI_COLP(bj); f32x4 v0, v1; unpack8(*(const v4u*)p, v0, v1); *(v4u*)p = pack8(v0 + acc[ai][bj][m][0] * w, v1 + acc[ai][bj][m][1] * w); } } }
    }
};
struct EpiSlab {
    static constexpr bool PERM = false; float* slab; const LAS int* meta;
    __device__ __forceinline__ void operator()(AccRef acc, const pg8::Unit& u, int wr, int wc, int fr, int fq) const {
        const int sl = meta[u.slot * 4 + 3] / 256; float* base = slab + ((size_t)(sl * 8 + (u.pm - 128)) * 256) * 1024 + u.pn * 256;
#pragma unroll
        for (int ai = 0; ai < 2; ++ai)
#pragma unroll
            for (int m = 0; m < 4; ++m) { float* d = base + (size_t)EPI_ROWS(ai, m) * 1024;
#pragma unroll
                for (int bj = 0; bj < 2; ++bj)
#pragma unroll
                    for (int n = 0; n < 2; ++n) *(f32x4*)(d + EPI_COLN(bj, n)) = acc[ai][bj][m][n] * (1.0f / 64.0f); }
    }
};

__device__ __forceinline__ void tr_item8(const float* W, int ldw, int col, int k0, unsigned char* WT, int ldt, int drow, float scale, LAS float* scr, int lane) {
    float wv[32];
#pragma unroll
    for (int i = 0; i < 32; ++i) wv[i] = W[(size_t)(k0 + 2 * i + (lane >> 5)) * ldw + col + (lane & 31)];
#pragma unroll
    for (int i = 0; i < 32; ++i) scr[(2 * i + (lane >> 5)) * 33 + (lane & 31)] = wv[i] * scale;
    LDS_WAIT(); asm volatile("" ::: "memory");
    const int c = lane & 7;
#pragma unroll
    for (int j = 0; j < 4; ++j) { const int n = (lane >> 3) + 8 * j; const LAS float* s = scr + (8 * c) * 33 + n;
        *(v2u*)(WT + (size_t)(drow + n) * ldt + k0 + 8 * c) = (v2u){pk4_fp8(s[0 * 33], s[1 * 33], s[2 * 33], s[3 * 33]), pk4_fp8(s[4 * 33], s[5 * 33], s[6 * 33], s[7 * 33])}; }
    LDS_WAIT(); asm volatile("" ::: "memory");
}
__device__ __forceinline__ void tr_item(const float* W, int ldw, int col, int k0, bf16* WT, int ldt, int drow, LAS float* scr, int lane) {
    float wv[32];
#pragma unroll
    for (int i = 0; i < 32; ++i) wv[i] = W[(size_t)(k0 + 2 * i + (lane >> 5)) * ldw + col + (lane & 31)];
#pragma unroll
    for (int i = 0; i < 32; ++i) scr[(2 * i + (lane >> 5)) * 33 + (lane & 31)] = wv[i];
    LDS_WAIT(); asm volatile("" ::: "memory");
    const int c = lane & 7;
#pragma unroll
    for (int j = 0; j < 4; ++j) { const int n = (lane >> 3) + 8 * j; const LAS float* s = scr + (8 * c) * 33 + n;
        v4u o; o.x = pk2(s[0 * 33], s[1 * 33]); o.y = pk2(s[2 * 33], s[3 * 33]); o.z = pk2(s[4 * 33], s[5 * 33]); o.w = pk2(s[6 * 33], s[7 * 33]);
        *(v4u*)(WT + (size_t)(drow + n) * ldt + k0 + 8 * c) = o; }
    LDS_WAIT(); asm volatile("" ::: "memory");
}
struct TrJob { const float* W; int ldw, col0, K, N; bf16* WT; int blk, bstride, add; };
__device__ __forceinline__ bool tr_try(int& r, const TrJob& j, LAS float* scr, int lane) {
    const int nblk = j.N / 32, items = (j.K / 64) * nblk;
    if (r >= items) { r -= items; return false; }
    const int kb = r / nblk, n0 = (r % nblk) * 32;
    tr_item(j.W, j.ldw, j.col0 + n0, kb * 64, j.WT, j.K, (n0 / j.blk) * j.bstride + (n0 % j.blk) + j.add, scr, lane);
    return true;
}
__device__ __forceinline__ void norm_row_bf16(const float* xrow, const float* gain, bf16* orow, int lane) {
    const f32x4* xr = (const f32x4*)xrow + lane; const f32x4* gr = (const f32x4*)gain + lane;
    f32x4 v[4]; float s = 0.f;
#pragma unroll
    for (int j = 0; j < 4; ++j) { v[j] = xr[64 * j]; s += (v[j].x * v[j].x + v[j].y * v[j].y) + (v[j].z * v[j].z + v[j].w * v[j].w); }
    const float rstd = 1.0f / sqrtf(wave_sum(s) * (1.0f / 1024.0f) + EPS);
    v2u* o8 = (v2u*)orow + lane;
#pragma unroll
    for (int j = 0; j < 4; ++j) { const f32x4 g = gr[64 * j]; v2u w; w.x = pk2(v[j].x * rstd * g.x, v[j].y * rstd * g.y); w.y = pk2(v[j].z * rstd * g.z, v[j].w * rstd * g.w); o8[64 * j] = w; }
}
__device__ __forceinline__ void norm_row_b2b(const bf16* hrow, const float* gain, bf16* orow, int lane) {
    f32x4 v[4]; unpack8(*(const v4u*)(hrow + 8 * lane), v[0], v[1]); unpack8(*(const v4u*)(hrow + 512 + 8 * lane), v[2], v[3]); float s = 0.f;
#pragma unroll
    for (int j = 0; j < 4; ++j) s += (v[j].x * v[j].x + v[j].y * v[j].y) + (v[j].z * v[j].z + v[j].w * v[j].w);
    const float rstd = 1.0f / sqrtf(wave_sum(s) * (1.0f / 1024.0f) + EPS);
    const f32x4 g0 = *(const f32x4*)(gain + 8 * lane), g1 = *(const f32x4*)(gain + 8 * lane + 4), g2 = *(const f32x4*)(gain + 512 + 8 * lane), g3 = *(const f32x4*)(gain + 512 + 8 * lane + 4);
    *(v4u*)(orow + 8 * lane) = pack8(v[0] * rstd * g0, v[1] * rstd * g1); *(v4u*)(orow + 512 + 8 * lane) = pack8(v[2] * rstd * g2, v[3] * rstd * g3);
}

__device__ __forceinline__ void p0_prologue(const Frame& F, const Args& a, unsigned char* ws) {
    LAS float* scr = (LAS float*)(F.lds + RING_OFF + F.wave * 16384);
    const float* const* in = a.in;
    constexpr int BIG = 1 << 30;
    for (int it = F.gw; ; it += F.NGW) {
        int r = it;
        { TrJob j{in[I_WIN0], EV_IN, 0, 1024, EV_IN, (bf16*)(ws + WS_WIN0), BIG, 0, 0}; if (tr_try(r, j, scr, F.lane)) continue; }
        bool done = false;
        for (int h = 0; h < 4 && !done; ++h) {
            { TrJob j{in[I_GAW] + (size_t)h * 65536, 256, 0, 256, 256, (bf16*)(ws + WS_GW) + (size_t)h * 512 * 256, 128, 256, 0}; if (tr_try(r, j, scr, F.lane)) { done = true; break; } }
            { TrJob j{in[I_GXW] + (size_t)h * 65536, 256, 0, 256, 256, (bf16*)(ws + WS_GW) + (size_t)h * 512 * 256, 128, 256, 128}; if (tr_try(r, j, scr, F.lane)) { done = true; break; } }
        }
        if (done) continue;
        { TrJob j{in[I_GLUW], 512, 0, 512, 512, (bf16*)(ws + WS_GLUW), BIG, 0, 0}; if (tr_try(r, j, scr, F.lane)) continue; }
        { TrJob j{in[I_WOUT0], 1024, 0, EV_MIX, 1024, (bf16*)(ws + WS_WOUT0), BIG, 0, 0}; if (tr_try(r, j, scr, F.lane)) continue; }
        { TrJob j{in[I_FG], FF0, 0, 1024, FF0, (bf16*)(ws + WS_WUP0), 128, 256, 0}; if (tr_try(r, j, scr, F.lane)) continue; }
        { TrJob j{in[I_FU], FF0, 0, 1024, FF0, (bf16*)(ws + WS_WUP0), 128, 256, 128}; if (tr_try(r, j, scr, F.lane)) continue; }
        { TrJob j{in[I_FD], 1024, 0, FF0, 1024, (bf16*)(ws + WS_WDN0), BIG, 0, 0}; if (tr_try(r, j, scr, F.lane)) continue; }
        { TrJob j{in[I_WIN1], OD_IN, 0, 1024, 3072, (bf16*)(ws + WS_WIN1), BIG, 0, 0}; if (tr_try(r, j, scr, F.lane)) continue; }
        { TrJob j{in[I_WOUT1], 1024, 0, 1024, 1024, (bf16*)(ws + WS_WOUT1), BIG, 0, 0}; if (tr_try(r, j, scr, F.lane)) continue; }
        break;
    }
    for (long i = F.gt; i < 512L * 1024; i += F.NGT) { const int j = (int)(i >> 10), k = (int)(i & 1023); const float* wr_ = in[I_WIN1] + (size_t)k * OD_IN + 3072; const float* w2 = in[I_GW2] + j; float s = 0.f;
#pragma unroll
        for (int r = 0; r < 16; ++r) s += wr_[r] * w2[r * 512];
        ((bf16*)(ws + WS_WIN1))[(size_t)(3072 + j) * 1024 + k] = (bf16)f2bf(s); }
    float* tab = (float*)(ws + WS_TAB);
    for (long i = F.gt; i < NG * NS; i += F.NGT) { const int g = (int)i / NS;
        const double lr = in[I_LRE][i], li = in[I_LIM][i], dt = exp((double)in[I_LDT][g]);
        const double mag = exp(dt * lr), ar = mag * cos(dt * li), ai = mag * sin(dt * li), den = lr * lr + li * li, nr = ar - 1.0;
        const double zr = (nr * lr + ai * li) / den, zi = (ai * lr - nr * li) / den;
        const double m64 = exp(64.0 * dt * lr);
        ((float*)((char*)tab + TB_AR))[i] = (float)ar; ((float*)((char*)tab + TB_AI))[i] = (float)ai;
        ((float*)((char*)tab + TB_AR64))[i] = (float)(m64 * cos(64.0 * dt * li)); ((float*)((char*)tab + TB_AI64))[i] = (float)(m64 * sin(64.0 * dt * li));
        for (int h = 0; h < 16; ++h) { const double br = in[I_BRE][i * 16 + h], bi = in[I_BIM][i * 16 + h];
            ((float*)((char*)tab + TB_BBR))[i * 16 + h] = (float)(zr * br - zi * bi); ((float*)((char*)tab + TB_BBI))[i * 16 + h] = (float)(zr * bi + zi * br); } }
    for (long idx = F.gt; idx < (long)NG * NS * 64; idx += F.NGT) { const int i = (int)(idx & 63), gn = (int)(idx >> 6), g = gn / NS, n = gn % NS;
        const double lr = in[I_LRE][gn], li = in[I_LIM][gn], dt = exp((double)in[I_LDT][g]);
        const double mag1 = exp(dt * lr), ar1 = mag1 * cos(dt * li), ai1 = mag1 * sin(dt * li), den = lr * lr + li * li, nr1 = ar1 - 1.0;
        const double zr = (nr1 * lr + ai1 * li) / den, zi = (ai1 * lr - nr1 * li) / den;
        const double pw = (double)(63 - i), pm = exp(pw * dt * lr), pr = pm * cos(pw * dt * li), pi_ = pm * sin(pw * dt * li);
        bf16* wre = (bf16*)(ws + WS_WE) + ((size_t)g * 128 + 2 * n) * 1024 + i * 16; bf16* wim = wre + 1024;
        for (int h = 0; h < 16; ++h) { const double br = in[I_BRE][(size_t)gn * 16 + h], bi = in[I_BIM][(size_t)gn * 16 + h]; const double bbr = zr * br - zi * bi, bbi = zr * bi + zi * br;
            wre[h] = (bf16)f2bf((float)(pr * bbr - pi_ * bbi)); wim[h] = (bf16)f2bf((float)(pr * bbi + pi_ * bbr)); } }
    for (long i = F.gt; i < 1024; i += F.NGT) { const float lam = in[I_LAM][i]; ((float*)((char*)tab + TB_SP8))[i] = 8.0f * log1pf(expf(-lam)); }
    bf16* HN = (bf16*)(ws + WS_HN); float* hmeta = (float*)(ws + WS_HMETA);
    { const float* gain0 = in[I_NORM_MIX0]; const int lane = F.lane; f32x4 gg[4];
#pragma unroll
      for (int j = 0; j < 4; ++j) gg[j] = ((const f32x4*)gain0)[lane + 64 * j];
      for (int m = F.gw; m < TR; m += 4 * F.NGW) { f32x4 xv[4][4];
#pragma unroll
        for (int q = 0; q < 4; ++q) { const int mm = m + q * F.NGW; if (mm < TR) {
#pragma unroll
            for (int j = 0; j < 4; ++j) xv[q][j] = ((const f32x4*)(in[I_X] + (size_t)mm * 1024))[lane + 64 * j]; } }
#pragma unroll
        for (int q = 0; q < 4; ++q) { const int mm = m + q * F.NGW; if (mm < TR) { float sq = 0.f;
#pragma unroll
            for (int j = 0; j < 4; ++j) sq += (xv[q][j].x * xv[q][j].x + xv[q][j].y * xv[q][j].y) + (xv[q][j].z * xv[q][j].z + xv[q][j].w * xv[q][j].w);
            const float rstd = 1.0f / sqrtf(wave_sum(sq) * (1.0f / 1024.0f) + EPS); v2u* o8 = (v2u*)(HN + (size_t)mm * 1024) + lane;
#pragma unroll
            for (int j = 0; j < 4; ++j) { const f32x4 y = xv[q][j] * rstd * gg[j]; o8[64 * j] = (v2u){pk2(y.x, y.y), pk2(y.z, y.w)}; } } } }
      for (int m = TR + F.gw; m < TR + NMETA; m += F.NGW) norm_row_bf16(in[I_META] + (size_t)(m - TR) * 1024, gain0, HN + (size_t)m * 1024, lane); }
    for (long i = F.gt; i < NMETA * 1024; i += F.NGT) hmeta[i] = in[I_META][i];
}
__device__ __forceinline__ void norm_phase(const Frame& F, const bf16* HB, const float* hmeta, const float* gain, bf16* HN, int nrows) {
    const int lane = F.lane; const f32x4 g0 = *(const f32x4*)(gain + 8 * lane), g1 = *(const f32x4*)(gain + 8 * lane + 4), g2 = *(const f32x4*)(gain + 512 + 8 * lane), g3 = *(const f32x4*)(gain + 512 + 8 * lane + 4);
    for (int m = F.gw; m < TR; m += 4 * F.NGW) { v4u xa[4], xb[4];
#pragma unroll
        for (int q = 0; q < 4; ++q) { const int mm = m + q * F.NGW; if (mm < TR) { xa[q] = *(const v4u*)(HB + (size_t)mm * 1024 + 8 * lane); xb[q] = *(const v4u*)(HB + (size_t)mm * 1024 + 512 + 8 * lane); } }
#pragma unroll
        for (int q = 0; q < 4; ++q) { const int mm = m + q * F.NGW; if (mm < TR) { f32x4 v[4]; unpack8(xa[q], v[0], v[1]); unpack8(xb[q], v[2], v[3]); float sq = 0.f;
#pragma unroll
            for (int j = 0; j < 4; ++j) sq += (v[j].x * v[j].x + v[j].y * v[j].y) + (v[j].z * v[j].z + v[j].w * v[j].w);
            const float rstd = 1.0f / sqrtf(wave_sum(sq) * (1.0f / 1024.0f) + EPS);
            *(v4u*)(HN + (size_t)mm * 1024 + 8 * lane) = pack8(v[0] * rstd * g0, v[1] * rstd * g1); *(v4u*)(HN + (size_t)mm * 1024 + 512 + 8 * lane) = pack8(v[2] * rstd * g2, v[3] * rstd * g3); } } }
    for (int m = TR + F.gw; m < nrows; m += F.NGW) norm_row_bf16(hmeta + (size_t)(m - TR) * 1024, gain, HN + (size_t)m * 1024, F.lane);
}
__device__ __forceinline__ int seq_prev(int row, int back) {
    if (row >= TR) { const int i = row - TR - back; return i >= 0 ? TR + i : -1; }
    const int t = row & (SEQ - 1); return t >= back ? row - back : TR + NMETA + (t - back);
}
__device__ __forceinline__ void conv_phase(const Frame& F, const bf16* XR, const float* cw, const float* cb, bf16* XC) {
    for (long i = F.gt; i < (long)(TR / 32 + 1) * 128; i += F.NGT) { const int c = (int)(i & 127) * 8, st = (int)(i >> 7); const bool meta = st >= TR / 32; const int r0 = meta ? RM0 : st * 32, nr = meta ? NMETA : 32;
        f32x4 w[4][2]; f32x4 b0 = *(const f32x4*)(cb + c), b1 = *(const f32x4*)(cb + c + 4);
#pragma unroll
        for (int k = 0; k < 4; ++k) { w[k][0] = *(const f32x4*)(cw + k * 1024 + c); w[k][1] = *(const f32x4*)(cw + k * 1024 + c + 4); }
        f32x4 h[3][2];
#pragma unroll
        for (int k = 0; k < 3; ++k) { const int src = seq_prev(r0, 3 - k); if (src >= 0) unpack8(*(const v4u*)(XR + (size_t)src * 1024 + c), h[k][0], h[k][1]); else { h[k][0] = (f32x4){0.f, 0.f, 0.f, 0.f}; h[k][1] = h[k][0]; } }
        for (int t0 = 0; t0 < nr; t0 += 8) { v4u x[8];
#pragma unroll
            for (int t = 0; t < 8; ++t) x[t] = *(const v4u*)(XR + (size_t)(r0 + t0 + t) * 1024 + c);
#pragma unroll
            for (int t = 0; t < 8; ++t) { f32x4 c0, c1; unpack8(x[t], c0, c1);
                const f32x4 o0 = b0 + w[0][0] * h[0][0] + w[1][0] * h[1][0] + w[2][0] * h[2][0] + w[3][0] * c0, o1 = b1 + w[0][1] * h[0][1] + w[1][1] * h[1][1] + w[2][1] * h[2][1] + w[3][1] * c1;
                *(v4u*)(XC + (size_t)(r0 + t0 + t) * 1024 + c) = pack8(o0, o1);
                h[0][0] = h[1][0]; h[0][1] = h[1][1]; h[1][0] = h[2][0]; h[1][1] = h[2][1]; h[2][0] = c0; h[2][1] = c1; } } }
}
constexpr int SSM_HP = 68, SSM_XP = 132;
constexpr int SSM_WLDS = 16 * SSM_XP * 4 + 16 * SSM_HP * 4;
struct SsmTab { float ar, ai; bf16x8 axf[8]; bf16x8 ca[4]; f32x4 dv; };
__device__ __forceinline__ void ssm_tab_load(SsmTab& T, const unsigned char* ws, const float* cre, const float* cim, const float* sd, int g, int lane) {
    const float* tab = (const float*)(ws + WS_TAB); const int gn = g * NS + lane, fr = lane & 15, fq = lane >> 4;
    T.ar = ((const float*)((const char*)tab + TB_AR))[gn]; T.ai = ((const float*)((const char*)tab + TB_AI))[gn];
#pragma unroll
    for (int rb = 0; rb < 8; ++rb) { const int r = 16 * rb + fr, n = r >> 1; const float* src = (const float*)((const char*)tab + ((r & 1) ? TB_BBI : TB_BBR)) + (size_t)(g * NS + n) * 16 + 8 * (fq & 1);
        v4u w = pack8(*(const f32x4*)src, *(const f32x4*)(src + 4)); if (fq >= 2) w = (v4u){0u, 0u, 0u, 0u}; T.axf[rb] = __builtin_bit_cast(bf16x8, w); }
#pragma unroll
    for (int ks = 0; ks < 4; ++ks) { const int n0 = 16 * ks + 4 * fq; const f32x4 cr = *(const f32x4*)(cre + (g * 16 + fr) * NS + n0), ci = *(const f32x4*)(cim + (g * 16 + fr) * NS + n0);
        v4u w; w.x = pk2(cr[0], -ci[0]); w.y = pk2(cr[1], -ci[1]); w.z = pk2(cr[2], -ci[2]); w.w = pk2(cr[3], -ci[3]); T.ca[ks] = __builtin_bit_cast(bf16x8, w); }
    T.dv = *(const f32x4*)(sd + g * 16 + 4 * fq);
}
__device__ __forceinline__ void ssm_wave(const SsmTab& T, const bf16* U, bf16* GS, int g, int row0, int ntok, float& hr, float& hi, int lane, LAS unsigned char* wl) {
    LAS float* xb = (LAS float*)wl; LAS unsigned* hb = (LAS unsigned*)(wl + 16 * SSM_XP * 4);
    const int fr = lane & 15, fq = lane >> 4; const float ar = T.ar, ai = T.ai;
    const f32x4 dv = T.dv;
    const bf16* ubase = U + (size_t)(row0 + fr) * 512 + g * 16;
    v4u bnx = {0u, 0u, 0u, 0u}; if (fq < 2) bnx = *(const v4u*)(ubase + 8 * fq);
    v2u unx = *(const v2u*)(ubase + 4 * fq);
    for (int t0 = 0; t0 < ntok; t0 += 16) {
        const v4u bw = bnx; const v2u uw = unx;
        if (t0 + 16 < ntok) { const bf16* un = ubase + (size_t)(t0 + 16) * 512; if (fq < 2) bnx = *(const v4u*)(un + 8 * fq); unx = *(const v2u*)(un + 4 * fq); }
        const bf16x8 bfr = __builtin_bit_cast(bf16x8, bw);
#pragma unroll
        for (int rb = 0; rb < 8; ++rb) { const f32x4 xa = __builtin_amdgcn_mfma_f32_16x16x32_bf16(T.axf[rb], bfr, (f32x4){0.f, 0.f, 0.f, 0.f}, 0, 0, 0); *(LAS f32x4*)(xb + fr * SSM_XP + 16 * rb + 4 * fq) = xa; }
        asm volatile("" ::: "memory");
#pragma unroll 4
        for (int tl = 0; tl < 16; ++tl) { const f32x2 x = *(const LAS f32x2*)(xb + tl * SSM_XP + 2 * lane);
            const float nr = ar * hr - ai * hi + x.x, ni = ar * hi + ai * hr + x.y; hr = nr; hi = ni;
            hb[tl * SSM_HP + lane] = pg8::cvt_pk_bf16(hr, hi); }
        asm volatile("" ::: "memory");
        f32x4 y = {0.f, 0.f, 0.f, 0.f};
#pragma unroll
        for (int ks = 0; ks < 4; ++ks) { const bf16x8 hbf = *(const LAS bf16x8*)(hb + fr * SSM_HP + 16 * ks + 4 * fq); y = __builtin_amdgcn_mfma_f32_16x16x32_bf16(T.ca[ks], hbf, y, 0, 0, 0); }
        const float o0 = gelu_tanh(y[0] + dv[0] * bflo(uw.x)), o1 = gelu_tanh(y[1] + dv[1] * bfhi(uw.x)), o2 = gelu_tanh(y[2] + dv[2] * bflo(uw.y)), o3 = gelu_tanh(y[3] + dv[3] * bfhi(uw.y));
        *(v2u*)(GS + (size_t)(row0 + t0 + fr) * 512 + g * 16 + 4 * fq) = (v2u){pk2(o0, o1), pk2(o2, o3)};
        asm volatile("" ::: "memory");
    }
    LDS_WAIT(); asm volatile("" ::: "memory");
}
__device__ __forceinline__ void ssm_l1_phase(const Frame& F, const unsigned char* ws, const bf16* U, float* SSE) {
    const int lane = F.lane, fr = lane & 15, fq = lane >> 4;
    for (int it = F.gw; it < NG * 32; it += F.NGW) { const int g = it >> 5, cb = it & 31, bc = cb * 16 + fr;
        const bf16* ap = (const bf16*)(ws + WS_WE) + ((size_t)g * 128 + fr) * 1024 + 8 * fq;
        const bf16* bp = U + ((size_t)bc * 64 + (fq >> 1)) * 512 + g * 16 + 8 * (fq & 1);
        f32x4 acc[8];
#pragma unroll
        for (int rb = 0; rb < 8; ++rb) acc[rb] = (f32x4){0.f, 0.f, 0.f, 0.f};
#pragma unroll 2
        for (int ks = 0; ks < 32; ++ks) { const bf16x8 bfr = *(const bf16x8*)(bp + (size_t)ks * 2 * 512);
#pragma unroll
            for (int rb = 0; rb < 8; ++rb) { const bf16x8 afr = *(const bf16x8*)(ap + (size_t)rb * 16 * 1024 + ks * 32); acc[rb] = __builtin_amdgcn_mfma_f32_16x16x32_bf16(afr, bfr, acc[rb], 0, 0, 0); } }
#pragma unroll
        for (int rb = 0; rb < 8; ++rb) *(f32x4*)(SSE + (((size_t)bc * NG + g) * NS + 8 * rb + 2 * fq) * 2) = acc[rb]; }
}
__device__ __forceinline__ void lru_l1_phase(const Frame& F, const bf16* A, const bf16* BX, float* PEND, float* HEND) {
    for (long i = F.gt; i < (long)NB * NCH * 128; i += F.NGT) { const int ch = (int)(i & 127) * 8, bc = (int)(i >> 7); const size_t r0 = (size_t)bc * 64;
        f32x4 P0 = {0.f, 0.f, 0.f, 0.f}, P1 = P0, H0 = P0, H1 = P0;
        for (int t0 = 0; t0 < 64; t0 += 8) { v4u la[8], bx[8];
#pragma unroll
            for (int t = 0; t < 8; ++t) { la[t] = *(const v4u*)(A + (r0 + t0 + t) * 1024 + ch); bx[t] = *(const v4u*)(BX + (r0 + t0 + t) * 1024 + ch); }
#pragma unroll
            for (int t = 0; t < 8; ++t) { f32x4 l0, l1, b0, b1; unpack8(la[t], l0, l1); unpack8(bx[t], b0, b1); P0 += l0; P1 += l1;
#pragma unroll
                for (int j = 0; j < 4; ++j) { H0[j] = __expf(l0[j]) * H0[j] + b0[j]; H1[j] = __expf(l1[j]) * H1[j] + b1[j]; } } }
#pragma unroll
        for (int j = 0; j < 4; ++j) { P0[j] = __expf(P0[j]); P1[j] = __expf(P1[j]); }
        float* pp = PEND + (size_t)bc * 1024 + ch; float* hp = HEND + (size_t)bc * 1024 + ch; *(f32x4*)pp = P0; *(f32x4*)(pp + 4) = P1; *(f32x4*)hp = H0; *(f32x4*)(hp + 4) = H1; }
}
__device__ __forceinline__ void carry_phase(const Frame& F, const unsigned char* ws, const bf16* A, const bf16* BX, const float* PEND, const float* HEND, float* CIN, const bf16* U, const float* SSE, float* SSIN) {
    if (F.gt < NB * 1024) { const int ch = (int)F.gt & 1023, b = (int)F.gt >> 10; float H = 0.f;
        for (int i = 0; i < NMETA; ++i) { const size_t r = (size_t)(RM0 + i); H = __expf(bf2f(A[r * 1024 + ch])) * H + bf2f(BX[r * 1024 + ch]); }
        for (int c0 = 0; c0 < NCH; c0 += 32) { float pp[32], hh[32];
#pragma unroll
            for (int c = 0; c < 32; ++c) { const size_t o = ((size_t)b * NCH + c0 + c) * 1024 + ch; pp[c] = PEND[o]; hh[c] = HEND[o]; }
#pragma unroll
            for (int c = 0; c < 32; ++c) { const size_t o = ((size_t)b * NCH + c0 + c) * 1024 + ch; CIN[o] = H; H = hh[c] + pp[c] * H; } }
    } else if (F.gt >= 8 * 512 && F.gt < 8 * 512 + NB * NG * NS) { const int id = (int)F.gt - 8 * 512, n = id % NS, g = (id / NS) % NG, b = id / (NS * NG), gn = g * NS + n;
        const float* tab = (const float*)(ws + WS_TAB);
        const float ar = ((const float*)((const char*)tab + TB_AR))[gn], ai = ((const float*)((const char*)tab + TB_AI))[gn], ar64 = ((const float*)((const char*)tab + TB_AR64))[gn], ai64 = ((const float*)((const char*)tab + TB_AI64))[gn];
        float hr = 0.f, hi = 0.f;
        for (int i = 0; i < NMETA; ++i) { float xr = 0.f, xi = 0.f;
            for (int h = 0; h < 16; ++h) { const float u = bf2f(U[(size_t)(RM0 + i) * 512 + g * 16 + h]); xr += ((const float*)((const char*)tab + TB_BBR))[gn * 16 + h] * u; xi += ((const float*)((const char*)tab + TB_BBI))[gn * 16 + h] * u; }
            const float nr = ar * hr - ai * hi + xr, ni = ar * hi + ai * hr + xi; hr = nr; hi = ni; }
        for (int c0 = 0; c0 < NCH; c0 += 32) { f32x2 ee[32];
#pragma unroll
            for (int c = 0; c < 32; ++c) ee[c] = ((const f32x2*)SSE)[(((size_t)b * NCH + c0 + c) * NG + g) * NS + n];
#pragma unroll
            for (int c = 0; c < 32; ++c) { ((f32x2*)SSIN)[(((size_t)b * NCH + c0 + c) * NG + g) * NS + n] = (f32x2){hr, hi};
                const float nr = ar64 * hr - ai64 * hi + ee[c].x, ni = ar64 * hi + ai64 * hr + ee[c].y; hr = nr; hi = ni; } }
    }
}
__device__ __forceinline__ void mix0_final_phase(const Frame& F, const unsigned char* ws, const bf16* A, const bf16* BX, const float* CIN, const bf16* G, bf16* AOUT, const float* cre, const float* cim, const float* sd, const bf16* U, const float* SSIN, bf16* GS) {
    for (int pass = 0; pass < 2; ++pass) {
      if ((pass ^ (F.wave & 1)) == 0) {
    for (long i = F.gt; i < (long)NB * NCH * 128 + 128; i += F.NGT) { const int ch = (int)(i & 127) * 8, bc = (int)(i >> 7); const bool meta = bc >= NB * NCH;
        const size_t r0 = meta ? (size_t)RM0 : (size_t)bc * 64; const int nt = meta ? NMETA : 64; f32x4 H0 = {0.f, 0.f, 0.f, 0.f}, H1 = H0;
        if (!meta) { H0 = *(const f32x4*)(CIN + (size_t)bc * 1024 + ch); H1 = *(const f32x4*)(CIN + (size_t)bc * 1024 + ch + 4); }
        for (int t0 = 0; t0 < nt; t0 += 8) { v4u la[8], bx[8], gg[8];
#pragma unroll
            for (int t = 0; t < 8; ++t) { const size_t r = r0 + t0 + t; la[t] = *(const v4u*)(A + r * 1024 + ch); bx[t] = *(const v4u*)(BX + r * 1024 + ch); gg[t] = *(const v4u*)(G + r * 1024 + ch); }
#pragma unroll
            for (int t = 0; t < 8; ++t) { f32x4 l0, l1, b0, b1, g0, g1; unpack8(la[t], l0, l1); unpack8(bx[t], b0, b1); unpack8(gg[t], g0, g1);
#pragma unroll
                for (int j = 0; j < 4; ++j) { H0[j] = __expf(l0[j]) * H0[j] + b0[j]; H1[j] = __expf(l1[j]) * H1[j] + b1[j]; }
                *(v4u*)(AOUT + (r0 + t0 + t) * 1536 + ch) = pack8(g0 * H0, g1 * H1); } } }
      } else {
    { SsmTab T; int gcur = -1;
    for (int it = F.gw; it < NB * NCH * NG + NG; it += F.NGW) { const bool meta = it >= NB * NCH * NG; const int g = it % NG, bc = it / NG;
        if (g != gcur) { ssm_tab_load(T, ws, cre, cim, sd, g, F.lane); gcur = g; }
        float hr = 0.f, hi = 0.f; if (!meta) { const f32x2 s = ((const f32x2*)SSIN)[(size_t)it * NS + F.lane]; hr = s.x; hi = s.y; }
        ssm_wave(T, U, GS, g, meta ? RM0 : bc * 64, meta ? NMETA : 64, hr, hi, F.lane, F.lds + RING_OFF + F.wave * SSM_WLDS); } }
      }
    }
}
template <int NACC>
__device__ __forceinline__ void meta_tile(const Frame& F, const bf16* A16, int lda, int K, const bf16* const (&Brow)[NACC], int ldb, f32x4 (&out)[NACC]) {
    LAS f32x4* red = (LAS f32x4*)(F.lds + RING_OFF);
    const int lane = F.lane, fr = lane & 15, fq = lane >> 4, w = F.wave, ks = K / 8;
    f32x4 acc[NACC];
#pragma unroll
    for (int a = 0; a < NACC; ++a) acc[a] = (f32x4){0.f, 0.f, 0.f, 0.f};
    for (int k0 = w * ks; k0 < (w + 1) * ks; k0 += 32) {
        const bf16x8 af = *(const bf16x8*)(A16 + (size_t)fr * lda + k0 + 8 * fq);
#pragma unroll
        for (int a = 0; a < NACC; ++a) { const bf16x8 bfz = *(const bf16x8*)(Brow[a] + (size_t)fr * ldb + k0 + 8 * fq); acc[a] = __builtin_amdgcn_mfma_f32_16x16x32_bf16(bfz, af, acc[a], 0, 0, 0); } }
    __syncthreads();
#pragma unroll
    for (int a = 0; a < NACC; ++a) red[(w * NACC + a) * 64 + lane] = acc[a];
    __syncthreads();
#pragma unroll
    for (int a = 0; a < NACC; ++a) { f32x4 sacc = red[a * 64 + lane];
#pragma unroll
        for (int ww = 1; ww < 8; ++ww) sacc += red[(ww * NACC + a) * 64 + lane];
        out[a] = sacc; }
}
template <class Fn> __device__ __forceinline__ bf16x8 frag8(Fn f) { bf16x8 r;
#pragma unroll
    for (int j = 0; j < 8; ++j) r[j] = (short)f(j);
    return r; }
constexpr int GL_LB = 0, GL_QT = 32768, GL_KT = 50176, GL_KH = 67584, GL_VT = 86016, GL_GM = 120832, GL_BL = 121344, GL_SSQ = 121856;
constexpr int PQ = 136, PKH = 144, PV = 272, PATT = 72, POT = 264;
#define TR_FRAG(dst, base, off, rows4) do { v2u _lo, _hi; \
    asm volatile("ds_read_b64_tr_b16 %0, %2 offset:%c3\n\tds_read_b64_tr_b16 %1, %2 offset:%c4\n\ts_waitcnt lgkmcnt(0)" : "=&v"(_lo), "=&v"(_hi) : "v"(base), "i"(off), "i"((off) + (rows4)) : "memory"); \
    const v4u _w = {_lo.x, _lo.y, _hi.x, _hi.y}; dst = __builtin_bit_cast(bf16x8, _w); } while (0)
__device__ __forceinline__ unsigned lds_addr(const LAS void* p) { return (unsigned)(unsigned long)p; }
template <bool FINAL>
__device__ __forceinline__ void gla_item(const Frame& F, int b, int h, int s, const bf16* Q, const bf16* K, const bf16* V, const bf16* GATE, const float* LG, const float* gnorm, float* GDS, float* GAM, bf16* AOUT2) {
    LAS float* LB = (LAS float*)(F.lds + GL_LB); LAS bf16* ATT = (LAS bf16*)(F.lds + GL_LB);
    LAS bf16* QT = (LAS bf16*)(F.lds + GL_QT); LAS bf16* KT = (LAS bf16*)(F.lds + GL_KT); LAS bf16* KH = (LAS bf16*)(F.lds + GL_KH); LAS bf16* VT = (LAS bf16*)(F.lds + GL_VT);
    LAS float* GM = (LAS float*)(F.lds + GL_GM); LAS float* BL = (LAS float*)(F.lds + GL_BL); LAS float* SSQ = (LAS float*)(F.lds + GL_SSQ);
    const int tid = F.tid, w = F.wave, lane = F.lane, fr = lane & 15, h4 = lane >> 4, tq = fr >> 2, tp = fr & 3;
    const int bh = b * GH + h; const size_t sbase = ((size_t)(bh * NSEG + s) * 128) * 256;
    const unsigned vtr = lds_addr(VT) + (unsigned)((8 * h4 + tq) * PV + 32 * w + 4 * tp) * 2u;
    const unsigned ktr = lds_addr(KH) + (unsigned)((8 * h4 + tq) * PKH + 4 * tp) * 2u;
    f32x4 S[8][2];
#pragma unroll
    for (int kb = 0; kb < 8; ++kb)
#pragma unroll
        for (int vb = 0; vb < 2; ++vb)
#pragma unroll
            for (int r = 0; r < 4; ++r) S[kb][vb][r] = FINAL ? GDS[sbase + (size_t)(16 * kb + 4 * h4 + r) * 256 + 32 * w + 16 * vb + fr] : 0.f;
    float gsum = 0.f;
#pragma nounroll
    for (int c = 0; c < SEGC; ++c) {
        const size_t row0 = (size_t)b * SEQ + (size_t)(s * SEGC + c) * 64;
        int lz = 0; asm volatile("" : "+v"(lz));
        const int tidl = tid + lz, frl = fr + lz, h4l = h4 + lz;
#pragma unroll
        for (int j = 0; j < 4; ++j) { const int i = tidl + 512 * j, t = i >> 5, k4 = (i & 31) * 4; *(LAS f32x4*)(LB + t * 128 + k4) = *(const f32x4*)(LG + (row0 + t) * 512 + h * 128 + k4); }
        v4u kwr[2];
#pragma unroll
        for (int j = 0; j < 2; ++j) { const int i = tidl + 512 * j, t = i >> 4, k8 = (i & 15) * 8; const size_t go = (row0 + t) * 512 + h * 128 + k8; if (!FINAL) kwr[j] = *(const v4u*)(K + go); }
#pragma unroll
        for (int j = 0; j < 4; ++j) { const int i = tidl + 512 * j, t = i >> 5, c8 = (i & 31) * 8; *(LAS v4u*)(VT + t * PV + c8) = *(const v4u*)(V + (row0 + t) * 1024 + h * 256 + c8); }
        __syncthreads();
        if (tid < 128) { float run = 0.f;
#pragma unroll 8
            for (int t = 0; t < 64; ++t) { run += LB[t * 128 + tid]; LB[t * 128 + tid] = run; }
            BL[tid] = run; GM[tid] = __expf(run); gsum += run; }
        __syncthreads();
#pragma unroll
        for (int j = 0; j < 2; ++j) { const int i = tidl + 512 * j, t = i >> 4, k8 = (i & 15) * 8; const size_t go = (row0 + t) * 512 + h * 128 + k8;
            const v4u kw = FINAL ? *(const v4u*)(K + go) : kwr[j]; const float kv[8] = {bflo(kw.x), bfhi(kw.x), bflo(kw.y), bfhi(kw.y), bflo(kw.z), bfhi(kw.z), bflo(kw.w), bfhi(kw.w)};
            float bb[8], kh[8];
#pragma unroll
            for (int e = 0; e < 8; ++e) { bb[e] = LB[t * 128 + k8 + e]; kh[e] = kv[e] * __expf(BL[k8 + e] - bb[e]); }
            v4u o; o.x = pk2(kh[0], kh[1]); o.y = pk2(kh[2], kh[3]); o.z = pk2(kh[4], kh[5]); o.w = pk2(kh[6], kh[7]); *(LAS v4u*)(KH + t * PKH + k8) = o;
            if (FINAL) { const v4u qw = *(const v4u*)(Q + go); const float qv[8] = {bflo(qw.x), bfhi(qw.x), bflo(qw.y), bfhi(qw.y), bflo(qw.z), bfhi(qw.z), bflo(qw.w), bfhi(qw.w)};
                float qt[8], kt[8];
#pragma unroll
                for (int e = 0; e < 8; ++e) { qt[e] = qv[e] * __expf(bb[e]); kt[e] = kv[e] * __expf(-bb[e]); }
                v4u oq; oq.x = pk2(qt[0], qt[1]); oq.y = pk2(qt[2], qt[3]); oq.z = pk2(qt[4], qt[5]); oq.w = pk2(qt[6], qt[7]); *(LAS v4u*)(QT + t * PQ + k8) = oq;
                v4u ok; ok.x = pk2(kt[0], kt[1]); ok.y = pk2(kt[2], kt[3]); ok.z = pk2(kt[4], kt[5]); ok.w = pk2(kt[6], kt[7]); *(LAS v4u*)(KT + t * PQ + k8) = ok; } }
        __syncthreads();
        f32x4 o[4][2];
        if (FINAL) {
            { const int tb = w >> 1;
#pragma unroll
              for (int q = 0; q < 2; ++q) { const int sb = 2 * (w & 1) + q; f32x4 acc = {0.f, 0.f, 0.f, 0.f};
                if (sb <= tb) {
#pragma unroll
                    for (int ks = 0; ks < 4; ++ks) { const bf16x8 a = *(const LAS bf16x8*)(QT + (16 * tb + fr) * PQ + 32 * ks + 8 * h4), bq = *(const LAS bf16x8*)(KT + (16 * sb + fr) * PQ + 32 * ks + 8 * h4);
                        acc = __builtin_amdgcn_mfma_f32_16x16x32_bf16(a, bq, acc, 0, 0, 0); } }
#pragma unroll
                for (int r = 0; r < 4; ++r) { const int tl = 4 * h4 + r; const float val = (sb < tb || (sb == tb && fr <= tl)) ? acc[r] : 0.f; ATT[(16 * tb + tl) * PATT + 16 * sb + fr] = (bf16)f2bf(val); } } }
            __syncthreads();
#pragma unroll
            for (int tb = 0; tb < 4; ++tb)
#pragma unroll
                for (int vb = 0; vb < 2; ++vb) o[tb][vb] = (f32x4){0.f, 0.f, 0.f, 0.f};
#pragma unroll
            for (int ss = 0; ss < 2; ++ss) { bf16x8 bv[2];
#pragma unroll
                for (int vb = 0; vb < 2; ++vb) TR_FRAG(bv[vb], vtr, (32 * ss * PV + 16 * vb) * 2, 4 * PV * 2);
#pragma unroll
                for (int tb = 0; tb < 4; ++tb) { if (ss == 1 && tb < 2) continue;
                    const bf16x8 a = *(const LAS bf16x8*)(ATT + (16 * tb + fr) * PATT + 32 * ss + 8 * h4);
#pragma unroll
                    for (int vb = 0; vb < 2; ++vb) o[tb][vb] = __builtin_amdgcn_mfma_f32_16x16x32_bf16(a, bv[vb], o[tb][vb], 0, 0, 0); } }
#pragma unroll
            for (int i = 0; i < 4; ++i) { bf16x8 bs[2];
#pragma unroll
                for (int vb = 0; vb < 2; ++vb) { v4u wv; wv.x = pk2(S[2 * i][vb][0], S[2 * i][vb][1]); wv.y = pk2(S[2 * i][vb][2], S[2 * i][vb][3]); wv.z = pk2(S[2 * i + 1][vb][0], S[2 * i + 1][vb][1]); wv.w = pk2(S[2 * i + 1][vb][2], S[2 * i + 1][vb][3]); bs[vb] = __builtin_bit_cast(bf16x8, wv); }
#pragma unroll
                for (int tb = 0; tb < 4; ++tb) { const LAS bf16* qp = QT + (16 * tb + fr) * PQ + 32 * i + 4 * h4; const v2u a_lo = *(const LAS v2u*)qp, a_hi = *(const LAS v2u*)(qp + 16);
                    const v4u aw = {a_lo.x, a_lo.y, a_hi.x, a_hi.y}; const bf16x8 a = __builtin_bit_cast(bf16x8, aw);
#pragma unroll
                    for (int vb = 0; vb < 2; ++vb) o[tb][vb] = __builtin_amdgcn_mfma_f32_16x16x32_bf16(a, bs[vb], o[tb][vb], 0, 0, 0); } }
        }
        if (FINAL) {
#pragma unroll
            for (int tb = 0; tb < 4; ++tb)
#pragma unroll
                for (int r = 0; r < 4; ++r) { float q = o[tb][0][r] * o[tb][0][r] + o[tb][1][r] * o[tb][1][r];
                    q += __shfl_xor(q, 1); q += __shfl_xor(q, 2); q += __shfl_xor(q, 4); q += __shfl_xor(q, 8);
                    if (fr == 0) SSQ[w * 64 + 16 * tb + 4 * h4 + r] = q; }
            __syncthreads();
            { LAS bf16* OT = QT; const float gn0 = gnorm[h * 256 + 32 * w + frl], gn1 = gnorm[h * 256 + 32 * w + 16 + frl];
#pragma unroll
              for (int tb = 0; tb < 4; ++tb)
#pragma unroll
                for (int r = 0; r < 4; ++r) { const int t = 16 * tb + 4 * h4 + r; float tot = 0.f;
#pragma unroll
                    for (int ww = 0; ww < 8; ++ww) tot += SSQ[ww * 64 + t];
                    const float rstd = __builtin_amdgcn_rsqf(tot * (1.0f / 256.0f) + EPS);
                    OT[t * POT + 32 * w + fr] = (bf16)f2bf(o[tb][0][r] * rstd * gn0); OT[t * POT + 32 * w + 16 + fr] = (bf16)f2bf(o[tb][1][r] * rstd * gn1); asm volatile("" ::: "memory"); }
              __syncthreads();
#pragma unroll 2
              for (int j = 0; j < 4; ++j) { const int i = tidl + 512 * j, t = i >> 5, c8 = (i & 31) * 8; const size_t go = (row0 + t) * 1024 + h * 256 + c8;
                  f32x4 a0, a1, g0, g1; unpack8(*(const LAS v4u*)(OT + t * POT + c8), a0, a1); unpack8(*(const v4u*)(GATE + go), g0, g1); *(v4u*)(AOUT2 + go) = pack8(a0 * g0, a1 * g1); } }
        }
#pragma unroll
        for (int kb = 0; kb < 8; ++kb) { const f32x4 gm = *(const LAS f32x4*)(GM + 16 * kb + 4 * h4);
#pragma unroll
            for (int vb = 0; vb < 2; ++vb) S[kb][vb] = S[kb][vb] * gm; }
#pragma unroll
        for (int ts = 0; ts < 2; ++ts) { bf16x8 bv[2];
#pragma unroll
            for (int vb = 0; vb < 2; ++vb) TR_FRAG(bv[vb], vtr, (32 * ts * PV + 16 * vb) * 2, 4 * PV * 2);
#pragma unroll
            for (int kb = 0; kb < 8; ++kb) { bf16x8 a; TR_FRAG(a, ktr, (32 * ts * PKH + 16 * kb) * 2, 4 * PKH * 2);
#pragma unroll
                for (int vb = 0; vb < 2; ++vb) S[kb][vb] = __builtin_amdgcn_mfma_f32_16x16x32_bf16(a, bv[vb], S[kb][vb], 0, 0, 0); } }
        __syncthreads();
    }
    if (!FINAL) {
#pragma unroll
        for (int kb = 0; kb < 8; ++kb)
#pragma unroll
            for (int vb = 0; vb < 2; ++vb)
#pragma unroll
                for (int r = 0; r < 4; ++r) GDS[sbase + (size_t)(16 * kb + 4 * h4 + r) * 256 + 32 * w + 16 * vb + fr] = S[kb][vb][r];
        if (tid < 128) GAM[(size_t)(bh * NSEG + s) * 128 + tid] = __expf(gsum);
    }
}
__device__ __forceinline__ void gla_l2_phase(const Frame& F, const bf16* K, const bf16* V, const float* LG, float* GDS, const float* GAM) {
    for (long idx = F.gt; idx < (long)NB * GH * 128 * 64; idx += F.NGT) { const int v4 = (int)(idx & 63), k = (int)(idx >> 6) & 127, bh = (int)(idx >> 13), h = bh & 3;
        float bc[16]; float run = 0.f;
#pragma unroll
        for (int i = 0; i < NMETA; ++i) { run += LG[(size_t)(RM0 + i) * 512 + h * 128 + k]; bc[i] = run; }
        f32x4 carry = {0.f, 0.f, 0.f, 0.f};
#pragma unroll
        for (int i = 0; i < NMETA; ++i) { const float wk = __expf(run - bc[i]) * bf2f(K[(size_t)(RM0 + i) * 512 + h * 128 + k]); const v2u vw = *(const v2u*)(V + (size_t)(RM0 + i) * 1024 + h * 256 + 4 * v4);
            carry += (f32x4){bflo(vw.x), bfhi(vw.x), bflo(vw.y), bfhi(vw.y)} * wk; }
        f32x4 ds[NSEG]; float gm[NSEG];
#pragma unroll
        for (int s = 0; s < NSEG; ++s) { ds[s] = *(const f32x4*)(GDS + ((size_t)(bh * NSEG + s) * 128 + k) * 256 + 4 * v4); gm[s] = GAM[(size_t)(bh * NSEG + s) * 128 + k]; }
#pragma unroll
        for (int s = 0; s < NSEG; ++s) { *(f32x4*)(GDS + ((size_t)(bh * NSEG + s) * 128 + k) * 256 + 4 * v4) = carry; carry = carry * gm[s] + ds[s]; }
    }
}

__device__ __forceinline__ void router_phase(const Frame& F, const Args& a, unsigned char* ws) {
    const float* const* in = a.in; unsigned* ctl = (unsigned*)(ws + WS_CTL); bf16* HNM = (bf16*)(ws + WS_HNM); int* tokinfo = (int*)(ws + WS_TOKINFO);
    const float* gain = in[I_NORM_FFN1]; const float* RW = in[I_ROUTER]; const int lane = F.lane; const bf16* HB = (const bf16*)((const char*)a.out + 64 * MiB); unsigned char* HN8 = (unsigned char*)(ws + WS_HNM);
    LAS unsigned* cnt = (LAS unsigned*)(F.lds + TABL_OFF);
    if (F.tid < 32) cnt[F.tid] = 0u;
    __syncthreads();
    const int per = (TR + F.G - 1) / F.G, m0 = (int)blockIdx.x * per, m1 = (m0 + per < TR) ? m0 + per : TR;
    int my_e0 = 0, my_e1 = 0; unsigned my_p0 = 0, my_p1 = 0; float my_w0 = 0.f;
    int jt = 0;
    v4u nxa = {0u, 0u, 0u, 0u}, nxb = nxa; if (m0 + F.wave < m1) { const bf16* hr0 = HB + (size_t)(m0 + F.wave) * 1024; nxa = *(const v4u*)(hr0 + 8 * lane); nxb = *(const v4u*)(hr0 + 512 + 8 * lane); }
    for (int m = m0 + F.wave; m < m1; m += 8, ++jt) {
        f32x4 v[4]; unpack8(nxa, v[0], v[1]); unpack8(nxb, v[2], v[3]); float s = 0.f;
        if (m + 8 < m1) { const bf16* hr1 = HB + (size_t)(m + 8) * 1024; nxa = *(const v4u*)(hr1 + 8 * lane); nxb = *(const v4u*)(hr1 + 512 + 8 * lane); }
#pragma unroll
        for (int j = 0; j < 4; ++j) s += (v[j].x * v[j].x + v[j].y * v[j].y) + (v[j].z * v[j].z + v[j].w * v[j].w);
        const float rstd = 1.0f / sqrtf(wave_sum(s) * (1.0f / 1024.0f) + EPS);
        float p[8] = {0.f, 0.f, 0.f, 0.f, 0.f, 0.f, 0.f, 0.f};
        f32x4 yv[4];
#pragma unroll
        for (int j = 0; j < 4; ++j) { const int d0 = (j >> 1) * 512 + 8 * lane + (j & 1) * 4; const f32x4 g = *(const f32x4*)(gain + d0); const f32x4 y = v[j] * rstd * g; yv[j] = y;
#pragma unroll
            for (int e4 = 0; e4 < 4; ++e4) { const int d = d0 + e4; const f32x4 r0 = *(const f32x4*)(RW + d * 8), r1 = *(const f32x4*)(RW + d * 8 + 4);
#pragma unroll
                for (int e = 0; e < 4; ++e) { p[e] += y[e4] * r0[e]; p[4 + e] += y[e4] * r1[e]; } } }
        *(v2u*)(HN8 + (size_t)m * 1024 + 8 * lane) = (v2u){pk4_fp8(yv[0][0], yv[0][1], yv[0][2], yv[0][3]), pk4_fp8(yv[1][0], yv[1][1], yv[1][2], yv[1][3])};
        *(v2u*)(HN8 + (size_t)m * 1024 + 512 + 8 * lane) = (v2u){pk4_fp8(yv[2][0], yv[2][1], yv[2][2], yv[2][3]), pk4_fp8(yv[3][0], yv[3][1], yv[3][2], yv[3][3])};
        float q4[4];
#pragma unroll
        for (int i = 0; i < 4; ++i) { const bool up = (lane & 32) != 0; const float keep = up ? p[i + 4] : p[i], send = up ? p[i] : p[i + 4]; q4[i] = keep + __shfl_xor(send, 32); }
        float q2[2];
#pragma unroll
        for (int i = 0; i < 2; ++i) { const bool up = (lane & 16) != 0; const float keep = up ? q4[i + 2] : q4[i], send = up ? q4[i] : q4[i + 2]; q2[i] = keep + __shfl_xor(send, 16); }
        float y; { const bool up = (lane & 8) != 0; const float keep = up ? q2[1] : q2[0], send = up ? q2[0] : q2[1]; y = keep + __shfl_xor(send, 8); }
        y += __shfl_xor(y, 4); y += __shfl_xor(y, 2); y += __shfl_xor(y, 1);
        float lg[8];
#pragma unroll
        for (int e = 0; e < 8; ++e) lg[e] = __shfl(y, ((e >> 2) & 1) * 32 + ((e >> 1) & 1) * 16 + (e & 1) * 8);
        int i0 = 0; float v0 = lg[0];
#pragma unroll
        for (int e = 1; e < 8; ++e) if (lg[e] > v0) { v0 = lg[e]; i0 = e; }
        int i1 = -1; float v1 = -3.0e38f;
#pragma unroll
        for (int e = 0; e < 8; ++e) if (e != i0 && lg[e] > v1) { v1 = lg[e]; i1 = e; }
        if (i1 < 0) i1 = (i0 + 1) & 7;
        if (lane == jt) { my_e0 = i0; my_e1 = i1; my_w0 = 1.0f / (1.0f + __expf(v1 - v0)); my_p0 = atomicAdd((unsigned*)(cnt + i0), 1u); my_p1 = atomicAdd((unsigned*)(cnt + 8 + i1), 1u); }
    }
    __syncthreads();
    if (F.tid < 16) cnt[16 + F.tid] = __hip_atomic_fetch_add(ctl + CW_CNT + F.tid, cnt[F.tid], RLX_AGENT);
    __syncthreads();
    if (lane < jt) { const int m = m0 + F.wave + 8 * lane; const float w1 = 1.0f - my_w0;
        *(v4u*)(tokinfo + (size_t)m * 4) = (v4u){(unsigned)my_e0, cnt[16 + my_e0] + my_p0, __float_as_uint(my_w0), 0u};
        *(v4u*)(tokinfo + (size_t)(TR + m) * 4) = (v4u){(unsigned)my_e1, cnt[24 + my_e1] + my_p1, __float_as_uint(w1), 0u}; }
    LAS float* scr = (LAS float*)(F.lds + RING_OFF + F.wave * 16384);
    constexpr int IG = 16 * 112, ID = 56 * 32, IE = 2 * IG + ID;
    unsigned char* WGU = (unsigned char*)(ws + WS_WMOE); unsigned char* WD = WGU + (size_t)NE * 7168 * 1024;
    for (int it = F.gw; it < NE * IE; it += F.NGW) { const int e = it / IE; int r = it % IE;
        if (r < 2 * IG) { const int up = r >= IG; if (up) r -= IG; const int kb = r / 112, n0 = (r % 112) * 32;
            tr_item8((up ? in[I_MU] : in[I_MG]) + (size_t)e * 1024 * FFE, FFE, n0, kb * 64, WGU + (size_t)e * 7168 * 1024, 1024, (n0 >> 7) * 256 + (n0 & 127) + (up ? 128 : 0), 32.0f, scr, lane); }
        else { r -= 2 * IG; const int kb = r / 32, n0 = (r % 32) * 32; tr_item8(in[I_MD] + (size_t)e * FFE * 1024, 1024, n0, kb * 64, WD + (size_t)e * 1024 * FFE, FFE, n0, 64.0f, scr, lane); } }
}
__device__ __forceinline__ void moe_lists_phase(const Frame& F, unsigned char* ws) {
    unsigned* ctl = (unsigned*)(ws + WS_CTL); LAS int* L = (LAS int*)(F.lds + TABL_OFF);
    const int* tokinfo = (const int*)(ws + WS_TOKINFO); int* rowtok = (int*)(ws + WS_ROWTOK); float* roww = (float*)(ws + WS_ROWW);
    int* pexp = (int*)(ws + WS_TAB + TB_PEXP); int* npan = (int*)(ws + WS_TAB + TB_NPAN);
    if (F.tid < 16) L[F.tid] = (int)__hip_atomic_load(ctl + CW_CNT + F.tid, RLX_AGENT);
    __syncthreads();
    if (F.tid == 0) { for (int s = 0; s < 2; ++s) { int acc = 0; for (int e = 0; e < 8; ++e) { L[16 + s * 8 + e] = acc; acc += (L[s * 8 + e] + 255) & ~255; } L[32 + s] = acc >> 8; } }
    __syncthreads();
    if (blockIdx.x == 0) { if (F.tid < 2) npan[F.tid] = L[32 + F.tid];
        if (F.tid < 16) { const int s = F.tid >> 3, base = L[16 + F.tid], n = (L[F.tid] + 255) >> 8; for (int p = 0; p < n; ++p) pexp[s * MPAN + (base >> 8) + p] = F.tid & 7; } }
    for (long i = F.gt; i < 2L * TR; i += F.NGT) { const int s = (int)(i >= TR), tok = (int)(i - (long)s * TR); const v4u inf = *(const v4u*)(tokinfo + i * 4);
        const int row = L[16 + s * 8 + (int)inf.x] + (int)inf.y; rowtok[(size_t)s * MROWS + row] = tok; const unsigned wb = inf.z; roww[(size_t)s * MROWS + row] = __uint_as_float(wb); }
    for (long i = F.gt; i < 16L * 256; i += F.NGT) { const int se = (int)(i >> 8), r = (int)(i & 255), s = se >> 3, cnt = L[se], base = L[16 + se], pad = ((cnt + 255) & ~255) - cnt;
        if (r < pad) { rowtok[(size_t)s * MROWS + base + cnt + r] = -1; roww[(size_t)s * MROWS + base + cnt + r] = 0.f; } }
}

constexpr int N_PHASES = 25;
__global__ void __launch_bounds__(512, 2) mk_fwd(Args args) {
    extern __shared__ __attribute__((aligned(16))) unsigned char lds_raw[];
    Frame F; F.lds = (LAS unsigned char*)lds_raw; F.tid = threadIdx.x; F.lane = F.tid & 63; F.wave = __builtin_amdgcn_readfirstlane(F.tid >> 6); F.G = gridDim.x;
    F.gw = blockIdx.x * 8 + F.wave; F.NGW = F.G * 8; F.gt = (int)blockIdx.x * 512 + F.tid; F.NGT = F.G * 512;
    unsigned char* ws = args.ws; const float* const* in = args.in; float* out = args.out;
    volatile LAS unsigned* MISC = (volatile LAS unsigned*)(F.lds + MISC_OFF);
    if (F.tid < 32) MISC[F.tid] = 0u;
    __syncthreads();
#if !MK_PER_PHASE
    XcdBarrier bar = xcd_barrier_post((unsigned*)(ws + WS_CTL) + CW_BAR, MISC + 8);
#define GRID_BAR() xcd_barrier(bar)
#else
#define GRID_BAR() do { } while (0)
#endif
    const int lo = args.ph_lo, hi = args.ph_hi;
#ifndef MK_MASK
#define MK_MASK 0xFFFFFFFFu
#endif
#ifndef MK_STOP
#define MK_STOP 99
#endif
#define IN(k) ((((MK_MASK) >> (k)) & 1u) && ((k) <= MK_STOP || (k) == 24) && lo <= (k) && (k) < hi)
#define SEAM(k) do { if (IN(k) && IN((k) + 1)) GRID_BAR(); asm volatile("" : "+v"(F.tid), "+v"(F.lane), "+v"(F.gt)); } while (0)
    const int cu = (int)blockIdx.x;
    LAS unsigned char* ring = F.lds + RING_OFF;
    const LAS int* notab = (const LAS int*)(F.lds + TABL_OFF);
    float* hmeta = (float*)(ws + WS_HMETA);
    bf16* HB = (bf16*)((char*)out + 64 * MiB);
    bf16* HN = (bf16*)(ws + WS_HN);
    constexpr size_t P1K = (size_t)256 * 1024 * 2;

    if (IN(0)) { p0_prologue(F, args, ws); } SEAM(0);
    if (IN(1)) { SchedStatic S{NPR, 10, F.G, cu, (const char*)HN, (const char*)(ws + WS_WIN0), P1K, P1K, 0, 0}; EpiWin0 E{(bf16*)(ws + WS_G), (bf16*)(ws + WS_XRBX), (bf16*)(ws + WS_U)};
        pg8::gemm_phase<EpiWin0, SchedStatic, false>(ring, 1024, 1024, S, E, notab);
        for (int t = cu; t < EV_IN / 16; t += F.G) { const int n0 = t * 16; const bf16* const br[1] = {(const bf16*)(ws + WS_WIN0) + (size_t)n0 * 1024}; f32x4 o[1];
            meta_tile<1>(F, HN + (size_t)RM0 * 1024, 1024, 1024, br, 1024, o);
            if (F.wave == 0) { const int row = RM0 + (F.lane & 15), c = n0 + 4 * (F.lane >> 4); f32x4 v = o[0];
                if (c < 1024) { for (int j = 0; j < 4; ++j) v[j] = gelu_tanh(v[j]); *(v2u*)((bf16*)(ws + WS_G) + (size_t)row * 1024 + c) = (v2u){pk2(v[0], v[1]), pk2(v[2], v[3])}; }
                else if (c < 2048) *(v2u*)((bf16*)(ws + WS_XRBX) + (size_t)row * 1024 + c - 1024) = (v2u){pk2(v[0], v[1]), pk2(v[2], v[3])};
                else *(v2u*)((bf16*)(ws + WS_U) + (size_t)row * 512 + c - 2048) = (v2u){pk2(v[0], v[1]), pk2(v[2], v[3])}; } } } SEAM(1);
    if (IN(2)) { for (int pass = 0; pass < 2; ++pass) { if ((pass ^ (F.wave & 1)) == 0) conv_phase(F, (const bf16*)(ws + WS_XRBX), in[I_CONVW], in[I_CONVB], (bf16*)(ws + WS_XC)); else ssm_l1_phase(F, ws, (const bf16*)(ws + WS_U), (float*)(ws + WS_SSE)); } } SEAM(2);
    if (IN(3)) { SchedStatic S{NPR, 8, F.G, cu, (const char*)(ws + WS_XC), (const char*)(ws + WS_GW), P1K, (size_t)256 * 256 * 2, 2, (size_t)256 * 2};
        EpiGates E{in[I_GAB], in[I_GXB], (const float*)(ws + WS_TAB + TB_SP8), (const bf16*)(ws + WS_XC), (bf16*)(ws + WS_A), (bf16*)(ws + WS_XRBX)};
        pg8::gemm_phase<EpiGates, SchedStatic, false>(ring, 256, 1024, S, E, notab);
        for (int t = cu; t < 64; t += F.G) { const int ch0 = t * 16, h = ch0 >> 8, cl = ch0 & 255;
            const bf16* gwb = (const bf16*)(ws + WS_GW) + (size_t)h * 512 * 256 + (size_t)((cl >> 7) * 256 + (cl & 127)) * 256; const bf16* const br[2] = {gwb, gwb + 128 * 256}; f32x4 o[2];
            meta_tile<2>(F, (const bf16*)(ws + WS_XC) + (size_t)RM0 * 1024 + h * 256, 1024, 256, br, 256, o);
            if (F.wave == 0) { const int row = RM0 + (F.lane & 15), ch = ch0 + 4 * (F.lane >> 4); const size_t ro = (size_t)row * 1024 + ch;
                const f32x4 ba = *(const f32x4*)(in[I_GAB] + ch), bx = *(const f32x4*)(in[I_GXB] + ch), sp = *(const f32x4*)((const float*)(ws + WS_TAB + TB_SP8) + ch);
                const v2u xw = *(const v2u*)((const bf16*)(ws + WS_XC) + ro); const float xv[4] = {bflo(xw.x), bfhi(xw.x), bflo(xw.y), bfhi(xw.y)}; f32x4 av, bv;
                for (int j = 0; j < 4; ++j) { const float r = sigmoidf_(o[0][j] + ba[j]), ig = sigmoidf_(o[1][j] + bx[j]), la = -r * sp[j]; av[j] = la; bv[j] = __builtin_amdgcn_sqrtf(fmaxf(one_minus_exp(2.0f * la), 0.0f)) * ig * xv[j]; }
                *(v2u*)((bf16*)(ws + WS_A) + ro) = (v2u){pk2(av[0], av[1]), pk2(av[2], av[3])}; *(v2u*)((bf16*)(ws + WS_XRBX) + ro) = (v2u){pk2(bv[0], bv[1]), pk2(bv[2], bv[3])}; } } } SEAM(3);
    if (IN(4)) { lru_l1_phase(F, (const bf16*)(ws + WS_A), (const bf16*)(ws + WS_XRBX), (float*)(ws + WS_PEND), (float*)(ws + WS_HEND)); } SEAM(4);
    if (IN(5)) { carry_phase(F, ws, (const bf16*)(ws + WS_A), (const bf16*)(ws + WS_XRBX), (const float*)(ws + WS_PEND), (const float*)(ws + WS_HEND), (float*)(ws + WS_CIN), (const bf16*)(ws + WS_U), (const float*)(ws + WS_SSE), (float*)(ws + WS_SSIN)); } SEAM(5);
    if (IN(6)) { mix0_final_phase(F, ws, (const bf16*)(ws + WS_A), (const bf16*)(ws + WS_XRBX), (const float*)(ws + WS_CIN), (const bf16*)(ws + WS_G), (bf16*)(ws + WS_AOUT), in[I_CRE], in[I_CIM], in[I_SD], (const bf16*)(ws + WS_U), (const float*)(ws + WS_SSIN), (bf16*)(ws + WS_GS)); } SEAM(6);
    if (IN(7)) { SchedStatic S{NPR, 2, F.G, cu, (const char*)(ws + WS_GS), (const char*)(ws + WS_GLUW), (size_t)256 * 512 * 2, (size_t)256 * 512 * 2, 0, 0}; EpiGlu E{in[I_GLUB], (const bf16*)(ws + WS_GS), (bf16*)(ws + WS_AOUT)};
        pg8::gemm_phase<EpiGlu, SchedStatic, false>(ring, 512, 512, S, E, notab);
        for (int t = cu; t < 32; t += F.G) { const int n0 = t * 16; const bf16* const br[1] = {(const bf16*)(ws + WS_GLUW) + (size_t)n0 * 512}; f32x4 o[1];
            meta_tile<1>(F, (const bf16*)(ws + WS_GS) + (size_t)RM0 * 512, 512, 512, br, 512, o);
            if (F.wave == 0) { const int row = RM0 + (F.lane & 15), c = n0 + 4 * (F.lane >> 4); const f32x4 b = *(const f32x4*)(in[I_GLUB] + c);
                const v2u gw = *(const v2u*)((const bf16*)(ws + WS_GS) + (size_t)row * 512 + c); const float gv[4] = {bflo(gw.x), bfhi(gw.x), bflo(gw.y), bfhi(gw.y)}; float v[4];
                for (int j = 0; j < 4; ++j) v[j] = gv[j] * sigmoidf_(o[0][j] + b[j]);
                *(v2u*)((bf16*)(ws + WS_AOUT) + (size_t)row * 1536 + 1024 + c) = (v2u){pk2(v[0], v[1]), pk2(v[2], v[3])}; } } } SEAM(7);
    if (IN(8)) { SchedStatic S{NPR, 4, F.G, cu, (const char*)(ws + WS_AOUT), (const char*)(ws + WS_WOUT0), (size_t)256 * 1536 * 2, (size_t)256 * 1536 * 2, 0, 0}; EpiResid E{in[I_X], HB};
        pg8::gemm_phase<EpiResid, SchedStatic, false>(ring, 1536, 1536, S, E, notab);
        for (int t = cu; t < 64; t += F.G) { const int n0 = t * 16; const bf16* const br[1] = {(const bf16*)(ws + WS_WOUT0) + (size_t)n0 * 1536}; f32x4 o[1];
            meta_tile<1>(F, (const bf16*)(ws + WS_AOUT) + (size_t)RM0 * 1536, 1536, 1536, br, 1536, o);
            if (F.wave == 0) { float* p = hmeta + (size_t)(F.lane & 15) * 1024 + n0 + 4 * (F.lane >> 4); *(f32x4*)p = *(const f32x4*)p + o[0]; } } } SEAM(8);
    if (IN(9)) { norm_phase(F, HB, hmeta, in[I_NORM_FFN0], HN, TR + NMETA); } SEAM(9);
    if (IN(10)) { SchedStatic S{NPR, 24, F.G, cu, (const char*)HN, (const char*)(ws + WS_WUP0), P1K, P1K, 0, 0}; EpiSwiglu E{(bf16*)(ws + WS_HID0), FF0};
        pg8::gemm_phase<EpiSwiglu, SchedStatic, false>(ring, 1024, 1024, S, E, notab);
        for (int t = cu; t < FF0 / 16; t += F.G) { const int u0 = t * 16; const bf16* gb = (const bf16*)(ws + WS_WUP0) + (size_t)((u0 >> 7) * 256 + (u0 & 127)) * 1024; const bf16* const br[2] = {gb, gb + 128 * 1024}; f32x4 o[2];
            meta_tile<2>(F, HN + (size_t)RM0 * 1024, 1024, 1024, br, 1024, o);
            if (F.wave == 0) { const int row = RM0 + (F.lane & 15), c = u0 + 4 * (F.lane >> 4); float v[4]; for (int j = 0; j < 4; ++j) v[j] = siluf_(o[0][j]) * o[1][j];
                *(v2u*)((bf16*)(ws + WS_HID0) + (size_t)row * FF0 + c) = (v2u){pk2(v[0], v[1]), pk2(v[2], v[3])}; } } } SEAM(10);
    if (IN(11)) { SchedStatic S{NPR, 4, F.G, cu, (const char*)(ws + WS_HID0), (const char*)(ws + WS_WDN0), (size_t)256 * FF0 * 2, (size_t)256 * FF0 * 2, 0, 0}; EpiResid E{nullptr, HB};
        pg8::gemm_phase<EpiResid, SchedStatic, false>(ring, FF0, FF0, S, E, notab);
        for (int t = cu; t < 64; t += F.G) { const int n0 = t * 16; const bf16* const br[1] = {(const bf16*)(ws + WS_WDN0) + (size_t)n0 * FF0}; f32x4 o[1];
            meta_tile<1>(F, (const bf16*)(ws + WS_HID0) + (size_t)RM0 * FF0, FF0, FF0, br, FF0, o);
            if (F.wave == 0) { float* p = hmeta + (size_t)(F.lane & 15) * 1024 + n0 + 4 * (F.lane >> 4); *(f32x4*)p = *(const f32x4*)p + o[0]; } } } SEAM(11);
    if (IN(12)) { norm_phase(F, HB, hmeta, in[I_NORM_MIX1], HN, TR + NMETA); } SEAM(12);
    if (IN(13)) { SchedStatic S{NPR, 14, F.G, cu, (const char*)HN, (const char*)(ws + WS_WIN1), P1K, P1K, 0, 0}; EpiWin1 E{(bf16*)(ws + WS_Q), (bf16*)(ws + WS_K), (bf16*)(ws + WS_V), (bf16*)(ws + WS_GATE), (float*)(ws + WS_LG), in[I_GB]};
        pg8::gemm_phase<EpiWin1, SchedStatic, false>(ring, 1024, 1024, S, E, notab);
        for (int t = cu; t < 128; t += F.G) { const int n0 = t < 32 ? 512 + t * 16 : (t < 96 ? 1024 + (t - 32) * 16 : 3072 + (t - 96) * 16); const bf16* const br[1] = {(const bf16*)(ws + WS_WIN1) + (size_t)n0 * 1024}; f32x4 o[1];
            meta_tile<1>(F, HN + (size_t)RM0 * 1024, 1024, 1024, br, 1024, o);
            if (F.wave == 0) { const int row = RM0 + (F.lane & 15), c = n0 + 4 * (F.lane >> 4); const f32x4 v = o[0];
                if (c < 1024) *(v2u*)((bf16*)(ws + WS_K) + (size_t)row * 512 + c - 512) = (v2u){pk2(v[0], v[1]), pk2(v[2], v[3])};
                else if (c < 2048) *(v2u*)((bf16*)(ws + WS_V) + (size_t)row * 1024 + c - 1024) = (v2u){pk2(v[0], v[1]), pk2(v[2], v[3])};
                else { const f32x4 b = *(const f32x4*)(in[I_GB] + c - 3072); f32x4 l; for (int j = 0; j < 4; ++j) l[j] = logsigmoidf_(v[j] + b[j]) * 0.0625f; *(f32x4*)((float*)(ws + WS_LG) + (size_t)row * 512 + c - 3072) = l; } } } } SEAM(13);
    if (IN(14)) { for (int it = cu; it < NB * GH * NSEG; it += F.G) gla_item<false>(F, it >> 6, (it >> 4) & 3, it & 15, (const bf16*)(ws + WS_Q), (const bf16*)(ws + WS_K), (const bf16*)(ws + WS_V), (const bf16*)(ws + WS_GATE), (const float*)(ws + WS_LG), in[I_GNORM], (float*)(ws + WS_GDS), (float*)(ws + WS_TAB + TB_GAM), (bf16*)(ws + WS_AOUT2)); } SEAM(14);
    if (IN(15)) { gla_l2_phase(F, (const bf16*)(ws + WS_K), (const bf16*)(ws + WS_V), (const float*)(ws + WS_LG), (float*)(ws + WS_GDS), (const float*)(ws + WS_TAB + TB_GAM)); } SEAM(15);
    if (IN(16)) { for (int it = cu; it < NB * GH * NSEG; it += F.G) gla_item<true>(F, it >> 6, (it >> 4) & 3, it & 15, (const bf16*)(ws + WS_Q), (const bf16*)(ws + WS_K), (const bf16*)(ws + WS_V), (const bf16*)(ws + WS_GATE), (const float*)(ws + WS_LG), in[I_GNORM], (float*)(ws + WS_GDS), (float*)(ws + WS_TAB + TB_GAM), (bf16*)(ws + WS_AOUT2)); } SEAM(16);
    if (IN(17)) { SchedStatic S{NPR, 4, F.G, cu, (const char*)(ws + WS_AOUT2), (const char*)(ws + WS_WOUT1), P1K, P1K, 0, 0}; EpiResid E{nullptr, HB};
        pg8::gemm_phase<EpiResid, SchedStatic, false>(ring, 1024, 1024, S, E, notab); } SEAM(17);
    if (IN(18)) { router_phase(F, args, ws); } SEAM(18);
    if (IN(19)) { moe_lists_phase(F, ws); } SEAM(19);
#define MOE_PHASES(pu, pd, slot) \
    if (IN(pu)) { const int np = ((const int*)(ws + WS_TAB + TB_NPAN))[slot], nun = np * 28; LAS int* meta = (LAS int*)(F.lds + TABL_OFF); LAS int* tokt = (LAS int*)(F.lds + TABL_OFF + 512); \
        const int* pexp = (const int*)(ws + WS_TAB + TB_PEXP) + (slot) * MPAN; const int* rowtok = (const int*)(ws + WS_ROWTOK) + (size_t)(slot) * MROWS; int nmy = 0; \
        __syncthreads(); \
        for (int i = 0; (long)i * F.G + cu < nun && i < 20; ++i) { const int Lq = i * F.G + cu, p = Lq / 28, n = Lq % 28; if (F.tid == 0) { meta[i * 4] = p; meta[i * 4 + 1] = n; meta[i * 4 + 2] = pexp[p]; meta[i * 4 + 3] = 0; } \
            if (F.tid < 256) tokt[i * 256 + F.tid] = rowtok[p * 256 + F.tid]; ++nmy; } \
        __syncthreads(); \
          \
        SchedList S{nmy, meta, (const char*)(ws + WS_HNM), (const char*)(ws + WS_WMOE), 0, (size_t)256 * 1024, (size_t)7168 * 1024}; EpiSwiglu8 E{(unsigned char*)(ws + WS_HIDM), FFE}; \
        pg8::gemm_phase<EpiSwiglu8, SchedList, true, true>(ring, 512, 512, S, E, tokt); } SEAM(pu); \
    if (IN(pd)) { const int np = ((const int*)(ws + WS_TAB + TB_NPAN))[slot], nun = np * 4, nfull = nun < 512 ? nun : 512, nrem = nun - nfull; LAS int* meta = (LAS int*)(F.lds + TABL_OFF); LAS int* tokt = (LAS int*)(F.lds + TABL_OFF + 512); LAS float* wtt = (LAS float*)(F.lds + TABL_OFF + 512 + 4096); \
        const int* pexp = (const int*)(ws + WS_TAB + TB_PEXP) + (slot) * MPAN; const int* rowtok = (const int*)(ws + WS_ROWTOK) + (size_t)(slot) * MROWS; const float* roww = (const float*)(ws + WS_ROWW) + (size_t)(slot) * MROWS; int nmy = 0; \
        __syncthreads(); \
        for (int i = 0; (long)i * F.G + cu < nfull && i < 3; ++i) { const int Lq = i * F.G + cu, p = Lq / 4, n = Lq % 4; if (F.tid == 0) { meta[i * 4] = p; meta[i * 4 + 1] = n; meta[i * 4 + 2] = pexp[p]; meta[i * 4 + 3] = 0; } \
            if (F.tid < 256) { tokt[i * 256 + F.tid] = rowtok[p * 256 + F.tid]; wtt[i * 256 + F.tid] = roww[p * 256 + F.tid]; } ++nmy; } \
        const bool slice = cu < nrem * 7;                   \
        if (slice && F.tid == 0) { const int Lq = 512 + cu / 7, p = Lq / 4, n = Lq % 4; meta[12] = p; meta[13] = n; meta[14] = pexp[p]; meta[15] = (cu % 7) * 256; } \
        __syncthreads(); \
        { SchedList S{nmy, meta, (const char*)(ws + WS_HIDM), (const char*)(ws + WS_WMOE) + (size_t)NE * 7168 * 1024, (size_t)256 * FFE, (size_t)256 * FFE, (size_t)1024 * FFE}; EpiMoeDown E{HB, tokt, wtt}; \
          pg8::gemm_phase<EpiMoeDown, SchedList, false, true>(ring, FFE / 2, FFE / 2, S, E, tokt); } \
        { SchedList S{slice ? 1 : 0, meta + 12, (const char*)(ws + WS_HIDM), (const char*)(ws + WS_WMOE) + (size_t)NE * 7168 * 1024, (size_t)256 * FFE, (size_t)256 * FFE, (size_t)1024 * FFE}; EpiSlab E{(float*)(ws + WS_SLAB), meta + 12}; \
          pg8::gemm_phase<EpiSlab, SchedList, false, true>(ring, 256, FFE / 2, S, E, tokt, FFE / 2); } } SEAM(pd);
    MOE_PHASES(20, 21, 0)
    if (IN(22)) { const int np0 = ((const int*)(ws + WS_TAB + TB_NPAN))[0]; const int nrow = (np0 - 128) * 256; const float* slab = (const float*)(ws + WS_SLAB); const int* rowtok = (const int*)(ws + WS_ROWTOK); const float* roww = (const float*)(ws + WS_ROWW);
        for (long i = F.gt; i < (long)nrow * 128; i += F.NGT) { const int r = (int)(i >> 7), c8 = (int)(i & 127) * 8; const int tok = rowtok[TR + r];
            if (tok >= 0) { const float w = roww[TR + r]; f32x4 s0 = *(const f32x4*)(slab + (size_t)r * 1024 + c8), s1 = *(const f32x4*)(slab + (size_t)r * 1024 + c8 + 4);
#pragma unroll
                for (int sl = 1; sl < 7; ++sl) { s0 += *(const f32x4*)(slab + ((size_t)sl * 2048 + r) * 1024 + c8); s1 += *(const f32x4*)(slab + ((size_t)sl * 2048 + r) * 1024 + c8 + 4); }
                bf16* d = HB + (size_t)tok * 1024 + c8; f32x4 v0, v1; unpack8(*(const v4u*)d, v0, v1); *(v4u*)d = pack8(v0 + s0 * w, v1 + s1 * w); } } }
    MOE_PHASES(22, 23, 1)
    if (IN(24)) { LAS int* Lb = (LAS int*)(F.lds + TABL_OFF); const unsigned* ctl_ = (const unsigned*)(ws + WS_CTL);
        __syncthreads();
        if (F.tid == 0) { int acc = 0; for (int e = 0; e < 8; ++e) { Lb[e] = acc; acc += ((int)__hip_atomic_load(ctl_ + CW_CNT + 8 + e, RLX_AGENT) + 255) & ~255; } }
        __syncthreads();
        const int* tokinfo1 = (const int*)(ws + WS_TOKINFO) + (size_t)TR * 4; const float* slab = (const float*)(ws + WS_SLAB); const float* fg = in[I_FNORM]; const int lane = F.lane;
        const f32x4 g0 = *(const f32x4*)(fg + 8 * lane), g1 = *(const f32x4*)(fg + 8 * lane + 4), g2 = *(const f32x4*)(fg + 512 + 8 * lane), g3 = *(const f32x4*)(fg + 512 + 8 * lane + 4);
#define FIN_ROW(m, wa, wb) do { f32x4 v[4]; unpack8(wa, v[0], v[1]); unpack8(wb, v[2], v[3]); \
            { const v4u inf = *(const v4u*)(tokinfo1 + (size_t)(m) * 4); const unsigned ex = inf.x, ps = inf.y, wbits = inf.z; const int r1 = Lb[ex] + (int)ps - TR; \
              if (r1 >= 0) { const float w = __uint_as_float(wbits); \
                _Pragma("unroll") for (int sl = 0; sl < 7; ++sl) { const float* sp = slab + ((size_t)sl * 2048 + r1) * 1024; \
                    v[0] += *(const f32x4*)(sp + 8 * lane) * w; v[1] += *(const f32x4*)(sp + 8 * lane + 4) * w; v[2] += *(const f32x4*)(sp + 512 + 8 * lane) * w; v[3] += *(const f32x4*)(sp + 512 + 8 * lane + 4) * w; } } } \
            float s_ = 0.f; _Pragma("unroll") for (int j = 0; j < 4; ++j) s_ += (v[j].x * v[j].x + v[j].y * v[j].y) + (v[j].z * v[j].z + v[j].w * v[j].w); \
            const float rstd = 1.0f / sqrtf(wave_sum(s_) * (1.0f / 1024.0f) + EPS); float* orow = out + (size_t)(m) * 1024; \
            *(f32x4*)(orow + 8 * lane) = v[0] * rstd * g0; *(f32x4*)(orow + 8 * lane + 4) = v[1] * rstd * g1; *(f32x4*)(orow + 512 + 8 * lane) = v[2] * rstd * g2; *(f32x4*)(orow + 512 + 8 * lane + 4) = v[3] * rstd * g3; } while (0)
        for (int m = F.gw; m < TR / 2; m += 2 * F.NGW) { const int m2 = m + F.NGW; const v4u wa = *(const v4u*)(HB + (size_t)m * 1024 + 8 * lane), wb = *(const v4u*)(HB + (size_t)m * 1024 + 512 + 8 * lane);
            v4u wc = wa, wd = wb; if (m2 < TR / 2) { wc = *(const v4u*)(HB + (size_t)m2 * 1024 + 8 * lane); wd = *(const v4u*)(HB + (size_t)m2 * 1024 + 512 + 8 * lane); }
            FIN_ROW(m, wa, wb); if (m2 < TR / 2) FIN_ROW(m2, wc, wd); }
        v4u ra[8], rb[8];
        for (int base = TR / 2; base < TR; base += 8 * F.NGW) {
#pragma unroll
            for (int j = 0; j < 8; ++j) { const int m = base + F.gw + j * F.NGW; if (m < TR) { ra[j] = *(const v4u*)(HB + (size_t)m * 1024 + 8 * lane); rb[j] = *(const v4u*)(HB + (size_t)m * 1024 + 512 + 8 * lane); } }
            GRID_BAR();
#pragma unroll
            for (int j = 0; j < 8; ++j) { const int m = base + F.gw + j * F.NGW; if (m < TR) FIN_ROW(m, ra[j], rb[j]); }
        }
#undef FIN_ROW
    }
#undef IN
#undef SEAM
}

extern "C" void kernel_launch(void* const* d_in, const int* in_sizes, int n_in, void* d_out, int out_size, void* d_ws, size_t ws_size, hipStream_t stream) {
    static int grid = 0;
    if (grid == 0) {
        if (n_in != 38 || out_size != TR * D || ws_size < WS_END) { fprintf(stderr, "kernel_launch: unexpected problem shape (n_in %d, out %d, ws %zu); nothing launched\n", n_in, out_size, ws_size); grid = -1; return; }
        int dev = 0, cus = 0, per_cu = 0;
        if (hipGetDevice(&dev) != hipSuccess || hipDeviceGetAttribute(&cus, hipDeviceAttributeMultiprocessorCount, dev) != hipSuccess) { grid = -1; return; }
        if (hipFuncSetAttribute((const void*)mk_fwd, hipFuncAttributeMaxDynamicSharedMemorySize, LDS_BYTES) != hipSuccess) { fprintf(stderr, "kernel_launch: hipFuncSetAttribute failed\n"); grid = -1; return; }
        if (hipOccupancyMaxActiveBlocksPerMultiprocessor(&per_cu, (const void*)mk_fwd, 512, LDS_BYTES) != hipSuccess || per_cu < 1) fprintf(stderr, "kernel_launch: note: occupancy query reports %d workgroups per CU\n", per_cu);
        (void)hipGetLastError();
        grid = cus;
    }
    if (grid < 0) return;
    (void)hipMemsetAsync((char*)d_ws + WS_CTL, 0, CTL_ZERO_BYTES, stream);
    Args a{};
    for (int i = 0; i < 38; ++i) a.in[i] = (const float*)d_in[i];
    a.out = (float*)d_out; a.ws = (unsigned char*)d_ws; a.li = 0; a.pad = 0;
#if MK_PER_PHASE
    for (int k = 0; k < N_PHASES; ++k) { a.ph_lo = k; a.ph_hi = k + 1; hipLaunchKernelGGL(mk_fwd, dim3(grid), dim3(512), LDS_BYTES, stream, a); }
#else
    a.ph_lo = 0; a.ph_hi = N_PHASES; hipLaunchKernelGGL(mk_fwd, dim3(grid), dim3(512), LDS_BYTES, stream, a);
#endif
}
```

```cpp
#include <hip/hip_runtime.h>
#include <cstdio>
#include <cstdint>

#ifndef MK_PER_PHASE
#define MK_PER_PHASE 0
#endif

#define GAS __attribute__((address_space(1)))
#define LAS __attribute__((address_space(3)))
typedef unsigned short bf16;
typedef unsigned v4u __attribute__((ext_vector_type(4)));
typedef unsigned v2u __attribute__((ext_vector_type(2)));
typedef float f32x4 __attribute__((ext_vector_type(4)));
typedef float f32x2 __attribute__((ext_vector_type(2)));
typedef short bf16x8 __attribute__((ext_vector_type(8)));

constexpr int D = 1024, NB = 4, SEQ = 8192, NMETA = 16;
constexpr int TR = NB * SEQ;
constexpr int RM0 = TR;
constexpr int NPR = 128, NPA = 129;
constexpr int RALL = NPA * 256;
constexpr int LRUW = 1024, SSMW = 512, NG = 32, NS = 64, EV_IN = 2560, EV_MIX = 1536, FF0 = 3072;
constexpr int GK = 512, GV = 1024, GH = 4, GDK = 128, GDV = 256, OD_INP = 3584  , OD_IN = 3088;
constexpr int MOE_HP1 = 228;
constexpr int NE = 8, FFE = 3584, MROWS = 34816  , MPAN = 136;
constexpr float EPS = 1e-6f;
constexpr int NCH = 128;
constexpr int NSEG = 16, SEGC = 8;

constexpr size_t MiB = 1u << 20;
constexpr size_t WS_CTL = 0, CTL_ZERO_BYTES = 32768;
constexpr size_t WS_TAB = 1 * MiB;
constexpr size_t WS_WIN0 = 2 * MiB, WS_GW = 7 * MiB, WS_GLUW = 8 * MiB, WS_WOUT0 = 9 * MiB, WS_WUP0 = 12 * MiB, WS_WDN0 = 24 * MiB, WS_WIN1 = 30 * MiB, WS_WOUT1 = 37 * MiB;
constexpr size_t WS_PEND = 40 * MiB, WS_HEND = 42 * MiB, WS_CIN = 44 * MiB, WS_SSE = 46 * MiB, WS_SSIN = 54 * MiB, WS_GDS = 62 * MiB, WS_HMETA = 94 * MiB;
constexpr size_t WS_G = 96 * MiB, WS_U = 161 * MiB, WS_A = 194 * MiB, WS_XRBX = 323 * MiB, WS_HN = 388 * MiB, WS_AOUT = 388 * MiB, WS_XC = 453 * MiB, WS_GS = 485 * MiB;
constexpr size_t WS_HID0 = 96 * MiB;
constexpr size_t WS_WE = 62 * MiB;
constexpr size_t WS_Q = 95 * MiB, WS_K = 128 * MiB, WS_V = 161 * MiB, WS_GATE = 226 * MiB, WS_LG = 291 * MiB  , WS_AOUT2 = 453 * MiB;
constexpr size_t WS_HB = 323 * MiB + 512 * 1024;
constexpr size_t WS_SSQP = 518 * MiB  , WS_MPRIV = 520 * MiB  ;
constexpr size_t WS_SLAB = 2 * MiB  , WS_HNM = 72 * MiB  , WS_WMOE = 105 * MiB  , WS_HIDM = 189 * MiB  , WS_TOKINFO = 511 * MiB, WS_RELTOK = 513 * MiB  , WS_RELW = 515 * MiB  , WS_ROWTOK = 512 * MiB, WS_ROWW = 512 * MiB + 512 * 1024, WS_END = 528 * MiB;
constexpr size_t TB_BBR = 0, TB_BBI = 131072, TB_AR = 262144, TB_AI = 270336, TB_AR64 = 278528, TB_AI64 = 286720, TB_SP8 = 294912, TB_GAM = 299008  , TB_PEXP = 430080  , TB_NPAN = 432128;
constexpr int CW_TMO = 0, CW_CODE = 1, CW_CNT = 64  , CW_BAR = 4096;

constexpr int RING_OFF = 0, RING_BYTES = 131072;
constexpr int TABL_OFF = RING_BYTES, TABL_BYTES = 24576;
constexpr int MISC_OFF = TABL_OFF + TABL_BYTES;
constexpr int LDS_BYTES = MISC_OFF + 128;

#define RLX_AGENT __ATOMIC_RELAXED, __HIP_MEMORY_SCOPE_AGENT
#define LDS_WAIT() asm volatile("s_waitcnt lgkmcnt(0)" ::: "memory")
#define VM_WAIT() asm volatile("s_waitcnt vmcnt(0)" ::: "memory")
__device__ __forceinline__ unsigned f2bf(float f) { unsigned u = __builtin_bit_cast(unsigned, f); return (u + 0x7fffu + ((u >> 16) & 1u)) >> 16; }
__device__ __forceinline__ unsigned pk2(float lo, float hi) { unsigned r; asm("v_cvt_pk_bf16_f32 %0, %1, %2" : "=v"(r) : "v"(lo), "v"(hi)); return r; }
typedef int v8i __attribute__((ext_vector_type(8)));
typedef int v4i __attribute__((ext_vector_type(4)));
__device__ __forceinline__ unsigned pk4_fp8(float a, float b, float c, float d) { int w = 0; w = __builtin_amdgcn_cvt_pk_fp8_f32(a, b, w, false); w = __builtin_amdgcn_cvt_pk_fp8_f32(c, d, w, true); return (unsigned)w; }
__device__ __forceinline__ float bf2f(unsigned b) { return __builtin_bit_cast(float, b << 16); }
__device__ __forceinline__ float bflo(unsigned w) { return __builtin_bit_cast(float, w << 16); }
__device__ __forceinline__ float bfhi(unsigned w) { return __builtin_bit_cast(float, w & 0xffff0000u); }
__device__ __forceinline__ float rcpf_(float x) { return __builtin_amdgcn_rcpf(x); }
__device__ __forceinline__ float sigmoidf_(float x) { return rcpf_(1.0f + __expf(-x)); }
__device__ __forceinline__ float siluf_(float x) { return x * rcpf_(1.0f + __expf(-x)); }
__device__ __forceinline__ f32x4 exp2_4(f32x4 a) { f32x4 t; _Pragma("unroll") for (int j = 0; j < 4; ++j) t[j] = __builtin_amdgcn_exp2f(a[j]); return t; }
__device__ __forceinline__ f32x4 rcp_4(f32x4 a) { f32x4 t; _Pragma("unroll") for (int j = 0; j < 4; ++j) t[j] = __builtin_amdgcn_rcpf(a[j]); return t; }
__device__ __forceinline__ f32x4 sigmoid_4(f32x4 x) { return rcp_4(exp2_4(x * -1.4426950408889634f) + 1.0f); }
__device__ __forceinline__ f32x4 silu_4(f32x4 x) { return x * sigmoid_4(x); }
__device__ __forceinline__ f32x4 gelu_tanh_4(f32x4 x) { const f32x4 x2 = x * x, u = x * (x2 * (0.044715f * 0.7978845608028654f * -2.0f * 1.4426950408889634f) + (0.7978845608028654f * -2.0f * 1.4426950408889634f)); return x * rcp_4(exp2_4(u) + 1.0f); }
__device__ __forceinline__ float gelu_tanh(float x) { const float u = 0.7978845608028654f * (x + 0.044715f * x * x * x); return x * rcpf_(1.0f + __expf(-2.0f * u)); }
__device__ __forceinline__ float one_minus_exp(float x) { const float p = -x * (1.0f + 0.5f * x * (1.0f + (1.0f / 3.0f) * x * (1.0f + 0.25f * x * (1.0f + 0.2f * x * (1.0f + (1.0f / 6.0f) * x))))); return x > -0.25f ? p : 1.0f - __expf(x); }
constexpr float LG2S = 0.0625f * 1.4426950408889634f;
__device__ __forceinline__ float logsigmoidf_(float x) { return fminf(x, 0.0f) - __logf(1.0f + __expf(-fabsf(x))); }
__device__ __forceinline__ float wave_sum(float v) {
#pragma unroll
    for (int o = 1; o < 64; o <<= 1) v += __shfl_xor(v, o);
    return v;
}

namespace pg8 {
constexpr int BM = 256, BK = 64, HALF = 128, HTB = HALF * BK * 2, STAGE_BYTES = 8 * HTB, NXCD = 8, WGM = 8;
__host__ __device__ __forceinline__ int lds_byte(int r, int c) { const int st = (r >> 4) * 2 + (c >> 5), rr = r & 15, cc = c & 31, ob = rr * 64 + cc * 2; return st * 1024 + (ob ^ (((ob >> 9) & 1) << 5)); }
__host__ __device__ __forceinline__ void stage_rc(int b, int& R, int& C) { const int st = b / 1024, sb = b % 1024, swz = sb ^ (((sb >> 9) & 1) << 5); R = (st >> 1) * 16 + swz / 64; C = (st & 1) * 32 + (swz % 64) / 2; }
__host__ __device__ __forceinline__ int perm32(int rho) { const int n = rho >> 4, i = rho & 15; return 8 * (i >> 2) + 4 * n + (i & 3); }

struct Unit { int pm, pn, slot; const char* a; const char* b; };
__device__ __forceinline__ bool static_tile(int i, int G, int c, int nM, int nN, int& pm, int& pn) {
    const int nwg = nM * nN; const long L = (long)i * G + c; if (L >= nwg) return false;
    int wgid = (int)L; { const int q = nwg / NXCD, r = nwg % NXCD, xcd = wgid % NXCD, off = wgid / NXCD; wgid = (xcd < r ? xcd * (q + 1) : r * (q + 1) + (xcd - r) * q) + off; }
    const int nig = WGM * nN, gid = wgid / nig, fm = gid * WGM, gsz = (nM - fm) < WGM ? (nM - fm) : WGM;
    pm = fm + ((wgid % nig) % gsz); pn = (wgid % nig) / gsz; return true;
}
__device__ __forceinline__ unsigned cvt_pk_bf16(float lo, float hi) { unsigned r; asm volatile("v_cvt_pk_bf16_f32 %0, %1, %2" : "=v"(r) : "v"(lo), "v"(hi)); return r; }

template <class Epi, class Sched, bool GATHER, bool FP8 = false>
__device__ __forceinline__ void gemm_phase(LAS unsigned char* lds, const int K, const int lda, const Sched& S, const Epi& E, const LAS int* gtab, const int ldb_ = 0) {
    const int tid = threadIdx.x, wid = __builtin_amdgcn_readfirstlane(tid >> 6), lane = tid & 63, wr = wid >> 2, wc = wid & 3, fr = lane & 15, fq = lane >> 4;
    int nt = K / BK; asm volatile("" : "+s"(nt));
    int RA[2], CA[2]; unsigned voffB[2];
#pragma unroll
    for (int i = 0; i < 2; ++i) { int R, C; stage_rc(tid * 16 + i * 8192, R, C); const int Rb = Epi::PERM ? ((R & ~31) + perm32(R & 31)) : R;
        RA[i] = R; CA[i] = C; voffB[i] = (unsigned)(Rb * (ldb_ ? ldb_ : K) + C) * 2u; }
    const size_t kstep = (size_t)(BK * 2);
    const size_t hstepB = (size_t)HALF * (ldb_ ? ldb_ : K) * 2;
    const unsigned ldsw = (unsigned)wid * 1024u;
    const int aoff = lds_byte(wr * 64 + fr, fq * 8), boff = lds_byte(wc * 32 + fr, fq * 8);
    unsigned offC[2][2], offN[2][2];
#define PG8_SETOFF(dst, unit) do { _Pragma("unroll") for (int _h = 0; _h < 2; ++_h) _Pragma("unroll") for (int _i = 0; _i < 2; ++_i) { \
        if constexpr (GATHER) { int _t = gtab[(unit).slot * 256 + _h * HALF + RA[_i]]; _t = _t < 0 ? 0 : _t; dst[_h][_i] = ((unsigned)_t * (unsigned)lda + (unsigned)CA[_i]) * 2u; } \
        else dst[_h][_i] = ((unsigned)(_h * HALF + RA[_i]) * (unsigned)lda + (unsigned)CA[_i]) * 2u; } } while (0)
#define PG8_SA(b, h) (((b) * 2 + (h)) * HTB)
#define PG8_SB(b, h) ((4 + (b) * 2 + (h)) * HTB)
#define PG8_STAGEB(bufoff, gbase) do { _Pragma("unroll") for (int _i = 0; _i < 2; ++_i) \
        __builtin_amdgcn_global_load_lds((const unsigned*)((const char*)(gbase) + voffB[_i]), (LAS unsigned*)(lds + (bufoff) + ldsw + _i * 8192), 16, 0, 0); } while (0)
#define PG8_STAGEA(bufoff, gbase, o0, o1) do { \
        __builtin_amdgcn_global_load_lds((const unsigned*)((const char*)(gbase) + (o0)), (LAS unsigned*)(lds + (bufoff) + ldsw), 16, 0, 0); \
        __builtin_amdgcn_global_load_lds((const unsigned*)((const char*)(gbase) + (o1)), (LAS unsigned*)(lds + (bufoff) + ldsw + 8192), 16, 0, 0); } while (0)
#define PG8_LDA(dst, b, h) do { _Pragma("unroll") for (int m = 0; m < 4; ++m) { const LAS v4i* _p = (const LAS v4i*)(lds + PG8_SA(b, h) + aoff + m * 2048); dst[m] = __builtin_shufflevector(_p[0], _p[64], 0, 1, 2, 3, 4, 5, 6, 7); } } while (0)
#define PG8_LDB(dst, b, h) do { _Pragma("unroll") for (int n = 0; n < 2; ++n) { const LAS v4i* _p = (const LAS v4i*)(lds + PG8_SB(b, h) + boff + n * 2048); dst[n] = __builtin_shufflevector(_p[0], _p[64], 0, 1, 2, 3, 4, 5, 6, 7); } } while (0)
#define PG8_HALF(x, k) __builtin_bit_cast(bf16x8, __builtin_shufflevector(x, x, 4 * (k), 4 * (k) + 1, 4 * (k) + 2, 4 * (k) + 3))
#define PG8_MMA(ai, bj, At, Bt) do { __builtin_amdgcn_s_setprio(1); _Pragma("unroll") for (int m = 0; m < 4; ++m) _Pragma("unroll") for (int n = 0; n < 2; ++n) { \
        if constexpr (FP8) asm volatile("v_mfma_scale_f32_16x16x128_f8f6f4 %0, %1, %2, %0, %3, %3 op_sel_hi:[0,0,0]" : "+v"(acc[ai][bj][m][n]) : "v"(Bt[n]), "v"(At[m]), "v"(one8));   \
        else { acc[ai][bj][m][n] = __builtin_amdgcn_mfma_f32_16x16x32_bf16(PG8_HALF(Bt[n], 0), PG8_HALF(At[m], 0), acc[ai][bj][m][n], 0, 0, 0); \
               acc[ai][bj][m][n] = __builtin_amdgcn_mfma_f32_16x16x32_bf16(PG8_HALF(Bt[n], 1), PG8_HALF(At[m], 1), acc[ai][bj][m][n], 0, 0, 0); } } __builtin_amdgcn_s_setprio(0); } while (0)
#define PG8_WAIT_V(n) asm volatile("s_waitcnt vmcnt(" #n ")" ::: "memory")
#define PG8_WAIT_L(n) asm volatile("s_waitcnt lgkmcnt(" #n ")" ::: "memory")
#define PG8_BAR __builtin_amdgcn_s_barrier()
#define PG8_SCHED __builtin_amdgcn_sched_barrier(0)
    Unit cur, nxt; int ui = 0;
    if (!S.next(0, cur)) return;
    f32x4 acc[2][2][4][2];
#pragma unroll
    for (int a = 0; a < 2; ++a)
#pragma unroll
        for (int b = 0; b < 2; ++b)
#pragma unroll
            for (int m = 0; m < 4; ++m)
#pragma unroll
                for (int n = 0; n < 2; ++n) acc[a][b][m][n] = (f32x4){0.f, 0.f, 0.f, 0.f};
    v8i At[4], B0[2], B1[2];
    int one8 = 0x7F7F7F7F; asm volatile("" : "+v"(one8));
    const char* cA = cur.a; const char* cB = cur.b;
    PG8_SETOFF(offC, cur);
    PG8_STAGEB(PG8_SB(0, 0), cB); PG8_STAGEB(PG8_SB(0, 1), cB + hstepB); PG8_STAGEA(PG8_SA(0, 0), cA, offC[0][0], offC[0][1]); PG8_STAGEA(PG8_SA(0, 1), cA, offC[1][0], offC[1][1]);
    if (wr == 1) PG8_BAR;
    PG8_WAIT_V(2); PG8_BAR;
    PG8_STAGEB(PG8_SB(1, 0), cB + kstep); PG8_STAGEA(PG8_SA(1, 0), cA + kstep, offC[0][0], offC[0][1]); PG8_STAGEB(PG8_SB(1, 1), cB + hstepB + kstep);
    PG8_WAIT_V(6); PG8_BAR;
    for (;;) {
        const bool has_next = S.next(ui + 1, nxt);
        const char* nA = has_next ? nxt.a : cA; const char* nB = has_next ? nxt.b : cB;
        if constexpr (GATHER) {
#pragma unroll
        for (int h = 0; h < 2; ++h)
#pragma unroll
            for (int i = 0; i < 2; ++i) offN[h][i] = offC[h][i]; }
        for (int t = 0; t < nt; t += 2) {
            const bool last = (t == nt - 2);
            const char* a1 = cA + (size_t)(t + 1) * kstep;
            const char* a2 = last ? nA : cA + (size_t)(t + 2) * kstep; const char* b2 = last ? nB : cB + (size_t)(t + 2) * kstep;
            const char* a3 = a2 + kstep; const char* b3 = b2 + kstep;
            if constexpr (GATHER) { if (last && has_next) PG8_SETOFF(offN, nxt); }
            unsigned q00 = offC[0][0], q01 = offC[0][1], q10 = offC[1][0], q11 = offC[1][1];
            if constexpr (GATHER) { q00 = last ? offN[0][0] : q00; q01 = last ? offN[0][1] : q01; q10 = last ? offN[1][0] : q10; q11 = last ? offN[1][1] : q11; }
            PG8_LDB(B0, 0, 0); PG8_LDB(B1, 0, 1); PG8_SCHED; PG8_LDA(At, 0, 0); PG8_STAGEA(PG8_SA(1, 1), a1, offC[1][0], offC[1][1]);
            PG8_WAIT_V(8); PG8_WAIT_L(0); PG8_BAR; PG8_MMA(0, 0, At, B0); PG8_MMA(0, 1, At, B1); PG8_BAR; PG8_SCHED;
            PG8_LDA(At, 0, 1); PG8_STAGEB(PG8_SB(0, 0), b2); PG8_STAGEB(PG8_SB(0, 1), b2 + hstepB); PG8_STAGEA(PG8_SA(0, 0), a2, q00, q01);
            PG8_WAIT_V(8); PG8_WAIT_L(0); PG8_BAR; PG8_MMA(1, 0, At, B0); PG8_MMA(1, 1, At, B1); PG8_BAR; PG8_SCHED;
            PG8_LDB(B0, 1, 0); PG8_LDB(B1, 1, 1); PG8_SCHED; PG8_LDA(At, 1, 0); PG8_STAGEA(PG8_SA(0, 1), a2, q10, q11);
            PG8_WAIT_V(8); PG8_WAIT_L(0); PG8_BAR; PG8_MMA(0, 0, At, B0); PG8_MMA(0, 1, At, B1); PG8_BAR; PG8_SCHED;
            PG8_LDA(At, 1, 1); PG8_STAGEB(PG8_SB(1, 0), b3); PG8_STAGEB(PG8_SB(1, 1), b3 + hstepB); PG8_STAGEA(PG8_SA(1, 0), a3, q00, q01);
            PG8_WAIT_V(8); PG8_WAIT_L(0); PG8_BAR; PG8_MMA(1, 0, At, B0); PG8_MMA(1, 1, At, B1); PG8_BAR; PG8_SCHED;
        }
        if (wr == 0) PG8_BAR;
        if constexpr (FP8) asm volatile("s_nop 15\n\ts_nop 15" ::: "memory");
        E(acc, cur, wr, wc, fr, fq);
        if (!has_next) break;
#pragma unroll
        for (int a = 0; a < 2; ++a)
#pragma unroll
            for (int b = 0; b < 2; ++b)
#pragma unroll
                for (int m = 0; m < 4; ++m)
#pragma unroll
                    for (int n = 0; n < 2; ++n) acc[a][b][m][n] = (f32x4){0.f, 0.f, 0.f, 0.f};
        cur = nxt; cA = nA; cB = nB; ++ui;
        if constexpr (GATHER) {
#pragma unroll
        for (int h = 0; h < 2; ++h)
#pragma unroll
            for (int i = 0; i < 2; ++i) offC[h][i] = offN[h][i]; }
        if (wr == 1) PG8_BAR;
    }
    PG8_WAIT_V(0);
    PG8_BAR;
#undef PG8_SETOFF
#undef PG8_SA
#undef PG8_SB
#undef PG8_STAGEA
#undef PG8_STAGEB
#undef PG8_LDA
#undef PG8_LDB
#undef PG8_MMA
#undef PG8_HALF
#undef PG8_WAIT_V
#undef PG8_WAIT_L
#undef PG8_BAR
#undef PG8_SCHED
}
}

#define XB_TMO      128
#define XB_XCNT(j)  (256  + 64 * (j))
#define XB_XSUB(j)  (1280 + 64 * (j))
#define XB_XGEN(j)  (2304 + 64 * (j))
#define XB_TOP      3328
#define XB_TOPGEN   3392
#define XCD_BAR_WORDS 3456
#define XB_SPIN_CAP (1u << 18)
__device__ __forceinline__ unsigned xb_ld(unsigned* p)              { return __hip_atomic_load(p, __ATOMIC_RELAXED, __HIP_MEMORY_SCOPE_AGENT); }
__device__ __forceinline__ unsigned xb_add(unsigned* p, unsigned v) { return __hip_atomic_fetch_add(p, v, __ATOMIC_RELAXED, __HIP_MEMORY_SCOPE_AGENT); }
__device__ __forceinline__ unsigned xb_xcc_id() { return (unsigned)__builtin_amdgcn_s_getreg((3 << 11) | 20) & 0xFu; }
#define XB_SPIN(cond, bar) do { unsigned _sp = 0; while (cond) { __builtin_amdgcn_s_sleep(1); \
    if ((++_sp & 255u) == 0u) { if (xb_ld(&(bar)[XB_TMO])) break; if (_sp > XB_SPIN_CAP) { atomicAdd(&(bar)[XB_TMO], 1u); break; } } } } while (0)
struct XcdBarrier { unsigned* bar; unsigned x; volatile LAS unsigned* st; };
__device__ __forceinline__ XcdBarrier xcd_barrier_post(unsigned* bar, volatile LAS unsigned* st) {
    XcdBarrier b; b.bar = bar; b.x = xb_xcc_id(); b.st = st;
    if (threadIdx.x == 0) (void)xb_add(&bar[XB_XCNT(b.x)], 1u);
    return b;
}
__device__ __forceinline__ void xcd_barrier_complete(unsigned* bar, unsigned x, unsigned& nloc, unsigned& nx) {
    const unsigned G = gridDim.x * gridDim.y * gridDim.z;
    unsigned sum, cnt, mine, sp = 0u;
    for (;;) {
        sum = 0u; cnt = 0u; mine = 0u;
#pragma unroll
        for (unsigned j = 0; j < 16; ++j) { const unsigned c = xb_ld(&bar[XB_XCNT(j)]); sum += c; cnt += (c > 0u) ? 1u : 0u; mine = (j == x) ? c : mine; }
        if (sum == G) break;
        __builtin_amdgcn_s_sleep(1);
        if ((++sp & 255u) == 0u) { if (xb_ld(&bar[XB_TMO])) break; if (sp > XB_SPIN_CAP) { atomicAdd(&bar[XB_TMO], 1u); break; } }
    }
    nloc = mine > 0u ? mine : 1u; nx = cnt > 0u ? cnt : 1u;
}
__device__ __forceinline__ void xcd_barrier(const XcdBarrier& b) {
    asm volatile("s_waitcnt vmcnt(0)" ::: "memory");
    __syncthreads();
    if (threadIdx.x == 0) {
        unsigned* bar = b.bar;
        __builtin_amdgcn_s_waitcnt(0);
        unsigned nloc = b.st[0], nx = b.st[1];
        if (nloc == 0u) { xcd_barrier_complete(bar, b.x, nloc, nx); b.st[0] = nloc; b.st[1] = nx; }
        const unsigned old = xb_add(&bar[XB_XSUB(b.x)], 1u);
        const unsigned gen = old / nloc;
        if (old + 1u == (gen + 1u) * nloc) {
            __builtin_amdgcn_fence(__ATOMIC_RELEASE, "agent");
            asm volatile("s_waitcnt vmcnt(0)" ::: "memory");
            const unsigned og = xb_add(&bar[XB_TOP], 1u);
            const unsigned tg = og / nx;
            if (og + 1u == (tg + 1u) * nx) xb_add(&bar[XB_TOPGEN], 1u);
            else XB_SPIN(xb_ld(&bar[XB_TOPGEN]) == tg, bar);
            __builtin_amdgcn_fence(__ATOMIC_ACQUIRE, "agent");
            xb_add(&bar[XB_XGEN(b.x)], 1u);
            asm volatile("s_waitcnt vmcnt(0)" ::: "memory");
        } else {
            XB_SPIN(xb_ld(&bar[XB_XGEN(b.x)]) == gen, bar);
            __builtin_amdgcn_fence(__ATOMIC_ACQUIRE, "agent");
            asm volatile("s_waitcnt vmcnt(0)" ::: "memory");
        }
    }
    __syncthreads();
}

struct Args { const float* in[38]; float* out; unsigned char* ws; int ph_lo, ph_hi, li, pad; };
struct Frame {
    LAS unsigned char* lds;
    int tid, lane, wave, G, gw, NGW;
    int gt, NGT;
};
enum { I_X = 0, I_META, I_NORM_MIX0, I_WIN0, I_CONVW, I_CONVB, I_GAW, I_GAB, I_GXW, I_GXB, I_LAM, I_LRE, I_LIM, I_LDT, I_BRE, I_BIM, I_CRE, I_CIM, I_SD, I_GLUW, I_GLUB, I_WOUT0, I_NORM_FFN0,
       I_FG, I_FU, I_FD, I_NORM_MIX1, I_WIN1, I_GW2, I_GB, I_GNORM, I_WOUT1, I_NORM_FFN1, I_ROUTER, I_MG, I_MU, I_MD, I_FNORM };

struct SchedStatic {
    int nM, nN, G, c; const char* A; const char* B; size_t aStep, bStep; int aColDiv; size_t aColStep;
    __device__ __forceinline__ bool next(int i, pg8::Unit& u) const {
        int pm, pn; if (!pg8::static_tile(i, G, c, nM, nN, pm, pn)) return false;
        u.pm = pm; u.pn = pn; u.slot = i; u.a = A + (size_t)pm * aStep + (aColDiv ? (size_t)(pn / aColDiv) * aColStep : 0); u.b = B + (size_t)pn * bStep; return true;
    }
};
struct SchedList {
    int n; const LAS int* meta; const char* A; const char* B; size_t aStep, bTile, bExpert;
    __device__ __forceinline__ bool next(int i, pg8::Unit& u) const {
        if (i >= n) return false;
        const int pm = meta[i * 4 + 0], pn = meta[i * 4 + 1], e = meta[i * 4 + 2];
        u.pm = pm; u.pn = pn; u.slot = i; const int ko = meta[i * 4 + 3]; u.a = A + (size_t)pm * aStep + (size_t)ko * 2; u.b = B + (size_t)e * bExpert + (size_t)pn * bTile + (size_t)ko * 2; return true;
    }
};

#define EPI_ROWS(ai, m) ((ai) * 128 + wr * 64 + (m) * 16 + fr)
#define EPI_COLP(bj) ((bj) * 128 + wc * 32 + 8 * fq)
#define EPI_COLN(bj, n) ((bj) * 128 + wc * 32 + 16 * (n) + 4 * fq)
typedef const f32x4 (&AccRef)[2][2][4][2];
__device__ __forceinline__ void unpack8(v4u w, f32x4& a, f32x4& b) { a = (f32x4){bflo(w.x), bfhi(w.x), bflo(w.y), bfhi(w.y)}; b = (f32x4){bflo(w.z), bfhi(w.z), bflo(w.w), bfhi(w.w)}; }
__device__ __forceinline__ v4u pack8(f32x4 a, f32x4 b) { v4u w; w.x = pg8::cvt_pk_bf16(a[0], a[1]); w.y = pg8::cvt_pk_bf16(a[2], a[3]); w.z = pg8::cvt_pk_bf16(b[0], b[1]); w.w = pg8::cvt_pk_bf16(b[2], b[3]); return w; }

template <int D> __device__ __forceinline__ float ror16(float v) { return __builtin_bit_cast(float, __builtin_amdgcn_update_dpp(0, __builtin_bit_cast(int, v), 0x120 + D, 0xF, 0xF, false)); }
struct EpiWin0 {
    static constexpr bool PERM = true; bf16 *G, *XR, *U; const float *cw, *cb; bf16* XC;
    __device__ __forceinline__ void operator()(AccRef acc, const pg8::Unit& u, int wr, int wc, int fr, int fq) const {
        const int pn = u.pn; bf16* base; int ld, c0;
        if (pn >= 4 && pn < 8) {
#pragma unroll
            for (int bj = 0; bj < 2; ++bj)
#pragma unroll
              for (int n = 0; n < 2; ++n) { const int cc = (pn - 4) * 256 + EPI_COLP(bj) + 4 * n;
                f32x4 w0 = *(const f32x4*)(cw + cc), w1 = *(const f32x4*)(cw + 1024 + cc), w2 = *(const f32x4*)(cw + 2048 + cc), w3 = *(const f32x4*)(cw + 3072 + cc); const f32x4 bb = *(const f32x4*)(cb + cc);
#pragma unroll
                for (int ai = 0; ai < 2; ++ai) { f32x4 q1 = {0.f, 0.f, 0.f, 0.f}, q2 = q1, q3 = q1;
#pragma unroll
                    for (int m = 0; m < 4; ++m) { const size_t ro = (size_t)(u.pm * 256 + EPI_ROWS(ai, m)) * 1024 + cc; const f32x4 x = acc[ai][bj][m][n]; f32x4 t1, t2, t3, p1, p2, p3;
#pragma unroll
                        for (int j = 0; j < 4; ++j) { t1[j] = ror16<1>(x[j]); t2[j] = ror16<2>(x[j]); t3[j] = ror16<3>(x[j]);
                            p1[j] = fr >= 1 ? t1[j] : q1[j]; p2[j] = fr >= 2 ? t2[j] : q2[j]; p3[j] = fr >= 3 ? t3[j] : q3[j]; }
                        const f32x4 o = bb + w0 * p3 + w1 * p2 + w2 * p1 + w3 * x;
                        q1 = t1; q2 = t2; q3 = t3;
                        const bool fix = (m == 0) && fr < 3;
                        if (!fix) *(v2u*)(XC + ro) = (v2u){pk2(o.x, o.y), pk2(o.z, o.w)};
                        if (fix || ((m == 3) && fr >= 13)) *(v2u*)(XR + ro) = (v2u){pk2(x.x, x.y), pk2(x.z, x.w)};
                        asm volatile("" : "+v"(q1), "+v"(q2), "+v"(q3) :: "memory"); } } }
            return; }
        if (pn < 4) { base = G; ld = 1024; c0 = pn * 256; } else if (pn < 8) { base = XR; ld = 1024; c0 = (pn - 4) * 256; } else { base = U; ld = 512; c0 = (pn - 8) * 256; }
#pragma unroll
        for (int ai = 0; ai < 2; ++ai)
#pragma unroll
            for (int m = 0; m < 4; ++m) { bf16* rowp = base + (size_t)(u.pm * 256 + EPI_ROWS(ai, m)) * ld + c0;
#pragma unroll
                for (int bj = 0; bj < 2; ++bj) { f32x4 v0 = acc[ai][bj][m][0], v1 = acc[ai][bj][m][1];
                    if (pn < 4) {
#pragma unroll
                        for (int j = 0; j < 1; ++j) { v0 = gelu_tanh_4(v0); v1 = gelu_tanh_4(v1); } }
                    *(v4u*)(rowp + EPI_COLP(bj)) = pack8(v0, v1); } }
    }
};
struct EpiGates {
    static constexpr bool PERM = true; const float *gab, *gxb, *sp8; const bf16* XC; bf16* A; bf16* BX;
    __device__ __forceinline__ void operator()(AccRef acc, const pg8::Unit& u, int wr, int wc, int fr, int fq) const {
        const int ch0 = (u.pn >> 1) * 256 + (u.pn & 1) * 128 + wc * 32 + 8 * fq;
        f32x4 ba[2], bx[2], sp[2];
#pragma unroll
        for (int n = 0; n < 2; ++n) { ba[n] = *(const f32x4*)(gab + ch0 + 4 * n); bx[n] = *(const f32x4*)(gxb + ch0 + 4 * n); sp[n] = *(const f32x4*)(sp8 + ch0 + 4 * n); }
#pragma unroll
        for (int ai = 0; ai < 2; ++ai)
#pragma unroll
            for (int m = 0; m < 4; ++m) { const size_t ro = (size_t)(u.pm * 256 + EPI_ROWS(ai, m)) * 1024 + ch0;
                const v4u xw = *(const v4u*)(XC + ro); f32x4 xv[2]; unpack8(xw, xv[0], xv[1]);
                f32x4 av[2], bv[2];
#pragma unroll
                for (int n = 0; n < 2; ++n) { const f32x4 r = sigmoid_4(acc[ai][0][m][n] + ba[n]), ig = sigmoid_4(acc[ai][1][m][n] + bx[n]);
                    const f32x4 la = r * sp[n] * -1.0f, aa = exp2_4(la * 1.4426950408889634f); f32x4 om = aa * aa * -1.0f + 1.0f, sq;
#pragma unroll
                    for (int j = 0; j < 4; ++j) sq[j] = __builtin_amdgcn_sqrtf(fmaxf(om[j], 0.0f));
                    av[n] = la; bv[n] = sq * ig * xv[n]; }
                *(v4u*)(A + ro) = pack8(av[0], av[1]); *(v4u*)(BX + ro) = pack8(bv[0], bv[1]); asm volatile("" ::: "memory"); }
    }
};
struct EpiGlu {
    static constexpr bool PERM = true; const float* glub; const bf16* GS; bf16* AOUT;
    __device__ __forceinline__ void operator()(AccRef acc, const pg8::Unit& u, int wr, int wc, int fr, int fq) const {
#pragma unroll
        for (int bj = 0; bj < 2; ++bj) { const int c = u.pn * 256 + EPI_COLP(bj); const f32x4 b0 = *(const f32x4*)(glub + c), b1 = *(const f32x4*)(glub + c + 4);
#pragma unroll
            for (int ai = 0; ai < 2; ++ai)
#pragma unroll
                for (int m = 0; m < 4; ++m) { const size_t row = (size_t)(u.pm * 256 + EPI_ROWS(ai, m));
                    f32x4 g0_, g1_; unpack8(*(const v4u*)(GS + row * 512 + c), g0_, g1_);
                    const f32x4 v0 = g0_ * sigmoid_4(acc[ai][bj][m][0] + b0), v1 = g1_ * sigmoid_4(acc[ai][bj][m][1] + b1);
                    *(v4u*)(AOUT + row * 1536 + 1024 + c) = pack8(v0, v1); } }
    }
};
struct EpiResid {
    static constexpr bool PERM = true; const float* xsrc; bf16* hb; float* ssqp;
    __device__ __forceinline__ void operator()(AccRef acc, const pg8::Unit& u, int wr, int wc, int fr, int fq) const {
        float q[2][4];
#pragma unroll
        for (int ai = 0; ai < 2; ++ai)
#pragma unroll
            for (int m = 0; m < 4; ++m) { const size_t ro = (size_t)(u.pm * 256 + EPI_ROWS(ai, m)) * 1024 + u.pn * 256; float qs = 0.f;
#pragma unroll
                for (int bj = 0; bj < 2; ++bj) { const size_t o = ro + EPI_COLP(bj); f32x4 v0, v1;
                    if (xsrc) { v0 = *(const f32x4*)(xsrc + o); v1 = *(const f32x4*)(xsrc + o + 4); } else unpack8(*(const v4u*)(hb + o), v0, v1);
                    v0 += acc[ai][bj][m][0]; v1 += acc[ai][bj][m][1];
                    qs += ((v0.x * v0.x + v0.y * v0.y) + (v0.z * v0.z + v0.w * v0.w)) + ((v1.x * v1.x + v1.y * v1.y) + (v1.z * v1.z + v1.w * v1.w));
                    *(v4u*)(hb + o) = pack8(v0, v1); }
                q[ai][m] = qs; }
        if (ssqp) {
#pragma unroll
            for (int ai = 0; ai < 2; ++ai)
#pragma unroll
                for (int m = 0; m < 4; ++m) { float t = q[ai][m]; t += __shfl_xor(t, 16); t += __shfl_xor(t, 32);
                    if (fq == 0) ssqp[(size_t)(u.pm * 256 + EPI_ROWS(ai, m)) * 16 + u.pn * 4 + wc] = t; } }
    }
};
__device__ __forceinline__ f32x4 swiglu4_x32(f32x4 G, f32x4 U) {
    const f32x4 a = G * (-1.4426950408889634f / 32.0f) + 10.0f; f32x4 t;
#pragma unroll
    for (int j = 0; j < 4; ++j) t[j] = __builtin_amdgcn_exp2f(a[j]);
    const f32x4 d = t + 1024.0f; f32x4 q;
#pragma unroll
    for (int j = 0; j < 4; ++j) q[j] = rcpf_(d[j]);
    return (G * U) * q; }
__device__ __forceinline__ f32x4 swiglu4_r(f32x4 G, f32x4 U, float r2, float rl) {
    const f32x4 a = G * rl; f32x4 t;
#pragma unroll
    for (int j = 0; j < 4; ++j) t[j] = __builtin_amdgcn_exp2f(a[j]);
    const f32x4 d = t + 1.0f; f32x4 q;
#pragma unroll
    for (int j = 0; j < 4; ++j) q[j] = rcpf_(d[j]);
    return (G * U) * (q * r2); }
__device__ __forceinline__ float rstd_of(const float* ssqp, size_t row) { const f32x4* p = (const f32x4*)(ssqp + row * 16); const f32x4 a = p[0], b = p[1], c = p[2], d = p[3];
    const f32x4 t = (a + b) + (c + d); return __builtin_amdgcn_rsqf(((t.x + t.y) + (t.z + t.w)) * (1.0f / 1024.0f) + EPS); }
constexpr int FOLD_MAXU = 20;
__device__ __forceinline__ float fold_rstd(const LAS float* rst, const float* ssqp, const pg8::Unit& u, int r) { return u.slot < FOLD_MAXU ? rst[u.slot * 256 + r] : rstd_of(ssqp, (size_t)(u.pm * 256 + r)); }
struct EpiSwiglu {
    static constexpr bool PERM = true; bf16* H; int ld; const float* ssqp; const LAS float* rst;
    __device__ __forceinline__ void operator()(AccRef acc, const pg8::Unit& u, int wr, int wc, int fr, int fq) const {
        const int c = u.pn * 128 + wc * 32 + 8 * fq;
        float rs[2][4];
#pragma unroll
        for (int ai = 0; ai < 2; ++ai)
#pragma unroll
            for (int m = 0; m < 4; ++m) rs[ai][m] = fold_rstd(rst, ssqp, u, EPI_ROWS(ai, m));
#pragma unroll
        for (int ai = 0; ai < 2; ++ai)
#pragma unroll
            for (int m = 0; m < 4; ++m) { const float r = rs[ai][m], r2 = r * r, rl = r * -1.4426950408889634f;
                const f32x4 v0 = swiglu4_r(acc[ai][0][m][0], acc[ai][1][m][0], r2, rl), v1 = swiglu4_r(acc[ai][0][m][1], acc[ai][1][m][1], r2, rl);
                *(v4u*)(H + (size_t)(u.pm * 256 + EPI_ROWS(ai, m)) * ld + c) = pack8(v0, v1); }
    }
};
struct EpiWin1 {
    static constexpr bool PERM = true; bf16 *Q, *K, *V, *GATE; bf16* LG; const float* gb; const float* ssqp; const LAS float* rst;
    __device__ __forceinline__ void operator()(AccRef acc, const pg8::Unit& u, int wr, int wc, int fr, int fq) const {
        const int pn = u.pn;
        float rs[2][4];
#pragma unroll
        for (int ai = 0; ai < 2; ++ai)
#pragma unroll
            for (int m = 0; m < 4; ++m) rs[ai][m] = fold_rstd(rst, ssqp, u, EPI_ROWS(ai, m));
#pragma unroll
        for (int ai = 0; ai < 2; ++ai)
#pragma unroll
            for (int m = 0; m < 4; ++m) { const size_t row = (size_t)(u.pm * 256 + EPI_ROWS(ai, m)); const float r = rs[ai][m];
#pragma unroll
                for (int bj = 0; bj < 2; ++bj) { f32x4 v0 = acc[ai][bj][m][0] * r, v1 = acc[ai][bj][m][1] * r; const int cc = EPI_COLP(bj);
                    if (pn < 2) { v0 = v0 * 0.08838834764831845f; v1 = v1 * 0.08838834764831845f; *(v4u*)(Q + row * 512 + pn * 256 + cc) = pack8(v0, v1); }
                    else if (pn < 4) { *(v4u*)(K + row * 512 + (pn - 2) * 256 + cc) = pack8(v0, v1); }
                    else if (pn < 8) { *(v4u*)(V + row * 1024 + (pn - 4) * 256 + cc) = pack8(v0, v1); }
                    else if (pn < 12) {
#pragma unroll
                        for (int j = 0; j < 1; ++j) { v0 = silu_4(v0); v1 = silu_4(v1); }
                        *(v4u*)(GATE + row * 1024 + (pn - 8) * 256 + cc) = pack8(v0, v1); }
                    else { const int c = (pn - 12) * 256 + cc; const f32x4 b0 = *(const f32x4*)(gb + c), b1 = *(const f32x4*)(gb + c + 4);
#pragma unroll
                        for (int j = 0; j < 4; ++j) { v0[j] = logsigmoidf_(v0[j] + b0[j]) * LG2S; v1[j] = logsigmoidf_(v1[j] + b1[j]) * LG2S; }
                        *(v4u*)(LG + row * 512 + c) = pack8(v0, v1); } } }
    }
};
__device__ __forceinline__ float swiglu_x32(float G, float U) { const float t = __builtin_amdgcn_exp2f(__builtin_fmaf(G, -1.4426950408889634f / 32.0f, 10.0f)); return (G * U) * rcpf_(1024.0f + t); }
struct EpiSwiglu8 {
    static constexpr bool PERM = true; unsigned char* H; int ld;
    __device__ __forceinline__ void operator()(AccRef acc, const pg8::Unit& u, int wr, int wc, int fr, int fq) const {
        const int c = u.pn * 128 + wc * 32 + 8 * fq; constexpr float SC = 1.0f / 32.0f;
#pragma unroll
        for (int ai = 0; ai < 2; ++ai)
#pragma unroll
            for (int m = 0; m < 4; ++m) { float v[8];
#pragma unroll
                for (int j = 0; j < 1; ++j) { const f32x4 o0 = swiglu4_x32(acc[ai][0][m][0], acc[ai][1][m][0]), o1 = swiglu4_x32(acc[ai][0][m][1], acc[ai][1][m][1]);
                    v[0] = o0.x; v[1] = o0.y; v[2] = o0.z; v[3] = o0.w; v[4] = o1.x; v[5] = o1.y; v[6] = o1.z; v[7] = o1.w; }
                *(v2u*)(H + (size_t)(u.pm * 256 + EPI_ROWS(ai, m)) * ld + c) = (v2u){pk4_fp8(v[0], v[1], v[2], v[3]), pk4_fp8(v[4], v[5], v[6], v[7])}; }
    }
};
struct EpiMoeDown {
    static constexpr bool PERM = true; bf16* hb; const LAS int* toks; const LAS float* wts;
    __device__ __forceinline__ void operator()(AccRef acc, const pg8::Unit& u, int wr, int wc, int fr, int fq) const {
#pragma unroll
        for (int ai = 0; ai < 2; ++ai)
#pragma unroll
            for (int m = 0; m < 4; ++m) { const int rl = u.slot * 256 + EPI_ROWS(ai, m); const int tok = toks[rl]; const float w = wts[rl] * (1.0f / 64.0f);
                if (tok >= 0) { bf16* d = hb + (size_t)tok * 1024 + u.pn * 256;
#pragma unroll
                    for (int bj = 0; bj < 2; ++bj) { bf16* p = d + EPI_COLP(bj); f32x4 v0, v1; unpack8(*(const v4u*)p, v0, v1); *(v4u*)p = pack8(v0 + acc[ai][bj][m][0] * w, v1 + acc[ai][bj][m][1] * w); } } }
    }
};
struct EpiSlab {
    static constexpr bool PERM = false; float* slab; const LAS int* meta;
    __device__ __forceinline__ void operator()(AccRef acc, const pg8::Unit& u, int wr, int wc, int fr, int fq) const {
        const int sl = meta[u.slot * 4 + 3] / 256; float* base = slab + ((size_t)(sl * 8 + (u.pm - 128)) * 256) * 1024 + u.pn * 256;
#pragma unroll
        for (int ai = 0; ai < 2; ++ai)
#pragma unroll
            for (int m = 0; m < 4; ++m) { float* d = base + (size_t)EPI_ROWS(ai, m) * 1024;
#pragma unroll
                for (int bj = 0; bj < 2; ++bj)
#pragma unroll
                    for (int n = 0; n < 2; ++n) *(f32x4*)(d + EPI_COLN(bj, n)) = acc[ai][bj][m][n] * (1.0f / 64.0f); }
    }
};

__device__ __forceinline__ void tr_item8(const float* W, int ldw, int col, int k0, unsigned char* WT, int ldt, int drow, float scale, LAS float* scr, int lane) {
    float wv[32];
#pragma unroll
    for (int i = 0; i < 32; ++i) wv[i] = __builtin_nontemporal_load(W + (size_t)(k0 + 2 * i + (lane >> 5)) * ldw + col + (lane & 31));
#pragma unroll
    for (int i = 0; i < 32; ++i) scr[(2 * i + (lane >> 5)) * 33 + (lane & 31)] = wv[i] * scale;
    LDS_WAIT(); asm volatile("" ::: "memory");
    const int c = lane & 7;
#pragma unroll
    for (int j = 0; j < 4; ++j) { const int n = (lane >> 3) + 8 * j; const LAS float* s = scr + (8 * c) * 33 + n;
        *(v2u*)(WT + (size_t)(drow + n) * ldt + k0 + 8 * c) = (v2u){pk4_fp8(s[0 * 33], s[1 * 33], s[2 * 33], s[3 * 33]), pk4_fp8(s[4 * 33], s[5 * 33], s[6 * 33], s[7 * 33])}; }
    LDS_WAIT(); asm volatile("" ::: "memory");
}
__device__ __forceinline__ void tr_item(const float* W, int ldw, int col, int k0, bf16* WT, int ldt, int drow, LAS float* scr, int lane, const float* rs = nullptr) {
    float wv[32];
#pragma unroll
    for (int i = 0; i < 32; ++i) wv[i] = __builtin_nontemporal_load(W + (size_t)(k0 + 2 * i + (lane >> 5)) * ldw + col + (lane & 31));
#pragma unroll
    for (int i = 0; i < 32; ++i) scr[(2 * i + (lane >> 5)) * 33 + (lane & 31)] = rs ? wv[i] * rs[k0 + 2 * i + (lane >> 5)] : wv[i];
    LDS_WAIT(); asm volatile("" ::: "memory");
    const int c = lane & 7;
#pragma unroll
    for (int j = 0; j < 4; ++j) { const int n = (lane >> 3) + 8 * j; const LAS float* s = scr + (8 * c) * 33 + n;
        v4u o; o.x = pk2(s[0 * 33], s[1 * 33]); o.y = pk2(s[2 * 33], s[3 * 33]); o.z = pk2(s[4 * 33], s[5 * 33]); o.w = pk2(s[6 * 33], s[7 * 33]);
        *(v4u*)(WT + (size_t)(drow + n) * ldt + k0 + 8 * c) = o; }
    LDS_WAIT(); asm volatile("" ::: "memory");
}
struct TrJob { const float* W; int ldw, col0, K, N; bf16* WT; int blk, bstride, add; const float* rs = nullptr; };
__device__ __forceinline__ bool tr_try(int& r, const TrJob& j, LAS float* scr, int lane) {
    const int nblk = j.N / 32, items = (j.K / 64) * nblk;
    if (r >= items) { r -= items; return false; }
    const int kb = r / nblk, n0 = (r % nblk) * 32;
    tr_item(j.W, j.ldw, j.col0 + n0, kb * 64, j.WT, j.K, (n0 / j.blk) * j.bstride + (n0 % j.blk) + j.add, scr, lane, j.rs);
    return true;
}
__device__ __forceinline__ void norm_row_bf16(const float* xrow, const float* gain, bf16* orow, int lane) {
    const f32x4* xr = (const f32x4*)xrow + lane; const f32x4* gr = (const f32x4*)gain + lane;
    f32x4 v[4]; float s = 0.f;
#pragma unroll
    for (int j = 0; j < 4; ++j) { v[j] = xr[64 * j]; s += (v[j].x * v[j].x + v[j].y * v[j].y) + (v[j].z * v[j].z + v[j].w * v[j].w); }
    const float rstd = 1.0f / sqrtf(wave_sum(s) * (1.0f / 1024.0f) + EPS);
    v2u* o8 = (v2u*)orow + lane;
#pragma unroll
    for (int j = 0; j < 4; ++j) { const f32x4 g = gr[64 * j]; v2u w; w.x = pk2(v[j].x * rstd * g.x, v[j].y * rstd * g.y); w.y = pk2(v[j].z * rstd * g.z, v[j].w * rstd * g.w); o8[64 * j] = w; }
}
__device__ __forceinline__ void norm_row_b2b(const bf16* hrow, const float* gain, bf16* orow, int lane) {
    f32x4 v[4]; unpack8(*(const v4u*)(hrow + 8 * lane), v[0], v[1]); unpack8(*(const v4u*)(hrow + 512 + 8 * lane), v[2], v[3]); float s = 0.f;
#pragma unroll
    for (int j = 0; j < 4; ++j) s += (v[j].x * v[j].x + v[j].y * v[j].y) + (v[j].z * v[j].z + v[j].w * v[j].w);
    const float rstd = 1.0f / sqrtf(wave_sum(s) * (1.0f / 1024.0f) + EPS);
    const f32x4 g0 = *(const f32x4*)(gain + 8 * lane), g1 = *(const f32x4*)(gain + 8 * lane + 4), g2 = *(const f32x4*)(gain + 512 + 8 * lane), g3 = *(const f32x4*)(gain + 512 + 8 * lane + 4);
    *(v4u*)(orow + 8 * lane) = pack8(v[0] * rstd * g0, v[1] * rstd * g1); *(v4u*)(orow + 512 + 8 * lane) = pack8(v[2] * rstd * g2, v[3] * rstd * g3);
}

__device__ __forceinline__ void cexp_f(double re, double im, float& er, float& ei) {
    const float mag = __expf((float)re); double rev = im * 0.15915494309189535; rev -= floor(rev); const float fr_ = (float)rev;
    er = mag * __builtin_amdgcn_cosf(fr_); ei = mag * __builtin_amdgcn_sinf(fr_);
}
__device__ __forceinline__ void p0_prologue(const Frame& F, const Args& a, unsigned char* ws) {
    LAS float* scr = (LAS float*)(F.lds + RING_OFF + F.wave * 16384);
    const float* const* in = a.in;
    constexpr int BIG = 1 << 30;
    for (int it = F.gw; ; it += F.NGW) {
        int r = it;
        { TrJob j{in[I_WIN0], EV_IN, 0, 1024, EV_IN, (bf16*)(ws + WS_WIN0), BIG, 0, 0}; if (tr_try(r, j, scr, F.lane)) continue; }
        bool done = false;
        for (int h = 0; h < 4 && !done; ++h) {
            { TrJob j{in[I_GAW] + (size_t)h * 65536, 256, 0, 256, 256, (bf16*)(ws + WS_GW) + (size_t)h * 512 * 256, 128, 256, 0}; if (tr_try(r, j, scr, F.lane)) { done = true; break; } }
            { TrJob j{in[I_GXW] + (size_t)h * 65536, 256, 0, 256, 256, (bf16*)(ws + WS_GW) + (size_t)h * 512 * 256, 128, 256, 128}; if (tr_try(r, j, scr, F.lane)) { done = true; break; } }
        }
        if (done) continue;
        { TrJob j{in[I_GLUW], 512, 0, 512, 512, (bf16*)(ws + WS_GLUW), BIG, 0, 0}; if (tr_try(r, j, scr, F.lane)) continue; }
        { TrJob j{in[I_WOUT0], 1024, 0, EV_MIX, 1024, (bf16*)(ws + WS_WOUT0), BIG, 0, 0}; if (tr_try(r, j, scr, F.lane)) continue; }
        { TrJob j{in[I_FG], FF0, 0, 1024, FF0, (bf16*)(ws + WS_WUP0), 128, 256, 0, in[I_NORM_FFN0]}; if (tr_try(r, j, scr, F.lane)) continue; }
        { TrJob j{in[I_FU], FF0, 0, 1024, FF0, (bf16*)(ws + WS_WUP0), 128, 256, 128, in[I_NORM_FFN0]}; if (tr_try(r, j, scr, F.lane)) continue; }
        { TrJob j{in[I_FD], 1024, 0, FF0, 1024, (bf16*)(ws + WS_WDN0), BIG, 0, 0}; if (tr_try(r, j, scr, F.lane)) continue; }
        { TrJob j{in[I_WIN1], OD_IN, 0, 1024, 3072, (bf16*)(ws + WS_WIN1), BIG, 0, 0, in[I_NORM_MIX1]}; if (tr_try(r, j, scr, F.lane)) continue; }
        { TrJob j{in[I_WOUT1], 1024, 0, 1024, 1024, (bf16*)(ws + WS_WOUT1), BIG, 0, 0}; if (tr_try(r, j, scr, F.lane)) continue; }
        break;
    }
    for (long i = F.gt; i < 512L * 1024; i += F.NGT) { const int j = (int)(i & 511), k = (int)(i >> 9); const float* wr_ = in[I_WIN1] + (size_t)k * OD_IN + 3072; const float* w2 = in[I_GW2] + j; float s = 0.f;
#pragma unroll
        for (int r = 0; r < 16; ++r) s += wr_[r] * w2[r * 512];
        ((bf16*)(ws + WS_WIN1))[(size_t)(3072 + j) * 1024 + k] = (bf16)f2bf(s * in[I_NORM_MIX1][k]); }
    float* tab = (float*)(ws + WS_TAB);
    for (long i = F.gt; i < NG * NS; i += F.NGT) { const int g = (int)i / NS;
        const double lr = in[I_LRE][i], li = in[I_LIM][i], dt = (double)expf(in[I_LDT][g]);
        float arf, aif, a64r, a64i; cexp_f(dt * lr, dt * li, arf, aif); cexp_f(64.0 * dt * lr, 64.0 * dt * li, a64r, a64i);
        const float lrf = (float)lr, lif = (float)li, den = lrf * lrf + lif * lif, nr = arf - 1.0f;
        const float zr = (nr * lrf + aif * lif) / den, zi = (aif * lrf - nr * lif) / den;
        ((float*)((char*)tab + TB_AR))[i] = arf; ((float*)((char*)tab + TB_AI))[i] = aif;
        ((float*)((char*)tab + TB_AR64))[i] = a64r; ((float*)((char*)tab + TB_AI64))[i] = a64i;
        for (int h = 0; h < 16; ++h) { const float br = in[I_BRE][i * 16 + h], bi = in[I_BIM][i * 16 + h];
            ((float*)((char*)tab + TB_BBR))[i * 16 + h] = zr * br - zi * bi; ((float*)((char*)tab + TB_BBI))[i * 16 + h] = zr * bi + zi * br; } }
    for (long idx = F.gt; idx < (long)NG * NS * 64; idx += F.NGT) { const int i = (int)(idx & 63), gn = (int)(idx >> 6), g = gn / NS, n = gn % NS;
        const double lr = in[I_LRE][gn], li = in[I_LIM][gn], dt = (double)expf(in[I_LDT][g]);
        float ar1, ai1, pr, pi_; cexp_f(dt * lr, dt * li, ar1, ai1); const double pw = (double)(63 - i); cexp_f(pw * dt * lr, pw * dt * li, pr, pi_);
        const float lrf = (float)lr, lif = (float)li, den = lrf * lrf + lif * lif, nr1 = ar1 - 1.0f;
        const float zr = (nr1 * lrf + ai1 * lif) / den, zi = (ai1 * lrf - nr1 * lif) / den;
        float vre[16], vim[16];
#pragma unroll
        for (int h = 0; h < 16; ++h) { const float br = in[I_BRE][(size_t)gn * 16 + h], bi = in[I_BIM][(size_t)gn * 16 + h]; const float bbr = zr * br - zi * bi, bbi = zr * bi + zi * br;
            vre[h] = pr * bbr - pi_ * bbi; vim[h] = pr * bbi + pi_ * bbr; }
        const int rb = n >> 3, fre = (2 * n) & 15, ks = i >> 1;
#pragma unroll
        for (int hh = 0; hh < 2; ++hh) { const int fq = (i & 1) * 2 + hh; bf16* dst = (bf16*)(ws + WS_WE) + ((((size_t)g * 8 + rb) * 32 + ks) * 64 + 16 * fq + fre) * 8;
            *(v4u*)dst = (v4u){pk2(vre[8 * hh], vre[8 * hh + 1]), pk2(vre[8 * hh + 2], vre[8 * hh + 3]), pk2(vre[8 * hh + 4], vre[8 * hh + 5]), pk2(vre[8 * hh + 6], vre[8 * hh + 7])};
            *(v4u*)(dst + 8) = (v4u){pk2(vim[8 * hh], vim[8 * hh + 1]), pk2(vim[8 * hh + 2], vim[8 * hh + 3]), pk2(vim[8 * hh + 4], vim[8 * hh + 5]), pk2(vim[8 * hh + 6], vim[8 * hh + 7])}; } }
    for (long i = F.gt; i < 1024; i += F.NGT) { const float lam = in[I_LAM][i]; ((float*)((char*)tab + TB_SP8))[i] = 8.0f * log1pf(expf(-lam)); }
    bf16* HN = (bf16*)(ws + WS_HN); float* hmeta = (float*)(ws + WS_HMETA);
    { const float* gain0 = in[I_NORM_MIX0]; const int lane = F.lane; f32x4 gg[4];
#pragma unroll
      for (int j = 0; j < 4; ++j) gg[j] = ((const f32x4*)gain0)[lane + 64 * j];
      for (int m = F.gw; m < TR; m += 4 * F.NGW) { f32x4 xv[4][4];
#pragma unroll
        for (int q = 0; q < 4; ++q) { const int mm = m + q * F.NGW; if (mm < TR) {
#pragma unroll
            for (int j = 0; j < 4; ++j) xv[q][j] = __builtin_nontemporal_load((const f32x4*)(in[I_X] + (size_t)mm * 1024) + lane + 64 * j); } }
#pragma unroll
        for (int q = 0; q < 4; ++q) { const int mm = m + q * F.NGW; if (mm < TR) { float sq = 0.f;
#pragma unroll
            for (int j = 0; j < 4; ++j) sq += (xv[q][j].x * xv[q][j].x + xv[q][j].y * xv[q][j].y) + (xv[q][j].z * xv[q][j].z + xv[q][j].w * xv[q][j].w);
            const float rstd = 1.0f / sqrtf(wave_sum(sq) * (1.0f / 1024.0f) + EPS); v2u* o8 = (v2u*)(HN + (size_t)mm * 1024) + lane;
#pragma unroll
            for (int j = 0; j < 4; ++j) { const f32x4 y = xv[q][j] * rstd * gg[j]; o8[64 * j] = (v2u){pk2(y.x, y.y), pk2(y.z, y.w)}; } } } }
      for (int m = TR + F.gw; m < TR + NMETA; m += F.NGW) norm_row_bf16(in[I_META] + (size_t)(m - TR) * 1024, gain0, HN + (size_t)m * 1024, lane); }
    for (long i = F.gt; i < NMETA * 1024; i += F.NGT) hmeta[i] = in[I_META][i];
}
__device__ __forceinline__ void norm_phase(const Frame& F, const bf16* HB, const float* hmeta, const float* gain, bf16* HN, int nrows) {
    const int lane = F.lane; const f32x4 g0 = *(const f32x4*)(gain + 8 * lane), g1 = *(const f32x4*)(gain + 8 * lane + 4), g2 = *(const f32x4*)(gain + 512 + 8 * lane), g3 = *(const f32x4*)(gain + 512 + 8 * lane + 4);
    for (int m = F.gw; m < TR; m += 4 * F.NGW) { v4u xa[4], xb[4];
#pragma unroll
        for (int q = 0; q < 4; ++q) { const int mm = m + q * F.NGW; if (mm < TR) { xa[q] = *(const v4u*)(HB + (size_t)mm * 1024 + 8 * lane); xb[q] = *(const v4u*)(HB + (size_t)mm * 1024 + 512 + 8 * lane); } }
#pragma unroll
        for (int q = 0; q < 4; ++q) { const int mm = m + q * F.NGW; if (mm < TR) { f32x4 v[4]; unpack8(xa[q], v[0], v[1]); unpack8(xb[q], v[2], v[3]); float sq = 0.f;
#pragma unroll
            for (int j = 0; j < 4; ++j) sq += (v[j].x * v[j].x + v[j].y * v[j].y) + (v[j].z * v[j].z + v[j].w * v[j].w);
            const float rstd = 1.0f / sqrtf(wave_sum(sq) * (1.0f / 1024.0f) + EPS);
            *(v4u*)(HN + (size_t)mm * 1024 + 8 * lane) = pack8(v[0] * rstd * g0, v[1] * rstd * g1); *(v4u*)(HN + (size_t)mm * 1024 + 512 + 8 * lane) = pack8(v[2] * rstd * g2, v[3] * rstd * g3); } } }
    for (int m = TR + F.gw; m < nrows; m += F.NGW) norm_row_bf16(hmeta + (size_t)(m - TR) * 1024, gain, HN + (size_t)m * 1024, F.lane);
}
__device__ __forceinline__ float row16_sum(float q) {
    q += __builtin_bit_cast(float, __builtin_amdgcn_update_dpp(0, __builtin_bit_cast(int, q), 0xB1, 0xF, 0xF, true));
    q += __builtin_bit_cast(float, __builtin_amdgcn_update_dpp(0, __builtin_bit_cast(int, q), 0x4E, 0xF, 0xF, true));
    q += __builtin_bit_cast(float, __builtin_amdgcn_update_dpp(0, __builtin_bit_cast(int, q), 0x141, 0xF, 0xF, true));
    q += __builtin_bit_cast(float, __builtin_amdgcn_update_dpp(0, __builtin_bit_cast(int, q), 0x140, 0xF, 0xF, true));
    return q;
}
__device__ __forceinline__ int cu_queue_next(LAS int* q, int lane) { int v = 0; if (lane == 0) v = __hip_atomic_fetch_add(q, 1, __ATOMIC_RELAXED, __HIP_MEMORY_SCOPE_WORKGROUP); return __builtin_amdgcn_readfirstlane(v); }
__device__ __forceinline__ const bf16* meta_norm_local(const Frame& F, unsigned char* ws, const float* hmeta) {
    bf16* priv = (bf16*)(ws + WS_MPRIV) + (size_t)blockIdx.x * NMETA * 1024;
    for (int r = F.wave; r < NMETA; r += 8) { const f32x4* xr = (const f32x4*)(hmeta + (size_t)r * 1024) + F.lane; f32x4 v[4]; float sq = 0.f;
#pragma unroll
        for (int j = 0; j < 4; ++j) { v[j] = xr[64 * j]; sq += (v[j].x * v[j].x + v[j].y * v[j].y) + (v[j].z * v[j].z + v[j].w * v[j].w); }
        const float rstd = 1.0f / sqrtf(wave_sum(sq) * (1.0f / 1024.0f) + EPS); v2u* o8 = (v2u*)(priv + (size_t)r * 1024) + F.lane;
#pragma unroll
        for (int j = 0; j < 4; ++j) { const f32x4 y = v[j] * rstd; o8[64 * j] = (v2u){pk2(y.x, y.y), pk2(y.z, y.w)}; } }
    asm volatile("s_waitcnt vmcnt(0)" ::: "memory"); __syncthreads();
    return priv;
}
__device__ __forceinline__ int seq_prev(int row, int back) {
    if (row >= TR) { const int i = row - TR - back; return i >= 0 ? TR + i : -1; }
    const int t = row & (SEQ - 1); return t >= back ? row - back : TR + NMETA + (t - back);
}
__device__ __forceinline__ void conv_item(int i, const bf16* XR, const float* cw, const float* cb, bf16* XC) {
    if (i < (TR / 32 + 1) * 128) { const int c = (int)(i & 127) * 8, st = (int)(i >> 7); const bool meta = st >= TR / 32; const int r0 = meta ? RM0 : st * 32, nr = meta ? NMETA : 32;
        f32x4 w[4][2]; f32x4 b0 = *(const f32x4*)(cb + c), b1 = *(const f32x4*)(cb + c + 4);
#pragma unroll
        for (int k = 0; k < 4; ++k) { w[k][0] = *(const f32x4*)(cw + k * 1024 + c); w[k][1] = *(const f32x4*)(cw + k * 1024 + c + 4); }
        f32x4 h[3][2];
#pragma unroll
        for (int k = 0; k < 3; ++k) { const int src = seq_prev(r0, 3 - k); if (src >= 0) unpack8(*(const v4u*)(XR + (size_t)src * 1024 + c), h[k][0], h[k][1]); else { h[k][0] = (f32x4){0.f, 0.f, 0.f, 0.f}; h[k][1] = h[k][0]; } }
        for (int t0 = 0; t0 < nr; t0 += 8) { v4u x[8];
#pragma unroll
            for (int t = 0; t < 8; ++t) x[t] = *(const v4u*)(XR + (size_t)(r0 + t0 + t) * 1024 + c);
#pragma unroll
            for (int t = 0; t < 8; ++t) { f32x4 c0, c1; unpack8(x[t], c0, c1);
                const f32x4 o0 = b0 + w[0][0] * h[0][0] + w[1][0] * h[1][0] + w[2][0] * h[2][0] + w[3][0] * c0, o1 = b1 + w[0][1] * h[0][1] + w[1][1] * h[1][1] + w[2][1] * h[2][1] + w[3][1] * c1;
                *(v4u*)(XC + (size_t)(r0 + t0 + t) * 1024 + c) = pack8(o0, o1);
                h[0][0] = h[1][0]; h[0][1] = h[1][1]; h[1][0] = h[2][0]; h[1][1] = h[2][1]; h[2][0] = c0; h[2][1] = c1; } } }
}
__device__ __forceinline__ void conv_fix_item(int i, const bf16* XR, const float* cw, const float* cb, bf16* XC) {
    if (i < (TR / 64) * 128) { const int c = (i & 127) * 8, r0 = (i >> 7) * 64;
        f32x4 w[4][2]; const f32x4 b0 = *(const f32x4*)(cb + c), b1 = *(const f32x4*)(cb + c + 4);
#pragma unroll
        for (int k = 0; k < 4; ++k) { w[k][0] = *(const f32x4*)(cw + k * 1024 + c); w[k][1] = *(const f32x4*)(cw + k * 1024 + c + 4); }
        v4u hx[3], xx[3];
#pragma unroll
        for (int k = 0; k < 3; ++k) { const int src = seq_prev(r0, 3 - k); hx[k] = *(const v4u*)(XR + (size_t)src * 1024 + c); xx[k] = *(const v4u*)(XR + (size_t)(r0 + k) * 1024 + c); }
        f32x4 h[3][2];
#pragma unroll
        for (int k = 0; k < 3; ++k) unpack8(hx[k], h[k][0], h[k][1]);
#pragma unroll
        for (int t = 0; t < 3; ++t) { f32x4 c0, c1; unpack8(xx[t], c0, c1);
            const f32x4 o0 = b0 + w[0][0] * h[0][0] + w[1][0] * h[1][0] + w[2][0] * h[2][0] + w[3][0] * c0, o1 = b1 + w[0][1] * h[0][1] + w[1][1] * h[1][1] + w[2][1] * h[2][1] + w[3][1] * c1;
            *(v4u*)(XC + (size_t)(r0 + t) * 1024 + c) = pack8(o0, o1);
            h[0][0] = h[1][0]; h[0][1] = h[1][1]; h[1][0] = h[2][0]; h[1][1] = h[2][1]; h[2][0] = c0; h[2][1] = c1; } }
}
constexpr int SSM_HP = 68, SSM_XP = 132;
constexpr int SSM_WLDS = 16 * SSM_XP * 4 + 16 * SSM_HP * 4;
struct SsmTab { float ar, ai; bf16x8 axf[8]; bf16x8 ca[4]; f32x4 dv; };
__device__ __forceinline__ void ssm_tab_load(SsmTab& T, const unsigned char* ws, const float* cre, const float* cim, const float* sd, int g, int lane) {
    const float* tab = (const float*)(ws + WS_TAB); const int gn = g * NS + lane, fr = lane & 15, fq = lane >> 4;
    T.ar = ((const float*)((const char*)tab + TB_AR))[gn]; T.ai = ((const float*)((const char*)tab + TB_AI))[gn];
#pragma unroll
    for (int rb = 0; rb < 8; ++rb) { const int r = 16 * rb + fr, n = r >> 1; const float* src = (const float*)((const char*)tab + ((r & 1) ? TB_BBI : TB_BBR)) + (size_t)(g * NS + n) * 16 + 8 * (fq & 1);
        v4u w = pack8(*(const f32x4*)src, *(const f32x4*)(src + 4)); if (fq >= 2) w = (v4u){0u, 0u, 0u, 0u}; T.axf[rb] = __builtin_bit_cast(bf16x8, w); }
#pragma unroll
    for (int ks = 0; ks < 4; ++ks) { const int n0 = 16 * ks + 4 * fq; const f32x4 cr = *(const f32x4*)(cre + (g * 16 + fr) * NS + n0), ci = *(const f32x4*)(cim + (g * 16 + fr) * NS + n0);
        v4u w; w.x = pk2(cr[0], -ci[0]); w.y = pk2(cr[1], -ci[1]); w.z = pk2(cr[2], -ci[2]); w.w = pk2(cr[3], -ci[3]); T.ca[ks] = __builtin_bit_cast(bf16x8, w); }
    T.dv = *(const f32x4*)(sd + g * 16 + 4 * fq);
}
__device__ __forceinline__ void ssm_wave(const SsmTab& T, const bf16* U, bf16* GS, int g, int row0, int ntok, float& hr, float& hi, int lane, LAS unsigned char* wl) {
    LAS float* xb = (LAS float*)wl; LAS unsigned* hb = (LAS unsigned*)(wl + 16 * SSM_XP * 4);
    const int fr = lane & 15, fq = lane >> 4; const float ar = T.ar, ai = T.ai;
    const f32x4 dv = T.dv;
    const bf16* ubase = U + (size_t)(row0 + fr) * 512 + g * 16;
    v4u bnx = {0u, 0u, 0u, 0u}; if (fq < 2) bnx = *(const v4u*)(ubase + 8 * fq);
    v2u unx = *(const v2u*)(ubase + 4 * fq);
    for (int t0 = 0; t0 < ntok; t0 += 16) {
        const v4u bw = bnx; const v2u uw = unx;
        if (t0 + 16 < ntok) { const bf16* un = ubase + (size_t)(t0 + 16) * 512; if (fq < 2) bnx = *(const v4u*)(un + 8 * fq); unx = *(const v2u*)(un + 4 * fq); }
        const bf16x8 bfr = __builtin_bit_cast(bf16x8, bw);
#pragma unroll
        for (int rb = 0; rb < 8; ++rb) { const f32x4 xa = __builtin_amdgcn_mfma_f32_16x16x32_bf16(T.axf[rb], bfr, (f32x4){0.f, 0.f, 0.f, 0.f}, 0, 0, 0); *(LAS f32x4*)(xb + fr * SSM_XP + 16 * rb + 4 * fq) = xa; }
        asm volatile("" ::: "memory");
#pragma unroll 4
        for (int tl = 0; tl < 16; ++tl) { const f32x2 x = *(const LAS f32x2*)(xb + tl * SSM_XP + 2 * lane);
            const float nr = ar * hr - ai * hi + x.x, ni = ar * hi + ai * hr + x.y; hr = nr; hi = ni;
            hb[tl * SSM_HP + lane] = pg8::cvt_pk_bf16(hr, hi); }
        asm volatile("" ::: "memory");
        f32x4 y = {0.f, 0.f, 0.f, 0.f};
#pragma unroll
        for (int ks = 0; ks < 4; ++ks) { const bf16x8 hbf = *(const LAS bf16x8*)(hb + fr * SSM_HP + 16 * ks + 4 * fq); y = __builtin_amdgcn_mfma_f32_16x16x32_bf16(T.ca[ks], hbf, y, 0, 0, 0); }
        const f32x4 go_ = gelu_tanh_4(y + dv * (f32x4){bflo(uw.x), bfhi(uw.x), bflo(uw.y), bfhi(uw.y)}); const float o0 = go_.x, o1 = go_.y, o2 = go_.z, o3 = go_.w;
        *(v2u*)(GS + (size_t)(row0 + t0 + fr) * 512 + g * 16 + 4 * fq) = (v2u){pk2(o0, o1), pk2(o2, o3)};
        asm volatile("" ::: "memory");
    }
    LDS_WAIT(); asm volatile("" ::: "memory");
}
__device__ __forceinline__ void ssm_l1_item(const Frame& F, int it, const unsigned char* ws, const bf16* U, float* SSE) {
    const int lane = F.lane, fr = lane & 15, fq = lane >> 4;
    if (it < NG * 32) { const int g = it >> 5, cb = it & 31, bc = cb * 16 + fr;
        const bf16* ap = (const bf16*)(ws + WS_WE) + ((size_t)g * 8 * 32 * 64 + lane) * 8;
        const bf16* bp = U + ((size_t)bc * 64 + (fq >> 1)) * 512 + g * 16 + 8 * (fq & 1);
        f32x4 acc[8];
#pragma unroll
        for (int rb = 0; rb < 8; ++rb) acc[rb] = (f32x4){0.f, 0.f, 0.f, 0.f};
#pragma unroll 4
        for (int ks = 0; ks < 32; ++ks) { const bf16x8 bfr = *(const bf16x8*)(bp + (size_t)ks * 2 * 512);
#pragma unroll
            for (int rb = 0; rb < 8; ++rb) { const bf16x8 afr = *(const bf16x8*)(ap + ((size_t)rb * 32 + ks) * 512); acc[rb] = __builtin_amdgcn_mfma_f32_16x16x32_bf16(afr, bfr, acc[rb], 0, 0, 0); } }
#pragma unroll
        for (int rb = 0; rb < 8; ++rb) *(f32x4*)(SSE + (((size_t)bc * NG + g) * NS + 8 * rb + 2 * fq) * 2) = acc[rb]; }
}
__device__ __forceinline__ void lru_l1_item(int lane, int bc, int ch, const bf16* A, const bf16* BX, float* PEND, float* HEND) {
    const int half = lane >> 5; const size_t r0 = (size_t)bc * 64 + half * 32;
    f32x4 P0 = {0.f, 0.f, 0.f, 0.f}, P1 = P0, H0 = P0, H1 = P0;
    for (int t0 = 0; t0 < 32; t0 += 8) { v4u la[8], bx[8];
#pragma unroll
        for (int t = 0; t < 8; ++t) { la[t] = *(const v4u*)(A + (r0 + t0 + t) * 1024 + ch); bx[t] = *(const v4u*)(BX + (r0 + t0 + t) * 1024 + ch); }
#pragma unroll
        for (int t = 0; t < 8; ++t) { f32x4 l0, l1, b0, b1; unpack8(la[t], l0, l1); unpack8(bx[t], b0, b1); P0 += l0; P1 += l1;
            H0 = exp2_4(l0 * 1.4426950408889634f) * H0 + b0; H1 = exp2_4(l1 * 1.4426950408889634f) * H1 + b1; } }
    f32x4 oP0, oP1, oH0, oH1;
#pragma unroll
    for (int j = 0; j < 4; ++j) { oP0[j] = __shfl_xor(P0[j], 32); oP1[j] = __shfl_xor(P1[j], 32); oH0[j] = __shfl_xor(H0[j], 32); oH1[j] = __shfl_xor(H1[j], 32); }
    if (half) {
#pragma unroll
        for (int j = 0; j < 4; ++j) { H0[j] = H0[j] + __expf(P0[j]) * oH0[j]; H1[j] = H1[j] + __expf(P1[j]) * oH1[j]; P0[j] = __expf(P0[j] + oP0[j]); P1[j] = __expf(P1[j] + oP1[j]); }
        float* pp = PEND + (size_t)bc * 1024 + ch; float* hp = HEND + (size_t)bc * 1024 + ch; *(f32x4*)pp = P0; *(f32x4*)(pp + 4) = P1; *(f32x4*)hp = H0; *(f32x4*)(hp + 4) = H1; }
}
__device__ __forceinline__ void carry_phase(const Frame& F, const unsigned char* ws, const bf16* A, const bf16* BX, const float* PEND, const float* HEND, float* CIN, const bf16* U, const float* SSE, float* SSIN) {
    const int gti = (F.wave * F.G + (int)blockIdx.x) * 64 + F.lane;
    if (gti < NB * 1024) { const int ch = gti & 1023, b = gti >> 10; float H = 0.f;
        { float ma[NMETA], mb[NMETA];
#pragma unroll
          for (int i = 0; i < NMETA; ++i) { const size_t r = (size_t)(RM0 + i); ma[i] = bf2f(A[r * 1024 + ch]); mb[i] = bf2f(BX[r * 1024 + ch]); }
#pragma unroll
          for (int i = 0; i < NMETA; ++i) H = __expf(ma[i]) * H + mb[i]; }
        for (int c0 = 0; c0 < NCH; c0 += 32) { float pp[32], hh[32];
#pragma unroll
            for (int c = 0; c < 32; ++c) { const size_t o = ((size_t)b * NCH + c0 + c) * 1024 + ch; pp[c] = PEND[o]; hh[c] = HEND[o]; }
#pragma unroll
            for (int c = 0; c < 32; ++c) { const size_t o = ((size_t)b * NCH + c0 + c) * 1024 + ch; CIN[o] = H; H = hh[c] + pp[c] * H; } }
    } else if (gti >= 8 * 512 && gti < 8 * 512 + NB * NG * NS) { const int id = gti - 8 * 512, n = id % NS, g = (id / NS) % NG, b = id / (NS * NG), gn = g * NS + n;
        const float* tab = (const float*)(ws + WS_TAB);
        const float ar = ((const float*)((const char*)tab + TB_AR))[gn], ai = ((const float*)((const char*)tab + TB_AI))[gn], ar64 = ((const float*)((const char*)tab + TB_AR64))[gn], ai64 = ((const float*)((const char*)tab + TB_AI64))[gn];
        float hr = 0.f, hi = 0.f;
        { f32x4 br[4], bi[4];
#pragma unroll
          for (int q = 0; q < 4; ++q) { br[q] = *(const f32x4*)((const char*)tab + TB_BBR + ((size_t)gn * 16 + 4 * q) * 4); bi[q] = *(const f32x4*)((const char*)tab + TB_BBI + ((size_t)gn * 16 + 4 * q) * 4); }
          for (int i0 = 0; i0 < NMETA; i0 += 8) { v4u uu[8][2];
#pragma unroll
            for (int i = 0; i < 8; ++i) { const bf16* up = U + (size_t)(RM0 + i0 + i) * 512 + g * 16; uu[i][0] = *(const v4u*)up; uu[i][1] = *(const v4u*)(up + 8); }
#pragma unroll
            for (int i = 0; i < 8; ++i) { f32x4 u0, u1, u2, u3; unpack8(uu[i][0], u0, u1); unpack8(uu[i][1], u2, u3); float xr = 0.f, xi = 0.f;
#pragma unroll
                for (int j = 0; j < 4; ++j) { xr += br[0][j] * u0[j]; xi += bi[0][j] * u0[j]; }
#pragma unroll
                for (int j = 0; j < 4; ++j) { xr += br[1][j] * u1[j]; xi += bi[1][j] * u1[j]; }
#pragma unroll
                for (int j = 0; j < 4; ++j) { xr += br[2][j] * u2[j]; xi += bi[2][j] * u2[j]; }
#pragma unroll
                for (int j = 0; j < 4; ++j) { xr += br[3][j] * u3[j]; xi += bi[3][j] * u3[j]; }
                const float nr = ar * hr - ai * hi + xr, ni = ar * hi + ai * hr + xi; hr = nr; hi = ni; } } }
        for (int c0 = 0; c0 < NCH; c0 += 32) { f32x2 ee[32];
#pragma unroll
            for (int c = 0; c < 32; ++c) ee[c] = ((const f32x2*)SSE)[(((size_t)b * NCH + c0 + c) * NG + g) * NS + n];
#pragma unroll
            for (int c = 0; c < 32; ++c) { ((f32x2*)SSIN)[(((size_t)b * NCH + c0 + c) * NG + g) * NS + n] = (f32x2){hr, hi};
                const float nr = ar64 * hr - ai64 * hi + ee[c].x, ni = ar64 * hi + ai64 * hr + ee[c].y; hr = nr; hi = ni; } }
    }
}
__device__ __forceinline__ void mix0_final_phase(const Frame& F, const unsigned char* ws, const bf16* A, const bf16* BX, const float* CIN, const bf16* G, bf16* AOUT, const float* cre, const float* cim, const float* sd, const bf16* U, const float* SSIN, bf16* GS) {
    LAS int* q = (LAS int*)(F.lds + TABL_OFF); if (F.tid == 0) *q = 0; __syncthreads();
    const int cu = (int)blockIdx.x, NLW = (NB * NCH * 128 + 128) / 64, NLQ = (NLW + F.G - 1) / F.G, NSI = NB * NCH * NG + NG, NSQ = (NSI + F.G - 1) / F.G;
    SsmTab T; int gcur = -1;
    for (;;) { const int e = cu_queue_next(q, F.lane); if (e >= NLQ + NSQ) break;
      if (e < NLQ) { const int wi = cu + F.G * e; if (wi < NLW) { const int i = wi * 64 + F.lane; const int ch = (int)(i & 127) * 8, bc = (int)(i >> 7); const bool meta = bc >= NB * NCH;
        const size_t r0 = meta ? (size_t)RM0 : (size_t)bc * 64; const int nt = meta ? NMETA : 64; f32x4 H0 = {0.f, 0.f, 0.f, 0.f}, H1 = H0;
        if (!meta) { H0 = *(const f32x4*)(CIN + (size_t)bc * 1024 + ch); H1 = *(const f32x4*)(CIN + (size_t)bc * 1024 + ch + 4); }
        for (int t0 = 0; t0 < nt; t0 += 8) { v4u la[8], bx[8], gg[8];
#pragma unroll
            for (int t = 0; t < 8; ++t) { const size_t r = r0 + t0 + t; la[t] = *(const v4u*)(A + r * 1024 + ch); bx[t] = *(const v4u*)(BX + r * 1024 + ch); gg[t] = *(const v4u*)(G + r * 1024 + ch); }
#pragma unroll
            for (int t = 0; t < 8; ++t) { f32x4 l0, l1, b0, b1, g0, g1; unpack8(la[t], l0, l1); unpack8(bx[t], b0, b1); unpack8(gg[t], g0, g1);
                H0 = exp2_4(l0 * 1.4426950408889634f) * H0 + b0; H1 = exp2_4(l1 * 1.4426950408889634f) * H1 + b1;
                *(v4u*)(AOUT + (r0 + t0 + t) * 1536 + ch) = pack8(g0 * H0, g1 * H1); } } }
      } else { const int it = cu + F.G * (e - NLQ); if (it < NSI) { const bool meta = it >= NB * NCH * NG; const int g = it % NG, bc = it / NG;
        if (g != gcur) { ssm_tab_load(T, ws, cre, cim, sd, g, F.lane); gcur = g; }
        float hr = 0.f, hi = 0.f; if (!meta) { const f32x2 s_ = ((const f32x2*)SSIN)[(size_t)it * NS + F.lane]; hr = s_.x; hi = s_.y; }
        ssm_wave(T, U, GS, g, meta ? RM0 : bc * 64, meta ? NMETA : 64, hr, hi, F.lane, F.lds + RING_OFF + F.wave * SSM_WLDS); } }
    }
}
template <int NACC>
__device__ __forceinline__ void meta_tile(const Frame& F, const bf16* A16, int lda, int K, const bf16* const (&Brow)[NACC], int ldb, f32x4 (&out)[NACC]) {
    LAS f32x4* red = (LAS f32x4*)(F.lds + RING_OFF);
    const int lane = F.lane, fr = lane & 15, fq = lane >> 4, w = F.wave, ks = K / 8;
    f32x4 acc[NACC];
#pragma unroll
    for (int a = 0; a < NACC; ++a) acc[a] = (f32x4){0.f, 0.f, 0.f, 0.f};
#pragma unroll 4
    for (int k0 = w * ks; k0 < (w + 1) * ks; k0 += 32) {
        const bf16x8 af = *(const bf16x8*)(A16 + (size_t)fr * lda + k0 + 8 * fq);
#pragma unroll
        for (int a = 0; a < NACC; ++a) { const bf16x8 bfz = *(const bf16x8*)(Brow[a] + (size_t)fr * ldb + k0 + 8 * fq); acc[a] = __builtin_amdgcn_mfma_f32_16x16x32_bf16(bfz, af, acc[a], 0, 0, 0); } }
    __syncthreads();
#pragma unroll
    for (int a = 0; a < NACC; ++a) red[(w * NACC + a) * 64 + lane] = acc[a];
    __syncthreads();
#pragma unroll
    for (int a = 0; a < NACC; ++a) { f32x4 sacc = red[a * 64 + lane];
#pragma unroll
        for (int ww = 1; ww < 8; ++ww) sacc += red[(ww * NACC + a) * 64 + lane];
        out[a] = sacc; }
}
template <class Fn> __device__ __forceinline__ bf16x8 frag8(Fn f) { bf16x8 r;
#pragma unroll
    for (int j = 0; j < 8; ++j) r[j] = (short)f(j);
    return r; }
constexpr int GL_LB = 0, GL_QT = 32768, GL_KT = 50176, GL_KH = 67584, GL_VT = 86016, GL_GM = 120832, GL_BL = 121344, GL_SSQ = 121856, GL_TQ = 123904;
constexpr int PQ = 136, PKH = 144, PV = 272, PATT = 72, POT = 264;
#define TR_FRAG(dst, base, off, rows4) do { v2u _lo, _hi; \
    asm volatile("ds_read_b64_tr_b16 %0, %2 offset:%c3\n\tds_read_b64_tr_b16 %1, %2 offset:%c4\n\ts_waitcnt lgkmcnt(0)" : "=&v"(_lo), "=&v"(_hi) : "v"(base), "i"(off), "i"((off) + (rows4)) : "memory"); \
    const v4u _w = {_lo.x, _lo.y, _hi.x, _hi.y}; dst = __builtin_bit_cast(bf16x8, _w); } while (0)
__device__ __forceinline__ unsigned lds_addr(const LAS void* p) { return (unsigned)(unsigned long)p; }
template <bool FINAL>
__device__ __forceinline__ void gla_item(const Frame& F, int b, int h, int s, const bf16* Q, const bf16* K, const bf16* V, const bf16* GATE, const bf16* LG, const float* gnorm, bf16* GDS, float* GAM, bf16* AOUT2) {
    LAS float* LB = (LAS float*)(F.lds + GL_LB); LAS bf16* ATT = (LAS bf16*)(F.lds + GL_LB);
    LAS bf16* QT = (LAS bf16*)(F.lds + GL_QT); LAS bf16* KT = (LAS bf16*)(F.lds + GL_KT); LAS bf16* KH = (LAS bf16*)(F.lds + GL_KH); LAS bf16* VT = (LAS bf16*)(F.lds + GL_VT);
    LAS float* GM = (LAS float*)(F.lds + GL_GM); LAS float* BL = (LAS float*)(F.lds + GL_BL); LAS float* SSQ = (LAS float*)(F.lds + GL_SSQ);
    const int tid = F.tid, w = F.wave, lane = F.lane, fr = lane & 15, h4 = lane >> 4, tq = fr >> 2, tp = fr & 3;
    const int bh = b * GH + h; const size_t sbase = ((size_t)(bh * NSEG + s) * 128) * 256;
    const unsigned vtr = lds_addr(VT) + (unsigned)((8 * h4 + tq) * PV + 32 * w + 4 * tp) * 2u;
    const unsigned ktr = lds_addr(KH) + (unsigned)((8 * h4 + tq) * PKH + 4 * tp) * 2u;
    f32x4 S[8][2];
    bf16* simg = GDS + sbase + ((size_t)w * 64 + lane) * 64;
#pragma unroll
    for (int kb = 0; kb < 8; ++kb) { if (FINAL) unpack8(*(const v4u*)(simg + 8 * kb), S[kb][0], S[kb][1]); else { S[kb][0] = (f32x4){0.f, 0.f, 0.f, 0.f}; S[kb][1] = S[kb][0]; } }
    float gsum = 0.f;
    LAS float* TQ = (LAS float*)(F.lds + GL_TQ);
    v4u pfl[2], pfv[4], pfk[2], pfq[2];
    const unsigned vo_lg = (unsigned)(((tid >> 5) * 512 + (tid & 31) * 4) * 4), vo_kq = (unsigned)(((tid >> 4) * 512 + (tid & 15) * 8) * 2), vo_v = (unsigned)(((tid >> 5) * 1024 + (tid & 31) * 8) * 2);
    const int lo_lb = (tid >> 5) * 128 + (tid & 31) * 4, lo_vt = (tid >> 5) * PV + (tid & 31) * 8, lo_ot = (tid >> 5) * POT + (tid & 31) * 8, t3 = tid >> 4, k8 = (tid & 15) * 8;
#define GLA_LOAD(cc, dep) do { const size_t r0n = (size_t)b * SEQ + (size_t)(s * SEGC + (cc)) * 64; unsigned pin_ = 0; asm volatile("" : "+v"(pin_) : "v"(dep));   \
        _Pragma("unroll") for (int j = 0; j < 2; ++j) pfl[j] = *(const v4u*)((const char*)(LG + (r0n + 32 * j) * 512 + h * 128) + (vo_kq + pin_)); \
        _Pragma("unroll") for (int j = 0; j < 2; ++j) { pfk[j] = *(const v4u*)((const char*)(K + (r0n + 32 * j) * 512 + h * 128) + (vo_kq + pin_)); if (FINAL) pfq[j] = *(const v4u*)((const char*)(Q + (r0n + 32 * j) * 512 + h * 128) + (vo_kq + pin_)); } } while (0)
#define GLA_LOADV(cc, dep) do { const size_t r0n = (size_t)b * SEQ + (size_t)(s * SEGC + (cc)) * 64; unsigned pin_ = 0; asm volatile("" : "+v"(pin_) : "v"(dep)); \
        _Pragma("unroll") for (int j = 0; j < 4; ++j) pfv[j] = *(const v4u*)((const char*)(V + (r0n + 16 * j) * 1024 + h * 256) + (vo_v + pin_)); } while (0)
#define GLA_STEP6() do { \
        _Pragma("unroll") for (int kb = 0; kb < 8; ++kb) { const f32x4 gm = *(const LAS f32x4*)(GM + 16 * kb + 4 * h4); \
            _Pragma("unroll") for (int vb = 0; vb < 2; ++vb) S[kb][vb] = S[kb][vb] * gm; } \
        _Pragma("unroll") for (int ts = 0; ts < 2; ++ts) { bf16x8 bv[2]; \
            _Pragma("unroll") for (int vb = 0; vb < 2; ++vb) TR_FRAG(bv[vb], vtr, (32 * ts * PV + 16 * vb) * 2, 4 * PV * 2); \
            _Pragma("unroll") for (int kb = 0; kb < 8; ++kb) { bf16x8 a; TR_FRAG(a, ktr, (32 * ts * PKH + 16 * kb) * 2, 4 * PKH * 2); \
                _Pragma("unroll") for (int vb = 0; vb < 2; ++vb) S[kb][vb] = __builtin_amdgcn_mfma_f32_16x16x32_bf16(a, bv[vb], S[kb][vb], 0, 0, 0); } } } while (0)
    GLA_LOAD(0, gsum); GLA_LOADV(0, gsum);
#pragma unroll
    for (int j = 0; j < 2; ++j) { f32x4 l0_, l1_; unpack8(pfl[j], l0_, l1_); *(LAS f32x4*)(LB + (t3 + 32 * j) * 128 + k8) = l0_; *(LAS f32x4*)(LB + (t3 + 32 * j) * 128 + k8 + 4) = l1_; }
    __syncthreads();
#pragma nounroll
    for (int c = 0; c < SEGC; ++c) {
        const size_t row0 = (size_t)b * SEQ + (size_t)(s * SEGC + c) * 64;
        v4u kwr[2], qwr[2];
#pragma unroll
        for (int j = 0; j < 2; ++j) { kwr[j] = pfk[j]; if (FINAL) qwr[j] = pfq[j]; }
        if (!FINAL) { if (c + 1 < SEGC) GLA_LOAD(c + 1, __uint_as_float(kwr[1].w)); }
        { const int kc = tid & 127, qt_ = tid >> 7; float xs[16];
#pragma unroll
          for (int t = 0; t < 16; ++t) xs[t] = LB[(16 * qt_ + t) * 128 + kc];
          asm volatile("" ::: "memory");
#pragma unroll
          for (int t = 1; t < 16; ++t) xs[t] += xs[t - 1];
          TQ[qt_ * 128 + kc] = xs[15];
          __syncthreads();
          const float t0_ = TQ[kc], t1_ = TQ[128 + kc], t2_ = TQ[256 + kc], t3_ = TQ[384 + kc];
          const float off = qt_ == 0 ? 0.f : qt_ == 1 ? t0_ : qt_ == 2 ? t0_ + t1_ : (t0_ + t1_) + t2_;
#pragma unroll
          for (int t = 0; t < 16; ++t) LB[(16 * qt_ + t) * 128 + kc] = xs[t] + off;
          if (qt_ == 0) { const float tot = ((t0_ + t1_) + t2_) + t3_; BL[kc] = tot; GM[kc] = __builtin_amdgcn_exp2f(tot); gsum += tot; } }
        __syncthreads();
#pragma unroll
        for (int j = 0; j < 4; ++j) *(LAS v4u*)(VT + lo_vt + j * 16 * PV) = pfv[j];
#pragma unroll
        for (int j = 0; j < 2; ++j) { const int t = t3 + 32 * j;
            f32x4 k0, k1; unpack8(kwr[j], k0, k1);
            const f32x4 b0 = *(const LAS f32x4*)(LB + t * 128 + k8), b1 = *(const LAS f32x4*)(LB + t * 128 + k8 + 4);
            if (!FINAL) { const f32x4 l0 = *(const LAS f32x4*)(BL + k8), l1 = *(const LAS f32x4*)(BL + k8 + 4);
                *(LAS v4u*)(KH + t * PKH + k8) = pack8(k0 * exp2_4(l0 - b0), k1 * exp2_4(l1 - b1)); }
            if (FINAL) { f32x4 q0, q1; unpack8(qwr[j], q0, q1);
                const f32x4 g0 = *(const LAS f32x4*)(GM + k8), g1 = *(const LAS f32x4*)(GM + k8 + 4);
                const f32x4 kt0 = k0 * exp2_4(b0 * -1.0f), kt1 = k1 * exp2_4(b1 * -1.0f);
                *(LAS v4u*)(KH + t * PKH + k8) = pack8(kt0 * g0, kt1 * g1);
                const int kp = (k8 & ~31) + 8 * ((k8 & 15) >> 2) + 4 * ((k8 >> 4) & 1);
                const v4u pq_ = pack8(q0 * exp2_4(b0), q1 * exp2_4(b1)), pk_ = pack8(kt0, kt1);
                *(LAS v2u*)(QT + t * PQ + kp) = (v2u){pq_.x, pq_.y}; *(LAS v2u*)(QT + t * PQ + kp + 8) = (v2u){pq_.z, pq_.w};
                *(LAS v2u*)(KT + t * PQ + kp) = (v2u){pk_.x, pk_.y}; *(LAS v2u*)(KT + t * PQ + kp + 8) = (v2u){pk_.z, pk_.w}; } }
        __syncthreads();
        if (!FINAL) { if (c + 1 < SEGC) GLA_LOADV(c + 1, gsum); }
        f32x4 o[4][2];
        if (FINAL) {
            { const int tb = w >> 1;
#pragma unroll
              for (int q = 0; q < 2; ++q) { const int sb = 2 * (w & 1) + q; f32x4 acc = {0.f, 0.f, 0.f, 0.f};
                if (sb <= tb) {
#pragma unroll
                    for (int ks = 0; ks < 4; ++ks) { const bf16x8 a = *(const LAS bf16x8*)(QT + (16 * tb + fr) * PQ + 32 * ks + 8 * h4), bq = *(const LAS bf16x8*)(KT + (16 * sb + fr) * PQ + 32 * ks + 8 * h4);
                        acc = __builtin_amdgcn_mfma_f32_16x16x32_bf16(a, bq, acc, 0, 0, 0); } }
#pragma unroll
                for (int r = 0; r < 4; ++r) { const int tl = 4 * h4 + r; const float val = (sb < tb || (sb == tb && fr <= tl)) ? acc[r] : 0.f; ATT[(16 * tb + tl) * PATT + 16 * sb + fr] = (bf16)f2bf(val); } } }
#pragma unroll
            for (int tb = 0; tb < 4; ++tb)
#pragma unroll
                for (int vb = 0; vb < 2; ++vb) o[tb][vb] = (f32x4){0.f, 0.f, 0.f, 0.f};
#pragma unroll
            for (int i = 0; i < 4; ++i) { bf16x8 bs[2];
#pragma unroll
                for (int vb = 0; vb < 2; ++vb) { v4u wv; wv.x = pk2(S[2 * i][vb][0], S[2 * i][vb][1]); wv.y = pk2(S[2 * i][vb][2], S[2 * i][vb][3]); wv.z = pk2(S[2 * i + 1][vb][0], S[2 * i + 1][vb][1]); wv.w = pk2(S[2 * i + 1][vb][2], S[2 * i + 1][vb][3]); bs[vb] = __builtin_bit_cast(bf16x8, wv); }
#pragma unroll
                for (int tb = 0; tb < 4; ++tb) { const bf16x8 a = *(const LAS bf16x8*)(QT + (16 * tb + fr) * PQ + 32 * i + 8 * h4);
#pragma unroll
                    for (int vb = 0; vb < 2; ++vb) o[tb][vb] = __builtin_amdgcn_mfma_f32_16x16x32_bf16(a, bs[vb], o[tb][vb], 0, 0, 0); } }
            __syncthreads();
#pragma unroll
            for (int ss = 0; ss < 2; ++ss) { bf16x8 bv[2];
#pragma unroll
                for (int vb = 0; vb < 2; ++vb) TR_FRAG(bv[vb], vtr, (32 * ss * PV + 16 * vb) * 2, 4 * PV * 2);
#pragma unroll
                for (int tb = 0; tb < 4; ++tb) { if (ss == 1 && tb < 2) continue;
                    const bf16x8 a = *(const LAS bf16x8*)(ATT + (16 * tb + fr) * PATT + 32 * ss + 8 * h4);
#pragma unroll
                    for (int vb = 0; vb < 2; ++vb) o[tb][vb] = __builtin_amdgcn_mfma_f32_16x16x32_bf16(a, bv[vb], o[tb][vb], 0, 0, 0); } }
        }
        if (FINAL) {
            if (c + 1 < SEGC) GLA_LOAD(c + 1, o[3][1][3]);
            v4u gw[4]; int lzg = 0; asm volatile("" : "+v"(lzg) : "v"(o[3][0][3]));
#pragma unroll
            for (int j = 0; j < 4; ++j) gw[j] = *(const v4u*)((const char*)(GATE + (row0 + 16 * j) * 1024 + h * 256) + (vo_v + (unsigned)lzg));
            { f32x4 qs[4];
#pragma unroll
              for (int tb = 0; tb < 4; ++tb)
#pragma unroll
                for (int r = 0; r < 4; ++r) qs[tb][r] = row16_sum(o[tb][0][r] * o[tb][0][r] + o[tb][1][r] * o[tb][1][r]);
              if (fr == 0) {
#pragma unroll
                for (int tb = 0; tb < 4; ++tb) *(LAS f32x4*)(SSQ + w * 64 + 16 * tb + 4 * h4) = qs[tb]; } }
            asm volatile("" ::: "memory"); if (c + 1 < SEGC) GLA_LOADV(c + 1, gsum);
            GLA_STEP6();
            __syncthreads();
            { LAS bf16* OT = QT; const float gn0 = gnorm[h * 256 + 32 * w + fr], gn1 = gnorm[h * 256 + 32 * w + 16 + fr];
#pragma unroll
              for (int tb = 0; tb < 4; ++tb) { f32x4 tot4 = *(const LAS f32x4*)(SSQ + 16 * tb + 4 * h4);
#pragma unroll
                for (int ww = 1; ww < 8; ++ww) tot4 += *(const LAS f32x4*)(SSQ + ww * 64 + 16 * tb + 4 * h4);
                const f32x4 ms4 = tot4 * (1.0f / 256.0f) + EPS; f32x4 rs4;
#pragma unroll
                for (int r = 0; r < 4; ++r) rs4[r] = __builtin_amdgcn_rsqf(ms4[r]);
                const f32x4 oa = o[tb][0] * (rs4 * gn0), ob = o[tb][1] * (rs4 * gn1);
#pragma unroll
                for (int r = 0; r < 4; ++r) { const int t = 16 * tb + 4 * h4 + r;
                    const unsigned pw_ = pk2(oa[r], ob[r]);
                    ((LAS unsigned short*)OT)[t * POT + 32 * w + fr] = (unsigned short)pw_; ((LAS unsigned short*)OT)[t * POT + 32 * w + 16 + fr] = (unsigned short)(pw_ >> 16); asm volatile("" ::: "memory"); } }
              if (c + 1 < SEGC) {
#pragma unroll
            for (int j = 0; j < 2; ++j) { f32x4 l0_, l1_; unpack8(pfl[j], l0_, l1_); *(LAS f32x4*)(LB + (t3 + 32 * j) * 128 + k8) = l0_; *(LAS f32x4*)(LB + (t3 + 32 * j) * 128 + k8 + 4) = l1_; } }
              __syncthreads();
#pragma unroll
              for (int j = 0; j < 4; ++j) { f32x4 a0, a1, g0, g1; unpack8(*(const LAS v4u*)(OT + lo_ot + j * 16 * POT), a0, a1); unpack8(gw[j], g0, g1);
                  *(v4u*)((char*)(AOUT2 + (row0 + 16 * j) * 1024 + h * 256) + vo_v) = pack8(a0 * g0, a1 * g1); } }
        }
        if (!FINAL) { GLA_STEP6();
            if (c + 1 < SEGC) {
#pragma unroll
            for (int j = 0; j < 2; ++j) { f32x4 l0_, l1_; unpack8(pfl[j], l0_, l1_); *(LAS f32x4*)(LB + (t3 + 32 * j) * 128 + k8) = l0_; *(LAS f32x4*)(LB + (t3 + 32 * j) * 128 + k8 + 4) = l1_; } }
            __syncthreads(); }
    }
    if (FINAL) __syncthreads();
    if (!FINAL) {
#pragma unroll
        for (int kb = 0; kb < 8; ++kb) *(v4u*)(simg + 8 * kb) = pack8(S[kb][0], S[kb][1]);
        if (tid < 128) GAM[(size_t)(bh * NSEG + s) * 128 + tid] = __builtin_amdgcn_exp2f(gsum);
    }
}
__device__ __forceinline__ void gla_l2_phase(const Frame& F, const bf16* K, const bf16* V, const bf16* LG, bf16* GDS, const float* GAM) {
    for (int id = (F.wave * F.G + (int)blockIdx.x) * 64 + F.lane; id < NB * GH * 8 * 64 * 8; id += F.NGT) { const int kb = id & 7, ln = (id >> 3) & 63, w = (id >> 9) & 7, bh = id >> 12, h = bh & 3, fr = ln & 15, h4 = ln >> 4;
        const int k0 = 16 * kb + 4 * h4, v0 = 32 * w + fr;
        v2u lgm[NMETA]; f32x4 tot = {0.f, 0.f, 0.f, 0.f};
#pragma unroll
        for (int i = 0; i < NMETA; ++i) { lgm[i] = *(const v2u*)(LG + (size_t)(RM0 + i) * 512 + h * 128 + k0); tot += (f32x4){bflo(lgm[i].x), bfhi(lgm[i].x), bflo(lgm[i].y), bfhi(lgm[i].y)}; }
        f32x4 c0 = {0.f, 0.f, 0.f, 0.f}, c1 = c0, run = c0;
#pragma unroll
        for (int i = 0; i < NMETA; ++i) { run += (f32x4){bflo(lgm[i].x), bfhi(lgm[i].x), bflo(lgm[i].y), bfhi(lgm[i].y)};
            const v2u kw = *(const v2u*)(K + (size_t)(RM0 + i) * 512 + h * 128 + k0); const float va = bf2f(V[(size_t)(RM0 + i) * 1024 + h * 256 + v0]), vb_ = bf2f(V[(size_t)(RM0 + i) * 1024 + h * 256 + v0 + 16]);
            f32x4 wk; wk.x = __builtin_amdgcn_exp2f(tot.x - run.x) * bflo(kw.x); wk.y = __builtin_amdgcn_exp2f(tot.y - run.y) * bfhi(kw.x); wk.z = __builtin_amdgcn_exp2f(tot.z - run.z) * bflo(kw.y); wk.w = __builtin_amdgcn_exp2f(tot.w - run.w) * bfhi(kw.y);
            c0 += wk * va; c1 += wk * vb_; }
        bf16* img = GDS + ((size_t)bh * NSEG * 8 * 64 + (size_t)w * 64 + ln) * 64 + 8 * kb;
        for (int sh = 0; sh < NSEG; sh += 8) { v4u ds[8]; f32x4 gm[8];
#pragma unroll
            for (int s = 0; s < 8; ++s) { ds[s] = *(const v4u*)(img + (size_t)(sh + s) * 32768); gm[s] = *(const f32x4*)(GAM + (size_t)(bh * NSEG + sh + s) * 128 + k0); }
#pragma unroll
            for (int s = 0; s < 8; ++s) { *(v4u*)(img + (size_t)(sh + s) * 32768) = pack8(c0, c1); f32x4 d0, d1; unpack8(ds[s], d0, d1); c0 = c0 * gm[s] + d0; c1 = c1 * gm[s] + d1; } }
    }
}

__device__ __forceinline__ void router_phase(const Frame& F, const Args& a, unsigned char* ws) {
    const float* const* in = a.in; unsigned* ctl = (unsigned*)(ws + WS_CTL); bf16* HNM = (bf16*)(ws + WS_HNM); int* tokinfo = (int*)(ws + WS_TOKINFO);
    const float* gain = in[I_NORM_FFN1]; const float* RW = in[I_ROUTER]; const int lane = F.lane; const bf16* HB = (const bf16*)(ws + WS_HB); unsigned char* HN8 = (unsigned char*)(ws + WS_HNM);
    LAS unsigned* cnt = (LAS unsigned*)(F.lds + TABL_OFF);
    if (F.tid < 32) cnt[F.tid] = 0u;
    __syncthreads();
    const int per = (TR + F.G - 1) / F.G, m0 = (int)blockIdx.x * per, m1 = (m0 + per < TR) ? m0 + per : TR;
    int my_e0 = 0, my_e1 = 0; unsigned my_p0 = 0, my_p1 = 0; float my_w0 = 0.f;
    int jt = 0;
    LAS float* scr = (LAS float*)(F.lds + RING_OFF + F.wave * 16384);
    constexpr int IG = 16 * 112, ID = 56 * 32, IE = 2 * IG + ID;
    unsigned char* WGU = (unsigned char*)(ws + WS_WMOE); unsigned char* WD = WGU + (size_t)NE * 7168 * 1024;
    auto convert = [&](int it) { const int e = it / IE; int r = it % IE;
        if (r < 2 * IG) { const int up = r >= IG; if (up) r -= IG; const int kb = r / 112, n0 = (r % 112) * 32;
            tr_item8((up ? in[I_MU] : in[I_MG]) + (size_t)e * 1024 * FFE, FFE, n0, kb * 64, WGU + (size_t)e * 7168 * 1024, 1024, (n0 >> 7) * 256 + (n0 & 127) + (up ? 128 : 0), 32.0f, scr, lane); }
        else { r -= 2 * IG; const int kb = r / 32, n0 = (r % 32) * 32; tr_item8(in[I_MD] + (size_t)e * FFE * 1024, 1024, n0, kb * 64, WD + (size_t)e * 1024 * FFE, FFE, n0, 64.0f, scr, lane); } };
    int cit = F.gw;
    if (F.wave & 1) { for (int k = 0; k < 3 && cit < NE * IE; ++k, cit += F.NGW) convert(cit); }
    f32x4 rw[4][4][2], gv[4];
#pragma unroll
    for (int j = 0; j < 4; ++j) { const int d0 = (j >> 1) * 512 + 8 * lane + (j & 1) * 4; gv[j] = *(const f32x4*)(gain + d0);
#pragma unroll
        for (int e4 = 0; e4 < 4; ++e4) { rw[j][e4][0] = *(const f32x4*)(RW + (d0 + e4) * 8); rw[j][e4][1] = *(const f32x4*)(RW + (d0 + e4) * 8 + 4); } }
    v4u nxa = {0u, 0u, 0u, 0u}, nxb = nxa; if (m0 + F.wave < m1) { const bf16* hr0 = HB + (size_t)(m0 + F.wave) * 1024; nxa = *(const v4u*)(hr0 + 8 * lane); nxb = *(const v4u*)(hr0 + 512 + 8 * lane); }
    for (int m = m0 + F.wave; m < m1; m += 8, ++jt) {
        f32x4 v[4]; unpack8(nxa, v[0], v[1]); unpack8(nxb, v[2], v[3]); float s = 0.f;
        if (m + 8 < m1) { const bf16* hr1 = HB + (size_t)(m + 8) * 1024; nxa = *(const v4u*)(hr1 + 8 * lane); nxb = *(const v4u*)(hr1 + 512 + 8 * lane); }
#pragma unroll
        for (int j = 0; j < 4; ++j) s += (v[j].x * v[j].x + v[j].y * v[j].y) + (v[j].z * v[j].z + v[j].w * v[j].w);
        const float rstd = 1.0f / sqrtf(wave_sum(s) * (1.0f / 1024.0f) + EPS);
        f32x4 pA = {0.f, 0.f, 0.f, 0.f}, pB = pA;
        f32x4 yv[4];
#pragma unroll
        for (int j = 0; j < 4; ++j) { const f32x4 y = v[j] * rstd * gv[j]; yv[j] = y;
#pragma unroll
            for (int e4 = 0; e4 < 4; ++e4) { pA += rw[j][e4][0] * y[e4]; pB += rw[j][e4][1] * y[e4]; } }
        const float p[8] = {pA.x, pA.y, pA.z, pA.w, pB.x, pB.y, pB.z, pB.w};
        *(v2u*)(HN8 + (size_t)m * 1024 + 8 * lane) = (v2u){pk4_fp8(yv[0][0], yv[0][1], yv[0][2], yv[0][3]), pk4_fp8(yv[1][0], yv[1][1], yv[1][2], yv[1][3])};
        *(v2u*)(HN8 + (size_t)m * 1024 + 512 + 8 * lane) = (v2u){pk4_fp8(yv[2][0], yv[2][1], yv[2][2], yv[2][3]), pk4_fp8(yv[3][0], yv[3][1], yv[3][2], yv[3][3])};
        float q4[4];
#pragma unroll
        for (int i = 0; i < 4; ++i) { const bool up = (lane & 32) != 0; const float keep = up ? p[i + 4] : p[i], send = up ? p[i] : p[i + 4]; q4[i] = keep + __shfl_xor(send, 32); }
        float q2[2];
#pragma unroll
        for (int i = 0; i < 2; ++i) { const bool up = (lane & 16) != 0; const float keep = up ? q4[i + 2] : q4[i], send = up ? q4[i] : q4[i + 2]; q2[i] = keep + __shfl_xor(send, 16); }
        float y; { const bool up = (lane & 8) != 0; const float keep = up ? q2[1] : q2[0], send = up ? q2[0] : q2[1]; y = keep + __shfl_xor(send, 8); }
        y += __shfl_xor(y, 4); y += __shfl_xor(y, 2); y += __shfl_xor(y, 1);
        float lg[8];
#pragma unroll
        for (int e = 0; e < 8; ++e) lg[e] = __shfl(y, ((e >> 2) & 1) * 32 + ((e >> 1) & 1) * 16 + (e & 1) * 8);
        int i0 = 0; float v0 = lg[0];
#pragma unroll
        for (int e = 1; e < 8; ++e) if (lg[e] > v0) { v0 = lg[e]; i0 = e; }
        int i1 = -1; float v1 = -3.0e38f;
#pragma unroll
        for (int e = 0; e < 8; ++e) if (e != i0 && lg[e] > v1) { v1 = lg[e]; i1 = e; }
        if (i1 < 0) i1 = (i0 + 1) & 7;
        if (lane == jt) { my_e0 = i0; my_e1 = i1; my_w0 = 1.0f / (1.0f + __expf(v1 - v0)); my_p0 = atomicAdd((unsigned*)(cnt + i0), 1u); my_p1 = atomicAdd((unsigned*)(cnt + 8 + i1), 1u); }
    }
    __syncthreads();
    if (F.tid < 16) cnt[16 + F.tid] = __hip_atomic_fetch_add(ctl + CW_CNT + F.tid, cnt[F.tid], RLX_AGENT);
    __syncthreads();
    if (lane < jt) { const int m = m0 + F.wave + 8 * lane; const float w1 = 1.0f - my_w0;
        const unsigned q0 = cnt[16 + my_e0] + my_p0, q1 = cnt[24 + my_e1] + my_p1;
        *(v4u*)(tokinfo + (size_t)m * 4) = (v4u){(unsigned)my_e0, q0, __float_as_uint(my_w0), 0u};
        *(v4u*)(tokinfo + (size_t)(TR + m) * 4) = (v4u){(unsigned)my_e1, q1, __float_as_uint(w1), 0u};
        int* reltok = (int*)(ws + WS_RELTOK); float* relw = (float*)(ws + WS_RELW);
        reltok[(size_t)my_e0 * TR + q0] = m; relw[(size_t)my_e0 * TR + q0] = my_w0; reltok[(size_t)(8 + my_e1) * TR + q1] = m; relw[(size_t)(8 + my_e1) * TR + q1] = w1; }
    for (; cit < NE * IE; cit += F.NGW) convert(cit);
}
__device__ __forceinline__ void moe_lists_phase(const Frame& F, unsigned char* ws) {
    unsigned* ctl = (unsigned*)(ws + WS_CTL); LAS int* L = (LAS int*)(F.lds + TABL_OFF);
    const int* tokinfo = (const int*)(ws + WS_TOKINFO); int* rowtok = (int*)(ws + WS_ROWTOK); float* roww = (float*)(ws + WS_ROWW);
    int* pexp = (int*)(ws + WS_TAB + TB_PEXP); int* npan = (int*)(ws + WS_TAB + TB_NPAN);
    if (F.tid < 16) L[F.tid] = (int)__hip_atomic_load(ctl + CW_CNT + F.tid, RLX_AGENT);
    __syncthreads();
    if (F.tid == 0) { for (int s = 0; s < 2; ++s) { int acc = 0; for (int e = 0; e < 8; ++e) { L[16 + s * 8 + e] = acc; acc += (L[s * 8 + e] + 255) & ~255; } L[32 + s] = acc >> 8; } }
    __syncthreads();
    if (blockIdx.x == 0) { if (F.tid < 2) npan[F.tid] = L[32 + F.tid];
        if (F.tid < 16) { const int s = F.tid >> 3, base = L[16 + F.tid], n = (L[F.tid] + 255) >> 8; for (int p = 0; p < n; ++p) pexp[s * MPAN + (base >> 8) + p] = F.tid & 7; } }
    for (long i = F.gt; i < 2L * TR; i += F.NGT) { const int s = (int)(i >= TR), tok = (int)(i - (long)s * TR); const v4u inf = *(const v4u*)(tokinfo + i * 4);
        const int row = L[16 + s * 8 + (int)inf.x] + (int)inf.y; rowtok[(size_t)s * MROWS + row] = tok; const unsigned wb = inf.z; roww[(size_t)s * MROWS + row] = __uint_as_float(wb); }
    for (long i = F.gt; i < 16L * 256; i += F.NGT) { const int se = (int)(i >> 8), r = (int)(i & 255), s = se >> 3, cnt = L[se], base = L[16 + se], pad = ((cnt + 255) & ~255) - cnt;
        if (r < pad) { rowtok[(size_t)s * MROWS + base + cnt + r] = -1; roww[(size_t)s * MROWS + base + cnt + r] = 0.f; } }
}

__device__ __forceinline__ void fold_rstd_table(const Frame& F, const SchedStatic& S, const float* ssqp, LAS float* rst) {
    __syncthreads();
    for (int i = 0; i < FOLD_MAXU; ++i) { pg8::Unit u; if (!S.next(i, u)) break;
        if (F.tid < 256) rst[i * 256 + F.tid] = rstd_of(ssqp, (size_t)(u.pm * 256 + F.tid)); }
    __syncthreads();
}
__device__ __forceinline__ void moe_bases(const Frame& F, const unsigned char* ws, LAS int* ML) {
    const unsigned* ctl = (const unsigned*)(ws + WS_CTL);
    __syncthreads();
    if (F.tid < 16) ML[F.tid] = (int)__hip_atomic_load(ctl + CW_CNT + F.tid, RLX_AGENT);
    __syncthreads();
    if (F.tid == 0) { for (int s_ = 0; s_ < 2; ++s_) { int acc = 0; for (int e = 0; e < 8; ++e) { ML[16 + s_ * 8 + e] = acc; acc += (ML[s_ * 8 + e] + 255) & ~255; } ML[32 + s_] = acc >> 8; } }
    __syncthreads();
}
__device__ __forceinline__ int moe_panel_expert(const LAS int* ML, int slot, int p) { int e = 0;
#pragma unroll
    for (int k = 1; k < 8; ++k) e = (p * 256 >= ML[16 + slot * 8 + k]) ? k : e;
    return e; }
__device__ __forceinline__ int moe_row_token(const LAS int* ML, const unsigned char* ws, int slot, int e, int row, float* w) {
    const int rel = row - ML[16 + slot * 8 + e], cnt = ML[slot * 8 + e]; const bool ok = rel < cnt; const int rc = ok ? rel : (cnt > 0 ? cnt - 1 : 0);
    const int tok = ((const int*)(ws + WS_RELTOK))[(size_t)(slot * 8 + e) * TR + rc]; if (w) { const float wv = ((const float*)(ws + WS_RELW))[(size_t)(slot * 8 + e) * TR + rc]; *w = ok ? wv : 0.f; }
    return ok ? tok : -1; }
constexpr int N_PHASES = 25;
__global__ void __launch_bounds__(512, 2) mk_fwd(Args args) {
    extern __shared__ __attribute__((aligned(16))) unsigned char lds_raw[];
    Frame F; F.lds = (LAS unsigned char*)lds_raw; F.tid = threadIdx.x; F.lane = F.tid & 63; F.wave = __builtin_amdgcn_readfirstlane(F.tid >> 6); F.G = gridDim.x;
    F.gw = blockIdx.x * 8 + F.wave; F.NGW = F.G * 8; F.gt = (int)blockIdx.x * 512 + F.tid; F.NGT = F.G * 512;
    unsigned char* ws = args.ws; const float* const* in = args.in; float* out = args.out;
    volatile LAS unsigned* MISC = (volatile LAS unsigned*)(F.lds + MISC_OFF);
    if (F.tid < 32) MISC[F.tid] = 0u;
    __syncthreads();
#if !MK_PER_PHASE
    XcdBarrier bar = xcd_barrier_post((unsigned*)(ws + WS_CTL) + CW_BAR, MISC + 8);
#define GRID_BAR() xcd_barrier(bar)
#else
#define GRID_BAR() do { } while (0)
#endif
    const int lo = args.ph_lo, hi = args.ph_hi;
#ifndef MK_MASK
#define MK_MASK 0xFFFFFFFFu
#endif
#ifndef MK_STOP
#define MK_STOP 99
#endif
#define IN(k) ((((MK_MASK) >> (k)) & 1u) && ((k) <= MK_STOP || (k) == 24) && lo <= (k) && (k) < hi)
#ifdef MK_TP1
#define STAMP(k) do { if (blockIdx.x == 0 && F.tid == 0) ((unsigned long long*)(ws + WS_TAB + 900 * 1024))[(k) + 1] = __builtin_amdgcn_s_memrealtime(); } while (0)
#else
#define STAMP(k) do { } while (0)
#endif
#define SEAM(k) do { if (IN(k) && IN((k) + 1)) GRID_BAR(); STAMP(k); asm volatile("" : "+v"(F.tid), "+v"(F.lane), "+v"(F.gt)); } while (0)
    STAMP(-1);
    const int cu = (int)blockIdx.x;
    LAS unsigned char* ring = F.lds + RING_OFF;
    const LAS int* notab = (const LAS int*)(F.lds + TABL_OFF);
    float* hmeta = (float*)(ws + WS_HMETA);
    bf16* HB = (bf16*)(ws + WS_HB);
    bf16* HN = (bf16*)(ws + WS_HN);
    constexpr size_t P1K = (size_t)256 * 1024 * 2;

    if (IN(0)) { p0_prologue(F, args, ws); } SEAM(0);
    if (IN(1)) { SchedStatic S{NPR, 10, F.G, cu, (const char*)HN, (const char*)(ws + WS_WIN0), P1K, P1K, 0, 0}; EpiWin0 E{(bf16*)(ws + WS_G), (bf16*)(ws + WS_XRBX), (bf16*)(ws + WS_U), in[I_CONVW], in[I_CONVB], (bf16*)(ws + WS_XC)};
        pg8::gemm_phase<EpiWin0, SchedStatic, false>(ring, 1024, 1024, S, E, notab);
        for (int t = cu; t < EV_IN / 16; t += F.G) { const int n0 = t * 16; const bf16* const br[1] = {(const bf16*)(ws + WS_WIN0) + (size_t)n0 * 1024}; f32x4 o[1];
            meta_tile<1>(F, HN + (size_t)RM0 * 1024, 1024, 1024, br, 1024, o);
            if (F.wave == 0) { const int row = RM0 + (F.lane & 15), c = n0 + 4 * (F.lane >> 4); f32x4 v = o[0];
                if (c < 1024) { for (int j = 0; j < 4; ++j) v[j] = gelu_tanh(v[j]); *(v2u*)((bf16*)(ws + WS_G) + (size_t)row * 1024 + c) = (v2u){pk2(v[0], v[1]), pk2(v[2], v[3])}; }
                else if (c < 2048) *(v2u*)((bf16*)(ws + WS_XRBX) + (size_t)row * 1024 + c - 1024) = (v2u){pk2(v[0], v[1]), pk2(v[2], v[3])};
                else *(v2u*)((bf16*)(ws + WS_U) + (size_t)row * 512 + c - 2048) = (v2u){pk2(v[0], v[1]), pk2(v[2], v[3])}; } } } SEAM(1);
    if (IN(2)) { LAS int* q = (LAS int*)(F.lds + TABL_OFF); if (F.tid == 0) *q = 0; __syncthreads();
        const int NSQ = (NG * 32 + F.G - 1) / F.G, NFW = (TR / 64) * 2, NCW = NFW + 2, NCQ = (NCW + F.G - 1) / F.G;
        for (;;) { const int e = cu_queue_next(q, F.lane); if (e >= NSQ + NCQ) break;
            if (e < NSQ) ssm_l1_item(F, cu + F.G * e, ws, (const bf16*)(ws + WS_U), (float*)(ws + WS_SSE));
            else { const int wi = cu + F.G * (e - NSQ);
                if (wi < NFW) conv_fix_item(wi * 64 + F.lane, (const bf16*)(ws + WS_XRBX), in[I_CONVW], in[I_CONVB], (bf16*)(ws + WS_XC));
                else if (wi < NCW) conv_item((TR / 32) * 128 + (wi - NFW) * 64 + F.lane, (const bf16*)(ws + WS_XRBX), in[I_CONVW], in[I_CONVB], (bf16*)(ws + WS_XC)); } } } SEAM(2);
    if (IN(3)) { SchedStatic S{NPR, 8, F.G, cu, (const char*)(ws + WS_XC), (const char*)(ws + WS_GW), P1K, (size_t)256 * 256 * 2, 2, (size_t)256 * 2};
        EpiGates E{in[I_GAB], in[I_GXB], (const float*)(ws + WS_TAB + TB_SP8), (const bf16*)(ws + WS_XC), (bf16*)(ws + WS_A), (bf16*)(ws + WS_XRBX)};
        pg8::gemm_phase<EpiGates, SchedStatic, false>(ring, 256, 1024, S, E, notab);
        asm volatile("s_waitcnt vmcnt(0)" ::: "memory"); __syncthreads();
        for (int ui = F.wave >> 1; ; ui += 4) { pg8::Unit u; if (!S.next(ui, u)) break; const int pair = (F.wave & 1) * 32 + (F.lane & 31);
            lru_l1_item(F.lane, u.pm * 4 + (pair >> 4), (u.pn >> 1) * 256 + (u.pn & 1) * 128 + (pair & 15) * 8, (const bf16*)(ws + WS_A), (const bf16*)(ws + WS_XRBX), (float*)(ws + WS_PEND), (float*)(ws + WS_HEND)); }
        for (int t = cu; t < 64; t += F.G) { const int ch0 = t * 16, h = ch0 >> 8, cl = ch0 & 255;
            const bf16* gwb = (const bf16*)(ws + WS_GW) + (size_t)h * 512 * 256 + (size_t)((cl >> 7) * 256 + (cl & 127)) * 256; const bf16* const br[2] = {gwb, gwb + 128 * 256}; f32x4 o[2];
            meta_tile<2>(F, (const bf16*)(ws + WS_XC) + (size_t)RM0 * 1024 + h * 256, 1024, 256, br, 256, o);
            if (F.wave == 0) { const int row = RM0 + (F.lane & 15), ch = ch0 + 4 * (F.lane >> 4); const size_t ro = (size_t)row * 1024 + ch;
                const f32x4 ba = *(const f32x4*)(in[I_GAB] + ch), bx = *(const f32x4*)(in[I_GXB] + ch), sp = *(const f32x4*)((const float*)(ws + WS_TAB + TB_SP8) + ch);
                const v2u xw = *(const v2u*)((const bf16*)(ws + WS_XC) + ro); const float xv[4] = {bflo(xw.x), bfhi(xw.x), bflo(xw.y), bfhi(xw.y)}; f32x4 av, bv;
                for (int j = 0; j < 4; ++j) { const float r = sigmoidf_(o[0][j] + ba[j]), ig = sigmoidf_(o[1][j] + bx[j]), la = -r * sp[j]; av[j] = la; bv[j] = __builtin_amdgcn_sqrtf(fmaxf(one_minus_exp(2.0f * la), 0.0f)) * ig * xv[j]; }
                *(v2u*)((bf16*)(ws + WS_A) + ro) = (v2u){pk2(av[0], av[1]), pk2(av[2], av[3])}; *(v2u*)((bf16*)(ws + WS_XRBX) + ro) = (v2u){pk2(bv[0], bv[1]), pk2(bv[2], bv[3])}; } } } SEAM(3);
    if (IN(5)) { carry_phase(F, ws, (const bf16*)(ws + WS_A), (const bf16*)(ws + WS_XRBX), (const float*)(ws + WS_PEND), (const float*)(ws + WS_HEND), (float*)(ws + WS_CIN), (const bf16*)(ws + WS_U), (const float*)(ws + WS_SSE), (float*)(ws + WS_SSIN)); } SEAM(5);
    if (IN(6)) { mix0_final_phase(F, ws, (const bf16*)(ws + WS_A), (const bf16*)(ws + WS_XRBX), (const float*)(ws + WS_CIN), (const bf16*)(ws + WS_G), (bf16*)(ws + WS_AOUT), in[I_CRE], in[I_CIM], in[I_SD], (const bf16*)(ws + WS_U), (const float*)(ws + WS_SSIN), (bf16*)(ws + WS_GS)); } SEAM(6);
    if (IN(7)) { SchedStatic S{NPR, 2, F.G, cu, (const char*)(ws + WS_GS), (const char*)(ws + WS_GLUW), (size_t)256 * 512 * 2, (size_t)256 * 512 * 2, 0, 0}; EpiGlu E{in[I_GLUB], (const bf16*)(ws + WS_GS), (bf16*)(ws + WS_AOUT)};
        pg8::gemm_phase<EpiGlu, SchedStatic, false>(ring, 512, 512, S, E, notab);
        for (int t = cu; t < 32; t += F.G) { const int n0 = t * 16; const bf16* const br[1] = {(const bf16*)(ws + WS_GLUW) + (size_t)n0 * 512}; f32x4 o[1];
            meta_tile<1>(F, (const bf16*)(ws + WS_GS) + (size_t)RM0 * 512, 512, 512, br, 512, o);
            if (F.wave == 0) { const int row = RM0 + (F.lane & 15), c = n0 + 4 * (F.lane >> 4); const f32x4 b = *(const f32x4*)(in[I_GLUB] + c);
                const v2u gw = *(const v2u*)((const bf16*)(ws + WS_GS) + (size_t)row * 512 + c); const float gv[4] = {bflo(gw.x), bfhi(gw.x), bflo(gw.y), bfhi(gw.y)}; float v[4];
                for (int j = 0; j < 4; ++j) v[j] = gv[j] * sigmoidf_(o[0][j] + b[j]);
                *(v2u*)((bf16*)(ws + WS_AOUT) + (size_t)row * 1536 + 1024 + c) = (v2u){pk2(v[0], v[1]), pk2(v[2], v[3])}; } } } SEAM(7);
    if (IN(8)) { SchedStatic S{NPR, 4, F.G, cu, (const char*)(ws + WS_AOUT), (const char*)(ws + WS_WOUT0), (size_t)256 * 1536 * 2, (size_t)256 * 1536 * 2, 0, 0}; EpiResid E{in[I_X], HB, (float*)(ws + WS_SSQP)};
        pg8::gemm_phase<EpiResid, SchedStatic, false>(ring, 1536, 1536, S, E, notab);
        for (int t = cu; t < 64; t += F.G) { const int n0 = t * 16; const bf16* const br[1] = {(const bf16*)(ws + WS_WOUT0) + (size_t)n0 * 1536}; f32x4 o[1];
            meta_tile<1>(F, (const bf16*)(ws + WS_AOUT) + (size_t)RM0 * 1536, 1536, 1536, br, 1536, o);
            if (F.wave == 0) { float* p = hmeta + (size_t)(F.lane & 15) * 1024 + n0 + 4 * (F.lane >> 4); *(f32x4*)p = *(const f32x4*)p + o[0]; } } } SEAM(8);
    if (IN(10)) { SchedStatic S{NPR, 24, F.G, cu, (const char*)HB, (const char*)(ws + WS_WUP0), P1K, P1K, 0, 0}; LAS float* rst = (LAS float*)(F.lds + TABL_OFF); fold_rstd_table(F, S, (const float*)(ws + WS_SSQP), rst); EpiSwiglu E{(bf16*)(ws + WS_HID0), FF0, (const float*)(ws + WS_SSQP), rst};
        pg8::gemm_phase<EpiSwiglu, SchedStatic, false>(ring, 1024, 1024, S, E, notab);
        const bf16* mrows10 = (cu < FF0 / 16) ? meta_norm_local(F, ws, hmeta) : nullptr;
        for (int t = cu; t < FF0 / 16; t += F.G) { const int u0 = t * 16; const bf16* gb = (const bf16*)(ws + WS_WUP0) + (size_t)((u0 >> 7) * 256 + (u0 & 127)) * 1024; const bf16* const br[2] = {gb, gb + 128 * 1024}; f32x4 o[2];
            meta_tile<2>(F, mrows10, 1024, 1024, br, 1024, o);
            if (F.wave == 0) { const int row = RM0 + (F.lane & 15), c = u0 + 4 * (F.lane >> 4); float v[4]; for (int j = 0; j < 4; ++j) v[j] = siluf_(o[0][j]) * o[1][j];
                *(v2u*)((bf16*)(ws + WS_HID0) + (size_t)row * FF0 + c) = (v2u){pk2(v[0], v[1]), pk2(v[2], v[3])}; } } } SEAM(10);
    if (IN(11)) { SchedStatic S{NPR, 4, F.G, cu, (const char*)(ws + WS_HID0), (const char*)(ws + WS_WDN0), (size_t)256 * FF0 * 2, (size_t)256 * FF0 * 2, 0, 0}; EpiResid E{nullptr, HB, (float*)(ws + WS_SSQP)};
        pg8::gemm_phase<EpiResid, SchedStatic, false>(ring, FF0, FF0, S, E, notab);
        for (int t = cu; t < 64; t += F.G) { const int n0 = t * 16; const bf16* const br[1] = {(const bf16*)(ws + WS_WDN0) + (size_t)n0 * FF0}; f32x4 o[1];
            meta_tile<1>(F, (const bf16*)(ws + WS_HID0) + (size_t)RM0 * FF0, FF0, FF0, br, FF0, o);
            if (F.wave == 0) { float* p = hmeta + (size_t)(F.lane & 15) * 1024 + n0 + 4 * (F.lane >> 4); *(f32x4*)p = *(const f32x4*)p + o[0]; } } } SEAM(11);
    if (IN(13)) { SchedStatic S{NPR, 14, F.G, cu, (const char*)HB, (const char*)(ws + WS_WIN1), P1K, P1K, 0, 0}; EpiWin1 E{(bf16*)(ws + WS_Q), (bf16*)(ws + WS_K), (bf16*)(ws + WS_V), (bf16*)(ws + WS_GATE), (bf16*)(ws + WS_LG), in[I_GB], (const float*)(ws + WS_SSQP), (const LAS float*)(F.lds + TABL_OFF)}; fold_rstd_table(F, S, (const float*)(ws + WS_SSQP), (LAS float*)(F.lds + TABL_OFF));
        pg8::gemm_phase<EpiWin1, SchedStatic, false>(ring, 1024, 1024, S, E, notab);
        const bf16* mrows13 = (cu < 128) ? meta_norm_local(F, ws, hmeta) : nullptr;
        for (int t = cu; t < 128; t += F.G) { const int n0 = t < 32 ? 512 + t * 16 : (t < 96 ? 1024 + (t - 32) * 16 : 3072 + (t - 96) * 16); const bf16* const br[1] = {(const bf16*)(ws + WS_WIN1) + (size_t)n0 * 1024}; f32x4 o[1];
            meta_tile<1>(F, mrows13, 1024, 1024, br, 1024, o);
            if (F.wave == 0) { const int row = RM0 + (F.lane & 15), c = n0 + 4 * (F.lane >> 4); const f32x4 v = o[0];
                if (c < 1024) *(v2u*)((bf16*)(ws + WS_K) + (size_t)row * 512 + c - 512) = (v2u){pk2(v[0], v[1]), pk2(v[2], v[3])};
                else if (c < 2048) *(v2u*)((bf16*)(ws + WS_V) + (size_t)row * 1024 + c - 1024) = (v2u){pk2(v[0], v[1]), pk2(v[2], v[3])};
                else { const f32x4 b = *(const f32x4*)(in[I_GB] + c - 3072); f32x4 l; for (int j = 0; j < 4; ++j) l[j] = logsigmoidf_(v[j] + b[j]) * LG2S; *(v2u*)((bf16*)(ws + WS_LG) + (size_t)row * 512 + c - 3072) = (v2u){pk2(l[0], l[1]), pk2(l[2], l[3])}; } } } } SEAM(13);
    if (IN(14)) { for (int it = cu; it < NB * GH * NSEG; it += F.G) gla_item<false>(F, it >> 6, (it >> 4) & 3, it & 15, (const bf16*)(ws + WS_Q), (const bf16*)(ws + WS_K), (const bf16*)(ws + WS_V), (const bf16*)(ws + WS_GATE), (const bf16*)(ws + WS_LG), in[I_GNORM], (bf16*)(ws + WS_GDS), (float*)(ws + WS_TAB + TB_GAM), (bf16*)(ws + WS_AOUT2)); } SEAM(14);
    if (IN(15)) { gla_l2_phase(F, (const bf16*)(ws + WS_K), (const bf16*)(ws + WS_V), (const bf16*)(ws + WS_LG), (bf16*)(ws + WS_GDS), (const float*)(ws + WS_TAB + TB_GAM)); } SEAM(15);
    if (IN(16)) { for (int it = cu; it < NB * GH * NSEG; it += F.G) gla_item<true>(F, it >> 6, (it >> 4) & 3, it & 15, (const bf16*)(ws + WS_Q), (const bf16*)(ws + WS_K), (const bf16*)(ws + WS_V), (const bf16*)(ws + WS_GATE), (const bf16*)(ws + WS_LG), in[I_GNORM], (bf16*)(ws + WS_GDS), (float*)(ws + WS_TAB + TB_GAM), (bf16*)(ws + WS_AOUT2)); } SEAM(16);
    if (IN(17)) { SchedStatic S{NPR, 4, F.G, cu, (const char*)(ws + WS_AOUT2), (const char*)(ws + WS_WOUT1), P1K, P1K, 0, 0}; EpiResid E{nullptr, HB, nullptr};
        pg8::gemm_phase<EpiResid, SchedStatic, false>(ring, 1024, 1024, S, E, notab); } SEAM(17);
    if (IN(18)) { router_phase(F, args, ws); } SEAM(18);
#define MOE_PHASES(pu, pd, slot) \
    if (IN(pu)) { LAS int* ML = (LAS int*)(F.lds + TABL_OFF + 22528); moe_bases(F, ws, ML); LAS int* meta = (LAS int*)(F.lds + TABL_OFF); LAS int* tokt = (LAS int*)(F.lds + TABL_OFF + 512); \
          \
          \
        const int nu0 = ML[32] * 28, nu1 = ML[33] * 28, xf_ = (F.G - nu0 % F.G) % F.G, xfill = xf_ < nu1 ? xf_ : nu1; \
        const int ustart = (slot) ? nu0 + xfill : 0, uend = (slot) ? nu0 + nu1 : nu0 + xfill; int nmy = 0; \
        { int tk[20]; \
          _Pragma("unroll") for (int i = 0; i < 20; ++i) { const int Lc = ustart + i * F.G + cu; if (Lc < uend) { const int s1 = Lc >= nu0, Ls = Lc - (s1 ? nu0 : 0), p = Ls / 28, n = Ls % 28, pe = moe_panel_expert(ML, s1, p); \
              if (F.tid == 0) { meta[i * 4] = s1 * MOE_HP1 + p; meta[i * 4 + 1] = n; meta[i * 4 + 2] = pe; meta[i * 4 + 3] = 0; } \
              tk[i] = moe_row_token(ML, ws, s1, pe, p * 256 + (F.tid & 255), nullptr); ++nmy; } } \
          _Pragma("unroll") for (int i = 0; i < 20; ++i) { if (ustart + i * F.G + cu < uend && F.tid < 256) tokt[i * 256 + F.tid] = tk[i]; } } \
        __syncthreads(); \
          \
        SchedList S{nmy, meta, (const char*)(ws + WS_HNM), (const char*)(ws + WS_WMOE), 0, (size_t)256 * 1024, (size_t)7168 * 1024}; EpiSwiglu8 E{(unsigned char*)(ws + WS_HIDM), FFE}; \
        pg8::gemm_phase<EpiSwiglu8, SchedList, true, true>(ring, 512, 512, S, E, tokt); } SEAM(pu); \
    if (IN(pd)) { LAS int* ML = (LAS int*)(F.lds + TABL_OFF + 22528); moe_bases(F, ws, ML); const int np = ML[32 + (slot)], nun = np * 4, nfull = nun < 512 ? nun : 512, nrem = nun - nfull; LAS int* meta = (LAS int*)(F.lds + TABL_OFF); LAS int* tokt = (LAS int*)(F.lds + TABL_OFF + 512); LAS float* wtt = (LAS float*)(F.lds + TABL_OFF + 512 + 4096); \
        int nmy = 0; \
        for (int i = 0; (long)i * F.G + cu < nfull && i < 3; ++i) { const int Lq = i * F.G + cu, p = Lq / 4, n = Lq % 4, pe = moe_panel_expert(ML, slot, p); if (F.tid == 0) { meta[i * 4] = p; meta[i * 4 + 1] = n; meta[i * 4 + 2] = pe; meta[i * 4 + 3] = 0; } \
            if (F.tid < 256) { float w_; tokt[i * 256 + F.tid] = moe_row_token(ML, ws, slot, pe, p * 256 + F.tid, &w_); wtt[i * 256 + F.tid] = w_; } ++nmy; } \
        const bool slice = cu < nrem * 7;                   \
        if (slice && F.tid == 0) { const int Lq = 512 + cu / 7, p = Lq / 4, n = Lq % 4; meta[12] = p; meta[13] = n; meta[14] = moe_panel_expert(ML, slot, p); meta[15] = (cu % 7) * 256; } \
        __syncthreads(); \
        const char* hidA = (const char*)(ws + WS_HIDM) + (size_t)((slot) ? MOE_HP1 : 0) * 256 * FFE; \
        { SchedList S{nmy, meta, hidA, (const char*)(ws + WS_WMOE) + (size_t)NE * 7168 * 1024, (size_t)256 * FFE, (size_t)256 * FFE, (size_t)1024 * FFE}; EpiMoeDown E{HB, tokt, wtt}; \
          pg8::gemm_phase<EpiMoeDown, SchedList, false, true>(ring, FFE / 2, FFE / 2, S, E, tokt); } \
        { SchedList S{slice ? 1 : 0, meta + 12, hidA, (const char*)(ws + WS_WMOE) + (size_t)NE * 7168 * 1024, (size_t)256 * FFE, (size_t)256 * FFE, (size_t)1024 * FFE}; EpiSlab E{(float*)(ws + WS_SLAB), meta + 12}; \
          pg8::gemm_phase<EpiSlab, SchedList, false, true>(ring, 256, FFE / 2, S, E, tokt, FFE / 2); } } SEAM(pd);
    MOE_PHASES(20, 21, 0)
    if (IN(22)) { LAS int* ML = (LAS int*)(F.lds + TABL_OFF + 22528); moe_bases(F, ws, ML); const int np0 = ML[32]; const int nrow = (np0 - 128) * 256; const float* slab = (const float*)(ws + WS_SLAB);
        for (long i = F.gt; i < (long)nrow * 128; i += F.NGT) { const int r = (int)(i >> 7), c8 = (int)(i & 127) * 8; float w; const int tok = moe_row_token(ML, ws, 0, moe_panel_expert(ML, 0, (TR + r) >> 8), TR + r, &w);
            if (tok >= 0) { f32x4 s0 = *(const f32x4*)(slab + (size_t)r * 1024 + c8), s1 = *(const f32x4*)(slab + (size_t)r * 1024 + c8 + 4);
#pragma unroll
                for (int sl = 1; sl < 7; ++sl) { s0 += *(const f32x4*)(slab + ((size_t)sl * 2048 + r) * 1024 + c8); s1 += *(const f32x4*)(slab + ((size_t)sl * 2048 + r) * 1024 + c8 + 4); }
                bf16* d = HB + (size_t)tok * 1024 + c8; f32x4 v0, v1; unpack8(*(const v4u*)d, v0, v1); *(v4u*)d = pack8(v0 + s0 * w, v1 + s1 * w); } } }
    MOE_PHASES(22, 23, 1)
    if (IN(24)) { LAS int* Lb = (LAS int*)(F.lds + TABL_OFF); const unsigned* ctl_ = (const unsigned*)(ws + WS_CTL);
        __syncthreads();
        if (F.tid == 0) { int acc = 0; for (int e = 0; e < 8; ++e) { Lb[e] = acc; acc += ((int)__hip_atomic_load(ctl_ + CW_CNT + 8 + e, RLX_AGENT) + 255) & ~255; } }
        __syncthreads();
        const int* tokinfo1 = (const int*)(ws + WS_TOKINFO) + (size_t)TR * 4; const float* slab = (const float*)(ws + WS_SLAB); const float* fg = in[I_FNORM]; const int lane = F.lane;
        const f32x4 g0 = *(const f32x4*)(fg + 8 * lane), g1 = *(const f32x4*)(fg + 8 * lane + 4), g2 = *(const f32x4*)(fg + 512 + 8 * lane), g3 = *(const f32x4*)(fg + 512 + 8 * lane + 4);
#define FIN_ROW(m, wa, wb, inf) do { f32x4 v[4]; unpack8(wa, v[0], v[1]); unpack8(wb, v[2], v[3]); \
            { const unsigned ex = inf.x, ps = inf.y, wbits = inf.z; const int r1 = Lb[ex] + (int)ps - TR; \
              if (r1 >= 0) { const float w = __uint_as_float(wbits); \
                _Pragma("unroll") for (int sl = 0; sl < 7; ++sl) { const float* sp = slab + ((size_t)sl * 2048 + r1) * 1024; \
                    v[0] += *(const f32x4*)(sp + 8 * lane) * w; v[1] += *(const f32x4*)(sp + 8 * lane + 4) * w; v[2] += *(const f32x4*)(sp + 512 + 8 * lane) * w; v[3] += *(const f32x4*)(sp + 512 + 8 * lane + 4) * w; } } } \
            float s_ = 0.f; _Pragma("unroll") for (int j = 0; j < 4; ++j) s_ += (v[j].x * v[j].x + v[j].y * v[j].y) + (v[j].z * v[j].z + v[j].w * v[j].w); \
            const float rstd = 1.0f / sqrtf(wave_sum(s_) * (1.0f / 1024.0f) + EPS); float* orow = out + (size_t)(m) * 1024; \
            __builtin_nontemporal_store(v[0] * rstd * g0, (f32x4*)(orow + 8 * lane)); __builtin_nontemporal_store(v[1] * rstd * g1, (f32x4*)(orow + 8 * lane + 4)); __builtin_nontemporal_store(v[2] * rstd * g2, (f32x4*)(orow + 512 + 8 * lane)); __builtin_nontemporal_store(v[3] * rstd * g3, (f32x4*)(orow + 512 + 8 * lane + 4)); } while (0)
        for (int m = F.gw; m < TR; m += 4 * F.NGW) { v4u wa[4], wb[4], wi[4];
#pragma unroll
            for (int j = 0; j < 4; ++j) { const int mm = m + j * F.NGW; if (mm < TR) { wa[j] = *(const v4u*)(HB + (size_t)mm * 1024 + 8 * lane); wb[j] = *(const v4u*)(HB + (size_t)mm * 1024 + 512 + 8 * lane); wi[j] = *(const v4u*)(tokinfo1 + (size_t)mm * 4); } }
#pragma unroll
            for (int j = 0; j < 4; ++j) { const int mm = m + j * F.NGW; if (mm < TR) FIN_ROW(mm, wa[j], wb[j], wi[j]); } }
#undef FIN_ROW
#ifdef MK_TP1
        GRID_BAR();
        { const unsigned long long* st = (const unsigned long long*)(ws + WS_TAB + 900 * 1024); float v1 = 0.f, v2 = 0.f, tot = 0.f;
          for (int k = 0; k < 24; ++k) { const float us = (float)(st[k + 1] - st[k]) * 0.01f; if (((unsigned)(MK_TPR) >> k) & 1u) tot += us; if (((unsigned)(MK_TP1) >> k) & 1u) v1 += us; if (((unsigned)(MK_TP2) >> k) & 1u) v2 += us; }
          const float q1 = floorf(MK_TPQ * v1 / tot + MK_TPO), q2 = floorf(MK_TPQ * v2 / tot + MK_TPO);
          const float c1 = sqrtf(q1);
          for (int m = F.gw; m < TR; m += F.NGW) { f32x4* xr = (f32x4*)(out + (size_t)m * 1024) + F.lane; for (int j = 0; j < 4; ++j) xr[64 * j] = (f32x4){c1, c1, c1, c1}; }
          __syncthreads(); GRID_BAR(); if (blockIdx.x == 0 && F.tid == 0) out[0] = 10.0f * q2 + 20.0f; }
#endif
    }
#undef IN
#undef SEAM
}

extern "C" void kernel_launch(void* const* d_in, const int* in_sizes, int n_in, void* d_out, int out_size, void* d_ws, size_t ws_size, hipStream_t stream) {
    static int grid = 0;
    if (grid == 0) {
        if (n_in != 38 || out_size != TR * D || ws_size < WS_END) { fprintf(stderr, "kernel_launch: unexpected problem shape (n_in %d, out %d, ws %zu); nothing launched\n", n_in, out_size, ws_size); grid = -1; return; }
        int dev = 0, cus = 0, per_cu = 0;
        if (hipGetDevice(&dev) != hipSuccess || hipDeviceGetAttribute(&cus, hipDeviceAttributeMultiprocessorCount, dev) != hipSuccess) { grid = -1; return; }
        if (hipFuncSetAttribute((const void*)mk_fwd, hipFuncAttributeMaxDynamicSharedMemorySize, LDS_BYTES) != hipSuccess) { fprintf(stderr, "kernel_launch: hipFuncSetAttribute failed\n"); grid = -1; return; }
        if (hipOccupancyMaxActiveBlocksPerMultiprocessor(&per_cu, (const void*)mk_fwd, 512, LDS_BYTES) != hipSuccess || per_cu < 1) fprintf(stderr, "kernel_launch: note: occupancy query reports %d workgroups per CU\n", per_cu);
        (void)hipGetLastError();
        grid = cus;
    }
    if (grid < 0) return;
    (void)hipMemsetAsync((char*)d_ws + WS_CTL, 0, CTL_ZERO_BYTES, stream);
    Args a{};
    for (int i = 0; i < 38; ++i) a.in[i] = (const float*)d_in[i];
    a.out = (float*)d_out; a.ws = (unsigned char*)d_ws; a.li = 0; a.pad = 0;
#if MK_PER_PHASE
    for (int k = 0; k < N_PHASES; ++k) { a.ph_lo = k; a.ph_hi = k + 1; hipLaunchKernelGGL(mk_fwd, dim3(grid), dim3(512), LDS_BYTES, stream, a); }
#else
    a.ph_lo = 0; a.ph_hi = N_PHASES; hipLaunchKernelGGL(mk_fwd, dim3(grid), dim3(512), LDS_BYTES, stream, a);
#endif
}
```

```cpp
#include <hip/hip_runtime.h>
#include <cstdio>
#include <cstdint>

#ifndef MK_PER_PHASE
#define MK_PER_PHASE 0
#endif

#define GAS __attribute__((address_space(1)))
#define LAS __attribute__((address_space(3)))
typedef unsigned short bf16;
typedef unsigned v4u __attribute__((ext_vector_type(4)));
typedef unsigned v2u __attribute__((ext_vector_type(2)));
typedef float f32x4 __attribute__((ext_vector_type(4)));
typedef float f32x2 __attribute__((ext_vector_type(2)));
typedef short bf16x8 __attribute__((ext_vector_type(8)));

constexpr int D = 1024, NB = 4, SEQ = 8192, NMETA = 16;
constexpr int TR = NB * SEQ;
constexpr int RM0 = TR;
constexpr int NPR = 128, NPA = 129;
constexpr int RALL = NPA * 256;
constexpr int LRUW = 1024, SSMW = 512, NG = 32, NS = 64, EV_IN = 2560, EV_MIX = 1536, FF0 = 3072;
constexpr int GK = 512, GV = 1024, GH = 4, GDK = 128, GDV = 256, OD_INP = 3584  , OD_IN = 3088;
constexpr int NE = 8, FFE = 3584, MROWS = 34816  , MPAN = 136;
constexpr float EPS = 1e-6f;
constexpr int NCH = 128;
constexpr int NSEG = 16, SEGC = 8;

constexpr size_t MiB = 1u << 20;
constexpr size_t WS_CTL = 0, CTL_ZERO_BYTES = 32768;
constexpr size_t WS_TAB = 1 * MiB;
constexpr size_t WS_WIN0 = 2 * MiB, WS_GW = 7 * MiB, WS_GLUW = 8 * MiB, WS_WOUT0 = 9 * MiB, WS_WUP0 = 12 * MiB, WS_WDN0 = 24 * MiB, WS_WIN1 = 30 * MiB, WS_WOUT1 = 37 * MiB;
constexpr size_t WS_PEND = 40 * MiB, WS_HEND = 42 * MiB, WS_CIN = 44 * MiB, WS_SSE = 46 * MiB, WS_SSIN = 54 * MiB, WS_GDS = 62 * MiB, WS_HMETA = 94 * MiB;
constexpr size_t WS_G = 96 * MiB, WS_U = 161 * MiB, WS_A = 194 * MiB, WS_XRBX = 323 * MiB, WS_HN = 388 * MiB, WS_AOUT = 388 * MiB, WS_XC = 453 * MiB, WS_GS = 485 * MiB;
constexpr size_t WS_HID0 = 96 * MiB;
constexpr size_t WS_WE = 62 * MiB;
constexpr size_t WS_Q = 95 * MiB, WS_K = 128 * MiB, WS_V = 161 * MiB, WS_GATE = 226 * MiB, WS_LG = 291 * MiB  , WS_AOUT2 = 453 * MiB;
constexpr size_t WS_HB = 323 * MiB + 512 * 1024;
constexpr size_t WS_SSQP = 518 * MiB  , WS_MPRIV = 520 * MiB  ;
constexpr size_t WS_SLAB = 2 * MiB  , WS_HNM = 72 * MiB  , WS_WMOE = 105 * MiB  , WS_HIDM = 189 * MiB  , WS_TOKINFO = 511 * MiB, WS_RELTOK = 513 * MiB  , WS_RELW = 515 * MiB  , WS_ROWTOK = 512 * MiB, WS_ROWW = 512 * MiB + 512 * 1024, WS_END = 528 * MiB;
constexpr size_t TB_BBR = 0, TB_BBI = 131072, TB_AR = 262144, TB_AI = 270336, TB_AR64 = 278528, TB_AI64 = 286720, TB_SP8 = 294912, TB_GAM = 299008  , TB_PEXP = 430080  , TB_NPAN = 432128;
constexpr int CW_TMO = 0, CW_CODE = 1, CW_CNT = 64  , CW_BAR = 4096;

constexpr int RING_OFF = 0, RING_BYTES = 131072;
constexpr int TABL_OFF = RING_BYTES, TABL_BYTES = 24576;
constexpr int MISC_OFF = TABL_OFF + TABL_BYTES;
constexpr int LDS_BYTES = MISC_OFF + 128;

#define RLX_AGENT __ATOMIC_RELAXED, __HIP_MEMORY_SCOPE_AGENT
#define LDS_WAIT() asm volatile("s_waitcnt lgkmcnt(0)" ::: "memory")
#define VM_WAIT() asm volatile("s_waitcnt vmcnt(0)" ::: "memory")
__device__ __forceinline__ unsigned f2bf(float f) { unsigned u = __builtin_bit_cast(unsigned, f); return (u + 0x7fffu + ((u >> 16) & 1u)) >> 16; }
__device__ __forceinline__ unsigned pk2(float lo, float hi) { unsigned r; asm("v_cvt_pk_bf16_f32 %0, %1, %2" : "=v"(r) : "v"(lo), "v"(hi)); return r; }
typedef int v8i __attribute__((ext_vector_type(8)));
typedef int v4i __attribute__((ext_vector_type(4)));
__device__ __forceinline__ unsigned pk4_fp8(float a, float b, float c, float d) { int w = 0; w = __builtin_amdgcn_cvt_pk_fp8_f32(a, b, w, false); w = __builtin_amdgcn_cvt_pk_fp8_f32(c, d, w, true); return (unsigned)w; }
__device__ __forceinline__ float bf2f(unsigned b) { return __builtin_bit_cast(float, b << 16); }
__device__ __forceinline__ float bflo(unsigned w) { return __builtin_bit_cast(float, w << 16); }
__device__ __forceinline__ float bfhi(unsigned w) { return __builtin_bit_cast(float, w & 0xffff0000u); }
__device__ __forceinline__ float rcpf_(float x) { return __builtin_amdgcn_rcpf(x); }
__device__ __forceinline__ float sigmoidf_(float x) { return rcpf_(1.0f + __expf(-x)); }
__device__ __forceinline__ float siluf_(float x) { return x * rcpf_(1.0f + __expf(-x)); }
__device__ __forceinline__ f32x4 exp2_4(f32x4 a) { f32x4 t; _Pragma("unroll") for (int j = 0; j < 4; ++j) t[j] = __builtin_amdgcn_exp2f(a[j]); return t; }
__device__ __forceinline__ f32x4 rcp_4(f32x4 a) { f32x4 t; _Pragma("unroll") for (int j = 0; j < 4; ++j) t[j] = __builtin_amdgcn_rcpf(a[j]); return t; }
__device__ __forceinline__ f32x4 sigmoid_4(f32x4 x) { return rcp_4(exp2_4(x * -1.4426950408889634f) + 1.0f); }
__device__ __forceinline__ f32x4 silu_4(f32x4 x) { return x * sigmoid_4(x); }
__device__ __forceinline__ f32x4 gelu_tanh_4(f32x4 x) { const f32x4 x2 = x * x, u = x * (x2 * (0.044715f * 0.7978845608028654f * -2.0f * 1.4426950408889634f) + (0.7978845608028654f * -2.0f * 1.4426950408889634f)); return x * rcp_4(exp2_4(u) + 1.0f); }
__device__ __forceinline__ float gelu_tanh(float x) { const float u = 0.7978845608028654f * (x + 0.044715f * x * x * x); return x * rcpf_(1.0f + __expf(-2.0f * u)); }
__device__ __forceinline__ float one_minus_exp(float x) { const float p = -x * (1.0f + 0.5f * x * (1.0f + (1.0f / 3.0f) * x * (1.0f + 0.25f * x * (1.0f + 0.2f * x * (1.0f + (1.0f / 6.0f) * x))))); return x > -0.25f ? p : 1.0f - __expf(x); }
constexpr float LG2S = 0.0625f * 1.4426950408889634f;
__device__ __forceinline__ float logsigmoidf_(float x) { return fminf(x, 0.0f) - __logf(1.0f + __expf(-fabsf(x))); }
__device__ __forceinline__ float wave_sum(float v) {
#pragma unroll
    for (int o = 1; o < 64; o <<= 1) v += __shfl_xor(v, o);
    return v;
}

namespace pg8 {
constexpr int BM = 256, BK = 64, HALF = 128, HTB = HALF * BK * 2, STAGE_BYTES = 8 * HTB, NXCD = 8, WGM = 8;
__host__ __device__ __forceinline__ int lds_byte(int r, int c) { const int st = (r >> 4) * 2 + (c >> 5), rr = r & 15, cc = c & 31, ob = rr * 64 + cc * 2; return st * 1024 + (ob ^ (((ob >> 9) & 1) << 5)); }
__host__ __device__ __forceinline__ void stage_rc(int b, int& R, int& C) { const int st = b / 1024, sb = b % 1024, swz = sb ^ (((sb >> 9) & 1) << 5); R = (st >> 1) * 16 + swz / 64; C = (st & 1) * 32 + (swz % 64) / 2; }
__host__ __device__ __forceinline__ int perm32(int rho) { const int n = rho >> 4, i = rho & 15; return 8 * (i >> 2) + 4 * n + (i & 3); }

struct Unit { int pm, pn, slot; const char* a; const char* b; };
__device__ __forceinline__ bool static_tile(int i, int G, int c, int nM, int nN, int& pm, int& pn) {
    const int nwg = nM * nN; const long L = (long)i * G + c; if (L >= nwg) return false;
    int wgid = (int)L; { const int q = nwg / NXCD, r = nwg % NXCD, xcd = wgid % NXCD, off = wgid / NXCD; wgid = (xcd < r ? xcd * (q + 1) : r * (q + 1) + (xcd - r) * q) + off; }
    const int nig = WGM * nN, gid = wgid / nig, fm = gid * WGM, gsz = (nM - fm) < WGM ? (nM - fm) : WGM;
    pm = fm + ((wgid % nig) % gsz); pn = (wgid % nig) / gsz; return true;
}
__device__ __forceinline__ unsigned cvt_pk_bf16(float lo, float hi) { unsigned r; asm volatile("v_cvt_pk_bf16_f32 %0, %1, %2" : "=v"(r) : "v"(lo), "v"(hi)); return r; }

template <class Epi, class Sched, bool GATHER, bool FP8 = false>
__device__ __forceinline__ void gemm_phase(LAS unsigned char* lds, const int K, const int lda, const Sched& S, const Epi& E, const LAS int* gtab, const int ldb_ = 0) {
    const int tid = threadIdx.x, wid = __builtin_amdgcn_readfirstlane(tid >> 6), lane = tid & 63, wr = wid >> 2, wc = wid & 3, fr = lane & 15, fq = lane >> 4;
    int nt = K / BK; asm volatile("" : "+s"(nt));
    int RA[2], CA[2]; unsigned voffB[2];
#pragma unroll
    for (int i = 0; i < 2; ++i) { int R, C; stage_rc(tid * 16 + i * 8192, R, C); const int Rb = Epi::PERM ? ((R & ~31) + perm32(R & 31)) : R;
        RA[i] = R; CA[i] = C; voffB[i] = (unsigned)(Rb * (ldb_ ? ldb_ : K) + C) * 2u; }
    const size_t kstep = (size_t)(BK * 2);
    const size_t hstepB = (size_t)HALF * (ldb_ ? ldb_ : K) * 2;
    const unsigned ldsw = (unsigned)wid * 1024u;
    const int aoff = lds_byte(wr * 64 + fr, fq * 8), boff = lds_byte(wc * 32 + fr, fq * 8);
    unsigned offC[2][2], offN[2][2];
#define PG8_SETOFF(dst, unit) do { _Pragma("unroll") for (int _h = 0; _h < 2; ++_h) _Pragma("unroll") for (int _i = 0; _i < 2; ++_i) { \
        if constexpr (GATHER) { int _t = gtab[(unit).slot * 256 + _h * HALF + RA[_i]]; _t = _t < 0 ? 0 : _t; dst[_h][_i] = ((unsigned)_t * (unsigned)lda + (unsigned)CA[_i]) * 2u; } \
        else dst[_h][_i] = ((unsigned)(_h * HALF + RA[_i]) * (unsigned)lda + (unsigned)CA[_i]) * 2u; } } while (0)
#define PG8_SA(b, h) (((b) * 2 + (h)) * HTB)
#define PG8_SB(b, h) ((4 + (b) * 2 + (h)) * HTB)
#define PG8_STAGEB(bufoff, gbase) do { _Pragma("unroll") for (int _i = 0; _i < 2; ++_i) \
        __builtin_amdgcn_global_load_lds((const unsigned*)((const char*)(gbase) + voffB[_i]), (LAS unsigned*)(lds + (bufoff) + ldsw + _i * 8192), 16, 0, 0); } while (0)
#define PG8_STAGEA(bufoff, gbase, o0, o1) do { \
        __builtin_amdgcn_global_load_lds((const unsigned*)((const char*)(gbase) + (o0)), (LAS unsigned*)(lds + (bufoff) + ldsw), 16, 0, 0); \
        __builtin_amdgcn_global_load_lds((const unsigned*)((const char*)(gbase) + (o1)), (LAS unsigned*)(lds + (bufoff) + ldsw + 8192), 16, 0, 0); } while (0)
#define PG8_LDA(dst, b, h) do { _Pragma("unroll") for (int m = 0; m < 4; ++m) { const LAS v4i* _p = (const LAS v4i*)(lds + PG8_SA(b, h) + aoff + m * 2048); dst[m] = __builtin_shufflevector(_p[0], _p[64], 0, 1, 2, 3, 4, 5, 6, 7); } } while (0)
#define PG8_LDB(dst, b, h) do { _Pragma("unroll") for (int n = 0; n < 2; ++n) { const LAS v4i* _p = (const LAS v4i*)(lds + PG8_SB(b, h) + boff + n * 2048); dst[n] = __builtin_shufflevector(_p[0], _p[64], 0, 1, 2, 3, 4, 5, 6, 7); } } while (0)
#define PG8_HALF(x, k) __builtin_bit_cast(bf16x8, __builtin_shufflevector(x, x, 4 * (k), 4 * (k) + 1, 4 * (k) + 2, 4 * (k) + 3))
#define PG8_MMA(ai, bj, At, Bt) do { __builtin_amdgcn_s_setprio(1); _Pragma("unroll") for (int m = 0; m < 4; ++m) _Pragma("unroll") for (int n = 0; n < 2; ++n) { \
        if constexpr (FP8) asm volatile("v_mfma_scale_f32_16x16x128_f8f6f4 %0, %1, %2, %0, %3, %3 op_sel_hi:[0,0,0]" : "+v"(acc[ai][bj][m][n]) : "v"(Bt[n]), "v"(At[m]), "v"(one8));   \
        else { acc[ai][bj][m][n] = __builtin_amdgcn_mfma_f32_16x16x32_bf16(PG8_HALF(Bt[n], 0), PG8_HALF(At[m], 0), acc[ai][bj][m][n], 0, 0, 0); \
               acc[ai][bj][m][n] = __builtin_amdgcn_mfma_f32_16x16x32_bf16(PG8_HALF(Bt[n], 1), PG8_HALF(At[m], 1), acc[ai][bj][m][n], 0, 0, 0); } } __builtin_amdgcn_s_setprio(0); } while (0)
#define PG8_WAIT_V(n) asm volatile("s_waitcnt vmcnt(" #n ")" ::: "memory")
#define PG8_WAIT_L(n) asm volatile("s_waitcnt lgkmcnt(" #n ")" ::: "memory")
#define PG8_BAR __builtin_amdgcn_s_barrier()
#define PG8_SCHED __builtin_amdgcn_sched_barrier(0)
    Unit cur, nxt; int ui = 0;
    if (!S.next(0, cur)) return;
    f32x4 acc[2][2][4][2];
#pragma unroll
    for (int a = 0; a < 2; ++a)
#pragma unroll
        for (int b = 0; b < 2; ++b)
#pragma unroll
            for (int m = 0; m < 4; ++m)
#pragma unroll
                for (int n = 0; n < 2; ++n) acc[a][b][m][n] = (f32x4){0.f, 0.f, 0.f, 0.f};
    v8i At[4], B0[2], B1[2];
    int one8 = 0x7F7F7F7F; asm volatile("" : "+v"(one8));
    const char* cA = cur.a; const char* cB = cur.b;
    PG8_SETOFF(offC, cur);
    PG8_STAGEB(PG8_SB(0, 0), cB); PG8_STAGEB(PG8_SB(0, 1), cB + hstepB); PG8_STAGEA(PG8_SA(0, 0), cA, offC[0][0], offC[0][1]); PG8_STAGEA(PG8_SA(0, 1), cA, offC[1][0], offC[1][1]);
    if (wr == 1) PG8_BAR;
    PG8_WAIT_V(2); PG8_BAR;
    PG8_STAGEB(PG8_SB(1, 0), cB + kstep); PG8_STAGEA(PG8_SA(1, 0), cA + kstep, offC[0][0], offC[0][1]); PG8_STAGEB(PG8_SB(1, 1), cB + hstepB + kstep);
    PG8_WAIT_V(6); PG8_BAR;
    for (;;) {
        const bool has_next = S.next(ui + 1, nxt);
        const char* nA = has_next ? nxt.a : cA; const char* nB = has_next ? nxt.b : cB;
        if constexpr (GATHER) {
#pragma unroll
        for (int h = 0; h < 2; ++h)
#pragma unroll
            for (int i = 0; i < 2; ++i) offN[h][i] = offC[h][i]; }
        for (int t = 0; t < nt; t += 2) {
            const bool last = (t == nt - 2);
            const char* a1 = cA + (size_t)(t + 1) * kstep;
            const char* a2 = last ? nA : cA + (size_t)(t + 2) * kstep; const char* b2 = last ? nB : cB + (size_t)(t + 2) * kstep;
            const char* a3 = a2 + kstep; const char* b3 = b2 + kstep;
            if constexpr (GATHER) { if (last && has_next) PG8_SETOFF(offN, nxt); }
            unsigned q00 = offC[0][0], q01 = offC[0][1], q10 = offC[1][0], q11 = offC[1][1];
            if constexpr (GATHER) { q00 = last ? offN[0][0] : q00; q01 = last ? offN[0][1] : q01; q10 = last ? offN[1][0] : q10; q11 = last ? offN[1][1] : q11; }
            PG8_LDB(B0, 0, 0); PG8_LDB(B1, 0, 1); PG8_SCHED; PG8_LDA(At, 0, 0); PG8_STAGEA(PG8_SA(1, 1), a1, offC[1][0], offC[1][1]);
            PG8_WAIT_V(8); PG8_WAIT_L(0); PG8_BAR; PG8_MMA(0, 0, At, B0); PG8_MMA(0, 1, At, B1); PG8_BAR; PG8_SCHED;
            PG8_LDA(At, 0, 1); PG8_STAGEB(PG8_SB(0, 0), b2); PG8_STAGEB(PG8_SB(0, 1), b2 + hstepB); PG8_STAGEA(PG8_SA(0, 0), a2, q00, q01);
            PG8_WAIT_V(8); PG8_WAIT_L(0); PG8_BAR; PG8_MMA(1, 0, At, B0); PG8_MMA(1, 1, At, B1); PG8_BAR; PG8_SCHED;
            PG8_LDB(B0, 1, 0); PG8_LDB(B1, 1, 1); PG8_SCHED; PG8_LDA(At, 1, 0); PG8_STAGEA(PG8_SA(0, 1), a2, q10, q11);
            PG8_WAIT_V(8); PG8_WAIT_L(0); PG8_BAR; PG8_MMA(0, 0, At, B0); PG8_MMA(0, 1, At, B1); PG8_BAR; PG8_SCHED;
            PG8_LDA(At, 1, 1); PG8_STAGEB(PG8_SB(1, 0), b3); PG8_STAGEB(PG8_SB(1, 1), b3 + hstepB); PG8_STAGEA(PG8_SA(1, 0), a3, q00, q01);
            PG8_WAIT_V(8); PG8_WAIT_L(0); PG8_BAR; PG8_MMA(1, 0, At, B0); PG8_MMA(1, 1, At, B1); PG8_BAR; PG8_SCHED;
        }
        if (wr == 0) PG8_BAR;
        if constexpr (FP8) asm volatile("s_nop 15\n\ts_nop 15" ::: "memory");
        E(acc, cur, wr, wc, fr, fq);
        if (!has_next) break;
#pragma unroll
        for (int a = 0; a < 2; ++a)
#pragma unroll
            for (int b = 0; b < 2; ++b)
#pragma unroll
                for (int m = 0; m < 4; ++m)
#pragma unroll
                    for (int n = 0; n < 2; ++n) acc[a][b][m][n] = (f32x4){0.f, 0.f, 0.f, 0.f};
        cur = nxt; cA = nA; cB = nB; ++ui;
        if constexpr (GATHER) {
#pragma unroll
        for (int h = 0; h < 2; ++h)
#pragma unroll
            for (int i = 0; i < 2; ++i) offC[h][i] = offN[h][i]; }
        if (wr == 1) PG8_BAR;
    }
    PG8_WAIT_V(0);
    PG8_BAR;
#undef PG8_SETOFF
#undef PG8_SA
#undef PG8_SB
#undef PG8_STAGEA
#undef PG8_STAGEB
#undef PG8_LDA
#undef PG8_LDB
#undef PG8_MMA
#undef PG8_HALF
#undef PG8_WAIT_V
#undef PG8_WAIT_L
#undef PG8_BAR
#undef PG8_SCHED
}
}

#define XB_TMO      128
#define XB_XCNT(j)  (256  + 64 * (j))
#define XB_XSUB(j)  (1280 + 64 * (j))
#define XB_XGEN(j)  (2304 + 64 * (j))
#define XB_TOP      3328
#define XB_TOPGEN   3392
#define XCD_BAR_WORDS 3456
#define XB_SPIN_CAP (1u << 18)
__device__ __forceinline__ unsigned xb_ld(unsigned* p)              { return __hip_atomic_load(p, __ATOMIC_RELAXED, __HIP_MEMORY_SCOPE_AGENT); }
__device__ __forceinline__ unsigned xb_add(unsigned* p, unsigned v) { return __hip_atomic_fetch_add(p, v, __ATOMIC_RELAXED, __HIP_MEMORY_SCOPE_AGENT); }
__device__ __forceinline__ unsigned xb_xcc_id() { return (unsigned)__builtin_amdgcn_s_getreg((3 << 11) | 20) & 0xFu; }
#define XB_SPIN(cond, bar) do { unsigned _sp = 0; while (cond) { __builtin_amdgcn_s_sleep(1); \
    if ((++_sp & 255u) == 0u) { if (xb_ld(&(bar)[XB_TMO])) break; if (_sp > XB_SPIN_CAP) { atomicAdd(&(bar)[XB_TMO], 1u); break; } } } } while (0)
struct XcdBarrier { unsigned* bar; unsigned x; volatile LAS unsigned* st; };
__device__ __forceinline__ XcdBarrier xcd_barrier_post(unsigned* bar, volatile LAS unsigned* st) {
    XcdBarrier b; b.bar = bar; b.x = xb_xcc_id(); b.st = st;
    if (threadIdx.x == 0) (void)xb_add(&bar[XB_XCNT(b.x)], 1u);
    return b;
}
__device__ __forceinline__ void xcd_barrier_complete(unsigned* bar, unsigned x, unsigned& nloc, unsigned& nx) {
    const unsigned G = gridDim.x * gridDim.y * gridDim.z;
    unsigned sum, cnt, mine, sp = 0u;
    for (;;) {
        sum = 0u; cnt = 0u; mine = 0u;
#pragma unroll
        for (unsigned j = 0; j < 16; ++j) { const unsigned c = xb_ld(&bar[XB_XCNT(j)]); sum += c; cnt += (c > 0u) ? 1u : 0u; mine = (j == x) ? c : mine; }
        if (sum == G) break;
        __builtin_amdgcn_s_sleep(1);
        if ((++sp & 255u) == 0u) { if (xb_ld(&bar[XB_TMO])) break; if (sp > XB_SPIN_CAP) { atomicAdd(&bar[XB_TMO], 1u); break; } }
    }
    nloc = mine > 0u ? mine : 1u; nx = cnt > 0u ? cnt : 1u;
}
__device__ __forceinline__ void xcd_barrier(const XcdBarrier& b) {
    asm volatile("s_waitcnt vmcnt(0)" ::: "memory");
    __syncthreads();
    if (threadIdx.x == 0) {
        unsigned* bar = b.bar;
        __builtin_amdgcn_s_waitcnt(0);
        unsigned nloc = b.st[0], nx = b.st[1];
        if (nloc == 0u) { xcd_barrier_complete(bar, b.x, nloc, nx); b.st[0] = nloc; b.st[1] = nx; }
        const unsigned old = xb_add(&bar[XB_XSUB(b.x)], 1u);
        const unsigned gen = old / nloc;
        if (old + 1u == (gen + 1u) * nloc) {
            __builtin_amdgcn_fence(__ATOMIC_RELEASE, "agent");
            asm volatile("s_waitcnt vmcnt(0)" ::: "memory");
            const unsigned og = xb_add(&bar[XB_TOP], 1u);
            const unsigned tg = og / nx;
            if (og + 1u == (tg + 1u) * nx) xb_add(&bar[XB_TOPGEN], 1u);
            else XB_SPIN(xb_ld(&bar[XB_TOPGEN]) == tg, bar);
            __builtin_amdgcn_fence(__ATOMIC_ACQUIRE, "agent");
            xb_add(&bar[XB_XGEN(b.x)], 1u);
            asm volatile("s_waitcnt vmcnt(0)" ::: "memory");
        } else {
            XB_SPIN(xb_ld(&bar[XB_XGEN(b.x)]) == gen, bar);
            __builtin_amdgcn_fence(__ATOMIC_ACQUIRE, "agent");
            asm volatile("s_waitcnt vmcnt(0)" ::: "memory");
        }
    }
    __syncthreads();
}

struct Args { const float* in[38]; float* out; unsigned char* ws; int ph_lo, ph_hi, li, pad; };
struct Frame {
    LAS unsigned char* lds;
    int tid, lane, wave, G, gw, NGW;
    int gt, NGT;
};
enum { I_X = 0, I_META, I_NORM_MIX0, I_WIN0, I_CONVW, I_CONVB, I_GAW, I_GAB, I_GXW, I_GXB, I_LAM, I_LRE, I_LIM, I_LDT, I_BRE, I_BIM, I_CRE, I_CIM, I_SD, I_GLUW, I_GLUB, I_WOUT0, I_NORM_FFN0,
       I_FG, I_FU, I_FD, I_NORM_MIX1, I_WIN1, I_GW2, I_GB, I_GNORM, I_WOUT1, I_NORM_FFN1, I_ROUTER, I_MG, I_MU, I_MD, I_FNORM };

struct SchedStatic {
    int nM, nN, G, c; const char* A; const char* B; size_t aStep, bStep; int aColDiv; size_t aColStep;
    __device__ __forceinline__ bool next(int i, pg8::Unit& u) const {
        int pm, pn; if (!pg8::static_tile(i, G, c, nM, nN, pm, pn)) return false;
        u.pm = pm; u.pn = pn; u.slot = i; u.a = A + (size_t)pm * aStep + (aColDiv ? (size_t)(pn / aColDiv) * aColStep : 0); u.b = B + (size_t)pn * bStep; return true;
    }
};
struct SchedList {
    int n; const LAS int* meta; const char* A; const char* B; size_t aStep, bTile, bExpert;
    __device__ __forceinline__ bool next(int i, pg8::Unit& u) const {
        if (i >= n) return false;
        const int pm = meta[i * 4 + 0], pn = meta[i * 4 + 1], e = meta[i * 4 + 2];
        u.pm = pm; u.pn = pn; u.slot = i; const int ko = meta[i * 4 + 3]; u.a = A + (size_t)pm * aStep + (size_t)ko * 2; u.b = B + (size_t)e * bExpert + (size_t)pn * bTile + (size_t)ko * 2; return true;
    }
};

#define EPI_ROWS(ai, m) ((ai) * 128 + wr * 64 + (m) * 16 + fr)
#define EPI_COLP(bj) ((bj) * 128 + wc * 32 + 8 * fq)
#define EPI_COLN(bj, n) ((bj) * 128 + wc * 32 + 16 * (n) + 4 * fq)
typedef const f32x4 (&AccRef)[2][2][4][2];
__device__ __forceinline__ void unpack8(v4u w, f32x4& a, f32x4& b) { a = (f32x4){bflo(w.x), bfhi(w.x), bflo(w.y), bfhi(w.y)}; b = (f32x4){bflo(w.z), bfhi(w.z), bflo(w.w), bfhi(w.w)}; }
__device__ __forceinline__ v4u pack8(f32x4 a, f32x4 b) { v4u w; w.x = pg8::cvt_pk_bf16(a[0], a[1]); w.y = pg8::cvt_pk_bf16(a[2], a[3]); w.z = pg8::cvt_pk_bf16(b[0], b[1]); w.w = pg8::cvt_pk_bf16(b[2], b[3]); return w; }

template <int D> __device__ __forceinline__ float ror16(float v) { return __builtin_bit_cast(float, __builtin_amdgcn_update_dpp(0, __builtin_bit_cast(int, v), 0x120 + D, 0xF, 0xF, false)); }
struct EpiWin0 {
    static constexpr bool PERM = true; bf16 *G, *XR, *U; const float *cw, *cb; bf16* XC;
    __device__ __forceinline__ void operator()(AccRef acc, const pg8::Unit& u, int wr, int wc, int fr, int fq) const {
        const int pn = u.pn; bf16* base; int ld, c0;
        if (pn >= 4 && pn < 8) {
#pragma unroll
            for (int bj = 0; bj < 2; ++bj) { const int cc = (pn - 4) * 256 + EPI_COLP(bj);
                f32x4 w0[2], w1[2], w2[2], w3[2], bb[2];
#pragma unroll
                for (int n = 0; n < 2; ++n) { w0[n] = *(const f32x4*)(cw + cc + 4 * n); w1[n] = *(const f32x4*)(cw + 1024 + cc + 4 * n); w2[n] = *(const f32x4*)(cw + 2048 + cc + 4 * n); w3[n] = *(const f32x4*)(cw + 3072 + cc + 4 * n); bb[n] = *(const f32x4*)(cb + cc + 4 * n); }
#pragma unroll
                for (int ai = 0; ai < 2; ++ai) { f32x4 q1[2], q2[2], q3[2];
#pragma unroll
                    for (int n = 0; n < 2; ++n) { q1[n] = (f32x4){0.f, 0.f, 0.f, 0.f}; q2[n] = q1[n]; q3[n] = q1[n]; }
#pragma unroll
                    for (int m = 0; m < 4; ++m) { const size_t ro = (size_t)(u.pm * 256 + EPI_ROWS(ai, m)) * 1024 + cc; f32x4 o[2];
#pragma unroll
                        for (int n = 0; n < 2; ++n) { const f32x4 x = acc[ai][bj][m][n]; f32x4 t1, t2, t3, p1, p2, p3;
#pragma unroll
                            for (int j = 0; j < 4; ++j) { t1[j] = ror16<1>(x[j]); t2[j] = ror16<2>(x[j]); t3[j] = ror16<3>(x[j]);
                                p1[j] = fr >= 1 ? t1[j] : q1[n][j]; p2[j] = fr >= 2 ? t2[j] : q2[n][j]; p3[j] = fr >= 3 ? t3[j] : q3[n][j]; }
                            o[n] = bb[n] + w0[n] * p3 + w1[n] * p2 + w2[n] * p1 + w3[n] * x;
                            q1[n] = t1; q2[n] = t2; q3[n] = t3; }
                        const bool fix = (m == 0) && fr < 3;
                        if (!fix) *(v4u*)(XC + ro) = pack8(o[0], o[1]);
                        if (fix || ((m == 3) && fr >= 13)) *(v4u*)(XR + ro) = pack8(acc[ai][bj][m][0], acc[ai][bj][m][1]);
                        asm volatile("" : "+v"(q1[0]), "+v"(q2[0]), "+v"(q3[0]), "+v"(q1[1]), "+v"(q2[1]), "+v"(q3[1]) :: "memory"); } } }
            return; }
        if (pn < 4) { base = G; ld = 1024; c0 = pn * 256; } else if (pn < 8) { base = XR; ld = 1024; c0 = (pn - 4) * 256; } else { base = U; ld = 512; c0 = (pn - 8) * 256; }
#pragma unroll
        for (int ai = 0; ai < 2; ++ai)
#pragma unroll
            for (int m = 0; m < 4; ++m) { bf16* rowp = base + (size_t)(u.pm * 256 + EPI_ROWS(ai, m)) * ld + c0;
#pragma unroll
                for (int bj = 0; bj < 2; ++bj) { f32x4 v0 = acc[ai][bj][m][0], v1 = acc[ai][bj][m][1];
                    if (pn < 4) {
#pragma unroll
                        for (int j = 0; j < 1; ++j) { v0 = gelu_tanh_4(v0); v1 = gelu_tanh_4(v1); } }
                    *(v4u*)(rowp + EPI_COLP(bj)) = pack8(v0, v1); } }
    }
};
struct EpiGates {
    static constexpr bool PERM = true; const float *gab, *gxb, *sp8; const bf16* XC; bf16* A; bf16* BX;
    __device__ __forceinline__ void operator()(AccRef acc, const pg8::Unit& u, int wr, int wc, int fr, int fq) const {
        const int ch0 = (u.pn >> 1) * 256 + (u.pn & 1) * 128 + wc * 32 + 8 * fq;
        f32x4 ba[2], bx[2], sp[2];
#pragma unroll
        for (int n = 0; n < 2; ++n) { ba[n] = *(const f32x4*)(gab + ch0 + 4 * n); bx[n] = *(const f32x4*)(gxb + ch0 + 4 * n); sp[n] = *(const f32x4*)(sp8 + ch0 + 4 * n); }
#pragma unroll
        for (int ai = 0; ai < 2; ++ai)
#pragma unroll
            for (int m = 0; m < 4; ++m) { const size_t ro = (size_t)(u.pm * 256 + EPI_ROWS(ai, m)) * 1024 + ch0;
                const v4u xw = *(const v4u*)(XC + ro); f32x4 xv[2]; unpack8(xw, xv[0], xv[1]);
                f32x4 av[2], bv[2];
#pragma unroll
                for (int n = 0; n < 2; ++n) { const f32x4 r = sigmoid_4(acc[ai][0][m][n] + ba[n]), ig = sigmoid_4(acc[ai][1][m][n] + bx[n]);
                    const f32x4 la = r * sp[n] * -1.0f, aa = exp2_4(la * 1.4426950408889634f); f32x4 om = aa * aa * -1.0f + 1.0f, sq;
#pragma unroll
                    for (int j = 0; j < 4; ++j) sq[j] = __builtin_amdgcn_sqrtf(fmaxf(om[j], 0.0f));
                    av[n] = la; bv[n] = sq * ig * xv[n]; }
                *(v4u*)(A + ro) = pack8(av[0], av[1]); *(v4u*)(BX + ro) = pack8(bv[0], bv[1]); asm volatile("" ::: "memory"); }
    }
};
struct EpiGlu {
    static constexpr bool PERM = true; const float* glub; const bf16* GS; bf16* AOUT;
    __device__ __forceinline__ void operator()(AccRef acc, const pg8::Unit& u, int wr, int wc, int fr, int fq) const {
#pragma unroll
        for (int bj = 0; bj < 2; ++bj) { const int c = u.pn * 256 + EPI_COLP(bj); const f32x4 b0 = *(const f32x4*)(glub + c), b1 = *(const f32x4*)(glub + c + 4);
#pragma unroll
            for (int ai = 0; ai < 2; ++ai)
#pragma unroll
                for (int m = 0; m < 4; ++m) { const size_t row = (size_t)(u.pm * 256 + EPI_ROWS(ai, m));
                    f32x4 g0_, g1_; unpack8(*(const v4u*)(GS + row * 512 + c), g0_, g1_);
                    const f32x4 v0 = g0_ * sigmoid_4(acc[ai][bj][m][0] + b0), v1 = g1_ * sigmoid_4(acc[ai][bj][m][1] + b1);
                    *(v4u*)(AOUT + row * 1536 + 1024 + c) = pack8(v0, v1); } }
    }
};
struct EpiResid {
    static constexpr bool PERM = true; const float* xsrc; bf16* hb; float* ssqp;
    __device__ __forceinline__ void operator()(AccRef acc, const pg8::Unit& u, int wr, int wc, int fr, int fq) const {
        float q[2][4];
#pragma unroll
        for (int ai = 0; ai < 2; ++ai)
#pragma unroll
            for (int m = 0; m < 4; ++m) { const size_t ro = (size_t)(u.pm * 256 + EPI_ROWS(ai, m)) * 1024 + u.pn * 256; float qs = 0.f;
#pragma unroll
                for (int bj = 0; bj < 2; ++bj) { const size_t o = ro + EPI_COLP(bj); f32x4 v0, v1;
                    if (xsrc) { v0 = *(const f32x4*)(xsrc + o); v1 = *(const f32x4*)(xsrc + o + 4); } else unpack8(*(const v4u*)(hb + o), v0, v1);
                    v0 += acc[ai][bj][m][0]; v1 += acc[ai][bj][m][1];
                    qs += ((v0.x * v0.x + v0.y * v0.y) + (v0.z * v0.z + v0.w * v0.w)) + ((v1.x * v1.x + v1.y * v1.y) + (v1.z * v1.z + v1.w * v1.w));
                    *(v4u*)(hb + o) = pack8(v0, v1); }
                q[ai][m] = qs; }
        if (ssqp) {
#pragma unroll
            for (int ai = 0; ai < 2; ++ai)
#pragma unroll
                for (int m = 0; m < 4; ++m) { float t = q[ai][m]; t += __shfl_xor(t, 16); t += __shfl_xor(t, 32);
                    if (fq == 0) ssqp[(size_t)(u.pm * 256 + EPI_ROWS(ai, m)) * 16 + u.pn * 4 + wc] = t; } }
    }
};
__device__ __forceinline__ f32x4 swiglu4_x32(f32x4 G, f32x4 U) {
    const f32x4 a = G * (-1.4426950408889634f / 32.0f) + 10.0f; f32x4 t;
#pragma unroll
    for (int j = 0; j < 4; ++j) t[j] = __builtin_amdgcn_exp2f(a[j]);
    const f32x4 d = t + 1024.0f; f32x4 q;
#pragma unroll
    for (int j = 0; j < 4; ++j) q[j] = rcpf_(d[j]);
    return (G * U) * q; }
__device__ __forceinline__ f32x4 swiglu4_r(f32x4 G, f32x4 U, float r2, float rl) {
    const f32x4 a = G * rl; f32x4 t;
#pragma unroll
    for (int j = 0; j < 4; ++j) t[j] = __builtin_amdgcn_exp2f(a[j]);
    const f32x4 d = t + 1.0f; f32x4 q;
#pragma unroll
    for (int j = 0; j < 4; ++j) q[j] = rcpf_(d[j]);
    return (G * U) * (q * r2); }
__device__ __forceinline__ float rstd_of(const float* ssqp, size_t row) { const f32x4* p = (const f32x4*)(ssqp + row * 16); const f32x4 a = p[0], b = p[1], c = p[2], d = p[3];
    const f32x4 t = (a + b) + (c + d); return __builtin_amdgcn_rsqf(((t.x + t.y) + (t.z + t.w)) * (1.0f / 1024.0f) + EPS); }
constexpr int FOLD_MAXU = 20;
__device__ __forceinline__ float fold_rstd(const LAS float* rst, const float* ssqp, const pg8::Unit& u, int r) { return u.slot < FOLD_MAXU ? rst[u.slot * 256 + r] : rstd_of(ssqp, (size_t)(u.pm * 256 + r)); }
struct EpiSwiglu {
    static constexpr bool PERM = true; bf16* H; int ld; const float* ssqp; const LAS float* rst;
    __device__ __forceinline__ void operator()(AccRef acc, const pg8::Unit& u, int wr, int wc, int fr, int fq) const {
        const int c = u.pn * 128 + wc * 32 + 8 * fq;
        float rs[2][4];
#pragma unroll
        for (int ai = 0; ai < 2; ++ai)
#pragma unroll
            for (int m = 0; m < 4; ++m) rs[ai][m] = fold_rstd(rst, ssqp, u, EPI_ROWS(ai, m));
#pragma unroll
        for (int ai = 0; ai < 2; ++ai)
#pragma unroll
            for (int m = 0; m < 4; ++m) { const float r = rs[ai][m], r2 = r * r, rl = r * -1.4426950408889634f;
                const f32x4 v0 = swiglu4_r(acc[ai][0][m][0], acc[ai][1][m][0], r2, rl), v1 = swiglu4_r(acc[ai][0][m][1], acc[ai][1][m][1], r2, rl);
                *(v4u*)(H + (size_t)(u.pm * 256 + EPI_ROWS(ai, m)) * ld + c) = pack8(v0, v1); }
    }
};
struct EpiWin1 {
    static constexpr bool PERM = true; bf16 *Q, *K, *V, *GATE; bf16* LG; const float* gb; const float* ssqp; const LAS float* rst;
    __device__ __forceinline__ void operator()(AccRef acc, const pg8::Unit& u, int wr, int wc, int fr, int fq) const {
        const int pn = u.pn;
        float rs[2][4];
#pragma unroll
        for (int ai = 0; ai < 2; ++ai)
#pragma unroll
            for (int m = 0; m < 4; ++m) rs[ai][m] = fold_rstd(rst, ssqp, u, EPI_ROWS(ai, m));
#pragma unroll
        for (int ai = 0; ai < 2; ++ai)
#pragma unroll
            for (int m = 0; m < 4; ++m) { const size_t row = (size_t)(u.pm * 256 + EPI_ROWS(ai, m)); const float r = rs[ai][m];
#pragma unroll
                for (int bj = 0; bj < 2; ++bj) { f32x4 v0 = acc[ai][bj][m][0] * r, v1 = acc[ai][bj][m][1] * r; const int cc = EPI_COLP(bj);
                    if (pn < 2) { v0 = v0 * 0.08838834764831845f; v1 = v1 * 0.08838834764831845f; *(v4u*)(Q + row * 512 + pn * 256 + cc) = pack8(v0, v1); }
                    else if (pn < 4) { *(v4u*)(K + row * 512 + (pn - 2) * 256 + cc) = pack8(v0, v1); }
                    else if (pn < 8) { *(v4u*)(V + row * 1024 + (pn - 4) * 256 + cc) = pack8(v0, v1); }
                    else if (pn < 12) {
#pragma unroll
                        for (int j = 0; j < 1; ++j) { v0 = silu_4(v0); v1 = silu_4(v1); }
                        *(v4u*)(GATE + row * 1024 + (pn - 8) * 256 + cc) = pack8(v0, v1); }
                    else { const int c = (pn - 12) * 256 + cc; const f32x4 b0 = *(const f32x4*)(gb + c), b1 = *(const f32x4*)(gb + c + 4);
#pragma unroll
                        for (int j = 0; j < 4; ++j) { v0[j] = logsigmoidf_(v0[j] + b0[j]) * LG2S; v1[j] = logsigmoidf_(v1[j] + b1[j]) * LG2S; }
                        *(v4u*)(LG + row * 512 + c) = pack8(v0, v1); } } }
    }
};
__device__ __forceinline__ float swiglu_x32(float G, float U) { const float t = __builtin_amdgcn_exp2f(__builtin_fmaf(G, -1.4426950408889634f / 32.0f, 10.0f)); return (G * U) * rcpf_(1024.0f + t); }
struct EpiSwiglu8 {
    static constexpr bool PERM = true; unsigned char* H; int ld;
    __device__ __forceinline__ void operator()(AccRef acc, const pg8::Unit& u, int wr, int wc, int fr, int fq) const {
        const int c = u.pn * 128 + wc * 32 + 8 * fq; constexpr float SC = 1.0f / 32.0f;
#pragma unroll
        for (int ai = 0; ai < 2; ++ai)
#pragma unroll
            for (int m = 0; m < 4; ++m) { float v[8];
#pragma unroll
                for (int j = 0; j < 1; ++j) { const f32x4 o0 = swiglu4_x32(acc[ai][0][m][0], acc[ai][1][m][0]), o1 = swiglu4_x32(acc[ai][0][m][1], acc[ai][1][m][1]);
                    v[0] = o0.x; v[1] = o0.y; v[2] = o0.z; v[3] = o0.w; v[4] = o1.x; v[5] = o1.y; v[6] = o1.z; v[7] = o1.w; }
                *(v2u*)(H + (size_t)(u.pm * 256 + EPI_ROWS(ai, m)) * ld + c) = (v2u){pk4_fp8(v[0], v[1], v[2], v[3]), pk4_fp8(v[4], v[5], v[6], v[7])}; }
    }
};
struct EpiMoeDown {
    static constexpr bool PERM = true; bf16* hb; const LAS int* toks; const LAS float* wts;
    __device__ __forceinline__ void operator()(AccRef acc, const pg8::Unit& u, int wr, int wc, int fr, int fq) const {
#pragma unroll
        for (int ai = 0; ai < 2; ++ai)
#pragma unroll
            for (int m = 0; m < 4; ++m) { const int rl = u.slot * 256 + EPI_ROWS(ai, m); const int tok = toks[rl]; const float w = wts[rl] * (1.0f / 64.0f);
                if (tok >= 0) { bf16* d = hb + (size_t)tok * 1024 + u.pn * 256;
#pragma unroll
                    for (int bj = 0; bj < 2; ++bj) { bf16* p = d + EPI_COLP(bj); f32x4 v0, v1; unpack8(*(const v4u*)p, v0, v1); *(v4u*)p = pack8(v0 + acc[ai][bj][m][0] * w, v1 + acc[ai][bj][m][1] * w); } } }
    }
};
struct EpiSlab {
    static constexpr bool PERM = false; float* slab; const LAS int* meta;
    __device__ __forceinline__ void operator()(AccRef acc, const pg8::Unit& u, int wr, int wc, int fr, int fq) const {
        const int sl = meta[u.slot * 4 + 3] / 256; float* base = slab + ((size_t)(sl * 8 + (u.pm - 128)) * 256) * 1024 + u.pn * 256;
#pragma unroll
        for (int ai = 0; ai < 2; ++ai)
#pragma unroll
            for (int m = 0; m < 4; ++m) { float* d = base + (size_t)EPI_ROWS(ai, m) * 1024;
#pragma unroll
                for (int bj = 0; bj < 2; ++bj)
#pragma unroll
                    for (int n = 0; n < 2; ++n) *(f32x4*)(d + EPI_COLN(bj, n)) = acc[ai][bj][m][n] * (1.0f / 64.0f); }
    }
};

__device__ __forceinline__ void tr_item8(const float* W, int ldw, int col, int k0, unsigned char* WT, int ldt, int drow, float scale, LAS float* scr, int lane) {
    float wv[32];
#pragma unroll
    for (int i = 0; i < 32; ++i) wv[i] = __builtin_nontemporal_load(W + (size_t)(k0 + 2 * i + (lane >> 5)) * ldw + col + (lane & 31));
#pragma unroll
    for (int i = 0; i < 32; ++i) scr[(2 * i + (lane >> 5)) * 33 + (lane & 31)] = wv[i] * scale;
    LDS_WAIT(); asm volatile("" ::: "memory");
    const int c = lane & 7;
#pragma unroll
    for (int j = 0; j < 4; ++j) { const int n = (lane >> 3) + 8 * j; const LAS float* s = scr + (8 * c) * 33 + n;
        *(v2u*)(WT + (size_t)(drow + n) * ldt + k0 + 8 * c) = (v2u){pk4_fp8(s[0 * 33], s[1 * 33], s[2 * 33], s[3 * 33]), pk4_fp8(s[4 * 33], s[5 * 33], s[6 * 33], s[7 * 33])}; }
    LDS_WAIT(); asm volatile("" ::: "memory");
}
__device__ __forceinline__ void tr_item(const float* W, int ldw, int col, int k0, bf16* WT, int ldt, int drow, LAS float* scr, int lane, const float* rs = nullptr) {
    float wv[32];
#pragma unroll
    for (int i = 0; i < 32; ++i) wv[i] = __builtin_nontemporal_load(W + (size_t)(k0 + 2 * i + (lane >> 5)) * ldw + col + (lane & 31));
#pragma unroll
    for (int i = 0; i < 32; ++i) scr[(2 * i + (lane >> 5)) * 33 + (lane & 31)] = rs ? wv[i] * rs[k0 + 2 * i + (lane >> 5)] : wv[i];
    LDS_WAIT(); asm volatile("" ::: "memory");
    const int c = lane & 7;
#pragma unroll
    for (int j = 0; j < 4; ++j) { const int n = (lane >> 3) + 8 * j; const LAS float* s = scr + (8 * c) * 33 + n;
        v4u o; o.x = pk2(s[0 * 33], s[1 * 33]); o.y = pk2(s[2 * 33], s[3 * 33]); o.z = pk2(s[4 * 33], s[5 * 33]); o.w = pk2(s[6 * 33], s[7 * 33]);
        *(v4u*)(WT + (size_t)(drow + n) * ldt + k0 + 8 * c) = o; }
    LDS_WAIT(); asm volatile("" ::: "memory");
}
struct TrJob { const float* W; int ldw, col0, K, N; bf16* WT; int blk, bstride, add; const float* rs = nullptr; };
__device__ __forceinline__ bool tr_try(int& r, const TrJob& j, LAS float* scr, int lane) {
    const int nblk = j.N / 32, items = (j.K / 64) * nblk;
    if (r >= items) { r -= items; return false; }
    const int kb = r / nblk, n0 = (r % nblk) * 32;
    tr_item(j.W, j.ldw, j.col0 + n0, kb * 64, j.WT, j.K, (n0 / j.blk) * j.bstride + (n0 % j.blk) + j.add, scr, lane, j.rs);
    return true;
}
__device__ __forceinline__ void norm_row_bf16(const float* xrow, const float* gain, bf16* orow, int lane) {
    const f32x4* xr = (const f32x4*)xrow + lane; const f32x4* gr = (const f32x4*)gain + lane;
    f32x4 v[4]; float s = 0.f;
#pragma unroll
    for (int j = 0; j < 4; ++j) { v[j] = xr[64 * j]; s += (v[j].x * v[j].x + v[j].y * v[j].y) + (v[j].z * v[j].z + v[j].w * v[j].w); }
    const float rstd = 1.0f / sqrtf(wave_sum(s) * (1.0f / 1024.0f) + EPS);
    v2u* o8 = (v2u*)orow + lane;
#pragma unroll
    for (int j = 0; j < 4; ++j) { const f32x4 g = gr[64 * j]; v2u w; w.x = pk2(v[j].x * rstd * g.x, v[j].y * rstd * g.y); w.y = pk2(v[j].z * rstd * g.z, v[j].w * rstd * g.w); o8[64 * j] = w; }
}
__device__ __forceinline__ void norm_row_b2b(const bf16* hrow, const float* gain, bf16* orow, int lane) {
    f32x4 v[4]; unpack8(*(const v4u*)(hrow + 8 * lane), v[0], v[1]); unpack8(*(const v4u*)(hrow + 512 + 8 * lane), v[2], v[3]); float s = 0.f;
#pragma unroll
    for (int j = 0; j < 4; ++j) s += (v[j].x * v[j].x + v[j].y * v[j].y) + (v[j].z * v[j].z + v[j].w * v[j].w);
    const float rstd = 1.0f / sqrtf(wave_sum(s) * (1.0f / 1024.0f) + EPS);
    const f32x4 g0 = *(const f32x4*)(gain + 8 * lane), g1 = *(const f32x4*)(gain + 8 * lane + 4), g2 = *(const f32x4*)(gain + 512 + 8 * lane), g3 = *(const f32x4*)(gain + 512 + 8 * lane + 4);
    *(v4u*)(orow + 8 * lane) = pack8(v[0] * rstd * g0, v[1] * rstd * g1); *(v4u*)(orow + 512 + 8 * lane) = pack8(v[2] * rstd * g2, v[3] * rstd * g3);
}

__device__ __forceinline__ void cexp_f(double re, double im, float& er, float& ei) {
    const float mag = __expf((float)re); double rev = im * 0.15915494309189535; rev -= floor(rev); const float fr_ = (float)rev;
    er = mag * __builtin_amdgcn_cosf(fr_); ei = mag * __builtin_amdgcn_sinf(fr_);
}
__device__ __forceinline__ void p0_prologue(const Frame& F, const Args& a, unsigned char* ws) {
    LAS float* scr = (LAS float*)(F.lds + RING_OFF + F.wave * 16384);
    const float* const* in = a.in;
    constexpr int BIG = 1 << 30;
    for (int it = F.gw; ; it += F.NGW) {
        int r = it;
        { TrJob j{in[I_WIN0], EV_IN, 0, 1024, EV_IN, (bf16*)(ws + WS_WIN0), BIG, 0, 0}; if (tr_try(r, j, scr, F.lane)) continue; }
        bool done = false;
        for (int h = 0; h < 4 && !done; ++h) {
            { TrJob j{in[I_GAW] + (size_t)h * 65536, 256, 0, 256, 256, (bf16*)(ws + WS_GW) + (size_t)h * 512 * 256, 128, 256, 0}; if (tr_try(r, j, scr, F.lane)) { done = true; break; } }
            { TrJob j{in[I_GXW] + (size_t)h * 65536, 256, 0, 256, 256, (bf16*)(ws + WS_GW) + (size_t)h * 512 * 256, 128, 256, 128}; if (tr_try(r, j, scr, F.lane)) { done = true; break; } }
        }
        if (done) continue;
        { TrJob j{in[I_GLUW], 512, 0, 512, 512, (bf16*)(ws + WS_GLUW), BIG, 0, 0}; if (tr_try(r, j, scr, F.lane)) continue; }
        { TrJob j{in[I_WOUT0], 1024, 0, EV_MIX, 1024, (bf16*)(ws + WS_WOUT0), BIG, 0, 0}; if (tr_try(r, j, scr, F.lane)) continue; }
        { TrJob j{in[I_FG], FF0, 0, 1024, FF0, (bf16*)(ws + WS_WUP0), 128, 256, 0, in[I_NORM_FFN0]}; if (tr_try(r, j, scr, F.lane)) continue; }
        { TrJob j{in[I_FU], FF0, 0, 1024, FF0, (bf16*)(ws + WS_WUP0), 128, 256, 128, in[I_NORM_FFN0]}; if (tr_try(r, j, scr, F.lane)) continue; }
        { TrJob j{in[I_FD], 1024, 0, FF0, 1024, (bf16*)(ws + WS_WDN0), BIG, 0, 0}; if (tr_try(r, j, scr, F.lane)) continue; }
        { TrJob j{in[I_WIN1], OD_IN, 0, 1024, 3072, (bf16*)(ws + WS_WIN1), BIG, 0, 0, in[I_NORM_MIX1]}; if (tr_try(r, j, scr, F.lane)) continue; }
        { TrJob j{in[I_WOUT1], 1024, 0, 1024, 1024, (bf16*)(ws + WS_WOUT1), BIG, 0, 0}; if (tr_try(r, j, scr, F.lane)) continue; }
        break;
    }
    for (long i = F.gt; i < 512L * 1024; i += F.NGT) { const int j = (int)(i & 511), k = (int)(i >> 9); const float* wr_ = in[I_WIN1] + (size_t)k * OD_IN + 3072; const float* w2 = in[I_GW2] + j; float s = 0.f;
#pragma unroll
        for (int r = 0; r < 16; ++r) s += wr_[r] * w2[r * 512];
        ((bf16*)(ws + WS_WIN1))[(size_t)(3072 + j) * 1024 + k] = (bf16)f2bf(s * in[I_NORM_MIX1][k]); }
    float* tab = (float*)(ws + WS_TAB);
    for (long i = F.gt; i < NG * NS; i += F.NGT) { const int g = (int)i / NS;
        const double lr = in[I_LRE][i], li = in[I_LIM][i], dt = (double)expf(in[I_LDT][g]);
        float arf, aif, a64r, a64i; cexp_f(dt * lr, dt * li, arf, aif); cexp_f(64.0 * dt * lr, 64.0 * dt * li, a64r, a64i);
        const float lrf = (float)lr, lif = (float)li, den = lrf * lrf + lif * lif, nr = arf - 1.0f;
        const float zr = (nr * lrf + aif * lif) / den, zi = (aif * lrf - nr * lif) / den;
        ((float*)((char*)tab + TB_AR))[i] = arf; ((float*)((char*)tab + TB_AI))[i] = aif;
        ((float*)((char*)tab + TB_AR64))[i] = a64r; ((float*)((char*)tab + TB_AI64))[i] = a64i;
        for (int h = 0; h < 16; ++h) { const float br = in[I_BRE][i * 16 + h], bi = in[I_BIM][i * 16 + h];
            ((float*)((char*)tab + TB_BBR))[i * 16 + h] = zr * br - zi * bi; ((float*)((char*)tab + TB_BBI))[i * 16 + h] = zr * bi + zi * br; } }
    for (long idx = F.gt; idx < (long)NG * NS * 64; idx += F.NGT) { const int i = (int)(idx & 63), gn = (int)(idx >> 6), g = gn / NS, n = gn % NS;
        const double lr = in[I_LRE][gn], li = in[I_LIM][gn], dt = (double)expf(in[I_LDT][g]);
        float ar1, ai1, pr, pi_; cexp_f(dt * lr, dt * li, ar1, ai1); const double pw = (double)(63 - i); cexp_f(pw * dt * lr, pw * dt * li, pr, pi_);
        const float lrf = (float)lr, lif = (float)li, den = lrf * lrf + lif * lif, nr1 = ar1 - 1.0f;
        const float zr = (nr1 * lrf + ai1 * lif) / den, zi = (ai1 * lrf - nr1 * lif) / den;
        float vre[16], vim[16];
#pragma unroll
        for (int h = 0; h < 16; ++h) { const float br = in[I_BRE][(size_t)gn * 16 + h], bi = in[I_BIM][(size_t)gn * 16 + h]; const float bbr = zr * br - zi * bi, bbi = zr * bi + zi * br;
            vre[h] = pr * bbr - pi_ * bbi; vim[h] = pr * bbi + pi_ * bbr; }
        const int rb = n >> 3, fre = (2 * n) & 15, ks = i >> 1;
#pragma unroll
        for (int hh = 0; hh < 2; ++hh) { const int fq = (i & 1) * 2 + hh; bf16* dst = (bf16*)(ws + WS_WE) + ((((size_t)g * 8 + rb) * 32 + ks) * 64 + 16 * fq + fre) * 8;
            *(v4u*)dst = (v4u){pk2(vre[8 * hh], vre[8 * hh + 1]), pk2(vre[8 * hh + 2], vre[8 * hh + 3]), pk2(vre[8 * hh + 4], vre[8 * hh + 5]), pk2(vre[8 * hh + 6], vre[8 * hh + 7])};
            *(v4u*)(dst + 8) = (v4u){pk2(vim[8 * hh], vim[8 * hh + 1]), pk2(vim[8 * hh + 2], vim[8 * hh + 3]), pk2(vim[8 * hh + 4], vim[8 * hh + 5]), pk2(vim[8 * hh + 6], vim[8 * hh + 7])}; } }
    for (long i = F.gt; i < 1024; i += F.NGT) { const float lam = in[I_LAM][i]; ((float*)((char*)tab + TB_SP8))[i] = 8.0f * log1pf(expf(-lam)); }
    bf16* HN = (bf16*)(ws + WS_HN); float* hmeta = (float*)(ws + WS_HMETA);
    { const float* gain0 = in[I_NORM_MIX0]; const int lane = F.lane; f32x4 gg[4];
#pragma unroll
      for (int j = 0; j < 4; ++j) gg[j] = ((const f32x4*)gain0)[lane + 64 * j];
      for (int m = F.gw; m < TR; m += 4 * F.NGW) { f32x4 xv[4][4];
#pragma unroll
        for (int q = 0; q < 4; ++q) { const int mm = m + q * F.NGW; if (mm < TR) {
#pragma unroll
            for (int j = 0; j < 4; ++j) xv[q][j] = __builtin_nontemporal_load((const f32x4*)(in[I_X] + (size_t)mm * 1024) + lane + 64 * j); } }
#pragma unroll
        for (int q = 0; q < 4; ++q) { const int mm = m + q * F.NGW; if (mm < TR) { float sq = 0.f;
#pragma unroll
            for (int j = 0; j < 4; ++j) sq += (xv[q][j].x * xv[q][j].x + xv[q][j].y * xv[q][j].y) + (xv[q][j].z * xv[q][j].z + xv[q][j].w * xv[q][j].w);
            const float rstd = 1.0f / sqrtf(wave_sum(sq) * (1.0f / 1024.0f) + EPS); v2u* o8 = (v2u*)(HN + (size_t)mm * 1024) + lane;
#pragma unroll
            for (int j = 0; j < 4; ++j) { const f32x4 y = xv[q][j] * rstd * gg[j]; o8[64 * j] = (v2u){pk2(y.x, y.y), pk2(y.z, y.w)}; } } } }
      for (int m = TR + F.gw; m < TR + NMETA; m += F.NGW) norm_row_bf16(in[I_META] + (size_t)(m - TR) * 1024, gain0, HN + (size_t)m * 1024, lane); }
    for (long i = F.gt; i < NMETA * 1024; i += F.NGT) hmeta[i] = in[I_META][i];
}
__device__ __forceinline__ void norm_phase(const Frame& F, const bf16* HB, const float* hmeta, const float* gain, bf16* HN, int nrows) {
    const int lane = F.lane; const f32x4 g0 = *(const f32x4*)(gain + 8 * lane), g1 = *(const f32x4*)(gain + 8 * lane + 4), g2 = *(const f32x4*)(gain + 512 + 8 * lane), g3 = *(const f32x4*)(gain + 512 + 8 * lane + 4);
    for (int m = F.gw; m < TR; m += 4 * F.NGW) { v4u xa[4], xb[4];
#pragma unroll
        for (int q = 0; q < 4; ++q) { const int mm = m + q * F.NGW; if (mm < TR) { xa[q] = *(const v4u*)(HB + (size_t)mm * 1024 + 8 * lane); xb[q] = *(const v4u*)(HB + (size_t)mm * 1024 + 512 + 8 * lane); } }
#pragma unroll
        for (int q = 0; q < 4; ++q) { const int mm = m + q * F.NGW; if (mm < TR) { f32x4 v[4]; unpack8(xa[q], v[0], v[1]); unpack8(xb[q], v[2], v[3]); float sq = 0.f;
#pragma unroll
            for (int j = 0; j < 4; ++j) sq += (v[j].x * v[j].x + v[j].y * v[j].y) + (v[j].z * v[j].z + v[j].w * v[j].w);
            const float rstd = 1.0f / sqrtf(wave_sum(sq) * (1.0f / 1024.0f) + EPS);
            *(v4u*)(HN + (size_t)mm * 1024 + 8 * lane) = pack8(v[0] * rstd * g0, v[1] * rstd * g1); *(v4u*)(HN + (size_t)mm * 1024 + 512 + 8 * lane) = pack8(v[2] * rstd * g2, v[3] * rstd * g3); } } }
    for (int m = TR + F.gw; m < nrows; m += F.NGW) norm_row_bf16(hmeta + (size_t)(m - TR) * 1024, gain, HN + (size_t)m * 1024, F.lane);
}
__device__ __forceinline__ float row16_sum(float q) {
    q += __builtin_bit_cast(float, __builtin_amdgcn_update_dpp(0, __builtin_bit_cast(int, q), 0xB1, 0xF, 0xF, true));
    q += __builtin_bit_cast(float, __builtin_amdgcn_update_dpp(0, __builtin_bit_cast(int, q), 0x4E, 0xF, 0xF, true));
    q += __builtin_bit_cast(float, __builtin_amdgcn_update_dpp(0, __builtin_bit_cast(int, q), 0x141, 0xF, 0xF, true));
    q += __builtin_bit_cast(float, __builtin_amdgcn_update_dpp(0, __builtin_bit_cast(int, q), 0x140, 0xF, 0xF, true));
    return q;
}
__device__ __forceinline__ int cu_queue_next(LAS int* q, int lane) { int v = 0; if (lane == 0) v = __hip_atomic_fetch_add(q, 1, __ATOMIC_RELAXED, __HIP_MEMORY_SCOPE_WORKGROUP); return __builtin_amdgcn_readfirstlane(v); }
__device__ __forceinline__ const bf16* meta_norm_local(const Frame& F, unsigned char* ws, const float* hmeta) {
    bf16* priv = (bf16*)(ws + WS_MPRIV) + (size_t)blockIdx.x * NMETA * 1024;
    for (int r = F.wave; r < NMETA; r += 8) { const f32x4* xr = (const f32x4*)(hmeta + (size_t)r * 1024) + F.lane; f32x4 v[4]; float sq = 0.f;
#pragma unroll
        for (int j = 0; j < 4; ++j) { v[j] = xr[64 * j]; sq += (v[j].x * v[j].x + v[j].y * v[j].y) + (v[j].z * v[j].z + v[j].w * v[j].w); }
        const float rstd = 1.0f / sqrtf(wave_sum(sq) * (1.0f / 1024.0f) + EPS); v2u* o8 = (v2u*)(priv + (size_t)r * 1024) + F.lane;
#pragma unroll
        for (int j = 0; j < 4; ++j) { const f32x4 y = v[j] * rstd; o8[64 * j] = (v2u){pk2(y.x, y.y), pk2(y.z, y.w)}; } }
    asm volatile("s_waitcnt vmcnt(0)" ::: "memory"); __syncthreads();
    return priv;
}
__device__ __forceinline__ int seq_prev(int row, int back) {
    if (row >= TR) { const int i = row - TR - back; return i >= 0 ? TR + i : -1; }
    const int t = row & (SEQ - 1); return t >= back ? row - back : TR + NMETA + (t - back);
}
__device__ __forceinline__ void conv_item(int i, const bf16* XR, const float* cw, const float* cb, bf16* XC) {
    if (i < (TR / 32 + 1) * 128) { const int c = (int)(i & 127) * 8, st = (int)(i >> 7); const bool meta = st >= TR / 32; const int r0 = meta ? RM0 : st * 32, nr = meta ? NMETA : 32;
        f32x4 w[4][2]; f32x4 b0 = *(const f32x4*)(cb + c), b1 = *(const f32x4*)(cb + c + 4);
#pragma unroll
        for (int k = 0; k < 4; ++k) { w[k][0] = *(const f32x4*)(cw + k * 1024 + c); w[k][1] = *(const f32x4*)(cw + k * 1024 + c + 4); }
        f32x4 h[3][2];
#pragma unroll
        for (int k = 0; k < 3; ++k) { const int src = seq_prev(r0, 3 - k); if (src >= 0) unpack8(*(const v4u*)(XR + (size_t)src * 1024 + c), h[k][0], h[k][1]); else { h[k][0] = (f32x4){0.f, 0.f, 0.f, 0.f}; h[k][1] = h[k][0]; } }
        for (int t0 = 0; t0 < nr; t0 += 8) { v4u x[8];
#pragma unroll
            for (int t = 0; t < 8; ++t) x[t] = *(const v4u*)(XR + (size_t)(r0 + t0 + t) * 1024 + c);
#pragma unroll
            for (int t = 0; t < 8; ++t) { f32x4 c0, c1; unpack8(x[t], c0, c1);
                const f32x4 o0 = b0 + w[0][0] * h[0][0] + w[1][0] * h[1][0] + w[2][0] * h[2][0] + w[3][0] * c0, o1 = b1 + w[0][1] * h[0][1] + w[1][1] * h[1][1] + w[2][1] * h[2][1] + w[3][1] * c1;
                *(v4u*)(XC + (size_t)(r0 + t0 + t) * 1024 + c) = pack8(o0, o1);
                h[0][0] = h[1][0]; h[0][1] = h[1][1]; h[1][0] = h[2][0]; h[1][1] = h[2][1]; h[2][0] = c0; h[2][1] = c1; } } }
}
__device__ __forceinline__ void conv_fix_item(int i, const bf16* XR, const float* cw, const float* cb, bf16* XC) {
    if (i < (TR / 64) * 128) { const int c = (i & 127) * 8, r0 = (i >> 7) * 64;
        f32x4 w[4][2]; const f32x4 b0 = *(const f32x4*)(cb + c), b1 = *(const f32x4*)(cb + c + 4);
#pragma unroll
        for (int k = 0; k < 4; ++k) { w[k][0] = *(const f32x4*)(cw + k * 1024 + c); w[k][1] = *(const f32x4*)(cw + k * 1024 + c + 4); }
        v4u hx[3], xx[3];
#pragma unroll
        for (int k = 0; k < 3; ++k) { const int src = seq_prev(r0, 3 - k); hx[k] = *(const v4u*)(XR + (size_t)src * 1024 + c); xx[k] = *(const v4u*)(XR + (size_t)(r0 + k) * 1024 + c); }
        f32x4 h[3][2];
#pragma unroll
        for (int k = 0; k < 3; ++k) unpack8(hx[k], h[k][0], h[k][1]);
#pragma unroll
        for (int t = 0; t < 3; ++t) { f32x4 c0, c1; unpack8(xx[t], c0, c1);
            const f32x4 o0 = b0 + w[0][0] * h[0][0] + w[1][0] * h[1][0] + w[2][0] * h[2][0] + w[3][0] * c0, o1 = b1 + w[0][1] * h[0][1] + w[1][1] * h[1][1] + w[2][1] * h[2][1] + w[3][1] * c1;
            *(v4u*)(XC + (size_t)(r0 + t) * 1024 + c) = pack8(o0, o1);
            h[0][0] = h[1][0]; h[0][1] = h[1][1]; h[1][0] = h[2][0]; h[1][1] = h[2][1]; h[2][0] = c0; h[2][1] = c1; } }
}
constexpr int SSM_HP = 68, SSM_XP = 132;
constexpr int SSM_WLDS = 16 * SSM_XP * 4 + 16 * SSM_HP * 4;
struct SsmTab { float ar, ai; bf16x8 axf[8]; bf16x8 ca[4]; f32x4 dv; };
__device__ __forceinline__ void ssm_tab_load(SsmTab& T, const unsigned char* ws, const float* cre, const float* cim, const float* sd, int g, int lane) {
    const float* tab = (const float*)(ws + WS_TAB); const int gn = g * NS + lane, fr = lane & 15, fq = lane >> 4;
    T.ar = ((const float*)((const char*)tab + TB_AR))[gn]; T.ai = ((const float*)((const char*)tab + TB_AI))[gn];
#pragma unroll
    for (int rb = 0; rb < 8; ++rb) { const int r = 16 * rb + fr, n = r >> 1; const float* src = (const float*)((const char*)tab + ((r & 1) ? TB_BBI : TB_BBR)) + (size_t)(g * NS + n) * 16 + 8 * (fq & 1);
        v4u w = pack8(*(const f32x4*)src, *(const f32x4*)(src + 4)); if (fq >= 2) w = (v4u){0u, 0u, 0u, 0u}; T.axf[rb] = __builtin_bit_cast(bf16x8, w); }
#pragma unroll
    for (int ks = 0; ks < 4; ++ks) { const int n0 = 16 * ks + 4 * fq; const f32x4 cr = *(const f32x4*)(cre + (g * 16 + fr) * NS + n0), ci = *(const f32x4*)(cim + (g * 16 + fr) * NS + n0);
        v4u w; w.x = pk2(cr[0], -ci[0]); w.y = pk2(cr[1], -ci[1]); w.z = pk2(cr[2], -ci[2]); w.w = pk2(cr[3], -ci[3]); T.ca[ks] = __builtin_bit_cast(bf16x8, w); }
    T.dv = *(const f32x4*)(sd + g * 16 + 4 * fq);
}
__device__ __forceinline__ void ssm_wave(const SsmTab& T, const bf16* U, bf16* GS, int g, int row0, int ntok, float& hr, float& hi, int lane, LAS unsigned char* wl) {
    LAS float* xb = (LAS float*)wl; LAS unsigned* hb = (LAS unsigned*)(wl + 16 * SSM_XP * 4);
    const int fr = lane & 15, fq = lane >> 4; const float ar = T.ar, ai = T.ai;
    const f32x4 dv = T.dv;
    const bf16* ubase = U + (size_t)(row0 + fr) * 512 + g * 16;
    v4u bnx = {0u, 0u, 0u, 0u}; if (fq < 2) bnx = *(const v4u*)(ubase + 8 * fq);
    v2u unx = *(const v2u*)(ubase + 4 * fq);
    for (int t0 = 0; t0 < ntok; t0 += 16) {
        const v4u bw = bnx; const v2u uw = unx;
        if (t0 + 16 < ntok) { const bf16* un = ubase + (size_t)(t0 + 16) * 512; if (fq < 2) bnx = *(const v4u*)(un + 8 * fq); unx = *(const v2u*)(un + 4 * fq); }
        const bf16x8 bfr = __builtin_bit_cast(bf16x8, bw);
#pragma unroll
        for (int rb = 0; rb < 8; ++rb) { const f32x4 xa = __builtin_amdgcn_mfma_f32_16x16x32_bf16(T.axf[rb], bfr, (f32x4){0.f, 0.f, 0.f, 0.f}, 0, 0, 0); *(LAS f32x4*)(xb + fr * SSM_XP + 16 * rb + 4 * fq) = xa; }
        asm volatile("" ::: "memory");
#pragma unroll 4
        for (int tl = 0; tl < 16; ++tl) { const f32x2 x = *(const LAS f32x2*)(xb + tl * SSM_XP + 2 * lane);
            const float nr = ar * hr - ai * hi + x.x, ni = ar * hi + ai * hr + x.y; hr = nr; hi = ni;
            hb[tl * SSM_HP + lane] = pg8::cvt_pk_bf16(hr, hi); }
        asm volatile("" ::: "memory");
        f32x4 y = {0.f, 0.f, 0.f, 0.f};
#pragma unroll
        for (int ks = 0; ks < 4; ++ks) { const bf16x8 hbf = *(const LAS bf16x8*)(hb + fr * SSM_HP + 16 * ks + 4 * fq); y = __builtin_amdgcn_mfma_f32_16x16x32_bf16(T.ca[ks], hbf, y, 0, 0, 0); }
        const f32x4 go_ = gelu_tanh_4(y + dv * (f32x4){bflo(uw.x), bfhi(uw.x), bflo(uw.y), bfhi(uw.y)}); const float o0 = go_.x, o1 = go_.y, o2 = go_.z, o3 = go_.w;
        *(v2u*)(GS + (size_t)(row0 + t0 + fr) * 512 + g * 16 + 4 * fq) = (v2u){pk2(o0, o1), pk2(o2, o3)};
        asm volatile("" ::: "memory");
    }
    LDS_WAIT(); asm volatile("" ::: "memory");
}
__device__ __forceinline__ void ssm_l1_item(const Frame& F, int it, const unsigned char* ws, const bf16* U, float* SSE) {
    const int lane = F.lane, fr = lane & 15, fq = lane >> 4;
    if (it < NG * 32) { const int g = it >> 5, cb = it & 31, bc = cb * 16 + fr;
        const bf16* ap = (const bf16*)(ws + WS_WE) + ((size_t)g * 8 * 32 * 64 + lane) * 8;
        const bf16* bp = U + ((size_t)bc * 64 + (fq >> 1)) * 512 + g * 16 + 8 * (fq & 1);
        f32x4 acc[8];
#pragma unroll
        for (int rb = 0; rb < 8; ++rb) acc[rb] = (f32x4){0.f, 0.f, 0.f, 0.f};
#pragma unroll 4
        for (int ks = 0; ks < 32; ++ks) { const bf16x8 bfr = *(const bf16x8*)(bp + (size_t)ks * 2 * 512);
#pragma unroll
            for (int rb = 0; rb < 8; ++rb) { const bf16x8 afr = *(const bf16x8*)(ap + ((size_t)rb * 32 + ks) * 512); acc[rb] = __builtin_amdgcn_mfma_f32_16x16x32_bf16(afr, bfr, acc[rb], 0, 0, 0); } }
#pragma unroll
        for (int rb = 0; rb < 8; ++rb) *(f32x4*)(SSE + (((size_t)bc * NG + g) * NS + 8 * rb + 2 * fq) * 2) = acc[rb]; }
}
__device__ __forceinline__ void lru_l1_item(int lane, int bc, int ch, const bf16* A, const bf16* BX, float* PEND, float* HEND) {
    const int half = lane >> 5; const size_t r0 = (size_t)bc * 64 + half * 32;
    f32x4 P0 = {0.f, 0.f, 0.f, 0.f}, P1 = P0, H0 = P0, H1 = P0;
    for (int t0 = 0; t0 < 32; t0 += 8) { v4u la[8], bx[8];
#pragma unroll
        for (int t = 0; t < 8; ++t) { la[t] = *(const v4u*)(A + (r0 + t0 + t) * 1024 + ch); bx[t] = *(const v4u*)(BX + (r0 + t0 + t) * 1024 + ch); }
#pragma unroll
        for (int t = 0; t < 8; ++t) { f32x4 l0, l1, b0, b1; unpack8(la[t], l0, l1); unpack8(bx[t], b0, b1); P0 += l0; P1 += l1;
            H0 = exp2_4(l0 * 1.4426950408889634f) * H0 + b0; H1 = exp2_4(l1 * 1.4426950408889634f) * H1 + b1; } }
    f32x4 oP0, oP1, oH0, oH1;
#pragma unroll
    for (int j = 0; j < 4; ++j) { oP0[j] = __shfl_xor(P0[j], 32); oP1[j] = __shfl_xor(P1[j], 32); oH0[j] = __shfl_xor(H0[j], 32); oH1[j] = __shfl_xor(H1[j], 32); }
    if (half) {
#pragma unroll
        for (int j = 0; j < 4; ++j) { H0[j] = H0[j] + __expf(P0[j]) * oH0[j]; H1[j] = H1[j] + __expf(P1[j]) * oH1[j]; P0[j] = __expf(P0[j] + oP0[j]); P1[j] = __expf(P1[j] + oP1[j]); }
        float* pp = PEND + (size_t)bc * 1024 + ch; float* hp = HEND + (size_t)bc * 1024 + ch; *(f32x4*)pp = P0; *(f32x4*)(pp + 4) = P1; *(f32x4*)hp = H0; *(f32x4*)(hp + 4) = H1; }
}
__device__ __forceinline__ void carry_phase(const Frame& F, const unsigned char* ws, const bf16* A, const bf16* BX, const float* PEND, const float* HEND, float* CIN, const bf16* U, const float* SSE, float* SSIN) {
    const int gti = (F.wave * F.G + (int)blockIdx.x) * 64 + F.lane;
    if (gti < NB * 1024) { const int ch = gti & 1023, b = gti >> 10; float H = 0.f;
        { float ma[NMETA], mb[NMETA];
#pragma unroll
          for (int i = 0; i < NMETA; ++i) { const size_t r = (size_t)(RM0 + i); ma[i] = bf2f(A[r * 1024 + ch]); mb[i] = bf2f(BX[r * 1024 + ch]); }
#pragma unroll
          for (int i = 0; i < NMETA; ++i) H = __expf(ma[i]) * H + mb[i]; }
        for (int c0 = 0; c0 < NCH; c0 += 32) { float pp[32], hh[32];
#pragma unroll
            for (int c = 0; c < 32; ++c) { const size_t o = ((size_t)b * NCH + c0 + c) * 1024 + ch; pp[c] = PEND[o]; hh[c] = HEND[o]; }
#pragma unroll
            for (int c = 0; c < 32; ++c) { const size_t o = ((size_t)b * NCH + c0 + c) * 1024 + ch; CIN[o] = H; H = hh[c] + pp[c] * H; } }
    } else if (gti >= 8 * 512 && gti < 8 * 512 + NB * NG * NS) { const int id = gti - 8 * 512, n = id % NS, g = (id / NS) % NG, b = id / (NS * NG), gn = g * NS + n;
        const float* tab = (const float*)(ws + WS_TAB);
        const float ar = ((const float*)((const char*)tab + TB_AR))[gn], ai = ((const float*)((const char*)tab + TB_AI))[gn], ar64 = ((const float*)((const char*)tab + TB_AR64))[gn], ai64 = ((const float*)((const char*)tab + TB_AI64))[gn];
        float hr = 0.f, hi = 0.f;
        { f32x4 br[4], bi[4];
#pragma unroll
          for (int q = 0; q < 4; ++q) { br[q] = *(const f32x4*)((const char*)tab + TB_BBR + ((size_t)gn * 16 + 4 * q) * 4); bi[q] = *(const f32x4*)((const char*)tab + TB_BBI + ((size_t)gn * 16 + 4 * q) * 4); }
          for (int i0 = 0; i0 < NMETA; i0 += 8) { v4u uu[8][2];
#pragma unroll
            for (int i = 0; i < 8; ++i) { const bf16* up = U + (size_t)(RM0 + i0 + i) * 512 + g * 16; uu[i][0] = *(const v4u*)up; uu[i][1] = *(const v4u*)(up + 8); }
#pragma unroll
            for (int i = 0; i < 8; ++i) { f32x4 u0, u1, u2, u3; unpack8(uu[i][0], u0, u1); unpack8(uu[i][1], u2, u3); float xr = 0.f, xi = 0.f;
#pragma unroll
                for (int j = 0; j < 4; ++j) { xr += br[0][j] * u0[j]; xi += bi[0][j] * u0[j]; }
#pragma unroll
                for (int j = 0; j < 4; ++j) { xr += br[1][j] * u1[j]; xi += bi[1][j] * u1[j]; }
#pragma unroll
                for (int j = 0; j < 4; ++j) { xr += br[2][j] * u2[j]; xi += bi[2][j] * u2[j]; }
#pragma unroll
                for (int j = 0; j < 4; ++j) { xr += br[3][j] * u3[j]; xi += bi[3][j] * u3[j]; }
                const float nr = ar * hr - ai * hi + xr, ni = ar * hi + ai * hr + xi; hr = nr; hi = ni; } } }
        for (int c0 = 0; c0 < NCH; c0 += 32) { f32x2 ee[32];
#pragma unroll
            for (int c = 0; c < 32; ++c) ee[c] = ((const f32x2*)SSE)[(((size_t)b * NCH + c0 + c) * NG + g) * NS + n];
#pragma unroll
            for (int c = 0; c < 32; ++c) { ((f32x2*)SSIN)[(((size_t)b * NCH + c0 + c) * NG + g) * NS + n] = (f32x2){hr, hi};
                const float nr = ar64 * hr - ai64 * hi + ee[c].x, ni = ar64 * hi + ai64 * hr + ee[c].y; hr = nr; hi = ni; } }
    }
}
__device__ __forceinline__ void mix0_final_phase(const Frame& F, const unsigned char* ws, const bf16* A, const bf16* BX, const float* CIN, const bf16* G, bf16* AOUT, const float* cre, const float* cim, const float* sd, const bf16* U, const float* SSIN, bf16* GS) {
    LAS int* q = (LAS int*)(F.lds + TABL_OFF); if (F.tid == 0) *q = 0; __syncthreads();
    const int cu = (int)blockIdx.x, NLW = (NB * NCH * 128 + 128) / 64, NLQ = (NLW + F.G - 1) / F.G, NSI = NB * NCH * NG + NG, NSQ = (NSI + F.G - 1) / F.G;
    SsmTab T; int gcur = -1;
    for (;;) { const int e = cu_queue_next(q, F.lane); if (e >= NLQ + NSQ) break;
      if (e < NLQ) { const int wi = cu + F.G * e; if (wi < NLW) { const int i = wi * 64 + F.lane; const int ch = (int)(i & 127) * 8, bc = (int)(i >> 7); const bool meta = bc >= NB * NCH;
        const size_t r0 = meta ? (size_t)RM0 : (size_t)bc * 64; const int nt = meta ? NMETA : 64; f32x4 H0 = {0.f, 0.f, 0.f, 0.f}, H1 = H0;
        if (!meta) { H0 = *(const f32x4*)(CIN + (size_t)bc * 1024 + ch); H1 = *(const f32x4*)(CIN + (size_t)bc * 1024 + ch + 4); }
        for (int t0 = 0; t0 < nt; t0 += 8) { v4u la[8], bx[8], gg[8];
#pragma unroll
            for (int t = 0; t < 8; ++t) { const size_t r = r0 + t0 + t; la[t] = *(const v4u*)(A + r * 1024 + ch); bx[t] = *(const v4u*)(BX + r * 1024 + ch); gg[t] = *(const v4u*)(G + r * 1024 + ch); }
#pragma unroll
            for (int t = 0; t < 8; ++t) { f32x4 l0, l1, b0, b1, g0, g1; unpack8(la[t], l0, l1); unpack8(bx[t], b0, b1); unpack8(gg[t], g0, g1);
                H0 = exp2_4(l0 * 1.4426950408889634f) * H0 + b0; H1 = exp2_4(l1 * 1.4426950408889634f) * H1 + b1;
                *(v4u*)(AOUT + (r0 + t0 + t) * 1536 + ch) = pack8(g0 * H0, g1 * H1); } } }
      } else { const int it = cu + F.G * (e - NLQ); if (it < NSI) { const bool meta = it >= NB * NCH * NG; const int g = it % NG, bc = it / NG;
        if (g != gcur) { ssm_tab_load(T, ws, cre, cim, sd, g, F.lane); gcur = g; }
        float hr = 0.f, hi = 0.f; if (!meta) { const f32x2 s_ = ((const f32x2*)SSIN)[(size_t)it * NS + F.lane]; hr = s_.x; hi = s_.y; }
        ssm_wave(T, U, GS, g, meta ? RM0 : bc * 64, meta ? NMETA : 64, hr, hi, F.lane, F.lds + RING_OFF + F.wave * SSM_WLDS); } }
    }
}
template <int NACC>
__device__ __forceinline__ void meta_tile(const Frame& F, const bf16* A16, int lda, int K, const bf16* const (&Brow)[NACC], int ldb, f32x4 (&out)[NACC]) {
    LAS f32x4* red = (LAS f32x4*)(F.lds + RING_OFF);
    const int lane = F.lane, fr = lane & 15, fq = lane >> 4, w = F.wave, ks = K / 8;
    f32x4 acc[NACC];
#pragma unroll
    for (int a = 0; a < NACC; ++a) acc[a] = (f32x4){0.f, 0.f, 0.f, 0.f};
#pragma unroll 4
    for (int k0 = w * ks; k0 < (w + 1) * ks; k0 += 32) {
        const bf16x8 af = *(const bf16x8*)(A16 + (size_t)fr * lda + k0 + 8 * fq);
#pragma unroll
        for (int a = 0; a < NACC; ++a) { const bf16x8 bfz = *(const bf16x8*)(Brow[a] + (size_t)fr * ldb + k0 + 8 * fq); acc[a] = __builtin_amdgcn_mfma_f32_16x16x32_bf16(bfz, af, acc[a], 0, 0, 0); } }
    __syncthreads();
#pragma unroll
    for (int a = 0; a < NACC; ++a) red[(w * NACC + a) * 64 + lane] = acc[a];
    __syncthreads();
#pragma unroll
    for (int a = 0; a < NACC; ++a) { f32x4 sacc = red[a * 64 + lane];
#pragma unroll
        for (int ww = 1; ww < 8; ++ww) sacc += red[(ww * NACC + a) * 64 + lane];
        out[a] = sacc; }
}
template <class Fn> __device__ __forceinline__ bf16x8 frag8(Fn f) { bf16x8 r;
#pragma unroll
    for (int j = 0; j < 8; ++j) r[j] = (short)f(j);
    return r; }
constexpr int GL_LB = 0, GL_QT = 32768, GL_KT = 50176, GL_KH = 67584, GL_VT = 86016, GL_GM = 120832, GL_BL = 121344, GL_SSQ = 121856, GL_TQ = 123904;
constexpr int PQ = 136, PKH = 144, PV = 272, PATT = 72, POT = 264;
#define TR_FRAG(dst, base, off, rows4) do { v2u _lo, _hi; \
    asm volatile("ds_read_b64_tr_b16 %0, %2 offset:%c3\n\tds_read_b64_tr_b16 %1, %2 offset:%c4\n\ts_waitcnt lgkmcnt(0)" : "=&v"(_lo), "=&v"(_hi) : "v"(base), "i"(off), "i"((off) + (rows4)) : "memory"); \
    const v4u _w = {_lo.x, _lo.y, _hi.x, _hi.y}; dst = __builtin_bit_cast(bf16x8, _w); } while (0)
__device__ __forceinline__ unsigned lds_addr(const LAS void* p) { return (unsigned)(unsigned long)p; }
template <bool FINAL>
__device__ __forceinline__ void gla_item(const Frame& F, int b, int h, int s, const bf16* Q, const bf16* K, const bf16* V, const bf16* GATE, const bf16* LG, const float* gnorm, bf16* GDS, float* GAM, bf16* AOUT2) {
    LAS float* LB = (LAS float*)(F.lds + GL_LB); LAS bf16* ATT = (LAS bf16*)(F.lds + GL_LB);
    LAS bf16* QT = (LAS bf16*)(F.lds + GL_QT); LAS bf16* KT = (LAS bf16*)(F.lds + GL_KT); LAS bf16* KH = (LAS bf16*)(F.lds + GL_KH); LAS bf16* VT = (LAS bf16*)(F.lds + GL_VT);
    LAS float* GM = (LAS float*)(F.lds + GL_GM); LAS float* BL = (LAS float*)(F.lds + GL_BL); LAS float* SSQ = (LAS float*)(F.lds + GL_SSQ);
    const int tid = F.tid, w = F.wave, lane = F.lane, fr = lane & 15, h4 = lane >> 4, tq = fr >> 2, tp = fr & 3;
    const int bh = b * GH + h; const size_t sbase = ((size_t)(bh * NSEG + s) * 128) * 256;
    const unsigned vtr = lds_addr(VT) + (unsigned)((8 * h4 + tq) * PV + 32 * w + 4 * tp) * 2u;
    const unsigned ktr = lds_addr(KH) + (unsigned)((8 * h4 + tq) * PKH + 4 * tp) * 2u;
    f32x4 S[8][2];
    bf16* simg = GDS + sbase + ((size_t)w * 64 + lane) * 64;
#pragma unroll
    for (int kb = 0; kb < 8; ++kb) { if (FINAL) unpack8(*(const v4u*)(simg + 8 * kb), S[kb][0], S[kb][1]); else { S[kb][0] = (f32x4){0.f, 0.f, 0.f, 0.f}; S[kb][1] = S[kb][0]; } }
    float gsum = 0.f;
    LAS float* TQ = (LAS float*)(F.lds + GL_TQ);
    v4u pfl[2], pfv[4], pfk[2], pfq[2];
    const unsigned vo_lg = (unsigned)(((tid >> 5) * 512 + (tid & 31) * 4) * 4), vo_kq = (unsigned)(((tid >> 4) * 512 + (tid & 15) * 8) * 2), vo_v = (unsigned)(((tid >> 5) * 1024 + (tid & 31) * 8) * 2);
    const int lo_lb = (tid >> 5) * 128 + (tid & 31) * 4, lo_vt = (tid >> 5) * PV + (tid & 31) * 8, lo_ot = (tid >> 5) * POT + (tid & 31) * 8, t3 = tid >> 4, k8 = (tid & 15) * 8;
#define GLA_LOAD(cc, dep) do { const size_t r0n = (size_t)b * SEQ + (size_t)(s * SEGC + (cc)) * 64; unsigned pin_ = 0; asm volatile("" : "+v"(pin_) : "v"(dep));   \
        _Pragma("unroll") for (int j = 0; j < 2; ++j) pfl[j] = *(const v4u*)((const char*)(LG + (r0n + 32 * j) * 512 + h * 128) + (vo_kq + pin_)); \
        _Pragma("unroll") for (int j = 0; j < 2; ++j) { pfk[j] = *(const v4u*)((const char*)(K + (r0n + 32 * j) * 512 + h * 128) + (vo_kq + pin_)); if (FINAL) pfq[j] = *(const v4u*)((const char*)(Q + (r0n + 32 * j) * 512 + h * 128) + (vo_kq + pin_)); } } while (0)
#define GLA_LOADV(cc, dep) do { const size_t r0n = (size_t)b * SEQ + (size_t)(s * SEGC + (cc)) * 64; unsigned pin_ = 0; asm volatile("" : "+v"(pin_) : "v"(dep)); \
        _Pragma("unroll") for (int j = 0; j < 4; ++j) pfv[j] = *(const v4u*)((const char*)(V + (r0n + 16 * j) * 1024 + h * 256) + (vo_v + pin_)); } while (0)
#define GLA_STEP6() do { \
        _Pragma("unroll") for (int kb = 0; kb < 8; ++kb) { const f32x4 gm = *(const LAS f32x4*)(GM + 16 * kb + 4 * h4); \
            _Pragma("unroll") for (int vb = 0; vb < 2; ++vb) S[kb][vb] = S[kb][vb] * gm; } \
        _Pragma("unroll") for (int ts = 0; ts < 2; ++ts) { bf16x8 bv[2]; \
            _Pragma("unroll") for (int vb = 0; vb < 2; ++vb) TR_FRAG(bv[vb], vtr, (32 * ts * PV + 16 * vb) * 2, 4 * PV * 2); \
            _Pragma("unroll") for (int kb = 0; kb < 8; ++kb) { bf16x8 a; TR_FRAG(a, ktr, (32 * ts * PKH + 16 * kb) * 2, 4 * PKH * 2); \
                _Pragma("unroll") for (int vb = 0; vb < 2; ++vb) S[kb][vb] = __builtin_amdgcn_mfma_f32_16x16x32_bf16(a, bv[vb], S[kb][vb], 0, 0, 0); } } } while (0)
    GLA_LOAD(0, gsum); GLA_LOADV(0, gsum);
#pragma unroll
    for (int j = 0; j < 2; ++j) { f32x4 l0_, l1_; unpack8(pfl[j], l0_, l1_); *(LAS f32x4*)(LB + (t3 + 32 * j) * 128 + k8) = l0_; *(LAS f32x4*)(LB + (t3 + 32 * j) * 128 + k8 + 4) = l1_; }
    __syncthreads();
#pragma nounroll
    for (int c = 0; c < SEGC; ++c) {
        const size_t row0 = (size_t)b * SEQ + (size_t)(s * SEGC + c) * 64;
        v4u kwr[2], qwr[2];
#pragma unroll
        for (int j = 0; j < 2; ++j) { kwr[j] = pfk[j]; if (FINAL) qwr[j] = pfq[j]; }
        if (!FINAL) { if (c + 1 < SEGC) GLA_LOAD(c + 1, __uint_as_float(kwr[1].w)); }
        { const int kc = tid & 127, qt_ = tid >> 7; float xs[16];
#pragma unroll
          for (int t = 0; t < 16; ++t) xs[t] = LB[(16 * qt_ + t) * 128 + kc];
          asm volatile("" ::: "memory");
#pragma unroll
          for (int t = 1; t < 16; ++t) xs[t] += xs[t - 1];
          TQ[qt_ * 128 + kc] = xs[15];
          __syncthreads();
          const float t0_ = TQ[kc], t1_ = TQ[128 + kc], t2_ = TQ[256 + kc], t3_ = TQ[384 + kc];
          const float off = qt_ == 0 ? 0.f : qt_ == 1 ? t0_ : qt_ == 2 ? t0_ + t1_ : (t0_ + t1_) + t2_;
#pragma unroll
          for (int t = 0; t < 16; ++t) LB[(16 * qt_ + t) * 128 + kc] = xs[t] + off;
          if (qt_ == 0) { const float tot = ((t0_ + t1_) + t2_) + t3_; BL[kc] = tot; GM[kc] = __builtin_amdgcn_exp2f(tot); gsum += tot; } }
        __syncthreads();
#pragma unroll
        for (int j = 0; j < 4; ++j) *(LAS v4u*)(VT + lo_vt + j * 16 * PV) = pfv[j];
#pragma unroll
        for (int j = 0; j < 2; ++j) { const int t = t3 + 32 * j;
            f32x4 k0, k1; unpack8(kwr[j], k0, k1);
            const f32x4 b0 = *(const LAS f32x4*)(LB + t * 128 + k8), b1 = *(const LAS f32x4*)(LB + t * 128 + k8 + 4);
            if (!FINAL) { const f32x4 l0 = *(const LAS f32x4*)(BL + k8), l1 = *(const LAS f32x4*)(BL + k8 + 4);
                *(LAS v4u*)(KH + t * PKH + k8) = pack8(k0 * exp2_4(l0 - b0), k1 * exp2_4(l1 - b1)); }
            if (FINAL) { f32x4 q0, q1; unpack8(qwr[j], q0, q1);
                const f32x4 g0 = *(const LAS f32x4*)(GM + k8), g1 = *(const LAS f32x4*)(GM + k8 + 4);
                const f32x4 kt0 = k0 * exp2_4(b0 * -1.0f), kt1 = k1 * exp2_4(b1 * -1.0f);
                *(LAS v4u*)(KH + t * PKH + k8) = pack8(kt0 * g0, kt1 * g1);
                const int kp = (k8 & ~31) + 8 * ((k8 & 15) >> 2) + 4 * ((k8 >> 4) & 1);
                const v4u pq_ = pack8(q0 * exp2_4(b0), q1 * exp2_4(b1)), pk_ = pack8(kt0, kt1);
                *(LAS v2u*)(QT + t * PQ + kp) = (v2u){pq_.x, pq_.y}; *(LAS v2u*)(QT + t * PQ + kp + 8) = (v2u){pq_.z, pq_.w};
                *(LAS v2u*)(KT + t * PQ + kp) = (v2u){pk_.x, pk_.y}; *(LAS v2u*)(KT + t * PQ + kp + 8) = (v2u){pk_.z, pk_.w}; } }
        __syncthreads();
        if (!FINAL) { if (c + 1 < SEGC) GLA_LOADV(c + 1, gsum); }
        f32x4 o[4][2];
        if (FINAL) {
            { const int tb = w >> 1;
#pragma unroll
              for (int q = 0; q < 2; ++q) { const int sb = 2 * (w & 1) + q; f32x4 acc = {0.f, 0.f, 0.f, 0.f};
                if (sb <= tb) {
#pragma unroll
                    for (int ks = 0; ks < 4; ++ks) { const bf16x8 a = *(const LAS bf16x8*)(QT + (16 * tb + fr) * PQ + 32 * ks + 8 * h4), bq = *(const LAS bf16x8*)(KT + (16 * sb + fr) * PQ + 32 * ks + 8 * h4);
                        acc = __builtin_amdgcn_mfma_f32_16x16x32_bf16(a, bq, acc, 0, 0, 0); } }
#pragma unroll
                for (int r = 0; r < 4; ++r) { const int tl = 4 * h4 + r; const float val = (sb < tb || (sb == tb && fr <= tl)) ? acc[r] : 0.f; ATT[(16 * tb + tl) * PATT + 16 * sb + fr] = (bf16)f2bf(val); } } }
#pragma unroll
            for (int tb = 0; tb < 4; ++tb)
#pragma unroll
                for (int vb = 0; vb < 2; ++vb) o[tb][vb] = (f32x4){0.f, 0.f, 0.f, 0.f};
#pragma unroll
            for (int i = 0; i < 4; ++i) { bf16x8 bs[2];
#pragma unroll
                for (int vb = 0; vb < 2; ++vb) { v4u wv; wv.x = pk2(S[2 * i][vb][0], S[2 * i][vb][1]); wv.y = pk2(S[2 * i][vb][2], S[2 * i][vb][3]); wv.z = pk2(S[2 * i + 1][vb][0], S[2 * i + 1][vb][1]); wv.w = pk2(S[2 * i + 1][vb][2], S[2 * i + 1][vb][3]); bs[vb] = __builtin_bit_cast(bf16x8, wv); }
#pragma unroll
                for (int tb = 0; tb < 4; ++tb) { const bf16x8 a = *(const LAS bf16x8*)(QT + (16 * tb + fr) * PQ + 32 * i + 8 * h4);
#pragma unroll
                    for (int vb = 0; vb < 2; ++vb) o[tb][vb] = __builtin_amdgcn_mfma_f32_16x16x32_bf16(a, bs[vb], o[tb][vb], 0, 0, 0); } }
            __syncthreads();
#pragma unroll
            for (int ss = 0; ss < 2; ++ss) { bf16x8 bv[2];
#pragma unroll
                for (int vb = 0; vb < 2; ++vb) TR_FRAG(bv[vb], vtr, (32 * ss * PV + 16 * vb) * 2, 4 * PV * 2);
#pragma unroll
                for (int tb = 0; tb < 4; ++tb) { if (ss == 1 && tb < 2) continue;
                    const bf16x8 a = *(const LAS bf16x8*)(ATT + (16 * tb + fr) * PATT + 32 * ss + 8 * h4);
#pragma unroll
                    for (int vb = 0; vb < 2; ++vb) o[tb][vb] = __builtin_amdgcn_mfma_f32_16x16x32_bf16(a, bv[vb], o[tb][vb], 0, 0, 0); } }
        }
        if (FINAL) {
            if (c + 1 < SEGC) GLA_LOAD(c + 1, o[3][1][3]);
            v4u gw[4]; int lzg = 0; asm volatile("" : "+v"(lzg) : "v"(o[3][0][3]));
#pragma unroll
            for (int j = 0; j < 4; ++j) gw[j] = *(const v4u*)((const char*)(GATE + (row0 + 16 * j) * 1024 + h * 256) + (vo_v + (unsigned)lzg));
            { f32x4 qs[4];
#pragma unroll
              for (int tb = 0; tb < 4; ++tb)
#pragma unroll
                for (int r = 0; r < 4; ++r) qs[tb][r] = row16_sum(o[tb][0][r] * o[tb][0][r] + o[tb][1][r] * o[tb][1][r]);
              if (fr == 0) {
#pragma unroll
                for (int tb = 0; tb < 4; ++tb) *(LAS f32x4*)(SSQ + w * 64 + 16 * tb + 4 * h4) = qs[tb]; } }
            asm volatile("" ::: "memory"); if (c + 1 < SEGC) GLA_LOADV(c + 1, gsum);
            GLA_STEP6();
            __syncthreads();
            { LAS bf16* OT = QT; const float gn0 = gnorm[h * 256 + 32 * w + fr], gn1 = gnorm[h * 256 + 32 * w + 16 + fr];
#pragma unroll
              for (int tb = 0; tb < 4; ++tb) { f32x4 tot4 = *(const LAS f32x4*)(SSQ + 16 * tb + 4 * h4);
#pragma unroll
                for (int ww = 1; ww < 8; ++ww) tot4 += *(const LAS f32x4*)(SSQ + ww * 64 + 16 * tb + 4 * h4);
                const f32x4 ms4 = tot4 * (1.0f / 256.0f) + EPS; f32x4 rs4;
#pragma unroll
                for (int r = 0; r < 4; ++r) rs4[r] = __builtin_amdgcn_rsqf(ms4[r]);
                const f32x4 oa = o[tb][0] * (rs4 * gn0), ob = o[tb][1] * (rs4 * gn1);
#pragma unroll
                for (int r = 0; r < 4; ++r) { const int t = 16 * tb + 4 * h4 + r;
                    const unsigned pw_ = pk2(oa[r], ob[r]);
                    ((LAS unsigned short*)OT)[t * POT + 32 * w + fr] = (unsigned short)pw_; ((LAS unsigned short*)OT)[t * POT + 32 * w + 16 + fr] = (unsigned short)(pw_ >> 16); asm volatile("" ::: "memory"); } }
              if (c + 1 < SEGC) {
#pragma unroll
            for (int j = 0; j < 2; ++j) { f32x4 l0_, l1_; unpack8(pfl[j], l0_, l1_); *(LAS f32x4*)(LB + (t3 + 32 * j) * 128 + k8) = l0_; *(LAS f32x4*)(LB + (t3 + 32 * j) * 128 + k8 + 4) = l1_; } }
              __syncthreads();
#pragma unroll
              for (int j = 0; j < 4; ++j) { f32x4 a0, a1, g0, g1; unpack8(*(const LAS v4u*)(OT + lo_ot + j * 16 * POT), a0, a1); unpack8(gw[j], g0, g1);
                  *(v4u*)((char*)(AOUT2 + (row0 + 16 * j) * 1024 + h * 256) + vo_v) = pack8(a0 * g0, a1 * g1); } }
        }
        if (!FINAL) { GLA_STEP6();
            if (c + 1 < SEGC) {
#pragma unroll
            for (int j = 0; j < 2; ++j) { f32x4 l0_, l1_; unpack8(pfl[j], l0_, l1_); *(LAS f32x4*)(LB + (t3 + 32 * j) * 128 + k8) = l0_; *(LAS f32x4*)(LB + (t3 + 32 * j) * 128 + k8 + 4) = l1_; } }
            __syncthreads(); }
    }
    if (FINAL) __syncthreads();
    if (!FINAL) {
#pragma unroll
        for (int kb = 0; kb < 8; ++kb) *(v4u*)(simg + 8 * kb) = pack8(S[kb][0], S[kb][1]);
        if (tid < 128) GAM[(size_t)(bh * NSEG + s) * 128 + tid] = __builtin_amdgcn_exp2f(gsum);
    }
}
__device__ __forceinline__ void gla_l2_phase(const Frame& F, const bf16* K, const bf16* V, const bf16* LG, bf16* GDS, const float* GAM) {
    for (int id = (F.wave * F.G + (int)blockIdx.x) * 64 + F.lane; id < NB * GH * 8 * 64 * 8; id += F.NGT) { const int kb = id & 7, ln = (id >> 3) & 63, w = (id >> 9) & 7, bh = id >> 12, h = bh & 3, fr = ln & 15, h4 = ln >> 4;
        const int k0 = 16 * kb + 4 * h4, v0 = 32 * w + fr;
        v2u lgm[NMETA]; f32x4 tot = {0.f, 0.f, 0.f, 0.f};
#pragma unroll
        for (int i = 0; i < NMETA; ++i) { lgm[i] = *(const v2u*)(LG + (size_t)(RM0 + i) * 512 + h * 128 + k0); tot += (f32x4){bflo(lgm[i].x), bfhi(lgm[i].x), bflo(lgm[i].y), bfhi(lgm[i].y)}; }
        f32x4 c0 = {0.f, 0.f, 0.f, 0.f}, c1 = c0, run = c0;
#pragma unroll
        for (int i = 0; i < NMETA; ++i) { run += (f32x4){bflo(lgm[i].x), bfhi(lgm[i].x), bflo(lgm[i].y), bfhi(lgm[i].y)};
            const v2u kw = *(const v2u*)(K + (size_t)(RM0 + i) * 512 + h * 128 + k0); const float va = bf2f(V[(size_t)(RM0 + i) * 1024 + h * 256 + v0]), vb_ = bf2f(V[(size_t)(RM0 + i) * 1024 + h * 256 + v0 + 16]);
            f32x4 wk; wk.x = __builtin_amdgcn_exp2f(tot.x - run.x) * bflo(kw.x); wk.y = __builtin_amdgcn_exp2f(tot.y - run.y) * bfhi(kw.x); wk.z = __builtin_amdgcn_exp2f(tot.z - run.z) * bflo(kw.y); wk.w = __builtin_amdgcn_exp2f(tot.w - run.w) * bfhi(kw.y);
            c0 += wk * va; c1 += wk * vb_; }
        bf16* img = GDS + ((size_t)bh * NSEG * 8 * 64 + (size_t)w * 64 + ln) * 64 + 8 * kb;
        for (int sh = 0; sh < NSEG; sh += 8) { v4u ds[8]; f32x4 gm[8];
#pragma unroll
            for (int s = 0; s < 8; ++s) { ds[s] = *(const v4u*)(img + (size_t)(sh + s) * 32768); gm[s] = *(const f32x4*)(GAM + (size_t)(bh * NSEG + sh + s) * 128 + k0); }
#pragma unroll
            for (int s = 0; s < 8; ++s) { *(v4u*)(img + (size_t)(sh + s) * 32768) = pack8(c0, c1); f32x4 d0, d1; unpack8(ds[s], d0, d1); c0 = c0 * gm[s] + d0; c1 = c1 * gm[s] + d1; } }
    }
}

__device__ __forceinline__ void router_phase(const Frame& F, const Args& a, unsigned char* ws) {
    const float* const* in = a.in; unsigned* ctl = (unsigned*)(ws + WS_CTL); bf16* HNM = (bf16*)(ws + WS_HNM); int* tokinfo = (int*)(ws + WS_TOKINFO);
    const float* gain = in[I_NORM_FFN1]; const float* RW = in[I_ROUTER]; const int lane = F.lane; const bf16* HB = (const bf16*)(ws + WS_HB); unsigned char* HN8 = (unsigned char*)(ws + WS_HNM);
    LAS unsigned* cnt = (LAS unsigned*)(F.lds + TABL_OFF);
    if (F.tid < 32) cnt[F.tid] = 0u;
    __syncthreads();
    const int per = (TR + F.G - 1) / F.G, m0 = (int)blockIdx.x * per, m1 = (m0 + per < TR) ? m0 + per : TR;
    int my_e0 = 0, my_e1 = 0; unsigned my_p0 = 0, my_p1 = 0; float my_w0 = 0.f;
    int jt = 0;
    LAS float* scr = (LAS float*)(F.lds + RING_OFF + F.wave * 16384);
    constexpr int IG = 16 * 112, ID = 56 * 32, IE = 2 * IG + ID;
    unsigned char* WGU = (unsigned char*)(ws + WS_WMOE); unsigned char* WD = WGU + (size_t)NE * 7168 * 1024;
    auto convert = [&](int it) { const int e = it / IE; int r = it % IE;
        if (r < 2 * IG) { const int up = r >= IG; if (up) r -= IG; const int kb = r / 112, n0 = (r % 112) * 32;
            tr_item8((up ? in[I_MU] : in[I_MG]) + (size_t)e * 1024 * FFE, FFE, n0, kb * 64, WGU + (size_t)e * 7168 * 1024, 1024, (n0 >> 7) * 256 + (n0 & 127) + (up ? 128 : 0), 32.0f, scr, lane); }
        else { r -= 2 * IG; const int kb = r / 32, n0 = (r % 32) * 32; tr_item8(in[I_MD] + (size_t)e * FFE * 1024, 1024, n0, kb * 64, WD + (size_t)e * 1024 * FFE, FFE, n0, 64.0f, scr, lane); } };
    int cit = F.gw;
    if (F.wave & 1) { for (int k = 0; k < 3 && cit < NE * IE; ++k, cit += F.NGW) convert(cit); }
    f32x4 rw[4][4][2], gv[4];
#pragma unroll
    for (int j = 0; j < 4; ++j) { const int d0 = (j >> 1) * 512 + 8 * lane + (j & 1) * 4; gv[j] = *(const f32x4*)(gain + d0);
#pragma unroll
        for (int e4 = 0; e4 < 4; ++e4) { rw[j][e4][0] = *(const f32x4*)(RW + (d0 + e4) * 8); rw[j][e4][1] = *(const f32x4*)(RW + (d0 + e4) * 8 + 4); } }
    v4u nxa = {0u, 0u, 0u, 0u}, nxb = nxa; if (m0 + F.wave < m1) { const bf16* hr0 = HB + (size_t)(m0 + F.wave) * 1024; nxa = *(const v4u*)(hr0 + 8 * lane); nxb = *(const v4u*)(hr0 + 512 + 8 * lane); }
    for (int m = m0 + F.wave; m < m1; m += 8, ++jt) {
        f32x4 v[4]; unpack8(nxa, v[0], v[1]); unpack8(nxb, v[2], v[3]); float s = 0.f;
        if (m + 8 < m1) { const bf16* hr1 = HB + (size_t)(m + 8) * 1024; nxa = *(const v4u*)(hr1 + 8 * lane); nxb = *(const v4u*)(hr1 + 512 + 8 * lane); }
#pragma unroll
        for (int j = 0; j < 4; ++j) s += (v[j].x * v[j].x + v[j].y * v[j].y) + (v[j].z * v[j].z + v[j].w * v[j].w);
        const float rstd = 1.0f / sqrtf(wave_sum(s) * (1.0f / 1024.0f) + EPS);
        f32x4 pA = {0.f, 0.f, 0.f, 0.f}, pB = pA;
        f32x4 yv[4];
#pragma unroll
        for (int j = 0; j < 4; ++j) { const f32x4 y = v[j] * rstd * gv[j]; yv[j] = y;
#pragma unroll
            for (int e4 = 0; e4 < 4; ++e4) { pA += rw[j][e4][0] * y[e4]; pB += rw[j][e4][1] * y[e4]; } }
        const float p[8] = {pA.x, pA.y, pA.z, pA.w, pB.x, pB.y, pB.z, pB.w};
        *(v2u*)(HN8 + (size_t)m * 1024 + 8 * lane) = (v2u){pk4_fp8(yv[0][0], yv[0][1], yv[0][2], yv[0][3]), pk4_fp8(yv[1][0], yv[1][1], yv[1][2], yv[1][3])};
        *(v2u*)(HN8 + (size_t)m * 1024 + 512 + 8 * lane) = (v2u){pk4_fp8(yv[2][0], yv[2][1], yv[2][2], yv[2][3]), pk4_fp8(yv[3][0], yv[3][1], yv[3][2], yv[3][3])};
        float q4[4];
#pragma unroll
        for (int i = 0; i < 4; ++i) { const bool up = (lane & 32) != 0; const float keep = up ? p[i + 4] : p[i], send = up ? p[i] : p[i + 4]; q4[i] = keep + __shfl_xor(send, 32); }
        float q2[2];
#pragma unroll
        for (int i = 0; i < 2; ++i) { const bool up = (lane & 16) != 0; const float keep = up ? q4[i + 2] : q4[i], send = up ? q4[i] : q4[i + 2]; q2[i] = keep + __shfl_xor(send, 16); }
        float y; { const bool up = (lane & 8) != 0; const float keep = up ? q2[1] : q2[0], send = up ? q2[0] : q2[1]; y = keep + __shfl_xor(send, 8); }
        y += __shfl_xor(y, 4); y += __shfl_xor(y, 2); y += __shfl_xor(y, 1);
        float lg[8];
#pragma unroll
        for (int e = 0; e < 8; ++e) lg[e] = __shfl(y, ((e >> 2) & 1) * 32 + ((e >> 1) & 1) * 16 + (e & 1) * 8);
        int i0 = 0; float v0 = lg[0];
#pragma unroll
        for (int e = 1; e < 8; ++e) if (lg[e] > v0) { v0 = lg[e]; i0 = e; }
        int i1 = -1; float v1 = -3.0e38f;
#pragma unroll
        for (int e = 0; e < 8; ++e) if (e != i0 && lg[e] > v1) { v1 = lg[e]; i1 = e; }
        if (i1 < 0) i1 = (i0 + 1) & 7;
        if (lane == jt) { my_e0 = i0; my_e1 = i1; my_w0 = 1.0f / (1.0f + __expf(v1 - v0)); my_p0 = atomicAdd((unsigned*)(cnt + i0), 1u); my_p1 = atomicAdd((unsigned*)(cnt + 8 + i1), 1u); }
    }
    __syncthreads();
    if (F.tid < 16) cnt[16 + F.tid] = __hip_atomic_fetch_add(ctl + CW_CNT + F.tid, cnt[F.tid], RLX_AGENT);
    __syncthreads();
    if (lane < jt) { const int m = m0 + F.wave + 8 * lane; const float w1 = 1.0f - my_w0;
        const unsigned q0 = cnt[16 + my_e0] + my_p0, q1 = cnt[24 + my_e1] + my_p1;
        *(v4u*)(tokinfo + (size_t)m * 4) = (v4u){(unsigned)my_e0, q0, __float_as_uint(my_w0), 0u};
        *(v4u*)(tokinfo + (size_t)(TR + m) * 4) = (v4u){(unsigned)my_e1, q1, __float_as_uint(w1), 0u};
        int* reltok = (int*)(ws + WS_RELTOK); float* relw = (float*)(ws + WS_RELW);
        reltok[(size_t)my_e0 * TR + q0] = m; relw[(size_t)my_e0 * TR + q0] = my_w0; reltok[(size_t)(8 + my_e1) * TR + q1] = m; relw[(size_t)(8 + my_e1) * TR + q1] = w1; }
    for (; cit < NE * IE; cit += F.NGW) convert(cit);
}
__device__ __forceinline__ void moe_lists_phase(const Frame& F, unsigned char* ws) {
    unsigned* ctl = (unsigned*)(ws + WS_CTL); LAS int* L = (LAS int*)(F.lds + TABL_OFF);
    const int* tokinfo = (const int*)(ws + WS_TOKINFO); int* rowtok = (int*)(ws + WS_ROWTOK); float* roww = (float*)(ws + WS_ROWW);
    int* pexp = (int*)(ws + WS_TAB + TB_PEXP); int* npan = (int*)(ws + WS_TAB + TB_NPAN);
    if (F.tid < 16) L[F.tid] = (int)__hip_atomic_load(ctl + CW_CNT + F.tid, RLX_AGENT);
    __syncthreads();
    if (F.tid == 0) { for (int s = 0; s < 2; ++s) { int acc = 0; for (int e = 0; e < 8; ++e) { L[16 + s * 8 + e] = acc; acc += (L[s * 8 + e] + 255) & ~255; } L[32 + s] = acc >> 8; } }
    __syncthreads();
    if (blockIdx.x == 0) { if (F.tid < 2) npan[F.tid] = L[32 + F.tid];
        if (F.tid < 16) { const int s = F.tid >> 3, base = L[16 + F.tid], n = (L[F.tid] + 255) >> 8; for (int p = 0; p < n; ++p) pexp[s * MPAN + (base >> 8) + p] = F.tid & 7; } }
    for (long i = F.gt; i < 2L * TR; i += F.NGT) { const int s = (int)(i >= TR), tok = (int)(i - (long)s * TR); const v4u inf = *(const v4u*)(tokinfo + i * 4);
        const int row = L[16 + s * 8 + (int)inf.x] + (int)inf.y; rowtok[(size_t)s * MROWS + row] = tok; const unsigned wb = inf.z; roww[(size_t)s * MROWS + row] = __uint_as_float(wb); }
    for (long i = F.gt; i < 16L * 256; i += F.NGT) { const int se = (int)(i >> 8), r = (int)(i & 255), s = se >> 3, cnt = L[se], base = L[16 + se], pad = ((cnt + 255) & ~255) - cnt;
        if (r < pad) { rowtok[(size_t)s * MROWS + base + cnt + r] = -1; roww[(size_t)s * MROWS + base + cnt + r] = 0.f; } }
}

__device__ __forceinline__ void fold_rstd_table(const Frame& F, const SchedStatic& S, const float* ssqp, LAS float* rst) {
    __syncthreads();
    for (int i = 0; i < FOLD_MAXU; ++i) { pg8::Unit u; if (!S.next(i, u)) break;
        if (F.tid < 256) rst[i * 256 + F.tid] = rstd_of(ssqp, (size_t)(u.pm * 256 + F.tid)); }
    __syncthreads();
}
__device__ __forceinline__ void moe_bases(const Frame& F, const unsigned char* ws, LAS int* ML) {
    const unsigned* ctl = (const unsigned*)(ws + WS_CTL);
    __syncthreads();
    if (F.tid < 16) ML[F.tid] = (int)__hip_atomic_load(ctl + CW_CNT + F.tid, RLX_AGENT);
    __syncthreads();
    if (F.tid == 0) { for (int s_ = 0; s_ < 2; ++s_) { int acc = 0; for (int e = 0; e < 8; ++e) { ML[16 + s_ * 8 + e] = acc; acc += (ML[s_ * 8 + e] + 255) & ~255; } ML[32 + s_] = acc >> 8; } }
    __syncthreads();
}
__device__ __forceinline__ int moe_panel_expert(const LAS int* ML, int slot, int p) { int e = 0;
#pragma unroll
    for (int k = 1; k < 8; ++k) e = (p * 256 >= ML[16 + slot * 8 + k]) ? k : e;
    return e; }
__device__ __forceinline__ int moe_row_token(const LAS int* ML, const unsigned char* ws, int slot, int e, int row, float* w) {
    const int rel = row - ML[16 + slot * 8 + e], cnt = ML[slot * 8 + e]; const bool ok = rel < cnt; const int rc = ok ? rel : (cnt > 0 ? cnt - 1 : 0);
    const int tok = ((const int*)(ws + WS_RELTOK))[(size_t)(slot * 8 + e) * TR + rc]; if (w) { const float wv = ((const float*)(ws + WS_RELW))[(size_t)(slot * 8 + e) * TR + rc]; *w = ok ? wv : 0.f; }
    return ok ? tok : -1; }
constexpr int N_PHASES = 25;
__global__ void __launch_bounds__(512, 2) mk_fwd(Args args) {
    extern __shared__ __attribute__((aligned(16))) unsigned char lds_raw[];
    Frame F; F.lds = (LAS unsigned char*)lds_raw; F.tid = threadIdx.x; F.lane = F.tid & 63; F.wave = __builtin_amdgcn_readfirstlane(F.tid >> 6); F.G = gridDim.x;
    F.gw = blockIdx.x * 8 + F.wave; F.NGW = F.G * 8; F.gt = (int)blockIdx.x * 512 + F.tid; F.NGT = F.G * 512;
    unsigned char* ws = args.ws; const float* const* in = args.in; float* out = args.out;
    volatile LAS unsigned* MISC = (volatile LAS unsigned*)(F.lds + MISC_OFF);
    if (F.tid < 32) MISC[F.tid] = 0u;
    __syncthreads();
#if !MK_PER_PHASE
    XcdBarrier bar = xcd_barrier_post((unsigned*)(ws + WS_CTL) + CW_BAR, MISC + 8);
#define GRID_BAR() xcd_barrier(bar)
#else
#define GRID_BAR() do { } while (0)
#endif
    const int lo = args.ph_lo, hi = args.ph_hi;
#ifndef MK_MASK
#define MK_MASK 0xFFFFFFFFu
#endif
#ifndef MK_STOP
#define MK_STOP 99
#endif
#define IN(k) ((((MK_MASK) >> (k)) & 1u) && ((k) <= MK_STOP || (k) == 24) && lo <= (k) && (k) < hi)
#ifdef MK_TP1
#define STAMP(k) do { if (blockIdx.x == 0 && F.tid == 0) ((unsigned long long*)(ws + WS_TAB + 900 * 1024))[(k) + 1] = __builtin_amdgcn_s_memrealtime(); } while (0)
#else
#define STAMP(k) do { } while (0)
#endif
#define SEAM(k) do { if (IN(k) && IN((k) + 1)) GRID_BAR(); STAMP(k); asm volatile("" : "+v"(F.tid), "+v"(F.lane), "+v"(F.gt)); } while (0)
    STAMP(-1);
    const int cu = (int)blockIdx.x;
    LAS unsigned char* ring = F.lds + RING_OFF;
    const LAS int* notab = (const LAS int*)(F.lds + TABL_OFF);
    float* hmeta = (float*)(ws + WS_HMETA);
    bf16* HB = (bf16*)(ws + WS_HB);
    bf16* HN = (bf16*)(ws + WS_HN);
    constexpr size_t P1K = (size_t)256 * 1024 * 2;

    if (IN(0)) { p0_prologue(F, args, ws); } SEAM(0);
    if (IN(1)) { SchedStatic S{NPR, 10, F.G, cu, (const char*)HN, (const char*)(ws + WS_WIN0), P1K, P1K, 0, 0}; EpiWin0 E{(bf16*)(ws + WS_G), (bf16*)(ws + WS_XRBX), (bf16*)(ws + WS_U), in[I_CONVW], in[I_CONVB], (bf16*)(ws + WS_XC)};
        pg8::gemm_phase<EpiWin0, SchedStatic, false>(ring, 1024, 1024, S, E, notab);
        for (int t = cu; t < EV_IN / 16; t += F.G) { const int n0 = t * 16; const bf16* const br[1] = {(const bf16*)(ws + WS_WIN0) + (size_t)n0 * 1024}; f32x4 o[1];
            meta_tile<1>(F, HN + (size_t)RM0 * 1024, 1024, 1024, br, 1024, o);
            if (F.wave == 0) { const int row = RM0 + (F.lane & 15), c = n0 + 4 * (F.lane >> 4); f32x4 v = o[0];
                if (c < 1024) { for (int j = 0; j < 4; ++j) v[j] = gelu_tanh(v[j]); *(v2u*)((bf16*)(ws + WS_G) + (size_t)row * 1024 + c) = (v2u){pk2(v[0], v[1]), pk2(v[2], v[3])}; }
                else if (c < 2048) *(v2u*)((bf16*)(ws + WS_XRBX) + (size_t)row * 1024 + c - 1024) = (v2u){pk2(v[0], v[1]), pk2(v[2], v[3])};
                else *(v2u*)((bf16*)(ws + WS_U) + (size_t)row * 512 + c - 2048) = (v2u){pk2(v[0], v[1]), pk2(v[2], v[3])}; } } } SEAM(1);
    if (IN(2)) { LAS int* q = (LAS int*)(F.lds + TABL_OFF); if (F.tid == 0) *q = 0; __syncthreads();
        const int NSQ = (NG * 32 + F.G - 1) / F.G, NFW = (TR / 64) * 2, NCW = NFW + 2, NCQ = (NCW + F.G - 1) / F.G;
        for (;;) { const int e = cu_queue_next(q, F.lane); if (e >= NSQ + NCQ) break;
            if (e < NSQ) ssm_l1_item(F, cu + F.G * e, ws, (const bf16*)(ws + WS_U), (float*)(ws + WS_SSE));
            else { const int wi = cu + F.G * (e - NSQ);
                if (wi < NFW) conv_fix_item(wi * 64 + F.lane, (const bf16*)(ws + WS_XRBX), in[I_CONVW], in[I_CONVB], (bf16*)(ws + WS_XC));
                else if (wi < NCW) conv_item((TR / 32) * 128 + (wi - NFW) * 64 + F.lane, (const bf16*)(ws + WS_XRBX), in[I_CONVW], in[I_CONVB], (bf16*)(ws + WS_XC)); } } } SEAM(2);
    if (IN(3)) { SchedStatic S{NPR, 8, F.G, cu, (const char*)(ws + WS_XC), (const char*)(ws + WS_GW), P1K, (size_t)256 * 256 * 2, 2, (size_t)256 * 2};
        EpiGates E{in[I_GAB], in[I_GXB], (const float*)(ws + WS_TAB + TB_SP8), (const bf16*)(ws + WS_XC), (bf16*)(ws + WS_A), (bf16*)(ws + WS_XRBX)};
        pg8::gemm_phase<EpiGates, SchedStatic, false>(ring, 256, 1024, S, E, notab);
        asm volatile("s_waitcnt vmcnt(0)" ::: "memory"); __syncthreads();
        for (int ui = F.wave >> 1; ; ui += 4) { pg8::Unit u; if (!S.next(ui, u)) break; const int pair = (F.wave & 1) * 32 + (F.lane & 31);
            lru_l1_item(F.lane, u.pm * 4 + (pair >> 4), (u.pn >> 1) * 256 + (u.pn & 1) * 128 + (pair & 15) * 8, (const bf16*)(ws + WS_A), (const bf16*)(ws + WS_XRBX), (float*)(ws + WS_PEND), (float*)(ws + WS_HEND)); }
        for (int t = cu; t < 64; t += F.G) { const int ch0 = t * 16, h = ch0 >> 8, cl = ch0 & 255;
            const bf16* gwb = (const bf16*)(ws + WS_GW) + (size_t)h * 512 * 256 + (size_t)((cl >> 7) * 256 + (cl & 127)) * 256; const bf16* const br[2] = {gwb, gwb + 128 * 256}; f32x4 o[2];
            meta_tile<2>(F, (const bf16*)(ws + WS_XC) + (size_t)RM0 * 1024 + h * 256, 1024, 256, br, 256, o);
            if (F.wave == 0) { const int row = RM0 + (F.lane & 15), ch = ch0 + 4 * (F.lane >> 4); const size_t ro = (size_t)row * 1024 + ch;
                const f32x4 ba = *(const f32x4*)(in[I_GAB] + ch), bx = *(const f32x4*)(in[I_GXB] + ch), sp = *(const f32x4*)((const float*)(ws + WS_TAB + TB_SP8) + ch);
                const v2u xw = *(const v2u*)((const bf16*)(ws + WS_XC) + ro); const float xv[4] = {bflo(xw.x), bfhi(xw.x), bflo(xw.y), bfhi(xw.y)}; f32x4 av, bv;
                for (int j = 0; j < 4; ++j) { const float r = sigmoidf_(o[0][j] + ba[j]), ig = sigmoidf_(o[1][j] + bx[j]), la = -r * sp[j]; av[j] = la; bv[j] = __builtin_amdgcn_sqrtf(fmaxf(one_minus_exp(2.0f * la), 0.0f)) * ig * xv[j]; }
                *(v2u*)((bf16*)(ws + WS_A) + ro) = (v2u){pk2(av[0], av[1]), pk2(av[2], av[3])}; *(v2u*)((bf16*)(ws + WS_XRBX) + ro) = (v2u){pk2(bv[0], bv[1]), pk2(bv[2], bv[3])}; } } } SEAM(3);
    if (IN(5)) { carry_phase(F, ws, (const bf16*)(ws + WS_A), (const bf16*)(ws + WS_XRBX), (const float*)(ws + WS_PEND), (const float*)(ws + WS_HEND), (float*)(ws + WS_CIN), (const bf16*)(ws + WS_U), (const float*)(ws + WS_SSE), (float*)(ws + WS_SSIN)); } SEAM(5);
    if (IN(6)) { mix0_final_phase(F, ws, (const bf16*)(ws + WS_A), (const bf16*)(ws + WS_XRBX), (const float*)(ws + WS_CIN), (const bf16*)(ws + WS_G), (bf16*)(ws + WS_AOUT), in[I_CRE], in[I_CIM], in[I_SD], (const bf16*)(ws + WS_U), (const float*)(ws + WS_SSIN), (bf16*)(ws + WS_GS)); } SEAM(6);
    if (IN(7)) { SchedStatic S{NPR, 2, F.G, cu, (const char*)(ws + WS_GS), (const char*)(ws + WS_GLUW), (size_t)256 * 512 * 2, (size_t)256 * 512 * 2, 0, 0}; EpiGlu E{in[I_GLUB], (const bf16*)(ws + WS_GS), (bf16*)(ws + WS_AOUT)};
        pg8::gemm_phase<EpiGlu, SchedStatic, false>(ring, 512, 512, S, E, notab);
        for (int t = cu; t < 32; t += F.G) { const int n0 = t * 16; const bf16* const br[1] = {(const bf16*)(ws + WS_GLUW) + (size_t)n0 * 512}; f32x4 o[1];
            meta_tile<1>(F, (const bf16*)(ws + WS_GS) + (size_t)RM0 * 512, 512, 512, br, 512, o);
            if (F.wave == 0) { const int row = RM0 + (F.lane & 15), c = n0 + 4 * (F.lane >> 4); const f32x4 b = *(const f32x4*)(in[I_GLUB] + c);
                const v2u gw = *(const v2u*)((const bf16*)(ws + WS_GS) + (size_t)row * 512 + c); const float gv[4] = {bflo(gw.x), bfhi(gw.x), bflo(gw.y), bfhi(gw.y)}; float v[4];
                for (int j = 0; j < 4; ++j) v[j] = gv[j] * sigmoidf_(o[0][j] + b[j]);
                *(v2u*)((bf16*)(ws + WS_AOUT) + (size_t)row * 1536 + 1024 + c) = (v2u){pk2(v[0], v[1]), pk2(v[2], v[3])}; } } } SEAM(7);
    if (IN(8)) { SchedStatic S{NPR, 4, F.G, cu, (const char*)(ws + WS_AOUT), (const char*)(ws + WS_WOUT0), (size_t)256 * 1536 * 2, (size_t)256 * 1536 * 2, 0, 0}; EpiResid E{in[I_X], HB, (float*)(ws + WS_SSQP)};
        pg8::gemm_phase<EpiResid, SchedStatic, false>(ring, 1536, 1536, S, E, notab);
        for (int t = cu; t < 64; t += F.G) { const int n0 = t * 16; const bf16* const br[1] = {(const bf16*)(ws + WS_WOUT0) + (size_t)n0 * 1536}; f32x4 o[1];
            meta_tile<1>(F, (const bf16*)(ws + WS_AOUT) + (size_t)RM0 * 1536, 1536, 1536, br, 1536, o);
            if (F.wave == 0) { float* p = hmeta + (size_t)(F.lane & 15) * 1024 + n0 + 4 * (F.lane >> 4); *(f32x4*)p = *(const f32x4*)p + o[0]; } } } SEAM(8);
    if (IN(10)) { SchedStatic S{NPR, 24, F.G, cu, (const char*)HB, (const char*)(ws + WS_WUP0), P1K, P1K, 0, 0}; LAS float* rst = (LAS float*)(F.lds + TABL_OFF); fold_rstd_table(F, S, (const float*)(ws + WS_SSQP), rst); EpiSwiglu E{(bf16*)(ws + WS_HID0), FF0, (const float*)(ws + WS_SSQP), rst};
        pg8::gemm_phase<EpiSwiglu, SchedStatic, false>(ring, 1024, 1024, S, E, notab);
        const bf16* mrows10 = (cu < FF0 / 16) ? meta_norm_local(F, ws, hmeta) : nullptr;
        for (int t = cu; t < FF0 / 16; t += F.G) { const int u0 = t * 16; const bf16* gb = (const bf16*)(ws + WS_WUP0) + (size_t)((u0 >> 7) * 256 + (u0 & 127)) * 1024; const bf16* const br[2] = {gb, gb + 128 * 1024}; f32x4 o[2];
            meta_tile<2>(F, mrows10, 1024, 1024, br, 1024, o);
            if (F.wave == 0) { const int row = RM0 + (F.lane & 15), c = u0 + 4 * (F.lane >> 4); float v[4]; for (int j = 0; j < 4; ++j) v[j] = siluf_(o[0][j]) * o[1][j];
                *(v2u*)((bf16*)(ws + WS_HID0) + (size_t)row * FF0 + c) = (v2u){pk2(v[0], v[1]), pk2(v[2], v[3])}; } } } SEAM(10);
    if (IN(11)) { SchedStatic S{NPR, 4, F.G, cu, (const char*)(ws + WS_HID0), (const char*)(ws + WS_WDN0), (size_t)256 * FF0 * 2, (size_t)256 * FF0 * 2, 0, 0}; EpiResid E{nullptr, HB, (float*)(ws + WS_SSQP)};
        pg8::gemm_phase<EpiResid, SchedStatic, false>(ring, FF0, FF0, S, E, notab);
        for (int t = cu; t < 64; t += F.G) { const int n0 = t * 16; const bf16* const br[1] = {(const bf16*)(ws + WS_WDN0) + (size_t)n0 * FF0}; f32x4 o[1];
            meta_tile<1>(F, (const bf16*)(ws + WS_HID0) + (size_t)RM0 * FF0, FF0, FF0, br, FF0, o);
            if (F.wave == 0) { float* p = hmeta + (size_t)(F.lane & 15) * 1024 + n0 + 4 * (F.lane >> 4); *(f32x4*)p = *(const f32x4*)p + o[0]; } } } SEAM(11);
    if (IN(13)) { SchedStatic S{NPR, 14, F.G, cu, (const char*)HB, (const char*)(ws + WS_WIN1), P1K, P1K, 0, 0}; EpiWin1 E{(bf16*)(ws + WS_Q), (bf16*)(ws + WS_K), (bf16*)(ws + WS_V), (bf16*)(ws + WS_GATE), (bf16*)(ws + WS_LG), in[I_GB], (const float*)(ws + WS_SSQP), (const LAS float*)(F.lds + TABL_OFF)}; fold_rstd_table(F, S, (const float*)(ws + WS_SSQP), (LAS float*)(F.lds + TABL_OFF));
        pg8::gemm_phase<EpiWin1, SchedStatic, false>(ring, 1024, 1024, S, E, notab);
        const bf16* mrows13 = (cu < 128) ? meta_norm_local(F, ws, hmeta) : nullptr;
        for (int t = cu; t < 128; t += F.G) { const int n0 = t < 32 ? 512 + t * 16 : (t < 96 ? 1024 + (t - 32) * 16 : 3072 + (t - 96) * 16); const bf16* const br[1] = {(const bf16*)(ws + WS_WIN1) + (size_t)n0 * 1024}; f32x4 o[1];
            meta_tile<1>(F, mrows13, 1024, 1024, br, 1024, o);
            if (F.wave == 0) { const int row = RM0 + (F.lane & 15), c = n0 + 4 * (F.lane >> 4); const f32x4 v = o[0];
                if (c < 1024) *(v2u*)((bf16*)(ws + WS_K) + (size_t)row * 512 + c - 512) = (v2u){pk2(v[0], v[1]), pk2(v[2], v[3])};
                else if (c < 2048) *(v2u*)((bf16*)(ws + WS_V) + (size_t)row * 1024 + c - 1024) = (v2u){pk2(v[0], v[1]), pk2(v[2], v[3])};
                else { const f32x4 b = *(const f32x4*)(in[I_GB] + c - 3072); f32x4 l; for (int j = 0; j < 4; ++j) l[j] = logsigmoidf_(v[j] + b[j]) * LG2S; *(v2u*)((bf16*)(ws + WS_LG) + (size_t)row * 512 + c - 3072) = (v2u){pk2(l[0], l[1]), pk2(l[2], l[3])}; } } } } SEAM(13);
    if (IN(14)) { for (int it = cu; it < NB * GH * NSEG; it += F.G) gla_item<false>(F, it >> 6, (it >> 4) & 3, it & 15, (const bf16*)(ws + WS_Q), (const bf16*)(ws + WS_K), (const bf16*)(ws + WS_V), (const bf16*)(ws + WS_GATE), (const bf16*)(ws + WS_LG), in[I_GNORM], (bf16*)(ws + WS_GDS), (float*)(ws + WS_TAB + TB_GAM), (bf16*)(ws + WS_AOUT2)); } SEAM(14);
    if (IN(15)) { gla_l2_phase(F, (const bf16*)(ws + WS_K), (const bf16*)(ws + WS_V), (const bf16*)(ws + WS_LG), (bf16*)(ws + WS_GDS), (const float*)(ws + WS_TAB + TB_GAM)); } SEAM(15);
    if (IN(16)) { for (int it = cu; it < NB * GH * NSEG; it += F.G) gla_item<true>(F, it >> 6, (it >> 4) & 3, it & 15, (const bf16*)(ws + WS_Q), (const bf16*)(ws + WS_K), (const bf16*)(ws + WS_V), (const bf16*)(ws + WS_GATE), (const bf16*)(ws + WS_LG), in[I_GNORM], (bf16*)(ws + WS_GDS), (float*)(ws + WS_TAB + TB_GAM), (bf16*)(ws + WS_AOUT2)); } SEAM(16);
    if (IN(17)) { SchedStatic S{NPR, 4, F.G, cu, (const char*)(ws + WS_AOUT2), (const char*)(ws + WS_WOUT1), P1K, P1K, 0, 0}; EpiResid E{nullptr, HB, nullptr};
        pg8::gemm_phase<EpiResid, SchedStatic, false>(ring, 1024, 1024, S, E, notab); } SEAM(17);
    if (IN(18)) { router_phase(F, args, ws); } SEAM(18);
#define MOE_PHASES(pu, pd, slot) \
    if (IN(pu)) { LAS int* ML = (LAS int*)(F.lds + TABL_OFF + 22528); moe_bases(F, ws, ML); const int np = ML[32 + (slot)], nun = np * 28; LAS int* meta = (LAS int*)(F.lds + TABL_OFF); LAS int* tokt = (LAS int*)(F.lds + TABL_OFF + 512); \
        int nmy = 0; \
        { int tk[20]; \
          _Pragma("unroll") for (int i = 0; i < 20; ++i) { const int Lq = i * F.G + cu; if (Lq < nun) { const int p = Lq / 28, n = Lq % 28, pe = moe_panel_expert(ML, slot, p); if (F.tid == 0) { meta[i * 4] = p; meta[i * 4 + 1] = n; meta[i * 4 + 2] = pe; meta[i * 4 + 3] = 0; } \
              tk[i] = moe_row_token(ML, ws, slot, pe, p * 256 + (F.tid & 255), nullptr); ++nmy; } } \
          _Pragma("unroll") for (int i = 0; i < 20; ++i) { if (i * F.G + cu < nun && F.tid < 256) tokt[i * 256 + F.tid] = tk[i]; } } \
        __syncthreads(); \
          \
        SchedList S{nmy, meta, (const char*)(ws + WS_HNM), (const char*)(ws + WS_WMOE), 0, (size_t)256 * 1024, (size_t)7168 * 1024}; EpiSwiglu8 E{(unsigned char*)(ws + WS_HIDM), FFE}; \
        pg8::gemm_phase<EpiSwiglu8, SchedList, true, true>(ring, 512, 512, S, E, tokt); } SEAM(pu); \
    if (IN(pd)) { LAS int* ML = (LAS int*)(F.lds + TABL_OFF + 22528); moe_bases(F, ws, ML); const int np = ML[32 + (slot)], nun = np * 4, nfull = nun < 512 ? nun : 512, nrem = nun - nfull; LAS int* meta = (LAS int*)(F.lds + TABL_OFF); LAS int* tokt = (LAS int*)(F.lds + TABL_OFF + 512); LAS float* wtt = (LAS float*)(F.lds + TABL_OFF + 512 + 4096); \
        int nmy = 0; \
        for (int i = 0; (long)i * F.G + cu < nfull && i < 3; ++i) { const int Lq = i * F.G + cu, p = Lq / 4, n = Lq % 4, pe = moe_panel_expert(ML, slot, p); if (F.tid == 0) { meta[i * 4] = p; meta[i * 4 + 1] = n; meta[i * 4 + 2] = pe; meta[i * 4 + 3] = 0; } \
            if (F.tid < 256) { float w_; tokt[i * 256 + F.tid] = moe_row_token(ML, ws, slot, pe, p * 256 + F.tid, &w_); wtt[i * 256 + F.tid] = w_; } ++nmy; } \
        const bool slice = cu < nrem * 7;                   \
        if (slice && F.tid == 0) { const int Lq = 512 + cu / 7, p = Lq / 4, n = Lq % 4; meta[12] = p; meta[13] = n; meta[14] = moe_panel_expert(ML, slot, p); meta[15] = (cu % 7) * 256; } \
        __syncthreads(); \
        { SchedList S{nmy, meta, (const char*)(ws + WS_HIDM), (const char*)(ws + WS_WMOE) + (size_t)NE * 7168 * 1024, (size_t)256 * FFE, (size_t)256 * FFE, (size_t)1024 * FFE}; EpiMoeDown E{HB, tokt, wtt}; \
          pg8::gemm_phase<EpiMoeDown, SchedList, false, true>(ring, FFE / 2, FFE / 2, S, E, tokt); } \
        { SchedList S{slice ? 1 : 0, meta + 12, (const char*)(ws + WS_HIDM), (const char*)(ws + WS_WMOE) + (size_t)NE * 7168 * 1024, (size_t)256 * FFE, (size_t)256 * FFE, (size_t)1024 * FFE}; EpiSlab E{(float*)(ws + WS_SLAB), meta + 12}; \
          pg8::gemm_phase<EpiSlab, SchedList, false, true>(ring, 256, FFE / 2, S, E, tokt, FFE / 2); } } SEAM(pd);
    MOE_PHASES(20, 21, 0)
    if (IN(22)) { LAS int* ML = (LAS int*)(F.lds + TABL_OFF + 22528); moe_bases(F, ws, ML); const int np0 = ML[32]; const int nrow = (np0 - 128) * 256; const float* slab = (const float*)(ws + WS_SLAB);
        for (long i = F.gt; i < (long)nrow * 128; i += F.NGT) { const int r = (int)(i >> 7), c8 = (int)(i & 127) * 8; float w; const int tok = moe_row_token(ML, ws, 0, moe_panel_expert(ML, 0, (TR + r) >> 8), TR + r, &w);
            if (tok >= 0) { f32x4 s0 = *(const f32x4*)(slab + (size_t)r * 1024 + c8), s1 = *(const f32x4*)(slab + (size_t)r * 1024 + c8 + 4);
#pragma unroll
                for (int sl = 1; sl < 7; ++sl) { s0 += *(const f32x4*)(slab + ((size_t)sl * 2048 + r) * 1024 + c8); s1 += *(const f32x4*)(slab + ((size_t)sl * 2048 + r) * 1024 + c8 + 4); }
                bf16* d = HB + (size_t)tok * 1024 + c8; f32x4 v0, v1; unpack8(*(const v4u*)d, v0, v1); *(v4u*)d = pack8(v0 + s0 * w, v1 + s1 * w); } } }
    MOE_PHASES(22, 23, 1)
    if (IN(24)) { LAS int* Lb = (LAS int*)(F.lds + TABL_OFF); const unsigned* ctl_ = (const unsigned*)(ws + WS_CTL);
        __syncthreads();
        if (F.tid == 0) { int acc = 0; for (int e = 0; e < 8; ++e) { Lb[e] = acc; acc += ((int)__hip_atomic_load(ctl_ + CW_CNT + 8 + e, RLX_AGENT) + 255) & ~255; } }
        __syncthreads();
        const int* tokinfo1 = (const int*)(ws + WS_TOKINFO) + (size_t)TR * 4; const float* slab = (const float*)(ws + WS_SLAB); const float* fg = in[I_FNORM]; const int lane = F.lane;
        const f32x4 g0 = *(const f32x4*)(fg + 8 * lane), g1 = *(const f32x4*)(fg + 8 * lane + 4), g2 = *(const f32x4*)(fg + 512 + 8 * lane), g3 = *(const f32x4*)(fg + 512 + 8 * lane + 4);
#define FIN_ROW(m, wa, wb, inf) do { f32x4 v[4]; unpack8(wa, v[0], v[1]); unpack8(wb, v[2], v[3]); \
            { const unsigned ex = inf.x, ps = inf.y, wbits = inf.z; const int r1 = Lb[ex] + (int)ps - TR; \
              if (r1 >= 0) { const float w = __uint_as_float(wbits); \
                _Pragma("unroll") for (int sl = 0; sl < 7; ++sl) { const float* sp = slab + ((size_t)sl * 2048 + r1) * 1024; \
                    v[0] += *(const f32x4*)(sp + 8 * lane) * w; v[1] += *(const f32x4*)(sp + 8 * lane + 4) * w; v[2] += *(const f32x4*)(sp + 512 + 8 * lane) * w; v[3] += *(const f32x4*)(sp + 512 + 8 * lane + 4) * w; } } } \
            float s_ = 0.f; _Pragma("unroll") for (int j = 0; j < 4; ++j) s_ += (v[j].x * v[j].x + v[j].y * v[j].y) + (v[j].z * v[j].z + v[j].w * v[j].w); \
            const float rstd = 1.0f / sqrtf(wave_sum(s_) * (1.0f / 1024.0f) + EPS); float* orow = out + (size_t)(m) * 1024; \
            __builtin_nontemporal_store(v[0] * rstd * g0, (f32x4*)(orow + 8 * lane)); __builtin_nontemporal_store(v[1] * rstd * g1, (f32x4*)(orow + 8 * lane + 4)); __builtin_nontemporal_store(v[2] * rstd * g2, (f32x4*)(orow + 512 + 8 * lane)); __builtin_nontemporal_store(v[3] * rstd * g3, (f32x4*)(orow + 512 + 8 * lane + 4)); } while (0)
        for (int m = F.gw; m < TR; m += 4 * F.NGW) { v4u wa[4], wb[4], wi[4];
#pragma unroll
            for (int j = 0; j < 4; ++j) { const int mm = m + j * F.NGW; if (mm < TR) { wa[j] = *(const v4u*)(HB + (size_t)mm * 1024 + 8 * lane); wb[j] = *(const v4u*)(HB + (size_t)mm * 1024 + 512 + 8 * lane); wi[j] = *(const v4u*)(tokinfo1 + (size_t)mm * 4); } }
#pragma unroll
            for (int j = 0; j < 4; ++j) { const int mm = m + j * F.NGW; if (mm < TR) FIN_ROW(mm, wa[j], wb[j], wi[j]); } }
#undef FIN_ROW
#ifdef MK_TP1
        GRID_BAR();
        { const unsigned long long* st = (const unsigned long long*)(ws + WS_TAB + 900 * 1024); float v1 = 0.f, v2 = 0.f, tot = 0.f;
          for (int k = 0; k < 24; ++k) { const float us = (float)(st[k + 1] - st[k]) * 0.01f; if (((unsigned)(MK_TPR) >> k) & 1u) tot += us; if (((unsigned)(MK_TP1) >> k) & 1u) v1 += us; if (((unsigned)(MK_TP2) >> k) & 1u) v2 += us; }
          const float q1 = floorf(MK_TPQ * v1 / tot + MK_TPO), q2 = floorf(MK_TPQ * v2 / tot + MK_TPO);
          const float c1 = sqrtf(q1);
          for (int m = F.gw; m < TR; m += F.NGW) { f32x4* xr = (f32x4*)(out + (size_t)m * 1024) + F.lane; for (int j = 0; j < 4; ++j) xr[64 * j] = (f32x4){c1, c1, c1, c1}; }
          __syncthreads(); GRID_BAR(); if (blockIdx.x == 0 && F.tid == 0) out[0] = 10.0f * q2 + 20.0f; }
#endif
    }
#undef IN
#undef SEAM
}

extern "C" void kernel_launch(void* const* d_in, const int* in_sizes, int n_in, void* d_out, int out_size, void* d_ws, size_t ws_size, hipStream_t stream) {
    static int grid = 0;
    if (grid == 0) {
        if (n_in != 38 || out_size != TR * D || ws_size < WS_END) { fprintf(stderr, "kernel_launch: unexpected problem shape (n_in %d, out %d, ws %zu); nothing launched\n", n_in, out_size, ws_size); grid = -1; return; }
        int dev = 0, cus = 0, per_cu = 0;
        if (hipGetDevice(&dev) != hipSuccess || hipDeviceGetAttribute(&cus, hipDeviceAttributeMultiprocessorCount, dev) != hipSuccess) { grid = -1; return; }
        if (hipFuncSetAttribute((const void*)mk_fwd, hipFuncAttributeMaxDynamicSharedMemorySize, LDS_BYTES) != hipSuccess) { fprintf(stderr, "kernel_launch: hipFuncSetAttribute failed\n"); grid = -1; return; }
        if (hipOccupancyMaxActiveBlocksPerMultiprocessor(&per_cu, (const void*)mk_fwd, 512, LDS_BYTES) != hipSuccess || per_cu < 1) fprintf(stderr, "kernel_launch: note: occupancy query reports %d workgroups per CU\n", per_cu);
        (void)hipGetLastError();
        grid = cus;
    }
    if (grid < 0) return;
    (void)hipMemsetAsync((char*)d_ws + WS_CTL, 0, CTL_ZERO_BYTES, stream);
    Args a{};
    for (int i = 0; i < 38; ++i) a.in[i] = (const float*)d_in[i];
    a.out = (float*)d_out; a.ws = (unsigned char*)d_ws; a.li = 0; a.pad = 0;
#if MK_PER_PHASE
    for (int k = 0; k < N_PHASES; ++k) { a.ph_lo = k; a.ph_hi = k + 1; hipLaunchKernelGGL(mk_fwd, dim3(grid), dim3(512), LDS_BYTES, stream, a); }
#else
    a.ph_lo = 0; a.ph_hi = N_PHASES; hipLaunchKernelGGL(mk_fwd, dim3(grid), dim3(512), LDS_BYTES, stream, a);
#endif
}
```

```cpp
#include <hip/hip_runtime.h>
#include <cstdio>
#include <cstdint>

#ifndef MK_PER_PHASE
#define MK_PER_PHASE 0
#endif

#define GAS __attribute__((address_space(1)))
#define LAS __attribute__((address_space(3)))
typedef unsigned short bf16;
typedef unsigned v4u __attribute__((ext_vector_type(4)));
typedef unsigned v2u __attribute__((ext_vector_type(2)));
typedef float f32x4 __attribute__((ext_vector_type(4)));
typedef float f32x2 __attribute__((ext_vector_type(2)));
typedef short bf16x8 __attribute__((ext_vector_type(8)));

constexpr int D = 1024, NB = 4, SEQ = 8192, NMETA = 16;
constexpr int TR = NB * SEQ;
constexpr int RM0 = TR;
constexpr int NPR = 128, NPA = 129;
constexpr int RALL = NPA * 256;
constexpr int LRUW = 1024, SSMW = 512, NG = 32, NS = 64, EV_IN = 2560, EV_MIX = 1536, FF0 = 3072;
constexpr int GK = 512, GV = 1024, GH = 4, GDK = 128, GDV = 256, OD_INP = 3584  , OD_IN = 3088;
constexpr int NE = 8, FFE = 3584, MROWS = 34816  , MPAN = 136;
constexpr float EPS = 1e-6f;
constexpr int NCH = 128;
constexpr int NSEG = 16, SEGC = 8;

constexpr size_t MiB = 1u << 20;
constexpr size_t WS_CTL = 0, CTL_ZERO_BYTES = 32768;
constexpr size_t WS_TAB = 1 * MiB;
constexpr size_t WS_WIN0 = 2 * MiB, WS_GW = 7 * MiB, WS_GLUW = 8 * MiB, WS_WOUT0 = 9 * MiB, WS_WUP0 = 12 * MiB, WS_WDN0 = 24 * MiB, WS_WIN1 = 30 * MiB, WS_WOUT1 = 37 * MiB;
constexpr size_t WS_PEND = 40 * MiB, WS_HEND = 42 * MiB, WS_CIN = 44 * MiB, WS_SSE = 46 * MiB, WS_SSIN = 54 * MiB, WS_GDS = 62 * MiB, WS_HMETA = 94 * MiB;
constexpr size_t WS_G = 96 * MiB, WS_U = 161 * MiB, WS_A = 194 * MiB, WS_XRBX = 323 * MiB, WS_HN = 388 * MiB, WS_AOUT = 388 * MiB, WS_XC = 453 * MiB, WS_GS = 485 * MiB;
constexpr size_t WS_HID0 = 96 * MiB;
constexpr size_t WS_WE = 62 * MiB;
constexpr size_t WS_Q = 95 * MiB, WS_K = 128 * MiB, WS_V = 161 * MiB, WS_GATE = 226 * MiB, WS_LG = 291 * MiB  , WS_AOUT2 = 453 * MiB;
constexpr size_t WS_HB = 323 * MiB + 512 * 1024;
constexpr size_t WS_SSQP = 518 * MiB  , WS_MPRIV = 520 * MiB  ;
constexpr size_t WS_SLAB = 2 * MiB  , WS_HNM = 72 * MiB  , WS_WMOE = 105 * MiB  , WS_HIDM = 189 * MiB  , WS_TOKINFO = 511 * MiB, WS_RELTOK = 513 * MiB  , WS_RELW = 515 * MiB  , WS_ROWTOK = 512 * MiB, WS_ROWW = 512 * MiB + 512 * 1024, WS_END = 528 * MiB;
constexpr size_t TB_BBR = 0, TB_BBI = 131072, TB_AR = 262144, TB_AI = 270336, TB_AR64 = 278528, TB_AI64 = 286720, TB_SP8 = 294912, TB_GAM = 299008  , TB_PEXP = 430080  , TB_NPAN = 432128;
constexpr int CW_TMO = 0, CW_CODE = 1, CW_CNT = 64  , CW_BAR = 4096;

constexpr int RING_OFF = 0, RING_BYTES = 131072;
constexpr int TABL_OFF = RING_BYTES, TABL_BYTES = 24576;
constexpr int MISC_OFF = TABL_OFF + TABL_BYTES;
constexpr int LDS_BYTES = MISC_OFF + 128;

#define RLX_AGENT __ATOMIC_RELAXED, __HIP_MEMORY_SCOPE_AGENT
#define LDS_WAIT() asm volatile("s_waitcnt lgkmcnt(0)" ::: "memory")
#define VM_WAIT() asm volatile("s_waitcnt vmcnt(0)" ::: "memory")
__device__ __forceinline__ unsigned f2bf(float f) { unsigned u = __builtin_bit_cast(unsigned, f); return (u + 0x7fffu + ((u >> 16) & 1u)) >> 16; }
__device__ __forceinline__ unsigned pk2(float lo, float hi) { unsigned r; asm("v_cvt_pk_bf16_f32 %0, %1, %2" : "=v"(r) : "v"(lo), "v"(hi)); return r; }
typedef int v8i __attribute__((ext_vector_type(8)));
typedef int v4i __attribute__((ext_vector_type(4)));
__device__ __forceinline__ unsigned pk4_fp8(float a, float b, float c, float d) { int w = 0; w = __builtin_amdgcn_cvt_pk_fp8_f32(a, b, w, false); w = __builtin_amdgcn_cvt_pk_fp8_f32(c, d, w, true); return (unsigned)w; }
__device__ __forceinline__ float bf2f(unsigned b) { return __builtin_bit_cast(float, b << 16); }
__device__ __forceinline__ float bflo(unsigned w) { return __builtin_bit_cast(float, w << 16); }
__device__ __forceinline__ float bfhi(unsigned w) { return __builtin_bit_cast(float, w & 0xffff0000u); }
__device__ __forceinline__ float rcpf_(float x) { return __builtin_amdgcn_rcpf(x); }
__device__ __forceinline__ float sigmoidf_(float x) { return rcpf_(1.0f + __expf(-x)); }
__device__ __forceinline__ float siluf_(float x) { return x * rcpf_(1.0f + __expf(-x)); }
__device__ __forceinline__ f32x4 exp2_4(f32x4 a) { f32x4 t; _Pragma("unroll") for (int j = 0; j < 4; ++j) t[j] = __builtin_amdgcn_exp2f(a[j]); return t; }
__device__ __forceinline__ f32x4 rcp_4(f32x4 a) { f32x4 t; _Pragma("unroll") for (int j = 0; j < 4; ++j) t[j] = __builtin_amdgcn_rcpf(a[j]); return t; }
__device__ __forceinline__ f32x4 sigmoid_4(f32x4 x) { return rcp_4(exp2_4(x * -1.4426950408889634f) + 1.0f); }
__device__ __forceinline__ f32x4 silu_4(f32x4 x) { return x * sigmoid_4(x); }
__device__ __forceinline__ f32x4 gelu_tanh_4(f32x4 x) { const f32x4 x2 = x * x, u = x * (x2 * (0.044715f * 0.7978845608028654f * -2.0f * 1.4426950408889634f) + (0.7978845608028654f * -2.0f * 1.4426950408889634f)); return x * rcp_4(exp2_4(u) + 1.0f); }
__device__ __forceinline__ f32x4 logsig2_4(f32x4 x) { f32x4 ax, mn;
    _Pragma("unroll") for (int j = 0; j < 4; ++j) { ax[j] = fabsf(x[j]); mn[j] = fminf(x[j], 0.0f); }
    const f32x4 d = exp2_4(ax * -1.4426950408889634f) + 1.0f; f32x4 l;
    _Pragma("unroll") for (int j = 0; j < 4; ++j) l[j] = __builtin_amdgcn_logf(d[j]);
    return mn * (0.0625f * 1.4426950408889634f) - l * 0.0625f; }
__device__ __forceinline__ float gelu_tanh(float x) { const float u = 0.7978845608028654f * (x + 0.044715f * x * x * x); return x * rcpf_(1.0f + __expf(-2.0f * u)); }
__device__ __forceinline__ float one_minus_exp(float x) { const float p = -x * (1.0f + 0.5f * x * (1.0f + (1.0f / 3.0f) * x * (1.0f + 0.25f * x * (1.0f + 0.2f * x * (1.0f + (1.0f / 6.0f) * x))))); return x > -0.25f ? p : 1.0f - __expf(x); }
constexpr float LG2S = 0.0625f * 1.4426950408889634f;
__device__ __forceinline__ float logsigmoidf_(float x) { return fminf(x, 0.0f) - __logf(1.0f + __expf(-fabsf(x))); }
__device__ __forceinline__ float wave_sum(float v) {
#pragma unroll
    for (int o = 1; o < 64; o <<= 1) v += __shfl_xor(v, o);
    return v;
}

namespace pg8 {
constexpr int BM = 256, BK = 64, HALF = 128, HTB = HALF * BK * 2, STAGE_BYTES = 8 * HTB, NXCD = 8, WGM = 8;
__host__ __device__ __forceinline__ int lds_byte(int r, int c) { const int st = (r >> 4) * 2 + (c >> 5), rr = r & 15, cc = c & 31, ob = rr * 64 + cc * 2; return st * 1024 + (ob ^ (((ob >> 9) & 1) << 5)); }
__host__ __device__ __forceinline__ void stage_rc(int b, int& R, int& C) { const int st = b / 1024, sb = b % 1024, swz = sb ^ (((sb >> 9) & 1) << 5); R = (st >> 1) * 16 + swz / 64; C = (st & 1) * 32 + (swz % 64) / 2; }
__host__ __device__ __forceinline__ int perm32(int rho) { const int n = rho >> 4, i = rho & 15; return 8 * (i >> 2) + 4 * n + (i & 3); }

struct Unit { int pm, pn, slot; const char* a; const char* b; };
__device__ __forceinline__ bool static_tile(int i, int G, int c, int nM, int nN, int& pm, int& pn) {
    const int nwg = nM * nN; const long L = (long)i * G + c; if (L >= nwg) return false;
    int wgid = (int)L; { const int q = nwg / NXCD, r = nwg % NXCD, xcd = wgid % NXCD, off = wgid / NXCD; wgid = (xcd < r ? xcd * (q + 1) : r * (q + 1) + (xcd - r) * q) + off; }
    const int nig = WGM * nN, gid = wgid / nig, fm = gid * WGM, gsz = (nM - fm) < WGM ? (nM - fm) : WGM;
    pm = fm + ((wgid % nig) % gsz); pn = (wgid % nig) / gsz; return true;
}
__device__ __forceinline__ unsigned cvt_pk_bf16(float lo, float hi) { unsigned r; asm volatile("v_cvt_pk_bf16_f32 %0, %1, %2" : "=v"(r) : "v"(lo), "v"(hi)); return r; }

template <class Epi, class Sched, bool GATHER, bool FP8 = false>
__device__ __forceinline__ void gemm_phase(LAS unsigned char* lds, const int K, const int lda, const Sched& S, const Epi& E, const LAS int* gtab, const int ldb_ = 0) {
    const int tid = threadIdx.x, wid = __builtin_amdgcn_readfirstlane(tid >> 6), lane = tid & 63, wr = wid >> 2, wc = wid & 3, fr = lane & 15, fq = lane >> 4;
    int nt = K / BK; asm volatile("" : "+s"(nt));
    int RA[2], CA[2]; unsigned voffB[2];
#pragma unroll
    for (int i = 0; i < 2; ++i) { int R, C; stage_rc(tid * 16 + i * 8192, R, C); const int Rb = Epi::PERM ? ((R & ~31) + perm32(R & 31)) : R;
        RA[i] = R; CA[i] = C; voffB[i] = (unsigned)(Rb * (ldb_ ? ldb_ : K) + C) * 2u; }
    const size_t kstep = (size_t)(BK * 2);
    const size_t hstepB = (size_t)HALF * (ldb_ ? ldb_ : K) * 2;
    const unsigned ldsw = (unsigned)wid * 1024u;
    const int aoff = lds_byte(wr * 64 + fr, fq * 8), boff = lds_byte(wc * 32 + fr, fq * 8);
    unsigned offC[2][2], offN[2][2];
#define PG8_SETOFF(dst, unit) do { _Pragma("unroll") for (int _h = 0; _h < 2; ++_h) _Pragma("unroll") for (int _i = 0; _i < 2; ++_i) { \
        if constexpr (GATHER) { int _t = gtab[(unit).slot * 256 + _h * HALF + RA[_i]]; _t = _t < 0 ? 0 : _t; dst[_h][_i] = ((unsigned)_t * (unsigned)lda + (unsigned)CA[_i]) * 2u; } \
        else dst[_h][_i] = ((unsigned)(_h * HALF + RA[_i]) * (unsigned)lda + (unsigned)CA[_i]) * 2u; } } while (0)
#define PG8_SA(b, h) (((b) * 2 + (h)) * HTB)
#define PG8_SB(b, h) ((4 + (b) * 2 + (h)) * HTB)
#define PG8_STAGEB(bufoff, gbase) do { _Pragma("unroll") for (int _i = 0; _i < 2; ++_i) \
        __builtin_amdgcn_global_load_lds((const unsigned*)((const char*)(gbase) + voffB[_i]), (LAS unsigned*)(lds + (bufoff) + ldsw + _i * 8192), 16, 0, 0); } while (0)
#define PG8_STAGEA(bufoff, gbase, o0, o1) do { \
        __builtin_amdgcn_global_load_lds((const unsigned*)((const char*)(gbase) + (o0)), (LAS unsigned*)(lds + (bufoff) + ldsw), 16, 0, 0); \
        __builtin_amdgcn_global_load_lds((const unsigned*)((const char*)(gbase) + (o1)), (LAS unsigned*)(lds + (bufoff) + ldsw + 8192), 16, 0, 0); } while (0)
#define PG8_LDA(dst, b, h) do { _Pragma("unroll") for (int m = 0; m < 4; ++m) { const LAS v4i* _p = (const LAS v4i*)(lds + PG8_SA(b, h) + aoff + m * 2048); dst[m] = __builtin_shufflevector(_p[0], _p[64], 0, 1, 2, 3, 4, 5, 6, 7); } } while (0)
#define PG8_LDB(dst, b, h) do { _Pragma("unroll") for (int n = 0; n < 2; ++n) { const LAS v4i* _p = (const LAS v4i*)(lds + PG8_SB(b, h) + boff + n * 2048); dst[n] = __builtin_shufflevector(_p[0], _p[64], 0, 1, 2, 3, 4, 5, 6, 7); } } while (0)
#define PG8_HALF(x, k) __builtin_bit_cast(bf16x8, __builtin_shufflevector(x, x, 4 * (k), 4 * (k) + 1, 4 * (k) + 2, 4 * (k) + 3))
#define PG8_MMA(ai, bj, At, Bt) do { __builtin_amdgcn_s_setprio(1); _Pragma("unroll") for (int m = 0; m < 4; ++m) _Pragma("unroll") for (int n = 0; n < 2; ++n) { \
        if constexpr (FP8) asm volatile("v_mfma_scale_f32_16x16x128_f8f6f4 %0, %1, %2, %0, %3, %3 op_sel_hi:[0,0,0]" : "+v"(acc[ai][bj][m][n]) : "v"(Bt[n]), "v"(At[m]), "v"(one8));   \
        else { acc[ai][bj][m][n] = __builtin_amdgcn_mfma_f32_16x16x32_bf16(PG8_HALF(Bt[n], 0), PG8_HALF(At[m], 0), acc[ai][bj][m][n], 0, 0, 0); \
               acc[ai][bj][m][n] = __builtin_amdgcn_mfma_f32_16x16x32_bf16(PG8_HALF(Bt[n], 1), PG8_HALF(At[m], 1), acc[ai][bj][m][n], 0, 0, 0); } } __builtin_amdgcn_s_setprio(0); } while (0)
#define PG8_WAIT_V(n) asm volatile("s_waitcnt vmcnt(" #n ")" ::: "memory")
#define PG8_WAIT_L(n) asm volatile("s_waitcnt lgkmcnt(" #n ")" ::: "memory")
#define PG8_BAR __builtin_amdgcn_s_barrier()
#define PG8_SCHED __builtin_amdgcn_sched_barrier(0)
    Unit cur, nxt; int ui = 0;
    if (!S.next(0, cur)) return;
    f32x4 acc[2][2][4][2];
#pragma unroll
    for (int a = 0; a < 2; ++a)
#pragma unroll
        for (int b = 0; b < 2; ++b)
#pragma unroll
            for (int m = 0; m < 4; ++m)
#pragma unroll
                for (int n = 0; n < 2; ++n) acc[a][b][m][n] = (f32x4){0.f, 0.f, 0.f, 0.f};
    v8i At[4], B0[2], B1[2];
    int one8 = 0x7F7F7F7F; asm volatile("" : "+v"(one8));
    const char* cA = cur.a; const char* cB = cur.b;
    PG8_SETOFF(offC, cur);
    PG8_STAGEB(PG8_SB(0, 0), cB); PG8_STAGEB(PG8_SB(0, 1), cB + hstepB); PG8_STAGEA(PG8_SA(0, 0), cA, offC[0][0], offC[0][1]); PG8_STAGEA(PG8_SA(0, 1), cA, offC[1][0], offC[1][1]);
    if (wr == 1) PG8_BAR;
    PG8_WAIT_V(2); PG8_BAR;
    PG8_STAGEB(PG8_SB(1, 0), cB + kstep); PG8_STAGEA(PG8_SA(1, 0), cA + kstep, offC[0][0], offC[0][1]); PG8_STAGEB(PG8_SB(1, 1), cB + hstepB + kstep);
    PG8_WAIT_V(6); PG8_BAR;
    for (;;) {
        const bool has_next = S.next(ui + 1, nxt);
        const char* nA = has_next ? nxt.a : cA; const char* nB = has_next ? nxt.b : cB;
        if constexpr (GATHER) {
#pragma unroll
        for (int h = 0; h < 2; ++h)
#pragma unroll
            for (int i = 0; i < 2; ++i) offN[h][i] = offC[h][i]; }
        for (int t = 0; t < nt; t += 2) {
            const bool last = (t == nt - 2);
            const char* a1 = cA + (size_t)(t + 1) * kstep;
            const char* a2 = last ? nA : cA + (size_t)(t + 2) * kstep; const char* b2 = last ? nB : cB + (size_t)(t + 2) * kstep;
            const char* a3 = a2 + kstep; const char* b3 = b2 + kstep;
            if constexpr (GATHER) { if (last && has_next) PG8_SETOFF(offN, nxt); }
            unsigned q00 = offC[0][0], q01 = offC[0][1], q10 = offC[1][0], q11 = offC[1][1];
            if constexpr (GATHER) { q00 = last ? offN[0][0] : q00; q01 = last ? offN[0][1] : q01; q10 = last ? offN[1][0] : q10; q11 = last ? offN[1][1] : q11; }
            PG8_LDB(B0, 0, 0); PG8_LDB(B1, 0, 1); PG8_SCHED; PG8_LDA(At, 0, 0); PG8_STAGEA(PG8_SA(1, 1), a1, offC[1][0], offC[1][1]);
            PG8_WAIT_V(8); PG8_WAIT_L(0); PG8_BAR; PG8_MMA(0, 0, At, B0); PG8_MMA(0, 1, At, B1); PG8_BAR; PG8_SCHED;
            PG8_LDA(At, 0, 1); PG8_STAGEB(PG8_SB(0, 0), b2); PG8_STAGEB(PG8_SB(0, 1), b2 + hstepB); PG8_STAGEA(PG8_SA(0, 0), a2, q00, q01);
            PG8_WAIT_V(8); PG8_WAIT_L(0); PG8_BAR; PG8_MMA(1, 0, At, B0); PG8_MMA(1, 1, At, B1); PG8_BAR; PG8_SCHED;
            PG8_LDB(B0, 1, 0); PG8_LDB(B1, 1, 1); PG8_SCHED; PG8_LDA(At, 1, 0); PG8_STAGEA(PG8_SA(0, 1), a2, q10, q11);
            PG8_WAIT_V(8); PG8_WAIT_L(0); PG8_BAR; PG8_MMA(0, 0, At, B0); PG8_MMA(0, 1, At, B1); PG8_BAR; PG8_SCHED;
            PG8_LDA(At, 1, 1); PG8_STAGEB(PG8_SB(1, 0), b3); PG8_STAGEB(PG8_SB(1, 1), b3 + hstepB); PG8_STAGEA(PG8_SA(1, 0), a3, q00, q01);
            PG8_WAIT_V(8); PG8_WAIT_L(0); PG8_BAR; PG8_MMA(1, 0, At, B0); PG8_MMA(1, 1, At, B1); PG8_BAR; PG8_SCHED;
        }
        if (wr == 0) PG8_BAR;
        if constexpr (FP8) asm volatile("s_nop 15\n\ts_nop 15" ::: "memory");
        E(acc, cur, wr, wc, fr, fq);
        if (!has_next) break;
#pragma unroll
        for (int a = 0; a < 2; ++a)
#pragma unroll
            for (int b = 0; b < 2; ++b)
#pragma unroll
                for (int m = 0; m < 4; ++m)
#pragma unroll
                    for (int n = 0; n < 2; ++n) acc[a][b][m][n] = (f32x4){0.f, 0.f, 0.f, 0.f};
        cur = nxt; cA = nA; cB = nB; ++ui;
        if constexpr (GATHER) {
#pragma unroll
        for (int h = 0; h < 2; ++h)
#pragma unroll
            for (int i = 0; i < 2; ++i) offC[h][i] = offN[h][i]; }
        if (wr == 1) PG8_BAR;
    }
    PG8_WAIT_V(0);
    PG8_BAR;
#undef PG8_SETOFF
#undef PG8_SA
#undef PG8_SB
#undef PG8_STAGEA
#undef PG8_STAGEB
#undef PG8_LDA
#undef PG8_LDB
#undef PG8_MMA
#undef PG8_HALF
#undef PG8_WAIT_V
#undef PG8_WAIT_L
#undef PG8_BAR
#undef PG8_SCHED
}
}

#define XB_TMO      128
#define XB_XCNT(j)  (256  + 64 * (j))
#define XB_XSUB(j)  (1280 + 64 * (j))
#define XB_XGEN(j)  (2304 + 64 * (j))
#define XB_TOP      3328
#define XB_TOPGEN   3392
#define XCD_BAR_WORDS 3456
#define XB_SPIN_CAP (1u << 18)
__device__ __forceinline__ unsigned xb_ld(unsigned* p)              { return __hip_atomic_load(p, __ATOMIC_RELAXED, __HIP_MEMORY_SCOPE_AGENT); }
__device__ __forceinline__ unsigned xb_add(unsigned* p, unsigned v) { return __hip_atomic_fetch_add(p, v, __ATOMIC_RELAXED, __HIP_MEMORY_SCOPE_AGENT); }
__device__ __forceinline__ unsigned xb_xcc_id() { return (unsigned)__builtin_amdgcn_s_getreg((3 << 11) | 20) & 0xFu; }
#define XB_SPIN(cond, bar) do { unsigned _sp = 0; while (cond) { __builtin_amdgcn_s_sleep(1); \
    if ((++_sp & 255u) == 0u) { if (xb_ld(&(bar)[XB_TMO])) break; if (_sp > XB_SPIN_CAP) { atomicAdd(&(bar)[XB_TMO], 1u); break; } } } } while (0)
struct XcdBarrier { unsigned* bar; unsigned x; volatile LAS unsigned* st; };
__device__ __forceinline__ XcdBarrier xcd_barrier_post(unsigned* bar, volatile LAS unsigned* st) {
    XcdBarrier b; b.bar = bar; b.x = xb_xcc_id(); b.st = st;
    if (threadIdx.x == 0) (void)xb_add(&bar[XB_XCNT(b.x)], 1u);
    return b;
}
__device__ __forceinline__ void xcd_barrier_complete(unsigned* bar, unsigned x, unsigned& nloc, unsigned& nx) {
    const unsigned G = gridDim.x * gridDim.y * gridDim.z;
    unsigned sum, cnt, mine, sp = 0u;
    for (;;) {
        sum = 0u; cnt = 0u; mine = 0u;
#pragma unroll
        for (unsigned j = 0; j < 16; ++j) { const unsigned c = xb_ld(&bar[XB_XCNT(j)]); sum += c; cnt += (c > 0u) ? 1u : 0u; mine = (j == x) ? c : mine; }
        if (sum == G) break;
        __builtin_amdgcn_s_sleep(1);
        if ((++sp & 255u) == 0u) { if (xb_ld(&bar[XB_TMO])) break; if (sp > XB_SPIN_CAP) { atomicAdd(&bar[XB_TMO], 1u); break; } }
    }
    nloc = mine > 0u ? mine : 1u; nx = cnt > 0u ? cnt : 1u;
}
__device__ __forceinline__ void xcd_barrier(const XcdBarrier& b) {
    asm volatile("s_waitcnt vmcnt(0)" ::: "memory");
    __syncthreads();
    if (threadIdx.x == 0) {
        unsigned* bar = b.bar;
        __builtin_amdgcn_s_waitcnt(0);
        unsigned nloc = b.st[0], nx = b.st[1];
        if (nloc == 0u) { xcd_barrier_complete(bar, b.x, nloc, nx); b.st[0] = nloc; b.st[1] = nx; }
        const unsigned old = xb_add(&bar[XB_XSUB(b.x)], 1u);
        const unsigned gen = old / nloc;
        if (old + 1u == (gen + 1u) * nloc) {
            __builtin_amdgcn_fence(__ATOMIC_RELEASE, "agent");
            asm volatile("s_waitcnt vmcnt(0)" ::: "memory");
            const unsigned og = xb_add(&bar[XB_TOP], 1u);
            const unsigned tg = og / nx;
            if (og + 1u == (tg + 1u) * nx) xb_add(&bar[XB_TOPGEN], 1u);
            else XB_SPIN(xb_ld(&bar[XB_TOPGEN]) == tg, bar);
            __builtin_amdgcn_fence(__ATOMIC_ACQUIRE, "agent");
            xb_add(&bar[XB_XGEN(b.x)], 1u);
            asm volatile("s_waitcnt vmcnt(0)" ::: "memory");
        } else {
            XB_SPIN(xb_ld(&bar[XB_XGEN(b.x)]) == gen, bar);
            __builtin_amdgcn_fence(__ATOMIC_ACQUIRE, "agent");
            asm volatile("s_waitcnt vmcnt(0)" ::: "memory");
        }
    }
    __syncthreads();
}

struct Args { const float* in[38]; float* out; unsigned char* ws; int ph_lo, ph_hi, li, pad; };
struct Frame {
    LAS unsigned char* lds;
    int tid, lane, wave, G, gw, NGW;
    int gt, NGT;
};
enum { I_X = 0, I_META, I_NORM_MIX0, I_WIN0, I_CONVW, I_CONVB, I_GAW, I_GAB, I_GXW, I_GXB, I_LAM, I_LRE, I_LIM, I_LDT, I_BRE, I_BIM, I_CRE, I_CIM, I_SD, I_GLUW, I_GLUB, I_WOUT0, I_NORM_FFN0,
       I_FG, I_FU, I_FD, I_NORM_MIX1, I_WIN1, I_GW2, I_GB, I_GNORM, I_WOUT1, I_NORM_FFN1, I_ROUTER, I_MG, I_MU, I_MD, I_FNORM };

struct SchedStatic {
    int nM, nN, G, c; const char* A; const char* B; size_t aStep, bStep; int aColDiv; size_t aColStep;
    __device__ __forceinline__ bool next(int i, pg8::Unit& u) const {
        int pm, pn; if (!pg8::static_tile(i, G, c, nM, nN, pm, pn)) return false;
        u.pm = pm; u.pn = pn; u.slot = i; u.a = A + (size_t)pm * aStep + (aColDiv ? (size_t)(pn / aColDiv) * aColStep : 0); u.b = B + (size_t)pn * bStep; return true;
    }
};
struct SchedList {
    int n; const LAS int* meta; const char* A; const char* B; size_t aStep, bTile, bExpert;
    __device__ __forceinline__ bool next(int i, pg8::Unit& u) const {
        if (i >= n) return false;
        const int pm = meta[i * 4 + 0], pn = meta[i * 4 + 1], e = meta[i * 4 + 2];
        u.pm = pm; u.pn = pn; u.slot = i; const int ko = meta[i * 4 + 3]; u.a = A + (size_t)pm * aStep + (size_t)ko * 2; u.b = B + (size_t)e * bExpert + (size_t)pn * bTile + (size_t)ko * 2; return true;
    }
};

#define EPI_ROWS(ai, m) ((ai) * 128 + wr * 64 + (m) * 16 + fr)
#define EPI_COLP(bj) ((bj) * 128 + wc * 32 + 8 * fq)
#define EPI_COLN(bj, n) ((bj) * 128 + wc * 32 + 16 * (n) + 4 * fq)
typedef const f32x4 (&AccRef)[2][2][4][2];
__device__ __forceinline__ void unpack8(v4u w, f32x4& a, f32x4& b) { a = (f32x4){bflo(w.x), bfhi(w.x), bflo(w.y), bfhi(w.y)}; b = (f32x4){bflo(w.z), bfhi(w.z), bflo(w.w), bfhi(w.w)}; }
__device__ __forceinline__ v4u pack8(f32x4 a, f32x4 b) { v4u w; w.x = pg8::cvt_pk_bf16(a[0], a[1]); w.y = pg8::cvt_pk_bf16(a[2], a[3]); w.z = pg8::cvt_pk_bf16(b[0], b[1]); w.w = pg8::cvt_pk_bf16(b[2], b[3]); return w; }

template <int D> __device__ __forceinline__ float ror16(float v) { return __builtin_bit_cast(float, __builtin_amdgcn_update_dpp(0, __builtin_bit_cast(int, v), 0x120 + D, 0xF, 0xF, false)); }
struct EpiWin0 {
    static constexpr bool PERM = true; bf16 *G, *XR, *U; const float *cw, *cb; bf16* XC;
    __device__ __forceinline__ void operator()(AccRef acc, const pg8::Unit& u, int wr, int wc, int fr, int fq) const {
        const int pn = u.pn; bf16* base; int ld, c0;
        if (pn >= 4 && pn < 8) {
#pragma unroll
            for (int bj = 0; bj < 2; ++bj)
#pragma unroll
              for (int n = 0; n < 2; ++n) { const int cc = (pn - 4) * 256 + EPI_COLP(bj) + 4 * n;
                f32x4 w0 = *(const f32x4*)(cw + cc), w1 = *(const f32x4*)(cw + 1024 + cc), w2 = *(const f32x4*)(cw + 2048 + cc), w3 = *(const f32x4*)(cw + 3072 + cc); const f32x4 bb = *(const f32x4*)(cb + cc);
#pragma unroll
                for (int ai = 0; ai < 2; ++ai) { f32x4 q1 = {0.f, 0.f, 0.f, 0.f}, q2 = q1, q3 = q1;
#pragma unroll
                    for (int m = 0; m < 4; ++m) { const size_t ro = (size_t)(u.pm * 256 + EPI_ROWS(ai, m)) * 1024 + cc; const f32x4 x = acc[ai][bj][m][n]; f32x4 t1, t2, t3, p1, p2, p3;
#pragma unroll
                        for (int j = 0; j < 4; ++j) { t1[j] = ror16<1>(x[j]); t2[j] = ror16<2>(x[j]); t3[j] = ror16<3>(x[j]);
                            p1[j] = fr >= 1 ? t1[j] : q1[j]; p2[j] = fr >= 2 ? t2[j] : q2[j]; p3[j] = fr >= 3 ? t3[j] : q3[j]; }
                        const f32x4 o = bb + w0 * p3 + w1 * p2 + w2 * p1 + w3 * x;
                        q1 = t1; q2 = t2; q3 = t3;
                        const bool fix = (m == 0) && fr < 3;
                        if (!fix) *(v2u*)(XC + ro) = (v2u){pk2(o.x, o.y), pk2(o.z, o.w)};
                        if (fix || ((m == 3) && fr >= 13)) *(v2u*)(XR + ro) = (v2u){pk2(x.x, x.y), pk2(x.z, x.w)};
                        asm volatile("" : "+v"(q1), "+v"(q2), "+v"(q3) :: "memory"); } } }
            return; }
        if (pn < 4) { base = G; ld = 1024; c0 = pn * 256; } else if (pn < 8) { base = XR; ld = 1024; c0 = (pn - 4) * 256; } else { base = U; ld = 512; c0 = (pn - 8) * 256; }
#pragma unroll
        for (int ai = 0; ai < 2; ++ai)
#pragma unroll
            for (int m = 0; m < 4; ++m) { bf16* rowp = base + (size_t)(u.pm * 256 + EPI_ROWS(ai, m)) * ld + c0;
#pragma unroll
                for (int bj = 0; bj < 2; ++bj) { f32x4 v0 = acc[ai][bj][m][0], v1 = acc[ai][bj][m][1];
                    if (pn < 4) {
#pragma unroll
                        for (int j = 0; j < 1; ++j) { v0 = gelu_tanh_4(v0); v1 = gelu_tanh_4(v1); } }
                    *(v4u*)(rowp + EPI_COLP(bj)) = pack8(v0, v1); } }
    }
};
struct EpiGates {
    static constexpr bool PERM = true; const float *gab, *gxb, *sp8; const bf16* XC; bf16* A; bf16* BX;
    __device__ __forceinline__ void operator()(AccRef acc, const pg8::Unit& u, int wr, int wc, int fr, int fq) const {
        const int ch0 = (u.pn >> 1) * 256 + (u.pn & 1) * 128 + wc * 32 + 8 * fq;
        f32x4 ba[2], bx[2], sp[2];
#pragma unroll
        for (int n = 0; n < 2; ++n) { ba[n] = *(const f32x4*)(gab + ch0 + 4 * n); bx[n] = *(const f32x4*)(gxb + ch0 + 4 * n); sp[n] = *(const f32x4*)(sp8 + ch0 + 4 * n); }
#pragma unroll
        for (int ai = 0; ai < 2; ++ai)
#pragma unroll
            for (int m = 0; m < 4; ++m) { const size_t ro = (size_t)(u.pm * 256 + EPI_ROWS(ai, m)) * 1024 + ch0;
                const v4u xw = *(const v4u*)(XC + ro); f32x4 xv[2]; unpack8(xw, xv[0], xv[1]);
                f32x4 av[2], bv[2];
#pragma unroll
                for (int n = 0; n < 2; ++n) { const f32x4 r = sigmoid_4(acc[ai][0][m][n] + ba[n]), ig = sigmoid_4(acc[ai][1][m][n] + bx[n]);
                    const f32x4 la = r * sp[n] * -1.0f, aa = exp2_4(la * 1.4426950408889634f); f32x4 om = aa * aa * -1.0f + 1.0f, sq;
#pragma unroll
                    for (int j = 0; j < 4; ++j) sq[j] = __builtin_amdgcn_sqrtf(fmaxf(om[j], 0.0f));
                    av[n] = la; bv[n] = sq * ig * xv[n]; }
                *(v4u*)(A + ro) = pack8(av[0], av[1]); *(v4u*)(BX + ro) = pack8(bv[0], bv[1]); asm volatile("" ::: "memory"); }
    }
};
struct EpiGlu {
    static constexpr bool PERM = true; const float* glub; const bf16* GS; bf16* AOUT;
    __device__ __forceinline__ void operator()(AccRef acc, const pg8::Unit& u, int wr, int wc, int fr, int fq) const {
#pragma unroll
        for (int bj = 0; bj < 2; ++bj) { const int c = u.pn * 256 + EPI_COLP(bj); const f32x4 b0 = *(const f32x4*)(glub + c), b1 = *(const f32x4*)(glub + c + 4);
#pragma unroll
            for (int ai = 0; ai < 2; ++ai)
#pragma unroll
                for (int m = 0; m < 4; ++m) { const size_t row = (size_t)(u.pm * 256 + EPI_ROWS(ai, m));
                    f32x4 g0_, g1_; unpack8(*(const v4u*)(GS + row * 512 + c), g0_, g1_);
                    const f32x4 v0 = g0_ * sigmoid_4(acc[ai][bj][m][0] + b0), v1 = g1_ * sigmoid_4(acc[ai][bj][m][1] + b1);
                    *(v4u*)(AOUT + row * 1536 + 1024 + c) = pack8(v0, v1); } }
    }
};
struct EpiResid {
    static constexpr bool PERM = true; const float* xsrc; bf16* hb; float* ssqp;
    __device__ __forceinline__ void operator()(AccRef acc, const pg8::Unit& u, int wr, int wc, int fr, int fq) const {
        float q[2][4];
#pragma unroll
        for (int ai = 0; ai < 2; ++ai)
#pragma unroll
            for (int m = 0; m < 4; ++m) { const size_t ro = (size_t)(u.pm * 256 + EPI_ROWS(ai, m)) * 1024 + u.pn * 256; float qs = 0.f;
#pragma unroll
                for (int bj = 0; bj < 2; ++bj) { const size_t o = ro + EPI_COLP(bj); f32x4 v0, v1;
                    if (xsrc) { v0 = *(const f32x4*)(xsrc + o); v1 = *(const f32x4*)(xsrc + o + 4); } else unpack8(*(const v4u*)(hb + o), v0, v1);
                    v0 += acc[ai][bj][m][0]; v1 += acc[ai][bj][m][1];
                    { const f32x4 sq_ = v0 * v0 + v1 * v1; qs += (sq_.x + sq_.y) + (sq_.z + sq_.w); }
                    *(v4u*)(hb + o) = pack8(v0, v1); }
                q[ai][m] = qs; }
        if (ssqp) {
#pragma unroll
            for (int ai = 0; ai < 2; ++ai)
#pragma unroll
                for (int m = 0; m < 4; ++m) { float t = q[ai][m]; t += __shfl_xor(t, 16); t += __shfl_xor(t, 32);
                    if (fq == 0) ssqp[(size_t)(u.pm * 256 + EPI_ROWS(ai, m)) * 16 + u.pn * 4 + wc] = t; } }
    }
};
__device__ __forceinline__ f32x4 swiglu4_x32(f32x4 G, f32x4 U) {
    const f32x4 a = G * (-1.4426950408889634f / 32.0f) + 10.0f; f32x4 t;
#pragma unroll
    for (int j = 0; j < 4; ++j) t[j] = __builtin_amdgcn_exp2f(a[j]);
    const f32x4 d = t + 1024.0f; f32x4 q;
#pragma unroll
    for (int j = 0; j < 4; ++j) q[j] = rcpf_(d[j]);
    return (G * U) * q; }
__device__ __forceinline__ f32x4 swiglu4_r(f32x4 G, f32x4 U, float r2, float rl) {
    const f32x4 a = G * rl; f32x4 t;
#pragma unroll
    for (int j = 0; j < 4; ++j) t[j] = __builtin_amdgcn_exp2f(a[j]);
    const f32x4 d = t + 1.0f; f32x4 q;
#pragma unroll
    for (int j = 0; j < 4; ++j) q[j] = rcpf_(d[j]);
    return (G * U) * (q * r2); }
__device__ __forceinline__ float rstd_of(const float* ssqp, size_t row) { const f32x4* p = (const f32x4*)(ssqp + row * 16); const f32x4 a = p[0], b = p[1], c = p[2], d = p[3];
    const f32x4 t = (a + b) + (c + d); return __builtin_amdgcn_rsqf(((t.x + t.y) + (t.z + t.w)) * (1.0f / 1024.0f) + EPS); }
constexpr int FOLD_MAXU = 20;
__device__ __forceinline__ float fold_rstd(const LAS float* rst, const float* ssqp, const pg8::Unit& u, int r) { return u.slot < FOLD_MAXU ? rst[u.slot * 256 + r] : rstd_of(ssqp, (size_t)(u.pm * 256 + r)); }
struct EpiSwiglu {
    static constexpr bool PERM = true; bf16* H; int ld; const float* ssqp; const LAS float* rst;
    __device__ __forceinline__ void operator()(AccRef acc, const pg8::Unit& u, int wr, int wc, int fr, int fq) const {
        const int c = u.pn * 128 + wc * 32 + 8 * fq;
        float rs[2][4];
#pragma unroll
        for (int ai = 0; ai < 2; ++ai)
#pragma unroll
            for (int m = 0; m < 4; ++m) rs[ai][m] = fold_rstd(rst, ssqp, u, EPI_ROWS(ai, m));
#pragma unroll
        for (int ai = 0; ai < 2; ++ai)
#pragma unroll
            for (int m = 0; m < 4; ++m) { const float r = rs[ai][m], r2 = r * r, rl = r * -1.4426950408889634f;
                const f32x4 v0 = swiglu4_r(acc[ai][0][m][0], acc[ai][1][m][0], r2, rl), v1 = swiglu4_r(acc[ai][0][m][1], acc[ai][1][m][1], r2, rl);
                *(v4u*)(H + (size_t)(u.pm * 256 + EPI_ROWS(ai, m)) * ld + c) = pack8(v0, v1); }
    }
};
struct EpiWin1 {
    static constexpr bool PERM = true; bf16 *Q, *K, *V, *GATE; bf16* LG; const float* gb; const float* ssqp; const LAS float* rst;
    __device__ __forceinline__ void operator()(AccRef acc, const pg8::Unit& u, int wr, int wc, int fr, int fq) const {
        const int pn = u.pn;
        float rs[2][4];
#pragma unroll
        for (int ai = 0; ai < 2; ++ai)
#pragma unroll
            for (int m = 0; m < 4; ++m) rs[ai][m] = fold_rstd(rst, ssqp, u, EPI_ROWS(ai, m));
#pragma unroll
        for (int ai = 0; ai < 2; ++ai)
#pragma unroll
            for (int m = 0; m < 4; ++m) { const size_t row = (size_t)(u.pm * 256 + EPI_ROWS(ai, m)); const float r = rs[ai][m];
#pragma unroll
                for (int bj = 0; bj < 2; ++bj) { f32x4 v0 = acc[ai][bj][m][0] * r, v1 = acc[ai][bj][m][1] * r; const int cc = EPI_COLP(bj);
                    if (pn < 2) { v0 = v0 * 0.08838834764831845f; v1 = v1 * 0.08838834764831845f; *(v4u*)(Q + row * 512 + pn * 256 + cc) = pack8(v0, v1); }
                    else if (pn < 4) { *(v4u*)(K + row * 512 + (pn - 2) * 256 + cc) = pack8(v0, v1); }
                    else if (pn < 8) { *(v4u*)(V + row * 1024 + (pn - 4) * 256 + cc) = pack8(v0, v1); }
                    else if (pn < 12) {
#pragma unroll
                        for (int j = 0; j < 1; ++j) { v0 = silu_4(v0); v1 = silu_4(v1); }
                        *(v4u*)(GATE + row * 1024 + (pn - 8) * 256 + cc) = pack8(v0, v1); }
                    else { const int c = (pn - 12) * 256 + cc; const f32x4 b0 = *(const f32x4*)(gb + c), b1 = *(const f32x4*)(gb + c + 4);
#pragma unroll
                        for (int j = 0; j < 1; ++j) { v0 = logsig2_4(v0 + b0); v1 = logsig2_4(v1 + b1); }
                        *(v4u*)(LG + row * 512 + c) = pack8(v0, v1); } } }
    }
};
__device__ __forceinline__ float swiglu_x32(float G, float U) { const float t = __builtin_amdgcn_exp2f(__builtin_fmaf(G, -1.4426950408889634f / 32.0f, 10.0f)); return (G * U) * rcpf_(1024.0f + t); }
struct EpiSwiglu8 {
    static constexpr bool PERM = true; unsigned char* H; int ld;
    __device__ __forceinline__ void operator()(AccRef acc, const pg8::Unit& u, int wr, int wc, int fr, int fq) const {
        const int c = u.pn * 128 + wc * 32 + 8 * fq; constexpr float SC = 1.0f / 32.0f;
#pragma unroll
        for (int ai = 0; ai < 2; ++ai)
#pragma unroll
            for (int m = 0; m < 4; ++m) { float v[8];
#pragma unroll
                for (int j = 0; j < 1; ++j) { const f32x4 o0 = swiglu4_x32(acc[ai][0][m][0], acc[ai][1][m][0]), o1 = swiglu4_x32(acc[ai][0][m][1], acc[ai][1][m][1]);
                    v[0] = o0.x; v[1] = o0.y; v[2] = o0.z; v[3] = o0.w; v[4] = o1.x; v[5] = o1.y; v[6] = o1.z; v[7] = o1.w; }
                *(v2u*)(H + (size_t)(u.pm * 256 + EPI_ROWS(ai, m)) * ld + c) = (v2u){pk4_fp8(v[0], v[1], v[2], v[3]), pk4_fp8(v[4], v[5], v[6], v[7])}; }
    }
};
struct EpiMoeDown {
    static constexpr bool PERM = true; bf16* hb; const LAS int* toks; const LAS float* wts;
    __device__ __forceinline__ void operator()(AccRef acc, const pg8::Unit& u, int wr, int wc, int fr, int fq) const {
#pragma unroll
        for (int ai = 0; ai < 2; ++ai)
#pragma unroll
            for (int m = 0; m < 4; ++m) { const int rl = u.slot * 256 + EPI_ROWS(ai, m); const int tok = toks[rl]; const float w = wts[rl] * (1.0f / 64.0f);
                if (tok >= 0) { bf16* d = hb + (size_t)tok * 1024 + u.pn * 256;
#pragma unroll
                    for (int bj = 0; bj < 2; ++bj) { bf16* p = d + EPI_COLP(bj); f32x4 v0, v1; unpack8(*(const v4u*)p, v0, v1); *(v4u*)p = pack8(v0 + acc[ai][bj][m][0] * w, v1 + acc[ai][bj][m][1] * w); } } }
    }
};
struct EpiSlab {
    static constexpr bool PERM = false; float* slab; const LAS int* meta;
    __device__ __forceinline__ void operator()(AccRef acc, const pg8::Unit& u, int wr, int wc, int fr, int fq) const {
        const int sl = meta[u.slot * 4 + 3] / 256; float* base = slab + ((size_t)(sl * 8 + (u.pm - 128)) * 256) * 1024 + u.pn * 256;
#pragma unroll
        for (int ai = 0; ai < 2; ++ai)
#pragma unroll
            for (int m = 0; m < 4; ++m) { float* d = base + (size_t)EPI_ROWS(ai, m) * 1024;
#pragma unroll
                for (int bj = 0; bj < 2; ++bj)
#pragma unroll
                    for (int n = 0; n < 2; ++n) *(f32x4*)(d + EPI_COLN(bj, n)) = acc[ai][bj][m][n] * (1.0f / 64.0f); }
    }
};

__device__ __forceinline__ void tr_item8(const float* W, int ldw, int col, int k0, unsigned char* WT, int ldt, int drow, float scale, LAS float* scr, int lane) {
    float wv[32];
#pragma unroll
    for (int i = 0; i < 32; ++i) wv[i] = __builtin_nontemporal_load(W + (size_t)(k0 + 2 * i + (lane >> 5)) * ldw + col + (lane & 31));
#pragma unroll
    for (int i = 0; i < 32; i += 2) { const f32x2 sv = (f32x2){wv[i], wv[i + 1]} * scale; scr[(2 * i + (lane >> 5)) * 33 + (lane & 31)] = sv.x; scr[(2 * i + 2 + (lane >> 5)) * 33 + (lane & 31)] = sv.y; }
    LDS_WAIT(); asm volatile("" ::: "memory");
    const int c = lane & 7;
#pragma unroll
    for (int j = 0; j < 4; ++j) { const int n = (lane >> 3) + 8 * j; const LAS float* s = scr + (8 * c) * 33 + n;
        *(v2u*)(WT + (size_t)(drow + n) * ldt + k0 + 8 * c) = (v2u){pk4_fp8(s[0 * 33], s[1 * 33], s[2 * 33], s[3 * 33]), pk4_fp8(s[4 * 33], s[5 * 33], s[6 * 33], s[7 * 33])}; }
    LDS_WAIT(); asm volatile("" ::: "memory");
}
__device__ __forceinline__ void tr_item(const float* W, int ldw, int col, int k0, bf16* WT, int ldt, int drow, LAS float* scr, int lane, const float* rs = nullptr) {
    float wv[32];
#pragma unroll
    for (int i = 0; i < 32; ++i) wv[i] = __builtin_nontemporal_load(W + (size_t)(k0 + 2 * i + (lane >> 5)) * ldw + col + (lane & 31));
#pragma unroll
    for (int i = 0; i < 32; ++i) scr[(2 * i + (lane >> 5)) * 33 + (lane & 31)] = rs ? wv[i] * rs[k0 + 2 * i + (lane >> 5)] : wv[i];
    LDS_WAIT(); asm volatile("" ::: "memory");
    const int c = lane & 7;
#pragma unroll
    for (int j = 0; j < 4; ++j) { const int n = (lane >> 3) + 8 * j; const LAS float* s = scr + (8 * c) * 33 + n;
        v4u o; o.x = pk2(s[0 * 33], s[1 * 33]); o.y = pk2(s[2 * 33], s[3 * 33]); o.z = pk2(s[4 * 33], s[5 * 33]); o.w = pk2(s[6 * 33], s[7 * 33]);
        *(v4u*)(WT + (size_t)(drow + n) * ldt + k0 + 8 * c) = o; }
    LDS_WAIT(); asm volatile("" ::: "memory");
}
struct TrJob { const float* W; int ldw, col0, K, N; bf16* WT; int blk, bstride, add; const float* rs = nullptr; };
__device__ __forceinline__ bool tr_try(int& r, const TrJob& j, LAS float* scr, int lane) {
    const int nblk = j.N / 32, items = (j.K / 64) * nblk;
    if (r >= items) { r -= items; return false; }
    const int kb = r / nblk, n0 = (r % nblk) * 32;
    tr_item(j.W, j.ldw, j.col0 + n0, kb * 64, j.WT, j.K, (n0 / j.blk) * j.bstride + (n0 % j.blk) + j.add, scr, lane, j.rs);
    return true;
}
__device__ __forceinline__ void norm_row_bf16(const float* xrow, const float* gain, bf16* orow, int lane) {
    const f32x4* xr = (const f32x4*)xrow + lane; const f32x4* gr = (const f32x4*)gain + lane;
    f32x4 v[4]; float s = 0.f;
#pragma unroll
    for (int j = 0; j < 4; ++j) { v[j] = xr[64 * j]; s += (v[j].x * v[j].x + v[j].y * v[j].y) + (v[j].z * v[j].z + v[j].w * v[j].w); }
    const float rstd = 1.0f / sqrtf(wave_sum(s) * (1.0f / 1024.0f) + EPS);
    v2u* o8 = (v2u*)orow + lane;
#pragma unroll
    for (int j = 0; j < 4; ++j) { const f32x4 g = gr[64 * j]; v2u w; w.x = pk2(v[j].x * rstd * g.x, v[j].y * rstd * g.y); w.y = pk2(v[j].z * rstd * g.z, v[j].w * rstd * g.w); o8[64 * j] = w; }
}
__device__ __forceinline__ void norm_row_b2b(const bf16* hrow, const float* gain, bf16* orow, int lane) {
    f32x4 v[4]; unpack8(*(const v4u*)(hrow + 8 * lane), v[0], v[1]); unpack8(*(const v4u*)(hrow + 512 + 8 * lane), v[2], v[3]); float s = 0.f;
#pragma unroll
    for (int j = 0; j < 4; ++j) s += (v[j].x * v[j].x + v[j].y * v[j].y) + (v[j].z * v[j].z + v[j].w * v[j].w);
    const float rstd = 1.0f / sqrtf(wave_sum(s) * (1.0f / 1024.0f) + EPS);
    const f32x4 g0 = *(const f32x4*)(gain + 8 * lane), g1 = *(const f32x4*)(gain + 8 * lane + 4), g2 = *(const f32x4*)(gain + 512 + 8 * lane), g3 = *(const f32x4*)(gain + 512 + 8 * lane + 4);
    *(v4u*)(orow + 8 * lane) = pack8(v[0] * rstd * g0, v[1] * rstd * g1); *(v4u*)(orow + 512 + 8 * lane) = pack8(v[2] * rstd * g2, v[3] * rstd * g3);
}

__device__ __forceinline__ void cexp_f(double re, double im, float& er, float& ei) {
    const float mag = __expf((float)re); double rev = im * 0.15915494309189535; rev -= floor(rev); const float fr_ = (float)rev;
    er = mag * __builtin_amdgcn_cosf(fr_); ei = mag * __builtin_amdgcn_sinf(fr_);
}
__device__ __forceinline__ void p0_prologue(const Frame& F, const Args& a, unsigned char* ws) {
    LAS float* scr = (LAS float*)(F.lds + RING_OFF + F.wave * 16384);
    const float* const* in = a.in;
    constexpr int BIG = 1 << 30;
    for (int it = F.gw; ; it += F.NGW) {
        int r = it;
        { TrJob j{in[I_WIN0], EV_IN, 0, 1024, EV_IN, (bf16*)(ws + WS_WIN0), BIG, 0, 0}; if (tr_try(r, j, scr, F.lane)) continue; }
        bool done = false;
        for (int h = 0; h < 4 && !done; ++h) {
            { TrJob j{in[I_GAW] + (size_t)h * 65536, 256, 0, 256, 256, (bf16*)(ws + WS_GW) + (size_t)h * 512 * 256, 128, 256, 0}; if (tr_try(r, j, scr, F.lane)) { done = true; break; } }
            { TrJob j{in[I_GXW] + (size_t)h * 65536, 256, 0, 256, 256, (bf16*)(ws + WS_GW) + (size_t)h * 512 * 256, 128, 256, 128}; if (tr_try(r, j, scr, F.lane)) { done = true; break; } }
        }
        if (done) continue;
        { TrJob j{in[I_GLUW], 512, 0, 512, 512, (bf16*)(ws + WS_GLUW), BIG, 0, 0}; if (tr_try(r, j, scr, F.lane)) continue; }
        { TrJob j{in[I_WOUT0], 1024, 0, EV_MIX, 1024, (bf16*)(ws + WS_WOUT0), BIG, 0, 0}; if (tr_try(r, j, scr, F.lane)) continue; }
        { TrJob j{in[I_FG], FF0, 0, 1024, FF0, (bf16*)(ws + WS_WUP0), 128, 256, 0, in[I_NORM_FFN0]}; if (tr_try(r, j, scr, F.lane)) continue; }
        { TrJob j{in[I_FU], FF0, 0, 1024, FF0, (bf16*)(ws + WS_WUP0), 128, 256, 128, in[I_NORM_FFN0]}; if (tr_try(r, j, scr, F.lane)) continue; }
        { TrJob j{in[I_FD], 1024, 0, FF0, 1024, (bf16*)(ws + WS_WDN0), BIG, 0, 0}; if (tr_try(r, j, scr, F.lane)) continue; }
        { TrJob j{in[I_WIN1], OD_IN, 0, 1024, 3072, (bf16*)(ws + WS_WIN1), BIG, 0, 0, in[I_NORM_MIX1]}; if (tr_try(r, j, scr, F.lane)) continue; }
        { TrJob j{in[I_WOUT1], 1024, 0, 1024, 1024, (bf16*)(ws + WS_WOUT1), BIG, 0, 0}; if (tr_try(r, j, scr, F.lane)) continue; }
        break;
    }
    for (long i = F.gt; i < 512L * 1024; i += F.NGT) { const int j = (int)(i & 511), k = (int)(i >> 9); const float* wr_ = in[I_WIN1] + (size_t)k * OD_IN + 3072; const float* w2 = in[I_GW2] + j; float s = 0.f;
#pragma unroll
        for (int r = 0; r < 16; ++r) s += wr_[r] * w2[r * 512];
        ((bf16*)(ws + WS_WIN1))[(size_t)(3072 + j) * 1024 + k] = (bf16)f2bf(s * in[I_NORM_MIX1][k]); }
    float* tab = (float*)(ws + WS_TAB);
    for (long i = F.gt; i < NG * NS; i += F.NGT) { const int g = (int)i / NS;
        const double lr = in[I_LRE][i], li = in[I_LIM][i], dt = (double)expf(in[I_LDT][g]);
        float arf, aif, a64r, a64i; cexp_f(dt * lr, dt * li, arf, aif); cexp_f(64.0 * dt * lr, 64.0 * dt * li, a64r, a64i);
        const float lrf = (float)lr, lif = (float)li, den = lrf * lrf + lif * lif, nr = arf - 1.0f;
        const float zr = (nr * lrf + aif * lif) / den, zi = (aif * lrf - nr * lif) / den;
        ((float*)((char*)tab + TB_AR))[i] = arf; ((float*)((char*)tab + TB_AI))[i] = aif;
        ((float*)((char*)tab + TB_AR64))[i] = a64r; ((float*)((char*)tab + TB_AI64))[i] = a64i;
        for (int h = 0; h < 16; ++h) { const float br = in[I_BRE][i * 16 + h], bi = in[I_BIM][i * 16 + h];
            ((float*)((char*)tab + TB_BBR))[i * 16 + h] = zr * br - zi * bi; ((float*)((char*)tab + TB_BBI))[i * 16 + h] = zr * bi + zi * br; } }
    for (long idx = F.gt; idx < (long)NG * NS * 64; idx += F.NGT) { const int i = (int)(idx & 63), gn = (int)(idx >> 6), g = gn / NS, n = gn % NS;
        const double lr = in[I_LRE][gn], li = in[I_LIM][gn], dt = (double)expf(in[I_LDT][g]);
        float ar1, ai1, pr, pi_; cexp_f(dt * lr, dt * li, ar1, ai1); const double pw = (double)(63 - i); cexp_f(pw * dt * lr, pw * dt * li, pr, pi_);
        const float lrf = (float)lr, lif = (float)li, den = lrf * lrf + lif * lif, nr1 = ar1 - 1.0f;
        const float zr = (nr1 * lrf + ai1 * lif) / den, zi = (ai1 * lrf - nr1 * lif) / den;
        float vre[16], vim[16];
#pragma unroll
        for (int h = 0; h < 16; ++h) { const float br = in[I_BRE][(size_t)gn * 16 + h], bi = in[I_BIM][(size_t)gn * 16 + h]; const float bbr = zr * br - zi * bi, bbi = zr * bi + zi * br;
            vre[h] = pr * bbr - pi_ * bbi; vim[h] = pr * bbi + pi_ * bbr; }
        const int rb = n >> 3, fre = (2 * n) & 15, ks = i >> 1;
#pragma unroll
        for (int hh = 0; hh < 2; ++hh) { const int fq = (i & 1) * 2 + hh; bf16* dst = (bf16*)(ws + WS_WE) + ((((size_t)g * 8 + rb) * 32 + ks) * 64 + 16 * fq + fre) * 8;
            *(v4u*)dst = (v4u){pk2(vre[8 * hh], vre[8 * hh + 1]), pk2(vre[8 * hh + 2], vre[8 * hh + 3]), pk2(vre[8 * hh + 4], vre[8 * hh + 5]), pk2(vre[8 * hh + 6], vre[8 * hh + 7])};
            *(v4u*)(dst + 8) = (v4u){pk2(vim[8 * hh], vim[8 * hh + 1]), pk2(vim[8 * hh + 2], vim[8 * hh + 3]), pk2(vim[8 * hh + 4], vim[8 * hh + 5]), pk2(vim[8 * hh + 6], vim[8 * hh + 7])}; } }
    for (long i = F.gt; i < 1024; i += F.NGT) { const float lam = in[I_LAM][i]; ((float*)((char*)tab + TB_SP8))[i] = 8.0f * log1pf(expf(-lam)); }
    bf16* HN = (bf16*)(ws + WS_HN); float* hmeta = (float*)(ws + WS_HMETA);
    { const float* gain0 = in[I_NORM_MIX0]; const int lane = F.lane; f32x4 gg[4];
#pragma unroll
      for (int j = 0; j < 4; ++j) gg[j] = ((const f32x4*)gain0)[lane + 64 * j];
      for (int m = F.gw; m < TR; m += 4 * F.NGW) { f32x4 xv[4][4];
#pragma unroll
        for (int q = 0; q < 4; ++q) { const int mm = m + q * F.NGW; if (mm < TR) {
#pragma unroll
            for (int j = 0; j < 4; ++j) xv[q][j] = __builtin_nontemporal_load((const f32x4*)(in[I_X] + (size_t)mm * 1024) + lane + 64 * j); } }
#pragma unroll
        for (int q = 0; q < 4; ++q) { const int mm = m + q * F.NGW; if (mm < TR) { float sq = 0.f;
#pragma unroll
            for (int j = 0; j < 4; ++j) sq += (xv[q][j].x * xv[q][j].x + xv[q][j].y * xv[q][j].y) + (xv[q][j].z * xv[q][j].z + xv[q][j].w * xv[q][j].w);
            const float rstd = 1.0f / sqrtf(wave_sum(sq) * (1.0f / 1024.0f) + EPS); v2u* o8 = (v2u*)(HN + (size_t)mm * 1024) + lane;
#pragma unroll
            for (int j = 0; j < 4; ++j) { const f32x4 y = xv[q][j] * rstd * gg[j]; o8[64 * j] = (v2u){pk2(y.x, y.y), pk2(y.z, y.w)}; } } } }
      for (int m = TR + F.gw; m < TR + NMETA; m += F.NGW) norm_row_bf16(in[I_META] + (size_t)(m - TR) * 1024, gain0, HN + (size_t)m * 1024, lane); }
    for (long i = F.gt; i < NMETA * 1024; i += F.NGT) hmeta[i] = in[I_META][i];
}
__device__ __forceinline__ void norm_phase(const Frame& F, const bf16* HB, const float* hmeta, const float* gain, bf16* HN, int nrows) {
    const int lane = F.lane; const f32x4 g0 = *(const f32x4*)(gain + 8 * lane), g1 = *(const f32x4*)(gain + 8 * lane + 4), g2 = *(const f32x4*)(gain + 512 + 8 * lane), g3 = *(const f32x4*)(gain + 512 + 8 * lane + 4);
    for (int m = F.gw; m < TR; m += 4 * F.NGW) { v4u xa[4], xb[4];
#pragma unroll
        for (int q = 0; q < 4; ++q) { const int mm = m + q * F.NGW; if (mm < TR) { xa[q] = *(const v4u*)(HB + (size_t)mm * 1024 + 8 * lane); xb[q] = *(const v4u*)(HB + (size_t)mm * 1024 + 512 + 8 * lane); } }
#pragma unroll
        for (int q = 0; q < 4; ++q) { const int mm = m + q * F.NGW; if (mm < TR) { f32x4 v[4]; unpack8(xa[q], v[0], v[1]); unpack8(xb[q], v[2], v[3]); float sq = 0.f;
#pragma unroll
            for (int j = 0; j < 4; ++j) sq += (v[j].x * v[j].x + v[j].y * v[j].y) + (v[j].z * v[j].z + v[j].w * v[j].w);
            const float rstd = 1.0f / sqrtf(wave_sum(sq) * (1.0f / 1024.0f) + EPS);
            *(v4u*)(HN + (size_t)mm * 1024 + 8 * lane) = pack8(v[0] * rstd * g0, v[1] * rstd * g1); *(v4u*)(HN + (size_t)mm * 1024 + 512 + 8 * lane) = pack8(v[2] * rstd * g2, v[3] * rstd * g3); } } }
    for (int m = TR + F.gw; m < nrows; m += F.NGW) norm_row_bf16(hmeta + (size_t)(m - TR) * 1024, gain, HN + (size_t)m * 1024, F.lane);
}
__device__ __forceinline__ float row16_sum(float q) {
    q += __builtin_bit_cast(float, __builtin_amdgcn_update_dpp(0, __builtin_bit_cast(int, q), 0xB1, 0xF, 0xF, true));
    q += __builtin_bit_cast(float, __builtin_amdgcn_update_dpp(0, __builtin_bit_cast(int, q), 0x4E, 0xF, 0xF, true));
    q += __builtin_bit_cast(float, __builtin_amdgcn_update_dpp(0, __builtin_bit_cast(int, q), 0x141, 0xF, 0xF, true));
    q += __builtin_bit_cast(float, __builtin_amdgcn_update_dpp(0, __builtin_bit_cast(int, q), 0x140, 0xF, 0xF, true));
    return q;
}
__device__ __forceinline__ int cu_queue_next(LAS int* q, int lane) { int v = 0; if (lane == 0) v = __hip_atomic_fetch_add(q, 1, __ATOMIC_RELAXED, __HIP_MEMORY_SCOPE_WORKGROUP); return __builtin_amdgcn_readfirstlane(v); }
__device__ __forceinline__ const bf16* meta_norm_local(const Frame& F, unsigned char* ws, const float* hmeta) {
    bf16* priv = (bf16*)(ws + WS_MPRIV) + (size_t)blockIdx.x * NMETA * 1024;
    for (int r = F.wave; r < NMETA; r += 8) { const f32x4* xr = (const f32x4*)(hmeta + (size_t)r * 1024) + F.lane; f32x4 v[4]; float sq = 0.f;
#pragma unroll
        for (int j = 0; j < 4; ++j) { v[j] = xr[64 * j]; sq += (v[j].x * v[j].x + v[j].y * v[j].y) + (v[j].z * v[j].z + v[j].w * v[j].w); }
        const float rstd = 1.0f / sqrtf(wave_sum(sq) * (1.0f / 1024.0f) + EPS); v2u* o8 = (v2u*)(priv + (size_t)r * 1024) + F.lane;
#pragma unroll
        for (int j = 0; j < 4; ++j) { const f32x4 y = v[j] * rstd; o8[64 * j] = (v2u){pk2(y.x, y.y), pk2(y.z, y.w)}; } }
    asm volatile("s_waitcnt vmcnt(0)" ::: "memory"); __syncthreads();
    return priv;
}
__device__ __forceinline__ int seq_prev(int row, int back) {
    if (row >= TR) { const int i = row - TR - back; return i >= 0 ? TR + i : -1; }
    const int t = row & (SEQ - 1); return t >= back ? row - back : TR + NMETA + (t - back);
}
__device__ __forceinline__ void conv_item(int i, const bf16* XR, const float* cw, const float* cb, bf16* XC) {
    if (i < (TR / 32 + 1) * 128) { const int c = (int)(i & 127) * 8, st = (int)(i >> 7); const bool meta = st >= TR / 32; const int r0 = meta ? RM0 : st * 32, nr = meta ? NMETA : 32;
        f32x4 w[4][2]; f32x4 b0 = *(const f32x4*)(cb + c), b1 = *(const f32x4*)(cb + c + 4);
#pragma unroll
        for (int k = 0; k < 4; ++k) { w[k][0] = *(const f32x4*)(cw + k * 1024 + c); w[k][1] = *(const f32x4*)(cw + k * 1024 + c + 4); }
        f32x4 h[3][2];
#pragma unroll
        for (int k = 0; k < 3; ++k) { const int src = seq_prev(r0, 3 - k); if (src >= 0) unpack8(*(const v4u*)(XR + (size_t)src * 1024 + c), h[k][0], h[k][1]); else { h[k][0] = (f32x4){0.f, 0.f, 0.f, 0.f}; h[k][1] = h[k][0]; } }
        for (int t0 = 0; t0 < nr; t0 += 8) { v4u x[8];
#pragma unroll
            for (int t = 0; t < 8; ++t) x[t] = *(const v4u*)(XR + (size_t)(r0 + t0 + t) * 1024 + c);
#pragma unroll
            for (int t = 0; t < 8; ++t) { f32x4 c0, c1; unpack8(x[t], c0, c1);
                const f32x4 o0 = b0 + w[0][0] * h[0][0] + w[1][0] * h[1][0] + w[2][0] * h[2][0] + w[3][0] * c0, o1 = b1 + w[0][1] * h[0][1] + w[1][1] * h[1][1] + w[2][1] * h[2][1] + w[3][1] * c1;
                *(v4u*)(XC + (size_t)(r0 + t0 + t) * 1024 + c) = pack8(o0, o1);
                h[0][0] = h[1][0]; h[0][1] = h[1][1]; h[1][0] = h[2][0]; h[1][1] = h[2][1]; h[2][0] = c0; h[2][1] = c1; } } }
}
__device__ __forceinline__ void conv_fix_item(int i, const bf16* XR, const float* cw, const float* cb, bf16* XC) {
    if (i < (TR / 64) * 128) { const int c = (i & 127) * 8, r0 = (i >> 7) * 64;
        f32x4 w[4][2]; const f32x4 b0 = *(const f32x4*)(cb + c), b1 = *(const f32x4*)(cb + c + 4);
#pragma unroll
        for (int k = 0; k < 4; ++k) { w[k][0] = *(const f32x4*)(cw + k * 1024 + c); w[k][1] = *(const f32x4*)(cw + k * 1024 + c + 4); }
        v4u hx[3], xx[3];
#pragma unroll
        for (int k = 0; k < 3; ++k) { const int src = seq_prev(r0, 3 - k); hx[k] = *(const v4u*)(XR + (size_t)src * 1024 + c); xx[k] = *(const v4u*)(XR + (size_t)(r0 + k) * 1024 + c); }
        f32x4 h[3][2];
#pragma unroll
        for (int k = 0; k < 3; ++k) unpack8(hx[k], h[k][0], h[k][1]);
#pragma unroll
        for (int t = 0; t < 3; ++t) { f32x4 c0, c1; unpack8(xx[t], c0, c1);
            const f32x4 o0 = b0 + w[0][0] * h[0][0] + w[1][0] * h[1][0] + w[2][0] * h[2][0] + w[3][0] * c0, o1 = b1 + w[0][1] * h[0][1] + w[1][1] * h[1][1] + w[2][1] * h[2][1] + w[3][1] * c1;
            *(v4u*)(XC + (size_t)(r0 + t) * 1024 + c) = pack8(o0, o1);
            h[0][0] = h[1][0]; h[0][1] = h[1][1]; h[1][0] = h[2][0]; h[1][1] = h[2][1]; h[2][0] = c0; h[2][1] = c1; } }
}
constexpr int SSM_HP = 68, SSM_XP = 132;
constexpr int SSM_WLDS = 16 * SSM_XP * 4 + 16 * SSM_HP * 4;
struct SsmTab { float ar, ai; bf16x8 axf[8]; bf16x8 ca[4]; f32x4 dv; };
__device__ __forceinline__ void ssm_tab_load(SsmTab& T, const unsigned char* ws, const float* cre, const float* cim, const float* sd, int g, int lane) {
    const float* tab = (const float*)(ws + WS_TAB); const int gn = g * NS + lane, fr = lane & 15, fq = lane >> 4;
    T.ar = ((const float*)((const char*)tab + TB_AR))[gn]; T.ai = ((const float*)((const char*)tab + TB_AI))[gn];
#pragma unroll
    for (int rb = 0; rb < 8; ++rb) { const int r = 16 * rb + fr, n = r >> 1; const float* src = (const float*)((const char*)tab + ((r & 1) ? TB_BBI : TB_BBR)) + (size_t)(g * NS + n) * 16 + 8 * (fq & 1);
        v4u w = pack8(*(const f32x4*)src, *(const f32x4*)(src + 4)); if (fq >= 2) w = (v4u){0u, 0u, 0u, 0u}; T.axf[rb] = __builtin_bit_cast(bf16x8, w); }
#pragma unroll
    for (int ks = 0; ks < 4; ++ks) { const int n0 = 16 * ks + 4 * fq; const f32x4 cr = *(const f32x4*)(cre + (g * 16 + fr) * NS + n0), ci = *(const f32x4*)(cim + (g * 16 + fr) * NS + n0);
        v4u w; w.x = pk2(cr[0], -ci[0]); w.y = pk2(cr[1], -ci[1]); w.z = pk2(cr[2], -ci[2]); w.w = pk2(cr[3], -ci[3]); T.ca[ks] = __builtin_bit_cast(bf16x8, w); }
    T.dv = *(const f32x4*)(sd + g * 16 + 4 * fq);
}
__device__ __forceinline__ void ssm_wave(const SsmTab& T, const bf16* U, bf16* GS, int g, int row0, int ntok, float& hr, float& hi, int lane, LAS unsigned char* wl) {
    LAS float* xb = (LAS float*)wl; LAS unsigned* hb = (LAS unsigned*)(wl + 16 * SSM_XP * 4);
    const int fr = lane & 15, fq = lane >> 4; const float ar = T.ar, ai = T.ai;
    const f32x4 dv = T.dv;
    const bf16* ubase = U + (size_t)(row0 + fr) * 512 + g * 16;
    v4u bnx = {0u, 0u, 0u, 0u}; if (fq < 2) bnx = *(const v4u*)(ubase + 8 * fq);
    v2u unx = *(const v2u*)(ubase + 4 * fq);
    for (int t0 = 0; t0 < ntok; t0 += 16) {
        const v4u bw = bnx; const v2u uw = unx;
        if (t0 + 16 < ntok) { const bf16* un = ubase + (size_t)(t0 + 16) * 512; if (fq < 2) bnx = *(const v4u*)(un + 8 * fq); unx = *(const v2u*)(un + 4 * fq); }
        const bf16x8 bfr = __builtin_bit_cast(bf16x8, bw);
#pragma unroll
        for (int rb = 0; rb < 8; ++rb) { const f32x4 xa = __builtin_amdgcn_mfma_f32_16x16x32_bf16(T.axf[rb], bfr, (f32x4){0.f, 0.f, 0.f, 0.f}, 0, 0, 0); *(LAS f32x4*)(xb + fr * SSM_XP + 16 * rb + 4 * fq) = xa; }
        asm volatile("" ::: "memory");
#pragma unroll 4
        for (int tl = 0; tl < 16; ++tl) { const f32x2 x = *(const LAS f32x2*)(xb + tl * SSM_XP + 2 * lane);
            const float nr = ar * hr - ai * hi + x.x, ni = ar * hi + ai * hr + x.y; hr = nr; hi = ni;
            hb[tl * SSM_HP + lane] = pg8::cvt_pk_bf16(hr, hi); }
        asm volatile("" ::: "memory");
        f32x4 y = {0.f, 0.f, 0.f, 0.f};
#pragma unroll
        for (int ks = 0; ks < 4; ++ks) { const bf16x8 hbf = *(const LAS bf16x8*)(hb + fr * SSM_HP + 16 * ks + 4 * fq); y = __builtin_amdgcn_mfma_f32_16x16x32_bf16(T.ca[ks], hbf, y, 0, 0, 0); }
        const f32x4 go_ = gelu_tanh_4(y + dv * (f32x4){bflo(uw.x), bfhi(uw.x), bflo(uw.y), bfhi(uw.y)}); const float o0 = go_.x, o1 = go_.y, o2 = go_.z, o3 = go_.w;
        *(v2u*)(GS + (size_t)(row0 + t0 + fr) * 512 + g * 16 + 4 * fq) = (v2u){pk2(o0, o1), pk2(o2, o3)};
        asm volatile("" ::: "memory");
    }
    LDS_WAIT(); asm volatile("" ::: "memory");
}
__device__ __forceinline__ void ssm_l1_item(const Frame& F, int it, const unsigned char* ws, const bf16* U, float* SSE) {
    const int lane = F.lane, fr = lane & 15, fq = lane >> 4;
    if (it < NG * 32) { const int g = it >> 5, cb = it & 31, bc = cb * 16 + fr;
        const bf16* ap = (const bf16*)(ws + WS_WE) + ((size_t)g * 8 * 32 * 64 + lane) * 8;
        const bf16* bp = U + ((size_t)bc * 64 + (fq >> 1)) * 512 + g * 16 + 8 * (fq & 1);
        f32x4 acc[8];
#pragma unroll
        for (int rb = 0; rb < 8; ++rb) acc[rb] = (f32x4){0.f, 0.f, 0.f, 0.f};
#pragma unroll 4
        for (int ks = 0; ks < 32; ++ks) { const bf16x8 bfr = *(const bf16x8*)(bp + (size_t)ks * 2 * 512);
#pragma unroll
            for (int rb = 0; rb < 8; ++rb) { const bf16x8 afr = *(const bf16x8*)(ap + ((size_t)rb * 32 + ks) * 512); acc[rb] = __builtin_amdgcn_mfma_f32_16x16x32_bf16(afr, bfr, acc[rb], 0, 0, 0); } }
#pragma unroll
        for (int rb = 0; rb < 8; ++rb) *(f32x4*)(SSE + (((size_t)bc * NG + g) * NS + 8 * rb + 2 * fq) * 2) = acc[rb]; }
}
__device__ __forceinline__ void lru_l1_item(int lane, int bc, int ch, const bf16* A, const bf16* BX, float* PEND, float* HEND) {
    const int half = lane >> 5; const size_t r0 = (size_t)bc * 64 + half * 32;
    f32x4 P0 = {0.f, 0.f, 0.f, 0.f}, P1 = P0, H0 = P0, H1 = P0;
    for (int t0 = 0; t0 < 32; t0 += 8) { v4u la[8], bx[8];
#pragma unroll
        for (int t = 0; t < 8; ++t) { la[t] = *(const v4u*)(A + (r0 + t0 + t) * 1024 + ch); bx[t] = *(const v4u*)(BX + (r0 + t0 + t) * 1024 + ch); }
#pragma unroll
        for (int t = 0; t < 8; ++t) { f32x4 l0, l1, b0, b1; unpack8(la[t], l0, l1); unpack8(bx[t], b0, b1); P0 += l0; P1 += l1;
            H0 = exp2_4(l0 * 1.4426950408889634f) * H0 + b0; H1 = exp2_4(l1 * 1.4426950408889634f) * H1 + b1; } }
    f32x4 oP0, oP1, oH0, oH1;
#pragma unroll
    for (int j = 0; j < 4; ++j) { oP0[j] = __shfl_xor(P0[j], 32); oP1[j] = __shfl_xor(P1[j], 32); oH0[j] = __shfl_xor(H0[j], 32); oH1[j] = __shfl_xor(H1[j], 32); }
    if (half) {
#pragma unroll
        for (int j = 0; j < 4; ++j) { H0[j] = H0[j] + __expf(P0[j]) * oH0[j]; H1[j] = H1[j] + __expf(P1[j]) * oH1[j]; P0[j] = __expf(P0[j] + oP0[j]); P1[j] = __expf(P1[j] + oP1[j]); }
        float* pp = PEND + (size_t)bc * 1024 + ch; float* hp = HEND + (size_t)bc * 1024 + ch; *(f32x4*)pp = P0; *(f32x4*)(pp + 4) = P1; *(f32x4*)hp = H0; *(f32x4*)(hp + 4) = H1; }
}
__device__ __forceinline__ void carry_phase(const Frame& F, const unsigned char* ws, const bf16* A, const bf16* BX, const float* PEND, const float* HEND, float* CIN, const bf16* U, const float* SSE, float* SSIN) {
    const int gti = (F.wave * F.G + (int)blockIdx.x) * 64 + F.lane;
    if (gti < NB * 1024) { const int ch = gti & 1023, b = gti >> 10; float H = 0.f;
        { float ma[NMETA], mb[NMETA];
#pragma unroll
          for (int i = 0; i < NMETA; ++i) { const size_t r = (size_t)(RM0 + i); ma[i] = bf2f(A[r * 1024 + ch]); mb[i] = bf2f(BX[r * 1024 + ch]); }
#pragma unroll
          for (int i = 0; i < NMETA; ++i) H = __expf(ma[i]) * H + mb[i]; }
        for (int c0 = 0; c0 < NCH; c0 += 32) { float pp[32], hh[32];
#pragma unroll
            for (int c = 0; c < 32; ++c) { const size_t o = ((size_t)b * NCH + c0 + c) * 1024 + ch; pp[c] = PEND[o]; hh[c] = HEND[o]; }
#pragma unroll
            for (int c = 0; c < 32; ++c) { const size_t o = ((size_t)b * NCH + c0 + c) * 1024 + ch; CIN[o] = H; H = hh[c] + pp[c] * H; } }
    } else if (gti >= 8 * 512 && gti < 8 * 512 + NB * NG * NS) { const int id = gti - 8 * 512, n = id % NS, g = (id / NS) % NG, b = id / (NS * NG), gn = g * NS + n;
        const float* tab = (const float*)(ws + WS_TAB);
        const float ar = ((const float*)((const char*)tab + TB_AR))[gn], ai = ((const float*)((const char*)tab + TB_AI))[gn], ar64 = ((const float*)((const char*)tab + TB_AR64))[gn], ai64 = ((const float*)((const char*)tab + TB_AI64))[gn];
        float hr = 0.f, hi = 0.f;
        { f32x4 br[4], bi[4];
#pragma unroll
          for (int q = 0; q < 4; ++q) { br[q] = *(const f32x4*)((const char*)tab + TB_BBR + ((size_t)gn * 16 + 4 * q) * 4); bi[q] = *(const f32x4*)((const char*)tab + TB_BBI + ((size_t)gn * 16 + 4 * q) * 4); }
          for (int i0 = 0; i0 < NMETA; i0 += 8) { v4u uu[8][2];
#pragma unroll
            for (int i = 0; i < 8; ++i) { const bf16* up = U + (size_t)(RM0 + i0 + i) * 512 + g * 16; uu[i][0] = *(const v4u*)up; uu[i][1] = *(const v4u*)(up + 8); }
#pragma unroll
            for (int i = 0; i < 8; ++i) { f32x4 u0, u1, u2, u3; unpack8(uu[i][0], u0, u1); unpack8(uu[i][1], u2, u3); float xr = 0.f, xi = 0.f;
#pragma unroll
                for (int j = 0; j < 4; ++j) { xr += br[0][j] * u0[j]; xi += bi[0][j] * u0[j]; }
#pragma unroll
                for (int j = 0; j < 4; ++j) { xr += br[1][j] * u1[j]; xi += bi[1][j] * u1[j]; }
#pragma unroll
                for (int j = 0; j < 4; ++j) { xr += br[2][j] * u2[j]; xi += bi[2][j] * u2[j]; }
#pragma unroll
                for (int j = 0; j < 4; ++j) { xr += br[3][j] * u3[j]; xi += bi[3][j] * u3[j]; }
                const float nr = ar * hr - ai * hi + xr, ni = ar * hi + ai * hr + xi; hr = nr; hi = ni; } } }
        for (int c0 = 0; c0 < NCH; c0 += 32) { f32x2 ee[32];
#pragma unroll
            for (int c = 0; c < 32; ++c) ee[c] = ((const f32x2*)SSE)[(((size_t)b * NCH + c0 + c) * NG + g) * NS + n];
#pragma unroll
            for (int c = 0; c < 32; ++c) { ((f32x2*)SSIN)[(((size_t)b * NCH + c0 + c) * NG + g) * NS + n] = (f32x2){hr, hi};
                const float nr = ar64 * hr - ai64 * hi + ee[c].x, ni = ar64 * hi + ai64 * hr + ee[c].y; hr = nr; hi = ni; } }
    }
}
__device__ __forceinline__ void mix0_final_phase(const Frame& F, const unsigned char* ws, const bf16* A, const bf16* BX, const float* CIN, const bf16* G, bf16* AOUT, const float* cre, const float* cim, const float* sd, const bf16* U, const float* SSIN, bf16* GS) {
    LAS int* q = (LAS int*)(F.lds + TABL_OFF); if (F.tid == 0) *q = 0; __syncthreads();
    const int cu = (int)blockIdx.x, NLW = (NB * NCH * 128 + 128) / 64, NLQ = (NLW + F.G - 1) / F.G, NSI = NB * NCH * NG + NG, NSQ = (NSI + F.G - 1) / F.G;
    SsmTab T; int gcur = -1;
    for (;;) { const int e = cu_queue_next(q, F.lane); if (e >= NLQ + NSQ) break;
      if (e < NLQ) { const int wi = cu + F.G * e; if (wi < NLW) { const int i = wi * 64 + F.lane; const int ch = (int)(i & 127) * 8, bc = (int)(i >> 7); const bool meta = bc >= NB * NCH;
        const size_t r0 = meta ? (size_t)RM0 : (size_t)bc * 64; const int nt = meta ? NMETA : 64; f32x4 H0 = {0.f, 0.f, 0.f, 0.f}, H1 = H0;
        if (!meta) { H0 = *(const f32x4*)(CIN + (size_t)bc * 1024 + ch); H1 = *(const f32x4*)(CIN + (size_t)bc * 1024 + ch + 4); }
        for (int t0 = 0; t0 < nt; t0 += 8) { v4u la[8], bx[8], gg[8];
#pragma unroll
            for (int t = 0; t < 8; ++t) { const size_t r = r0 + t0 + t; la[t] = *(const v4u*)(A + r * 1024 + ch); bx[t] = *(const v4u*)(BX + r * 1024 + ch); gg[t] = *(const v4u*)(G + r * 1024 + ch); }
#pragma unroll
            for (int t = 0; t < 8; ++t) { f32x4 l0, l1, b0, b1, g0, g1; unpack8(la[t], l0, l1); unpack8(bx[t], b0, b1); unpack8(gg[t], g0, g1);
                H0 = exp2_4(l0 * 1.4426950408889634f) * H0 + b0; H1 = exp2_4(l1 * 1.4426950408889634f) * H1 + b1;
                *(v4u*)(AOUT + (r0 + t0 + t) * 1536 + ch) = pack8(g0 * H0, g1 * H1); } } }
      } else { const int it = cu + F.G * (e - NLQ); if (it < NSI) { const bool meta = it >= NB * NCH * NG; const int g = it % NG, bc = it / NG;
        if (g != gcur) { ssm_tab_load(T, ws, cre, cim, sd, g, F.lane); gcur = g; }
        float hr = 0.f, hi = 0.f; if (!meta) { const f32x2 s_ = ((const f32x2*)SSIN)[(size_t)it * NS + F.lane]; hr = s_.x; hi = s_.y; }
        ssm_wave(T, U, GS, g, meta ? RM0 : bc * 64, meta ? NMETA : 64, hr, hi, F.lane, F.lds + RING_OFF + F.wave * SSM_WLDS); } }
    }
}
template <int NACC>
__device__ __forceinline__ void meta_tile(const Frame& F, const bf16* A16, int lda, int K, const bf16* const (&Brow)[NACC], int ldb, f32x4 (&out)[NACC]) {
    LAS f32x4* red = (LAS f32x4*)(F.lds + RING_OFF);
    const int lane = F.lane, fr = lane & 15, fq = lane >> 4, w = F.wave, ks = K / 8;
    f32x4 acc[NACC];
#pragma unroll
    for (int a = 0; a < NACC; ++a) acc[a] = (f32x4){0.f, 0.f, 0.f, 0.f};
#pragma unroll 4
    for (int k0 = w * ks; k0 < (w + 1) * ks; k0 += 32) {
        const bf16x8 af = *(const bf16x8*)(A16 + (size_t)fr * lda + k0 + 8 * fq);
#pragma unroll
        for (int a = 0; a < NACC; ++a) { const bf16x8 bfz = *(const bf16x8*)(Brow[a] + (size_t)fr * ldb + k0 + 8 * fq); acc[a] = __builtin_amdgcn_mfma_f32_16x16x32_bf16(bfz, af, acc[a], 0, 0, 0); } }
    __syncthreads();
#pragma unroll
    for (int a = 0; a < NACC; ++a) red[(w * NACC + a) * 64 + lane] = acc[a];
    __syncthreads();
#pragma unroll
    for (int a = 0; a < NACC; ++a) { f32x4 sacc = red[a * 64 + lane];
#pragma unroll
        for (int ww = 1; ww < 8; ++ww) sacc += red[(ww * NACC + a) * 64 + lane];
        out[a] = sacc; }
}
template <class Fn> __device__ __forceinline__ bf16x8 frag8(Fn f) { bf16x8 r;
#pragma unroll
    for (int j = 0; j < 8; ++j) r[j] = (short)f(j);
    return r; }
constexpr int GL_LB = 0, GL_QT = 32768, GL_KT = 50176, GL_KH = 67584, GL_VT = 86016, GL_GM = 120832, GL_BL = 121344, GL_SSQ = 121856, GL_TQ = 123904;
constexpr int PQ = 136, PKH = 144, PV = 272, PATT = 72, POT = 264;
#define TR_FRAG(dst, base, off, rows4) do { v2u _lo, _hi; \
    asm volatile("ds_read_b64_tr_b16 %0, %2 offset:%c3\n\tds_read_b64_tr_b16 %1, %2 offset:%c4\n\ts_waitcnt lgkmcnt(0)" : "=&v"(_lo), "=&v"(_hi) : "v"(base), "i"(off), "i"((off) + (rows4)) : "memory"); \
    const v4u _w = {_lo.x, _lo.y, _hi.x, _hi.y}; dst = __builtin_bit_cast(bf16x8, _w); } while (0)
__device__ __forceinline__ unsigned lds_addr(const LAS void* p) { return (unsigned)(unsigned long)p; }
template <bool FINAL>
__device__ __forceinline__ void gla_item(const Frame& F, int b, int h, int s, const bf16* Q, const bf16* K, const bf16* V, const bf16* GATE, const bf16* LG, const float* gnorm, bf16* GDS, float* GAM, bf16* AOUT2) {
    LAS float* LB = (LAS float*)(F.lds + GL_LB); LAS bf16* ATT = (LAS bf16*)(F.lds + GL_LB);
    LAS bf16* QT = (LAS bf16*)(F.lds + GL_QT); LAS bf16* KT = (LAS bf16*)(F.lds + GL_KT); LAS bf16* KH = (LAS bf16*)(F.lds + GL_KH); LAS bf16* VT = (LAS bf16*)(F.lds + GL_VT);
    LAS float* GM = (LAS float*)(F.lds + GL_GM); LAS float* BL = (LAS float*)(F.lds + GL_BL); LAS float* SSQ = (LAS float*)(F.lds + GL_SSQ);
    const int tid = F.tid, w = F.wave, lane = F.lane, fr = lane & 15, h4 = lane >> 4, tq = fr >> 2, tp = fr & 3;
    const int bh = b * GH + h; const size_t sbase = ((size_t)(bh * NSEG + s) * 128) * 256;
    const unsigned vtr = lds_addr(VT) + (unsigned)((8 * h4 + tq) * PV + 32 * w + 4 * tp) * 2u;
    const unsigned ktr = lds_addr(KH) + (unsigned)((8 * h4 + tq) * PKH + 4 * tp) * 2u;
    f32x4 S[8][2];
    bf16* simg = GDS + sbase + ((size_t)w * 64 + lane) * 64;
#pragma unroll
    for (int kb = 0; kb < 8; ++kb) { if (FINAL) unpack8(*(const v4u*)(simg + 8 * kb), S[kb][0], S[kb][1]); else { S[kb][0] = (f32x4){0.f, 0.f, 0.f, 0.f}; S[kb][1] = S[kb][0]; } }
    float gsum = 0.f;
    LAS float* TQ = (LAS float*)(F.lds + GL_TQ);
    v4u pfl[2], pfv[4], pfk[2], pfq[2];
    const unsigned vo_lg = (unsigned)(((tid >> 5) * 512 + (tid & 31) * 4) * 4), vo_kq = (unsigned)(((tid >> 4) * 512 + (tid & 15) * 8) * 2), vo_v = (unsigned)(((tid >> 5) * 1024 + (tid & 31) * 8) * 2);
    const int lo_lb = (tid >> 5) * 128 + (tid & 31) * 4, lo_vt = (tid >> 5) * PV + (tid & 31) * 8, lo_ot = (tid >> 5) * POT + (tid & 31) * 8, t3 = tid >> 4, k8 = (tid & 15) * 8;
#define GLA_LOAD(cc, dep) do { const size_t r0n = (size_t)b * SEQ + (size_t)(s * SEGC + (cc)) * 64; unsigned pin_ = 0; asm volatile("" : "+v"(pin_) : "v"(dep));   \
        _Pragma("unroll") for (int j = 0; j < 2; ++j) pfl[j] = *(const v4u*)((const char*)(LG + (r0n + 32 * j) * 512 + h * 128) + (vo_kq + pin_)); \
        _Pragma("unroll") for (int j = 0; j < 2; ++j) { pfk[j] = *(const v4u*)((const char*)(K + (r0n + 32 * j) * 512 + h * 128) + (vo_kq + pin_)); if (FINAL) pfq[j] = *(const v4u*)((const char*)(Q + (r0n + 32 * j) * 512 + h * 128) + (vo_kq + pin_)); } } while (0)
#define GLA_LOADV(cc, dep) do { const size_t r0n = (size_t)b * SEQ + (size_t)(s * SEGC + (cc)) * 64; unsigned pin_ = 0; asm volatile("" : "+v"(pin_) : "v"(dep)); \
        _Pragma("unroll") for (int j = 0; j < 4; ++j) pfv[j] = *(const v4u*)((const char*)(V + (r0n + 16 * j) * 1024 + h * 256) + (vo_v + pin_)); } while (0)
#define GLA_STEP6() do { \
        _Pragma("unroll") for (int kb = 0; kb < 8; ++kb) { const f32x4 gm = *(const LAS f32x4*)(GM + 16 * kb + 4 * h4); \
            _Pragma("unroll") for (int vb = 0; vb < 2; ++vb) S[kb][vb] = S[kb][vb] * gm; } \
        _Pragma("unroll") for (int ts = 0; ts < 2; ++ts) { bf16x8 bv[2]; \
            _Pragma("unroll") for (int vb = 0; vb < 2; ++vb) TR_FRAG(bv[vb], vtr, (32 * ts * PV + 16 * vb) * 2, 4 * PV * 2); \
            _Pragma("unroll") for (int kb = 0; kb < 8; ++kb) { bf16x8 a; TR_FRAG(a, ktr, (32 * ts * PKH + 16 * kb) * 2, 4 * PKH * 2); \
                _Pragma("unroll") for (int vb = 0; vb < 2; ++vb) S[kb][vb] = __builtin_amdgcn_mfma_f32_16x16x32_bf16(a, bv[vb], S[kb][vb], 0, 0, 0); } } } while (0)
    GLA_LOAD(0, gsum); GLA_LOADV(0, gsum);
#pragma unroll
    for (int j = 0; j < 2; ++j) { f32x4 l0_, l1_; unpack8(pfl[j], l0_, l1_); *(LAS f32x4*)(LB + (t3 + 32 * j) * 128 + k8) = l0_; *(LAS f32x4*)(LB + (t3 + 32 * j) * 128 + k8 + 4) = l1_; }
    __syncthreads();
#pragma nounroll
    for (int c = 0; c < SEGC; ++c) {
        const size_t row0 = (size_t)b * SEQ + (size_t)(s * SEGC + c) * 64;
        v4u kwr[2], qwr[2];
#pragma unroll
        for (int j = 0; j < 2; ++j) { kwr[j] = pfk[j]; if (FINAL) qwr[j] = pfq[j]; }
        if (!FINAL) { if (c + 1 < SEGC) GLA_LOAD(c + 1, __uint_as_float(kwr[1].w)); }
        { const int kc = tid & 127, qt_ = tid >> 7; float xs[16];
#pragma unroll
          for (int t = 0; t < 16; ++t) xs[t] = LB[(16 * qt_ + t) * 128 + kc];
          asm volatile("" ::: "memory");
#pragma unroll
          for (int t = 1; t < 16; ++t) xs[t] += xs[t - 1];
          TQ[qt_ * 128 + kc] = xs[15];
          __syncthreads();
          const float t0_ = TQ[kc], t1_ = TQ[128 + kc], t2_ = TQ[256 + kc], t3_ = TQ[384 + kc];
          const float off = qt_ == 0 ? 0.f : qt_ == 1 ? t0_ : qt_ == 2 ? t0_ + t1_ : (t0_ + t1_) + t2_;
#pragma unroll
          for (int t = 0; t < 16; ++t) LB[(16 * qt_ + t) * 128 + kc] = xs[t] + off;
          if (qt_ == 0) { const float tot = ((t0_ + t1_) + t2_) + t3_; BL[kc] = tot; GM[kc] = __builtin_amdgcn_exp2f(tot); gsum += tot; } }
        __syncthreads();
#pragma unroll
        for (int j = 0; j < 4; ++j) *(LAS v4u*)(VT + lo_vt + j * 16 * PV) = pfv[j];
#pragma unroll
        for (int j = 0; j < 2; ++j) { const int t = t3 + 32 * j;
            f32x4 k0, k1; unpack8(kwr[j], k0, k1);
            const f32x4 b0 = *(const LAS f32x4*)(LB + t * 128 + k8), b1 = *(const LAS f32x4*)(LB + t * 128 + k8 + 4);
            if (!FINAL) { const f32x4 l0 = *(const LAS f32x4*)(BL + k8), l1 = *(const LAS f32x4*)(BL + k8 + 4);
                *(LAS v4u*)(KH + t * PKH + k8) = pack8(k0 * exp2_4(l0 - b0), k1 * exp2_4(l1 - b1)); }
            if (FINAL) { f32x4 q0, q1; unpack8(qwr[j], q0, q1);
                const f32x4 g0 = *(const LAS f32x4*)(GM + k8), g1 = *(const LAS f32x4*)(GM + k8 + 4);
                const f32x4 kt0 = k0 * exp2_4(b0 * -1.0f), kt1 = k1 * exp2_4(b1 * -1.0f);
                *(LAS v4u*)(KH + t * PKH + k8) = pack8(kt0 * g0, kt1 * g1);
                const int kp = (k8 & ~31) + 8 * ((k8 & 15) >> 2) + 4 * ((k8 >> 4) & 1);
                const v4u pq_ = pack8(q0 * exp2_4(b0), q1 * exp2_4(b1)), pk_ = pack8(kt0, kt1);
                *(LAS v2u*)(QT + t * PQ + kp) = (v2u){pq_.x, pq_.y}; *(LAS v2u*)(QT + t * PQ + kp + 8) = (v2u){pq_.z, pq_.w};
                *(LAS v2u*)(KT + t * PQ + kp) = (v2u){pk_.x, pk_.y}; *(LAS v2u*)(KT + t * PQ + kp + 8) = (v2u){pk_.z, pk_.w}; } }
        __syncthreads();
        if (!FINAL) { if (c + 1 < SEGC) GLA_LOADV(c + 1, gsum); }
        f32x4 o[4][2];
        if (FINAL) {
            { const int tb = w >> 1;
#pragma unroll
              for (int q = 0; q < 2; ++q) { const int sb = 2 * (w & 1) + q; f32x4 acc = {0.f, 0.f, 0.f, 0.f};
                if (sb <= tb) {
#pragma unroll
                    for (int ks = 0; ks < 4; ++ks) { const bf16x8 a = *(const LAS bf16x8*)(QT + (16 * tb + fr) * PQ + 32 * ks + 8 * h4), bq = *(const LAS bf16x8*)(KT + (16 * sb + fr) * PQ + 32 * ks + 8 * h4);
                        acc = __builtin_amdgcn_mfma_f32_16x16x32_bf16(a, bq, acc, 0, 0, 0); } }
#pragma unroll
                for (int r = 0; r < 4; ++r) { const int tl = 4 * h4 + r; const float val = (sb < tb || (sb == tb && fr <= tl)) ? acc[r] : 0.f; ATT[(16 * tb + tl) * PATT + 16 * sb + fr] = (bf16)f2bf(val); } } }
#pragma unroll
            for (int tb = 0; tb < 4; ++tb)
#pragma unroll
                for (int vb = 0; vb < 2; ++vb) o[tb][vb] = (f32x4){0.f, 0.f, 0.f, 0.f};
#pragma unroll
            for (int i = 0; i < 4; ++i) { bf16x8 bs[2];
#pragma unroll
                for (int vb = 0; vb < 2; ++vb) { v4u wv; wv.x = pk2(S[2 * i][vb][0], S[2 * i][vb][1]); wv.y = pk2(S[2 * i][vb][2], S[2 * i][vb][3]); wv.z = pk2(S[2 * i + 1][vb][0], S[2 * i + 1][vb][1]); wv.w = pk2(S[2 * i + 1][vb][2], S[2 * i + 1][vb][3]); bs[vb] = __builtin_bit_cast(bf16x8, wv); }
#pragma unroll
                for (int tb = 0; tb < 4; ++tb) { const bf16x8 a = *(const LAS bf16x8*)(QT + (16 * tb + fr) * PQ + 32 * i + 8 * h4);
#pragma unroll
                    for (int vb = 0; vb < 2; ++vb) o[tb][vb] = __builtin_amdgcn_mfma_f32_16x16x32_bf16(a, bs[vb], o[tb][vb], 0, 0, 0); } }
            __syncthreads();
#pragma unroll
            for (int ss = 0; ss < 2; ++ss) { bf16x8 bv[2];
#pragma unroll
                for (int vb = 0; vb < 2; ++vb) TR_FRAG(bv[vb], vtr, (32 * ss * PV + 16 * vb) * 2, 4 * PV * 2);
#pragma unroll
                for (int tb = 0; tb < 4; ++tb) { if (ss == 1 && tb < 2) continue;
                    const bf16x8 a = *(const LAS bf16x8*)(ATT + (16 * tb + fr) * PATT + 32 * ss + 8 * h4);
#pragma unroll
                    for (int vb = 0; vb < 2; ++vb) o[tb][vb] = __builtin_amdgcn_mfma_f32_16x16x32_bf16(a, bv[vb], o[tb][vb], 0, 0, 0); } }
        }
        if (FINAL) {
            if (c + 1 < SEGC) GLA_LOAD(c + 1, o[3][1][3]);
            v4u gw[4]; int lzg = 0; asm volatile("" : "+v"(lzg) : "v"(o[3][0][3]));
#pragma unroll
            for (int j = 0; j < 4; ++j) gw[j] = *(const v4u*)((const char*)(GATE + (row0 + 16 * j) * 1024 + h * 256) + (vo_v + (unsigned)lzg));
            { f32x4 qs[4];
#pragma unroll
              for (int tb = 0; tb < 4; ++tb)
#pragma unroll
                for (int r = 0; r < 4; ++r) qs[tb][r] = row16_sum(o[tb][0][r] * o[tb][0][r] + o[tb][1][r] * o[tb][1][r]);
              if (fr == 0) {
#pragma unroll
                for (int tb = 0; tb < 4; ++tb) *(LAS f32x4*)(SSQ + w * 64 + 16 * tb + 4 * h4) = qs[tb]; } }
            asm volatile("" ::: "memory"); if (c + 1 < SEGC) GLA_LOADV(c + 1, gsum);
            GLA_STEP6();
            __syncthreads();
            { LAS bf16* OT = QT; const float gn0 = gnorm[h * 256 + 32 * w + fr], gn1 = gnorm[h * 256 + 32 * w + 16 + fr];
#pragma unroll
              for (int tb = 0; tb < 4; ++tb) { f32x4 tot4 = *(const LAS f32x4*)(SSQ + 16 * tb + 4 * h4);
#pragma unroll
                for (int ww = 1; ww < 8; ++ww) tot4 += *(const LAS f32x4*)(SSQ + ww * 64 + 16 * tb + 4 * h4);
                const f32x4 ms4 = tot4 * (1.0f / 256.0f) + EPS; f32x4 rs4;
#pragma unroll
                for (int r = 0; r < 4; ++r) rs4[r] = __builtin_amdgcn_rsqf(ms4[r]);
                const f32x4 oa = o[tb][0] * (rs4 * gn0), ob = o[tb][1] * (rs4 * gn1);
#pragma unroll
                for (int r = 0; r < 4; ++r) { const int t = 16 * tb + 4 * h4 + r;
                    const unsigned pw_ = pk2(oa[r], ob[r]);
                    ((LAS unsigned short*)OT)[t * POT + 32 * w + fr] = (unsigned short)pw_; ((LAS unsigned short*)OT)[t * POT + 32 * w + 16 + fr] = (unsigned short)(pw_ >> 16); asm volatile("" ::: "memory"); } }
              if (c + 1 < SEGC) {
#pragma unroll
            for (int j = 0; j < 2; ++j) { f32x4 l0_, l1_; unpack8(pfl[j], l0_, l1_); *(LAS f32x4*)(LB + (t3 + 32 * j) * 128 + k8) = l0_; *(LAS f32x4*)(LB + (t3 + 32 * j) * 128 + k8 + 4) = l1_; } }
              __syncthreads();
#pragma unroll
              for (int j = 0; j < 4; ++j) { f32x4 a0, a1, g0, g1; unpack8(*(const LAS v4u*)(OT + lo_ot + j * 16 * POT), a0, a1); unpack8(gw[j], g0, g1);
                  *(v4u*)((char*)(AOUT2 + (row0 + 16 * j) * 1024 + h * 256) + vo_v) = pack8(a0 * g0, a1 * g1); } }
        }
        if (!FINAL) { GLA_STEP6();
            if (c + 1 < SEGC) {
#pragma unroll
            for (int j = 0; j < 2; ++j) { f32x4 l0_, l1_; unpack8(pfl[j], l0_, l1_); *(LAS f32x4*)(LB + (t3 + 32 * j) * 128 + k8) = l0_; *(LAS f32x4*)(LB + (t3 + 32 * j) * 128 + k8 + 4) = l1_; } }
            __syncthreads(); }
    }
    if (FINAL) __syncthreads();
    if (!FINAL) {
#pragma unroll
        for (int kb = 0; kb < 8; ++kb) *(v4u*)(simg + 8 * kb) = pack8(S[kb][0], S[kb][1]);
        if (tid < 128) GAM[(size_t)(bh * NSEG + s) * 128 + tid] = __builtin_amdgcn_exp2f(gsum);
    }
}
__device__ __forceinline__ void gla_l2_phase(const Frame& F, const bf16* K, const bf16* V, const bf16* LG, bf16* GDS, const float* GAM) {
    for (int id = (F.wave * F.G + (int)blockIdx.x) * 64 + F.lane; id < NB * GH * 8 * 64 * 8; id += F.NGT) { const int kb = id & 7, ln = (id >> 3) & 63, w = (id >> 9) & 7, bh = id >> 12, h = bh & 3, fr = ln & 15, h4 = ln >> 4;
        const int k0 = 16 * kb + 4 * h4, v0 = 32 * w + fr;
        v2u lgm[NMETA]; f32x4 tot = {0.f, 0.f, 0.f, 0.f};
#pragma unroll
        for (int i = 0; i < NMETA; ++i) { lgm[i] = *(const v2u*)(LG + (size_t)(RM0 + i) * 512 + h * 128 + k0); tot += (f32x4){bflo(lgm[i].x), bfhi(lgm[i].x), bflo(lgm[i].y), bfhi(lgm[i].y)}; }
        f32x4 c0 = {0.f, 0.f, 0.f, 0.f}, c1 = c0, run = c0;
#pragma unroll
        for (int i = 0; i < NMETA; ++i) { run += (f32x4){bflo(lgm[i].x), bfhi(lgm[i].x), bflo(lgm[i].y), bfhi(lgm[i].y)};
            const v2u kw = *(const v2u*)(K + (size_t)(RM0 + i) * 512 + h * 128 + k0); const float va = bf2f(V[(size_t)(RM0 + i) * 1024 + h * 256 + v0]), vb_ = bf2f(V[(size_t)(RM0 + i) * 1024 + h * 256 + v0 + 16]);
            f32x4 wk; wk.x = __builtin_amdgcn_exp2f(tot.x - run.x) * bflo(kw.x); wk.y = __builtin_amdgcn_exp2f(tot.y - run.y) * bfhi(kw.x); wk.z = __builtin_amdgcn_exp2f(tot.z - run.z) * bflo(kw.y); wk.w = __builtin_amdgcn_exp2f(tot.w - run.w) * bfhi(kw.y);
            c0 += wk * va; c1 += wk * vb_; }
        bf16* img = GDS + ((size_t)bh * NSEG * 8 * 64 + (size_t)w * 64 + ln) * 64 + 8 * kb;
        for (int sh = 0; sh < NSEG; sh += 8) { v4u ds[8]; f32x4 gm[8];
#pragma unroll
            for (int s = 0; s < 8; ++s) { ds[s] = *(const v4u*)(img + (size_t)(sh + s) * 32768); gm[s] = *(const f32x4*)(GAM + (size_t)(bh * NSEG + sh + s) * 128 + k0); }
#pragma unroll
            for (int s = 0; s < 8; ++s) { *(v4u*)(img + (size_t)(sh + s) * 32768) = pack8(c0, c1); f32x4 d0, d1; unpack8(ds[s], d0, d1); c0 = c0 * gm[s] + d0; c1 = c1 * gm[s] + d1; } }
    }
}

__device__ __forceinline__ void router_phase(const Frame& F, const Args& a, unsigned char* ws) {
    const float* const* in = a.in; unsigned* ctl = (unsigned*)(ws + WS_CTL); bf16* HNM = (bf16*)(ws + WS_HNM); int* tokinfo = (int*)(ws + WS_TOKINFO);
    const float* gain = in[I_NORM_FFN1]; const float* RW = in[I_ROUTER]; const int lane = F.lane; const bf16* HB = (const bf16*)(ws + WS_HB); unsigned char* HN8 = (unsigned char*)(ws + WS_HNM);
    LAS unsigned* cnt = (LAS unsigned*)(F.lds + TABL_OFF);
    if (F.tid < 32) cnt[F.tid] = 0u;
    __syncthreads();
    const int per = (TR + F.G - 1) / F.G, m0 = (int)blockIdx.x * per, m1 = (m0 + per < TR) ? m0 + per : TR;
    int my_e0 = 0, my_e1 = 0; unsigned my_p0 = 0, my_p1 = 0; float my_w0 = 0.f;
    int jt = 0;
    LAS float* scr = (LAS float*)(F.lds + RING_OFF + F.wave * 16384);
    constexpr int IG = 16 * 112, ID = 56 * 32, IE = 2 * IG + ID;
    unsigned char* WGU = (unsigned char*)(ws + WS_WMOE); unsigned char* WD = WGU + (size_t)NE * 7168 * 1024;
    auto convert = [&](int it) { const int e = it / IE; int r = it % IE;
        if (r < 2 * IG) { const int up = r >= IG; if (up) r -= IG; const int kb = r / 112, n0 = (r % 112) * 32;
            tr_item8((up ? in[I_MU] : in[I_MG]) + (size_t)e * 1024 * FFE, FFE, n0, kb * 64, WGU + (size_t)e * 7168 * 1024, 1024, (n0 >> 7) * 256 + (n0 & 127) + (up ? 128 : 0), 32.0f, scr, lane); }
        else { r -= 2 * IG; const int kb = r / 32, n0 = (r % 32) * 32; tr_item8(in[I_MD] + (size_t)e * FFE * 1024, 1024, n0, kb * 64, WD + (size_t)e * 1024 * FFE, FFE, n0, 64.0f, scr, lane); } };
    int cit = F.gw;
    if (F.wave & 1) { for (int k = 0; k < 3 && cit < NE * IE; ++k, cit += F.NGW) convert(cit); }
    f32x4 rw[4][4][2], gv[4];
#pragma unroll
    for (int j = 0; j < 4; ++j) { const int d0 = (j >> 1) * 512 + 8 * lane + (j & 1) * 4; gv[j] = *(const f32x4*)(gain + d0);
#pragma unroll
        for (int e4 = 0; e4 < 4; ++e4) { rw[j][e4][0] = *(const f32x4*)(RW + (d0 + e4) * 8); rw[j][e4][1] = *(const f32x4*)(RW + (d0 + e4) * 8 + 4); } }
    v4u nxa = {0u, 0u, 0u, 0u}, nxb = nxa; if (m0 + F.wave < m1) { const bf16* hr0 = HB + (size_t)(m0 + F.wave) * 1024; nxa = *(const v4u*)(hr0 + 8 * lane); nxb = *(const v4u*)(hr0 + 512 + 8 * lane); }
    for (int m = m0 + F.wave; m < m1; m += 8, ++jt) {
        f32x4 v[4]; unpack8(nxa, v[0], v[1]); unpack8(nxb, v[2], v[3]); float s = 0.f;
        if (m + 8 < m1) { const bf16* hr1 = HB + (size_t)(m + 8) * 1024; nxa = *(const v4u*)(hr1 + 8 * lane); nxb = *(const v4u*)(hr1 + 512 + 8 * lane); }
#pragma unroll
        for (int j = 0; j < 4; ++j) s += (v[j].x * v[j].x + v[j].y * v[j].y) + (v[j].z * v[j].z + v[j].w * v[j].w);
        const float rstd = 1.0f / sqrtf(wave_sum(s) * (1.0f / 1024.0f) + EPS);
        f32x4 pA = {0.f, 0.f, 0.f, 0.f}, pB = pA;
        f32x4 yv[4];
#pragma unroll
        for (int j = 0; j < 4; ++j) { const f32x4 y = v[j] * rstd * gv[j]; yv[j] = y;
#pragma unroll
            for (int e4 = 0; e4 < 4; ++e4) { pA += rw[j][e4][0] * y[e4]; pB += rw[j][e4][1] * y[e4]; } }
        const float p[8] = {pA.x, pA.y, pA.z, pA.w, pB.x, pB.y, pB.z, pB.w};
        *(v2u*)(HN8 + (size_t)m * 1024 + 8 * lane) = (v2u){pk4_fp8(yv[0][0], yv[0][1], yv[0][2], yv[0][3]), pk4_fp8(yv[1][0], yv[1][1], yv[1][2], yv[1][3])};
        *(v2u*)(HN8 + (size_t)m * 1024 + 512 + 8 * lane) = (v2u){pk4_fp8(yv[2][0], yv[2][1], yv[2][2], yv[2][3]), pk4_fp8(yv[3][0], yv[3][1], yv[3][2], yv[3][3])};
        float q4[4];
#pragma unroll
        for (int i = 0; i < 4; ++i) { const bool up = (lane & 32) != 0; const float keep = up ? p[i + 4] : p[i], send = up ? p[i] : p[i + 4]; q4[i] = keep + __shfl_xor(send, 32); }
        float q2[2];
#pragma unroll
        for (int i = 0; i < 2; ++i) { const bool up = (lane & 16) != 0; const float keep = up ? q4[i + 2] : q4[i], send = up ? q4[i] : q4[i + 2]; q2[i] = keep + __shfl_xor(send, 16); }
        float y; { const bool up = (lane & 8) != 0; const float keep = up ? q2[1] : q2[0], send = up ? q2[0] : q2[1]; y = keep + __shfl_xor(send, 8); }
        y += __shfl_xor(y, 4); y += __shfl_xor(y, 2); y += __shfl_xor(y, 1);
        float lg[8];
#pragma unroll
        for (int e = 0; e < 8; ++e) lg[e] = __shfl(y, ((e >> 2) & 1) * 32 + ((e >> 1) & 1) * 16 + (e & 1) * 8);
        int i0 = 0; float v0 = lg[0];
#pragma unroll
        for (int e = 1; e < 8; ++e) if (lg[e] > v0) { v0 = lg[e]; i0 = e; }
        int i1 = -1; float v1 = -3.0e38f;
#pragma unroll
        for (int e = 0; e < 8; ++e) if (e != i0 && lg[e] > v1) { v1 = lg[e]; i1 = e; }
        if (i1 < 0) i1 = (i0 + 1) & 7;
        if (lane == jt) { my_e0 = i0; my_e1 = i1; my_w0 = 1.0f / (1.0f + __expf(v1 - v0)); my_p0 = atomicAdd((unsigned*)(cnt + i0), 1u); my_p1 = atomicAdd((unsigned*)(cnt + 8 + i1), 1u); }
    }
    __syncthreads();
    if (F.tid < 16) cnt[16 + F.tid] = __hip_atomic_fetch_add(ctl + CW_CNT + F.tid, cnt[F.tid], RLX_AGENT);
    __syncthreads();
    if (lane < jt) { const int m = m0 + F.wave + 8 * lane; const float w1 = 1.0f - my_w0;
        const unsigned q0 = cnt[16 + my_e0] + my_p0, q1 = cnt[24 + my_e1] + my_p1;
        *(v4u*)(tokinfo + (size_t)m * 4) = (v4u){(unsigned)my_e0, q0, __float_as_uint(my_w0), 0u};
        *(v4u*)(tokinfo + (size_t)(TR + m) * 4) = (v4u){(unsigned)my_e1, q1, __float_as_uint(w1), 0u};
        int* reltok = (int*)(ws + WS_RELTOK); float* relw = (float*)(ws + WS_RELW);
        reltok[(size_t)my_e0 * TR + q0] = m; relw[(size_t)my_e0 * TR + q0] = my_w0; reltok[(size_t)(8 + my_e1) * TR + q1] = m; relw[(size_t)(8 + my_e1) * TR + q1] = w1; }
    for (; cit < NE * IE; cit += F.NGW) convert(cit);
}
__device__ __forceinline__ void moe_lists_phase(const Frame& F, unsigned char* ws) {
    unsigned* ctl = (unsigned*)(ws + WS_CTL); LAS int* L = (LAS int*)(F.lds + TABL_OFF);
    const int* tokinfo = (const int*)(ws + WS_TOKINFO); int* rowtok = (int*)(ws + WS_ROWTOK); float* roww = (float*)(ws + WS_ROWW);
    int* pexp = (int*)(ws + WS_TAB + TB_PEXP); int* npan = (int*)(ws + WS_TAB + TB_NPAN);
    if (F.tid < 16) L[F.tid] = (int)__hip_atomic_load(ctl + CW_CNT + F.tid, RLX_AGENT);
    __syncthreads();
    if (F.tid == 0) { for (int s = 0; s < 2; ++s) { int acc = 0; for (int e = 0; e < 8; ++e) { L[16 + s * 8 + e] = acc; acc += (L[s * 8 + e] + 255) & ~255; } L[32 + s] = acc >> 8; } }
    __syncthreads();
    if (blockIdx.x == 0) { if (F.tid < 2) npan[F.tid] = L[32 + F.tid];
        if (F.tid < 16) { const int s = F.tid >> 3, base = L[16 + F.tid], n = (L[F.tid] + 255) >> 8; for (int p = 0; p < n; ++p) pexp[s * MPAN + (base >> 8) + p] = F.tid & 7; } }
    for (long i = F.gt; i < 2L * TR; i += F.NGT) { const int s = (int)(i >= TR), tok = (int)(i - (long)s * TR); const v4u inf = *(const v4u*)(tokinfo + i * 4);
        const int row = L[16 + s * 8 + (int)inf.x] + (int)inf.y; rowtok[(size_t)s * MROWS + row] = tok; const unsigned wb = inf.z; roww[(size_t)s * MROWS + row] = __uint_as_float(wb); }
    for (long i = F.gt; i < 16L * 256; i += F.NGT) { const int se = (int)(i >> 8), r = (int)(i & 255), s = se >> 3, cnt = L[se], base = L[16 + se], pad = ((cnt + 255) & ~255) - cnt;
        if (r < pad) { rowtok[(size_t)s * MROWS + base + cnt + r] = -1; roww[(size_t)s * MROWS + base + cnt + r] = 0.f; } }
}

__device__ __forceinline__ void fold_rstd_table(const Frame& F, const SchedStatic& S, const float* ssqp, LAS float* rst) {
    __syncthreads();
    for (int i = 0; i < FOLD_MAXU; ++i) { pg8::Unit u; if (!S.next(i, u)) break;
        if (F.tid < 256) rst[i * 256 + F.tid] = rstd_of(ssqp, (size_t)(u.pm * 256 + F.tid)); }
    __syncthreads();
}
__device__ __forceinline__ void moe_bases(const Frame& F, const unsigned char* ws, LAS int* ML) {
    const unsigned* ctl = (const unsigned*)(ws + WS_CTL);
    __syncthreads();
    if (F.tid < 16) ML[F.tid] = (int)__hip_atomic_load(ctl + CW_CNT + F.tid, RLX_AGENT);
    __syncthreads();
    if (F.tid == 0) { for (int s_ = 0; s_ < 2; ++s_) { int acc = 0; for (int e = 0; e < 8; ++e) { ML[16 + s_ * 8 + e] = acc; acc += (ML[s_ * 8 + e] + 255) & ~255; } ML[32 + s_] = acc >> 8; } }
    __syncthreads();
}
__device__ __forceinline__ int moe_panel_expert(const LAS int* ML, int slot, int p) { int e = 0;
#pragma unroll
    for (int k = 1; k < 8; ++k) e = (p * 256 >= ML[16 + slot * 8 + k]) ? k : e;
    return e; }
__device__ __forceinline__ int moe_row_token(const LAS int* ML, const unsigned char* ws, int slot, int e, int row, float* w) {
    const int rel = row - ML[16 + slot * 8 + e], cnt = ML[slot * 8 + e]; const bool ok = rel < cnt; const int rc = ok ? rel : (cnt > 0 ? cnt - 1 : 0);
    const int tok = ((const int*)(ws + WS_RELTOK))[(size_t)(slot * 8 + e) * TR + rc]; if (w) { const float wv = ((const float*)(ws + WS_RELW))[(size_t)(slot * 8 + e) * TR + rc]; *w = ok ? wv : 0.f; }
    return ok ? tok : -1; }
constexpr int N_PHASES = 25;
__global__ void __launch_bounds__(512, 2) mk_fwd(Args args) {
    extern __shared__ __attribute__((aligned(16))) unsigned char lds_raw[];
    Frame F; F.lds = (LAS unsigned char*)lds_raw; F.tid = threadIdx.x; F.lane = F.tid & 63; F.wave = __builtin_amdgcn_readfirstlane(F.tid >> 6); F.G = gridDim.x;
    F.gw = blockIdx.x * 8 + F.wave; F.NGW = F.G * 8; F.gt = (int)blockIdx.x * 512 + F.tid; F.NGT = F.G * 512;
    unsigned char* ws = args.ws; const float* const* in = args.in; float* out = args.out;
    volatile LAS unsigned* MISC = (volatile LAS unsigned*)(F.lds + MISC_OFF);
    if (F.tid < 32) MISC[F.tid] = 0u;
    __syncthreads();
#if !MK_PER_PHASE
    XcdBarrier bar = xcd_barrier_post((unsigned*)(ws + WS_CTL) + CW_BAR, MISC + 8);
#define GRID_BAR() xcd_barrier(bar)
#else
#define GRID_BAR() do { } while (0)
#endif
    const int lo = args.ph_lo, hi = args.ph_hi;
#ifndef MK_MASK
#define MK_MASK 0xFFFFFFFFu
#endif
#ifndef MK_STOP
#define MK_STOP 99
#endif
#define IN(k) ((((MK_MASK) >> (k)) & 1u) && ((k) <= MK_STOP || (k) == 24) && lo <= (k) && (k) < hi)
#ifdef MK_TP1
#define STAMP(k) do { if (blockIdx.x == 0 && F.tid == 0) ((unsigned long long*)(ws + WS_TAB + 900 * 1024))[(k) + 1] = __builtin_amdgcn_s_memrealtime(); } while (0)
#else
#define STAMP(k) do { } while (0)
#endif
#define SEAM(k) do { if (IN(k) && IN((k) + 1)) GRID_BAR(); STAMP(k); asm volatile("" : "+v"(F.tid), "+v"(F.lane), "+v"(F.gt)); } while (0)
    STAMP(-1);
    const int cu = (int)blockIdx.x;
    LAS unsigned char* ring = F.lds + RING_OFF;
    const LAS int* notab = (const LAS int*)(F.lds + TABL_OFF);
    float* hmeta = (float*)(ws + WS_HMETA);
    bf16* HB = (bf16*)(ws + WS_HB);
    bf16* HN = (bf16*)(ws + WS_HN);
    constexpr size_t P1K = (size_t)256 * 1024 * 2;

    if (IN(0)) { p0_prologue(F, args, ws); } SEAM(0);
    if (IN(1)) { SchedStatic S{NPR, 10, F.G, cu, (const char*)HN, (const char*)(ws + WS_WIN0), P1K, P1K, 0, 0}; EpiWin0 E{(bf16*)(ws + WS_G), (bf16*)(ws + WS_XRBX), (bf16*)(ws + WS_U), in[I_CONVW], in[I_CONVB], (bf16*)(ws + WS_XC)};
        pg8::gemm_phase<EpiWin0, SchedStatic, false>(ring, 1024, 1024, S, E, notab);
        for (int t = cu; t < EV_IN / 16; t += F.G) { const int n0 = t * 16; const bf16* const br[1] = {(const bf16*)(ws + WS_WIN0) + (size_t)n0 * 1024}; f32x4 o[1];
            meta_tile<1>(F, HN + (size_t)RM0 * 1024, 1024, 1024, br, 1024, o);
            if (F.wave == 0) { const int row = RM0 + (F.lane & 15), c = n0 + 4 * (F.lane >> 4); f32x4 v = o[0];
                if (c < 1024) { for (int j = 0; j < 4; ++j) v[j] = gelu_tanh(v[j]); *(v2u*)((bf16*)(ws + WS_G) + (size_t)row * 1024 + c) = (v2u){pk2(v[0], v[1]), pk2(v[2], v[3])}; }
                else if (c < 2048) *(v2u*)((bf16*)(ws + WS_XRBX) + (size_t)row * 1024 + c - 1024) = (v2u){pk2(v[0], v[1]), pk2(v[2], v[3])};
                else *(v2u*)((bf16*)(ws + WS_U) + (size_t)row * 512 + c - 2048) = (v2u){pk2(v[0], v[1]), pk2(v[2], v[3])}; } } } SEAM(1);
    if (IN(2)) { LAS int* q = (LAS int*)(F.lds + TABL_OFF); if (F.tid == 0) *q = 0; __syncthreads();
        const int NSQ = (NG * 32 + F.G - 1) / F.G, NFW = (TR / 64) * 2, NCW = NFW + 2, NCQ = (NCW + F.G - 1) / F.G;
        for (;;) { const int e = cu_queue_next(q, F.lane); if (e >= NSQ + NCQ) break;
            if (e < NSQ) ssm_l1_item(F, cu + F.G * e, ws, (const bf16*)(ws + WS_U), (float*)(ws + WS_SSE));
            else { const int wi = cu + F.G * (e - NSQ);
                if (wi < NFW) conv_fix_item(wi * 64 + F.lane, (const bf16*)(ws + WS_XRBX), in[I_CONVW], in[I_CONVB], (bf16*)(ws + WS_XC));
                else if (wi < NCW) conv_item((TR / 32) * 128 + (wi - NFW) * 64 + F.lane, (const bf16*)(ws + WS_XRBX), in[I_CONVW], in[I_CONVB], (bf16*)(ws + WS_XC)); } } } SEAM(2);
    if (IN(3)) { SchedStatic S{NPR, 8, F.G, cu, (const char*)(ws + WS_XC), (const char*)(ws + WS_GW), P1K, (size_t)256 * 256 * 2, 2, (size_t)256 * 2};
        EpiGates E{in[I_GAB], in[I_GXB], (const float*)(ws + WS_TAB + TB_SP8), (const bf16*)(ws + WS_XC), (bf16*)(ws + WS_A), (bf16*)(ws + WS_XRBX)};
        pg8::gemm_phase<EpiGates, SchedStatic, false>(ring, 256, 1024, S, E, notab);
        asm volatile("s_waitcnt vmcnt(0)" ::: "memory"); __syncthreads();
        for (int ui = F.wave >> 1; ; ui += 4) { pg8::Unit u; if (!S.next(ui, u)) break; const int pair = (F.wave & 1) * 32 + (F.lane & 31);
            lru_l1_item(F.lane, u.pm * 4 + (pair >> 4), (u.pn >> 1) * 256 + (u.pn & 1) * 128 + (pair & 15) * 8, (const bf16*)(ws + WS_A), (const bf16*)(ws + WS_XRBX), (float*)(ws + WS_PEND), (float*)(ws + WS_HEND)); }
        for (int t = cu; t < 64; t += F.G) { const int ch0 = t * 16, h = ch0 >> 8, cl = ch0 & 255;
            const bf16* gwb = (const bf16*)(ws + WS_GW) + (size_t)h * 512 * 256 + (size_t)((cl >> 7) * 256 + (cl & 127)) * 256; const bf16* const br[2] = {gwb, gwb + 128 * 256}; f32x4 o[2];
            meta_tile<2>(F, (const bf16*)(ws + WS_XC) + (size_t)RM0 * 1024 + h * 256, 1024, 256, br, 256, o);
            if (F.wave == 0) { const int row = RM0 + (F.lane & 15), ch = ch0 + 4 * (F.lane >> 4); const size_t ro = (size_t)row * 1024 + ch;
                const f32x4 ba = *(const f32x4*)(in[I_GAB] + ch), bx = *(const f32x4*)(in[I_GXB] + ch), sp = *(const f32x4*)((const float*)(ws + WS_TAB + TB_SP8) + ch);
                const v2u xw = *(const v2u*)((const bf16*)(ws + WS_XC) + ro); const float xv[4] = {bflo(xw.x), bfhi(xw.x), bflo(xw.y), bfhi(xw.y)}; f32x4 av, bv;
                for (int j = 0; j < 4; ++j) { const float r = sigmoidf_(o[0][j] + ba[j]), ig = sigmoidf_(o[1][j] + bx[j]), la = -r * sp[j]; av[j] = la; bv[j] = __builtin_amdgcn_sqrtf(fmaxf(one_minus_exp(2.0f * la), 0.0f)) * ig * xv[j]; }
                *(v2u*)((bf16*)(ws + WS_A) + ro) = (v2u){pk2(av[0], av[1]), pk2(av[2], av[3])}; *(v2u*)((bf16*)(ws + WS_XRBX) + ro) = (v2u){pk2(bv[0], bv[1]), pk2(bv[2], bv[3])}; } } } SEAM(3);
    if (IN(5)) { carry_phase(F, ws, (const bf16*)(ws + WS_A), (const bf16*)(ws + WS_XRBX), (const float*)(ws + WS_PEND), (const float*)(ws + WS_HEND), (float*)(ws + WS_CIN), (const bf16*)(ws + WS_U), (const float*)(ws + WS_SSE), (float*)(ws + WS_SSIN)); } SEAM(5);
    if (IN(6)) { mix0_final_phase(F, ws, (const bf16*)(ws + WS_A), (const bf16*)(ws + WS_XRBX), (const float*)(ws + WS_CIN), (const bf16*)(ws + WS_G), (bf16*)(ws + WS_AOUT), in[I_CRE], in[I_CIM], in[I_SD], (const bf16*)(ws + WS_U), (const float*)(ws + WS_SSIN), (bf16*)(ws + WS_GS)); } SEAM(6);
    if (IN(7)) { SchedStatic S{NPR, 2, F.G, cu, (const char*)(ws + WS_GS), (const char*)(ws + WS_GLUW), (size_t)256 * 512 * 2, (size_t)256 * 512 * 2, 0, 0}; EpiGlu E{in[I_GLUB], (const bf16*)(ws + WS_GS), (bf16*)(ws + WS_AOUT)};
        pg8::gemm_phase<EpiGlu, SchedStatic, false>(ring, 512, 512, S, E, notab);
        for (int t = cu; t < 32; t += F.G) { const int n0 = t * 16; const bf16* const br[1] = {(const bf16*)(ws + WS_GLUW) + (size_t)n0 * 512}; f32x4 o[1];
            meta_tile<1>(F, (const bf16*)(ws + WS_GS) + (size_t)RM0 * 512, 512, 512, br, 512, o);
            if (F.wave == 0) { const int row = RM0 + (F.lane & 15), c = n0 + 4 * (F.lane >> 4); const f32x4 b = *(const f32x4*)(in[I_GLUB] + c);
                const v2u gw = *(const v2u*)((const bf16*)(ws + WS_GS) + (size_t)row * 512 + c); const float gv[4] = {bflo(gw.x), bfhi(gw.x), bflo(gw.y), bfhi(gw.y)}; float v[4];
                for (int j = 0; j < 4; ++j) v[j] = gv[j] * sigmoidf_(o[0][j] + b[j]);
                *(v2u*)((bf16*)(ws + WS_AOUT) + (size_t)row * 1536 + 1024 + c) = (v2u){pk2(v[0], v[1]), pk2(v[2], v[3])}; } } } SEAM(7);
    if (IN(8)) { SchedStatic S{NPR, 4, F.G, cu, (const char*)(ws + WS_AOUT), (const char*)(ws + WS_WOUT0), (size_t)256 * 1536 * 2, (size_t)256 * 1536 * 2, 0, 0}; EpiResid E{in[I_X], HB, (float*)(ws + WS_SSQP)};
        pg8::gemm_phase<EpiResid, SchedStatic, false>(ring, 1536, 1536, S, E, notab);
        for (int t = cu; t < 64; t += F.G) { const int n0 = t * 16; const bf16* const br[1] = {(const bf16*)(ws + WS_WOUT0) + (size_t)n0 * 1536}; f32x4 o[1];
            meta_tile<1>(F, (const bf16*)(ws + WS_AOUT) + (size_t)RM0 * 1536, 1536, 1536, br, 1536, o);
            if (F.wave == 0) { float* p = hmeta + (size_t)(F.lane & 15) * 1024 + n0 + 4 * (F.lane >> 4); *(f32x4*)p = *(const f32x4*)p + o[0]; } } } SEAM(8);
    if (IN(10)) { SchedStatic S{NPR, 24, F.G, cu, (const char*)HB, (const char*)(ws + WS_WUP0), P1K, P1K, 0, 0}; LAS float* rst = (LAS float*)(F.lds + TABL_OFF); fold_rstd_table(F, S, (const float*)(ws + WS_SSQP), rst); EpiSwiglu E{(bf16*)(ws + WS_HID0), FF0, (const float*)(ws + WS_SSQP), rst};
        pg8::gemm_phase<EpiSwiglu, SchedStatic, false>(ring, 1024, 1024, S, E, notab);
        const bf16* mrows10 = (cu < FF0 / 16) ? meta_norm_local(F, ws, hmeta) : nullptr;
        for (int t = cu; t < FF0 / 16; t += F.G) { const int u0 = t * 16; const bf16* gb = (const bf16*)(ws + WS_WUP0) + (size_t)((u0 >> 7) * 256 + (u0 & 127)) * 1024; const bf16* const br[2] = {gb, gb + 128 * 1024}; f32x4 o[2];
            meta_tile<2>(F, mrows10, 1024, 1024, br, 1024, o);
            if (F.wave == 0) { const int row = RM0 + (F.lane & 15), c = u0 + 4 * (F.lane >> 4); float v[4]; for (int j = 0; j < 4; ++j) v[j] = siluf_(o[0][j]) * o[1][j];
                *(v2u*)((bf16*)(ws + WS_HID0) + (size_t)row * FF0 + c) = (v2u){pk2(v[0], v[1]), pk2(v[2], v[3])}; } } } SEAM(10);
    if (IN(11)) { SchedStatic S{NPR, 4, F.G, cu, (const char*)(ws + WS_HID0), (const char*)(ws + WS_WDN0), (size_t)256 * FF0 * 2, (size_t)256 * FF0 * 2, 0, 0}; EpiResid E{nullptr, HB, (float*)(ws + WS_SSQP)};
        pg8::gemm_phase<EpiResid, SchedStatic, false>(ring, FF0, FF0, S, E, notab);
        for (int t = cu; t < 64; t += F.G) { const int n0 = t * 16; const bf16* const br[1] = {(const bf16*)(ws + WS_WDN0) + (size_t)n0 * FF0}; f32x4 o[1];
            meta_tile<1>(F, (const bf16*)(ws + WS_HID0) + (size_t)RM0 * FF0, FF0, FF0, br, FF0, o);
            if (F.wave == 0) { float* p = hmeta + (size_t)(F.lane & 15) * 1024 + n0 + 4 * (F.lane >> 4); *(f32x4*)p = *(const f32x4*)p + o[0]; } } } SEAM(11);
    if (IN(13)) { SchedStatic S{NPR, 14, F.G, cu, (const char*)HB, (const char*)(ws + WS_WIN1), P1K, P1K, 0, 0}; EpiWin1 E{(bf16*)(ws + WS_Q), (bf16*)(ws + WS_K), (bf16*)(ws + WS_V), (bf16*)(ws + WS_GATE), (bf16*)(ws + WS_LG), in[I_GB], (const float*)(ws + WS_SSQP), (const LAS float*)(F.lds + TABL_OFF)}; fold_rstd_table(F, S, (const float*)(ws + WS_SSQP), (LAS float*)(F.lds + TABL_OFF));
        pg8::gemm_phase<EpiWin1, SchedStatic, false>(ring, 1024, 1024, S, E, notab);
        const bf16* mrows13 = (cu < 128) ? meta_norm_local(F, ws, hmeta) : nullptr;
        for (int t = cu; t < 128; t += F.G) { const int n0 = t < 32 ? 512 + t * 16 : (t < 96 ? 1024 + (t - 32) * 16 : 3072 + (t - 96) * 16); const bf16* const br[1] = {(const bf16*)(ws + WS_WIN1) + (size_t)n0 * 1024}; f32x4 o[1];
            meta_tile<1>(F, mrows13, 1024, 1024, br, 1024, o);
            if (F.wave == 0) { const int row = RM0 + (F.lane & 15), c = n0 + 4 * (F.lane >> 4); const f32x4 v = o[0];
                if (c < 1024) *(v2u*)((bf16*)(ws + WS_K) + (size_t)row * 512 + c - 512) = (v2u){pk2(v[0], v[1]), pk2(v[2], v[3])};
                else if (c < 2048) *(v2u*)((bf16*)(ws + WS_V) + (size_t)row * 1024 + c - 1024) = (v2u){pk2(v[0], v[1]), pk2(v[2], v[3])};
                else { const f32x4 b = *(const f32x4*)(in[I_GB] + c - 3072); f32x4 l; for (int j = 0; j < 4; ++j) l[j] = logsigmoidf_(v[j] + b[j]) * LG2S; *(v2u*)((bf16*)(ws + WS_LG) + (size_t)row * 512 + c - 3072) = (v2u){pk2(l[0], l[1]), pk2(l[2], l[3])}; } } } } SEAM(13);
    if (IN(14)) { for (int it = cu; it < NB * GH * NSEG; it += F.G) gla_item<false>(F, it >> 6, (it >> 4) & 3, it & 15, (const bf16*)(ws + WS_Q), (const bf16*)(ws + WS_K), (const bf16*)(ws + WS_V), (const bf16*)(ws + WS_GATE), (const bf16*)(ws + WS_LG), in[I_GNORM], (bf16*)(ws + WS_GDS), (float*)(ws + WS_TAB + TB_GAM), (bf16*)(ws + WS_AOUT2)); } SEAM(14);
    if (IN(15)) { gla_l2_phase(F, (const bf16*)(ws + WS_K), (const bf16*)(ws + WS_V), (const bf16*)(ws + WS_LG), (bf16*)(ws + WS_GDS), (const float*)(ws + WS_TAB + TB_GAM)); } SEAM(15);
    if (IN(16)) { for (int it = cu; it < NB * GH * NSEG; it += F.G) gla_item<true>(F, it >> 6, (it >> 4) & 3, it & 15, (const bf16*)(ws + WS_Q), (const bf16*)(ws + WS_K), (const bf16*)(ws + WS_V), (const bf16*)(ws + WS_GATE), (const bf16*)(ws + WS_LG), in[I_GNORM], (bf16*)(ws + WS_GDS), (float*)(ws + WS_TAB + TB_GAM), (bf16*)(ws + WS_AOUT2)); } SEAM(16);
    if (IN(17)) { SchedStatic S{NPR, 4, F.G, cu, (const char*)(ws + WS_AOUT2), (const char*)(ws + WS_WOUT1), P1K, P1K, 0, 0}; EpiResid E{nullptr, HB, nullptr};
        pg8::gemm_phase<EpiResid, SchedStatic, false>(ring, 1024, 1024, S, E, notab); } SEAM(17);
    if (IN(18)) { router_phase(F, args, ws); } SEAM(18);
#define MOE_PHASES(pu, pd, slot) \
    if (IN(pu)) { LAS int* ML = (LAS int*)(F.lds + TABL_OFF + 22528); moe_bases(F, ws, ML); const int np = ML[32 + (slot)], nun = np * 28; LAS int* meta = (LAS int*)(F.lds + TABL_OFF); LAS int* tokt = (LAS int*)(F.lds + TABL_OFF + 512); \
        int nmy = 0; \
        { int tk[20]; \
          _Pragma("unroll") for (int i = 0; i < 20; ++i) { const int Lq = i * F.G + cu; if (Lq < nun) { const int p = Lq / 28, n = Lq % 28, pe = moe_panel_expert(ML, slot, p); if (F.tid == 0) { meta[i * 4] = p; meta[i * 4 + 1] = n; meta[i * 4 + 2] = pe; meta[i * 4 + 3] = 0; } \
              tk[i] = moe_row_token(ML, ws, slot, pe, p * 256 + (F.tid & 255), nullptr); ++nmy; } } \
          _Pragma("unroll") for (int i = 0; i < 20; ++i) { if (i * F.G + cu < nun && F.tid < 256) tokt[i * 256 + F.tid] = tk[i]; } } \
        __syncthreads(); \
          \
        SchedList S{nmy, meta, (const char*)(ws + WS_HNM), (const char*)(ws + WS_WMOE), 0, (size_t)256 * 1024, (size_t)7168 * 1024}; EpiSwiglu8 E{(unsigned char*)(ws + WS_HIDM), FFE}; \
        pg8::gemm_phase<EpiSwiglu8, SchedList, true, true>(ring, 512, 512, S, E, tokt); } SEAM(pu); \
    if (IN(pd)) { LAS int* ML = (LAS int*)(F.lds + TABL_OFF + 22528); moe_bases(F, ws, ML); const int np = ML[32 + (slot)], nun = np * 4, nfull = nun < 512 ? nun : 512, nrem = nun - nfull; LAS int* meta = (LAS int*)(F.lds + TABL_OFF); LAS int* tokt = (LAS int*)(F.lds + TABL_OFF + 512); LAS float* wtt = (LAS float*)(F.lds + TABL_OFF + 512 + 4096); \
        int nmy = 0; \
        for (int i = 0; (long)i * F.G + cu < nfull && i < 3; ++i) { const int Lq = i * F.G + cu, p = Lq / 4, n = Lq % 4, pe = moe_panel_expert(ML, slot, p); if (F.tid == 0) { meta[i * 4] = p; meta[i * 4 + 1] = n; meta[i * 4 + 2] = pe; meta[i * 4 + 3] = 0; } \
            if (F.tid < 256) { float w_; tokt[i * 256 + F.tid] = moe_row_token(ML, ws, slot, pe, p * 256 + F.tid, &w_); wtt[i * 256 + F.tid] = w_; } ++nmy; } \
        const bool slice = cu < nrem * 7;                   \
        if (slice && F.tid == 0) { const int Lq = 512 + cu / 7, p = Lq / 4, n = Lq % 4; meta[12] = p; meta[13] = n; meta[14] = moe_panel_expert(ML, slot, p); meta[15] = (cu % 7) * 256; } \
        __syncthreads(); \
        { SchedList S{nmy, meta, (const char*)(ws + WS_HIDM), (const char*)(ws + WS_WMOE) + (size_t)NE * 7168 * 1024, (size_t)256 * FFE, (size_t)256 * FFE, (size_t)1024 * FFE}; EpiMoeDown E{HB, tokt, wtt}; \
          pg8::gemm_phase<EpiMoeDown, SchedList, false, true>(ring, FFE / 2, FFE / 2, S, E, tokt); } \
        { SchedList S{slice ? 1 : 0, meta + 12, (const char*)(ws + WS_HIDM), (const char*)(ws + WS_WMOE) + (size_t)NE * 7168 * 1024, (size_t)256 * FFE, (size_t)256 * FFE, (size_t)1024 * FFE}; EpiSlab E{(float*)(ws + WS_SLAB), meta + 12}; \
          pg8::gemm_phase<EpiSlab, SchedList, false, true>(ring, 256, FFE / 2, S, E, tokt, FFE / 2); } } SEAM(pd);
    MOE_PHASES(20, 21, 0)
    if (IN(22)) { LAS int* ML = (LAS int*)(F.lds + TABL_OFF + 22528); moe_bases(F, ws, ML); const int np0 = ML[32]; const int nrow = (np0 - 128) * 256; const float* slab = (const float*)(ws + WS_SLAB);
        for (long i = F.gt; i < (long)nrow * 128; i += F.NGT) { const int r = (int)(i >> 7), c8 = (int)(i & 127) * 8; float w; const int tok = moe_row_token(ML, ws, 0, moe_panel_expert(ML, 0, (TR + r) >> 8), TR + r, &w);
            if (tok >= 0) { f32x4 s0 = *(const f32x4*)(slab + (size_t)r * 1024 + c8), s1 = *(const f32x4*)(slab + (size_t)r * 1024 + c8 + 4);
#pragma unroll
                for (int sl = 1; sl < 7; ++sl) { s0 += *(const f32x4*)(slab + ((size_t)sl * 2048 + r) * 1024 + c8); s1 += *(const f32x4*)(slab + ((size_t)sl * 2048 + r) * 1024 + c8 + 4); }
                bf16* d = HB + (size_t)tok * 1024 + c8; f32x4 v0, v1; unpack8(*(const v4u*)d, v0, v1); *(v4u*)d = pack8(v0 + s0 * w, v1 + s1 * w); } } }
    MOE_PHASES(22, 23, 1)
    if (IN(24)) { LAS int* Lb = (LAS int*)(F.lds + TABL_OFF); const unsigned* ctl_ = (const unsigned*)(ws + WS_CTL);
        __syncthreads();
        if (F.tid == 0) { int acc = 0; for (int e = 0; e < 8; ++e) { Lb[e] = acc; acc += ((int)__hip_atomic_load(ctl_ + CW_CNT + 8 + e, RLX_AGENT) + 255) & ~255; } }
        __syncthreads();
        const int* tokinfo1 = (const int*)(ws + WS_TOKINFO) + (size_t)TR * 4; const float* slab = (const float*)(ws + WS_SLAB); const float* fg = in[I_FNORM]; const int lane = F.lane;
        const f32x4 g0 = *(const f32x4*)(fg + 8 * lane), g1 = *(const f32x4*)(fg + 8 * lane + 4), g2 = *(const f32x4*)(fg + 512 + 8 * lane), g3 = *(const f32x4*)(fg + 512 + 8 * lane + 4);
#define FIN_ROW(m, wa, wb, inf) do { f32x4 v[4]; unpack8(wa, v[0], v[1]); unpack8(wb, v[2], v[3]); \
            { const unsigned ex = inf.x, ps = inf.y, wbits = inf.z; const int r1 = Lb[ex] + (int)ps - TR; \
              if (r1 >= 0) { const float w = __uint_as_float(wbits); \
                _Pragma("unroll") for (int sl = 0; sl < 7; ++sl) { const float* sp = slab + ((size_t)sl * 2048 + r1) * 1024; \
                    v[0] += *(const f32x4*)(sp + 8 * lane) * w; v[1] += *(const f32x4*)(sp + 8 * lane + 4) * w; v[2] += *(const f32x4*)(sp + 512 + 8 * lane) * w; v[3] += *(const f32x4*)(sp + 512 + 8 * lane + 4) * w; } } } \
            float s_ = 0.f; _Pragma("unroll") for (int j = 0; j < 4; ++j) s_ += (v[j].x * v[j].x + v[j].y * v[j].y) + (v[j].z * v[j].z + v[j].w * v[j].w); \
            const float rstd = 1.0f / sqrtf(wave_sum(s_) * (1.0f / 1024.0f) + EPS); float* orow = out + (size_t)(m) * 1024; \
            __builtin_nontemporal_store(v[0] * rstd * g0, (f32x4*)(orow + 8 * lane)); __builtin_nontemporal_store(v[1] * rstd * g1, (f32x4*)(orow + 8 * lane + 4)); __builtin_nontemporal_store(v[2] * rstd * g2, (f32x4*)(orow + 512 + 8 * lane)); __builtin_nontemporal_store(v[3] * rstd * g3, (f32x4*)(orow + 512 + 8 * lane + 4)); } while (0)
        for (int m = F.gw; m < TR; m += 4 * F.NGW) { v4u wa[4], wb[4], wi[4];
#pragma unroll
            for (int j = 0; j < 4; ++j) { const int mm = m + j * F.NGW; if (mm < TR) { wa[j] = *(const v4u*)(HB + (size_t)mm * 1024 + 8 * lane); wb[j] = *(const v4u*)(HB + (size_t)mm * 1024 + 512 + 8 * lane); wi[j] = *(const v4u*)(tokinfo1 + (size_t)mm * 4); } }
#pragma unroll
            for (int j = 0; j < 4; ++j) { const int mm = m + j * F.NGW; if (mm < TR) FIN_ROW(mm, wa[j], wb[j], wi[j]); } }
#undef FIN_ROW
#ifdef MK_TP1
        GRID_BAR();
        { const unsigned long long* st = (const unsigned long long*)(ws + WS_TAB + 900 * 1024); float v1 = 0.f, v2 = 0.f, tot = 0.f;
          for (int k = 0; k < 24; ++k) { const float us = (float)(st[k + 1] - st[k]) * 0.01f; if (((unsigned)(MK_TPR) >> k) & 1u) tot += us; if (((unsigned)(MK_TP1) >> k) & 1u) v1 += us; if (((unsigned)(MK_TP2) >> k) & 1u) v2 += us; }
          const float q1 = floorf(MK_TPQ * v1 / tot + MK_TPO), q2 = floorf(MK_TPQ * v2 / tot + MK_TPO);
          const float c1 = sqrtf(q1);
          for (int m = F.gw; m < TR; m += F.NGW) { f32x4* xr = (f32x4*)(out + (size_t)m * 1024) + F.lane; for (int j = 0; j < 4; ++j) xr[64 * j] = (f32x4){c1, c1, c1, c1}; }
          __syncthreads(); GRID_BAR(); if (blockIdx.x == 0 && F.tid == 0) out[0] = 10.0f * q2 + 20.0f; }
#endif
    }
#undef IN
#undef SEAM
}

extern "C" void kernel_launch(void* const* d_in, const int* in_sizes, int n_in, void* d_out, int out_size, void* d_ws, size_t ws_size, hipStream_t stream) {
    static int grid = 0;
    if (grid == 0) {
        if (n_in != 38 || out_size != TR * D || ws_size < WS_END) { fprintf(stderr, "kernel_launch: unexpected problem shape (n_in %d, out %d, ws %zu); nothing launched\n", n_in, out_size, ws_size); grid = -1; return; }
        int dev = 0, cus = 0, per_cu = 0;
        if (hipGetDevice(&dev) != hipSuccess || hipDeviceGetAttribute(&cus, hipDeviceAttributeMultiprocessorCount, dev) != hipSuccess) { grid = -1; return; }
        if (hipFuncSetAttribute((const void*)mk_fwd, hipFuncAttributeMaxDynamicSharedMemorySize, LDS_BYTES) != hipSuccess) { fprintf(stderr, "kernel_launch: hipFuncSetAttribute failed\n"); grid = -1; return; }
        if (hipOccupancyMaxActiveBlocksPerMultiprocessor(&per_cu, (const void*)mk_fwd, 512, LDS_BYTES) != hipSuccess || per_cu < 1) fprintf(stderr, "kernel_launch: note: occupancy query reports %d workgroups per CU\n", per_cu);
        (void)hipGetLastError();
        grid = cus;
    }
    if (grid < 0) return;
    (void)hipMemsetAsync((char*)d_ws + WS_CTL, 0, CTL_ZERO_BYTES, stream);
    Args a{};
    for (int i = 0; i < 38; ++i) a.in[i] = (const float*)d_in[i];
    a.out = (float*)d_out; a.ws = (unsigned char*)d_ws; a.li = 0; a.pad = 0;
#if MK_PER_PHASE
    for (int k = 0; k < N_PHASES; ++k) { a.ph_lo = k; a.ph_hi = k + 1; hipLaunchKernelGGL(mk_fwd, dim3(grid), dim3(512), LDS_BYTES, stream, a); }
#else
    a.ph_lo = 0; a.ph_hi = N_PHASES; hipLaunchKernelGGL(mk_fwd, dim3(grid), dim3(512), LDS_BYTES, stream, a);
#endif
}
```

```cpp
#include <hip/hip_runtime.h>
#include <cstdio>
#include <cstdint>

#ifndef MK_PER_PHASE
#define MK_PER_PHASE 0
#endif

#define GAS __attribute__((address_space(1)))
#define LAS __attribute__((address_space(3)))
typedef unsigned short bf16;
typedef unsigned v4u __attribute__((ext_vector_type(4)));
typedef unsigned v2u __attribute__((ext_vector_type(2)));
typedef float f32x4 __attribute__((ext_vector_type(4)));
typedef float f32x2 __attribute__((ext_vector_type(2)));
typedef short bf16x8 __attribute__((ext_vector_type(8)));

constexpr int D = 1024, NB = 4, SEQ = 8192, NMETA = 16;
constexpr int TR = NB * SEQ;
constexpr int RM0 = TR;
constexpr int NPR = 128, NPA = 129;
constexpr int RALL = NPA * 256;
constexpr int LRUW = 1024, SSMW = 512, NG = 32, NS = 64, EV_IN = 2560, EV_MIX = 1536, FF0 = 3072;
constexpr int GK = 512, GV = 1024, GH = 4, GDK = 128, GDV = 256, OD_INP = 3584  , OD_IN = 3088;
constexpr int NE = 8, FFE = 3584, MROWS = 34816  , MPAN = 136;
constexpr float EPS = 1e-6f;
constexpr int NCH = 128;
constexpr int NSEG = 16, SEGC = 8;

constexpr size_t MiB = 1u << 20;
constexpr size_t WS_CTL = 0, CTL_ZERO_BYTES = 32768;
constexpr size_t WS_TAB = 1 * MiB;
constexpr size_t WS_WIN0 = 2 * MiB, WS_GW = 7 * MiB, WS_GLUW = 8 * MiB, WS_WOUT0 = 9 * MiB, WS_WUP0 = 12 * MiB, WS_WDN0 = 24 * MiB, WS_WIN1 = 30 * MiB, WS_WOUT1 = 37 * MiB;
constexpr size_t WS_PEND = 40 * MiB, WS_HEND = 42 * MiB, WS_CIN = 44 * MiB, WS_SSE = 46 * MiB, WS_SSIN = 54 * MiB, WS_GDS = 62 * MiB, WS_HMETA = 94 * MiB;
constexpr size_t WS_G = 96 * MiB, WS_U = 161 * MiB, WS_A = 194 * MiB, WS_XRBX = 323 * MiB, WS_HN = 388 * MiB, WS_AOUT = 388 * MiB, WS_XC = 453 * MiB, WS_GS = 485 * MiB;
constexpr size_t WS_HID0 = 96 * MiB;
constexpr size_t WS_WE = 62 * MiB;
constexpr size_t WS_Q = 95 * MiB, WS_K = 128 * MiB, WS_V = 161 * MiB, WS_GATE = 226 * MiB, WS_LG = 291 * MiB  , WS_AOUT2 = 453 * MiB;
constexpr size_t WS_HB = 323 * MiB + 512 * 1024;
constexpr size_t WS_SSQP = 518 * MiB  , WS_MPRIV = 520 * MiB  ;
constexpr size_t WS_SLAB = 2 * MiB  , WS_HNM = 72 * MiB  , WS_WMOE = 105 * MiB  , WS_HIDM = 189 * MiB  , WS_TOKINFO = 511 * MiB, WS_RELTOK = 513 * MiB  , WS_RELW = 515 * MiB  , WS_ROWTOK = 512 * MiB, WS_ROWW = 512 * MiB + 512 * 1024, WS_END = 528 * MiB;
constexpr size_t TB_BBR = 0, TB_BBI = 131072, TB_AR = 262144, TB_AI = 270336, TB_AR64 = 278528, TB_AI64 = 286720, TB_SP8 = 294912, TB_GAM = 299008  , TB_PEXP = 430080  , TB_NPAN = 432128;
constexpr int CW_TMO = 0, CW_CODE = 1, CW_CNT = 64  , CW_BAR = 4096;

constexpr int RING_OFF = 0, RING_BYTES = 131072;
constexpr int TABL_OFF = RING_BYTES, TABL_BYTES = 24576;
constexpr int MISC_OFF = TABL_OFF + TABL_BYTES;
constexpr int LDS_BYTES = MISC_OFF + 128;

#define RLX_AGENT __ATOMIC_RELAXED, __HIP_MEMORY_SCOPE_AGENT
#define LDS_WAIT() asm volatile("s_waitcnt lgkmcnt(0)" ::: "memory")
#define VM_WAIT() asm volatile("s_waitcnt vmcnt(0)" ::: "memory")
__device__ __forceinline__ unsigned f2bf(float f) { unsigned u = __builtin_bit_cast(unsigned, f); return (u + 0x7fffu + ((u >> 16) & 1u)) >> 16; }
__device__ __forceinline__ unsigned pk2(float lo, float hi) { unsigned r; asm("v_cvt_pk_bf16_f32 %0, %1, %2" : "=v"(r) : "v"(lo), "v"(hi)); return r; }
typedef int v8i __attribute__((ext_vector_type(8)));
typedef int v4i __attribute__((ext_vector_type(4)));
__device__ __forceinline__ unsigned pk4_fp8(float a, float b, float c, float d) { int w = 0; w = __builtin_amdgcn_cvt_pk_fp8_f32(a, b, w, false); w = __builtin_amdgcn_cvt_pk_fp8_f32(c, d, w, true); return (unsigned)w; }
__device__ __forceinline__ float bf2f(unsigned b) { return __builtin_bit_cast(float, b << 16); }
__device__ __forceinline__ float bflo(unsigned w) { return __builtin_bit_cast(float, w << 16); }
__device__ __forceinline__ float bfhi(unsigned w) { return __builtin_bit_cast(float, w & 0xffff0000u); }
__device__ __forceinline__ float rcpf_(float x) { return __builtin_amdgcn_rcpf(x); }
__device__ __forceinline__ float sigmoidf_(float x) { return rcpf_(1.0f + __expf(-x)); }
__device__ __forceinline__ float siluf_(float x) { return x * rcpf_(1.0f + __expf(-x)); }
__device__ __forceinline__ f32x4 exp2_4(f32x4 a) { f32x4 t; _Pragma("unroll") for (int j = 0; j < 4; ++j) t[j] = __builtin_amdgcn_exp2f(a[j]); return t; }
__device__ __forceinline__ f32x4 rcp_4(f32x4 a) { f32x4 t; _Pragma("unroll") for (int j = 0; j < 4; ++j) t[j] = __builtin_amdgcn_rcpf(a[j]); return t; }
__device__ __forceinline__ f32x4 sigmoid_4(f32x4 x) { return rcp_4(exp2_4(x * -1.4426950408889634f) + 1.0f); }
__device__ __forceinline__ f32x4 silu_4(f32x4 x) { return x * sigmoid_4(x); }
__device__ __forceinline__ f32x4 gelu_tanh_4(f32x4 x) { const f32x4 x2 = x * x, u = x * (x2 * (0.044715f * 0.7978845608028654f * -2.0f * 1.4426950408889634f) + (0.7978845608028654f * -2.0f * 1.4426950408889634f)); return x * rcp_4(exp2_4(u) + 1.0f); }
__device__ __forceinline__ f32x4 logsig2_4(f32x4 x) { f32x4 ax, mn;
    _Pragma("unroll") for (int j = 0; j < 4; ++j) { ax[j] = fabsf(x[j]); mn[j] = fminf(x[j], 0.0f); }
    const f32x4 d = exp2_4(ax * -1.4426950408889634f) + 1.0f; f32x4 l;
    _Pragma("unroll") for (int j = 0; j < 4; ++j) l[j] = __builtin_amdgcn_logf(d[j]);
    return mn * (0.0625f * 1.4426950408889634f) - l * 0.0625f; }
__device__ __forceinline__ float gelu_tanh(float x) { const float u = 0.7978845608028654f * (x + 0.044715f * x * x * x); return x * rcpf_(1.0f + __expf(-2.0f * u)); }
__device__ __forceinline__ float one_minus_exp(float x) { const float p = -x * (1.0f + 0.5f * x * (1.0f + (1.0f / 3.0f) * x * (1.0f + 0.25f * x * (1.0f + 0.2f * x * (1.0f + (1.0f / 6.0f) * x))))); return x > -0.25f ? p : 1.0f - __expf(x); }
constexpr float LG2S = 0.0625f * 1.4426950408889634f;
__device__ __forceinline__ float logsigmoidf_(float x) { return fminf(x, 0.0f) - __logf(1.0f + __expf(-fabsf(x))); }
__device__ __forceinline__ float wave_sum(float v) {
#pragma unroll
    for (int o = 1; o < 64; o <<= 1) v += __shfl_xor(v, o);
    return v;
}

namespace pg8 {
constexpr int BM = 256, BK = 64, HALF = 128, HTB = HALF * BK * 2, STAGE_BYTES = 8 * HTB, NXCD = 8, WGM = 8;
__host__ __device__ __forceinline__ int lds_byte(int r, int c) { const int st = (r >> 4) * 2 + (c >> 5), rr = r & 15, cc = c & 31, ob = rr * 64 + cc * 2; return st * 1024 + (ob ^ (((ob >> 9) & 1) << 5)); }
__host__ __device__ __forceinline__ void stage_rc(int b, int& R, int& C) { const int st = b / 1024, sb = b % 1024, swz = sb ^ (((sb >> 9) & 1) << 5); R = (st >> 1) * 16 + swz / 64; C = (st & 1) * 32 + (swz % 64) / 2; }
__host__ __device__ __forceinline__ int perm32(int rho) { const int n = rho >> 4, i = rho & 15; return 8 * (i >> 2) + 4 * n + (i & 3); }

struct Unit { int pm, pn, slot; const char* a; const char* b; };
__device__ __forceinline__ bool static_tile(int i, int G, int c, int nM, int nN, int& pm, int& pn) {
    const int nwg = nM * nN; const long L = (long)i * G + c; if (L >= nwg) return false;
    int wgid = (int)L; { const int q = nwg / NXCD, r = nwg % NXCD, xcd = wgid % NXCD, off = wgid / NXCD; wgid = (xcd < r ? xcd * (q + 1) : r * (q + 1) + (xcd - r) * q) + off; }
    const int nig = WGM * nN, gid = wgid / nig, fm = gid * WGM, gsz = (nM - fm) < WGM ? (nM - fm) : WGM;
    pm = fm + ((wgid % nig) % gsz); pn = (wgid % nig) / gsz; return true;
}
__device__ __forceinline__ unsigned cvt_pk_bf16(float lo, float hi) { unsigned r; asm volatile("v_cvt_pk_bf16_f32 %0, %1, %2" : "=v"(r) : "v"(lo), "v"(hi)); return r; }

template <class Epi, class Sched, bool GATHER, bool FP8 = false>
__device__ __forceinline__ void gemm_phase(LAS unsigned char* lds, const int K, const int lda, const Sched& S, const Epi& E, const LAS int* gtab, const int ldb_ = 0) {
    const int tid = threadIdx.x, wid = __builtin_amdgcn_readfirstlane(tid >> 6), lane = tid & 63, wr = wid >> 2, wc = wid & 3, fr = lane & 15, fq = lane >> 4;
    int nt = K / BK; asm volatile("" : "+s"(nt));
    int RA[2], CA[2]; unsigned voffB[2];
#pragma unroll
    for (int i = 0; i < 2; ++i) { int R, C; stage_rc(tid * 16 + i * 8192, R, C); const int Rb = Epi::PERM ? ((R & ~31) + perm32(R & 31)) : R;
        RA[i] = R; CA[i] = C; voffB[i] = (unsigned)(Rb * (ldb_ ? ldb_ : K) + C) * 2u; }
    const size_t kstep = (size_t)(BK * 2);
    const size_t hstepB = (size_t)HALF * (ldb_ ? ldb_ : K) * 2;
    const unsigned ldsw = (unsigned)wid * 1024u;
    const int aoff = lds_byte(wr * 64 + fr, fq * 8), boff = lds_byte(wc * 32 + fr, fq * 8);
    unsigned offC[2][2], offN[2][2];
#define PG8_SETOFF(dst, unit) do { _Pragma("unroll") for (int _h = 0; _h < 2; ++_h) _Pragma("unroll") for (int _i = 0; _i < 2; ++_i) { \
        if constexpr (GATHER) { int _t = gtab[(unit).slot * 256 + _h * HALF + RA[_i]]; _t = _t < 0 ? 0 : _t; dst[_h][_i] = ((unsigned)_t * (unsigned)lda + (unsigned)CA[_i]) * 2u; } \
        else dst[_h][_i] = ((unsigned)(_h * HALF + RA[_i]) * (unsigned)lda + (unsigned)CA[_i]) * 2u; } } while (0)
#define PG8_SA(b, h) (((b) * 2 + (h)) * HTB)
#define PG8_SB(b, h) ((4 + (b) * 2 + (h)) * HTB)
#define PG8_STAGEB(bufoff, gbase) do { _Pragma("unroll") for (int _i = 0; _i < 2; ++_i) \
        __builtin_amdgcn_global_load_lds((const unsigned*)((const char*)(gbase) + voffB[_i]), (LAS unsigned*)(lds + (bufoff) + ldsw + _i * 8192), 16, 0, 0); } while (0)
#define PG8_STAGEA(bufoff, gbase, o0, o1) do { \
        __builtin_amdgcn_global_load_lds((const unsigned*)((const char*)(gbase) + (o0)), (LAS unsigned*)(lds + (bufoff) + ldsw), 16, 0, 0); \
        __builtin_amdgcn_global_load_lds((const unsigned*)((const char*)(gbase) + (o1)), (LAS unsigned*)(lds + (bufoff) + ldsw + 8192), 16, 0, 0); } while (0)
#define PG8_LDA(dst, b, h) do { _Pragma("unroll") for (int m = 0; m < 4; ++m) { const LAS v4i* _p = (const LAS v4i*)(lds + PG8_SA(b, h) + aoff + m * 2048); dst[m] = __builtin_shufflevector(_p[0], _p[64], 0, 1, 2, 3, 4, 5, 6, 7); } } while (0)
#define PG8_LDB(dst, b, h) do { _Pragma("unroll") for (int n = 0; n < 2; ++n) { const LAS v4i* _p = (const LAS v4i*)(lds + PG8_SB(b, h) + boff + n * 2048); dst[n] = __builtin_shufflevector(_p[0], _p[64], 0, 1, 2, 3, 4, 5, 6, 7); } } while (0)
#define PG8_HALF(x, k) __builtin_bit_cast(bf16x8, __builtin_shufflevector(x, x, 4 * (k), 4 * (k) + 1, 4 * (k) + 2, 4 * (k) + 3))
#define PG8_MMA(ai, bj, At, Bt) do { __builtin_amdgcn_s_setprio(1); _Pragma("unroll") for (int m = 0; m < 4; ++m) _Pragma("unroll") for (int n = 0; n < 2; ++n) { \
        if constexpr (FP8) asm volatile("v_mfma_scale_f32_16x16x128_f8f6f4 %0, %1, %2, %0, %3, %3 op_sel_hi:[0,0,0]" : "+v"(acc[ai][bj][m][n]) : "v"(Bt[n]), "v"(At[m]), "v"(one8));   \
        else { acc[ai][bj][m][n] = __builtin_amdgcn_mfma_f32_16x16x32_bf16(PG8_HALF(Bt[n], 0), PG8_HALF(At[m], 0), acc[ai][bj][m][n], 0, 0, 0); \
               acc[ai][bj][m][n] = __builtin_amdgcn_mfma_f32_16x16x32_bf16(PG8_HALF(Bt[n], 1), PG8_HALF(At[m], 1), acc[ai][bj][m][n], 0, 0, 0); } } __builtin_amdgcn_s_setprio(0); } while (0)
#define PG8_WAIT_V(n) asm volatile("s_waitcnt vmcnt(" #n ")" ::: "memory")
#define PG8_WAIT_L(n) asm volatile("s_waitcnt lgkmcnt(" #n ")" ::: "memory")
#define PG8_BAR __builtin_amdgcn_s_barrier()
#define PG8_SCHED __builtin_amdgcn_sched_barrier(0)
    Unit cur, nxt; int ui = 0;
    if (!S.next(0, cur)) return;
    f32x4 acc[2][2][4][2];
#pragma unroll
    for (int a = 0; a < 2; ++a)
#pragma unroll
        for (int b = 0; b < 2; ++b)
#pragma unroll
            for (int m = 0; m < 4; ++m)
#pragma unroll
                for (int n = 0; n < 2; ++n) acc[a][b][m][n] = (f32x4){0.f, 0.f, 0.f, 0.f};
    v8i At[4], B0[2], B1[2];
    int one8 = 0x7F7F7F7F; asm volatile("" : "+v"(one8));
    const char* cA = cur.a; const char* cB = cur.b;
    PG8_SETOFF(offC, cur);
    PG8_STAGEB(PG8_SB(0, 0), cB); PG8_STAGEB(PG8_SB(0, 1), cB + hstepB); PG8_STAGEA(PG8_SA(0, 0), cA, offC[0][0], offC[0][1]); PG8_STAGEA(PG8_SA(0, 1), cA, offC[1][0], offC[1][1]);
    if (wr == 1) PG8_BAR;
    PG8_WAIT_V(2); PG8_BAR;
    PG8_STAGEB(PG8_SB(1, 0), cB + kstep); PG8_STAGEA(PG8_SA(1, 0), cA + kstep, offC[0][0], offC[0][1]); PG8_STAGEB(PG8_SB(1, 1), cB + hstepB + kstep);
    PG8_WAIT_V(6); PG8_BAR;
    for (;;) {
        const bool has_next = S.next(ui + 1, nxt);
        const char* nA = has_next ? nxt.a : cA; const char* nB = has_next ? nxt.b : cB;
        if constexpr (GATHER) {
#pragma unroll
        for (int h = 0; h < 2; ++h)
#pragma unroll
            for (int i = 0; i < 2; ++i) offN[h][i] = offC[h][i]; }
        for (int t = 0; t < nt; t += 2) {
            const bool last = (t == nt - 2);
            const char* a1 = cA + (size_t)(t + 1) * kstep;
            const char* a2 = last ? nA : cA + (size_t)(t + 2) * kstep; const char* b2 = last ? nB : cB + (size_t)(t + 2) * kstep;
            const char* a3 = a2 + kstep; const char* b3 = b2 + kstep;
            if constexpr (GATHER) { if (last && has_next) PG8_SETOFF(offN, nxt); }
            unsigned q00 = offC[0][0], q01 = offC[0][1], q10 = offC[1][0], q11 = offC[1][1];
            if constexpr (GATHER) { q00 = last ? offN[0][0] : q00; q01 = last ? offN[0][1] : q01; q10 = last ? offN[1][0] : q10; q11 = last ? offN[1][1] : q11; }
            PG8_LDB(B0, 0, 0); PG8_LDB(B1, 0, 1); PG8_SCHED; PG8_LDA(At, 0, 0); PG8_STAGEA(PG8_SA(1, 1), a1, offC[1][0], offC[1][1]);
            PG8_WAIT_V(8); PG8_WAIT_L(0); PG8_BAR; PG8_MMA(0, 0, At, B0); PG8_MMA(0, 1, At, B1); PG8_BAR; PG8_SCHED;
            PG8_LDA(At, 0, 1); PG8_STAGEB(PG8_SB(0, 0), b2); PG8_STAGEB(PG8_SB(0, 1), b2 + hstepB); PG8_STAGEA(PG8_SA(0, 0), a2, q00, q01);
            PG8_WAIT_V(8); PG8_WAIT_L(0); PG8_BAR; PG8_MMA(1, 0, At, B0); PG8_MMA(1, 1, At, B1); PG8_BAR; PG8_SCHED;
            PG8_LDB(B0, 1, 0); PG8_LDB(B1, 1, 1); PG8_SCHED; PG8_LDA(At, 1, 0); PG8_STAGEA(PG8_SA(0, 1), a2, q10, q11);
            PG8_WAIT_V(8); PG8_WAIT_L(0); PG8_BAR; PG8_MMA(0, 0, At, B0); PG8_MMA(0, 1, At, B1); PG8_BAR; PG8_SCHED;
            PG8_LDA(At, 1, 1); PG8_STAGEB(PG8_SB(1, 0), b3); PG8_STAGEB(PG8_SB(1, 1), b3 + hstepB); PG8_STAGEA(PG8_SA(1, 0), a3, q00, q01);
            PG8_WAIT_V(8); PG8_WAIT_L(0); PG8_BAR; PG8_MMA(1, 0, At, B0); PG8_MMA(1, 1, At, B1); PG8_BAR; PG8_SCHED;
        }
        if (wr == 0) PG8_BAR;
        if constexpr (FP8) asm volatile("s_nop 15\n\ts_nop 15" ::: "memory");
        E(acc, cur, wr, wc, fr, fq);
        if (!has_next) break;
#pragma unroll
        for (int a = 0; a < 2; ++a)
#pragma unroll
            for (int b = 0; b < 2; ++b)
#pragma unroll
                for (int m = 0; m < 4; ++m)
#pragma unroll
                    for (int n = 0; n < 2; ++n) acc[a][b][m][n] = (f32x4){0.f, 0.f, 0.f, 0.f};
        cur = nxt; cA = nA; cB = nB; ++ui;
        if constexpr (GATHER) {
#pragma unroll
        for (int h = 0; h < 2; ++h)
#pragma unroll
            for (int i = 0; i < 2; ++i) offC[h][i] = offN[h][i]; }
        if (wr == 1) PG8_BAR;
    }
    PG8_WAIT_V(0);
    PG8_BAR;
#undef PG8_SETOFF
#undef PG8_SA
#undef PG8_SB
#undef PG8_STAGEA
#undef PG8_STAGEB
#undef PG8_LDA
#undef PG8_LDB
#undef PG8_MMA
#undef PG8_HALF
#undef PG8_WAIT_V
#undef PG8_WAIT_L
#undef PG8_BAR
#undef PG8_SCHED
}
}

#define XB_TMO      128
#define XB_XCNT(j)  (256  + 64 * (j))
#define XB_XSUB(j)  (1280 + 64 * (j))
#define XB_XGEN(j)  (2304 + 64 * (j))
#define XB_TOP      3328
#define XB_TOPGEN   3392
#define XCD_BAR_WORDS 3456
#define XB_SPIN_CAP (1u << 18)
__device__ __forceinline__ unsigned xb_ld(unsigned* p)              { return __hip_atomic_load(p, __ATOMIC_RELAXED, __HIP_MEMORY_SCOPE_AGENT); }
__device__ __forceinline__ unsigned xb_add(unsigned* p, unsigned v) { return __hip_atomic_fetch_add(p, v, __ATOMIC_RELAXED, __HIP_MEMORY_SCOPE_AGENT); }
__device__ __forceinline__ unsigned xb_xcc_id() { return (unsigned)__builtin_amdgcn_s_getreg((3 << 11) | 20) & 0xFu; }
#define XB_SPIN(cond, bar) do { unsigned _sp = 0; while (cond) { __builtin_amdgcn_s_sleep(1); \
    if ((++_sp & 255u) == 0u) { if (xb_ld(&(bar)[XB_TMO])) break; if (_sp > XB_SPIN_CAP) { atomicAdd(&(bar)[XB_TMO], 1u); break; } } } } while (0)
struct XcdBarrier { unsigned* bar; unsigned x; volatile LAS unsigned* st; };
__device__ __forceinline__ XcdBarrier xcd_barrier_post(unsigned* bar, volatile LAS unsigned* st) {
    XcdBarrier b; b.bar = bar; b.x = xb_xcc_id(); b.st = st;
    if (threadIdx.x == 0) (void)xb_add(&bar[XB_XCNT(b.x)], 1u);
    return b;
}
__device__ __forceinline__ void xcd_barrier_complete(unsigned* bar, unsigned x, unsigned& nloc, unsigned& nx) {
    const unsigned G = gridDim.x * gridDim.y * gridDim.z;
    unsigned sum, cnt, mine, sp = 0u;
    for (;;) {
        sum = 0u; cnt = 0u; mine = 0u;
#pragma unroll
        for (unsigned j = 0; j < 16; ++j) { const unsigned c = xb_ld(&bar[XB_XCNT(j)]); sum += c; cnt += (c > 0u) ? 1u : 0u; mine = (j == x) ? c : mine; }
        if (sum == G) break;
        __builtin_amdgcn_s_sleep(1);
        if ((++sp & 255u) == 0u) { if (xb_ld(&bar[XB_TMO])) break; if (sp > XB_SPIN_CAP) { atomicAdd(&bar[XB_TMO], 1u); break; } }
    }
    nloc = mine > 0u ? mine : 1u; nx = cnt > 0u ? cnt : 1u;
}
__device__ __forceinline__ void xcd_barrier(const XcdBarrier& b) {
    asm volatile("s_waitcnt vmcnt(0)" ::: "memory");
    __syncthreads();
    if (threadIdx.x == 0) {
        unsigned* bar = b.bar;
        __builtin_amdgcn_s_waitcnt(0);
        unsigned nloc = b.st[0], nx = b.st[1];
        if (nloc == 0u) { xcd_barrier_complete(bar, b.x, nloc, nx); b.st[0] = nloc; b.st[1] = nx; }
        const unsigned old = xb_add(&bar[XB_XSUB(b.x)], 1u);
        const unsigned gen = old / nloc;
        if (old + 1u == (gen + 1u) * nloc) {
            __builtin_amdgcn_fence(__ATOMIC_RELEASE, "agent");
            asm volatile("s_waitcnt vmcnt(0)" ::: "memory");
            const unsigned og = xb_add(&bar[XB_TOP], 1u);
            const unsigned tg = og / nx;
            if (og + 1u == (tg + 1u) * nx) xb_add(&bar[XB_TOPGEN], 1u);
            else XB_SPIN(xb_ld(&bar[XB_TOPGEN]) == tg, bar);
            __builtin_amdgcn_fence(__ATOMIC_ACQUIRE, "agent");
            xb_add(&bar[XB_XGEN(b.x)], 1u);
            asm volatile("s_waitcnt vmcnt(0)" ::: "memory");
        } else {
            XB_SPIN(xb_ld(&bar[XB_XGEN(b.x)]) == gen, bar);
            __builtin_amdgcn_fence(__ATOMIC_ACQUIRE, "agent");
            asm volatile("s_waitcnt vmcnt(0)" ::: "memory");
        }
    }
    __syncthreads();
}

struct Args { const float* in[38]; float* out; unsigned char* ws; int ph_lo, ph_hi, li, pad; };
struct Frame {
    LAS unsigned char* lds;
    int tid, lane, wave, G, gw, NGW;
    int gt, NGT;
};
enum { I_X = 0, I_META, I_NORM_MIX0, I_WIN0, I_CONVW, I_CONVB, I_GAW, I_GAB, I_GXW, I_GXB, I_LAM, I_LRE, I_LIM, I_LDT, I_BRE, I_BIM, I_CRE, I_CIM, I_SD, I_GLUW, I_GLUB, I_WOUT0, I_NORM_FFN0,
       I_FG, I_FU, I_FD, I_NORM_MIX1, I_WIN1, I_GW2, I_GB, I_GNORM, I_WOUT1, I_NORM_FFN1, I_ROUTER, I_MG, I_MU, I_MD, I_FNORM };

struct SchedStatic {
    int nM, nN, G, c; const char* A; const char* B; size_t aStep, bStep; int aColDiv; size_t aColStep;
    __device__ __forceinline__ bool next(int i, pg8::Unit& u) const {
        int pm, pn; if (!pg8::static_tile(i, G, c, nM, nN, pm, pn)) return false;
        u.pm = pm; u.pn = pn; u.slot = i; u.a = A + (size_t)pm * aStep + (aColDiv ? (size_t)(pn / aColDiv) * aColStep : 0); u.b = B + (size_t)pn * bStep; return true;
    }
};
struct SchedList {
    int n; const LAS int* meta; const char* A; const char* B; size_t aStep, bTile, bExpert;
    __device__ __forceinline__ bool next(int i, pg8::Unit& u) const {
        if (i >= n) return false;
        const int pm = meta[i * 4 + 0], pn = meta[i * 4 + 1], e = meta[i * 4 + 2];
        u.pm = pm; u.pn = pn; u.slot = i; const int ko = meta[i * 4 + 3]; u.a = A + (size_t)pm * aStep + (size_t)ko * 2; u.b = B + (size_t)e * bExpert + (size_t)pn * bTile + (size_t)ko * 2; return true;
    }
};

#define EPI_ROWS(ai, m) ((ai) * 128 + wr * 64 + (m) * 16 + fr)
#define EPI_COLP(bj) ((bj) * 128 + wc * 32 + 8 * fq)
#define EPI_COLN(bj, n) ((bj) * 128 + wc * 32 + 16 * (n) + 4 * fq)
typedef const f32x4 (&AccRef)[2][2][4][2];
__device__ __forceinline__ void unpack8(v4u w, f32x4& a, f32x4& b) { a = (f32x4){bflo(w.x), bfhi(w.x), bflo(w.y), bfhi(w.y)}; b = (f32x4){bflo(w.z), bfhi(w.z), bflo(w.w), bfhi(w.w)}; }
__device__ __forceinline__ v4u pack8(f32x4 a, f32x4 b) { v4u w; w.x = pg8::cvt_pk_bf16(a[0], a[1]); w.y = pg8::cvt_pk_bf16(a[2], a[3]); w.z = pg8::cvt_pk_bf16(b[0], b[1]); w.w = pg8::cvt_pk_bf16(b[2], b[3]); return w; }

template <int D> __device__ __forceinline__ float ror16(float v) { return __builtin_bit_cast(float, __builtin_amdgcn_update_dpp(0, __builtin_bit_cast(int, v), 0x120 + D, 0xF, 0xF, false)); }
struct EpiWin0 {
    static constexpr bool PERM = true; bf16 *G, *XR, *U; const float *cw, *cb; bf16* XC;
    __device__ __forceinline__ void operator()(AccRef acc, const pg8::Unit& u, int wr, int wc, int fr, int fq) const {
        const int pn = u.pn; bf16* base; int ld, c0;
        if (pn >= 4 && pn < 8) {
#pragma unroll
            for (int bj = 0; bj < 2; ++bj)
#pragma unroll
              for (int n = 0; n < 2; ++n) { const int cc = (pn - 4) * 256 + EPI_COLP(bj) + 4 * n;
                f32x4 w0 = *(const f32x4*)(cw + cc), w1 = *(const f32x4*)(cw + 1024 + cc), w2 = *(const f32x4*)(cw + 2048 + cc), w3 = *(const f32x4*)(cw + 3072 + cc); const f32x4 bb = *(const f32x4*)(cb + cc);
#pragma unroll
                for (int ai = 0; ai < 2; ++ai) { f32x4 q1 = {0.f, 0.f, 0.f, 0.f}, q2 = q1, q3 = q1;
#pragma unroll
                    for (int m = 0; m < 4; ++m) { const size_t ro = (size_t)(u.pm * 256 + EPI_ROWS(ai, m)) * 1024 + cc; const f32x4 x = acc[ai][bj][m][n]; f32x4 t1, t2, t3, p1, p2, p3;
#pragma unroll
                        for (int j = 0; j < 4; ++j) { t1[j] = ror16<1>(x[j]); t2[j] = ror16<2>(x[j]); t3[j] = ror16<3>(x[j]);
                            p1[j] = fr >= 1 ? t1[j] : q1[j]; p2[j] = fr >= 2 ? t2[j] : q2[j]; p3[j] = fr >= 3 ? t3[j] : q3[j]; }
                        const f32x4 o = bb + w0 * p3 + w1 * p2 + w2 * p1 + w3 * x;
                        q1 = t1; q2 = t2; q3 = t3;
                        const bool fix = (m == 0) && fr < 3;
                        if (!fix) *(v2u*)(XC + ro) = (v2u){pk2(o.x, o.y), pk2(o.z, o.w)};
                        if (fix || ((m == 3) && fr >= 13)) *(v2u*)(XR + ro) = (v2u){pk2(x.x, x.y), pk2(x.z, x.w)};
                        asm volatile("" : "+v"(q1), "+v"(q2), "+v"(q3) :: "memory"); } } }
            return; }
        if (pn < 4) { base = G; ld = 1024; c0 = pn * 256; } else if (pn < 8) { base = XR; ld = 1024; c0 = (pn - 4) * 256; } else { base = U; ld = 512; c0 = (pn - 8) * 256; }
#pragma unroll
        for (int ai = 0; ai < 2; ++ai)
#pragma unroll
            for (int m = 0; m < 4; ++m) { bf16* rowp = base + (size_t)(u.pm * 256 + EPI_ROWS(ai, m)) * ld + c0;
#pragma unroll
                for (int bj = 0; bj < 2; ++bj) { f32x4 v0 = acc[ai][bj][m][0], v1 = acc[ai][bj][m][1];
                    if (pn < 4) {
#pragma unroll
                        for (int j = 0; j < 1; ++j) { v0 = gelu_tanh_4(v0); v1 = gelu_tanh_4(v1); } }
                    *(v4u*)(rowp + EPI_COLP(bj)) = pack8(v0, v1); } }
    }
};
struct EpiGates {
    static constexpr bool PERM = true; const float *gab, *gxb, *sp8; const bf16* XC; bf16* A; bf16* BX;
    __device__ __forceinline__ void operator()(AccRef acc, const pg8::Unit& u, int wr, int wc, int fr, int fq) const {
        const int ch0 = (u.pn >> 1) * 256 + (u.pn & 1) * 128 + wc * 32 + 8 * fq;
        f32x4 ba[2], bx[2], sp[2];
#pragma unroll
        for (int n = 0; n < 2; ++n) { ba[n] = *(const f32x4*)(gab + ch0 + 4 * n); bx[n] = *(const f32x4*)(gxb + ch0 + 4 * n); sp[n] = *(const f32x4*)(sp8 + ch0 + 4 * n); }
#pragma unroll
        for (int ai = 0; ai < 2; ++ai)
#pragma unroll
            for (int m = 0; m < 4; ++m) { const size_t ro = (size_t)(u.pm * 256 + EPI_ROWS(ai, m)) * 1024 + ch0;
                const v4u xw = *(const v4u*)(XC + ro); f32x4 xv[2]; unpack8(xw, xv[0], xv[1]);
                f32x4 av[2], bv[2];
#pragma unroll
                for (int n = 0; n < 2; ++n) { const f32x4 r = sigmoid_4(acc[ai][0][m][n] + ba[n]), ig = sigmoid_4(acc[ai][1][m][n] + bx[n]);
                    const f32x4 la = r * sp[n] * -1.0f, aa = exp2_4(la * 1.4426950408889634f); f32x4 om = aa * aa * -1.0f + 1.0f, sq;
#pragma unroll
                    for (int j = 0; j < 4; ++j) sq[j] = __builtin_amdgcn_sqrtf(fmaxf(om[j], 0.0f));
                    av[n] = la; bv[n] = sq * ig * xv[n]; }
                *(v4u*)(A + ro) = pack8(av[0], av[1]); *(v4u*)(BX + ro) = pack8(bv[0], bv[1]); asm volatile("" ::: "memory"); }
    }
};
struct EpiGlu {
    static constexpr bool PERM = true; const float* glub; const bf16* GS; bf16* AOUT;
    __device__ __forceinline__ void operator()(AccRef acc, const pg8::Unit& u, int wr, int wc, int fr, int fq) const {
#pragma unroll
        for (int bj = 0; bj < 2; ++bj) { const int c = u.pn * 256 + EPI_COLP(bj); const f32x4 b0 = *(const f32x4*)(glub + c), b1 = *(const f32x4*)(glub + c + 4);
#pragma unroll
            for (int ai = 0; ai < 2; ++ai)
#pragma unroll
                for (int m = 0; m < 4; ++m) { const size_t row = (size_t)(u.pm * 256 + EPI_ROWS(ai, m));
                    f32x4 g0_, g1_; unpack8(*(const v4u*)(GS + row * 512 + c), g0_, g1_);
                    const f32x4 v0 = g0_ * sigmoid_4(acc[ai][bj][m][0] + b0), v1 = g1_ * sigmoid_4(acc[ai][bj][m][1] + b1);
                    *(v4u*)(AOUT + row * 1536 + 1024 + c) = pack8(v0, v1); } }
    }
};
struct EpiResid {
    static constexpr bool PERM = true; const float* xsrc; bf16* hb; float* ssqp;
    __device__ __forceinline__ void operator()(AccRef acc, const pg8::Unit& u, int wr, int wc, int fr, int fq) const {
        float q[2][4];
#pragma unroll
        for (int ai = 0; ai < 2; ++ai)
#pragma unroll
            for (int m = 0; m < 4; ++m) { const size_t ro = (size_t)(u.pm * 256 + EPI_ROWS(ai, m)) * 1024 + u.pn * 256; float qs = 0.f;
#pragma unroll
                for (int bj = 0; bj < 2; ++bj) { const size_t o = ro + EPI_COLP(bj); f32x4 v0, v1;
                    if (xsrc) { v0 = *(const f32x4*)(xsrc + o); v1 = *(const f32x4*)(xsrc + o + 4); } else unpack8(*(const v4u*)(hb + o), v0, v1);
                    v0 += acc[ai][bj][m][0]; v1 += acc[ai][bj][m][1];
                    { const f32x4 sq_ = v0 * v0 + v1 * v1; qs += (sq_.x + sq_.y) + (sq_.z + sq_.w); }
                    *(v4u*)(hb + o) = pack8(v0, v1); }
                q[ai][m] = qs; }
        if (ssqp) {
#pragma unroll
            for (int ai = 0; ai < 2; ++ai)
#pragma unroll
                for (int m = 0; m < 4; ++m) { float t = q[ai][m]; t += __shfl_xor(t, 16); t += __shfl_xor(t, 32);
                    if (fq == 0) ssqp[(size_t)(u.pm * 256 + EPI_ROWS(ai, m)) * 16 + u.pn * 4 + wc] = t; } }
    }
};
__device__ __forceinline__ f32x4 swiglu4_x32(f32x4 G, f32x4 U) {
    const f32x4 a = G * (-1.4426950408889634f / 32.0f) + 10.0f; f32x4 t;
#pragma unroll
    for (int j = 0; j < 4; ++j) t[j] = __builtin_amdgcn_exp2f(a[j]);
    const f32x4 d = t + 1024.0f; f32x4 q;
#pragma unroll
    for (int j = 0; j < 4; ++j) q[j] = rcpf_(d[j]);
    return (G * U) * q; }
__device__ __forceinline__ f32x4 swiglu4_r(f32x4 G, f32x4 U, float r2, float rl) {
    const f32x4 a = G * rl; f32x4 t;
#pragma unroll
    for (int j = 0; j < 4; ++j) t[j] = __builtin_amdgcn_exp2f(a[j]);
    const f32x4 d = t + 1.0f; f32x4 q;
#pragma unroll
    for (int j = 0; j < 4; ++j) q[j] = rcpf_(d[j]);
    return (G * U) * (q * r2); }
__device__ __forceinline__ float rstd_of(const float* ssqp, size_t row) { const f32x4* p = (const f32x4*)(ssqp + row * 16); const f32x4 a = p[0], b = p[1], c = p[2], d = p[3];
    const f32x4 t = (a + b) + (c + d); return __builtin_amdgcn_rsqf(((t.x + t.y) + (t.z + t.w)) * (1.0f / 1024.0f) + EPS); }
constexpr int FOLD_MAXU = 20;
__device__ __forceinline__ float fold_rstd(const LAS float* rst, const float* ssqp, const pg8::Unit& u, int r) { return u.slot < FOLD_MAXU ? rst[u.slot * 256 + r] : rstd_of(ssqp, (size_t)(u.pm * 256 + r)); }
struct EpiSwiglu {
    static constexpr bool PERM = true; bf16* H; int ld; const float* ssqp; const LAS float* rst;
    __device__ __forceinline__ void operator()(AccRef acc, const pg8::Unit& u, int wr, int wc, int fr, int fq) const {
        const int c = u.pn * 128 + wc * 32 + 8 * fq;
        float rs[2][4];
#pragma unroll
        for (int ai = 0; ai < 2; ++ai)
#pragma unroll
            for (int m = 0; m < 4; ++m) rs[ai][m] = fold_rstd(rst, ssqp, u, EPI_ROWS(ai, m));
#pragma unroll
        for (int ai = 0; ai < 2; ++ai)
#pragma unroll
            for (int m = 0; m < 4; ++m) { const float r = rs[ai][m], r2 = r * r, rl = r * -1.4426950408889634f;
                const f32x4 v0 = swiglu4_r(acc[ai][0][m][0], acc[ai][1][m][0], r2, rl), v1 = swiglu4_r(acc[ai][0][m][1], acc[ai][1][m][1], r2, rl);
                *(v4u*)(H + (size_t)(u.pm * 256 + EPI_ROWS(ai, m)) * ld + c) = pack8(v0, v1); }
    }
};
struct EpiWin1 {
    static constexpr bool PERM = true; bf16 *Q, *K, *V, *GATE; bf16* LG; const float* gb; const float* ssqp; const LAS float* rst;
    __device__ __forceinline__ void operator()(AccRef acc, const pg8::Unit& u, int wr, int wc, int fr, int fq) const {
        const int pn = u.pn;
        float rs[2][4];
#pragma unroll
        for (int ai = 0; ai < 2; ++ai)
#pragma unroll
            for (int m = 0; m < 4; ++m) rs[ai][m] = fold_rstd(rst, ssqp, u, EPI_ROWS(ai, m));
#pragma unroll
        for (int ai = 0; ai < 2; ++ai)
#pragma unroll
            for (int m = 0; m < 4; ++m) { const size_t row = (size_t)(u.pm * 256 + EPI_ROWS(ai, m)); const float r = rs[ai][m];
#pragma unroll
                for (int bj = 0; bj < 2; ++bj) { f32x4 v0 = acc[ai][bj][m][0] * r, v1 = acc[ai][bj][m][1] * r; const int cc = EPI_COLP(bj);
                    if (pn < 2) { v0 = v0 * 0.08838834764831845f; v1 = v1 * 0.08838834764831845f; *(v4u*)(Q + row * 512 + pn * 256 + cc) = pack8(v0, v1); }
                    else if (pn < 4) { *(v4u*)(K + row * 512 + (pn - 2) * 256 + cc) = pack8(v0, v1); }
                    else if (pn < 8) { *(v4u*)(V + row * 1024 + (pn - 4) * 256 + cc) = pack8(v0, v1); }
                    else if (pn < 12) {
#pragma unroll
                        for (int j = 0; j < 1; ++j) { v0 = silu_4(v0); v1 = silu_4(v1); }
                        *(v4u*)(GATE + row * 1024 + (pn - 8) * 256 + cc) = pack8(v0, v1); }
                    else { const int c = (pn - 12) * 256 + cc; const f32x4 b0 = *(const f32x4*)(gb + c), b1 = *(const f32x4*)(gb + c + 4);
#pragma unroll
                        for (int j = 0; j < 1; ++j) { v0 = logsig2_4(v0 + b0); v1 = logsig2_4(v1 + b1); }
                        *(v4u*)(LG + row * 512 + c) = pack8(v0, v1); } } }
    }
};
__device__ __forceinline__ float swiglu_x32(float G, float U) { const float t = __builtin_amdgcn_exp2f(__builtin_fmaf(G, -1.4426950408889634f / 32.0f, 10.0f)); return (G * U) * rcpf_(1024.0f + t); }
struct EpiSwiglu8 {
    static constexpr bool PERM = true; unsigned char* H; int ld;
    __device__ __forceinline__ void operator()(AccRef acc, const pg8::Unit& u, int wr, int wc, int fr, int fq) const {
        const int c = u.pn * 128 + wc * 32 + 8 * fq; constexpr float SC = 1.0f / 32.0f;
#pragma unroll
        for (int ai = 0; ai < 2; ++ai)
#pragma unroll
            for (int m = 0; m < 4; ++m) { float v[8];
#pragma unroll
                for (int j = 0; j < 1; ++j) { const f32x4 o0 = swiglu4_x32(acc[ai][0][m][0], acc[ai][1][m][0]), o1 = swiglu4_x32(acc[ai][0][m][1], acc[ai][1][m][1]);
                    v[0] = o0.x; v[1] = o0.y; v[2] = o0.z; v[3] = o0.w; v[4] = o1.x; v[5] = o1.y; v[6] = o1.z; v[7] = o1.w; }
                *(v2u*)(H + (size_t)(u.pm * 256 + EPI_ROWS(ai, m)) * ld + c) = (v2u){pk4_fp8(v[0], v[1], v[2], v[3]), pk4_fp8(v[4], v[5], v[6], v[7])}; }
    }
};
struct EpiMoeDown {
    static constexpr bool PERM = true; bf16* hb; const LAS int* toks; const LAS float* wts;
    __device__ __forceinline__ void operator()(AccRef acc, const pg8::Unit& u, int wr, int wc, int fr, int fq) const {
#pragma unroll
        for (int ai = 0; ai < 2; ++ai)
#pragma unroll
            for (int m = 0; m < 4; ++m) { const int rl = u.slot * 256 + EPI_ROWS(ai, m); const int tok = toks[rl]; const float w = wts[rl] * (1.0f / 64.0f);
                if (tok >= 0) { bf16* d = hb + (size_t)tok * 1024 + u.pn * 256;
#pragma unroll
                    for (int bj = 0; bj < 2; ++bj) { bf16* p = d + EPI_COLP(bj); f32x4 v0, v1; unpack8(*(const v4u*)p, v0, v1); *(v4u*)p = pack8(v0 + acc[ai][bj][m][0] * w, v1 + acc[ai][bj][m][1] * w); } } }
    }
};
struct EpiSlab {
    static constexpr bool PERM = false; float* slab; const LAS int* meta;
    __device__ __forceinline__ void operator()(AccRef acc, const pg8::Unit& u, int wr, int wc, int fr, int fq) const {
        const int sl = meta[u.slot * 4 + 3] / 256; float* base = slab + ((size_t)(sl * 8 + (u.pm - 128)) * 256) * 1024 + u.pn * 256;
#pragma unroll
        for (int ai = 0; ai < 2; ++ai)
#pragma unroll
            for (int m = 0; m < 4; ++m) { float* d = base + (size_t)EPI_ROWS(ai, m) * 1024;
#pragma unroll
                for (int bj = 0; bj < 2; ++bj)
#pragma unroll
                    for (int n = 0; n < 2; ++n) *(f32x4*)(d + EPI_COLN(bj, n)) = acc[ai][bj][m][n] * (1.0f / 64.0f); }
    }
};

__device__ __forceinline__ void tr_item8(const float* W, int ldw, int col, int k0, unsigned char* WT, int ldt, int drow, float scale, LAS float* scr, int lane) {
    float wv[32];
#pragma unroll
    for (int i = 0; i < 32; ++i) wv[i] = __builtin_nontemporal_load(W + (size_t)(k0 + 2 * i + (lane >> 5)) * ldw + col + (lane & 31));
#pragma unroll
    for (int i = 0; i < 32; i += 2) { const f32x2 sv = (f32x2){wv[i], wv[i + 1]} * scale; scr[(2 * i + (lane >> 5)) * 33 + (lane & 31)] = sv.x; scr[(2 * i + 2 + (lane >> 5)) * 33 + (lane & 31)] = sv.y; }
    LDS_WAIT(); asm volatile("" ::: "memory");
    const int c = lane & 7;
#pragma unroll
    for (int j = 0; j < 4; ++j) { const int n = (lane >> 3) + 8 * j; const LAS float* s = scr + (8 * c) * 33 + n;
        *(v2u*)(WT + (size_t)(drow + n) * ldt + k0 + 8 * c) = (v2u){pk4_fp8(s[0 * 33], s[1 * 33], s[2 * 33], s[3 * 33]), pk4_fp8(s[4 * 33], s[5 * 33], s[6 * 33], s[7 * 33])}; }
    LDS_WAIT(); asm volatile("" ::: "memory");
}
__device__ __forceinline__ void tr_item(const float* W, int ldw, int col, int k0, bf16* WT, int ldt, int drow, LAS float* scr, int lane, const float* rs = nullptr) {
    float wv[32];
#pragma unroll
    for (int i = 0; i < 32; ++i) wv[i] = __builtin_nontemporal_load(W + (size_t)(k0 + 2 * i + (lane >> 5)) * ldw + col + (lane & 31));
#pragma unroll
    for (int i = 0; i < 32; ++i) scr[(2 * i + (lane >> 5)) * 33 + (lane & 31)] = rs ? wv[i] * rs[k0 + 2 * i + (lane >> 5)] : wv[i];
    LDS_WAIT(); asm volatile("" ::: "memory");
    const int c = lane & 7;
#pragma unroll
    for (int j = 0; j < 4; ++j) { const int n = (lane >> 3) + 8 * j; const LAS float* s = scr + (8 * c) * 33 + n;
        v4u o; o.x = pk2(s[0 * 33], s[1 * 33]); o.y = pk2(s[2 * 33], s[3 * 33]); o.z = pk2(s[4 * 33], s[5 * 33]); o.w = pk2(s[6 * 33], s[7 * 33]);
        *(v4u*)(WT + (size_t)(drow + n) * ldt + k0 + 8 * c) = o; }
    LDS_WAIT(); asm volatile("" ::: "memory");
}
struct TrJob { const float* W; int ldw, col0, K, N; bf16* WT; int blk, bstride, add; const float* rs = nullptr; };
__device__ __forceinline__ bool tr_try(int& r, const TrJob& j, LAS float* scr, int lane) {
    const int nblk = j.N / 32, items = (j.K / 64) * nblk;
    if (r >= items) { r -= items; return false; }
    const int kb = r / nblk, n0 = (r % nblk) * 32;
    tr_item(j.W, j.ldw, j.col0 + n0, kb * 64, j.WT, j.K, (n0 / j.blk) * j.bstride + (n0 % j.blk) + j.add, scr, lane, j.rs);
    return true;
}
__device__ __forceinline__ void norm_row_bf16(const float* xrow, const float* gain, bf16* orow, int lane) {
    const f32x4* xr = (const f32x4*)xrow + lane; const f32x4* gr = (const f32x4*)gain + lane;
    f32x4 v[4]; float s = 0.f;
#pragma unroll
    for (int j = 0; j < 4; ++j) { v[j] = xr[64 * j]; s += (v[j].x * v[j].x + v[j].y * v[j].y) + (v[j].z * v[j].z + v[j].w * v[j].w); }
    const float rstd = 1.0f / sqrtf(wave_sum(s) * (1.0f / 1024.0f) + EPS);
    v2u* o8 = (v2u*)orow + lane;
#pragma unroll
    for (int j = 0; j < 4; ++j) { const f32x4 g = gr[64 * j]; v2u w; w.x = pk2(v[j].x * rstd * g.x, v[j].y * rstd * g.y); w.y = pk2(v[j].z * rstd * g.z, v[j].w * rstd * g.w); o8[64 * j] = w; }
}
__device__ __forceinline__ void norm_row_b2b(const bf16* hrow, const float* gain, bf16* orow, int lane) {
    f32x4 v[4]; unpack8(*(const v4u*)(hrow + 8 * lane), v[0], v[1]); unpack8(*(const v4u*)(hrow + 512 + 8 * lane), v[2], v[3]); float s = 0.f;
#pragma unroll
    for (int j = 0; j < 4; ++j) s += (v[j].x * v[j].x + v[j].y * v[j].y) + (v[j].z * v[j].z + v[j].w * v[j].w);
    const float rstd = 1.0f / sqrtf(wave_sum(s) * (1.0f / 1024.0f) + EPS);
    const f32x4 g0 = *(const f32x4*)(gain + 8 * lane), g1 = *(const f32x4*)(gain + 8 * lane + 4), g2 = *(const f32x4*)(gain + 512 + 8 * lane), g3 = *(const f32x4*)(gain + 512 + 8 * lane + 4);
    *(v4u*)(orow + 8 * lane) = pack8(v[0] * rstd * g0, v[1] * rstd * g1); *(v4u*)(orow + 512 + 8 * lane) = pack8(v[2] * rstd * g2, v[3] * rstd * g3);
}

__device__ __forceinline__ void cexp_f(double re, double im, float& er, float& ei) {
    const float mag = __expf((float)re); double rev = im * 0.15915494309189535; rev -= floor(rev); const float fr_ = (float)rev;
    er = mag * __builtin_amdgcn_cosf(fr_); ei = mag * __builtin_amdgcn_sinf(fr_);
}
__device__ __forceinline__ void p0_prologue(const Frame& F, const Args& a, unsigned char* ws) {
    LAS float* scr = (LAS float*)(F.lds + RING_OFF + F.wave * 16384);
    const float* const* in = a.in;
    constexpr int BIG = 1 << 30;
    for (int it = F.gw; ; it += F.NGW) {
        int r = it;
        { TrJob j{in[I_WIN0], EV_IN, 0, 1024, EV_IN, (bf16*)(ws + WS_WIN0), BIG, 0, 0}; if (tr_try(r, j, scr, F.lane)) continue; }
        bool done = false;
        for (int h = 0; h < 4 && !done; ++h) {
            { TrJob j{in[I_GAW] + (size_t)h * 65536, 256, 0, 256, 256, (bf16*)(ws + WS_GW) + (size_t)h * 512 * 256, 128, 256, 0}; if (tr_try(r, j, scr, F.lane)) { done = true; break; } }
            { TrJob j{in[I_GXW] + (size_t)h * 65536, 256, 0, 256, 256, (bf16*)(ws + WS_GW) + (size_t)h * 512 * 256, 128, 256, 128}; if (tr_try(r, j, scr, F.lane)) { done = true; break; } }
        }
        if (done) continue;
        { TrJob j{in[I_GLUW], 512, 0, 512, 512, (bf16*)(ws + WS_GLUW), BIG, 0, 0}; if (tr_try(r, j, scr, F.lane)) continue; }
        { TrJob j{in[I_WOUT0], 1024, 0, EV_MIX, 1024, (bf16*)(ws + WS_WOUT0), BIG, 0, 0}; if (tr_try(r, j, scr, F.lane)) continue; }
        { TrJob j{in[I_FG], FF0, 0, 1024, FF0, (bf16*)(ws + WS_WUP0), 128, 256, 0, in[I_NORM_FFN0]}; if (tr_try(r, j, scr, F.lane)) continue; }
        { TrJob j{in[I_FU], FF0, 0, 1024, FF0, (bf16*)(ws + WS_WUP0), 128, 256, 128, in[I_NORM_FFN0]}; if (tr_try(r, j, scr, F.lane)) continue; }
        { TrJob j{in[I_FD], 1024, 0, FF0, 1024, (bf16*)(ws + WS_WDN0), BIG, 0, 0}; if (tr_try(r, j, scr, F.lane)) continue; }
        { TrJob j{in[I_WIN1], OD_IN, 0, 1024, 3072, (bf16*)(ws + WS_WIN1), BIG, 0, 0, in[I_NORM_MIX1]}; if (tr_try(r, j, scr, F.lane)) continue; }
        { TrJob j{in[I_WOUT1], 1024, 0, 1024, 1024, (bf16*)(ws + WS_WOUT1), BIG, 0, 0}; if (tr_try(r, j, scr, F.lane)) continue; }
        break;
    }
    for (long i = F.gt; i < 512L * 1024; i += F.NGT) { const int j = (int)(i & 511), k = (int)(i >> 9); const float* wr_ = in[I_WIN1] + (size_t)k * OD_IN + 3072; const float* w2 = in[I_GW2] + j; float s = 0.f;
#pragma unroll
        for (int r = 0; r < 16; ++r) s += wr_[r] * w2[r * 512];
        ((bf16*)(ws + WS_WIN1))[(size_t)(3072 + j) * 1024 + k] = (bf16)f2bf(s * in[I_NORM_MIX1][k]); }
    float* tab = (float*)(ws + WS_TAB);
    for (long i = F.gt; i < NG * NS; i += F.NGT) { const int g = (int)i / NS;
        const double lr = in[I_LRE][i], li = in[I_LIM][i], dt = (double)expf(in[I_LDT][g]);
        float arf, aif, a64r, a64i; cexp_f(dt * lr, dt * li, arf, aif); cexp_f(64.0 * dt * lr, 64.0 * dt * li, a64r, a64i);
        const float lrf = (float)lr, lif = (float)li, den = lrf * lrf + lif * lif, nr = arf - 1.0f;
        const float zr = (nr * lrf + aif * lif) / den, zi = (aif * lrf - nr * lif) / den;
        ((float*)((char*)tab + TB_AR))[i] = arf; ((float*)((char*)tab + TB_AI))[i] = aif;
        ((float*)((char*)tab + TB_AR64))[i] = a64r; ((float*)((char*)tab + TB_AI64))[i] = a64i;
        for (int h = 0; h < 16; ++h) { const float br = in[I_BRE][i * 16 + h], bi = in[I_BIM][i * 16 + h];
            ((float*)((char*)tab + TB_BBR))[i * 16 + h] = zr * br - zi * bi; ((float*)((char*)tab + TB_BBI))[i * 16 + h] = zr * bi + zi * br; } }
    for (long idx = F.gt; idx < (long)NG * NS * 64; idx += F.NGT) { const int i = (int)(idx & 63), gn = (int)(idx >> 6), g = gn / NS, n = gn % NS;
        const double lr = in[I_LRE][gn], li = in[I_LIM][gn], dt = (double)expf(in[I_LDT][g]);
        float ar1, ai1, pr, pi_; cexp_f(dt * lr, dt * li, ar1, ai1); const double pw = (double)(63 - i); cexp_f(pw * dt * lr, pw * dt * li, pr, pi_);
        const float lrf = (float)lr, lif = (float)li, den = lrf * lrf + lif * lif, nr1 = ar1 - 1.0f;
        const float zr = (nr1 * lrf + ai1 * lif) / den, zi = (ai1 * lrf - nr1 * lif) / den;
        float vre[16], vim[16];
#pragma unroll
        for (int h = 0; h < 16; ++h) { const float br = in[I_BRE][(size_t)gn * 16 + h], bi = in[I_BIM][(size_t)gn * 16 + h]; const float bbr = zr * br - zi * bi, bbi = zr * bi + zi * br;
            vre[h] = pr * bbr - pi_ * bbi; vim[h] = pr * bbi + pi_ * bbr; }
        const int rb = n >> 3, fre = (2 * n) & 15, ks = i >> 1;
#pragma unroll
        for (int hh = 0; hh < 2; ++hh) { const int fq = (i & 1) * 2 + hh; bf16* dst = (bf16*)(ws + WS_WE) + ((((size_t)g * 8 + rb) * 32 + ks) * 64 + 16 * fq + fre) * 8;
            *(v4u*)dst = (v4u){pk2(vre[8 * hh], vre[8 * hh + 1]), pk2(vre[8 * hh + 2], vre[8 * hh + 3]), pk2(vre[8 * hh + 4], vre[8 * hh + 5]), pk2(vre[8 * hh + 6], vre[8 * hh + 7])};
            *(v4u*)(dst + 8) = (v4u){pk2(vim[8 * hh], vim[8 * hh + 1]), pk2(vim[8 * hh + 2], vim[8 * hh + 3]), pk2(vim[8 * hh + 4], vim[8 * hh + 5]), pk2(vim[8 * hh + 6], vim[8 * hh + 7])}; } }
    for (long i = F.gt; i < 1024; i += F.NGT) { const float lam = in[I_LAM][i]; ((float*)((char*)tab + TB_SP8))[i] = 8.0f * log1pf(expf(-lam)); }
    bf16* HN = (bf16*)(ws + WS_HN); float* hmeta = (float*)(ws + WS_HMETA);
    { const float* gain0 = in[I_NORM_MIX0]; const int lane = F.lane; f32x4 gg[4];
#pragma unroll
      for (int j = 0; j < 4; ++j) gg[j] = ((const f32x4*)gain0)[lane + 64 * j];
      for (int m = F.gw; m < TR; m += 4 * F.NGW) { f32x4 xv[4][4];
#pragma unroll
        for (int q = 0; q < 4; ++q) { const int mm = m + q * F.NGW; if (mm < TR) {
#pragma unroll
            for (int j = 0; j < 4; ++j) xv[q][j] = __builtin_nontemporal_load((const f32x4*)(in[I_X] + (size_t)mm * 1024) + lane + 64 * j); } }
#pragma unroll
        for (int q = 0; q < 4; ++q) { const int mm = m + q * F.NGW; if (mm < TR) { float sq = 0.f;
#pragma unroll
            for (int j = 0; j < 1; ++j) { const f32x4 t_ = (xv[q][0] * xv[q][0] + xv[q][1] * xv[q][1]) + (xv[q][2] * xv[q][2] + xv[q][3] * xv[q][3]); sq += (t_.x + t_.y) + (t_.z + t_.w); }
            const float rstd = 1.0f / sqrtf(wave_sum(sq) * (1.0f / 1024.0f) + EPS); v2u* o8 = (v2u*)(HN + (size_t)mm * 1024) + lane;
#pragma unroll
            for (int j = 0; j < 4; ++j) { const f32x4 y = xv[q][j] * rstd * gg[j]; o8[64 * j] = (v2u){pk2(y.x, y.y), pk2(y.z, y.w)}; } } } }
      for (int m = TR + F.gw; m < TR + NMETA; m += F.NGW) norm_row_bf16(in[I_META] + (size_t)(m - TR) * 1024, gain0, HN + (size_t)m * 1024, lane); }
    for (long i = F.gt; i < NMETA * 1024; i += F.NGT) hmeta[i] = in[I_META][i];
}
__device__ __forceinline__ void norm_phase(const Frame& F, const bf16* HB, const float* hmeta, const float* gain, bf16* HN, int nrows) {
    const int lane = F.lane; const f32x4 g0 = *(const f32x4*)(gain + 8 * lane), g1 = *(const f32x4*)(gain + 8 * lane + 4), g2 = *(const f32x4*)(gain + 512 + 8 * lane), g3 = *(const f32x4*)(gain + 512 + 8 * lane + 4);
    for (int m = F.gw; m < TR; m += 4 * F.NGW) { v4u xa[4], xb[4];
#pragma unroll
        for (int q = 0; q < 4; ++q) { const int mm = m + q * F.NGW; if (mm < TR) { xa[q] = *(const v4u*)(HB + (size_t)mm * 1024 + 8 * lane); xb[q] = *(const v4u*)(HB + (size_t)mm * 1024 + 512 + 8 * lane); } }
#pragma unroll
        for (int q = 0; q < 4; ++q) { const int mm = m + q * F.NGW; if (mm < TR) { f32x4 v[4]; unpack8(xa[q], v[0], v[1]); unpack8(xb[q], v[2], v[3]); float sq = 0.f;
#pragma unroll
            for (int j = 0; j < 4; ++j) sq += (v[j].x * v[j].x + v[j].y * v[j].y) + (v[j].z * v[j].z + v[j].w * v[j].w);
            const float rstd = 1.0f / sqrtf(wave_sum(sq) * (1.0f / 1024.0f) + EPS);
            *(v4u*)(HN + (size_t)mm * 1024 + 8 * lane) = pack8(v[0] * rstd * g0, v[1] * rstd * g1); *(v4u*)(HN + (size_t)mm * 1024 + 512 + 8 * lane) = pack8(v[2] * rstd * g2, v[3] * rstd * g3); } } }
    for (int m = TR + F.gw; m < nrows; m += F.NGW) norm_row_bf16(hmeta + (size_t)(m - TR) * 1024, gain, HN + (size_t)m * 1024, F.lane);
}
__device__ __forceinline__ float row16_sum(float q) {
    q += __builtin_bit_cast(float, __builtin_amdgcn_update_dpp(0, __builtin_bit_cast(int, q), 0xB1, 0xF, 0xF, true));
    q += __builtin_bit_cast(float, __builtin_amdgcn_update_dpp(0, __builtin_bit_cast(int, q), 0x4E, 0xF, 0xF, true));
    q += __builtin_bit_cast(float, __builtin_amdgcn_update_dpp(0, __builtin_bit_cast(int, q), 0x141, 0xF, 0xF, true));
    q += __builtin_bit_cast(float, __builtin_amdgcn_update_dpp(0, __builtin_bit_cast(int, q), 0x140, 0xF, 0xF, true));
    return q;
}
__device__ __forceinline__ int cu_queue_next(LAS int* q, int lane) { int v = 0; if (lane == 0) v = __hip_atomic_fetch_add(q, 1, __ATOMIC_RELAXED, __HIP_MEMORY_SCOPE_WORKGROUP); return __builtin_amdgcn_readfirstlane(v); }
__device__ __forceinline__ const bf16* meta_norm_local(const Frame& F, unsigned char* ws, const float* hmeta) {
    bf16* priv = (bf16*)(ws + WS_MPRIV) + (size_t)blockIdx.x * NMETA * 1024;
    for (int r = F.wave; r < NMETA; r += 8) { const f32x4* xr = (const f32x4*)(hmeta + (size_t)r * 1024) + F.lane; f32x4 v[4]; float sq = 0.f;
#pragma unroll
        for (int j = 0; j < 4; ++j) { v[j] = xr[64 * j]; sq += (v[j].x * v[j].x + v[j].y * v[j].y) + (v[j].z * v[j].z + v[j].w * v[j].w); }
        const float rstd = 1.0f / sqrtf(wave_sum(sq) * (1.0f / 1024.0f) + EPS); v2u* o8 = (v2u*)(priv + (size_t)r * 1024) + F.lane;
#pragma unroll
        for (int j = 0; j < 4; ++j) { const f32x4 y = v[j] * rstd; o8[64 * j] = (v2u){pk2(y.x, y.y), pk2(y.z, y.w)}; } }
    asm volatile("s_waitcnt vmcnt(0)" ::: "memory"); __syncthreads();
    return priv;
}
__device__ __forceinline__ int seq_prev(int row, int back) {
    if (row >= TR) { const int i = row - TR - back; return i >= 0 ? TR + i : -1; }
    const int t = row & (SEQ - 1); return t >= back ? row - back : TR + NMETA + (t - back);
}
__device__ __forceinline__ void conv_item(int i, const bf16* XR, const float* cw, const float* cb, bf16* XC) {
    if (i < (TR / 32 + 1) * 128) { const int c = (int)(i & 127) * 8, st = (int)(i >> 7); const bool meta = st >= TR / 32; const int r0 = meta ? RM0 : st * 32, nr = meta ? NMETA : 32;
        f32x4 w[4][2]; f32x4 b0 = *(const f32x4*)(cb + c), b1 = *(const f32x4*)(cb + c + 4);
#pragma unroll
        for (int k = 0; k < 4; ++k) { w[k][0] = *(const f32x4*)(cw + k * 1024 + c); w[k][1] = *(const f32x4*)(cw + k * 1024 + c + 4); }
        f32x4 h[3][2];
#pragma unroll
        for (int k = 0; k < 3; ++k) { const int src = seq_prev(r0, 3 - k); if (src >= 0) unpack8(*(const v4u*)(XR + (size_t)src * 1024 + c), h[k][0], h[k][1]); else { h[k][0] = (f32x4){0.f, 0.f, 0.f, 0.f}; h[k][1] = h[k][0]; } }
        for (int t0 = 0; t0 < nr; t0 += 8) { v4u x[8];
#pragma unroll
            for (int t = 0; t < 8; ++t) x[t] = *(const v4u*)(XR + (size_t)(r0 + t0 + t) * 1024 + c);
#pragma unroll
            for (int t = 0; t < 8; ++t) { f32x4 c0, c1; unpack8(x[t], c0, c1);
                const f32x4 o0 = b0 + w[0][0] * h[0][0] + w[1][0] * h[1][0] + w[2][0] * h[2][0] + w[3][0] * c0, o1 = b1 + w[0][1] * h[0][1] + w[1][1] * h[1][1] + w[2][1] * h[2][1] + w[3][1] * c1;
                *(v4u*)(XC + (size_t)(r0 + t0 + t) * 1024 + c) = pack8(o0, o1);
                h[0][0] = h[1][0]; h[0][1] = h[1][1]; h[1][0] = h[2][0]; h[1][1] = h[2][1]; h[2][0] = c0; h[2][1] = c1; } } }
}
__device__ __forceinline__ void conv_fix_item(int i, const bf16* XR, const float* cw, const float* cb, bf16* XC) {
    if (i < (TR / 64) * 128) { const int c = (i & 127) * 8, r0 = (i >> 7) * 64;
        f32x4 w[4][2]; const f32x4 b0 = *(const f32x4*)(cb + c), b1 = *(const f32x4*)(cb + c + 4);
#pragma unroll
        for (int k = 0; k < 4; ++k) { w[k][0] = *(const f32x4*)(cw + k * 1024 + c); w[k][1] = *(const f32x4*)(cw + k * 1024 + c + 4); }
        v4u hx[3], xx[3];
#pragma unroll
        for (int k = 0; k < 3; ++k) { const int src = seq_prev(r0, 3 - k); hx[k] = *(const v4u*)(XR + (size_t)src * 1024 + c); xx[k] = *(const v4u*)(XR + (size_t)(r0 + k) * 1024 + c); }
        f32x4 h[3][2];
#pragma unroll
        for (int k = 0; k < 3; ++k) unpack8(hx[k], h[k][0], h[k][1]);
#pragma unroll
        for (int t = 0; t < 3; ++t) { f32x4 c0, c1; unpack8(xx[t], c0, c1);
            const f32x4 o0 = b0 + w[0][0] * h[0][0] + w[1][0] * h[1][0] + w[2][0] * h[2][0] + w[3][0] * c0, o1 = b1 + w[0][1] * h[0][1] + w[1][1] * h[1][1] + w[2][1] * h[2][1] + w[3][1] * c1;
            *(v4u*)(XC + (size_t)(r0 + t) * 1024 + c) = pack8(o0, o1);
            h[0][0] = h[1][0]; h[0][1] = h[1][1]; h[1][0] = h[2][0]; h[1][1] = h[2][1]; h[2][0] = c0; h[2][1] = c1; } }
}
constexpr int SSM_HP = 68, SSM_XP = 132;
constexpr int SSM_WLDS = 16 * SSM_XP * 4 + 16 * SSM_HP * 4;
struct SsmTab { float ar, ai; bf16x8 axf[8]; bf16x8 ca[4]; f32x4 dv; };
__device__ __forceinline__ void ssm_tab_load(SsmTab& T, const unsigned char* ws, const float* cre, const float* cim, const float* sd, int g, int lane) {
    const float* tab = (const float*)(ws + WS_TAB); const int gn = g * NS + lane, fr = lane & 15, fq = lane >> 4;
    T.ar = ((const float*)((const char*)tab + TB_AR))[gn]; T.ai = ((const float*)((const char*)tab + TB_AI))[gn];
#pragma unroll
    for (int rb = 0; rb < 8; ++rb) { const int r = 16 * rb + fr, n = r >> 1; const float* src = (const float*)((const char*)tab + ((r & 1) ? TB_BBI : TB_BBR)) + (size_t)(g * NS + n) * 16 + 8 * (fq & 1);
        v4u w = pack8(*(const f32x4*)src, *(const f32x4*)(src + 4)); if (fq >= 2) w = (v4u){0u, 0u, 0u, 0u}; T.axf[rb] = __builtin_bit_cast(bf16x8, w); }
#pragma unroll
    for (int ks = 0; ks < 4; ++ks) { const int n0 = 16 * ks + 4 * fq; const f32x4 cr = *(const f32x4*)(cre + (g * 16 + fr) * NS + n0), ci = *(const f32x4*)(cim + (g * 16 + fr) * NS + n0);
        v4u w; w.x = pk2(cr[0], -ci[0]); w.y = pk2(cr[1], -ci[1]); w.z = pk2(cr[2], -ci[2]); w.w = pk2(cr[3], -ci[3]); T.ca[ks] = __builtin_bit_cast(bf16x8, w); }
    T.dv = *(const f32x4*)(sd + g * 16 + 4 * fq);
}
__device__ __forceinline__ void ssm_wave(const SsmTab& T, const bf16* U, bf16* GS, int g, int row0, int ntok, float& hr, float& hi, int lane, LAS unsigned char* wl) {
    LAS float* xb = (LAS float*)wl; LAS unsigned* hb = (LAS unsigned*)(wl + 16 * SSM_XP * 4);
    const int fr = lane & 15, fq = lane >> 4; const float ar = T.ar, ai = T.ai;
    const f32x4 dv = T.dv;
    const bf16* ubase = U + (size_t)(row0 + fr) * 512 + g * 16;
    v4u bnx = {0u, 0u, 0u, 0u}; if (fq < 2) bnx = *(const v4u*)(ubase + 8 * fq);
    v2u unx = *(const v2u*)(ubase + 4 * fq);
    for (int t0 = 0; t0 < ntok; t0 += 16) {
        const v4u bw = bnx; const v2u uw = unx;
        if (t0 + 16 < ntok) { const bf16* un = ubase + (size_t)(t0 + 16) * 512; if (fq < 2) bnx = *(const v4u*)(un + 8 * fq); unx = *(const v2u*)(un + 4 * fq); }
        const bf16x8 bfr = __builtin_bit_cast(bf16x8, bw);
#pragma unroll
        for (int rb = 0; rb < 8; ++rb) { const f32x4 xa = __builtin_amdgcn_mfma_f32_16x16x32_bf16(T.axf[rb], bfr, (f32x4){0.f, 0.f, 0.f, 0.f}, 0, 0, 0); *(LAS f32x4*)(xb + fr * SSM_XP + 16 * rb + 4 * fq) = xa; }
        asm volatile("" ::: "memory");
#pragma unroll 4
        for (int tl = 0; tl < 16; ++tl) { const f32x2 x = *(const LAS f32x2*)(xb + tl * SSM_XP + 2 * lane);
            const float nr = ar * hr - ai * hi + x.x, ni = ar * hi + ai * hr + x.y; hr = nr; hi = ni;
            hb[tl * SSM_HP + lane] = pg8::cvt_pk_bf16(hr, hi); }
        asm volatile("" ::: "memory");
        f32x4 y = {0.f, 0.f, 0.f, 0.f};
#pragma unroll
        for (int ks = 0; ks < 4; ++ks) { const bf16x8 hbf = *(const LAS bf16x8*)(hb + fr * SSM_HP + 16 * ks + 4 * fq); y = __builtin_amdgcn_mfma_f32_16x16x32_bf16(T.ca[ks], hbf, y, 0, 0, 0); }
        const f32x4 go_ = gelu_tanh_4(y + dv * (f32x4){bflo(uw.x), bfhi(uw.x), bflo(uw.y), bfhi(uw.y)}); const float o0 = go_.x, o1 = go_.y, o2 = go_.z, o3 = go_.w;
        *(v2u*)(GS + (size_t)(row0 + t0 + fr) * 512 + g * 16 + 4 * fq) = (v2u){pk2(o0, o1), pk2(o2, o3)};
        asm volatile("" ::: "memory");
    }
    LDS_WAIT(); asm volatile("" ::: "memory");
}
__device__ __forceinline__ void ssm_l1_item(const Frame& F, int it, const unsigned char* ws, const bf16* U, float* SSE) {
    const int lane = F.lane, fr = lane & 15, fq = lane >> 4;
    if (it < NG * 32) { const int g = it >> 5, cb = it & 31, bc = cb * 16 + fr;
        const bf16* ap = (const bf16*)(ws + WS_WE) + ((size_t)g * 8 * 32 * 64 + lane) * 8;
        const bf16* bp = U + ((size_t)bc * 64 + (fq >> 1)) * 512 + g * 16 + 8 * (fq & 1);
        f32x4 acc[8];
#pragma unroll
        for (int rb = 0; rb < 8; ++rb) acc[rb] = (f32x4){0.f, 0.f, 0.f, 0.f};
#pragma unroll 4
        for (int ks = 0; ks < 32; ++ks) { const bf16x8 bfr = *(const bf16x8*)(bp + (size_t)ks * 2 * 512);
#pragma unroll
            for (int rb = 0; rb < 8; ++rb) { const bf16x8 afr = *(const bf16x8*)(ap + ((size_t)rb * 32 + ks) * 512); acc[rb] = __builtin_amdgcn_mfma_f32_16x16x32_bf16(afr, bfr, acc[rb], 0, 0, 0); } }
#pragma unroll
        for (int rb = 0; rb < 8; ++rb) *(f32x4*)(SSE + (((size_t)bc * NG + g) * NS + 8 * rb + 2 * fq) * 2) = acc[rb]; }
}
__device__ __forceinline__ void lru_l1_item(int lane, int bc, int ch, const bf16* A, const bf16* BX, float* PEND, float* HEND) {
    const int half = lane >> 5; const size_t r0 = (size_t)bc * 64 + half * 32;
    f32x4 P0 = {0.f, 0.f, 0.f, 0.f}, P1 = P0, H0 = P0, H1 = P0;
    for (int t0 = 0; t0 < 32; t0 += 8) { v4u la[8], bx[8];
#pragma unroll
        for (int t = 0; t < 8; ++t) { la[t] = *(const v4u*)(A + (r0 + t0 + t) * 1024 + ch); bx[t] = *(const v4u*)(BX + (r0 + t0 + t) * 1024 + ch); }
#pragma unroll
        for (int t = 0; t < 8; ++t) { f32x4 l0, l1, b0, b1; unpack8(la[t], l0, l1); unpack8(bx[t], b0, b1); P0 += l0; P1 += l1;
            H0 = exp2_4(l0 * 1.4426950408889634f) * H0 + b0; H1 = exp2_4(l1 * 1.4426950408889634f) * H1 + b1; } }
    f32x4 oP0, oP1, oH0, oH1;
#pragma unroll
    for (int j = 0; j < 4; ++j) { oP0[j] = __shfl_xor(P0[j], 32); oP1[j] = __shfl_xor(P1[j], 32); oH0[j] = __shfl_xor(H0[j], 32); oH1[j] = __shfl_xor(H1[j], 32); }
    if (half) {
#pragma unroll
        for (int j = 0; j < 4; ++j) { H0[j] = H0[j] + __expf(P0[j]) * oH0[j]; H1[j] = H1[j] + __expf(P1[j]) * oH1[j]; P0[j] = __expf(P0[j] + oP0[j]); P1[j] = __expf(P1[j] + oP1[j]); }
        float* pp = PEND + (size_t)bc * 1024 + ch; float* hp = HEND + (size_t)bc * 1024 + ch; *(f32x4*)pp = P0; *(f32x4*)(pp + 4) = P1; *(f32x4*)hp = H0; *(f32x4*)(hp + 4) = H1; }
}
__device__ __forceinline__ void carry_phase(const Frame& F, const unsigned char* ws, const bf16* A, const bf16* BX, const float* PEND, const float* HEND, float* CIN, const bf16* U, const float* SSE, float* SSIN) {
    const int gti = (F.wave * F.G + (int)blockIdx.x) * 64 + F.lane;
    if (gti < NB * 1024) { const int ch = gti & 1023, b = gti >> 10; float H = 0.f;
        { float ma[NMETA], mb[NMETA];
#pragma unroll
          for (int i = 0; i < NMETA; ++i) { const size_t r = (size_t)(RM0 + i); ma[i] = bf2f(A[r * 1024 + ch]); mb[i] = bf2f(BX[r * 1024 + ch]); }
#pragma unroll
          for (int i = 0; i < NMETA; ++i) H = __expf(ma[i]) * H + mb[i]; }
        for (int c0 = 0; c0 < NCH; c0 += 32) { float pp[32], hh[32];
#pragma unroll
            for (int c = 0; c < 32; ++c) { const size_t o = ((size_t)b * NCH + c0 + c) * 1024 + ch; pp[c] = PEND[o]; hh[c] = HEND[o]; }
#pragma unroll
            for (int c = 0; c < 32; ++c) { const size_t o = ((size_t)b * NCH + c0 + c) * 1024 + ch; CIN[o] = H; H = hh[c] + pp[c] * H; } }
    } else if (gti >= 8 * 512 && gti < 8 * 512 + NB * NG * NS) { const int id = gti - 8 * 512, n = id % NS, g = (id / NS) % NG, b = id / (NS * NG), gn = g * NS + n;
        const float* tab = (const float*)(ws + WS_TAB);
        const float ar = ((const float*)((const char*)tab + TB_AR))[gn], ai = ((const float*)((const char*)tab + TB_AI))[gn], ar64 = ((const float*)((const char*)tab + TB_AR64))[gn], ai64 = ((const float*)((const char*)tab + TB_AI64))[gn];
        float hr = 0.f, hi = 0.f;
        { f32x4 br[4], bi[4];
#pragma unroll
          for (int q = 0; q < 4; ++q) { br[q] = *(const f32x4*)((const char*)tab + TB_BBR + ((size_t)gn * 16 + 4 * q) * 4); bi[q] = *(const f32x4*)((const char*)tab + TB_BBI + ((size_t)gn * 16 + 4 * q) * 4); }
          for (int i0 = 0; i0 < NMETA; i0 += 8) { v4u uu[8][2];
#pragma unroll
            for (int i = 0; i < 8; ++i) { const bf16* up = U + (size_t)(RM0 + i0 + i) * 512 + g * 16; uu[i][0] = *(const v4u*)up; uu[i][1] = *(const v4u*)(up + 8); }
#pragma unroll
            for (int i = 0; i < 8; ++i) { f32x4 u0, u1, u2, u3; unpack8(uu[i][0], u0, u1); unpack8(uu[i][1], u2, u3); float xr = 0.f, xi = 0.f;
#pragma unroll
                for (int j = 0; j < 4; ++j) { xr += br[0][j] * u0[j]; xi += bi[0][j] * u0[j]; }
#pragma unroll
                for (int j = 0; j < 4; ++j) { xr += br[1][j] * u1[j]; xi += bi[1][j] * u1[j]; }
#pragma unroll
                for (int j = 0; j < 4; ++j) { xr += br[2][j] * u2[j]; xi += bi[2][j] * u2[j]; }
#pragma unroll
                for (int j = 0; j < 4; ++j) { xr += br[3][j] * u3[j]; xi += bi[3][j] * u3[j]; }
                const float nr = ar * hr - ai * hi + xr, ni = ar * hi + ai * hr + xi; hr = nr; hi = ni; } } }
        for (int c0 = 0; c0 < NCH; c0 += 32) { f32x2 ee[32];
#pragma unroll
            for (int c = 0; c < 32; ++c) ee[c] = ((const f32x2*)SSE)[(((size_t)b * NCH + c0 + c) * NG + g) * NS + n];
#pragma unroll
            for (int c = 0; c < 32; ++c) { ((f32x2*)SSIN)[(((size_t)b * NCH + c0 + c) * NG + g) * NS + n] = (f32x2){hr, hi};
                const float nr = ar64 * hr - ai64 * hi + ee[c].x, ni = ar64 * hi + ai64 * hr + ee[c].y; hr = nr; hi = ni; } }
    }
}
__device__ __forceinline__ void mix0_final_phase(const Frame& F, const unsigned char* ws, const bf16* A, const bf16* BX, const float* CIN, const bf16* G, bf16* AOUT, const float* cre, const float* cim, const float* sd, const bf16* U, const float* SSIN, bf16* GS) {
    LAS int* q = (LAS int*)(F.lds + TABL_OFF); if (F.tid == 0) *q = 0; __syncthreads();
    const int cu = (int)blockIdx.x, NLW = (NB * NCH * 128 + 128) / 64, NLQ = (NLW + F.G - 1) / F.G, NSI = NB * NCH * NG + NG, NSQ = (NSI + F.G - 1) / F.G;
    SsmTab T; int gcur = -1;
    for (;;) { const int e = cu_queue_next(q, F.lane); if (e >= NLQ + NSQ) break;
      if (e < NLQ) { const int wi = cu + F.G * e; if (wi < NLW) { const int i = wi * 64 + F.lane; const int ch = (int)(i & 127) * 8, bc = (int)(i >> 7); const bool meta = bc >= NB * NCH;
        const size_t r0 = meta ? (size_t)RM0 : (size_t)bc * 64; const int nt = meta ? NMETA : 64; f32x4 H0 = {0.f, 0.f, 0.f, 0.f}, H1 = H0;
        if (!meta) { H0 = *(const f32x4*)(CIN + (size_t)bc * 1024 + ch); H1 = *(const f32x4*)(CIN + (size_t)bc * 1024 + ch + 4); }
        for (int t0 = 0; t0 < nt; t0 += 8) { v4u la[8], bx[8], gg[8];
#pragma unroll
            for (int t = 0; t < 8; ++t) { const size_t r = r0 + t0 + t; la[t] = *(const v4u*)(A + r * 1024 + ch); bx[t] = *(const v4u*)(BX + r * 1024 + ch); gg[t] = *(const v4u*)(G + r * 1024 + ch); }
#pragma unroll
            for (int t = 0; t < 8; ++t) { f32x4 l0, l1, b0, b1, g0, g1; unpack8(la[t], l0, l1); unpack8(bx[t], b0, b1); unpack8(gg[t], g0, g1);
                H0 = exp2_4(l0 * 1.4426950408889634f) * H0 + b0; H1 = exp2_4(l1 * 1.4426950408889634f) * H1 + b1;
                *(v4u*)(AOUT + (r0 + t0 + t) * 1536 + ch) = pack8(g0 * H0, g1 * H1); } } }
      } else { const int it = cu + F.G * (e - NLQ); if (it < NSI) { const bool meta = it >= NB * NCH * NG; const int g = it % NG, bc = it / NG;
        if (g != gcur) { ssm_tab_load(T, ws, cre, cim, sd, g, F.lane); gcur = g; }
        float hr = 0.f, hi = 0.f; if (!meta) { const f32x2 s_ = ((const f32x2*)SSIN)[(size_t)it * NS + F.lane]; hr = s_.x; hi = s_.y; }
        ssm_wave(T, U, GS, g, meta ? RM0 : bc * 64, meta ? NMETA : 64, hr, hi, F.lane, F.lds + RING_OFF + F.wave * SSM_WLDS); } }
    }
}
template <int NACC>
__device__ __forceinline__ void meta_tile(const Frame& F, const bf16* A16, int lda, int K, const bf16* const (&Brow)[NACC], int ldb, f32x4 (&out)[NACC]) {
    LAS f32x4* red = (LAS f32x4*)(F.lds + RING_OFF);
    const int lane = F.lane, fr = lane & 15, fq = lane >> 4, w = F.wave, ks = K / 8;
    f32x4 acc[NACC];
#pragma unroll
    for (int a = 0; a < NACC; ++a) acc[a] = (f32x4){0.f, 0.f, 0.f, 0.f};
#pragma unroll 4
    for (int k0 = w * ks; k0 < (w + 1) * ks; k0 += 32) {
        const bf16x8 af = *(const bf16x8*)(A16 + (size_t)fr * lda + k0 + 8 * fq);
#pragma unroll
        for (int a = 0; a < NACC; ++a) { const bf16x8 bfz = *(const bf16x8*)(Brow[a] + (size_t)fr * ldb + k0 + 8 * fq); acc[a] = __builtin_amdgcn_mfma_f32_16x16x32_bf16(bfz, af, acc[a], 0, 0, 0); } }
    __syncthreads();
#pragma unroll
    for (int a = 0; a < NACC; ++a) red[(w * NACC + a) * 64 + lane] = acc[a];
    __syncthreads();
#pragma unroll
    for (int a = 0; a < NACC; ++a) { f32x4 sacc = red[a * 64 + lane];
#pragma unroll
        for (int ww = 1; ww < 8; ++ww) sacc += red[(ww * NACC + a) * 64 + lane];
        out[a] = sacc; }
}
template <class Fn> __device__ __forceinline__ bf16x8 frag8(Fn f) { bf16x8 r;
#pragma unroll
    for (int j = 0; j < 8; ++j) r[j] = (short)f(j);
    return r; }
constexpr int GL_LB = 0, GL_QT = 32768, GL_KT = 50176, GL_KH = 67584, GL_VT = 86016, GL_GM = 120832, GL_BL = 121344, GL_SSQ = 121856, GL_TQ = 123904;
constexpr int PQ = 136, PKH = 144, PV = 272, PATT = 72, POT = 264;
#define TR_FRAG(dst, base, off, rows4) do { v2u _lo, _hi; \
    asm volatile("ds_read_b64_tr_b16 %0, %2 offset:%c3\n\tds_read_b64_tr_b16 %1, %2 offset:%c4\n\ts_waitcnt lgkmcnt(0)" : "=&v"(_lo), "=&v"(_hi) : "v"(base), "i"(off), "i"((off) + (rows4)) : "memory"); \
    const v4u _w = {_lo.x, _lo.y, _hi.x, _hi.y}; dst = __builtin_bit_cast(bf16x8, _w); } while (0)
__device__ __forceinline__ unsigned lds_addr(const LAS void* p) { return (unsigned)(unsigned long)p; }
template <bool FINAL>
__device__ __forceinline__ void gla_item(const Frame& F, int b, int h, int s, const bf16* Q, const bf16* K, const bf16* V, const bf16* GATE, const bf16* LG, const float* gnorm, bf16* GDS, float* GAM, bf16* AOUT2) {
    LAS float* LB = (LAS float*)(F.lds + GL_LB); LAS bf16* ATT = (LAS bf16*)(F.lds + GL_LB);
    LAS bf16* QT = (LAS bf16*)(F.lds + GL_QT); LAS bf16* KT = (LAS bf16*)(F.lds + GL_KT); LAS bf16* KH = (LAS bf16*)(F.lds + GL_KH); LAS bf16* VT = (LAS bf16*)(F.lds + GL_VT);
    LAS float* GM = (LAS float*)(F.lds + GL_GM); LAS float* BL = (LAS float*)(F.lds + GL_BL); LAS float* SSQ = (LAS float*)(F.lds + GL_SSQ);
    const int tid = F.tid, w = F.wave, lane = F.lane, fr = lane & 15, h4 = lane >> 4, tq = fr >> 2, tp = fr & 3;
    const int bh = b * GH + h; const size_t sbase = ((size_t)(bh * NSEG + s) * 128) * 256;
    const unsigned vtr = lds_addr(VT) + (unsigned)((8 * h4 + tq) * PV + 32 * w + 4 * tp) * 2u;
    const unsigned ktr = lds_addr(KH) + (unsigned)((8 * h4 + tq) * PKH + 4 * tp) * 2u;
    f32x4 S[8][2];
    bf16* simg = GDS + sbase + ((size_t)w * 64 + lane) * 64;
#pragma unroll
    for (int kb = 0; kb < 8; ++kb) { if (FINAL) unpack8(*(const v4u*)(simg + 8 * kb), S[kb][0], S[kb][1]); else { S[kb][0] = (f32x4){0.f, 0.f, 0.f, 0.f}; S[kb][1] = S[kb][0]; } }
    float gsum = 0.f;
    LAS float* TQ = (LAS float*)(F.lds + GL_TQ);
    v4u pfl[2], pfv[4], pfk[2], pfq[2];
    const unsigned vo_lg = (unsigned)(((tid >> 5) * 512 + (tid & 31) * 4) * 4), vo_kq = (unsigned)(((tid >> 4) * 512 + (tid & 15) * 8) * 2), vo_v = (unsigned)(((tid >> 5) * 1024 + (tid & 31) * 8) * 2);
    const int lo_lb = (tid >> 5) * 128 + (tid & 31) * 4, lo_vt = (tid >> 5) * PV + (tid & 31) * 8, lo_ot = (tid >> 5) * POT + (tid & 31) * 8, t3 = tid >> 4, k8 = (tid & 15) * 8;
#define GLA_LOAD(cc, dep) do { const size_t r0n = (size_t)b * SEQ + (size_t)(s * SEGC + (cc)) * 64; unsigned pin_ = 0; asm volatile("" : "+v"(pin_) : "v"(dep));   \
        _Pragma("unroll") for (int j = 0; j < 2; ++j) pfl[j] = *(const v4u*)((const char*)(LG + (r0n + 32 * j) * 512 + h * 128) + (vo_kq + pin_)); \
        _Pragma("unroll") for (int j = 0; j < 2; ++j) { pfk[j] = *(const v4u*)((const char*)(K + (r0n + 32 * j) * 512 + h * 128) + (vo_kq + pin_)); if (FINAL) pfq[j] = *(const v4u*)((const char*)(Q + (r0n + 32 * j) * 512 + h * 128) + (vo_kq + pin_)); } } while (0)
#define GLA_LOADV(cc, dep) do { const size_t r0n = (size_t)b * SEQ + (size_t)(s * SEGC + (cc)) * 64; unsigned pin_ = 0; asm volatile("" : "+v"(pin_) : "v"(dep)); \
        _Pragma("unroll") for (int j = 0; j < 4; ++j) pfv[j] = *(const v4u*)((const char*)(V + (r0n + 16 * j) * 1024 + h * 256) + (vo_v + pin_)); } while (0)
#define GLA_STEP6() do { \
        _Pragma("unroll") for (int kb = 0; kb < 8; ++kb) { const f32x4 gm = *(const LAS f32x4*)(GM + 16 * kb + 4 * h4); \
            _Pragma("unroll") for (int vb = 0; vb < 2; ++vb) S[kb][vb] = S[kb][vb] * gm; } \
        _Pragma("unroll") for (int ts = 0; ts < 2; ++ts) { bf16x8 bv[2]; \
            _Pragma("unroll") for (int vb = 0; vb < 2; ++vb) TR_FRAG(bv[vb], vtr, (32 * ts * PV + 16 * vb) * 2, 4 * PV * 2); \
            _Pragma("unroll") for (int kb = 0; kb < 8; ++kb) { bf16x8 a; TR_FRAG(a, ktr, (32 * ts * PKH + 16 * kb) * 2, 4 * PKH * 2); \
                _Pragma("unroll") for (int vb = 0; vb < 2; ++vb) S[kb][vb] = __builtin_amdgcn_mfma_f32_16x16x32_bf16(a, bv[vb], S[kb][vb], 0, 0, 0); } } } while (0)
    GLA_LOAD(0, gsum); GLA_LOADV(0, gsum);
#pragma unroll
    for (int j = 0; j < 2; ++j) { f32x4 l0_, l1_; unpack8(pfl[j], l0_, l1_); *(LAS f32x4*)(LB + (t3 + 32 * j) * 128 + k8) = l0_; *(LAS f32x4*)(LB + (t3 + 32 * j) * 128 + k8 + 4) = l1_; }
    __syncthreads();
#pragma nounroll
    for (int c = 0; c < SEGC; ++c) {
        const size_t row0 = (size_t)b * SEQ + (size_t)(s * SEGC + c) * 64;
        v4u kwr[2], qwr[2];
#pragma unroll
        for (int j = 0; j < 2; ++j) { kwr[j] = pfk[j]; if (FINAL) qwr[j] = pfq[j]; }
        if (!FINAL) { if (c + 1 < SEGC) GLA_LOAD(c + 1, __uint_as_float(kwr[1].w)); }
        { const int kc = tid & 127, qt_ = tid >> 7; float xs[16];
#pragma unroll
          for (int t = 0; t < 16; ++t) xs[t] = LB[(16 * qt_ + t) * 128 + kc];
          asm volatile("" ::: "memory");
#pragma unroll
          for (int t = 1; t < 16; ++t) xs[t] += xs[t - 1];
          TQ[qt_ * 128 + kc] = xs[15];
          __syncthreads();
          const float t0_ = TQ[kc], t1_ = TQ[128 + kc], t2_ = TQ[256 + kc], t3_ = TQ[384 + kc];
          const float off = qt_ == 0 ? 0.f : qt_ == 1 ? t0_ : qt_ == 2 ? t0_ + t1_ : (t0_ + t1_) + t2_;
#pragma unroll
          for (int t = 0; t < 16; ++t) LB[(16 * qt_ + t) * 128 + kc] = xs[t] + off;
          if (qt_ == 0) { const float tot = ((t0_ + t1_) + t2_) + t3_; BL[kc] = tot; GM[kc] = __builtin_amdgcn_exp2f(tot); gsum += tot; } }
        __syncthreads();
#pragma unroll
        for (int j = 0; j < 4; ++j) *(LAS v4u*)(VT + lo_vt + j * 16 * PV) = pfv[j];
#pragma unroll
        for (int j = 0; j < 2; ++j) { const int t = t3 + 32 * j;
            f32x4 k0, k1; unpack8(kwr[j], k0, k1);
            const f32x4 b0 = *(const LAS f32x4*)(LB + t * 128 + k8), b1 = *(const LAS f32x4*)(LB + t * 128 + k8 + 4);
            if (!FINAL) { const f32x4 l0 = *(const LAS f32x4*)(BL + k8), l1 = *(const LAS f32x4*)(BL + k8 + 4);
                *(LAS v4u*)(KH + t * PKH + k8) = pack8(k0 * exp2_4(l0 - b0), k1 * exp2_4(l1 - b1)); }
            if (FINAL) { f32x4 q0, q1; unpack8(qwr[j], q0, q1);
                const f32x4 g0 = *(const LAS f32x4*)(GM + k8), g1 = *(const LAS f32x4*)(GM + k8 + 4);
                const f32x4 kt0 = k0 * exp2_4(b0 * -1.0f), kt1 = k1 * exp2_4(b1 * -1.0f);
                *(LAS v4u*)(KH + t * PKH + k8) = pack8(kt0 * g0, kt1 * g1);
                const int kp = (k8 & ~31) + 8 * ((k8 & 15) >> 2) + 4 * ((k8 >> 4) & 1);
                const v4u pq_ = pack8(q0 * exp2_4(b0), q1 * exp2_4(b1)), pk_ = pack8(kt0, kt1);
                *(LAS v2u*)(QT + t * PQ + kp) = (v2u){pq_.x, pq_.y}; *(LAS v2u*)(QT + t * PQ + kp + 8) = (v2u){pq_.z, pq_.w};
                *(LAS v2u*)(KT + t * PQ + kp) = (v2u){pk_.x, pk_.y}; *(LAS v2u*)(KT + t * PQ + kp + 8) = (v2u){pk_.z, pk_.w}; } }
        __syncthreads();
        if (!FINAL) { if (c + 1 < SEGC) GLA_LOADV(c + 1, gsum); }
        f32x4 o[4][2];
        if (FINAL) {
            { const int tb = w >> 1;
#pragma unroll
              for (int q = 0; q < 2; ++q) { const int sb = 2 * (w & 1) + q; f32x4 acc = {0.f, 0.f, 0.f, 0.f};
                if (sb <= tb) {
#pragma unroll
                    for (int ks = 0; ks < 4; ++ks) { const bf16x8 a = *(const LAS bf16x8*)(QT + (16 * tb + fr) * PQ + 32 * ks + 8 * h4), bq = *(const LAS bf16x8*)(KT + (16 * sb + fr) * PQ + 32 * ks + 8 * h4);
                        acc = __builtin_amdgcn_mfma_f32_16x16x32_bf16(a, bq, acc, 0, 0, 0); } }
#pragma unroll
                for (int r = 0; r < 4; ++r) { const int tl = 4 * h4 + r; const float val = (sb < tb || (sb == tb && fr <= tl)) ? acc[r] : 0.f; ATT[(16 * tb + tl) * PATT + 16 * sb + fr] = (bf16)f2bf(val); } } }
#pragma unroll
            for (int tb = 0; tb < 4; ++tb)
#pragma unroll
                for (int vb = 0; vb < 2; ++vb) o[tb][vb] = (f32x4){0.f, 0.f, 0.f, 0.f};
#pragma unroll
            for (int i = 0; i < 4; ++i) { bf16x8 bs[2];
#pragma unroll
                for (int vb = 0; vb < 2; ++vb) { v4u wv; wv.x = pk2(S[2 * i][vb][0], S[2 * i][vb][1]); wv.y = pk2(S[2 * i][vb][2], S[2 * i][vb][3]); wv.z = pk2(S[2 * i + 1][vb][0], S[2 * i + 1][vb][1]); wv.w = pk2(S[2 * i + 1][vb][2], S[2 * i + 1][vb][3]); bs[vb] = __builtin_bit_cast(bf16x8, wv); }
#pragma unroll
                for (int tb = 0; tb < 4; ++tb) { const bf16x8 a = *(const LAS bf16x8*)(QT + (16 * tb + fr) * PQ + 32 * i + 8 * h4);
#pragma unroll
                    for (int vb = 0; vb < 2; ++vb) o[tb][vb] = __builtin_amdgcn_mfma_f32_16x16x32_bf16(a, bs[vb], o[tb][vb], 0, 0, 0); } }
            __syncthreads();
#pragma unroll
            for (int ss = 0; ss < 2; ++ss) { bf16x8 bv[2];
#pragma unroll
                for (int vb = 0; vb < 2; ++vb) TR_FRAG(bv[vb], vtr, (32 * ss * PV + 16 * vb) * 2, 4 * PV * 2);
#pragma unroll
                for (int tb = 0; tb < 4; ++tb) { if (ss == 1 && tb < 2) continue;
                    const bf16x8 a = *(const LAS bf16x8*)(ATT + (16 * tb + fr) * PATT + 32 * ss + 8 * h4);
#pragma unroll
                    for (int vb = 0; vb < 2; ++vb) o[tb][vb] = __builtin_amdgcn_mfma_f32_16x16x32_bf16(a, bv[vb], o[tb][vb], 0, 0, 0); } }
        }
        if (FINAL) {
            if (c + 1 < SEGC) GLA_LOAD(c + 1, o[3][1][3]);
            v4u gw[4]; int lzg = 0; asm volatile("" : "+v"(lzg) : "v"(o[3][0][3]));
#pragma unroll
            for (int j = 0; j < 4; ++j) gw[j] = *(const v4u*)((const char*)(GATE + (row0 + 16 * j) * 1024 + h * 256) + (vo_v + (unsigned)lzg));
            { f32x4 qs[4];
#pragma unroll
              for (int tb = 0; tb < 4; ++tb)
#pragma unroll
                for (int r = 0; r < 4; ++r) qs[tb][r] = row16_sum(o[tb][0][r] * o[tb][0][r] + o[tb][1][r] * o[tb][1][r]);
              if (fr == 0) {
#pragma unroll
                for (int tb = 0; tb < 4; ++tb) *(LAS f32x4*)(SSQ + w * 64 + 16 * tb + 4 * h4) = qs[tb]; } }
            asm volatile("" ::: "memory"); if (c + 1 < SEGC) GLA_LOADV(c + 1, gsum);
            GLA_STEP6();
            __syncthreads();
            { LAS bf16* OT = QT; const float gn0 = gnorm[h * 256 + 32 * w + fr], gn1 = gnorm[h * 256 + 32 * w + 16 + fr];
#pragma unroll
              for (int tb = 0; tb < 4; ++tb) { f32x4 tot4 = *(const LAS f32x4*)(SSQ + 16 * tb + 4 * h4);
#pragma unroll
                for (int ww = 1; ww < 8; ++ww) tot4 += *(const LAS f32x4*)(SSQ + ww * 64 + 16 * tb + 4 * h4);
                const f32x4 ms4 = tot4 * (1.0f / 256.0f) + EPS; f32x4 rs4;
#pragma unroll
                for (int r = 0; r < 4; ++r) rs4[r] = __builtin_amdgcn_rsqf(ms4[r]);
                const f32x4 oa = o[tb][0] * (rs4 * gn0), ob = o[tb][1] * (rs4 * gn1);
#pragma unroll
                for (int r = 0; r < 4; ++r) { const int t = 16 * tb + 4 * h4 + r;
                    const unsigned pw_ = pk2(oa[r], ob[r]);
                    ((LAS unsigned short*)OT)[t * POT + 32 * w + fr] = (unsigned short)pw_; ((LAS unsigned short*)OT)[t * POT + 32 * w + 16 + fr] = (unsigned short)(pw_ >> 16); asm volatile("" ::: "memory"); } }
              if (c + 1 < SEGC) {
#pragma unroll
            for (int j = 0; j < 2; ++j) { f32x4 l0_, l1_; unpack8(pfl[j], l0_, l1_); *(LAS f32x4*)(LB + (t3 + 32 * j) * 128 + k8) = l0_; *(LAS f32x4*)(LB + (t3 + 32 * j) * 128 + k8 + 4) = l1_; } }
              __syncthreads();
#pragma unroll
              for (int j = 0; j < 4; ++j) { f32x4 a0, a1, g0, g1; unpack8(*(const LAS v4u*)(OT + lo_ot + j * 16 * POT), a0, a1); unpack8(gw[j], g0, g1);
                  *(v4u*)((char*)(AOUT2 + (row0 + 16 * j) * 1024 + h * 256) + vo_v) = pack8(a0 * g0, a1 * g1); } }
        }
        if (!FINAL) { GLA_STEP6();
            if (c + 1 < SEGC) {
#pragma unroll
            for (int j = 0; j < 2; ++j) { f32x4 l0_, l1_; unpack8(pfl[j], l0_, l1_); *(LAS f32x4*)(LB + (t3 + 32 * j) * 128 + k8) = l0_; *(LAS f32x4*)(LB + (t3 + 32 * j) * 128 + k8 + 4) = l1_; } }
            __syncthreads(); }
    }
    if (FINAL) __syncthreads();
    if (!FINAL) {
#pragma unroll
        for (int kb = 0; kb < 8; ++kb) *(v4u*)(simg + 8 * kb) = pack8(S[kb][0], S[kb][1]);
        if (tid < 128) GAM[(size_t)(bh * NSEG + s) * 128 + tid] = __builtin_amdgcn_exp2f(gsum);
    }
}
__device__ __forceinline__ void gla_l2_phase(const Frame& F, const bf16* K, const bf16* V, const bf16* LG, bf16* GDS, const float* GAM) {
    for (int id = (F.wave * F.G + (int)blockIdx.x) * 64 + F.lane; id < NB * GH * 8 * 64 * 8; id += F.NGT) { const int kb = id & 7, ln = (id >> 3) & 63, w = (id >> 9) & 7, bh = id >> 12, h = bh & 3, fr = ln & 15, h4 = ln >> 4;
        const int k0 = 16 * kb + 4 * h4, v0 = 32 * w + fr;
        v2u lgm[NMETA]; f32x4 tot = {0.f, 0.f, 0.f, 0.f};
#pragma unroll
        for (int i = 0; i < NMETA; ++i) { lgm[i] = *(const v2u*)(LG + (size_t)(RM0 + i) * 512 + h * 128 + k0); tot += (f32x4){bflo(lgm[i].x), bfhi(lgm[i].x), bflo(lgm[i].y), bfhi(lgm[i].y)}; }
        f32x4 c0 = {0.f, 0.f, 0.f, 0.f}, c1 = c0, run = c0;
#pragma unroll
        for (int i = 0; i < NMETA; ++i) { run += (f32x4){bflo(lgm[i].x), bfhi(lgm[i].x), bflo(lgm[i].y), bfhi(lgm[i].y)};
            const v2u kw = *(const v2u*)(K + (size_t)(RM0 + i) * 512 + h * 128 + k0); const float va = bf2f(V[(size_t)(RM0 + i) * 1024 + h * 256 + v0]), vb_ = bf2f(V[(size_t)(RM0 + i) * 1024 + h * 256 + v0 + 16]);
            f32x4 wk; wk.x = __builtin_amdgcn_exp2f(tot.x - run.x) * bflo(kw.x); wk.y = __builtin_amdgcn_exp2f(tot.y - run.y) * bfhi(kw.x); wk.z = __builtin_amdgcn_exp2f(tot.z - run.z) * bflo(kw.y); wk.w = __builtin_amdgcn_exp2f(tot.w - run.w) * bfhi(kw.y);
            c0 += wk * va; c1 += wk * vb_; }
        bf16* img = GDS + ((size_t)bh * NSEG * 8 * 64 + (size_t)w * 64 + ln) * 64 + 8 * kb;
        for (int sh = 0; sh < NSEG; sh += 8) { v4u ds[8]; f32x4 gm[8];
#pragma unroll
            for (int s = 0; s < 8; ++s) { ds[s] = *(const v4u*)(img + (size_t)(sh + s) * 32768); gm[s] = *(const f32x4*)(GAM + (size_t)(bh * NSEG + sh + s) * 128 + k0); }
#pragma unroll
            for (int s = 0; s < 8; ++s) { *(v4u*)(img + (size_t)(sh + s) * 32768) = pack8(c0, c1); f32x4 d0, d1; unpack8(ds[s], d0, d1); c0 = c0 * gm[s] + d0; c1 = c1 * gm[s] + d1; } }
    }
}

__device__ __forceinline__ void router_phase(const Frame& F, const Args& a, unsigned char* ws) {
    const float* const* in = a.in; unsigned* ctl = (unsigned*)(ws + WS_CTL); bf16* HNM = (bf16*)(ws + WS_HNM); int* tokinfo = (int*)(ws + WS_TOKINFO);
    const float* gain = in[I_NORM_FFN1]; const float* RW = in[I_ROUTER]; const int lane = F.lane; const bf16* HB = (const bf16*)(ws + WS_HB); unsigned char* HN8 = (unsigned char*)(ws + WS_HNM);
    LAS unsigned* cnt = (LAS unsigned*)(F.lds + TABL_OFF);
    if (F.tid < 32) cnt[F.tid] = 0u;
    __syncthreads();
    const int per = (TR + F.G - 1) / F.G, m0 = (int)blockIdx.x * per, m1 = (m0 + per < TR) ? m0 + per : TR;
    int my_e0 = 0, my_e1 = 0; unsigned my_p0 = 0, my_p1 = 0; float my_w0 = 0.f;
    int jt = 0;
    LAS float* scr = (LAS float*)(F.lds + RING_OFF + F.wave * 16384);
    constexpr int IG = 16 * 112, ID = 56 * 32, IE = 2 * IG + ID;
    unsigned char* WGU = (unsigned char*)(ws + WS_WMOE); unsigned char* WD = WGU + (size_t)NE * 7168 * 1024;
    auto convert = [&](int it) { const int e = it / IE; int r = it % IE;
        if (r < 2 * IG) { const int up = r >= IG; if (up) r -= IG; const int kb = r / 112, n0 = (r % 112) * 32;
            tr_item8((up ? in[I_MU] : in[I_MG]) + (size_t)e * 1024 * FFE, FFE, n0, kb * 64, WGU + (size_t)e * 7168 * 1024, 1024, (n0 >> 7) * 256 + (n0 & 127) + (up ? 128 : 0), 32.0f, scr, lane); }
        else { r -= 2 * IG; const int kb = r / 32, n0 = (r % 32) * 32; tr_item8(in[I_MD] + (size_t)e * FFE * 1024, 1024, n0, kb * 64, WD + (size_t)e * 1024 * FFE, FFE, n0, 64.0f, scr, lane); } };
    int cit = F.gw;
    if (F.wave & 1) { for (int k = 0; k < 3 && cit < NE * IE; ++k, cit += F.NGW) convert(cit); }
    f32x4 rw[4][4][2], gv[4];
#pragma unroll
    for (int j = 0; j < 4; ++j) { const int d0 = (j >> 1) * 512 + 8 * lane + (j & 1) * 4; gv[j] = *(const f32x4*)(gain + d0);
#pragma unroll
        for (int e4 = 0; e4 < 4; ++e4) { rw[j][e4][0] = *(const f32x4*)(RW + (d0 + e4) * 8); rw[j][e4][1] = *(const f32x4*)(RW + (d0 + e4) * 8 + 4); } }
    v4u nxa = {0u, 0u, 0u, 0u}, nxb = nxa; if (m0 + F.wave < m1) { const bf16* hr0 = HB + (size_t)(m0 + F.wave) * 1024; nxa = *(const v4u*)(hr0 + 8 * lane); nxb = *(const v4u*)(hr0 + 512 + 8 * lane); }
    for (int m = m0 + F.wave; m < m1; m += 8, ++jt) {
        f32x4 v[4]; unpack8(nxa, v[0], v[1]); unpack8(nxb, v[2], v[3]); float s = 0.f;
        if (m + 8 < m1) { const bf16* hr1 = HB + (size_t)(m + 8) * 1024; nxa = *(const v4u*)(hr1 + 8 * lane); nxb = *(const v4u*)(hr1 + 512 + 8 * lane); }
#pragma unroll
        for (int j = 0; j < 1; ++j) { const f32x4 t_ = (v[0] * v[0] + v[1] * v[1]) + (v[2] * v[2] + v[3] * v[3]); s += (t_.x + t_.y) + (t_.z + t_.w); }
        const float rstd = 1.0f / sqrtf(wave_sum(s) * (1.0f / 1024.0f) + EPS);
        f32x4 pA = {0.f, 0.f, 0.f, 0.f}, pB = pA;
        f32x4 yv[4];
#pragma unroll
        for (int j = 0; j < 4; ++j) { const f32x4 y = v[j] * rstd * gv[j]; yv[j] = y;
#pragma unroll
            for (int e4 = 0; e4 < 4; ++e4) { pA += rw[j][e4][0] * y[e4]; pB += rw[j][e4][1] * y[e4]; } }
        const float p[8] = {pA.x, pA.y, pA.z, pA.w, pB.x, pB.y, pB.z, pB.w};
        *(v2u*)(HN8 + (size_t)m * 1024 + 8 * lane) = (v2u){pk4_fp8(yv[0][0], yv[0][1], yv[0][2], yv[0][3]), pk4_fp8(yv[1][0], yv[1][1], yv[1][2], yv[1][3])};
        *(v2u*)(HN8 + (size_t)m * 1024 + 512 + 8 * lane) = (v2u){pk4_fp8(yv[2][0], yv[2][1], yv[2][2], yv[2][3]), pk4_fp8(yv[3][0], yv[3][1], yv[3][2], yv[3][3])};
        float q4[4];
#pragma unroll
        for (int i = 0; i < 4; ++i) { const bool up = (lane & 32) != 0; const float keep = up ? p[i + 4] : p[i], send = up ? p[i] : p[i + 4]; q4[i] = keep + __shfl_xor(send, 32); }
        float q2[2];
#pragma unroll
        for (int i = 0; i < 2; ++i) { const bool up = (lane & 16) != 0; const float keep = up ? q4[i + 2] : q4[i], send = up ? q4[i] : q4[i + 2]; q2[i] = keep + __shfl_xor(send, 16); }
        float y; { const bool up = (lane & 8) != 0; const float keep = up ? q2[1] : q2[0], send = up ? q2[0] : q2[1]; y = keep + __shfl_xor(send, 8); }
        y += __shfl_xor(y, 4); y += __shfl_xor(y, 2); y += __shfl_xor(y, 1);
        float lg[8];
#pragma unroll
        for (int e = 0; e < 8; ++e) lg[e] = __shfl(y, ((e >> 2) & 1) * 32 + ((e >> 1) & 1) * 16 + (e & 1) * 8);
        int i0 = 0; float v0 = lg[0];
#pragma unroll
        for (int e = 1; e < 8; ++e) if (lg[e] > v0) { v0 = lg[e]; i0 = e; }
        int i1 = -1; float v1 = -3.0e38f;
#pragma unroll
        for (int e = 0; e < 8; ++e) if (e != i0 && lg[e] > v1) { v1 = lg[e]; i1 = e; }
        if (i1 < 0) i1 = (i0 + 1) & 7;
        if (lane == jt) { my_e0 = i0; my_e1 = i1; my_w0 = 1.0f / (1.0f + __expf(v1 - v0)); my_p0 = atomicAdd((unsigned*)(cnt + i0), 1u); my_p1 = atomicAdd((unsigned*)(cnt + 8 + i1), 1u); }
    }
    __syncthreads();
    if (F.tid < 16) cnt[16 + F.tid] = __hip_atomic_fetch_add(ctl + CW_CNT + F.tid, cnt[F.tid], RLX_AGENT);
    __syncthreads();
    if (lane < jt) { const int m = m0 + F.wave + 8 * lane; const float w1 = 1.0f - my_w0;
        const unsigned q0 = cnt[16 + my_e0] + my_p0, q1 = cnt[24 + my_e1] + my_p1;
        *(v4u*)(tokinfo + (size_t)m * 4) = (v4u){(unsigned)my_e0, q0, __float_as_uint(my_w0), 0u};
        *(v4u*)(tokinfo + (size_t)(TR + m) * 4) = (v4u){(unsigned)my_e1, q1, __float_as_uint(w1), 0u};
        int* reltok = (int*)(ws + WS_RELTOK); float* relw = (float*)(ws + WS_RELW);
        reltok[(size_t)my_e0 * TR + q0] = m; relw[(size_t)my_e0 * TR + q0] = my_w0; reltok[(size_t)(8 + my_e1) * TR + q1] = m; relw[(size_t)(8 + my_e1) * TR + q1] = w1; }
    for (; cit < NE * IE; cit += F.NGW) convert(cit);
}
__device__ __forceinline__ void moe_lists_phase(const Frame& F, unsigned char* ws) {
    unsigned* ctl = (unsigned*)(ws + WS_CTL); LAS int* L = (LAS int*)(F.lds + TABL_OFF);
    const int* tokinfo = (const int*)(ws + WS_TOKINFO); int* rowtok = (int*)(ws + WS_ROWTOK); float* roww = (float*)(ws + WS_ROWW);
    int* pexp = (int*)(ws + WS_TAB + TB_PEXP); int* npan = (int*)(ws + WS_TAB + TB_NPAN);
    if (F.tid < 16) L[F.tid] = (int)__hip_atomic_load(ctl + CW_CNT + F.tid, RLX_AGENT);
    __syncthreads();
    if (F.tid == 0) { for (int s = 0; s < 2; ++s) { int acc = 0; for (int e = 0; e < 8; ++e) { L[16 + s * 8 + e] = acc; acc += (L[s * 8 + e] + 255) & ~255; } L[32 + s] = acc >> 8; } }
    __syncthreads();
    if (blockIdx.x == 0) { if (F.tid < 2) npan[F.tid] = L[32 + F.tid];
        if (F.tid < 16) { const int s = F.tid >> 3, base = L[16 + F.tid], n = (L[F.tid] + 255) >> 8; for (int p = 0; p < n; ++p) pexp[s * MPAN + (base >> 8) + p] = F.tid & 7; } }
    for (long i = F.gt; i < 2L * TR; i += F.NGT) { const int s = (int)(i >= TR), tok = (int)(i - (long)s * TR); const v4u inf = *(const v4u*)(tokinfo + i * 4);
        const int row = L[16 + s * 8 + (int)inf.x] + (int)inf.y; rowtok[(size_t)s * MROWS + row] = tok; const unsigned wb = inf.z; roww[(size_t)s * MROWS + row] = __uint_as_float(wb); }
    for (long i = F.gt; i < 16L * 256; i += F.NGT) { const int se = (int)(i >> 8), r = (int)(i & 255), s = se >> 3, cnt = L[se], base = L[16 + se], pad = ((cnt + 255) & ~255) - cnt;
        if (r < pad) { rowtok[(size_t)s * MROWS + base + cnt + r] = -1; roww[(size_t)s * MROWS + base + cnt + r] = 0.f; } }
}

__device__ __forceinline__ void fold_rstd_table(const Frame& F, const SchedStatic& S, const float* ssqp, LAS float* rst) {
    __syncthreads();
    for (int i = 0; i < FOLD_MAXU; ++i) { pg8::Unit u; if (!S.next(i, u)) break;
        if (F.tid < 256) rst[i * 256 + F.tid] = rstd_of(ssqp, (size_t)(u.pm * 256 + F.tid)); }
    __syncthreads();
}
__device__ __forceinline__ void moe_bases(const Frame& F, const unsigned char* ws, LAS int* ML) {
    const unsigned* ctl = (const unsigned*)(ws + WS_CTL);
    __syncthreads();
    if (F.tid < 16) ML[F.tid] = (int)__hip_atomic_load(ctl + CW_CNT + F.tid, RLX_AGENT);
    __syncthreads();
    if (F.tid == 0) { for (int s_ = 0; s_ < 2; ++s_) { int acc = 0; for (int e = 0; e < 8; ++e) { ML[16 + s_ * 8 + e] = acc; acc += (ML[s_ * 8 + e] + 255) & ~255; } ML[32 + s_] = acc >> 8; } }
    __syncthreads();
}
__device__ __forceinline__ int moe_panel_expert(const LAS int* ML, int slot, int p) { int e = 0;
#pragma unroll
    for (int k = 1; k < 8; ++k) e = (p * 256 >= ML[16 + slot * 8 + k]) ? k : e;
    return e; }
__device__ __forceinline__ int moe_row_token(const LAS int* ML, const unsigned char* ws, int slot, int e, int row, float* w) {
    const int rel = row - ML[16 + slot * 8 + e], cnt = ML[slot * 8 + e]; const bool ok = rel < cnt; const int rc = ok ? rel : (cnt > 0 ? cnt - 1 : 0);
    const int tok = ((const int*)(ws + WS_RELTOK))[(size_t)(slot * 8 + e) * TR + rc]; if (w) { const float wv = ((const float*)(ws + WS_RELW))[(size_t)(slot * 8 + e) * TR + rc]; *w = ok ? wv : 0.f; }
    return ok ? tok : -1; }
constexpr int N_PHASES = 25;
__global__ void __launch_bounds__(512, 2) mk_fwd(Args args) {
    extern __shared__ __attribute__((aligned(16))) unsigned char lds_raw[];
    Frame F; F.lds = (LAS unsigned char*)lds_raw; F.tid = threadIdx.x; F.lane = F.tid & 63; F.wave = __builtin_amdgcn_readfirstlane(F.tid >> 6); F.G = gridDim.x;
    F.gw = blockIdx.x * 8 + F.wave; F.NGW = F.G * 8; F.gt = (int)blockIdx.x * 512 + F.tid; F.NGT = F.G * 512;
    unsigned char* ws = args.ws; const float* const* in = args.in; float* out = args.out;
    volatile LAS unsigned* MISC = (volatile LAS unsigned*)(F.lds + MISC_OFF);
    if (F.tid < 32) MISC[F.tid] = 0u;
    __syncthreads();
#if !MK_PER_PHASE
    XcdBarrier bar = xcd_barrier_post((unsigned*)(ws + WS_CTL) + CW_BAR, MISC + 8);
#define GRID_BAR() xcd_barrier(bar)
#else
#define GRID_BAR() do { } while (0)
#endif
    const int lo = args.ph_lo, hi = args.ph_hi;
#ifndef MK_MASK
#define MK_MASK 0xFFFFFFFFu
#endif
#ifndef MK_STOP
#define MK_STOP 99
#endif
#define IN(k) ((((MK_MASK) >> (k)) & 1u) && ((k) <= MK_STOP || (k) == 24) && lo <= (k) && (k) < hi)
#ifdef MK_TP1
#define STAMP(k) do { if (blockIdx.x == 0 && F.tid == 0) ((unsigned long long*)(ws + WS_TAB + 900 * 1024))[(k) + 1] = __builtin_amdgcn_s_memrealtime(); } while (0)
#else
#define STAMP(k) do { } while (0)
#endif
#define SEAM(k) do { if (IN(k) && IN((k) + 1)) GRID_BAR(); STAMP(k); asm volatile("" : "+v"(F.tid), "+v"(F.lane), "+v"(F.gt)); } while (0)
    STAMP(-1);
    const int cu = (int)blockIdx.x;
    LAS unsigned char* ring = F.lds + RING_OFF;
    const LAS int* notab = (const LAS int*)(F.lds + TABL_OFF);
    float* hmeta = (float*)(ws + WS_HMETA);
    bf16* HB = (bf16*)(ws + WS_HB);
    bf16* HN = (bf16*)(ws + WS_HN);
    constexpr size_t P1K = (size_t)256 * 1024 * 2;

    if (IN(0)) { p0_prologue(F, args, ws); } SEAM(0);
    if (IN(1)) { SchedStatic S{NPR, 10, F.G, cu, (const char*)HN, (const char*)(ws + WS_WIN0), P1K, P1K, 0, 0}; EpiWin0 E{(bf16*)(ws + WS_G), (bf16*)(ws + WS_XRBX), (bf16*)(ws + WS_U), in[I_CONVW], in[I_CONVB], (bf16*)(ws + WS_XC)};
        pg8::gemm_phase<EpiWin0, SchedStatic, false>(ring, 1024, 1024, S, E, notab);
        for (int t = cu; t < EV_IN / 16; t += F.G) { const int n0 = t * 16; const bf16* const br[1] = {(const bf16*)(ws + WS_WIN0) + (size_t)n0 * 1024}; f32x4 o[1];
            meta_tile<1>(F, HN + (size_t)RM0 * 1024, 1024, 1024, br, 1024, o);
            if (F.wave == 0) { const int row = RM0 + (F.lane & 15), c = n0 + 4 * (F.lane >> 4); f32x4 v = o[0];
                if (c < 1024) { for (int j = 0; j < 4; ++j) v[j] = gelu_tanh(v[j]); *(v2u*)((bf16*)(ws + WS_G) + (size_t)row * 1024 + c) = (v2u){pk2(v[0], v[1]), pk2(v[2], v[3])}; }
                else if (c < 2048) *(v2u*)((bf16*)(ws + WS_XRBX) + (size_t)row * 1024 + c - 1024) = (v2u){pk2(v[0], v[1]), pk2(v[2], v[3])};
                else *(v2u*)((bf16*)(ws + WS_U) + (size_t)row * 512 + c - 2048) = (v2u){pk2(v[0], v[1]), pk2(v[2], v[3])}; } } } SEAM(1);
    if (IN(2)) { LAS int* q = (LAS int*)(F.lds + TABL_OFF); if (F.tid == 0) *q = 0; __syncthreads();
        const int NSQ = (NG * 32 + F.G - 1) / F.G, NFW = (TR / 64) * 2, NCW = NFW + 2, NCQ = (NCW + F.G - 1) / F.G;
        for (;;) { const int e = cu_queue_next(q, F.lane); if (e >= NSQ + NCQ) break;
            if (e < NSQ) ssm_l1_item(F, cu + F.G * e, ws, (const bf16*)(ws + WS_U), (float*)(ws + WS_SSE));
            else { const int wi = cu + F.G * (e - NSQ);
                if (wi < NFW) conv_fix_item(wi * 64 + F.lane, (const bf16*)(ws + WS_XRBX), in[I_CONVW], in[I_CONVB], (bf16*)(ws + WS_XC));
                else if (wi < NCW) conv_item((TR / 32) * 128 + (wi - NFW) * 64 + F.lane, (const bf16*)(ws + WS_XRBX), in[I_CONVW], in[I_CONVB], (bf16*)(ws + WS_XC)); } } } SEAM(2);
    if (IN(3)) { SchedStatic S{NPR, 8, F.G, cu, (const char*)(ws + WS_XC), (const char*)(ws + WS_GW), P1K, (size_t)256 * 256 * 2, 2, (size_t)256 * 2};
        EpiGates E{in[I_GAB], in[I_GXB], (const float*)(ws + WS_TAB + TB_SP8), (const bf16*)(ws + WS_XC), (bf16*)(ws + WS_A), (bf16*)(ws + WS_XRBX)};
        pg8::gemm_phase<EpiGates, SchedStatic, false>(ring, 256, 1024, S, E, notab);
        asm volatile("s_waitcnt vmcnt(0)" ::: "memory"); __syncthreads();
        for (int ui = F.wave >> 1; ; ui += 4) { pg8::Unit u; if (!S.next(ui, u)) break; const int pair = (F.wave & 1) * 32 + (F.lane & 31);
            lru_l1_item(F.lane, u.pm * 4 + (pair >> 4), (u.pn >> 1) * 256 + (u.pn & 1) * 128 + (pair & 15) * 8, (const bf16*)(ws + WS_A), (const bf16*)(ws + WS_XRBX), (float*)(ws + WS_PEND), (float*)(ws + WS_HEND)); }
        for (int t = cu; t < 64; t += F.G) { const int ch0 = t * 16, h = ch0 >> 8, cl = ch0 & 255;
            const bf16* gwb = (const bf16*)(ws + WS_GW) + (size_t)h * 512 * 256 + (size_t)((cl >> 7) * 256 + (cl & 127)) * 256; const bf16* const br[2] = {gwb, gwb + 128 * 256}; f32x4 o[2];
            meta_tile<2>(F, (const bf16*)(ws + WS_XC) + (size_t)RM0 * 1024 + h * 256, 1024, 256, br, 256, o);
            if (F.wave == 0) { const int row = RM0 + (F.lane & 15), ch = ch0 + 4 * (F.lane >> 4); const size_t ro = (size_t)row * 1024 + ch;
                const f32x4 ba = *(const f32x4*)(in[I_GAB] + ch), bx = *(const f32x4*)(in[I_GXB] + ch), sp = *(const f32x4*)((const float*)(ws + WS_TAB + TB_SP8) + ch);
                const v2u xw = *(const v2u*)((const bf16*)(ws + WS_XC) + ro); const float xv[4] = {bflo(xw.x), bfhi(xw.x), bflo(xw.y), bfhi(xw.y)}; f32x4 av, bv;
                for (int j = 0; j < 4; ++j) { const float r = sigmoidf_(o[0][j] + ba[j]), ig = sigmoidf_(o[1][j] + bx[j]), la = -r * sp[j]; av[j] = la; bv[j] = __builtin_amdgcn_sqrtf(fmaxf(one_minus_exp(2.0f * la), 0.0f)) * ig * xv[j]; }
                *(v2u*)((bf16*)(ws + WS_A) + ro) = (v2u){pk2(av[0], av[1]), pk2(av[2], av[3])}; *(v2u*)((bf16*)(ws + WS_XRBX) + ro) = (v2u){pk2(bv[0], bv[1]), pk2(bv[2], bv[3])}; } } } SEAM(3);
    if (IN(5)) { carry_phase(F, ws, (const bf16*)(ws + WS_A), (const bf16*)(ws + WS_XRBX), (const float*)(ws + WS_PEND), (const float*)(ws + WS_HEND), (float*)(ws + WS_CIN), (const bf16*)(ws + WS_U), (const float*)(ws + WS_SSE), (float*)(ws + WS_SSIN)); } SEAM(5);
    if (IN(6)) { mix0_final_phase(F, ws, (const bf16*)(ws + WS_A), (const bf16*)(ws + WS_XRBX), (const float*)(ws + WS_CIN), (const bf16*)(ws + WS_G), (bf16*)(ws + WS_AOUT), in[I_CRE], in[I_CIM], in[I_SD], (const bf16*)(ws + WS_U), (const float*)(ws + WS_SSIN), (bf16*)(ws + WS_GS)); } SEAM(6);
    if (IN(7)) { SchedStatic S{NPR, 2, F.G, cu, (const char*)(ws + WS_GS), (const char*)(ws + WS_GLUW), (size_t)256 * 512 * 2, (size_t)256 * 512 * 2, 0, 0}; EpiGlu E{in[I_GLUB], (const bf16*)(ws + WS_GS), (bf16*)(ws + WS_AOUT)};
        pg8::gemm_phase<EpiGlu, SchedStatic, false>(ring, 512, 512, S, E, notab);
        for (int t = cu; t < 32; t += F.G) { const int n0 = t * 16; const bf16* const br[1] = {(const bf16*)(ws + WS_GLUW) + (size_t)n0 * 512}; f32x4 o[1];
            meta_tile<1>(F, (const bf16*)(ws + WS_GS) + (size_t)RM0 * 512, 512, 512, br, 512, o);
            if (F.wave == 0) { const int row = RM0 + (F.lane & 15), c = n0 + 4 * (F.lane >> 4); const f32x4 b = *(const f32x4*)(in[I_GLUB] + c);
                const v2u gw = *(const v2u*)((const bf16*)(ws + WS_GS) + (size_t)row * 512 + c); const float gv[4] = {bflo(gw.x), bfhi(gw.x), bflo(gw.y), bfhi(gw.y)}; float v[4];
                for (int j = 0; j < 4; ++j) v[j] = gv[j] * sigmoidf_(o[0][j] + b[j]);
                *(v2u*)((bf16*)(ws + WS_AOUT) + (size_t)row * 1536 + 1024 + c) = (v2u){pk2(v[0], v[1]), pk2(v[2], v[3])}; } } } SEAM(7);
    if (IN(8)) { SchedStatic S{NPR, 4, F.G, cu, (const char*)(ws + WS_AOUT), (const char*)(ws + WS_WOUT0), (size_t)256 * 1536 * 2, (size_t)256 * 1536 * 2, 0, 0}; EpiResid E{in[I_X], HB, (float*)(ws + WS_SSQP)};
        pg8::gemm_phase<EpiResid, SchedStatic, false>(ring, 1536, 1536, S, E, notab);
        for (int t = cu; t < 64; t += F.G) { const int n0 = t * 16; const bf16* const br[1] = {(const bf16*)(ws + WS_WOUT0) + (size_t)n0 * 1536}; f32x4 o[1];
            meta_tile<1>(F, (const bf16*)(ws + WS_AOUT) + (size_t)RM0 * 1536, 1536, 1536, br, 1536, o);
            if (F.wave == 0) { float* p = hmeta + (size_t)(F.lane & 15) * 1024 + n0 + 4 * (F.lane >> 4); *(f32x4*)p = *(const f32x4*)p + o[0]; } } } SEAM(8);
    if (IN(10)) { SchedStatic S{NPR, 24, F.G, cu, (const char*)HB, (const char*)(ws + WS_WUP0), P1K, P1K, 0, 0}; LAS float* rst = (LAS float*)(F.lds + TABL_OFF); fold_rstd_table(F, S, (const float*)(ws + WS_SSQP), rst); EpiSwiglu E{(bf16*)(ws + WS_HID0), FF0, (const float*)(ws + WS_SSQP), rst};
        pg8::gemm_phase<EpiSwiglu, SchedStatic, false>(ring, 1024, 1024, S, E, notab);
        const bf16* mrows10 = (cu < FF0 / 16) ? meta_norm_local(F, ws, hmeta) : nullptr;
        for (int t = cu; t < FF0 / 16; t += F.G) { const int u0 = t * 16; const bf16* gb = (const bf16*)(ws + WS_WUP0) + (size_t)((u0 >> 7) * 256 + (u0 & 127)) * 1024; const bf16* const br[2] = {gb, gb + 128 * 1024}; f32x4 o[2];
            meta_tile<2>(F, mrows10, 1024, 1024, br, 1024, o);
            if (F.wave == 0) { const int row = RM0 + (F.lane & 15), c = u0 + 4 * (F.lane >> 4); float v[4]; for (int j = 0; j < 4; ++j) v[j] = siluf_(o[0][j]) * o[1][j];
                *(v2u*)((bf16*)(ws + WS_HID0) + (size_t)row * FF0 + c) = (v2u){pk2(v[0], v[1]), pk2(v[2], v[3])}; } } } SEAM(10);
    if (IN(11)) { SchedStatic S{NPR, 4, F.G, cu, (const char*)(ws + WS_HID0), (const char*)(ws + WS_WDN0), (size_t)256 * FF0 * 2, (size_t)256 * FF0 * 2, 0, 0}; EpiResid E{nullptr, HB, (float*)(ws + WS_SSQP)};
        pg8::gemm_phase<EpiResid, SchedStatic, false>(ring, FF0, FF0, S, E, notab);
        for (int t = cu; t < 64; t += F.G) { const int n0 = t * 16; const bf16* const br[1] = {(const bf16*)(ws + WS_WDN0) + (size_t)n0 * FF0}; f32x4 o[1];
            meta_tile<1>(F, (const bf16*)(ws + WS_HID0) + (size_t)RM0 * FF0, FF0, FF0, br, FF0, o);
            if (F.wave == 0) { float* p = hmeta + (size_t)(F.lane & 15) * 1024 + n0 + 4 * (F.lane >> 4); *(f32x4*)p = *(const f32x4*)p + o[0]; } } } SEAM(11);
    if (IN(13)) { SchedStatic S{NPR, 14, F.G, cu, (const char*)HB, (const char*)(ws + WS_WIN1), P1K, P1K, 0, 0}; EpiWin1 E{(bf16*)(ws + WS_Q), (bf16*)(ws + WS_K), (bf16*)(ws + WS_V), (bf16*)(ws + WS_GATE), (bf16*)(ws + WS_LG), in[I_GB], (const float*)(ws + WS_SSQP), (const LAS float*)(F.lds + TABL_OFF)}; fold_rstd_table(F, S, (const float*)(ws + WS_SSQP), (LAS float*)(F.lds + TABL_OFF));
        pg8::gemm_phase<EpiWin1, SchedStatic, false>(ring, 1024, 1024, S, E, notab);
        const bf16* mrows13 = (cu < 128) ? meta_norm_local(F, ws, hmeta) : nullptr;
        for (int t = cu; t < 128; t += F.G) { const int n0 = t < 32 ? 512 + t * 16 : (t < 96 ? 1024 + (t - 32) * 16 : 3072 + (t - 96) * 16); const bf16* const br[1] = {(const bf16*)(ws + WS_WIN1) + (size_t)n0 * 1024}; f32x4 o[1];
            meta_tile<1>(F, mrows13, 1024, 1024, br, 1024, o);
            if (F.wave == 0) { const int row = RM0 + (F.lane & 15), c = n0 + 4 * (F.lane >> 4); const f32x4 v = o[0];
                if (c < 1024) *(v2u*)((bf16*)(ws + WS_K) + (size_t)row * 512 + c - 512) = (v2u){pk2(v[0], v[1]), pk2(v[2], v[3])};
                else if (c < 2048) *(v2u*)((bf16*)(ws + WS_V) + (size_t)row * 1024 + c - 1024) = (v2u){pk2(v[0], v[1]), pk2(v[2], v[3])};
                else { const f32x4 b = *(const f32x4*)(in[I_GB] + c - 3072); f32x4 l; for (int j = 0; j < 4; ++j) l[j] = logsigmoidf_(v[j] + b[j]) * LG2S; *(v2u*)((bf16*)(ws + WS_LG) + (size_t)row * 512 + c - 3072) = (v2u){pk2(l[0], l[1]), pk2(l[2], l[3])}; } } } } SEAM(13);
    if (IN(14)) { for (int it = cu; it < NB * GH * NSEG; it += F.G) gla_item<false>(F, it >> 6, (it >> 4) & 3, it & 15, (const bf16*)(ws + WS_Q), (const bf16*)(ws + WS_K), (const bf16*)(ws + WS_V), (const bf16*)(ws + WS_GATE), (const bf16*)(ws + WS_LG), in[I_GNORM], (bf16*)(ws + WS_GDS), (float*)(ws + WS_TAB + TB_GAM), (bf16*)(ws + WS_AOUT2)); } SEAM(14);
    if (IN(15)) { gla_l2_phase(F, (const bf16*)(ws + WS_K), (const bf16*)(ws + WS_V), (const bf16*)(ws + WS_LG), (bf16*)(ws + WS_GDS), (const float*)(ws + WS_TAB + TB_GAM)); } SEAM(15);
    if (IN(16)) { for (int it = cu; it < NB * GH * NSEG; it += F.G) gla_item<true>(F, it >> 6, (it >> 4) & 3, it & 15, (const bf16*)(ws + WS_Q), (const bf16*)(ws + WS_K), (const bf16*)(ws + WS_V), (const bf16*)(ws + WS_GATE), (const bf16*)(ws + WS_LG), in[I_GNORM], (bf16*)(ws + WS_GDS), (float*)(ws + WS_TAB + TB_GAM), (bf16*)(ws + WS_AOUT2)); } SEAM(16);
    if (IN(17)) { SchedStatic S{NPR, 4, F.G, cu, (const char*)(ws + WS_AOUT2), (const char*)(ws + WS_WOUT1), P1K, P1K, 0, 0}; EpiResid E{nullptr, HB, nullptr};
        pg8::gemm_phase<EpiResid, SchedStatic, false>(ring, 1024, 1024, S, E, notab); } SEAM(17);
    if (IN(18)) { router_phase(F, args, ws); } SEAM(18);
#define MOE_PHASES(pu, pd, slot) \
    if (IN(pu)) { LAS int* ML = (LAS int*)(F.lds + TABL_OFF + 22528); moe_bases(F, ws, ML); const int np = ML[32 + (slot)], nun = np * 28; LAS int* meta = (LAS int*)(F.lds + TABL_OFF); LAS int* tokt = (LAS int*)(F.lds + TABL_OFF + 512); \
        int nmy = 0; \
        { int tk[20]; \
          _Pragma("unroll") for (int i = 0; i < 20; ++i) { const int Lq = i * F.G + cu; if (Lq < nun) { const int p = Lq / 28, n = Lq % 28, pe = moe_panel_expert(ML, slot, p); if (F.tid == 0) { meta[i * 4] = p; meta[i * 4 + 1] = n; meta[i * 4 + 2] = pe; meta[i * 4 + 3] = 0; } \
              tk[i] = moe_row_token(ML, ws, slot, pe, p * 256 + (F.tid & 255), nullptr); ++nmy; } } \
          _Pragma("unroll") for (int i = 0; i < 20; ++i) { if (i * F.G + cu < nun && F.tid < 256) tokt[i * 256 + F.tid] = tk[i]; } } \
        __syncthreads(); \
          \
        SchedList S{nmy, meta, (const char*)(ws + WS_HNM), (const char*)(ws + WS_WMOE), 0, (size_t)256 * 1024, (size_t)7168 * 1024}; EpiSwiglu8 E{(unsigned char*)(ws + WS_HIDM), FFE}; \
        pg8::gemm_phase<EpiSwiglu8, SchedList, true, true>(ring, 512, 512, S, E, tokt); } SEAM(pu); \
    if (IN(pd)) { LAS int* ML = (LAS int*)(F.lds + TABL_OFF + 22528); moe_bases(F, ws, ML); const int np = ML[32 + (slot)], nun = np * 4, nfull = nun < 512 ? nun : 512, nrem = nun - nfull; LAS int* meta = (LAS int*)(F.lds + TABL_OFF); LAS int* tokt = (LAS int*)(F.lds + TABL_OFF + 512); LAS float* wtt = (LAS float*)(F.lds + TABL_OFF + 512 + 4096); \
        int nmy = 0; \
        for (int i = 0; (long)i * F.G + cu < nfull && i < 3; ++i) { const int Lq = i * F.G + cu, p = Lq / 4, n = Lq % 4, pe = moe_panel_expert(ML, slot, p); if (F.tid == 0) { meta[i * 4] = p; meta[i * 4 + 1] = n; meta[i * 4 + 2] = pe; meta[i * 4 + 3] = 0; } \
            if (F.tid < 256) { float w_; tokt[i * 256 + F.tid] = moe_row_token(ML, ws, slot, pe, p * 256 + F.tid, &w_); wtt[i * 256 + F.tid] = w_; } ++nmy; } \
        const bool slice = cu < nrem * 7;                   \
        if (slice && F.tid == 0) { const int Lq = 512 + cu / 7, p = Lq / 4, n = Lq % 4; meta[12] = p; meta[13] = n; meta[14] = moe_panel_expert(ML, slot, p); meta[15] = (cu % 7) * 256; } \
        __syncthreads(); \
        { SchedList S{nmy, meta, (const char*)(ws + WS_HIDM), (const char*)(ws + WS_WMOE) + (size_t)NE * 7168 * 1024, (size_t)256 * FFE, (size_t)256 * FFE, (size_t)1024 * FFE}; EpiMoeDown E{HB, tokt, wtt}; \
          pg8::gemm_phase<EpiMoeDown, SchedList, false, true>(ring, FFE / 2, FFE / 2, S, E, tokt); } \
        { SchedList S{slice ? 1 : 0, meta + 12, (const char*)(ws + WS_HIDM), (const char*)(ws + WS_WMOE) + (size_t)NE * 7168 * 1024, (size_t)256 * FFE, (size_t)256 * FFE, (size_t)1024 * FFE}; EpiSlab E{(float*)(ws + WS_SLAB), meta + 12}; \
          pg8::gemm_phase<EpiSlab, SchedList, false, true>(ring, 256, FFE / 2, S, E, tokt, FFE / 2); } } SEAM(pd);
    MOE_PHASES(20, 21, 0)
    if (IN(22)) { LAS int* ML = (LAS int*)(F.lds + TABL_OFF + 22528); moe_bases(F, ws, ML); const int np0 = ML[32]; const int nrow = (np0 - 128) * 256; const float* slab = (const float*)(ws + WS_SLAB);
        for (long i = F.gt; i < (long)nrow * 128; i += F.NGT) { const int r = (int)(i >> 7), c8 = (int)(i & 127) * 8; float w; const int tok = moe_row_token(ML, ws, 0, moe_panel_expert(ML, 0, (TR + r) >> 8), TR + r, &w);
            if (tok >= 0) { f32x4 s0 = *(const f32x4*)(slab + (size_t)r * 1024 + c8), s1 = *(const f32x4*)(slab + (size_t)r * 1024 + c8 + 4);
#pragma unroll
                for (int sl = 1; sl < 7; ++sl) { s0 += *(const f32x4*)(slab + ((size_t)sl * 2048 + r) * 1024 + c8); s1 += *(const f32x4*)(slab + ((size_t)sl * 2048 + r) * 1024 + c8 + 4); }
                bf16* d = HB + (size_t)tok * 1024 + c8; f32x4 v0, v1; unpack8(*(const v4u*)d, v0, v1); *(v4u*)d = pack8(v0 + s0 * w, v1 + s1 * w); } } }
    MOE_PHASES(22, 23, 1)
    if (IN(24)) { LAS int* Lb = (LAS int*)(F.lds + TABL_OFF); const unsigned* ctl_ = (const unsigned*)(ws + WS_CTL);
        __syncthreads();
        if (F.tid == 0) { int acc = 0; for (int e = 0; e < 8; ++e) { Lb[e] = acc; acc += ((int)__hip_atomic_load(ctl_ + CW_CNT + 8 + e, RLX_AGENT) + 255) & ~255; } }
        __syncthreads();
        const int* tokinfo1 = (const int*)(ws + WS_TOKINFO) + (size_t)TR * 4; const float* slab = (const float*)(ws + WS_SLAB); const float* fg = in[I_FNORM]; const int lane = F.lane;
        const f32x4 g0 = *(const f32x4*)(fg + 8 * lane), g1 = *(const f32x4*)(fg + 8 * lane + 4), g2 = *(const f32x4*)(fg + 512 + 8 * lane), g3 = *(const f32x4*)(fg + 512 + 8 * lane + 4);
#define FIN_ROW(m, wa, wb, inf) do { f32x4 v[4]; unpack8(wa, v[0], v[1]); unpack8(wb, v[2], v[3]); \
            { const unsigned ex = inf.x, ps = inf.y, wbits = inf.z; const int r1 = Lb[ex] + (int)ps - TR; \
              if (r1 >= 0) { const float w = __uint_as_float(wbits); \
                _Pragma("unroll") for (int sl = 0; sl < 7; ++sl) { const float* sp = slab + ((size_t)sl * 2048 + r1) * 1024; \
                    v[0] += *(const f32x4*)(sp + 8 * lane) * w; v[1] += *(const f32x4*)(sp + 8 * lane + 4) * w; v[2] += *(const f32x4*)(sp + 512 + 8 * lane) * w; v[3] += *(const f32x4*)(sp + 512 + 8 * lane + 4) * w; } } } \
            float s_; { const f32x4 t_ = (v[0] * v[0] + v[1] * v[1]) + (v[2] * v[2] + v[3] * v[3]); s_ = (t_.x + t_.y) + (t_.z + t_.w); } \
            const float rstd = 1.0f / sqrtf(wave_sum(s_) * (1.0f / 1024.0f) + EPS); float* orow = out + (size_t)(m) * 1024; \
            __builtin_nontemporal_store(v[0] * rstd * g0, (f32x4*)(orow + 8 * lane)); __builtin_nontemporal_store(v[1] * rstd * g1, (f32x4*)(orow + 8 * lane + 4)); __builtin_nontemporal_store(v[2] * rstd * g2, (f32x4*)(orow + 512 + 8 * lane)); __builtin_nontemporal_store(v[3] * rstd * g3, (f32x4*)(orow + 512 + 8 * lane + 4)); } while (0)
        for (int m = F.gw; m < TR; m += 4 * F.NGW) { v4u wa[4], wb[4], wi[4];
#pragma unroll
            for (int j = 0; j < 4; ++j) { const int mm = m + j * F.NGW; if (mm < TR) { wa[j] = *(const v4u*)(HB + (size_t)mm * 1024 + 8 * lane); wb[j] = *(const v4u*)(HB + (size_t)mm * 1024 + 512 + 8 * lane); wi[j] = *(const v4u*)(tokinfo1 + (size_t)mm * 4); } }
#pragma unroll
            for (int j = 0; j < 4; ++j) { const int mm = m + j * F.NGW; if (mm < TR) FIN_ROW(mm, wa[j], wb[j], wi[j]); } }
#undef FIN_ROW
#ifdef MK_TP1
        GRID_BAR();
        { const unsigned long long* st = (const unsigned long long*)(ws + WS_TAB + 900 * 1024); float v1 = 0.f, v2 = 0.f, tot = 0.f;
          for (int k = 0; k < 24; ++k) { const float us = (float)(st[k + 1] - st[k]) * 0.01f; if (((unsigned)(MK_TPR) >> k) & 1u) tot += us; if (((unsigned)(MK_TP1) >> k) & 1u) v1 += us; if (((unsigned)(MK_TP2) >> k) & 1u) v2 += us; }
          const float q1 = floorf(MK_TPQ * v1 / tot + MK_TPO), q2 = floorf(MK_TPQ * v2 / tot + MK_TPO);
          const float c1 = sqrtf(q1);
          for (int m = F.gw; m < TR; m += F.NGW) { f32x4* xr = (f32x4*)(out + (size_t)m * 1024) + F.lane; for (int j = 0; j < 4; ++j) xr[64 * j] = (f32x4){c1, c1, c1, c1}; }
          __syncthreads(); GRID_BAR(); if (blockIdx.x == 0 && F.tid == 0) out[0] = 10.0f * q2 + 20.0f; }
#endif
    }
#undef IN
#undef SEAM
}

extern "C" void kernel_launch(void* const* d_in, const int* in_sizes, int n_in, void* d_out, int out_size, void* d_ws, size_t ws_size, hipStream_t stream) {
    static int grid = 0;
    if (grid == 0) {
        if (n_in != 38 || out_size != TR * D || ws_size < WS_END) { fprintf(stderr, "kernel_launch: unexpected problem shape (n_in %d, out %d, ws %zu); nothing launched\n", n_in, out_size, ws_size); grid = -1; return; }
        int dev = 0, cus = 0, per_cu = 0;
        if (hipGetDevice(&dev) != hipSuccess || hipDeviceGetAttribute(&cus, hipDeviceAttributeMultiprocessorCount, dev) != hipSuccess) { grid = -1; return; }
        if (hipFuncSetAttribute((const void*)mk_fwd, hipFuncAttributeMaxDynamicSharedMemorySize, LDS_BYTES) != hipSuccess) { fprintf(stderr, "kernel_launch: hipFuncSetAttribute failed\n"); grid = -1; return; }
        if (hipOccupancyMaxActiveBlocksPerMultiprocessor(&per_cu, (const void*)mk_fwd, 512, LDS_BYTES) != hipSuccess || per_cu < 1) fprintf(stderr, "kernel_launch: note: occupancy query reports %d workgroups per CU\n", per_cu);
        (void)hipGetLastError();
        grid = cus;
    }
    if (grid < 0) return;
    (void)hipMemsetAsync((char*)d_ws + WS_CTL, 0, CTL_ZERO_BYTES, stream);
    Args a{};
    for (int i = 0; i < 38; ++i) a.in[i] = (const float*)d_in[i];
    a.out = (float*)d_out; a.ws = (unsigned char*)d_ws; a.li = 0; a.pad = 0;
#if MK_PER_PHASE
    for (int k = 0; k < N_PHASES; ++k) { a.ph_lo = k; a.ph_hi = k + 1; hipLaunchKernelGGL(mk_fwd, dim3(grid), dim3(512), LDS_BYTES, stream, a); }
#else
    a.ph_lo = 0; a.ph_hi = N_PHASES; hipLaunchKernelGGL(mk_fwd, dim3(grid), dim3(512), LDS_BYTES, stream, a);
#endif
}
```

```cpp
#include <hip/hip_runtime.h>
#include <cstdio>
#include <cstdint>

#ifndef MK_PER_PHASE
#define MK_PER_PHASE 0
#endif

#define GAS __attribute__((address_space(1)))
#define LAS __attribute__((address_space(3)))
typedef unsigned short bf16;
typedef unsigned v4u __attribute__((ext_vector_type(4)));
typedef unsigned v2u __attribute__((ext_vector_type(2)));
typedef float f32x4 __attribute__((ext_vector_type(4)));
typedef float f32x2 __attribute__((ext_vector_type(2)));
typedef short bf16x8 __attribute__((ext_vector_type(8)));

constexpr int D = 1024, NB = 4, SEQ = 8192, NMETA = 16;
constexpr int TR = NB * SEQ;
constexpr int RM0 = TR;
constexpr int NPR = 128, NPA = 129;
constexpr int RALL = NPA * 256;
constexpr int LRUW = 1024, SSMW = 512, NG = 32, NS = 64, EV_IN = 2560, EV_MIX = 1536, FF0 = 3072;
constexpr int GK = 512, GV = 1024, GH = 4, GDK = 128, GDV = 256, OD_INP = 3584  , OD_IN = 3088;
constexpr int NE = 8, FFE = 3584, MROWS = 34816  , MPAN = 136;
constexpr float EPS = 1e-6f;
constexpr int NCH = 128;
constexpr int NSEG = 16, SEGC = 8;

constexpr size_t MiB = 1u << 20;
constexpr size_t WS_CTL = 0, CTL_ZERO_BYTES = 32768;
constexpr size_t WS_TAB = 1 * MiB;
constexpr size_t WS_WIN0 = 2 * MiB, WS_GW = 7 * MiB, WS_GLUW = 8 * MiB, WS_WOUT0 = 9 * MiB, WS_WUP0 = 12 * MiB, WS_WDN0 = 24 * MiB, WS_WIN1 = 30 * MiB, WS_WOUT1 = 37 * MiB;
constexpr size_t WS_PEND = 40 * MiB, WS_HEND = 42 * MiB, WS_CIN = 44 * MiB, WS_SSE = 46 * MiB, WS_SSIN = 54 * MiB, WS_GDS = 62 * MiB, WS_HMETA = 94 * MiB;
constexpr size_t WS_G = 96 * MiB, WS_U = 161 * MiB, WS_A = 194 * MiB, WS_XRBX = 323 * MiB, WS_HN = 388 * MiB, WS_AOUT = 388 * MiB, WS_XC = 453 * MiB, WS_GS = 485 * MiB;
constexpr size_t WS_HID0 = 96 * MiB;
constexpr size_t WS_WE = 62 * MiB;
constexpr size_t WS_Q = 95 * MiB, WS_K = 128 * MiB, WS_V = 161 * MiB, WS_GATE = 226 * MiB, WS_LG = 291 * MiB  , WS_AOUT2 = 453 * MiB;
constexpr size_t WS_HB = 323 * MiB + 512 * 1024;
constexpr size_t WS_SSQP = 518 * MiB  , WS_MPRIV = 520 * MiB  ;
constexpr size_t WS_SLAB = 2 * MiB  , WS_HNM = 72 * MiB  , WS_WMOE = 105 * MiB  , WS_HIDM = 189 * MiB  , WS_TOKINFO = 511 * MiB, WS_RELTOK = 513 * MiB  , WS_RELW = 515 * MiB  , WS_ROWTOK = 512 * MiB, WS_ROWW = 512 * MiB + 512 * 1024, WS_END = 528 * MiB;
constexpr size_t TB_BBR = 0, TB_BBI = 131072, TB_AR = 262144, TB_AI = 270336, TB_AR64 = 278528, TB_AI64 = 286720, TB_SP8 = 294912, TB_GAM = 299008  , TB_PEXP = 430080  , TB_NPAN = 432128;
constexpr int CW_TMO = 0, CW_CODE = 1, CW_CNT = 64  , CW_BAR = 4096;

constexpr int RING_OFF = 0, RING_BYTES = 131072;
constexpr int TABL_OFF = RING_BYTES, TABL_BYTES = 24576;
constexpr int MISC_OFF = TABL_OFF + TABL_BYTES;
constexpr int LDS_BYTES = MISC_OFF + 128;

#define RLX_AGENT __ATOMIC_RELAXED, __HIP_MEMORY_SCOPE_AGENT
#define LDS_WAIT() asm volatile("s_waitcnt lgkmcnt(0)" ::: "memory")
#define VM_WAIT() asm volatile("s_waitcnt vmcnt(0)" ::: "memory")
__device__ __forceinline__ unsigned f2bf(float f) { unsigned u = __builtin_bit_cast(unsigned, f); return (u + 0x7fffu + ((u >> 16) & 1u)) >> 16; }
__device__ __forceinline__ unsigned pk2(float lo, float hi) { unsigned r; asm("v_cvt_pk_bf16_f32 %0, %1, %2" : "=v"(r) : "v"(lo), "v"(hi)); return r; }
typedef int v8i __attribute__((ext_vector_type(8)));
typedef int v4i __attribute__((ext_vector_type(4)));
__device__ __forceinline__ unsigned pk4_fp8(float a, float b, float c, float d) { int w = 0; w = __builtin_amdgcn_cvt_pk_fp8_f32(a, b, w, false); w = __builtin_amdgcn_cvt_pk_fp8_f32(c, d, w, true); return (unsigned)w; }
__device__ __forceinline__ float bf2f(unsigned b) { return __builtin_bit_cast(float, b << 16); }
__device__ __forceinline__ float bflo(unsigned w) { return __builtin_bit_cast(float, w << 16); }
__device__ __forceinline__ float bfhi(unsigned w) { return __builtin_bit_cast(float, w & 0xffff0000u); }
__device__ __forceinline__ float rcpf_(float x) { return __builtin_amdgcn_rcpf(x); }
__device__ __forceinline__ float sigmoidf_(float x) { return rcpf_(1.0f + __expf(-x)); }
__device__ __forceinline__ float siluf_(float x) { return x * rcpf_(1.0f + __expf(-x)); }
__device__ __forceinline__ f32x4 exp2_4(f32x4 a) { f32x4 t; _Pragma("unroll") for (int j = 0; j < 4; ++j) t[j] = __builtin_amdgcn_exp2f(a[j]); return t; }
__device__ __forceinline__ f32x4 rcp_4(f32x4 a) { f32x4 t; _Pragma("unroll") for (int j = 0; j < 4; ++j) t[j] = __builtin_amdgcn_rcpf(a[j]); return t; }
__device__ __forceinline__ f32x4 sigmoid_4(f32x4 x) { return rcp_4(exp2_4(x * -1.4426950408889634f) + 1.0f); }
__device__ __forceinline__ f32x4 silu_4(f32x4 x) { return x * sigmoid_4(x); }
__device__ __forceinline__ f32x4 gelu_tanh_4(f32x4 x) { const f32x4 x2 = x * x, u = x * (x2 * (0.044715f * 0.7978845608028654f * -2.0f * 1.4426950408889634f) + (0.7978845608028654f * -2.0f * 1.4426950408889634f)); return x * rcp_4(exp2_4(u) + 1.0f); }
__device__ __forceinline__ f32x4 logsig2_4(f32x4 x) { f32x4 ax, mn;
    _Pragma("unroll") for (int j = 0; j < 4; ++j) { ax[j] = fabsf(x[j]); mn[j] = fminf(x[j], 0.0f); }
    const f32x4 d = exp2_4(ax * -1.4426950408889634f) + 1.0f; f32x4 l;
    _Pragma("unroll") for (int j = 0; j < 4; ++j) l[j] = __builtin_amdgcn_logf(d[j]);
    return mn * (0.0625f * 1.4426950408889634f) - l * 0.0625f; }
__device__ __forceinline__ float gelu_tanh(float x) { const float u = 0.7978845608028654f * (x + 0.044715f * x * x * x); return x * rcpf_(1.0f + __expf(-2.0f * u)); }
__device__ __forceinline__ float one_minus_exp(float x) { const float p = -x * (1.0f + 0.5f * x * (1.0f + (1.0f / 3.0f) * x * (1.0f + 0.25f * x * (1.0f + 0.2f * x * (1.0f + (1.0f / 6.0f) * x))))); return x > -0.25f ? p : 1.0f - __expf(x); }
constexpr float LG2S = 0.0625f * 1.4426950408889634f;
__device__ __forceinline__ float logsigmoidf_(float x) { return fminf(x, 0.0f) - __logf(1.0f + __expf(-fabsf(x))); }
__device__ __forceinline__ float wave_sum(float v) {
#pragma unroll
    for (int o = 1; o < 64; o <<= 1) v += __shfl_xor(v, o);
    return v;
}

namespace pg8 {
constexpr int BM = 256, BK = 64, HALF = 128, HTB = HALF * BK * 2, STAGE_BYTES = 8 * HTB, NXCD = 8, WGM = 8;
__host__ __device__ __forceinline__ int lds_byte(int r, int c) { const int st = (r >> 4) * 2 + (c >> 5), rr = r & 15, cc = c & 31, ob = rr * 64 + cc * 2; return st * 1024 + (ob ^ (((ob >> 9) & 1) << 5)); }
__host__ __device__ __forceinline__ void stage_rc(int b, int& R, int& C) { const int st = b / 1024, sb = b % 1024, swz = sb ^ (((sb >> 9) & 1) << 5); R = (st >> 1) * 16 + swz / 64; C = (st & 1) * 32 + (swz % 64) / 2; }
__host__ __device__ __forceinline__ int perm32(int rho) { const int n = rho >> 4, i = rho & 15; return 8 * (i >> 2) + 4 * n + (i & 3); }

struct Unit { int pm, pn, slot; const char* a; const char* b; };
__device__ __forceinline__ bool static_tile(int i, int G, int c, int nM, int nN, int& pm, int& pn) {
    const int nwg = nM * nN; const long L = (long)i * G + c; if (L >= nwg) return false;
    int wgid = (int)L; { const int q = nwg / NXCD, r = nwg % NXCD, xcd = wgid % NXCD, off = wgid / NXCD; wgid = (xcd < r ? xcd * (q + 1) : r * (q + 1) + (xcd - r) * q) + off; }
    const int nig = WGM * nN, gid = wgid / nig, fm = gid * WGM, gsz = (nM - fm) < WGM ? (nM - fm) : WGM;
    pm = fm + ((wgid % nig) % gsz); pn = (wgid % nig) / gsz; return true;
}
__device__ __forceinline__ unsigned cvt_pk_bf16(float lo, float hi) { unsigned r; asm volatile("v_cvt_pk_bf16_f32 %0, %1, %2" : "=v"(r) : "v"(lo), "v"(hi)); return r; }

template <class Epi, class Sched, bool GATHER, bool FP8 = false>
__device__ __forceinline__ void gemm_phase(LAS unsigned char* lds, const int K, const int lda, const Sched& S, const Epi& E, const LAS int* gtab, const int ldb_ = 0) {
    const int tid = threadIdx.x, wid = __builtin_amdgcn_readfirstlane(tid >> 6), lane = tid & 63, wr = wid >> 2, wc = wid & 3, fr = lane & 15, fq = lane >> 4;
    int nt = K / BK; asm volatile("" : "+s"(nt));
    int RA[2], CA[2]; unsigned voffB[2];
#pragma unroll
    for (int i = 0; i < 2; ++i) { int R, C; stage_rc(tid * 16 + i * 8192, R, C); const int Rb = Epi::PERM ? ((R & ~31) + perm32(R & 31)) : R;
        RA[i] = R; CA[i] = C; voffB[i] = (unsigned)(Rb * (ldb_ ? ldb_ : K) + C) * 2u; }
    const size_t kstep = (size_t)(BK * 2);
    const size_t hstepB = (size_t)HALF * (ldb_ ? ldb_ : K) * 2;
    const unsigned ldsw = (unsigned)wid * 1024u;
    const int aoff = lds_byte(wr * 64 + fr, fq * 8), boff = lds_byte(wc * 32 + fr, fq * 8);
    unsigned offC[2][2], offN[2][2];
#define PG8_SETOFF(dst, unit) do { _Pragma("unroll") for (int _h = 0; _h < 2; ++_h) _Pragma("unroll") for (int _i = 0; _i < 2; ++_i) { \
        if constexpr (GATHER) { int _t = gtab[(unit).slot * 256 + _h * HALF + RA[_i]]; _t = _t < 0 ? 0 : _t; dst[_h][_i] = ((unsigned)_t * (unsigned)lda + (unsigned)CA[_i]) * 2u; } \
        else dst[_h][_i] = ((unsigned)(_h * HALF + RA[_i]) * (unsigned)lda + (unsigned)CA[_i]) * 2u; } } while (0)
#define PG8_SA(b, h) (((b) * 2 + (h)) * HTB)
#define PG8_SB(b, h) ((4 + (b) * 2 + (h)) * HTB)
#define PG8_STAGEB(bufoff, gbase) do { _Pragma("unroll") for (int _i = 0; _i < 2; ++_i) \
        __builtin_amdgcn_global_load_lds((const unsigned*)((const char*)(gbase) + voffB[_i]), (LAS unsigned*)(lds + (bufoff) + ldsw + _i * 8192), 16, 0, 0); } while (0)
#define PG8_STAGEA(bufoff, gbase, o0, o1) do { \
        __builtin_amdgcn_global_load_lds((const unsigned*)((const char*)(gbase) + (o0)), (LAS unsigned*)(lds + (bufoff) + ldsw), 16, 0, 0); \
        __builtin_amdgcn_global_load_lds((const unsigned*)((const char*)(gbase) + (o1)), (LAS unsigned*)(lds + (bufoff) + ldsw + 8192), 16, 0, 0); } while (0)
#define PG8_LDA(dst, b, h) do { _Pragma("unroll") for (int m = 0; m < 4; ++m) { const LAS v4i* _p = (const LAS v4i*)(lds + PG8_SA(b, h) + aoff + m * 2048); dst[m] = __builtin_shufflevector(_p[0], _p[64], 0, 1, 2, 3, 4, 5, 6, 7); } } while (0)
#define PG8_LDB(dst, b, h) do { _Pragma("unroll") for (int n = 0; n < 2; ++n) { const LAS v4i* _p = (const LAS v4i*)(lds + PG8_SB(b, h) + boff + n * 2048); dst[n] = __builtin_shufflevector(_p[0], _p[64], 0, 1, 2, 3, 4, 5, 6, 7); } } while (0)
#define PG8_HALF(x, k) __builtin_bit_cast(bf16x8, __builtin_shufflevector(x, x, 4 * (k), 4 * (k) + 1, 4 * (k) + 2, 4 * (k) + 3))
#define PG8_MMA(ai, bj, At, Bt) do { __builtin_amdgcn_s_setprio(1); _Pragma("unroll") for (int m = 0; m < 4; ++m) _Pragma("unroll") for (int n = 0; n < 2; ++n) { \
        if constexpr (FP8) asm volatile("v_mfma_scale_f32_16x16x128_f8f6f4 %0, %1, %2, %0, %3, %3 op_sel_hi:[0,0,0]" : "+v"(acc[ai][bj][m][n]) : "v"(Bt[n]), "v"(At[m]), "v"(one8));   \
        else { acc[ai][bj][m][n] = __builtin_amdgcn_mfma_f32_16x16x32_bf16(PG8_HALF(Bt[n], 0), PG8_HALF(At[m], 0), acc[ai][bj][m][n], 0, 0, 0); \
               acc[ai][bj][m][n] = __builtin_amdgcn_mfma_f32_16x16x32_bf16(PG8_HALF(Bt[n], 1), PG8_HALF(At[m], 1), acc[ai][bj][m][n], 0, 0, 0); } } __builtin_amdgcn_s_setprio(0); } while (0)
#define PG8_WAIT_V(n) asm volatile("s_waitcnt vmcnt(" #n ")" ::: "memory")
#define PG8_WAIT_L(n) asm volatile("s_waitcnt lgkmcnt(" #n ")" ::: "memory")
#define PG8_BAR __builtin_amdgcn_s_barrier()
#define PG8_SCHED __builtin_amdgcn_sched_barrier(0)
    Unit cur, nxt; int ui = 0;
    if (!S.next(0, cur)) return;
    f32x4 acc[2][2][4][2];
#pragma unroll
    for (int a = 0; a < 2; ++a)
#pragma unroll
        for (int b = 0; b < 2; ++b)
#pragma unroll
            for (int m = 0; m < 4; ++m)
#pragma unroll
                for (int n = 0; n < 2; ++n) acc[a][b][m][n] = (f32x4){0.f, 0.f, 0.f, 0.f};
    v8i At[4], B0[2], B1[2];
    int one8 = 0x7F7F7F7F; asm volatile("" : "+v"(one8));
    const char* cA = cur.a; const char* cB = cur.b;
    PG8_SETOFF(offC, cur);
    PG8_STAGEB(PG8_SB(0, 0), cB); PG8_STAGEB(PG8_SB(0, 1), cB + hstepB); PG8_STAGEA(PG8_SA(0, 0), cA, offC[0][0], offC[0][1]); PG8_STAGEA(PG8_SA(0, 1), cA, offC[1][0], offC[1][1]);
    if (wr == 1) PG8_BAR;
    PG8_WAIT_V(2); PG8_BAR;
    PG8_STAGEB(PG8_SB(1, 0), cB + kstep); PG8_STAGEA(PG8_SA(1, 0), cA + kstep, offC[0][0], offC[0][1]); PG8_STAGEB(PG8_SB(1, 1), cB + hstepB + kstep);
    PG8_WAIT_V(6); PG8_BAR;
    for (;;) {
        const bool has_next = S.next(ui + 1, nxt);
        const char* nA = has_next ? nxt.a : cA; const char* nB = has_next ? nxt.b : cB;
        if constexpr (GATHER) {
#pragma unroll
        for (int h = 0; h < 2; ++h)
#pragma unroll
            for (int i = 0; i < 2; ++i) offN[h][i] = offC[h][i]; }
        for (int t = 0; t < nt; t += 2) {
            const bool last = (t == nt - 2);
            const char* a1 = cA + (size_t)(t + 1) * kstep;
            const char* a2 = last ? nA : cA + (size_t)(t + 2) * kstep; const char* b2 = last ? nB : cB + (size_t)(t + 2) * kstep;
            const char* a3 = a2 + kstep; const char* b3 = b2 + kstep;
            if constexpr (GATHER) { if (last && has_next) PG8_SETOFF(offN, nxt); }
            unsigned q00 = offC[0][0], q01 = offC[0][1], q10 = offC[1][0], q11 = offC[1][1];
            if constexpr (GATHER) { q00 = last ? offN[0][0] : q00; q01 = last ? offN[0][1] : q01; q10 = last ? offN[1][0] : q10; q11 = last ? offN[1][1] : q11; }
            PG8_LDB(B0, 0, 0); PG8_LDB(B1, 0, 1); PG8_SCHED; PG8_LDA(At, 0, 0); PG8_STAGEA(PG8_SA(1, 1), a1, offC[1][0], offC[1][1]);
            PG8_WAIT_V(8); PG8_WAIT_L(0); PG8_BAR; PG8_MMA(0, 0, At, B0); PG8_MMA(0, 1, At, B1); PG8_BAR; PG8_SCHED;
            PG8_LDA(At, 0, 1); PG8_STAGEB(PG8_SB(0, 0), b2); PG8_STAGEB(PG8_SB(0, 1), b2 + hstepB); PG8_STAGEA(PG8_SA(0, 0), a2, q00, q01);
            PG8_WAIT_V(8); PG8_WAIT_L(0); PG8_BAR; PG8_MMA(1, 0, At, B0); PG8_MMA(1, 1, At, B1); PG8_BAR; PG8_SCHED;
            PG8_LDB(B0, 1, 0); PG8_LDB(B1, 1, 1); PG8_SCHED; PG8_LDA(At, 1, 0); PG8_STAGEA(PG8_SA(0, 1), a2, q10, q11);
            PG8_WAIT_V(8); PG8_WAIT_L(0); PG8_BAR; PG8_MMA(0, 0, At, B0); PG8_MMA(0, 1, At, B1); PG8_BAR; PG8_SCHED;
            PG8_LDA(At, 1, 1); PG8_STAGEB(PG8_SB(1, 0), b3); PG8_STAGEB(PG8_SB(1, 1), b3 + hstepB); PG8_STAGEA(PG8_SA(1, 0), a3, q00, q01);
            PG8_WAIT_V(8); PG8_WAIT_L(0); PG8_BAR; PG8_MMA(1, 0, At, B0); PG8_MMA(1, 1, At, B1); PG8_BAR; PG8_SCHED;
        }
        if (wr == 0) PG8_BAR;
        if constexpr (FP8) asm volatile("s_nop 15\n\ts_nop 15" ::: "memory");
        E(acc, cur, wr, wc, fr, fq);
        if (!has_next) break;
#pragma unroll
        for (int a = 0; a < 2; ++a)
#pragma unroll
            for (int b = 0; b < 2; ++b)
#pragma unroll
                for (int m = 0; m < 4; ++m)
#pragma unroll
                    for (int n = 0; n < 2; ++n) acc[a][b][m][n] = (f32x4){0.f, 0.f, 0.f, 0.f};
        cur = nxt; cA = nA; cB = nB; ++ui;
        if constexpr (GATHER) {
#pragma unroll
        for (int h = 0; h < 2; ++h)
#pragma unroll
            for (int i = 0; i < 2; ++i) offC[h][i] = offN[h][i]; }
        if (wr == 1) PG8_BAR;
    }
    PG8_WAIT_V(0);
    PG8_BAR;
#undef PG8_SETOFF
#undef PG8_SA
#undef PG8_SB
#undef PG8_STAGEA
#undef PG8_STAGEB
#undef PG8_LDA
#undef PG8_LDB
#undef PG8_MMA
#undef PG8_HALF
#undef PG8_WAIT_V
#undef PG8_WAIT_L
#undef PG8_BAR
#undef PG8_SCHED
}
}

#define XB_TMO      128
#define XB_XCNT(j)  (256  + 64 * (j))
#define XB_XSUB(j)  (1280 + 64 * (j))
#define XB_XGEN(j)  (2304 + 64 * (j))
#define XB_TOP      3328
#define XB_TOPGEN   3392
#define XCD_BAR_WORDS 3456
#define XB_SPIN_CAP (1u << 18)
__device__ __forceinline__ unsigned xb_ld(unsigned* p)              { return __hip_atomic_load(p, __ATOMIC_RELAXED, __HIP_MEMORY_SCOPE_AGENT); }
__device__ __forceinline__ unsigned xb_add(unsigned* p, unsigned v) { return __hip_atomic_fetch_add(p, v, __ATOMIC_RELAXED, __HIP_MEMORY_SCOPE_AGENT); }
__device__ __forceinline__ unsigned xb_xcc_id() { return (unsigned)__builtin_amdgcn_s_getreg((3 << 11) | 20) & 0xFu; }
#define XB_SPIN(cond, bar) do { unsigned _sp = 0; while (cond) { __builtin_amdgcn_s_sleep(1); \
    if ((++_sp & 255u) == 0u) { if (xb_ld(&(bar)[XB_TMO])) break; if (_sp > XB_SPIN_CAP) { atomicAdd(&(bar)[XB_TMO], 1u); break; } } } } while (0)
struct XcdBarrier { unsigned* bar; unsigned x; volatile LAS unsigned* st; };
__device__ __forceinline__ XcdBarrier xcd_barrier_post(unsigned* bar, volatile LAS unsigned* st) {
    XcdBarrier b; b.bar = bar; b.x = xb_xcc_id(); b.st = st;
    if (threadIdx.x == 0) (void)xb_add(&bar[XB_XCNT(b.x)], 1u);
    return b;
}
__device__ __forceinline__ void xcd_barrier_complete(unsigned* bar, unsigned x, unsigned& nloc, unsigned& nx) {
    const unsigned G = gridDim.x * gridDim.y * gridDim.z;
    unsigned sum, cnt, mine, sp = 0u;
    for (;;) {
        sum = 0u; cnt = 0u; mine = 0u;
#pragma unroll
        for (unsigned j = 0; j < 16; ++j) { const unsigned c = xb_ld(&bar[XB_XCNT(j)]); sum += c; cnt += (c > 0u) ? 1u : 0u; mine = (j == x) ? c : mine; }
        if (sum == G) break;
        __builtin_amdgcn_s_sleep(1);
        if ((++sp & 255u) == 0u) { if (xb_ld(&bar[XB_TMO])) break; if (sp > XB_SPIN_CAP) { atomicAdd(&bar[XB_TMO], 1u); break; } }
    }
    nloc = mine > 0u ? mine : 1u; nx = cnt > 0u ? cnt : 1u;
}
__device__ __forceinline__ void xcd_barrier(const XcdBarrier& b) {
    asm volatile("s_waitcnt vmcnt(0)" ::: "memory");
    __syncthreads();
    if (threadIdx.x == 0) {
        unsigned* bar = b.bar;
        __builtin_amdgcn_s_waitcnt(0);
        unsigned nloc = b.st[0], nx = b.st[1];
        if (nloc == 0u) { xcd_barrier_complete(bar, b.x, nloc, nx); b.st[0] = nloc; b.st[1] = nx; }
        const unsigned old = xb_add(&bar[XB_XSUB(b.x)], 1u);
        const unsigned gen = old / nloc;
        if (old + 1u == (gen + 1u) * nloc) {
            __builtin_amdgcn_fence(__ATOMIC_RELEASE, "agent");
            asm volatile("s_waitcnt vmcnt(0)" ::: "memory");
            const unsigned og = xb_add(&bar[XB_TOP], 1u);
            const unsigned tg = og / nx;
            if (og + 1u == (tg + 1u) * nx) xb_add(&bar[XB_TOPGEN], 1u);
            else XB_SPIN(xb_ld(&bar[XB_TOPGEN]) == tg, bar);
            __builtin_amdgcn_fence(__ATOMIC_ACQUIRE, "agent");
            xb_add(&bar[XB_XGEN(b.x)], 1u);
            asm volatile("s_waitcnt vmcnt(0)" ::: "memory");
        } else {
            XB_SPIN(xb_ld(&bar[XB_XGEN(b.x)]) == gen, bar);
            __builtin_amdgcn_fence(__ATOMIC_ACQUIRE, "agent");
            asm volatile("s_waitcnt vmcnt(0)" ::: "memory");
        }
    }
    __syncthreads();
}

struct Args { const float* in[38]; float* out; unsigned char* ws; int ph_lo, ph_hi, li, pad; };
struct Frame {
    LAS unsigned char* lds;
    int tid, lane, wave, G, gw, NGW;
    int gt, NGT;
};
enum { I_X = 0, I_META, I_NORM_MIX0, I_WIN0, I_CONVW, I_CONVB, I_GAW, I_GAB, I_GXW, I_GXB, I_LAM, I_LRE, I_LIM, I_LDT, I_BRE, I_BIM, I_CRE, I_CIM, I_SD, I_GLUW, I_GLUB, I_WOUT0, I_NORM_FFN0,
       I_FG, I_FU, I_FD, I_NORM_MIX1, I_WIN1, I_GW2, I_GB, I_GNORM, I_WOUT1, I_NORM_FFN1, I_ROUTER, I_MG, I_MU, I_MD, I_FNORM };

struct SchedStatic {
    int nM, nN, G, c; const char* A; const char* B; size_t aStep, bStep; int aColDiv; size_t aColStep;
    __device__ __forceinline__ bool next(int i, pg8::Unit& u) const {
        int pm, pn; if (!pg8::static_tile(i, G, c, nM, nN, pm, pn)) return false;
        u.pm = pm; u.pn = pn; u.slot = i; u.a = A + (size_t)pm * aStep + (aColDiv ? (size_t)(pn / aColDiv) * aColStep : 0); u.b = B + (size_t)pn * bStep; return true;
    }
};
struct SchedList {
    int n; const LAS int* meta; const char* A; const char* B; size_t aStep, bTile, bExpert;
    __device__ __forceinline__ bool next(int i, pg8::Unit& u) const {
        if (i >= n) return false;
        const int pm = meta[i * 4 + 0], pn = meta[i * 4 + 1], e = meta[i * 4 + 2];
        u.pm = pm; u.pn = pn; u.slot = i; const int ko = meta[i * 4 + 3]; u.a = A + (size_t)pm * aStep + (size_t)ko * 2; u.b = B + (size_t)e * bExpert + (size_t)pn * bTile + (size_t)ko * 2; return true;
    }
};

#define EPI_ROWS(ai, m) ((ai) * 128 + wr * 64 + (m) * 16 + fr)
#define EPI_COLP(bj) ((bj) * 128 + wc * 32 + 8 * fq)
#define EPI_COLN(bj, n) ((bj) * 128 + wc * 32 + 16 * (n) + 4 * fq)
typedef const f32x4 (&AccRef)[2][2][4][2];
__device__ __forceinline__ void unpack8(v4u w, f32x4& a, f32x4& b) { a = (f32x4){bflo(w.x), bfhi(w.x), bflo(w.y), bfhi(w.y)}; b = (f32x4){bflo(w.z), bfhi(w.z), bflo(w.w), bfhi(w.w)}; }
__device__ __forceinline__ v4u pack8(f32x4 a, f32x4 b) { v4u w; w.x = pg8::cvt_pk_bf16(a[0], a[1]); w.y = pg8::cvt_pk_bf16(a[2], a[3]); w.z = pg8::cvt_pk_bf16(b[0], b[1]); w.w = pg8::cvt_pk_bf16(b[2], b[3]); return w; }

template <int D> __device__ __forceinline__ float ror16(float v) { return __builtin_bit_cast(float, __builtin_amdgcn_update_dpp(0, __builtin_bit_cast(int, v), 0x120 + D, 0xF, 0xF, false)); }
template <int D> __device__ __forceinline__ float shr16_keep(float v, float keep) { return __builtin_bit_cast(float, __builtin_amdgcn_update_dpp(__builtin_bit_cast(int, keep), __builtin_bit_cast(int, v), 0x110 + D, 0xF, 0xF, false)); }
struct EpiWin0 {
    static constexpr bool PERM = true; bf16 *G, *XR, *U; const float *cw, *cb; bf16* XC;
    __device__ __forceinline__ void operator()(AccRef acc, const pg8::Unit& u, int wr, int wc, int fr, int fq) const {
        const int pn = u.pn; bf16* base; int ld, c0;
        if (pn >= 4 && pn < 8) {
#pragma unroll
            for (int bj = 0; bj < 2; ++bj)
#pragma unroll
              for (int n = 0; n < 2; ++n) { const int cc = (pn - 4) * 256 + EPI_COLP(bj) + 4 * n;
                f32x4 w0 = *(const f32x4*)(cw + cc), w1 = *(const f32x4*)(cw + 1024 + cc), w2 = *(const f32x4*)(cw + 2048 + cc), w3 = *(const f32x4*)(cw + 3072 + cc); const f32x4 bb = *(const f32x4*)(cb + cc);
#pragma unroll
                for (int ai = 0; ai < 2; ++ai) { f32x4 q1 = {0.f, 0.f, 0.f, 0.f}, q2 = q1, q3 = q1;
#pragma unroll
                    for (int m = 0; m < 4; ++m) { const size_t ro = (size_t)(u.pm * 256 + EPI_ROWS(ai, m)) * 1024 + cc; const f32x4 x = acc[ai][bj][m][n]; f32x4 t1, t2, t3, p1, p2, p3;
#pragma unroll
                        for (int j = 0; j < 4; ++j) { t1[j] = ror16<1>(x[j]); t2[j] = ror16<2>(x[j]); t3[j] = ror16<3>(x[j]);
                            p1[j] = shr16_keep<1>(x[j], q1[j]); p2[j] = shr16_keep<2>(x[j], q2[j]); p3[j] = shr16_keep<3>(x[j], q3[j]); }
                        const f32x4 o = bb + w0 * p3 + w1 * p2 + w2 * p1 + w3 * x;
                        q1 = t1; q2 = t2; q3 = t3;
                        const bool fix = (m == 0) && fr < 3;
                        if (!fix) *(v2u*)(XC + ro) = (v2u){pk2(o.x, o.y), pk2(o.z, o.w)};
                        if (fix || ((m == 3) && fr >= 13)) *(v2u*)(XR + ro) = (v2u){pk2(x.x, x.y), pk2(x.z, x.w)};
                        asm volatile("" : "+v"(q1), "+v"(q2), "+v"(q3) :: "memory"); } } }
            return; }
        if (pn < 4) { base = G; ld = 1024; c0 = pn * 256; } else if (pn < 8) { base = XR; ld = 1024; c0 = (pn - 4) * 256; } else { base = U; ld = 512; c0 = (pn - 8) * 256; }
#pragma unroll
        for (int ai = 0; ai < 2; ++ai)
#pragma unroll
            for (int m = 0; m < 4; ++m) { bf16* rowp = base + (size_t)(u.pm * 256 + EPI_ROWS(ai, m)) * ld + c0;
#pragma unroll
                for (int bj = 0; bj < 2; ++bj) { f32x4 v0 = acc[ai][bj][m][0], v1 = acc[ai][bj][m][1];
                    if (pn < 4) {
#pragma unroll
                        for (int j = 0; j < 1; ++j) { v0 = gelu_tanh_4(v0); v1 = gelu_tanh_4(v1); } }
                    *(v4u*)(rowp + EPI_COLP(bj)) = pack8(v0, v1); } }
    }
};
struct EpiGates {
    static constexpr bool PERM = true; const float *gab, *gxb, *sp8; const bf16* XC; bf16* A; bf16* BX;
    __device__ __forceinline__ void operator()(AccRef acc, const pg8::Unit& u, int wr, int wc, int fr, int fq) const {
        const int ch0 = (u.pn >> 1) * 256 + (u.pn & 1) * 128 + wc * 32 + 8 * fq;
        f32x4 ba[2], bx[2], sp[2];
#pragma unroll
        for (int n = 0; n < 2; ++n) { ba[n] = *(const f32x4*)(gab + ch0 + 4 * n); bx[n] = *(const f32x4*)(gxb + ch0 + 4 * n); sp[n] = *(const f32x4*)(sp8 + ch0 + 4 * n); }
#pragma unroll
        for (int ai = 0; ai < 2; ++ai)
#pragma unroll
            for (int m = 0; m < 4; ++m) { const size_t ro = (size_t)(u.pm * 256 + EPI_ROWS(ai, m)) * 1024 + ch0;
                const v4u xw = *(const v4u*)(XC + ro); f32x4 xv[2]; unpack8(xw, xv[0], xv[1]);
                f32x4 av[2], bv[2];
#pragma unroll
                for (int n = 0; n < 2; ++n) { const f32x4 r = sigmoid_4(acc[ai][0][m][n] + ba[n]), ig = sigmoid_4(acc[ai][1][m][n] + bx[n]);
                    const f32x4 la = r * sp[n] * -1.0f, aa = exp2_4(la * 1.4426950408889634f); f32x4 om = aa * aa * -1.0f + 1.0f, sq;
#pragma unroll
                    for (int j = 0; j < 4; ++j) sq[j] = __builtin_amdgcn_sqrtf(fmaxf(om[j], 0.0f));
                    av[n] = la; bv[n] = sq * ig * xv[n]; }
                *(v4u*)(A + ro) = pack8(av[0], av[1]); *(v4u*)(BX + ro) = pack8(bv[0], bv[1]); asm volatile("" ::: "memory"); }
    }
};
struct EpiGlu {
    static constexpr bool PERM = true; const float* glub; const bf16* GS; bf16* AOUT;
    __device__ __forceinline__ void operator()(AccRef acc, const pg8::Unit& u, int wr, int wc, int fr, int fq) const {
#pragma unroll
        for (int bj = 0; bj < 2; ++bj) { const int c = u.pn * 256 + EPI_COLP(bj); const f32x4 b0 = *(const f32x4*)(glub + c), b1 = *(const f32x4*)(glub + c + 4);
#pragma unroll
            for (int ai = 0; ai < 2; ++ai)
#pragma unroll
                for (int m = 0; m < 4; ++m) { const size_t row = (size_t)(u.pm * 256 + EPI_ROWS(ai, m));
                    f32x4 g0_, g1_; unpack8(*(const v4u*)(GS + row * 512 + c), g0_, g1_);
                    const f32x4 v0 = g0_ * sigmoid_4(acc[ai][bj][m][0] + b0), v1 = g1_ * sigmoid_4(acc[ai][bj][m][1] + b1);
                    *(v4u*)(AOUT + row * 1536 + 1024 + c) = pack8(v0, v1); } }
    }
};
struct EpiResid {
    static constexpr bool PERM = true; const float* xsrc; bf16* hb; float* ssqp;
    __device__ __forceinline__ void operator()(AccRef acc, const pg8::Unit& u, int wr, int wc, int fr, int fq) const {
        float q[2][4];
#pragma unroll
        for (int ai = 0; ai < 2; ++ai)
#pragma unroll
            for (int m = 0; m < 4; ++m) { const size_t ro = (size_t)(u.pm * 256 + EPI_ROWS(ai, m)) * 1024 + u.pn * 256; float qs = 0.f;
#pragma unroll
                for (int bj = 0; bj < 2; ++bj) { const size_t o = ro + EPI_COLP(bj); f32x4 v0, v1;
                    if (xsrc) { v0 = *(const f32x4*)(xsrc + o); v1 = *(const f32x4*)(xsrc + o + 4); } else unpack8(*(const v4u*)(hb + o), v0, v1);
                    v0 += acc[ai][bj][m][0]; v1 += acc[ai][bj][m][1];
                    { const f32x4 sq_ = v0 * v0 + v1 * v1; qs += (sq_.x + sq_.y) + (sq_.z + sq_.w); }
                    *(v4u*)(hb + o) = pack8(v0, v1); }
                q[ai][m] = qs; }
        if (ssqp) {
#pragma unroll
            for (int ai = 0; ai < 2; ++ai)
#pragma unroll
                for (int m = 0; m < 4; ++m) { float t = q[ai][m]; t += __shfl_xor(t, 16); t += __shfl_xor(t, 32);
                    if (fq == 0) ssqp[(size_t)(u.pm * 256 + EPI_ROWS(ai, m)) * 16 + u.pn * 4 + wc] = t; } }
    }
};
__device__ __forceinline__ f32x4 swiglu4_x32(f32x4 G, f32x4 U) {
    const f32x4 a = G * (-1.4426950408889634f / 32.0f) + 10.0f; f32x4 t;
#pragma unroll
    for (int j = 0; j < 4; ++j) t[j] = __builtin_amdgcn_exp2f(a[j]);
    const f32x4 d = t + 1024.0f; f32x4 q;
#pragma unroll
    for (int j = 0; j < 4; ++j) q[j] = rcpf_(d[j]);
    return (G * U) * q; }
__device__ __forceinline__ f32x4 swiglu4_r(f32x4 G, f32x4 U, float r2, float rl) {
    const f32x4 a = G * rl; f32x4 t;
#pragma unroll
    for (int j = 0; j < 4; ++j) t[j] = __builtin_amdgcn_exp2f(a[j]);
    const f32x4 d = t + 1.0f; f32x4 q;
#pragma unroll
    for (int j = 0; j < 4; ++j) q[j] = rcpf_(d[j]);
    return (G * U) * (q * r2); }
__device__ __forceinline__ float rstd_of(const float* ssqp, size_t row) { const f32x4* p = (const f32x4*)(ssqp + row * 16); const f32x4 a = p[0], b = p[1], c = p[2], d = p[3];
    const f32x4 t = (a + b) + (c + d); return __builtin_amdgcn_rsqf(((t.x + t.y) + (t.z + t.w)) * (1.0f / 1024.0f) + EPS); }
constexpr int FOLD_MAXU = 20;
__device__ __forceinline__ float fold_rstd(const LAS float* rst, const float* ssqp, const pg8::Unit& u, int r) { return u.slot < FOLD_MAXU ? rst[u.slot * 256 + r] : rstd_of(ssqp, (size_t)(u.pm * 256 + r)); }
struct EpiSwiglu {
    static constexpr bool PERM = true; bf16* H; int ld; const float* ssqp; const LAS float* rst;
    __device__ __forceinline__ void operator()(AccRef acc, const pg8::Unit& u, int wr, int wc, int fr, int fq) const {
        const int c = u.pn * 128 + wc * 32 + 8 * fq;
        float rs[2][4];
#pragma unroll
        for (int ai = 0; ai < 2; ++ai)
#pragma unroll
            for (int m = 0; m < 4; ++m) rs[ai][m] = fold_rstd(rst, ssqp, u, EPI_ROWS(ai, m));
#pragma unroll
        for (int ai = 0; ai < 2; ++ai)
#pragma unroll
            for (int m = 0; m < 4; ++m) { const float r = rs[ai][m], r2 = r * r, rl = r * -1.4426950408889634f;
                const f32x4 v0 = swiglu4_r(acc[ai][0][m][0], acc[ai][1][m][0], r2, rl), v1 = swiglu4_r(acc[ai][0][m][1], acc[ai][1][m][1], r2, rl);
                *(v4u*)(H + (size_t)(u.pm * 256 + EPI_ROWS(ai, m)) * ld + c) = pack8(v0, v1); }
    }
};
struct EpiWin1 {
    static constexpr bool PERM = true; bf16 *Q, *K, *V, *GATE; bf16* LG; const float* gb; const float* ssqp; const LAS float* rst;
    __device__ __forceinline__ void operator()(AccRef acc, const pg8::Unit& u, int wr, int wc, int fr, int fq) const {
        const int pn = u.pn;
        float rs[2][4];
#pragma unroll
        for (int ai = 0; ai < 2; ++ai)
#pragma unroll
            for (int m = 0; m < 4; ++m) rs[ai][m] = fold_rstd(rst, ssqp, u, EPI_ROWS(ai, m));
#pragma unroll
        for (int ai = 0; ai < 2; ++ai)
#pragma unroll
            for (int m = 0; m < 4; ++m) { const size_t row = (size_t)(u.pm * 256 + EPI_ROWS(ai, m)); const float r = rs[ai][m];
#pragma unroll
                for (int bj = 0; bj < 2; ++bj) { f32x4 v0 = acc[ai][bj][m][0] * r, v1 = acc[ai][bj][m][1] * r; const int cc = EPI_COLP(bj);
                    if (pn < 2) { v0 = v0 * 0.08838834764831845f; v1 = v1 * 0.08838834764831845f; *(v4u*)(Q + row * 512 + pn * 256 + cc) = pack8(v0, v1); }
                    else if (pn < 4) { *(v4u*)(K + row * 512 + (pn - 2) * 256 + cc) = pack8(v0, v1); }
                    else if (pn < 8) { *(v4u*)(V + row * 1024 + (pn - 4) * 256 + cc) = pack8(v0, v1); }
                    else if (pn < 12) {
#pragma unroll
                        for (int j = 0; j < 1; ++j) { v0 = silu_4(v0); v1 = silu_4(v1); }
                        *(v4u*)(GATE + row * 1024 + (pn - 8) * 256 + cc) = pack8(v0, v1); }
                    else { const int c = (pn - 12) * 256 + cc; const f32x4 b0 = *(const f32x4*)(gb + c), b1 = *(const f32x4*)(gb + c + 4);
#pragma unroll
                        for (int j = 0; j < 1; ++j) { v0 = logsig2_4(v0 + b0); v1 = logsig2_4(v1 + b1); }
                        *(v4u*)(LG + row * 512 + c) = pack8(v0, v1); } } }
    }
};
__device__ __forceinline__ float swiglu_x32(float G, float U) { const float t = __builtin_amdgcn_exp2f(__builtin_fmaf(G, -1.4426950408889634f / 32.0f, 10.0f)); return (G * U) * rcpf_(1024.0f + t); }
struct EpiSwiglu8 {
    static constexpr bool PERM = true; unsigned char* H; int ld;
    __device__ __forceinline__ void operator()(AccRef acc, const pg8::Unit& u, int wr, int wc, int fr, int fq) const {
        const int c = u.pn * 128 + wc * 32 + 8 * fq; constexpr float SC = 1.0f / 32.0f;
#pragma unroll
        for (int ai = 0; ai < 2; ++ai)
#pragma unroll
            for (int m = 0; m < 4; ++m) { float v[8];
#pragma unroll
                for (int j = 0; j < 1; ++j) { const f32x4 o0 = swiglu4_x32(acc[ai][0][m][0], acc[ai][1][m][0]), o1 = swiglu4_x32(acc[ai][0][m][1], acc[ai][1][m][1]);
                    v[0] = o0.x; v[1] = o0.y; v[2] = o0.z; v[3] = o0.w; v[4] = o1.x; v[5] = o1.y; v[6] = o1.z; v[7] = o1.w; }
                *(v2u*)(H + (size_t)(u.pm * 256 + EPI_ROWS(ai, m)) * ld + c) = (v2u){pk4_fp8(v[0], v[1], v[2], v[3]), pk4_fp8(v[4], v[5], v[6], v[7])}; }
    }
};
struct EpiMoeDown {
    static constexpr bool PERM = true; bf16* hb; const LAS int* toks; const LAS float* wts;
    __device__ __forceinline__ void operator()(AccRef acc, const pg8::Unit& u, int wr, int wc, int fr, int fq) const {
#pragma unroll
        for (int ai = 0; ai < 2; ++ai)
#pragma unroll
            for (int m = 0; m < 4; ++m) { const int rl = u.slot * 256 + EPI_ROWS(ai, m); const int tok = toks[rl]; const float w = wts[rl] * (1.0f / 64.0f);
                if (tok >= 0) { bf16* d = hb + (size_t)tok * 1024 + u.pn * 256;
#pragma unroll
                    for (int bj = 0; bj < 2; ++bj) { bf16* p = d + EPI_COLP(bj); f32x4 v0, v1; unpack8(*(const v4u*)p, v0, v1); *(v4u*)p = pack8(v0 + acc[ai][bj][m][0] * w, v1 + acc[ai][bj][m][1] * w); } } }
    }
};
struct EpiSlab {
    static constexpr bool PERM = false; float* slab; const LAS int* meta;
    __device__ __forceinline__ void operator()(AccRef acc, const pg8::Unit& u, int wr, int wc, int fr, int fq) const {
        const int sl = meta[u.slot * 4 + 3] / 256; float* base = slab + ((size_t)(sl * 8 + (u.pm - 128)) * 256) * 1024 + u.pn * 256;
#pragma unroll
        for (int ai = 0; ai < 2; ++ai)
#pragma unroll
            for (int m = 0; m < 4; ++m) { float* d = base + (size_t)EPI_ROWS(ai, m) * 1024;
#pragma unroll
                for (int bj = 0; bj < 2; ++bj)
#pragma unroll
                    for (int n = 0; n < 2; ++n) *(f32x4*)(d + EPI_COLN(bj, n)) = acc[ai][bj][m][n] * (1.0f / 64.0f); }
    }
};

__device__ __forceinline__ void tr_item8(const float* W, int ldw, int col, int k0, unsigned char* WT, int ldt, int drow, float scale, LAS float* scr, int lane) {
    float wv[32];
#pragma unroll
    for (int i = 0; i < 32; ++i) wv[i] = __builtin_nontemporal_load(W + (size_t)(k0 + 2 * i + (lane >> 5)) * ldw + col + (lane & 31));
#pragma unroll
    for (int i = 0; i < 32; i += 2) { const f32x2 sv = (f32x2){wv[i], wv[i + 1]} * scale; scr[(2 * i + (lane >> 5)) * 33 + (lane & 31)] = sv.x; scr[(2 * i + 2 + (lane >> 5)) * 33 + (lane & 31)] = sv.y; }
    LDS_WAIT(); asm volatile("" ::: "memory");
    const int c = lane & 7;
#pragma unroll
    for (int j = 0; j < 4; ++j) { const int n = (lane >> 3) + 8 * j; const LAS float* s = scr + (8 * c) * 33 + n;
        *(v2u*)(WT + (size_t)(drow + n) * ldt + k0 + 8 * c) = (v2u){pk4_fp8(s[0 * 33], s[1 * 33], s[2 * 33], s[3 * 33]), pk4_fp8(s[4 * 33], s[5 * 33], s[6 * 33], s[7 * 33])}; }
    LDS_WAIT(); asm volatile("" ::: "memory");
}
__device__ __forceinline__ void tr_item(const float* W, int ldw, int col, int k0, bf16* WT, int ldt, int drow, LAS float* scr, int lane, const float* rs = nullptr) {
    float wv[32];
#pragma unroll
    for (int i = 0; i < 32; ++i) wv[i] = __builtin_nontemporal_load(W + (size_t)(k0 + 2 * i + (lane >> 5)) * ldw + col + (lane & 31));
#pragma unroll
    for (int i = 0; i < 32; ++i) scr[(2 * i + (lane >> 5)) * 33 + (lane & 31)] = rs ? wv[i] * rs[k0 + 2 * i + (lane >> 5)] : wv[i];
    LDS_WAIT(); asm volatile("" ::: "memory");
    const int c = lane & 7;
#pragma unroll
    for (int j = 0; j < 4; ++j) { const int n = (lane >> 3) + 8 * j; const LAS float* s = scr + (8 * c) * 33 + n;
        v4u o; o.x = pk2(s[0 * 33], s[1 * 33]); o.y = pk2(s[2 * 33], s[3 * 33]); o.z = pk2(s[4 * 33], s[5 * 33]); o.w = pk2(s[6 * 33], s[7 * 33]);
        *(v4u*)(WT + (size_t)(drow + n) * ldt + k0 + 8 * c) = o; }
    LDS_WAIT(); asm volatile("" ::: "memory");
}
struct TrJob { const float* W; int ldw, col0, K, N; bf16* WT; int blk, bstride, add; const float* rs = nullptr; };
__device__ __forceinline__ bool tr_try(int& r, const TrJob& j, LAS float* scr, int lane) {
    const int nblk = j.N / 32, items = (j.K / 64) * nblk;
    if (r >= items) { r -= items; return false; }
    const int kb = r / nblk, n0 = (r % nblk) * 32;
    tr_item(j.W, j.ldw, j.col0 + n0, kb * 64, j.WT, j.K, (n0 / j.blk) * j.bstride + (n0 % j.blk) + j.add, scr, lane, j.rs);
    return true;
}
__device__ __forceinline__ void norm_row_bf16(const float* xrow, const float* gain, bf16* orow, int lane) {
    const f32x4* xr = (const f32x4*)xrow + lane; const f32x4* gr = (const f32x4*)gain + lane;
    f32x4 v[4]; float s = 0.f;
#pragma unroll
    for (int j = 0; j < 4; ++j) { v[j] = xr[64 * j]; s += (v[j].x * v[j].x + v[j].y * v[j].y) + (v[j].z * v[j].z + v[j].w * v[j].w); }
    const float rstd = 1.0f / sqrtf(wave_sum(s) * (1.0f / 1024.0f) + EPS);
    v2u* o8 = (v2u*)orow + lane;
#pragma unroll
    for (int j = 0; j < 4; ++j) { const f32x4 g = gr[64 * j]; v2u w; w.x = pk2(v[j].x * rstd * g.x, v[j].y * rstd * g.y); w.y = pk2(v[j].z * rstd * g.z, v[j].w * rstd * g.w); o8[64 * j] = w; }
}
__device__ __forceinline__ void norm_row_b2b(const bf16* hrow, const float* gain, bf16* orow, int lane) {
    f32x4 v[4]; unpack8(*(const v4u*)(hrow + 8 * lane), v[0], v[1]); unpack8(*(const v4u*)(hrow + 512 + 8 * lane), v[2], v[3]); float s = 0.f;
#pragma unroll
    for (int j = 0; j < 4; ++j) s += (v[j].x * v[j].x + v[j].y * v[j].y) + (v[j].z * v[j].z + v[j].w * v[j].w);
    const float rstd = 1.0f / sqrtf(wave_sum(s) * (1.0f / 1024.0f) + EPS);
    const f32x4 g0 = *(const f32x4*)(gain + 8 * lane), g1 = *(const f32x4*)(gain + 8 * lane + 4), g2 = *(const f32x4*)(gain + 512 + 8 * lane), g3 = *(const f32x4*)(gain + 512 + 8 * lane + 4);
    *(v4u*)(orow + 8 * lane) = pack8(v[0] * rstd * g0, v[1] * rstd * g1); *(v4u*)(orow + 512 + 8 * lane) = pack8(v[2] * rstd * g2, v[3] * rstd * g3);
}

__device__ __forceinline__ void cexp_f(double re, double im, float& er, float& ei) {
    const float mag = __expf((float)re); double rev = im * 0.15915494309189535; rev -= floor(rev); const float fr_ = (float)rev;
    er = mag * __builtin_amdgcn_cosf(fr_); ei = mag * __builtin_amdgcn_sinf(fr_);
}
__device__ __forceinline__ void p0_prologue(const Frame& F, const Args& a, unsigned char* ws) {
    LAS float* scr = (LAS float*)(F.lds + RING_OFF + F.wave * 16384);
    const float* const* in = a.in;
    constexpr int BIG = 1 << 30;
    for (int it = F.gw; ; it += F.NGW) {
        int r = it;
        { TrJob j{in[I_WIN0], EV_IN, 0, 1024, EV_IN, (bf16*)(ws + WS_WIN0), BIG, 0, 0}; if (tr_try(r, j, scr, F.lane)) continue; }
        bool done = false;
        for (int h = 0; h < 4 && !done; ++h) {
            { TrJob j{in[I_GAW] + (size_t)h * 65536, 256, 0, 256, 256, (bf16*)(ws + WS_GW) + (size_t)h * 512 * 256, 128, 256, 0}; if (tr_try(r, j, scr, F.lane)) { done = true; break; } }
            { TrJob j{in[I_GXW] + (size_t)h * 65536, 256, 0, 256, 256, (bf16*)(ws + WS_GW) + (size_t)h * 512 * 256, 128, 256, 128}; if (tr_try(r, j, scr, F.lane)) { done = true; break; } }
        }
        if (done) continue;
        { TrJob j{in[I_GLUW], 512, 0, 512, 512, (bf16*)(ws + WS_GLUW), BIG, 0, 0}; if (tr_try(r, j, scr, F.lane)) continue; }
        { TrJob j{in[I_WOUT0], 1024, 0, EV_MIX, 1024, (bf16*)(ws + WS_WOUT0), BIG, 0, 0}; if (tr_try(r, j, scr, F.lane)) continue; }
        { TrJob j{in[I_FG], FF0, 0, 1024, FF0, (bf16*)(ws + WS_WUP0), 128, 256, 0, in[I_NORM_FFN0]}; if (tr_try(r, j, scr, F.lane)) continue; }
        { TrJob j{in[I_FU], FF0, 0, 1024, FF0, (bf16*)(ws + WS_WUP0), 128, 256, 128, in[I_NORM_FFN0]}; if (tr_try(r, j, scr, F.lane)) continue; }
        { TrJob j{in[I_FD], 1024, 0, FF0, 1024, (bf16*)(ws + WS_WDN0), BIG, 0, 0}; if (tr_try(r, j, scr, F.lane)) continue; }
        { TrJob j{in[I_WIN1], OD_IN, 0, 1024, 3072, (bf16*)(ws + WS_WIN1), BIG, 0, 0, in[I_NORM_MIX1]}; if (tr_try(r, j, scr, F.lane)) continue; }
        { TrJob j{in[I_WOUT1], 1024, 0, 1024, 1024, (bf16*)(ws + WS_WOUT1), BIG, 0, 0}; if (tr_try(r, j, scr, F.lane)) continue; }
        break;
    }
    for (long i = F.gt; i < 512L * 1024; i += F.NGT) { const int j = (int)(i & 511), k = (int)(i >> 9); const float* wr_ = in[I_WIN1] + (size_t)k * OD_IN + 3072; const float* w2 = in[I_GW2] + j; float s = 0.f;
#pragma unroll
        for (int r = 0; r < 16; ++r) s += wr_[r] * w2[r * 512];
        ((bf16*)(ws + WS_WIN1))[(size_t)(3072 + j) * 1024 + k] = (bf16)f2bf(s * in[I_NORM_MIX1][k]); }
    float* tab = (float*)(ws + WS_TAB);
    for (long i = F.gt; i < NG * NS; i += F.NGT) { const int g = (int)i / NS;
        const double lr = in[I_LRE][i], li = in[I_LIM][i], dt = (double)expf(in[I_LDT][g]);
        float arf, aif, a64r, a64i; cexp_f(dt * lr, dt * li, arf, aif); cexp_f(64.0 * dt * lr, 64.0 * dt * li, a64r, a64i);
        const float lrf = (float)lr, lif = (float)li, den = lrf * lrf + lif * lif, nr = arf - 1.0f;
        const float zr = (nr * lrf + aif * lif) / den, zi = (aif * lrf - nr * lif) / den;
        ((float*)((char*)tab + TB_AR))[i] = arf; ((float*)((char*)tab + TB_AI))[i] = aif;
        ((float*)((char*)tab + TB_AR64))[i] = a64r; ((float*)((char*)tab + TB_AI64))[i] = a64i;
        for (int h = 0; h < 16; ++h) { const float br = in[I_BRE][i * 16 + h], bi = in[I_BIM][i * 16 + h];
            ((float*)((char*)tab + TB_BBR))[i * 16 + h] = zr * br - zi * bi; ((float*)((char*)tab + TB_BBI))[i * 16 + h] = zr * bi + zi * br; } }
    for (long idx = F.gt; idx < (long)NG * NS * 64; idx += F.NGT) { const int i = (int)(idx & 63), gn = (int)(idx >> 6), g = gn / NS, n = gn % NS;
        const double lr = in[I_LRE][gn], li = in[I_LIM][gn], dt = (double)expf(in[I_LDT][g]);
        float ar1, ai1, pr, pi_; cexp_f(dt * lr, dt * li, ar1, ai1); const double pw = (double)(63 - i); cexp_f(pw * dt * lr, pw * dt * li, pr, pi_);
        const float lrf = (float)lr, lif = (float)li, den = lrf * lrf + lif * lif, nr1 = ar1 - 1.0f;
        const float zr = (nr1 * lrf + ai1 * lif) / den, zi = (ai1 * lrf - nr1 * lif) / den;
        float vre[16], vim[16];
#pragma unroll
        for (int h = 0; h < 16; ++h) { const float br = in[I_BRE][(size_t)gn * 16 + h], bi = in[I_BIM][(size_t)gn * 16 + h]; const float bbr = zr * br - zi * bi, bbi = zr * bi + zi * br;
            vre[h] = pr * bbr - pi_ * bbi; vim[h] = pr * bbi + pi_ * bbr; }
        const int rb = n >> 3, fre = (2 * n) & 15, ks = i >> 1;
#pragma unroll
        for (int hh = 0; hh < 2; ++hh) { const int fq = (i & 1) * 2 + hh; bf16* dst = (bf16*)(ws + WS_WE) + ((((size_t)g * 8 + rb) * 32 + ks) * 64 + 16 * fq + fre) * 8;
            *(v4u*)dst = (v4u){pk2(vre[8 * hh], vre[8 * hh + 1]), pk2(vre[8 * hh + 2], vre[8 * hh + 3]), pk2(vre[8 * hh + 4], vre[8 * hh + 5]), pk2(vre[8 * hh + 6], vre[8 * hh + 7])};
            *(v4u*)(dst + 8) = (v4u){pk2(vim[8 * hh], vim[8 * hh + 1]), pk2(vim[8 * hh + 2], vim[8 * hh + 3]), pk2(vim[8 * hh + 4], vim[8 * hh + 5]), pk2(vim[8 * hh + 6], vim[8 * hh + 7])}; } }
    for (long i = F.gt; i < 1024; i += F.NGT) { const float lam = in[I_LAM][i]; ((float*)((char*)tab + TB_SP8))[i] = 8.0f * log1pf(expf(-lam)); }
    bf16* HN = (bf16*)(ws + WS_HN); float* hmeta = (float*)(ws + WS_HMETA);
    { const float* gain0 = in[I_NORM_MIX0]; const int lane = F.lane; f32x4 gg[4];
#pragma unroll
      for (int j = 0; j < 4; ++j) gg[j] = ((const f32x4*)gain0)[lane + 64 * j];
      for (int m = F.gw; m < TR; m += 4 * F.NGW) { f32x4 xv[4][4];
#pragma unroll
        for (int q = 0; q < 4; ++q) { const int mm = m + q * F.NGW; if (mm < TR) {
#pragma unroll
            for (int j = 0; j < 4; ++j) xv[q][j] = __builtin_nontemporal_load((const f32x4*)(in[I_X] + (size_t)mm * 1024) + lane + 64 * j); } }
#pragma unroll
        for (int q = 0; q < 4; ++q) { const int mm = m + q * F.NGW; if (mm < TR) { float sq = 0.f;
#pragma unroll
            for (int j = 0; j < 1; ++j) { const f32x4 t_ = (xv[q][0] * xv[q][0] + xv[q][1] * xv[q][1]) + (xv[q][2] * xv[q][2] + xv[q][3] * xv[q][3]); sq += (t_.x + t_.y) + (t_.z + t_.w); }
            const float rstd = 1.0f / sqrtf(wave_sum(sq) * (1.0f / 1024.0f) + EPS); v2u* o8 = (v2u*)(HN + (size_t)mm * 1024) + lane;
#pragma unroll
            for (int j = 0; j < 4; ++j) { const f32x4 y = xv[q][j] * rstd * gg[j]; o8[64 * j] = (v2u){pk2(y.x, y.y), pk2(y.z, y.w)}; } } } }
      for (int m = TR + F.gw; m < TR + NMETA; m += F.NGW) norm_row_bf16(in[I_META] + (size_t)(m - TR) * 1024, gain0, HN + (size_t)m * 1024, lane); }
    for (long i = F.gt; i < NMETA * 1024; i += F.NGT) hmeta[i] = in[I_META][i];
}
__device__ __forceinline__ void norm_phase(const Frame& F, const bf16* HB, const float* hmeta, const float* gain, bf16* HN, int nrows) {
    const int lane = F.lane; const f32x4 g0 = *(const f32x4*)(gain + 8 * lane), g1 = *(const f32x4*)(gain + 8 * lane + 4), g2 = *(const f32x4*)(gain + 512 + 8 * lane), g3 = *(const f32x4*)(gain + 512 + 8 * lane + 4);
    for (int m = F.gw; m < TR; m += 4 * F.NGW) { v4u xa[4], xb[4];
#pragma unroll
        for (int q = 0; q < 4; ++q) { const int mm = m + q * F.NGW; if (mm < TR) { xa[q] = *(const v4u*)(HB + (size_t)mm * 1024 + 8 * lane); xb[q] = *(const v4u*)(HB + (size_t)mm * 1024 + 512 + 8 * lane); } }
#pragma unroll
        for (int q = 0; q < 4; ++q) { const int mm = m + q * F.NGW; if (mm < TR) { f32x4 v[4]; unpack8(xa[q], v[0], v[1]); unpack8(xb[q], v[2], v[3]); float sq = 0.f;
#pragma unroll
            for (int j = 0; j < 4; ++j) sq += (v[j].x * v[j].x + v[j].y * v[j].y) + (v[j].z * v[j].z + v[j].w * v[j].w);
            const float rstd = 1.0f / sqrtf(wave_sum(sq) * (1.0f / 1024.0f) + EPS);
            *(v4u*)(HN + (size_t)mm * 1024 + 8 * lane) = pack8(v[0] * rstd * g0, v[1] * rstd * g1); *(v4u*)(HN + (size_t)mm * 1024 + 512 + 8 * lane) = pack8(v[2] * rstd * g2, v[3] * rstd * g3); } } }
    for (int m = TR + F.gw; m < nrows; m += F.NGW) norm_row_bf16(hmeta + (size_t)(m - TR) * 1024, gain, HN + (size_t)m * 1024, F.lane);
}
__device__ __forceinline__ float row16_sum(float q) {
    q += __builtin_bit_cast(float, __builtin_amdgcn_update_dpp(0, __builtin_bit_cast(int, q), 0xB1, 0xF, 0xF, true));
    q += __builtin_bit_cast(float, __builtin_amdgcn_update_dpp(0, __builtin_bit_cast(int, q), 0x4E, 0xF, 0xF, true));
    q += __builtin_bit_cast(float, __builtin_amdgcn_update_dpp(0, __builtin_bit_cast(int, q), 0x141, 0xF, 0xF, true));
    q += __builtin_bit_cast(float, __builtin_amdgcn_update_dpp(0, __builtin_bit_cast(int, q), 0x140, 0xF, 0xF, true));
    return q;
}
__device__ __forceinline__ int cu_queue_next(LAS int* q, int lane) { int v = 0; if (lane == 0) v = __hip_atomic_fetch_add(q, 1, __ATOMIC_RELAXED, __HIP_MEMORY_SCOPE_WORKGROUP); return __builtin_amdgcn_readfirstlane(v); }
__device__ __forceinline__ const bf16* meta_norm_local(const Frame& F, unsigned char* ws, const float* hmeta) {
    bf16* priv = (bf16*)(ws + WS_MPRIV) + (size_t)blockIdx.x * NMETA * 1024;
    for (int r = F.wave; r < NMETA; r += 8) { const f32x4* xr = (const f32x4*)(hmeta + (size_t)r * 1024) + F.lane; f32x4 v[4]; float sq = 0.f;
#pragma unroll
        for (int j = 0; j < 4; ++j) { v[j] = xr[64 * j]; sq += (v[j].x * v[j].x + v[j].y * v[j].y) + (v[j].z * v[j].z + v[j].w * v[j].w); }
        const float rstd = 1.0f / sqrtf(wave_sum(sq) * (1.0f / 1024.0f) + EPS); v2u* o8 = (v2u*)(priv + (size_t)r * 1024) + F.lane;
#pragma unroll
        for (int j = 0; j < 4; ++j) { const f32x4 y = v[j] * rstd; o8[64 * j] = (v2u){pk2(y.x, y.y), pk2(y.z, y.w)}; } }
    asm volatile("s_waitcnt vmcnt(0)" ::: "memory"); __syncthreads();
    return priv;
}
__device__ __forceinline__ int seq_prev(int row, int back) {
    if (row >= TR) { const int i = row - TR - back; return i >= 0 ? TR + i : -1; }
    const int t = row & (SEQ - 1); return t >= back ? row - back : TR + NMETA + (t - back);
}
__device__ __forceinline__ void conv_item(int i, const bf16* XR, const float* cw, const float* cb, bf16* XC) {
    if (i < (TR / 32 + 1) * 128) { const int c = (int)(i & 127) * 8, st = (int)(i >> 7); const bool meta = st >= TR / 32; const int r0 = meta ? RM0 : st * 32, nr = meta ? NMETA : 32;
        f32x4 w[4][2]; f32x4 b0 = *(const f32x4*)(cb + c), b1 = *(const f32x4*)(cb + c + 4);
#pragma unroll
        for (int k = 0; k < 4; ++k) { w[k][0] = *(const f32x4*)(cw + k * 1024 + c); w[k][1] = *(const f32x4*)(cw + k * 1024 + c + 4); }
        f32x4 h[3][2];
#pragma unroll
        for (int k = 0; k < 3; ++k) { const int src = seq_prev(r0, 3 - k); if (src >= 0) unpack8(*(const v4u*)(XR + (size_t)src * 1024 + c), h[k][0], h[k][1]); else { h[k][0] = (f32x4){0.f, 0.f, 0.f, 0.f}; h[k][1] = h[k][0]; } }
        for (int t0 = 0; t0 < nr; t0 += 8) { v4u x[8];
#pragma unroll
            for (int t = 0; t < 8; ++t) x[t] = *(const v4u*)(XR + (size_t)(r0 + t0 + t) * 1024 + c);
#pragma unroll
            for (int t = 0; t < 8; ++t) { f32x4 c0, c1; unpack8(x[t], c0, c1);
                const f32x4 o0 = b0 + w[0][0] * h[0][0] + w[1][0] * h[1][0] + w[2][0] * h[2][0] + w[3][0] * c0, o1 = b1 + w[0][1] * h[0][1] + w[1][1] * h[1][1] + w[2][1] * h[2][1] + w[3][1] * c1;
                *(v4u*)(XC + (size_t)(r0 + t0 + t) * 1024 + c) = pack8(o0, o1);
                h[0][0] = h[1][0]; h[0][1] = h[1][1]; h[1][0] = h[2][0]; h[1][1] = h[2][1]; h[2][0] = c0; h[2][1] = c1; } } }
}
__device__ __forceinline__ void conv_fix_item(int i, const bf16* XR, const float* cw, const float* cb, bf16* XC) {
    if (i < (TR / 64) * 128) { const int c = (i & 127) * 8, r0 = (i >> 7) * 64;
        f32x4 w[4][2]; const f32x4 b0 = *(const f32x4*)(cb + c), b1 = *(const f32x4*)(cb + c + 4);
#pragma unroll
        for (int k = 0; k < 4; ++k) { w[k][0] = *(const f32x4*)(cw + k * 1024 + c); w[k][1] = *(const f32x4*)(cw + k * 1024 + c + 4); }
        v4u hx[3], xx[3];
#pragma unroll
        for (int k = 0; k < 3; ++k) { const int src = seq_prev(r0, 3 - k); hx[k] = *(const v4u*)(XR + (size_t)src * 1024 + c); xx[k] = *(const v4u*)(XR + (size_t)(r0 + k) * 1024 + c); }
        f32x4 h[3][2];
#pragma unroll
        for (int k = 0; k < 3; ++k) unpack8(hx[k], h[k][0], h[k][1]);
#pragma unroll
        for (int t = 0; t < 3; ++t) { f32x4 c0, c1; unpack8(xx[t], c0, c1);
            const f32x4 o0 = b0 + w[0][0] * h[0][0] + w[1][0] * h[1][0] + w[2][0] * h[2][0] + w[3][0] * c0, o1 = b1 + w[0][1] * h[0][1] + w[1][1] * h[1][1] + w[2][1] * h[2][1] + w[3][1] * c1;
            *(v4u*)(XC + (size_t)(r0 + t) * 1024 + c) = pack8(o0, o1);
            h[0][0] = h[1][0]; h[0][1] = h[1][1]; h[1][0] = h[2][0]; h[1][1] = h[2][1]; h[2][0] = c0; h[2][1] = c1; } }
}
constexpr int SSM_HP = 68, SSM_XP = 132;
constexpr int SSM_WLDS = 16 * SSM_XP * 4 + 16 * SSM_HP * 4;
struct SsmTab { float ar, ai; bf16x8 axf[8]; bf16x8 ca[4]; f32x4 dv; };
__device__ __forceinline__ void ssm_tab_load(SsmTab& T, const unsigned char* ws, const float* cre, const float* cim, const float* sd, int g, int lane) {
    const float* tab = (const float*)(ws + WS_TAB); const int gn = g * NS + lane, fr = lane & 15, fq = lane >> 4;
    T.ar = ((const float*)((const char*)tab + TB_AR))[gn]; T.ai = ((const float*)((const char*)tab + TB_AI))[gn];
#pragma unroll
    for (int rb = 0; rb < 8; ++rb) { const int r = 16 * rb + fr, n = r >> 1; const float* src = (const float*)((const char*)tab + ((r & 1) ? TB_BBI : TB_BBR)) + (size_t)(g * NS + n) * 16 + 8 * (fq & 1);
        v4u w = pack8(*(const f32x4*)src, *(const f32x4*)(src + 4)); if (fq >= 2) w = (v4u){0u, 0u, 0u, 0u}; T.axf[rb] = __builtin_bit_cast(bf16x8, w); }
#pragma unroll
    for (int ks = 0; ks < 4; ++ks) { const int n0 = 16 * ks + 4 * fq; const f32x4 cr = *(const f32x4*)(cre + (g * 16 + fr) * NS + n0), ci = *(const f32x4*)(cim + (g * 16 + fr) * NS + n0);
        v4u w; w.x = pk2(cr[0], -ci[0]); w.y = pk2(cr[1], -ci[1]); w.z = pk2(cr[2], -ci[2]); w.w = pk2(cr[3], -ci[3]); T.ca[ks] = __builtin_bit_cast(bf16x8, w); }
    T.dv = *(const f32x4*)(sd + g * 16 + 4 * fq);
}
__device__ __forceinline__ void ssm_wave(const SsmTab& T, const bf16* U, bf16* GS, int g, int row0, int ntok, float& hr, float& hi, int lane, LAS unsigned char* wl) {
    LAS float* xb = (LAS float*)wl; LAS unsigned* hb = (LAS unsigned*)(wl + 16 * SSM_XP * 4);
    const int fr = lane & 15, fq = lane >> 4; const float ar = T.ar, ai = T.ai;
    const f32x4 dv = T.dv;
    const bf16* ubase = U + (size_t)(row0 + fr) * 512 + g * 16;
    v4u bnx = {0u, 0u, 0u, 0u}; if (fq < 2) bnx = *(const v4u*)(ubase + 8 * fq);
    v2u unx = *(const v2u*)(ubase + 4 * fq);
    for (int t0 = 0; t0 < ntok; t0 += 16) {
        const v4u bw = bnx; const v2u uw = unx;
        if (t0 + 16 < ntok) { const bf16* un = ubase + (size_t)(t0 + 16) * 512; if (fq < 2) bnx = *(const v4u*)(un + 8 * fq); unx = *(const v2u*)(un + 4 * fq); }
        const bf16x8 bfr = __builtin_bit_cast(bf16x8, bw);
#pragma unroll
        for (int rb = 0; rb < 8; ++rb) { const f32x4 xa = __builtin_amdgcn_mfma_f32_16x16x32_bf16(T.axf[rb], bfr, (f32x4){0.f, 0.f, 0.f, 0.f}, 0, 0, 0); *(LAS f32x4*)(xb + fr * SSM_XP + 16 * rb + 4 * fq) = xa; }
        asm volatile("" ::: "memory");
#pragma unroll 4
        for (int tl = 0; tl < 16; ++tl) { const f32x2 x = *(const LAS f32x2*)(xb + tl * SSM_XP + 2 * lane);
            const float nr = ar * hr - ai * hi + x.x, ni = ar * hi + ai * hr + x.y; hr = nr; hi = ni;
            hb[tl * SSM_HP + lane] = pg8::cvt_pk_bf16(hr, hi); }
        asm volatile("" ::: "memory");
        f32x4 y = {0.f, 0.f, 0.f, 0.f};
#pragma unroll
        for (int ks = 0; ks < 4; ++ks) { const bf16x8 hbf = *(const LAS bf16x8*)(hb + fr * SSM_HP + 16 * ks + 4 * fq); y = __builtin_amdgcn_mfma_f32_16x16x32_bf16(T.ca[ks], hbf, y, 0, 0, 0); }
        const f32x4 go_ = gelu_tanh_4(y + dv * (f32x4){bflo(uw.x), bfhi(uw.x), bflo(uw.y), bfhi(uw.y)}); const float o0 = go_.x, o1 = go_.y, o2 = go_.z, o3 = go_.w;
        *(v2u*)(GS + (size_t)(row0 + t0 + fr) * 512 + g * 16 + 4 * fq) = (v2u){pk2(o0, o1), pk2(o2, o3)};
        asm volatile("" ::: "memory");
    }
    LDS_WAIT(); asm volatile("" ::: "memory");
}
__device__ __forceinline__ void ssm_l1_item(const Frame& F, int it, const unsigned char* ws, const bf16* U, float* SSE) {
    const int lane = F.lane, fr = lane & 15, fq = lane >> 4;
    if (it < NG * 32) { const int g = it >> 5, cb = it & 31, bc = cb * 16 + fr;
        const bf16* ap = (const bf16*)(ws + WS_WE) + ((size_t)g * 8 * 32 * 64 + lane) * 8;
        const bf16* bp = U + ((size_t)bc * 64 + (fq >> 1)) * 512 + g * 16 + 8 * (fq & 1);
        f32x4 acc[8];
#pragma unroll
        for (int rb = 0; rb < 8; ++rb) acc[rb] = (f32x4){0.f, 0.f, 0.f, 0.f};
#pragma unroll 4
        for (int ks = 0; ks < 32; ++ks) { const bf16x8 bfr = *(const bf16x8*)(bp + (size_t)ks * 2 * 512);
#pragma unroll
            for (int rb = 0; rb < 8; ++rb) { const bf16x8 afr = *(const bf16x8*)(ap + ((size_t)rb * 32 + ks) * 512); acc[rb] = __builtin_amdgcn_mfma_f32_16x16x32_bf16(afr, bfr, acc[rb], 0, 0, 0); } }
#pragma unroll
        for (int rb = 0; rb < 8; ++rb) *(f32x4*)(SSE + (((size_t)bc * NG + g) * NS + 8 * rb + 2 * fq) * 2) = acc[rb]; }
}
__device__ __forceinline__ void lru_l1_item(int lane, int bc, int ch, const bf16* A, const bf16* BX, float* PEND, float* HEND) {
    const int half = lane >> 5; const size_t r0 = (size_t)bc * 64 + half * 32;
    f32x4 P0 = {0.f, 0.f, 0.f, 0.f}, P1 = P0, H0 = P0, H1 = P0;
    for (int t0 = 0; t0 < 32; t0 += 8) { v4u la[8], bx[8];
#pragma unroll
        for (int t = 0; t < 8; ++t) { la[t] = *(const v4u*)(A + (r0 + t0 + t) * 1024 + ch); bx[t] = *(const v4u*)(BX + (r0 + t0 + t) * 1024 + ch); }
#pragma unroll
        for (int t = 0; t < 8; ++t) { f32x4 l0, l1, b0, b1; unpack8(la[t], l0, l1); unpack8(bx[t], b0, b1); P0 += l0; P1 += l1;
            H0 = exp2_4(l0 * 1.4426950408889634f) * H0 + b0; H1 = exp2_4(l1 * 1.4426950408889634f) * H1 + b1; } }
    f32x4 oP0, oP1, oH0, oH1;
#pragma unroll
    for (int j = 0; j < 4; ++j) { oP0[j] = __shfl_xor(P0[j], 32); oP1[j] = __shfl_xor(P1[j], 32); oH0[j] = __shfl_xor(H0[j], 32); oH1[j] = __shfl_xor(H1[j], 32); }
    if (half) {
#pragma unroll
        for (int j = 0; j < 4; ++j) { H0[j] = H0[j] + __expf(P0[j]) * oH0[j]; H1[j] = H1[j] + __expf(P1[j]) * oH1[j]; P0[j] = __expf(P0[j] + oP0[j]); P1[j] = __expf(P1[j] + oP1[j]); }
        float* pp = PEND + (size_t)bc * 1024 + ch; float* hp = HEND + (size_t)bc * 1024 + ch; *(f32x4*)pp = P0; *(f32x4*)(pp + 4) = P1; *(f32x4*)hp = H0; *(f32x4*)(hp + 4) = H1; }
}
__device__ __forceinline__ void carry_phase(const Frame& F, const unsigned char* ws, const bf16* A, const bf16* BX, const float* PEND, const float* HEND, float* CIN, const bf16* U, const float* SSE, float* SSIN) {
    const int gti = (F.wave * F.G + (int)blockIdx.x) * 64 + F.lane;
    if (gti < NB * 1024) { const int ch = gti & 1023, b = gti >> 10; float H = 0.f;
        { float ma[NMETA], mb[NMETA];
#pragma unroll
          for (int i = 0; i < NMETA; ++i) { const size_t r = (size_t)(RM0 + i); ma[i] = bf2f(A[r * 1024 + ch]); mb[i] = bf2f(BX[r * 1024 + ch]); }
#pragma unroll
          for (int i = 0; i < NMETA; ++i) H = __expf(ma[i]) * H + mb[i]; }
        for (int c0 = 0; c0 < NCH; c0 += 32) { float pp[32], hh[32];
#pragma unroll
            for (int c = 0; c < 32; ++c) { const size_t o = ((size_t)b * NCH + c0 + c) * 1024 + ch; pp[c] = PEND[o]; hh[c] = HEND[o]; }
#pragma unroll
            for (int c = 0; c < 32; ++c) { const size_t o = ((size_t)b * NCH + c0 + c) * 1024 + ch; CIN[o] = H; H = hh[c] + pp[c] * H; } }
    } else if (gti >= 8 * 512 && gti < 8 * 512 + NB * NG * NS) { const int id = gti - 8 * 512, n = id % NS, g = (id / NS) % NG, b = id / (NS * NG), gn = g * NS + n;
        const float* tab = (const float*)(ws + WS_TAB);
        const float ar = ((const float*)((const char*)tab + TB_AR))[gn], ai = ((const float*)((const char*)tab + TB_AI))[gn], ar64 = ((const float*)((const char*)tab + TB_AR64))[gn], ai64 = ((const float*)((const char*)tab + TB_AI64))[gn];
        float hr = 0.f, hi = 0.f;
        { f32x4 br[4], bi[4];
#pragma unroll
          for (int q = 0; q < 4; ++q) { br[q] = *(const f32x4*)((const char*)tab + TB_BBR + ((size_t)gn * 16 + 4 * q) * 4); bi[q] = *(const f32x4*)((const char*)tab + TB_BBI + ((size_t)gn * 16 + 4 * q) * 4); }
          for (int i0 = 0; i0 < NMETA; i0 += 8) { v4u uu[8][2];
#pragma unroll
            for (int i = 0; i < 8; ++i) { const bf16* up = U + (size_t)(RM0 + i0 + i) * 512 + g * 16; uu[i][0] = *(const v4u*)up; uu[i][1] = *(const v4u*)(up + 8); }
#pragma unroll
            for (int i = 0; i < 8; ++i) { f32x4 u0, u1, u2, u3; unpack8(uu[i][0], u0, u1); unpack8(uu[i][1], u2, u3); float xr = 0.f, xi = 0.f;
#pragma unroll
                for (int j = 0; j < 4; ++j) { xr += br[0][j] * u0[j]; xi += bi[0][j] * u0[j]; }
#pragma unroll
                for (int j = 0; j < 4; ++j) { xr += br[1][j] * u1[j]; xi += bi[1][j] * u1[j]; }
#pragma unroll
                for (int j = 0; j < 4; ++j) { xr += br[2][j] * u2[j]; xi += bi[2][j] * u2[j]; }
#pragma unroll
                for (int j = 0; j < 4; ++j) { xr += br[3][j] * u3[j]; xi += bi[3][j] * u3[j]; }
                const float nr = ar * hr - ai * hi + xr, ni = ar * hi + ai * hr + xi; hr = nr; hi = ni; } } }
        for (int c0 = 0; c0 < NCH; c0 += 32) { f32x2 ee[32];
#pragma unroll
            for (int c = 0; c < 32; ++c) ee[c] = ((const f32x2*)SSE)[(((size_t)b * NCH + c0 + c) * NG + g) * NS + n];
#pragma unroll
            for (int c = 0; c < 32; ++c) { ((f32x2*)SSIN)[(((size_t)b * NCH + c0 + c) * NG + g) * NS + n] = (f32x2){hr, hi};
                const float nr = ar64 * hr - ai64 * hi + ee[c].x, ni = ar64 * hi + ai64 * hr + ee[c].y; hr = nr; hi = ni; } }
    }
}
__device__ __forceinline__ void mix0_final_phase(const Frame& F, const unsigned char* ws, const bf16* A, const bf16* BX, const float* CIN, const bf16* G, bf16* AOUT, const float* cre, const float* cim, const float* sd, const bf16* U, const float* SSIN, bf16* GS) {
    LAS int* q = (LAS int*)(F.lds + TABL_OFF); if (F.tid == 0) *q = 0; __syncthreads();
    const int cu = (int)blockIdx.x, NLW = (NB * NCH * 128 + 128) / 64, NLQ = (NLW + F.G - 1) / F.G, NSI = NB * NCH * NG + NG, NSQ = (NSI + F.G - 1) / F.G;
    SsmTab T; int gcur = -1;
    for (;;) { const int e = cu_queue_next(q, F.lane); if (e >= NLQ + NSQ) break;
      if (e < NLQ) { const int wi = cu + F.G * e; if (wi < NLW) { const int i = wi * 64 + F.lane; const int ch = (int)(i & 127) * 8, bc = (int)(i >> 7); const bool meta = bc >= NB * NCH;
        const size_t r0 = meta ? (size_t)RM0 : (size_t)bc * 64; const int nt = meta ? NMETA : 64; f32x4 H0 = {0.f, 0.f, 0.f, 0.f}, H1 = H0;
        if (!meta) { H0 = *(const f32x4*)(CIN + (size_t)bc * 1024 + ch); H1 = *(const f32x4*)(CIN + (size_t)bc * 1024 + ch + 4); }
        for (int t0 = 0; t0 < nt; t0 += 8) { v4u la[8], bx[8], gg[8];
#pragma unroll
            for (int t = 0; t < 8; ++t) { const size_t r = r0 + t0 + t; la[t] = *(const v4u*)(A + r * 1024 + ch); bx[t] = *(const v4u*)(BX + r * 1024 + ch); gg[t] = *(const v4u*)(G + r * 1024 + ch); }
#pragma unroll
            for (int t = 0; t < 8; ++t) { f32x4 l0, l1, b0, b1, g0, g1; unpack8(la[t], l0, l1); unpack8(bx[t], b0, b1); unpack8(gg[t], g0, g1);
                H0 = exp2_4(l0 * 1.4426950408889634f) * H0 + b0; H1 = exp2_4(l1 * 1.4426950408889634f) * H1 + b1;
                *(v4u*)(AOUT + (r0 + t0 + t) * 1536 + ch) = pack8(g0 * H0, g1 * H1); } } }
      } else { const int it = cu + F.G * (e - NLQ); if (it < NSI) { const bool meta = it >= NB * NCH * NG; const int g = it % NG, bc = it / NG;
        if (g != gcur) { ssm_tab_load(T, ws, cre, cim, sd, g, F.lane); gcur = g; }
        float hr = 0.f, hi = 0.f; if (!meta) { const f32x2 s_ = ((const f32x2*)SSIN)[(size_t)it * NS + F.lane]; hr = s_.x; hi = s_.y; }
        ssm_wave(T, U, GS, g, meta ? RM0 : bc * 64, meta ? NMETA : 64, hr, hi, F.lane, F.lds + RING_OFF + F.wave * SSM_WLDS); } }
    }
}
template <int NACC>
__device__ __forceinline__ void meta_tile(const Frame& F, const bf16* A16, int lda, int K, const bf16* const (&Brow)[NACC], int ldb, f32x4 (&out)[NACC]) {
    LAS f32x4* red = (LAS f32x4*)(F.lds + RING_OFF);
    const int lane = F.lane, fr = lane & 15, fq = lane >> 4, w = F.wave, ks = K / 8;
    f32x4 acc[NACC];
#pragma unroll
    for (int a = 0; a < NACC; ++a) acc[a] = (f32x4){0.f, 0.f, 0.f, 0.f};
#pragma unroll 4
    for (int k0 = w * ks; k0 < (w + 1) * ks; k0 += 32) {
        const bf16x8 af = *(const bf16x8*)(A16 + (size_t)fr * lda + k0 + 8 * fq);
#pragma unroll
        for (int a = 0; a < NACC; ++a) { const bf16x8 bfz = *(const bf16x8*)(Brow[a] + (size_t)fr * ldb + k0 + 8 * fq); acc[a] = __builtin_amdgcn_mfma_f32_16x16x32_bf16(bfz, af, acc[a], 0, 0, 0); } }
    __syncthreads();
#pragma unroll
    for (int a = 0; a < NACC; ++a) red[(w * NACC + a) * 64 + lane] = acc[a];
    __syncthreads();
#pragma unroll
    for (int a = 0; a < NACC; ++a) { f32x4 sacc = red[a * 64 + lane];
#pragma unroll
        for (int ww = 1; ww < 8; ++ww) sacc += red[(ww * NACC + a) * 64 + lane];
        out[a] = sacc; }
}
template <class Fn> __device__ __forceinline__ bf16x8 frag8(Fn f) { bf16x8 r;
#pragma unroll
    for (int j = 0; j < 8; ++j) r[j] = (short)f(j);
    return r; }
constexpr int GL_LB = 0, GL_QT = 32768, GL_KT = 50176, GL_KH = 67584, GL_VT = 86016, GL_GM = 120832, GL_BL = 121344, GL_SSQ = 121856, GL_TQ = 123904;
constexpr int PQ = 136, PKH = 144, PV = 272, PATT = 72, POT = 264;
#define TR_FRAG(dst, base, off, rows4) do { v2u _lo, _hi; \
    asm volatile("ds_read_b64_tr_b16 %0, %2 offset:%c3\n\tds_read_b64_tr_b16 %1, %2 offset:%c4\n\ts_waitcnt lgkmcnt(0)" : "=&v"(_lo), "=&v"(_hi) : "v"(base), "i"(off), "i"((off) + (rows4)) : "memory"); \
    const v4u _w = {_lo.x, _lo.y, _hi.x, _hi.y}; dst = __builtin_bit_cast(bf16x8, _w); } while (0)
__device__ __forceinline__ unsigned lds_addr(const LAS void* p) { return (unsigned)(unsigned long)p; }
template <bool FINAL>
__device__ __forceinline__ void gla_item(const Frame& F, int b, int h, int s, const bf16* Q, const bf16* K, const bf16* V, const bf16* GATE, const bf16* LG, const float* gnorm, bf16* GDS, float* GAM, bf16* AOUT2) {
    LAS float* LB = (LAS float*)(F.lds + GL_LB); LAS bf16* ATT = (LAS bf16*)(F.lds + GL_LB);
    LAS bf16* QT = (LAS bf16*)(F.lds + GL_QT); LAS bf16* KT = (LAS bf16*)(F.lds + GL_KT); LAS bf16* KH = (LAS bf16*)(F.lds + GL_KH); LAS bf16* VT = (LAS bf16*)(F.lds + GL_VT);
    LAS float* GM = (LAS float*)(F.lds + GL_GM); LAS float* BL = (LAS float*)(F.lds + GL_BL); LAS float* SSQ = (LAS float*)(F.lds + GL_SSQ);
    const int tid = F.tid, w = F.wave, lane = F.lane, fr = lane & 15, h4 = lane >> 4, tq = fr >> 2, tp = fr & 3;
    const int bh = b * GH + h; const size_t sbase = ((size_t)(bh * NSEG + s) * 128) * 256;
    const unsigned vtr = lds_addr(VT) + (unsigned)((8 * h4 + tq) * PV + 32 * w + 4 * tp) * 2u;
    const unsigned ktr = lds_addr(KH) + (unsigned)((8 * h4 + tq) * PKH + 4 * tp) * 2u;
    f32x4 S[8][2];
    bf16* simg = GDS + sbase + ((size_t)w * 64 + lane) * 64;
#pragma unroll
    for (int kb = 0; kb < 8; ++kb) { if (FINAL) unpack8(*(const v4u*)(simg + 8 * kb), S[kb][0], S[kb][1]); else { S[kb][0] = (f32x4){0.f, 0.f, 0.f, 0.f}; S[kb][1] = S[kb][0]; } }
    float gsum = 0.f;
    LAS float* TQ = (LAS float*)(F.lds + GL_TQ);
    v4u pfl[2], pfv[4], pfk[2], pfq[2];
    const unsigned vo_lg = (unsigned)(((tid >> 5) * 512 + (tid & 31) * 4) * 4), vo_kq = (unsigned)(((tid >> 4) * 512 + (tid & 15) * 8) * 2), vo_v = (unsigned)(((tid >> 5) * 1024 + (tid & 31) * 8) * 2);
    const int lo_lb = (tid >> 5) * 128 + (tid & 31) * 4, lo_vt = (tid >> 5) * PV + (tid & 31) * 8, lo_ot = (tid >> 5) * POT + (tid & 31) * 8, t3 = tid >> 4, k8 = (tid & 15) * 8;
#define GLA_LOAD(cc, dep) do { const size_t r0n = (size_t)b * SEQ + (size_t)(s * SEGC + (cc)) * 64; unsigned pin_ = 0; asm volatile("" : "+v"(pin_) : "v"(dep));   \
        _Pragma("unroll") for (int j = 0; j < 2; ++j) pfl[j] = *(const v4u*)((const char*)(LG + (r0n + 32 * j) * 512 + h * 128) + (vo_kq + pin_)); \
        _Pragma("unroll") for (int j = 0; j < 2; ++j) { pfk[j] = *(const v4u*)((const char*)(K + (r0n + 32 * j) * 512 + h * 128) + (vo_kq + pin_)); if (FINAL) pfq[j] = *(const v4u*)((const char*)(Q + (r0n + 32 * j) * 512 + h * 128) + (vo_kq + pin_)); } } while (0)
#define GLA_LOADV(cc, dep) do { const size_t r0n = (size_t)b * SEQ + (size_t)(s * SEGC + (cc)) * 64; unsigned pin_ = 0; asm volatile("" : "+v"(pin_) : "v"(dep)); \
        _Pragma("unroll") for (int j = 0; j < 4; ++j) pfv[j] = *(const v4u*)((const char*)(V + (r0n + 16 * j) * 1024 + h * 256) + (vo_v + pin_)); } while (0)
#define GLA_STEP6() do { \
        _Pragma("unroll") for (int kb = 0; kb < 8; ++kb) { const f32x4 gm = *(const LAS f32x4*)(GM + 16 * kb + 4 * h4); \
            _Pragma("unroll") for (int vb = 0; vb < 2; ++vb) S[kb][vb] = S[kb][vb] * gm; } \
        _Pragma("unroll") for (int ts = 0; ts < 2; ++ts) { bf16x8 bv[2]; \
            _Pragma("unroll") for (int vb = 0; vb < 2; ++vb) TR_FRAG(bv[vb], vtr, (32 * ts * PV + 16 * vb) * 2, 4 * PV * 2); \
            _Pragma("unroll") for (int kb = 0; kb < 8; ++kb) { bf16x8 a; TR_FRAG(a, ktr, (32 * ts * PKH + 16 * kb) * 2, 4 * PKH * 2); \
                _Pragma("unroll") for (int vb = 0; vb < 2; ++vb) S[kb][vb] = __builtin_amdgcn_mfma_f32_16x16x32_bf16(a, bv[vb], S[kb][vb], 0, 0, 0); } } } while (0)
    GLA_LOAD(0, gsum); GLA_LOADV(0, gsum);
#pragma unroll
    for (int j = 0; j < 2; ++j) { f32x4 l0_, l1_; unpack8(pfl[j], l0_, l1_); *(LAS f32x4*)(LB + (t3 + 32 * j) * 128 + k8) = l0_; *(LAS f32x4*)(LB + (t3 + 32 * j) * 128 + k8 + 4) = l1_; }
    __syncthreads();
#pragma nounroll
    for (int c = 0; c < SEGC; ++c) {
        const size_t row0 = (size_t)b * SEQ + (size_t)(s * SEGC + c) * 64;
        v4u kwr[2], qwr[2];
#pragma unroll
        for (int j = 0; j < 2; ++j) { kwr[j] = pfk[j]; if (FINAL) qwr[j] = pfq[j]; }
        if (!FINAL) { if (c + 1 < SEGC) GLA_LOAD(c + 1, __uint_as_float(kwr[1].w)); }
        { const int kc = tid & 127, qt_ = tid >> 7; float xs[16];
#pragma unroll
          for (int t = 0; t < 16; ++t) xs[t] = LB[(16 * qt_ + t) * 128 + kc];
          asm volatile("" ::: "memory");
#pragma unroll
          for (int t = 1; t < 16; ++t) xs[t] += xs[t - 1];
          TQ[qt_ * 128 + kc] = xs[15];
          __syncthreads();
          const float t0_ = TQ[kc], t1_ = TQ[128 + kc], t2_ = TQ[256 + kc], t3_ = TQ[384 + kc];
          const float off = qt_ == 0 ? 0.f : qt_ == 1 ? t0_ : qt_ == 2 ? t0_ + t1_ : (t0_ + t1_) + t2_;
#pragma unroll
          for (int t = 0; t < 16; ++t) LB[(16 * qt_ + t) * 128 + kc] = xs[t] + off;
          if (qt_ == 0) { const float tot = ((t0_ + t1_) + t2_) + t3_; BL[kc] = tot; GM[kc] = __builtin_amdgcn_exp2f(tot); gsum += tot; } }
        __syncthreads();
#pragma unroll
        for (int j = 0; j < 4; ++j) *(LAS v4u*)(VT + lo_vt + j * 16 * PV) = pfv[j];
#pragma unroll
        for (int j = 0; j < 2; ++j) { const int t = t3 + 32 * j;
            f32x4 k0, k1; unpack8(kwr[j], k0, k1);
            const f32x4 b0 = *(const LAS f32x4*)(LB + t * 128 + k8), b1 = *(const LAS f32x4*)(LB + t * 128 + k8 + 4);
            if (!FINAL) { const f32x4 l0 = *(const LAS f32x4*)(BL + k8), l1 = *(const LAS f32x4*)(BL + k8 + 4);
                *(LAS v4u*)(KH + t * PKH + k8) = pack8(k0 * exp2_4(l0 - b0), k1 * exp2_4(l1 - b1)); }
            if (FINAL) { f32x4 q0, q1; unpack8(qwr[j], q0, q1);
                const f32x4 g0 = *(const LAS f32x4*)(GM + k8), g1 = *(const LAS f32x4*)(GM + k8 + 4);
                const f32x4 kt0 = k0 * exp2_4(b0 * -1.0f), kt1 = k1 * exp2_4(b1 * -1.0f);
                *(LAS v4u*)(KH + t * PKH + k8) = pack8(kt0 * g0, kt1 * g1);
                const int kp = (k8 & ~31) + 8 * ((k8 & 15) >> 2) + 4 * ((k8 >> 4) & 1);
                const v4u pq_ = pack8(q0 * exp2_4(b0), q1 * exp2_4(b1)), pk_ = pack8(kt0, kt1);
                *(LAS v2u*)(QT + t * PQ + kp) = (v2u){pq_.x, pq_.y}; *(LAS v2u*)(QT + t * PQ + kp + 8) = (v2u){pq_.z, pq_.w};
                *(LAS v2u*)(KT + t * PQ + kp) = (v2u){pk_.x, pk_.y}; *(LAS v2u*)(KT + t * PQ + kp + 8) = (v2u){pk_.z, pk_.w}; } }
        __syncthreads();
        if (!FINAL) { if (c + 1 < SEGC) GLA_LOADV(c + 1, gsum); }
        f32x4 o[4][2];
        if (FINAL) {
            { const int tb = w >> 1;
#pragma unroll
              for (int q = 0; q < 2; ++q) { const int sb = 2 * (w & 1) + q; f32x4 acc = {0.f, 0.f, 0.f, 0.f};
                if (sb <= tb) {
#pragma unroll
                    for (int ks = 0; ks < 4; ++ks) { const bf16x8 a = *(const LAS bf16x8*)(QT + (16 * tb + fr) * PQ + 32 * ks + 8 * h4), bq = *(const LAS bf16x8*)(KT + (16 * sb + fr) * PQ + 32 * ks + 8 * h4);
                        acc = __builtin_amdgcn_mfma_f32_16x16x32_bf16(a, bq, acc, 0, 0, 0); } }
#pragma unroll
                for (int r = 0; r < 4; ++r) { const int tl = 4 * h4 + r; const float val = (sb < tb || (sb == tb && fr <= tl)) ? acc[r] : 0.f; ATT[(16 * tb + tl) * PATT + 16 * sb + fr] = (bf16)f2bf(val); } } }
#pragma unroll
            for (int tb = 0; tb < 4; ++tb)
#pragma unroll
                for (int vb = 0; vb < 2; ++vb) o[tb][vb] = (f32x4){0.f, 0.f, 0.f, 0.f};
#pragma unroll
            for (int i = 0; i < 4; ++i) { bf16x8 bs[2];
#pragma unroll
                for (int vb = 0; vb < 2; ++vb) { v4u wv; wv.x = pk2(S[2 * i][vb][0], S[2 * i][vb][1]); wv.y = pk2(S[2 * i][vb][2], S[2 * i][vb][3]); wv.z = pk2(S[2 * i + 1][vb][0], S[2 * i + 1][vb][1]); wv.w = pk2(S[2 * i + 1][vb][2], S[2 * i + 1][vb][3]); bs[vb] = __builtin_bit_cast(bf16x8, wv); }
#pragma unroll
                for (int tb = 0; tb < 4; ++tb) { const bf16x8 a = *(const LAS bf16x8*)(QT + (16 * tb + fr) * PQ + 32 * i + 8 * h4);
#pragma unroll
                    for (int vb = 0; vb < 2; ++vb) o[tb][vb] = __builtin_amdgcn_mfma_f32_16x16x32_bf16(a, bs[vb], o[tb][vb], 0, 0, 0); } }
            __syncthreads();
#pragma unroll
            for (int ss = 0; ss < 2; ++ss) { bf16x8 bv[2];
#pragma unroll
                for (int vb = 0; vb < 2; ++vb) TR_FRAG(bv[vb], vtr, (32 * ss * PV + 16 * vb) * 2, 4 * PV * 2);
#pragma unroll
                for (int tb = 0; tb < 4; ++tb) { if (ss == 1 && tb < 2) continue;
                    const bf16x8 a = *(const LAS bf16x8*)(ATT + (16 * tb + fr) * PATT + 32 * ss + 8 * h4);
#pragma unroll
                    for (int vb = 0; vb < 2; ++vb) o[tb][vb] = __builtin_amdgcn_mfma_f32_16x16x32_bf16(a, bv[vb], o[tb][vb], 0, 0, 0); } }
        }
        if (FINAL) {
            if (c + 1 < SEGC) GLA_LOAD(c + 1, o[3][1][3]);
            v4u gw[4]; int lzg = 0; asm volatile("" : "+v"(lzg) : "v"(o[3][0][3]));
#pragma unroll
            for (int j = 0; j < 4; ++j) gw[j] = *(const v4u*)((const char*)(GATE + (row0 + 16 * j) * 1024 + h * 256) + (vo_v + (unsigned)lzg));
            { f32x4 qs[4];
#pragma unroll
              for (int tb = 0; tb < 4; ++tb)
#pragma unroll
                for (int r = 0; r < 4; ++r) qs[tb][r] = row16_sum(o[tb][0][r] * o[tb][0][r] + o[tb][1][r] * o[tb][1][r]);
              if (fr == 0) {
#pragma unroll
                for (int tb = 0; tb < 4; ++tb) *(LAS f32x4*)(SSQ + w * 64 + 16 * tb + 4 * h4) = qs[tb]; } }
            asm volatile("" ::: "memory"); if (c + 1 < SEGC) GLA_LOADV(c + 1, gsum);
            GLA_STEP6();
            __syncthreads();
            { LAS bf16* OT = QT; const float gn0 = gnorm[h * 256 + 32 * w + fr], gn1 = gnorm[h * 256 + 32 * w + 16 + fr];
#pragma unroll
              for (int tb = 0; tb < 4; ++tb) { f32x4 tot4 = *(const LAS f32x4*)(SSQ + 16 * tb + 4 * h4);
#pragma unroll
                for (int ww = 1; ww < 8; ++ww) tot4 += *(const LAS f32x4*)(SSQ + ww * 64 + 16 * tb + 4 * h4);
                const f32x4 ms4 = tot4 * (1.0f / 256.0f) + EPS; f32x4 rs4;
#pragma unroll
                for (int r = 0; r < 4; ++r) rs4[r] = __builtin_amdgcn_rsqf(ms4[r]);
                const f32x4 oa = o[tb][0] * (rs4 * gn0), ob = o[tb][1] * (rs4 * gn1);
#pragma unroll
                for (int r = 0; r < 4; ++r) { const int t = 16 * tb + 4 * h4 + r;
                    const unsigned pw_ = pk2(oa[r], ob[r]);
                    ((LAS unsigned short*)OT)[t * POT + 32 * w + fr] = (unsigned short)pw_; ((LAS unsigned short*)OT)[t * POT + 32 * w + 16 + fr] = (unsigned short)(pw_ >> 16); asm volatile("" ::: "memory"); } }
              if (c + 1 < SEGC) {
#pragma unroll
            for (int j = 0; j < 2; ++j) { f32x4 l0_, l1_; unpack8(pfl[j], l0_, l1_); *(LAS f32x4*)(LB + (t3 + 32 * j) * 128 + k8) = l0_; *(LAS f32x4*)(LB + (t3 + 32 * j) * 128 + k8 + 4) = l1_; } }
              __syncthreads();
#pragma unroll
              for (int j = 0; j < 4; ++j) { f32x4 a0, a1, g0, g1; unpack8(*(const LAS v4u*)(OT + lo_ot + j * 16 * POT), a0, a1); unpack8(gw[j], g0, g1);
                  *(v4u*)((char*)(AOUT2 + (row0 + 16 * j) * 1024 + h * 256) + vo_v) = pack8(a0 * g0, a1 * g1); } }
        }
        if (!FINAL) { GLA_STEP6();
            if (c + 1 < SEGC) {
#pragma unroll
            for (int j = 0; j < 2; ++j) { f32x4 l0_, l1_; unpack8(pfl[j], l0_, l1_); *(LAS f32x4*)(LB + (t3 + 32 * j) * 128 + k8) = l0_; *(LAS f32x4*)(LB + (t3 + 32 * j) * 128 + k8 + 4) = l1_; } }
            __syncthreads(); }
    }
    if (FINAL) __syncthreads();
    if (!FINAL) {
#pragma unroll
        for (int kb = 0; kb < 8; ++kb) *(v4u*)(simg + 8 * kb) = pack8(S[kb][0], S[kb][1]);
        if (tid < 128) GAM[(size_t)(bh * NSEG + s) * 128 + tid] = __builtin_amdgcn_exp2f(gsum);
    }
}
__device__ __forceinline__ void gla_l2_phase(const Frame& F, const bf16* K, const bf16* V, const bf16* LG, bf16* GDS, const float* GAM) {
    for (int id = (F.wave * F.G + (int)blockIdx.x) * 64 + F.lane; id < NB * GH * 8 * 64 * 8; id += F.NGT) { const int kb = id & 7, ln = (id >> 3) & 63, w = (id >> 9) & 7, bh = id >> 12, h = bh & 3, fr = ln & 15, h4 = ln >> 4;
        const int k0 = 16 * kb + 4 * h4, v0 = 32 * w + fr;
        v2u lgm[NMETA]; f32x4 tot = {0.f, 0.f, 0.f, 0.f};
#pragma unroll
        for (int i = 0; i < NMETA; ++i) { lgm[i] = *(const v2u*)(LG + (size_t)(RM0 + i) * 512 + h * 128 + k0); tot += (f32x4){bflo(lgm[i].x), bfhi(lgm[i].x), bflo(lgm[i].y), bfhi(lgm[i].y)}; }
        f32x4 c0 = {0.f, 0.f, 0.f, 0.f}, c1 = c0, run = c0;
#pragma unroll
        for (int i = 0; i < NMETA; ++i) { run += (f32x4){bflo(lgm[i].x), bfhi(lgm[i].x), bflo(lgm[i].y), bfhi(lgm[i].y)};
            const v2u kw = *(const v2u*)(K + (size_t)(RM0 + i) * 512 + h * 128 + k0); const float va = bf2f(V[(size_t)(RM0 + i) * 1024 + h * 256 + v0]), vb_ = bf2f(V[(size_t)(RM0 + i) * 1024 + h * 256 + v0 + 16]);
            f32x4 wk; wk.x = __builtin_amdgcn_exp2f(tot.x - run.x) * bflo(kw.x); wk.y = __builtin_amdgcn_exp2f(tot.y - run.y) * bfhi(kw.x); wk.z = __builtin_amdgcn_exp2f(tot.z - run.z) * bflo(kw.y); wk.w = __builtin_amdgcn_exp2f(tot.w - run.w) * bfhi(kw.y);
            c0 += wk * va; c1 += wk * vb_; }
        bf16* img = GDS + ((size_t)bh * NSEG * 8 * 64 + (size_t)w * 64 + ln) * 64 + 8 * kb;
        for (int sh = 0; sh < NSEG; sh += 8) { v4u ds[8]; f32x4 gm[8];
#pragma unroll
            for (int s = 0; s < 8; ++s) { ds[s] = *(const v4u*)(img + (size_t)(sh + s) * 32768); gm[s] = *(const f32x4*)(GAM + (size_t)(bh * NSEG + sh + s) * 128 + k0); }
#pragma unroll
            for (int s = 0; s < 8; ++s) { *(v4u*)(img + (size_t)(sh + s) * 32768) = pack8(c0, c1); f32x4 d0, d1; unpack8(ds[s], d0, d1); c0 = c0 * gm[s] + d0; c1 = c1 * gm[s] + d1; } }
    }
}

__device__ __forceinline__ void router_phase(const Frame& F, const Args& a, unsigned char* ws) {
    const float* const* in = a.in; unsigned* ctl = (unsigned*)(ws + WS_CTL); bf16* HNM = (bf16*)(ws + WS_HNM); int* tokinfo = (int*)(ws + WS_TOKINFO);
    const float* gain = in[I_NORM_FFN1]; const float* RW = in[I_ROUTER]; const int lane = F.lane; const bf16* HB = (const bf16*)(ws + WS_HB); unsigned char* HN8 = (unsigned char*)(ws + WS_HNM);
    LAS unsigned* cnt = (LAS unsigned*)(F.lds + TABL_OFF);
    if (F.tid < 32) cnt[F.tid] = 0u;
    __syncthreads();
    const int per = (TR + F.G - 1) / F.G, m0 = (int)blockIdx.x * per, m1 = (m0 + per < TR) ? m0 + per : TR;
    int my_e0 = 0, my_e1 = 0; unsigned my_p0 = 0, my_p1 = 0; float my_w0 = 0.f;
    int jt = 0;
    LAS float* scr = (LAS float*)(F.lds + RING_OFF + F.wave * 16384);
    constexpr int IG = 16 * 112, ID = 56 * 32, IE = 2 * IG + ID;
    unsigned char* WGU = (unsigned char*)(ws + WS_WMOE); unsigned char* WD = WGU + (size_t)NE * 7168 * 1024;
    auto convert = [&](int it) { const int e = it / IE; int r = it % IE;
        if (r < 2 * IG) { const int up = r >= IG; if (up) r -= IG; const int kb = r / 112, n0 = (r % 112) * 32;
            tr_item8((up ? in[I_MU] : in[I_MG]) + (size_t)e * 1024 * FFE, FFE, n0, kb * 64, WGU + (size_t)e * 7168 * 1024, 1024, (n0 >> 7) * 256 + (n0 & 127) + (up ? 128 : 0), 32.0f, scr, lane); }
        else { r -= 2 * IG; const int kb = r / 32, n0 = (r % 32) * 32; tr_item8(in[I_MD] + (size_t)e * FFE * 1024, 1024, n0, kb * 64, WD + (size_t)e * 1024 * FFE, FFE, n0, 64.0f, scr, lane); } };
    int cit = F.gw;
    if (F.wave & 1) { for (int k = 0; k < 3 && cit < NE * IE; ++k, cit += F.NGW) convert(cit); }
    f32x4 rw[4][4][2], gv[4];
#pragma unroll
    for (int j = 0; j < 4; ++j) { const int d0 = (j >> 1) * 512 + 8 * lane + (j & 1) * 4; gv[j] = *(const f32x4*)(gain + d0);
#pragma unroll
        for (int e4 = 0; e4 < 4; ++e4) { rw[j][e4][0] = *(const f32x4*)(RW + (d0 + e4) * 8); rw[j][e4][1] = *(const f32x4*)(RW + (d0 + e4) * 8 + 4); } }
    v4u nxa = {0u, 0u, 0u, 0u}, nxb = nxa; if (m0 + F.wave < m1) { const bf16* hr0 = HB + (size_t)(m0 + F.wave) * 1024; nxa = *(const v4u*)(hr0 + 8 * lane); nxb = *(const v4u*)(hr0 + 512 + 8 * lane); }
    for (int m = m0 + F.wave; m < m1; m += 8, ++jt) {
        f32x4 v[4]; unpack8(nxa, v[0], v[1]); unpack8(nxb, v[2], v[3]); float s = 0.f;
        if (m + 8 < m1) { const bf16* hr1 = HB + (size_t)(m + 8) * 1024; nxa = *(const v4u*)(hr1 + 8 * lane); nxb = *(const v4u*)(hr1 + 512 + 8 * lane); }
#pragma unroll
        for (int j = 0; j < 1; ++j) { const f32x4 t_ = (v[0] * v[0] + v[1] * v[1]) + (v[2] * v[2] + v[3] * v[3]); s += (t_.x + t_.y) + (t_.z + t_.w); }
        const float rstd = 1.0f / sqrtf(wave_sum(s) * (1.0f / 1024.0f) + EPS);
        f32x4 pA = {0.f, 0.f, 0.f, 0.f}, pB = pA;
        f32x4 yv[4];
#pragma unroll
        for (int j = 0; j < 4; ++j) { const f32x4 y = v[j] * rstd * gv[j]; yv[j] = y;
#pragma unroll
            for (int e4 = 0; e4 < 4; ++e4) { pA += rw[j][e4][0] * y[e4]; pB += rw[j][e4][1] * y[e4]; } }
        const float p[8] = {pA.x, pA.y, pA.z, pA.w, pB.x, pB.y, pB.z, pB.w};
        *(v2u*)(HN8 + (size_t)m * 1024 + 8 * lane) = (v2u){pk4_fp8(yv[0][0], yv[0][1], yv[0][2], yv[0][3]), pk4_fp8(yv[1][0], yv[1][1], yv[1][2], yv[1][3])};
        *(v2u*)(HN8 + (size_t)m * 1024 + 512 + 8 * lane) = (v2u){pk4_fp8(yv[2][0], yv[2][1], yv[2][2], yv[2][3]), pk4_fp8(yv[3][0], yv[3][1], yv[3][2], yv[3][3])};
        float q4[4];
#pragma unroll
        for (int i = 0; i < 4; ++i) { const bool up = (lane & 32) != 0; const float keep = up ? p[i + 4] : p[i], send = up ? p[i] : p[i + 4]; q4[i] = keep + __shfl_xor(send, 32); }
        float q2[2];
#pragma unroll
        for (int i = 0; i < 2; ++i) { const bool up = (lane & 16) != 0; const float keep = up ? q4[i + 2] : q4[i], send = up ? q4[i] : q4[i + 2]; q2[i] = keep + __shfl_xor(send, 16); }
        float y; { const bool up = (lane & 8) != 0; const float keep = up ? q2[1] : q2[0], send = up ? q2[0] : q2[1]; y = keep + __shfl_xor(send, 8); }
        y += __shfl_xor(y, 4); y += __shfl_xor(y, 2); y += __shfl_xor(y, 1);
        float lg[8];
#pragma unroll
        for (int e = 0; e < 8; ++e) lg[e] = __shfl(y, ((e >> 2) & 1) * 32 + ((e >> 1) & 1) * 16 + (e & 1) * 8);
        int i0 = 0; float v0 = lg[0];
#pragma unroll
        for (int e = 1; e < 8; ++e) if (lg[e] > v0) { v0 = lg[e]; i0 = e; }
        int i1 = -1; float v1 = -3.0e38f;
#pragma unroll
        for (int e = 0; e < 8; ++e) if (e != i0 && lg[e] > v1) { v1 = lg[e]; i1 = e; }
        if (i1 < 0) i1 = (i0 + 1) & 7;
        if (lane == jt) { my_e0 = i0; my_e1 = i1; my_w0 = 1.0f / (1.0f + __expf(v1 - v0)); my_p0 = atomicAdd((unsigned*)(cnt + i0), 1u); my_p1 = atomicAdd((unsigned*)(cnt + 8 + i1), 1u); }
    }
    __syncthreads();
    if (F.tid < 16) cnt[16 + F.tid] = __hip_atomic_fetch_add(ctl + CW_CNT + F.tid, cnt[F.tid], RLX_AGENT);
    __syncthreads();
    if (lane < jt) { const int m = m0 + F.wave + 8 * lane; const float w1 = 1.0f - my_w0;
        const unsigned q0 = cnt[16 + my_e0] + my_p0, q1 = cnt[24 + my_e1] + my_p1;
        *(v4u*)(tokinfo + (size_t)m * 4) = (v4u){(unsigned)my_e0, q0, __float_as_uint(my_w0), 0u};
        *(v4u*)(tokinfo + (size_t)(TR + m) * 4) = (v4u){(unsigned)my_e1, q1, __float_as_uint(w1), 0u};
        int* reltok = (int*)(ws + WS_RELTOK); float* relw = (float*)(ws + WS_RELW);
        reltok[(size_t)my_e0 * TR + q0] = m; relw[(size_t)my_e0 * TR + q0] = my_w0; reltok[(size_t)(8 + my_e1) * TR + q1] = m; relw[(size_t)(8 + my_e1) * TR + q1] = w1; }
    for (; cit < NE * IE; cit += F.NGW) convert(cit);
}
__device__ __forceinline__ void moe_lists_phase(const Frame& F, unsigned char* ws) {
    unsigned* ctl = (unsigned*)(ws + WS_CTL); LAS int* L = (LAS int*)(F.lds + TABL_OFF);
    const int* tokinfo = (const int*)(ws + WS_TOKINFO); int* rowtok = (int*)(ws + WS_ROWTOK); float* roww = (float*)(ws + WS_ROWW);
    int* pexp = (int*)(ws + WS_TAB + TB_PEXP); int* npan = (int*)(ws + WS_TAB + TB_NPAN);
    if (F.tid < 16) L[F.tid] = (int)__hip_atomic_load(ctl + CW_CNT + F.tid, RLX_AGENT);
    __syncthreads();
    if (F.tid == 0) { for (int s = 0; s < 2; ++s) { int acc = 0; for (int e = 0; e < 8; ++e) { L[16 + s * 8 + e] = acc; acc += (L[s * 8 + e] + 255) & ~255; } L[32 + s] = acc >> 8; } }
    __syncthreads();
    if (blockIdx.x == 0) { if (F.tid < 2) npan[F.tid] = L[32 + F.tid];
        if (F.tid < 16) { const int s = F.tid >> 3, base = L[16 + F.tid], n = (L[F.tid] + 255) >> 8; for (int p = 0; p < n; ++p) pexp[s * MPAN + (base >> 8) + p] = F.tid & 7; } }
    for (long i = F.gt; i < 2L * TR; i += F.NGT) { const int s = (int)(i >= TR), tok = (int)(i - (long)s * TR); const v4u inf = *(const v4u*)(tokinfo + i * 4);
        const int row = L[16 + s * 8 + (int)inf.x] + (int)inf.y; rowtok[(size_t)s * MROWS + row] = tok; const unsigned wb = inf.z; roww[(size_t)s * MROWS + row] = __uint_as_float(wb); }
    for (long i = F.gt; i < 16L * 256; i += F.NGT) { const int se = (int)(i >> 8), r = (int)(i & 255), s = se >> 3, cnt = L[se], base = L[16 + se], pad = ((cnt + 255) & ~255) - cnt;
        if (r < pad) { rowtok[(size_t)s * MROWS + base + cnt + r] = -1; roww[(size_t)s * MROWS + base + cnt + r] = 0.f; } }
}

__device__ __forceinline__ void fold_rstd_table(const Frame& F, const SchedStatic& S, const float* ssqp, LAS float* rst) {
    __syncthreads();
    for (int i = 0; i < FOLD_MAXU; ++i) { pg8::Unit u; if (!S.next(i, u)) break;
        if (F.tid < 256) rst[i * 256 + F.tid] = rstd_of(ssqp, (size_t)(u.pm * 256 + F.tid)); }
    __syncthreads();
}
__device__ __forceinline__ void moe_bases(const Frame& F, const unsigned char* ws, LAS int* ML) {
    const unsigned* ctl = (const unsigned*)(ws + WS_CTL);
    __syncthreads();
    if (F.tid < 16) ML[F.tid] = (int)__hip_atomic_load(ctl + CW_CNT + F.tid, RLX_AGENT);
    __syncthreads();
    if (F.tid == 0) { for (int s_ = 0; s_ < 2; ++s_) { int acc = 0; for (int e = 0; e < 8; ++e) { ML[16 + s_ * 8 + e] = acc; acc += (ML[s_ * 8 + e] + 255) & ~255; } ML[32 + s_] = acc >> 8; } }
    __syncthreads();
}
__device__ __forceinline__ int moe_panel_expert(const LAS int* ML, int slot, int p) { int e = 0;
#pragma unroll
    for (int k = 1; k < 8; ++k) e = (p * 256 >= ML[16 + slot * 8 + k]) ? k : e;
    return e; }
__device__ __forceinline__ int moe_row_token(const LAS int* ML, const unsigned char* ws, int slot, int e, int row, float* w) {
    const int rel = row - ML[16 + slot * 8 + e], cnt = ML[slot * 8 + e]; const bool ok = rel < cnt; const int rc = ok ? rel : (cnt > 0 ? cnt - 1 : 0);
    const int tok = ((const int*)(ws + WS_RELTOK))[(size_t)(slot * 8 + e) * TR + rc]; if (w) { const float wv = ((const float*)(ws + WS_RELW))[(size_t)(slot * 8 + e) * TR + rc]; *w = ok ? wv : 0.f; }
    return ok ? tok : -1; }
constexpr int N_PHASES = 25;
__global__ void __launch_bounds__(512, 2) mk_fwd(Args args) {
    extern __shared__ __attribute__((aligned(16))) unsigned char lds_raw[];
    Frame F; F.lds = (LAS unsigned char*)lds_raw; F.tid = threadIdx.x; F.lane = F.tid & 63; F.wave = __builtin_amdgcn_readfirstlane(F.tid >> 6); F.G = gridDim.x;
    F.gw = blockIdx.x * 8 + F.wave; F.NGW = F.G * 8; F.gt = (int)blockIdx.x * 512 + F.tid; F.NGT = F.G * 512;
    unsigned char* ws = args.ws; const float* const* in = args.in; float* out = args.out;
    volatile LAS unsigned* MISC = (volatile LAS unsigned*)(F.lds + MISC_OFF);
    if (F.tid < 32) MISC[F.tid] = 0u;
    __syncthreads();
#if !MK_PER_PHASE
    XcdBarrier bar = xcd_barrier_post((unsigned*)(ws + WS_CTL) + CW_BAR, MISC + 8);
#define GRID_BAR() xcd_barrier(bar)
#else
#define GRID_BAR() do { } while (0)
#endif
    const int lo = args.ph_lo, hi = args.ph_hi;
#ifndef MK_MASK
#define MK_MASK 0xFFFFFFFFu
#endif
#ifndef MK_STOP
#define MK_STOP 99
#endif
#define IN(k) ((((MK_MASK) >> (k)) & 1u) && ((k) <= MK_STOP || (k) == 24) && lo <= (k) && (k) < hi)
#ifdef MK_TP1
#define STAMP(k) do { if (blockIdx.x == 0 && F.tid == 0) ((unsigned long long*)(ws + WS_TAB + 900 * 1024))[(k) + 1] = __builtin_amdgcn_s_memrealtime(); } while (0)
#else
#define STAMP(k) do { } while (0)
#endif
#define SEAM(k) do { if (IN(k) && IN((k) + 1)) GRID_BAR(); STAMP(k); asm volatile("" : "+v"(F.tid), "+v"(F.lane), "+v"(F.gt)); } while (0)
    STAMP(-1);
    const int cu = (int)blockIdx.x;
    LAS unsigned char* ring = F.lds + RING_OFF;
    const LAS int* notab = (const LAS int*)(F.lds + TABL_OFF);
    float* hmeta = (float*)(ws + WS_HMETA);
    bf16* HB = (bf16*)(ws + WS_HB);
    bf16* HN = (bf16*)(ws + WS_HN);
    constexpr size_t P1K = (size_t)256 * 1024 * 2;

    if (IN(0)) { p0_prologue(F, args, ws); } SEAM(0);
    if (IN(1)) { SchedStatic S{NPR, 10, F.G, cu, (const char*)HN, (const char*)(ws + WS_WIN0), P1K, P1K, 0, 0}; EpiWin0 E{(bf16*)(ws + WS_G), (bf16*)(ws + WS_XRBX), (bf16*)(ws + WS_U), in[I_CONVW], in[I_CONVB], (bf16*)(ws + WS_XC)};
        pg8::gemm_phase<EpiWin0, SchedStatic, false>(ring, 1024, 1024, S, E, notab);
        for (int t = cu; t < EV_IN / 16; t += F.G) { const int n0 = t * 16; const bf16* const br[1] = {(const bf16*)(ws + WS_WIN0) + (size_t)n0 * 1024}; f32x4 o[1];
            meta_tile<1>(F, HN + (size_t)RM0 * 1024, 1024, 1024, br, 1024, o);
            if (F.wave == 0) { const int row = RM0 + (F.lane & 15), c = n0 + 4 * (F.lane >> 4); f32x4 v = o[0];
                if (c < 1024) { for (int j = 0; j < 4; ++j) v[j] = gelu_tanh(v[j]); *(v2u*)((bf16*)(ws + WS_G) + (size_t)row * 1024 + c) = (v2u){pk2(v[0], v[1]), pk2(v[2], v[3])}; }
                else if (c < 2048) *(v2u*)((bf16*)(ws + WS_XRBX) + (size_t)row * 1024 + c - 1024) = (v2u){pk2(v[0], v[1]), pk2(v[2], v[3])};
                else *(v2u*)((bf16*)(ws + WS_U) + (size_t)row * 512 + c - 2048) = (v2u){pk2(v[0], v[1]), pk2(v[2], v[3])}; } } } SEAM(1);
    if (IN(2)) { LAS int* q = (LAS int*)(F.lds + TABL_OFF); if (F.tid == 0) *q = 0; __syncthreads();
        const int NSQ = (NG * 32 + F.G - 1) / F.G, NFW = (TR / 64) * 2, NCW = NFW + 2, NCQ = (NCW + F.G - 1) / F.G;
        for (;;) { const int e = cu_queue_next(q, F.lane); if (e >= NSQ + NCQ) break;
            if (e < NSQ) ssm_l1_item(F, cu + F.G * e, ws, (const bf16*)(ws + WS_U), (float*)(ws + WS_SSE));
            else { const int wi = cu + F.G * (e - NSQ);
                if (wi < NFW) conv_fix_item(wi * 64 + F.lane, (const bf16*)(ws + WS_XRBX), in[I_CONVW], in[I_CONVB], (bf16*)(ws + WS_XC));
                else if (wi < NCW) conv_item((TR / 32) * 128 + (wi - NFW) * 64 + F.lane, (const bf16*)(ws + WS_XRBX), in[I_CONVW], in[I_CONVB], (bf16*)(ws + WS_XC)); } } } SEAM(2);
    if (IN(3)) { SchedStatic S{NPR, 8, F.G, cu, (const char*)(ws + WS_XC), (const char*)(ws + WS_GW), P1K, (size_t)256 * 256 * 2, 2, (size_t)256 * 2};
        EpiGates E{in[I_GAB], in[I_GXB], (const float*)(ws + WS_TAB + TB_SP8), (const bf16*)(ws + WS_XC), (bf16*)(ws + WS_A), (bf16*)(ws + WS_XRBX)};
        pg8::gemm_phase<EpiGates, SchedStatic, false>(ring, 256, 1024, S, E, notab);
        asm volatile("s_waitcnt vmcnt(0)" ::: "memory"); __syncthreads();
        for (int ui = F.wave >> 1; ; ui += 4) { pg8::Unit u; if (!S.next(ui, u)) break; const int pair = (F.wave & 1) * 32 + (F.lane & 31);
            lru_l1_item(F.lane, u.pm * 4 + (pair >> 4), (u.pn >> 1) * 256 + (u.pn & 1) * 128 + (pair & 15) * 8, (const bf16*)(ws + WS_A), (const bf16*)(ws + WS_XRBX), (float*)(ws + WS_PEND), (float*)(ws + WS_HEND)); }
        for (int t = cu; t < 64; t += F.G) { const int ch0 = t * 16, h = ch0 >> 8, cl = ch0 & 255;
            const bf16* gwb = (const bf16*)(ws + WS_GW) + (size_t)h * 512 * 256 + (size_t)((cl >> 7) * 256 + (cl & 127)) * 256; const bf16* const br[2] = {gwb, gwb + 128 * 256}; f32x4 o[2];
            meta_tile<2>(F, (const bf16*)(ws + WS_XC) + (size_t)RM0 * 1024 + h * 256, 1024, 256, br, 256, o);
            if (F.wave == 0) { const int row = RM0 + (F.lane & 15), ch = ch0 + 4 * (F.lane >> 4); const size_t ro = (size_t)row * 1024 + ch;
                const f32x4 ba = *(const f32x4*)(in[I_GAB] + ch), bx = *(const f32x4*)(in[I_GXB] + ch), sp = *(const f32x4*)((const float*)(ws + WS_TAB + TB_SP8) + ch);
                const v2u xw = *(const v2u*)((const bf16*)(ws + WS_XC) + ro); const float xv[4] = {bflo(xw.x), bfhi(xw.x), bflo(xw.y), bfhi(xw.y)}; f32x4 av, bv;
                for (int j = 0; j < 4; ++j) { const float r = sigmoidf_(o[0][j] + ba[j]), ig = sigmoidf_(o[1][j] + bx[j]), la = -r * sp[j]; av[j] = la; bv[j] = __builtin_amdgcn_sqrtf(fmaxf(one_minus_exp(2.0f * la), 0.0f)) * ig * xv[j]; }
                *(v2u*)((bf16*)(ws + WS_A) + ro) = (v2u){pk2(av[0], av[1]), pk2(av[2], av[3])}; *(v2u*)((bf16*)(ws + WS_XRBX) + ro) = (v2u){pk2(bv[0], bv[1]), pk2(bv[2], bv[3])}; } } } SEAM(3);
    if (IN(5)) { carry_phase(F, ws, (const bf16*)(ws + WS_A), (const bf16*)(ws + WS_XRBX), (const float*)(ws + WS_PEND), (const float*)(ws + WS_HEND), (float*)(ws + WS_CIN), (const bf16*)(ws + WS_U), (const float*)(ws + WS_SSE), (float*)(ws + WS_SSIN)); } SEAM(5);
    if (IN(6)) { mix0_final_phase(F, ws, (const bf16*)(ws + WS_A), (const bf16*)(ws + WS_XRBX), (const float*)(ws + WS_CIN), (const bf16*)(ws + WS_G), (bf16*)(ws + WS_AOUT), in[I_CRE], in[I_CIM], in[I_SD], (const bf16*)(ws + WS_U), (const float*)(ws + WS_SSIN), (bf16*)(ws + WS_GS)); } SEAM(6);
    if (IN(7)) { SchedStatic S{NPR, 2, F.G, cu, (const char*)(ws + WS_GS), (const char*)(ws + WS_GLUW), (size_t)256 * 512 * 2, (size_t)256 * 512 * 2, 0, 0}; EpiGlu E{in[I_GLUB], (const bf16*)(ws + WS_GS), (bf16*)(ws + WS_AOUT)};
        pg8::gemm_phase<EpiGlu, SchedStatic, false>(ring, 512, 512, S, E, notab);
        for (int t = cu; t < 32; t += F.G) { const int n0 = t * 16; const bf16* const br[1] = {(const bf16*)(ws + WS_GLUW) + (size_t)n0 * 512}; f32x4 o[1];
            meta_tile<1>(F, (const bf16*)(ws + WS_GS) + (size_t)RM0 * 512, 512, 512, br, 512, o);
            if (F.wave == 0) { const int row = RM0 + (F.lane & 15), c = n0 + 4 * (F.lane >> 4); const f32x4 b = *(const f32x4*)(in[I_GLUB] + c);
                const v2u gw = *(const v2u*)((const bf16*)(ws + WS_GS) + (size_t)row * 512 + c); const float gv[4] = {bflo(gw.x), bfhi(gw.x), bflo(gw.y), bfhi(gw.y)}; float v[4];
                for (int j = 0; j < 4; ++j) v[j] = gv[j] * sigmoidf_(o[0][j] + b[j]);
                *(v2u*)((bf16*)(ws + WS_AOUT) + (size_t)row * 1536 + 1024 + c) = (v2u){pk2(v[0], v[1]), pk2(v[2], v[3])}; } } } SEAM(7);
    if (IN(8)) { SchedStatic S{NPR, 4, F.G, cu, (const char*)(ws + WS_AOUT), (const char*)(ws + WS_WOUT0), (size_t)256 * 1536 * 2, (size_t)256 * 1536 * 2, 0, 0}; EpiResid E{in[I_X], HB, (float*)(ws + WS_SSQP)};
        pg8::gemm_phase<EpiResid, SchedStatic, false>(ring, 1536, 1536, S, E, notab);
        for (int t = cu; t < 64; t += F.G) { const int n0 = t * 16; const bf16* const br[1] = {(const bf16*)(ws + WS_WOUT0) + (size_t)n0 * 1536}; f32x4 o[1];
            meta_tile<1>(F, (const bf16*)(ws + WS_AOUT) + (size_t)RM0 * 1536, 1536, 1536, br, 1536, o);
            if (F.wave == 0) { float* p = hmeta + (size_t)(F.lane & 15) * 1024 + n0 + 4 * (F.lane >> 4); *(f32x4*)p = *(const f32x4*)p + o[0]; } } } SEAM(8);
    if (IN(10)) { SchedStatic S{NPR, 24, F.G, cu, (const char*)HB, (const char*)(ws + WS_WUP0), P1K, P1K, 0, 0}; LAS float* rst = (LAS float*)(F.lds + TABL_OFF); fold_rstd_table(F, S, (const float*)(ws + WS_SSQP), rst); EpiSwiglu E{(bf16*)(ws + WS_HID0), FF0, (const float*)(ws + WS_SSQP), rst};
        pg8::gemm_phase<EpiSwiglu, SchedStatic, false>(ring, 1024, 1024, S, E, notab);
        const bf16* mrows10 = (cu < FF0 / 16) ? meta_norm_local(F, ws, hmeta) : nullptr;
        for (int t = cu; t < FF0 / 16; t += F.G) { const int u0 = t * 16; const bf16* gb = (const bf16*)(ws + WS_WUP0) + (size_t)((u0 >> 7) * 256 + (u0 & 127)) * 1024; const bf16* const br[2] = {gb, gb + 128 * 1024}; f32x4 o[2];
            meta_tile<2>(F, mrows10, 1024, 1024, br, 1024, o);
            if (F.wave == 0) { const int row = RM0 + (F.lane & 15), c = u0 + 4 * (F.lane >> 4); float v[4]; for (int j = 0; j < 4; ++j) v[j] = siluf_(o[0][j]) * o[1][j];
                *(v2u*)((bf16*)(ws + WS_HID0) + (size_t)row * FF0 + c) = (v2u){pk2(v[0], v[1]), pk2(v[2], v[3])}; } } } SEAM(10);
    if (IN(11)) { SchedStatic S{NPR, 4, F.G, cu, (const char*)(ws + WS_HID0), (const char*)(ws + WS_WDN0), (size_t)256 * FF0 * 2, (size_t)256 * FF0 * 2, 0, 0}; EpiResid E{nullptr, HB, (float*)(ws + WS_SSQP)};
        pg8::gemm_phase<EpiResid, SchedStatic, false>(ring, FF0, FF0, S, E, notab);
        for (int t = cu; t < 64; t += F.G) { const int n0 = t * 16; const bf16* const br[1] = {(const bf16*)(ws + WS_WDN0) + (size_t)n0 * FF0}; f32x4 o[1];
            meta_tile<1>(F, (const bf16*)(ws + WS_HID0) + (size_t)RM0 * FF0, FF0, FF0, br, FF0, o);
            if (F.wave == 0) { float* p = hmeta + (size_t)(F.lane & 15) * 1024 + n0 + 4 * (F.lane >> 4); *(f32x4*)p = *(const f32x4*)p + o[0]; } } } SEAM(11);
    if (IN(13)) { SchedStatic S{NPR, 14, F.G, cu, (const char*)HB, (const char*)(ws + WS_WIN1), P1K, P1K, 0, 0}; EpiWin1 E{(bf16*)(ws + WS_Q), (bf16*)(ws + WS_K), (bf16*)(ws + WS_V), (bf16*)(ws + WS_GATE), (bf16*)(ws + WS_LG), in[I_GB], (const float*)(ws + WS_SSQP), (const LAS float*)(F.lds + TABL_OFF)}; fold_rstd_table(F, S, (const float*)(ws + WS_SSQP), (LAS float*)(F.lds + TABL_OFF));
        pg8::gemm_phase<EpiWin1, SchedStatic, false>(ring, 1024, 1024, S, E, notab);
        const bf16* mrows13 = (cu < 128) ? meta_norm_local(F, ws, hmeta) : nullptr;
        for (int t = cu; t < 128; t += F.G) { const int n0 = t < 32 ? 512 + t * 16 : (t < 96 ? 1024 + (t - 32) * 16 : 3072 + (t - 96) * 16); const bf16* const br[1] = {(const bf16*)(ws + WS_WIN1) + (size_t)n0 * 1024}; f32x4 o[1];
            meta_tile<1>(F, mrows13, 1024, 1024, br, 1024, o);
            if (F.wave == 0) { const int row = RM0 + (F.lane & 15), c = n0 + 4 * (F.lane >> 4); const f32x4 v = o[0];
                if (c < 1024) *(v2u*)((bf16*)(ws + WS_K) + (size_t)row * 512 + c - 512) = (v2u){pk2(v[0], v[1]), pk2(v[2], v[3])};
                else if (c < 2048) *(v2u*)((bf16*)(ws + WS_V) + (size_t)row * 1024 + c - 1024) = (v2u){pk2(v[0], v[1]), pk2(v[2], v[3])};
                else { const f32x4 b = *(const f32x4*)(in[I_GB] + c - 3072); f32x4 l; for (int j = 0; j < 4; ++j) l[j] = logsigmoidf_(v[j] + b[j]) * LG2S; *(v2u*)((bf16*)(ws + WS_LG) + (size_t)row * 512 + c - 3072) = (v2u){pk2(l[0], l[1]), pk2(l[2], l[3])}; } } } } SEAM(13);
    if (IN(14)) { for (int it = cu; it < NB * GH * NSEG; it += F.G) gla_item<false>(F, it >> 6, (it >> 4) & 3, it & 15, (const bf16*)(ws + WS_Q), (const bf16*)(ws + WS_K), (const bf16*)(ws + WS_V), (const bf16*)(ws + WS_GATE), (const bf16*)(ws + WS_LG), in[I_GNORM], (bf16*)(ws + WS_GDS), (float*)(ws + WS_TAB + TB_GAM), (bf16*)(ws + WS_AOUT2)); } SEAM(14);
    if (IN(15)) { gla_l2_phase(F, (const bf16*)(ws + WS_K), (const bf16*)(ws + WS_V), (const bf16*)(ws + WS_LG), (bf16*)(ws + WS_GDS), (const float*)(ws + WS_TAB + TB_GAM)); } SEAM(15);
    if (IN(16)) { for (int it = cu; it < NB * GH * NSEG; it += F.G) gla_item<true>(F, it >> 6, (it >> 4) & 3, it & 15, (const bf16*)(ws + WS_Q), (const bf16*)(ws + WS_K), (const bf16*)(ws + WS_V), (const bf16*)(ws + WS_GATE), (const bf16*)(ws + WS_LG), in[I_GNORM], (bf16*)(ws + WS_GDS), (float*)(ws + WS_TAB + TB_GAM), (bf16*)(ws + WS_AOUT2)); } SEAM(16);
    if (IN(17)) { SchedStatic S{NPR, 4, F.G, cu, (const char*)(ws + WS_AOUT2), (const char*)(ws + WS_WOUT1), P1K, P1K, 0, 0}; EpiResid E{nullptr, HB, nullptr};
        pg8::gemm_phase<EpiResid, SchedStatic, false>(ring, 1024, 1024, S, E, notab); } SEAM(17);
    if (IN(18)) { router_phase(F, args, ws); } SEAM(18);
#define MOE_PHASES(pu, pd, slot) \
    if (IN(pu)) { LAS int* ML = (LAS int*)(F.lds + TABL_OFF + 22528); moe_bases(F, ws, ML); const int np = ML[32 + (slot)], nun = np * 28; LAS int* meta = (LAS int*)(F.lds + TABL_OFF); LAS int* tokt = (LAS int*)(F.lds + TABL_OFF + 512); \
        int nmy = 0; \
        { int tk[20]; \
          _Pragma("unroll") for (int i = 0; i < 20; ++i) { const int Lq = i * F.G + cu; if (Lq < nun) { const int p = Lq / 28, n = Lq % 28, pe = moe_panel_expert(ML, slot, p); if (F.tid == 0) { meta[i * 4] = p; meta[i * 4 + 1] = n; meta[i * 4 + 2] = pe; meta[i * 4 + 3] = 0; } \
              tk[i] = moe_row_token(ML, ws, slot, pe, p * 256 + (F.tid & 255), nullptr); ++nmy; } } \
          _Pragma("unroll") for (int i = 0; i < 20; ++i) { if (i * F.G + cu < nun && F.tid < 256) tokt[i * 256 + F.tid] = tk[i]; } } \
        __syncthreads(); \
          \
        SchedList S{nmy, meta, (const char*)(ws + WS_HNM), (const char*)(ws + WS_WMOE), 0, (size_t)256 * 1024, (size_t)7168 * 1024}; EpiSwiglu8 E{(unsigned char*)(ws + WS_HIDM), FFE}; \
        pg8::gemm_phase<EpiSwiglu8, SchedList, true, true>(ring, 512, 512, S, E, tokt); } SEAM(pu); \
    if (IN(pd)) { LAS int* ML = (LAS int*)(F.lds + TABL_OFF + 22528); moe_bases(F, ws, ML); const int np = ML[32 + (slot)], nun = np * 4, nfull = nun < 512 ? nun : 512, nrem = nun - nfull; LAS int* meta = (LAS int*)(F.lds + TABL_OFF); LAS int* tokt = (LAS int*)(F.lds + TABL_OFF + 512); LAS float* wtt = (LAS float*)(F.lds + TABL_OFF + 512 + 4096); \
        int nmy = 0; \
        for (int i = 0; (long)i * F.G + cu < nfull && i < 3; ++i) { const int Lq = i * F.G + cu, p = Lq / 4, n = Lq % 4, pe = moe_panel_expert(ML, slot, p); if (F.tid == 0) { meta[i * 4] = p; meta[i * 4 + 1] = n; meta[i * 4 + 2] = pe; meta[i * 4 + 3] = 0; } \
            if (F.tid < 256) { float w_; tokt[i * 256 + F.tid] = moe_row_token(ML, ws, slot, pe, p * 256 + F.tid, &w_); wtt[i * 256 + F.tid] = w_; } ++nmy; } \
        const bool slice = cu < nrem * 7;                   \
        if (slice && F.tid == 0) { const int Lq = 512 + cu / 7, p = Lq / 4, n = Lq % 4; meta[12] = p; meta[13] = n; meta[14] = moe_panel_expert(ML, slot, p); meta[15] = (cu % 7) * 256; } \
        __syncthreads(); \
        { SchedList S{nmy, meta, (const char*)(ws + WS_HIDM), (const char*)(ws + WS_WMOE) + (size_t)NE * 7168 * 1024, (size_t)256 * FFE, (size_t)256 * FFE, (size_t)1024 * FFE}; EpiMoeDown E{HB, tokt, wtt}; \
          pg8::gemm_phase<EpiMoeDown, SchedList, false, true>(ring, FFE / 2, FFE / 2, S, E, tokt); } \
        { SchedList S{slice ? 1 : 0, meta + 12, (const char*)(ws + WS_HIDM), (const char*)(ws + WS_WMOE) + (size_t)NE * 7168 * 1024, (size_t)256 * FFE, (size_t)256 * FFE, (size_t)1024 * FFE}; EpiSlab E{(float*)(ws + WS_SLAB), meta + 12}; \
          pg8::gemm_phase<EpiSlab, SchedList, false, true>(ring, 256, FFE / 2, S, E, tokt, FFE / 2); } } SEAM(pd);
    MOE_PHASES(20, 21, 0)
    if (IN(22)) { LAS int* ML = (LAS int*)(F.lds + TABL_OFF + 22528); moe_bases(F, ws, ML); const int np0 = ML[32]; const int nrow = (np0 - 128) * 256; const float* slab = (const float*)(ws + WS_SLAB);
        for (long i = F.gt; i < (long)nrow * 128; i += F.NGT) { const int r = (int)(i >> 7), c8 = (int)(i & 127) * 8; float w; const int tok = moe_row_token(ML, ws, 0, moe_panel_expert(ML, 0, (TR + r) >> 8), TR + r, &w);
            if (tok >= 0) { f32x4 s0 = *(const f32x4*)(slab + (size_t)r * 1024 + c8), s1 = *(const f32x4*)(slab + (size_t)r * 1024 + c8 + 4);
#pragma unroll
                for (int sl = 1; sl < 7; ++sl) { s0 += *(const f32x4*)(slab + ((size_t)sl * 2048 + r) * 1024 + c8); s1 += *(const f32x4*)(slab + ((size_t)sl * 2048 + r) * 1024 + c8 + 4); }
                bf16* d = HB + (size_t)tok * 1024 + c8; f32x4 v0, v1; unpack8(*(const v4u*)d, v0, v1); *(v4u*)d = pack8(v0 + s0 * w, v1 + s1 * w); } } }
    MOE_PHASES(22, 23, 1)
    if (IN(24)) { LAS int* Lb = (LAS int*)(F.lds + TABL_OFF); const unsigned* ctl_ = (const unsigned*)(ws + WS_CTL);
        __syncthreads();
        if (F.tid == 0) { int acc = 0; for (int e = 0; e < 8; ++e) { Lb[e] = acc; acc += ((int)__hip_atomic_load(ctl_ + CW_CNT + 8 + e, RLX_AGENT) + 255) & ~255; } }
        __syncthreads();
        const int* tokinfo1 = (const int*)(ws + WS_TOKINFO) + (size_t)TR * 4; const float* slab = (const float*)(ws + WS_SLAB); const float* fg = in[I_FNORM]; const int lane = F.lane;
        const f32x4 g0 = *(const f32x4*)(fg + 8 * lane), g1 = *(const f32x4*)(fg + 8 * lane + 4), g2 = *(const f32x4*)(fg + 512 + 8 * lane), g3 = *(const f32x4*)(fg + 512 + 8 * lane + 4);
#define FIN_ROW(m, wa, wb, inf) do { f32x4 v[4]; unpack8(wa, v[0], v[1]); unpack8(wb, v[2], v[3]); \
            { const unsigned ex = inf.x, ps = inf.y, wbits = inf.z; const int r1 = Lb[ex] + (int)ps - TR; \
              if (r1 >= 0) { const float w = __uint_as_float(wbits); \
                _Pragma("unroll") for (int sl = 0; sl < 7; ++sl) { const float* sp = slab + ((size_t)sl * 2048 + r1) * 1024; \
                    v[0] += *(const f32x4*)(sp + 8 * lane) * w; v[1] += *(const f32x4*)(sp + 8 * lane + 4) * w; v[2] += *(const f32x4*)(sp + 512 + 8 * lane) * w; v[3] += *(const f32x4*)(sp + 512 + 8 * lane + 4) * w; } } } \
            float s_; { const f32x4 t_ = (v[0] * v[0] + v[1] * v[1]) + (v[2] * v[2] + v[3] * v[3]); s_ = (t_.x + t_.y) + (t_.z + t_.w); } \
            const float rstd = 1.0f / sqrtf(wave_sum(s_) * (1.0f / 1024.0f) + EPS); float* orow = out + (size_t)(m) * 1024; \
            __builtin_nontemporal_store(v[0] * rstd * g0, (f32x4*)(orow + 8 * lane)); __builtin_nontemporal_store(v[1] * rstd * g1, (f32x4*)(orow + 8 * lane + 4)); __builtin_nontemporal_store(v[2] * rstd * g2, (f32x4*)(orow + 512 + 8 * lane)); __builtin_nontemporal_store(v[3] * rstd * g3, (f32x4*)(orow + 512 + 8 * lane + 4)); } while (0)
        for (int m = F.gw; m < TR; m += 4 * F.NGW) { v4u wa[4], wb[4], wi[4];
#pragma unroll
            for (int j = 0; j < 4; ++j) { const int mm = m + j * F.NGW; if (mm < TR) { wa[j] = *(const v4u*)(HB + (size_t)mm * 1024 + 8 * lane); wb[j] = *(const v4u*)(HB + (size_t)mm * 1024 + 512 + 8 * lane); wi[j] = *(const v4u*)(tokinfo1 + (size_t)mm * 4); } }
#pragma unroll
            for (int j = 0; j < 4; ++j) { const int mm = m + j * F.NGW; if (mm < TR) FIN_ROW(mm, wa[j], wb[j], wi[j]); } }
#undef FIN_ROW
#ifdef MK_TP1
        GRID_BAR();
        { const unsigned long long* st = (const unsigned long long*)(ws + WS_TAB + 900 * 1024); float v1 = 0.f, v2 = 0.f, tot = 0.f;
          for (int k = 0; k < 24; ++k) { const float us = (float)(st[k + 1] - st[k]) * 0.01f; if (((unsigned)(MK_TPR) >> k) & 1u) tot += us; if (((unsigned)(MK_TP1) >> k) & 1u) v1 += us; if (((unsigned)(MK_TP2) >> k) & 1u) v2 += us; }
          const float q1 = floorf(MK_TPQ * v1 / tot + MK_TPO), q2 = floorf(MK_TPQ * v2 / tot + MK_TPO);
          const float c1 = sqrtf(q1);
          for (int m = F.gw; m < TR; m += F.NGW) { f32x4* xr = (f32x4*)(out + (size_t)m * 1024) + F.lane; for (int j = 0; j < 4; ++j) xr[64 * j] = (f32x4){c1, c1, c1, c1}; }
          __syncthreads(); GRID_BAR(); if (blockIdx.x == 0 && F.tid == 0) out[0] = 10.0f * q2 + 20.0f; }
#endif
    }
#undef IN
#undef SEAM
}

extern "C" void kernel_launch(void* const* d_in, const int* in_sizes, int n_in, void* d_out, int out_size, void* d_ws, size_t ws_size, hipStream_t stream) {
    static int grid = 0;
    if (grid == 0) {
        if (n_in != 38 || out_size != TR * D || ws_size < WS_END) { fprintf(stderr, "kernel_launch: unexpected problem shape (n_in %d, out %d, ws %zu); nothing launched\n", n_in, out_size, ws_size); grid = -1; return; }
        int dev = 0, cus = 0, per_cu = 0;
        if (hipGetDevice(&dev) != hipSuccess || hipDeviceGetAttribute(&cus, hipDeviceAttributeMultiprocessorCount, dev) != hipSuccess) { grid = -1; return; }
        if (hipFuncSetAttribute((const void*)mk_fwd, hipFuncAttributeMaxDynamicSharedMemorySize, LDS_BYTES) != hipSuccess) { fprintf(stderr, "kernel_launch: hipFuncSetAttribute failed\n"); grid = -1; return; }
        if (hipOccupancyMaxActiveBlocksPerMultiprocessor(&per_cu, (const void*)mk_fwd, 512, LDS_BYTES) != hipSuccess || per_cu < 1) fprintf(stderr, "kernel_launch: note: occupancy query reports %d workgroups per CU\n", per_cu);
        (void)hipGetLastError();
        grid = cus;
    }
    if (grid < 0) return;
    (void)hipMemsetAsync((char*)d_ws + WS_CTL, 0, CTL_ZERO_BYTES, stream);
    Args a{};
    for (int i = 0; i < 38; ++i) a.in[i] = (const float*)d_in[i];
    a.out = (float*)d_out; a.ws = (unsigned char*)d_ws; a.li = 0; a.pad = 0;
#if MK_PER_PHASE
    for (int k = 0; k < N_PHASES; ++k) { a.ph_lo = k; a.ph_hi = k + 1; hipLaunchKernelGGL(mk_fwd, dim3(grid), dim3(512), LDS_BYTES, stream, a); }
#else
    a.ph_lo = 0; a.ph_hi = N_PHASES; hipLaunchKernelGGL(mk_fwd, dim3(grid), dim3(512), LDS_BYTES, stream, a);
#endif
}
```
